# Optimizing an MI355X kernel written in HIP

```python
import functools
import jax, jax.numpy as jnp
from jax import lax
import numpy as np

D_MODEL = 1024
BATCH = 2
SEQ = 8192
DEPTH = 1

GRID_W = 64
CTX_LEN = 256
CHUNK = 64
EPS = 1e-6
NEG_BIG = -1e30
ML_HEADS = 4
ML_QK = D_MODEL // 8
ML_V = D_MODEL // 4
GLA_HEADS = 4
GLA_QK = D_MODEL // 8
GLA_V = D_MODEL // 4
GLA_RANK = 16
GLA_TAU = 16.0
CONV_K = 3
N_GROUPS = 4
EXPERTS_PER_GROUP = 4
N_EXPERTS = N_GROUPS * EXPERTS_PER_GROUP
TOP_K = 2
D_EXPERT = D_MODEL // 2
MOE_BLOCK = 128
ML_QK_W = ML_HEADS * ML_QK
ML_V_W = ML_HEADS * ML_V
GLA_QK_W = GLA_HEADS * GLA_QK
GLA_V_W = GLA_HEADS * GLA_V
IN_SIZES = (ML_QK_W, ML_QK_W, ML_V_W, ML_V_W, 4 * ML_HEADS,
            GLA_QK_W, GLA_QK_W, GLA_V_W, GLA_V_W, 2 * GLA_RANK,
            D_MODEL, D_MODEL)
IN_WIDTH = sum(IN_SIZES)

kernel_name = 'hybrid_mlstm_gla_hmoe_dit'


def rms_norm(x, g):
    xf = x.astype(jnp.float32)
    xf = xf * lax.rsqrt(jnp.mean(xf * xf, axis=-1, keepdims=True) + EPS)
    return xf.astype(x.dtype) * g


def split_heads(a, n_heads):
    bn, t, w = a.shape
    return a.reshape(bn, t, n_heads, w // n_heads).transpose(0, 2, 1, 3)


def merge_heads_rms(h, g, dtype):
    bn, nh, t, dh = h.shape
    h = h.transpose(0, 2, 1, 3)
    h = h * lax.rsqrt(jnp.mean(h * h, axis=-1, keepdims=True) + EPS)
    return h.reshape(bn, t, nh * dh).astype(dtype) * g


def flip_t(a):
    return jnp.flip(a, axis=2)


def dw_conv_silu(u, w, b, rows, cols):
    bn, t, ch = u.shape
    img = u.reshape(bn, rows, cols, ch)
    out = lax.conv_general_dilated(img, w[:, :, None, :], window_strides=(1, 1), padding='SAME',
                                   dimension_numbers=('NHWC', 'HWIO', 'NHWC'), feature_group_count=ch)
    return jax.nn.silu(out.reshape(bn, t, ch) + b)


def to_chunks(a):
    bn, nh, t = a.shape[:3]
    return jnp.moveaxis(a.reshape(bn, nh, t // CHUNK, CHUNK, *a.shape[3:]), 2, 0)


def from_chunks(a):
    nc, bn, nh, l = a.shape[:4]
    return jnp.moveaxis(a, 0, 2).reshape(bn, nh, nc * l, *a.shape[4:])


def mlstm_scan(q, k, v, i_pre, f_pre, state, with_output):
    tri = jnp.arange(CHUNK)[:, None] >= jnp.arange(CHUNK)[None, :]
    log_f = jax.nn.log_sigmoid(f_pre)

    def step(carry, xs):
        c_mat, n_vec, m = carry
        qc, kc, vc, ic, fc = xs
        b = jnp.cumsum(fc, axis=-1)
        b_end = b[..., -1]
        log_w = b_end[..., None] - b + ic
        m_new = jnp.maximum(b_end + m, jnp.max(log_w, axis=-1))
        w = jnp.exp(log_w - m_new[..., None])
        decay = jnp.exp(b_end + m - m_new)
        c_new = decay[..., None, None] * c_mat + jnp.einsum('bhs,bhsd,bhsv->bhdv', w, kc, vc)
        n_new = decay[..., None] * n_vec + jnp.einsum('bhs,bhsd->bhd', w, kc)
        if not with_output:
            return (c_new, n_new, m_new), None
        log_d = jnp.where(tri, b[..., :, None] - b[..., None, :] + ic[..., None, :], -jnp.inf)
        log_inter = b + m[..., None]
        m_t = jnp.maximum(log_inter, jnp.max(log_d, axis=-1))
        s = jnp.einsum('bhtd,bhsd->bhts', qc, kc) * jnp.exp(log_d - m_t[..., None])
        w_inter = jnp.exp(log_inter - m_t)
        num = jnp.einsum('bhts,bhsv->bhtv', s, vc) + w_inter[..., None] * jnp.einsum('bhtd,bhdv->bhtv', qc, c_mat)
        den = jnp.abs(jnp.sum(s, axis=-1) + w_inter * jnp.einsum('bhtd,bhd->bht', qc, n_vec))
        h = num / jnp.maximum(den, jnp.exp(-m_t))[..., None]
        return (c_new, n_new, m_new), h

    state, hs = lax.scan(step, state, (to_chunks(q), to_chunks(k), to_chunks(v), to_chunks(i_pre), to_chunks(log_f)))
    return (from_chunks(hs) if with_output else None), state


def gla_scan(q, k, v, log_a, state, with_output):
    tri = jnp.arange(CHUNK)[:, None] >= jnp.arange(CHUNK)[None, :]

    def step(s_mat, xs):
        qc, kc, vc, ac = xs
        b = jnp.cumsum(ac, axis=2)
        b_end = b[:, :, -1]
        s_new = jnp.exp(b_end)[..., None] * s_mat + jnp.einsum('bhsd,bhsv->bhdv', kc * jnp.exp(b_end[:, :, None] - b), vc)
        if not with_output:
            return s_new, None
        rel = jnp.where(tri[:, :, None], b[:, :, :, None] - b[:, :, None], -jnp.inf)
        scores = jnp.einsum('bhtd,bhsd,bhtsd->bhts', qc, kc, jnp.exp(rel))
        o = jnp.einsum('bhts,bhsv->bhtv', scores, vc) + jnp.einsum('bhtd,bhdv->bhtv', qc * jnp.exp(b), s_mat)
        return s_new, o

    state, os_ = lax.scan(step, state, (to_chunks(q), to_chunks(k), to_chunks(v), to_chunks(log_a)))
    return (from_chunks(os_) if with_output else None), state


def empty_states(bn):
    ml = (jnp.zeros((bn, ML_HEADS, ML_QK, ML_V), jnp.float32),
          jnp.zeros((bn, ML_HEADS, ML_QK), jnp.float32),
          jnp.full((bn, ML_HEADS), NEG_BIG, jnp.float32))
    gla = jnp.zeros((bn, GLA_HEADS, GLA_QK, GLA_V), jnp.float32)
    return (ml, ml, gla, gla)


def token_mixers(h, conv_fn, init_states, with_output, w_in, ml_conv, ml_conv_b, b_mgate, ml_norm,
                 gla_w2, gla_b2, gla_norm, w_proj_m, w_proj_g, w_out):
    bn, t, _ = h.shape
    f32 = jnp.float32
    cuts = [int(s) for s in np.cumsum(IN_SIZES)[:-1]]
    (q_m, k_m, v_m, o_m, gate_m, q_g, k_g, v_g, r_g, lr_g, mg_m, mg_g) = jnp.split(h @ w_in, cuts, axis=-1)
    st_mf, st_mb, st_gf, st_gb = init_states

    qk = conv_fn(jnp.concatenate([q_m, k_m], axis=-1), ml_conv, ml_conv_b)
    q_m, k_m = jnp.split(qk, 2, axis=-1)
    qm = split_heads(q_m, ML_HEADS).astype(f32)
    km = split_heads(k_m, ML_HEADS).astype(f32) * (ML_QK ** -0.5)
    vm = split_heads(v_m, ML_HEADS).astype(f32)
    gm = (gate_m + b_mgate).astype(f32).reshape(bn, t, 2, 2, ML_HEADS).transpose(2, 3, 0, 4, 1)
    hm_f, st_mf = mlstm_scan(qm, km, vm, gm[0, 0], gm[0, 1], st_mf, with_output)
    hm_b, st_mb = mlstm_scan(flip_t(qm), flip_t(km), flip_t(vm), flip_t(gm[1, 0]), flip_t(gm[1, 1]), st_mb, with_output)

    qg = split_heads(q_g, GLA_HEADS).astype(f32) * (GLA_QK ** -0.5)
    kg = split_heads(k_g, GLA_HEADS).astype(f32)
    vg = split_heads(v_g, GLA_HEADS).astype(f32)
    lr = lr_g.astype(f32).reshape(bn, t, 2, GLA_RANK)
    log_a = jax.nn.log_sigmoid(jnp.einsum('btdr,dre->dbte', lr, gla_w2.astype(f32)) + gla_b2.astype(f32)[:, None, None, :]) / GLA_TAU
    og_f, st_gf = gla_scan(qg, kg, vg, split_heads(log_a[0], GLA_HEADS), st_gf, with_output)
    og_b, st_gb = gla_scan(flip_t(qg), flip_t(kg), flip_t(vg), flip_t(split_heads(log_a[1], GLA_HEADS)), st_gb, with_output)

    states = (st_mf, st_mb, st_gf, st_gb)
    if not with_output:
        return None, states
    y_m = merge_heads_rms(hm_f + flip_t(hm_b), ml_norm, h.dtype) * jax.nn.sigmoid(o_m)
    y_g = merge_heads_rms(og_f + flip_t(og_b), gla_norm, h.dtype) * jax.nn.silu(r_g)
    y = jax.nn.sigmoid(mg_m) * (y_m @ w_proj_m) + jax.nn.sigmoid(mg_g) * (y_g @ w_proj_g)
    return y @ w_out, states


def hier_moe(h, w_grp, b_grp, w_rexp, b_rexp, w_up, w_down):
    bn, t, d = h.shape
    n_tok = bn * t
    hf = h.reshape(n_tok, d)
    p_grp = jax.nn.softmax((hf @ w_grp + b_grp).astype(jnp.float32), axis=-1)
    grp_p, grp = lax.top_k(p_grp, 1)
    e_logits = (hf @ w_rexp + b_rexp).astype(jnp.float32).reshape(n_tok, N_GROUPS, EXPERTS_PER_GROUP)
    p_in = jax.nn.softmax(e_logits[jnp.arange(n_tok), grp[:, 0]], axis=-1)
    top_p, top_i = lax.top_k(p_in, TOP_K)
    weights = grp_p * top_p / jnp.sum(top_p, axis=-1, keepdims=True)
    expert = grp * EXPERTS_PER_GROUP + top_i

    n_assign = n_tok * TOP_K
    flat_e = expert.reshape(n_assign)
    flat_t = jnp.repeat(jnp.arange(n_tok, dtype=jnp.int32), TOP_K)
    flat_w = weights.reshape(n_assign)
    order = jnp.argsort(flat_e)
    se, st, sw = flat_e[order], flat_t[order], flat_w[order]
    counts = jnp.zeros((N_EXPERTS,), jnp.int32).at[flat_e].add(1)
    padded = (counts + MOE_BLOCK - 1) // MOE_BLOCK * MOE_BLOCK
    pad_end = jnp.cumsum(padded)
    dest = (pad_end - padded)[se] + jnp.arange(n_assign, dtype=jnp.int32) - (jnp.cumsum(counts) - counts)[se]
    n_blocks = -(-n_assign // MOE_BLOCK) + N_EXPERTS
    n_rows = n_blocks * MOE_BLOCK
    row_tok = jnp.full((n_rows,), n_tok, jnp.int32).at[dest].set(st)
    row_w = jnp.zeros((n_rows,), jnp.float32).at[dest].set(sw)
    block_e = jnp.minimum(jnp.searchsorted(pad_end, jnp.arange(n_blocks, dtype=jnp.int32) * MOE_BLOCK, side='right'), N_EXPERTS - 1)
    x_rows = jnp.concatenate([hf, jnp.zeros((1, d), h.dtype)], axis=0)[row_tok].reshape(n_blocks, MOE_BLOCK, d)

    def expert_block(args):
        xb, e = args
        gate, up = jnp.split(xb @ w_up[e], 2, axis=-1)
        return (jax.nn.silu(gate) * up) @ w_down[e]

    y_rows = lax.map(expert_block, (x_rows, block_e)).reshape(n_rows, d)
    y = jnp.zeros((n_tok + 1, d), h.dtype).at[row_tok].add(y_rows * row_w[:, None].astype(h.dtype))
    return y[:n_tok].reshape(bn, t, d)


def setup_inputs(seed: int = 0) -> dict:
    key = jax.random.key(seed)
    ks = jax.random.split(key, 26)

    def nrm(k, shape, scale):
        return jax.random.normal(k, shape, jnp.float32) * scale

    L = DEPTH
    d = D_MODEL
    inv = d ** -0.5
    gate_offset = jnp.array([0.0, 3.0], jnp.float32)[None, None, :, None]
    return {
        'x': nrm(ks[0], (BATCH, SEQ, d), 1.0),
        'c': nrm(ks[1], (BATCH, d), 1.0),
        'ctx': nrm(ks[2], (BATCH, CTX_LEN, d), 1.0),
        'c_ctx': nrm(ks[3], (d,), 1.0),
        'w_mod': nrm(ks[4], (L, d, 6 * d), 0.5 * inv),
        'b_mod': nrm(ks[5], (L, 6 * d), 0.01),
        'g_norm1': 1.0 + nrm(ks[6], (L, d), 0.1),
        'w_in': nrm(ks[7], (L, d, IN_WIDTH), inv),
        'ml_conv': nrm(ks[8], (L, CONV_K, CONV_K, 2 * ML_QK_W), 1.0 / CONV_K),
        'ml_conv_b': nrm(ks[9], (L, 2 * ML_QK_W), 0.01),
        'b_mgate': (nrm(ks[10], (L, 2, 2, ML_HEADS), 0.1) + gate_offset).reshape(L, 4 * ML_HEADS),
        'ml_norm': 1.0 + nrm(ks[11], (L, ML_V_W), 0.1),
        'gla_w2': nrm(ks[12], (L, 2, GLA_RANK, GLA_QK_W), GLA_RANK ** -0.5),
        'gla_b2': nrm(ks[13], (L, 2, GLA_QK_W), 0.01),
        'gla_norm': 1.0 + nrm(ks[14], (L, GLA_V_W), 0.1),
        'w_proj_m': nrm(ks[15], (L, ML_V_W, d), ML_V_W ** -0.5),
        'w_proj_g': nrm(ks[16], (L, GLA_V_W, d), GLA_V_W ** -0.5),
        'w_out': nrm(ks[17], (L, d, d), inv),
        'g_norm2': 1.0 + nrm(ks[18], (L, d), 0.1),
        'w_grp': nrm(ks[19], (L, d, N_GROUPS), inv),
        'b_grp': nrm(ks[20], (L, N_GROUPS), 0.01),
        'w_rexp': nrm(ks[21], (L, d, N_EXPERTS), inv),
        'b_rexp': nrm(ks[22], (L, N_EXPERTS), 0.01),
        'w_up': nrm(ks[23], (L, N_EXPERTS, d, 2 * D_EXPERT), inv),
        'w_down': nrm(ks[24], (L, N_EXPERTS, D_EXPERT, d), D_EXPERT ** -0.5),
        'g_final': 1.0 + nrm(ks[25], (d,), 0.1),
    }


def reference(x, c, ctx, c_ctx, w_mod, b_mod, g_norm1, w_in, ml_conv, ml_conv_b, b_mgate, ml_norm,
              gla_w2, gla_b2, gla_norm, w_proj_m, w_proj_g, w_out, g_norm2, w_grp, b_grp, w_rexp, b_rexp,
              w_up, w_down, g_final):
    bn, t, _ = x.shape
    rows = t // GRID_W
    conv_lat = functools.partial(dw_conv_silu, rows=rows, cols=GRID_W)
    conv_ctx = functools.partial(dw_conv_silu, rows=1, cols=ctx.shape[1])
    h_ctx = ctx
    for l in range(DEPTH):
        last = l == DEPTH - 1
        sh1, sc1, gt1, sh2, sc2, gt2 = [m[:, None, :] for m in jnp.split(jax.nn.silu(c) @ w_mod[l] + b_mod[l], 6, axis=-1)]
        sh1c, sc1c, gt1c, sh2c, sc2c, gt2c = jnp.split(jax.nn.silu(c_ctx) @ w_mod[l] + b_mod[l], 6, axis=-1)
        mix = functools.partial(token_mixers, w_in=w_in[l], ml_conv=ml_conv[l], ml_conv_b=ml_conv_b[l],
                                b_mgate=b_mgate[l], ml_norm=ml_norm[l], gla_w2=gla_w2[l], gla_b2=gla_b2[l],
                                gla_norm=gla_norm[l], w_proj_m=w_proj_m[l], w_proj_g=w_proj_g[l], w_out=w_out[l])
        ffn = functools.partial(hier_moe, w_grp=w_grp[l], b_grp=b_grp[l], w_rexp=w_rexp[l], b_rexp=b_rexp[l],
                                w_up=w_up[l], w_down=w_down[l])
        hc = rms_norm(h_ctx, g_norm1[l]) * (1.0 + sc1c) + sh1c
        ctx_out, ctx_states = mix(hc, conv_fn=conv_ctx, init_states=empty_states(bn), with_output=not last)
        hx = rms_norm(x, g_norm1[l]) * (1.0 + sc1) + sh1
        x_mix, _ = mix(hx, conv_fn=conv_lat, init_states=ctx_states, with_output=True)
        x = x + gt1 * x_mix
        x = x + gt2 * ffn(rms_norm(x, g_norm2[l]) * (1.0 + sc2) + sh2)
        if not last:
            h_ctx = h_ctx + gt1c * ctx_out
            h_ctx = h_ctx + gt2c * ffn(rms_norm(h_ctx, g_norm2[l]) * (1.0 + sc2c) + sh2c)
    return rms_norm(x, g_final)
```

```cpp
#include <hip/hip_runtime.h>
#include <cstdio>
#include <cstdint>

#ifndef SCAN_SCALAR
#define SCAN_SCALAR 0
#endif
#ifndef REP_MASK
#define REP_MASK 0x0
#endif
#ifndef MK_ONE_LAUNCH
#define MK_ONE_LAUNCH 1
#endif

#define LAS __attribute__((address_space(3)))
typedef unsigned short bf16;
typedef short bf16x8 __attribute__((ext_vector_type(8)));
typedef float f32x4 __attribute__((ext_vector_type(4)));
typedef float f32x2 __attribute__((ext_vector_type(2)));
typedef unsigned u32x4 __attribute__((ext_vector_type(4)));
typedef unsigned u32x2 __attribute__((ext_vector_type(2)));

constexpr int D = 1024, BATCH = 2, SEQ = 8192, CTXL = 256;
constexpr int M_LAT = BATCH * SEQ;
constexpr int M_CTX = BATCH * CTXL;
constexpr int MT = M_LAT + M_CTX;
constexpr int NW = 8, NTHR = 512;
constexpr int IN_W = 8240;
constexpr int NA = 4352;
constexpr int NB = 4096;
constexpr int CHUNK = 64, NCH_LAT = SEQ / CHUNK  , NCH_CTX = CTXL / CHUNK  ;
constexpr int NCHUNK = BATCH * NCH_LAT + BATCH * NCH_CTX;
constexpr int NSEG = 8, CPS = NCH_LAT / NSEG;
constexpr int NEXP = 16, DEXP = 512, NROWS_MAX = 36864  ;
constexpr float EPS = 1e-6f;

constexpr size_t MiB = 1u << 20;
constexpr size_t BIG = (size_t)MT * 1024 * 2;
constexpr size_t WS_CTL = 0, CTL_ZERO_BYTES = 1 * MiB;
constexpr size_t WS_MODV = 1 * MiB;
constexpr size_t WS_AB = 2 * MiB;
constexpr size_t WS_GENDM = WS_AB + 1088 * 1024;
constexpr size_t WS_GENDG = 4 * MiB;
constexpr size_t WS_SSQ = WS_GENDG + 1088 * 1024;
constexpr size_t WS_WA = 7 * MiB;
constexpr size_t WS_WB = 16 * MiB;
constexpr size_t WS_WPM = 24 * MiB, WS_WPG = 26 * MiB, WS_WOUT = 28 * MiB;
constexpr size_t WS_GATES = 30 * MiB;
constexpr size_t WS_NST = 35 * MiB;
constexpr size_t WS_GSEG = WS_NST + 256 * 1024;
constexpr size_t WS_ROUTE = 36 * MiB;
constexpr size_t WS_HX = 37 * MiB;
constexpr size_t WS_QKM = WS_HX + BIG;
constexpr size_t WS_VM = WS_QKM + BIG;
constexpr size_t WS_QKG = WS_VM + BIG;
constexpr size_t WS_VG = WS_QKG + BIG;
constexpr size_t WS_QKMC = WS_VG + BIG;
constexpr size_t WS_STATE = WS_QKMC + BIG;
constexpr size_t WS_QKGTC = WS_STATE + 16 * MiB;
constexpr size_t WS_END = WS_QKGTC + 2 * MiB;
static_assert(WS_END <= 256 * MiB, "ws map");
constexpr size_t WS_WUP = WS_HX;
constexpr size_t WS_H2 = 70 * MiB;
constexpr size_t WS_WDN = 103 * MiB;
constexpr size_t WS_HID = 136 * MiB;
constexpr size_t WS_YROWS = 172 * MiB;
constexpr size_t RT_EXP = 0;
constexpr size_t RT_W = 128 * 1024;
constexpr size_t RT_POS = 256 * 1024;
constexpr size_t RT_ROWTOK = 384 * 1024;
constexpr size_t RT_ROWW = 384 * 1024 + 144 * 1024;
constexpr size_t RT_TILE_E = 384 * 1024 + 288 * 1024;
constexpr size_t WS_LTOK = 120 * MiB, WS_LW = 122 * MiB;
constexpr int LCAP = 32768;
constexpr int LDS_TAB = 147456 - 1024 + 768;
constexpr int CW_BAR = 4096;
constexpr int CW_CNT = 8192;

#define LDS_WAIT() asm volatile("s_waitcnt lgkmcnt(0)" ::: "memory")
#define VM_WAIT() asm volatile("s_waitcnt vmcnt(0)" ::: "memory")
__device__ __forceinline__ unsigned f2bf(float f) { unsigned u = __builtin_bit_cast(unsigned, f); return (u + 0x7fffu + ((u >> 16) & 1u)) >> 16; }
typedef __bf16 bf16x2_t __attribute__((ext_vector_type(2)));
__device__ __forceinline__ unsigned pkbf(float lo, float hi) { f32x2 v = {lo, hi}; return __builtin_bit_cast(unsigned, __builtin_convertvector(v, bf16x2_t)); }
__device__ __forceinline__ unsigned pk2(float lo, float hi) { return pkbf(lo, hi); }
__device__ __forceinline__ float bf2f(unsigned short h) { return __builtin_bit_cast(float, (unsigned)h << 16); }
__device__ __forceinline__ float bflo(unsigned w) { return __builtin_bit_cast(float, w << 16); }
__device__ __forceinline__ float bfhi(unsigned w) { return __builtin_bit_cast(float, w & 0xffff0000u); }
__device__ __forceinline__ float sigm(float x) { return __builtin_amdgcn_rcpf(1.f + __expf(-x)); }
__device__ __forceinline__ float siluf(float x) { return x * __builtin_amdgcn_rcpf(1.f + __expf(-x)); }
__device__ __forceinline__ float logsig(float x) { return fminf(x, 0.f) - log1pf(expf(-fabsf(x))); }
__device__ __forceinline__ float wave_sum(float v) {
#pragma unroll
    for (int o = 1; o < 64; o <<= 1) v += __shfl_xor(v, o);
    return v;
}

namespace pg8 {
#define PG8_LAS __attribute__((address_space(3)))
constexpr int BM = 256, BK = 64, HALF = 128, HTB = HALF * BK * 2, STAGE_BYTES = 8 * HTB, NXCD = 8, WGM = 8;
__host__ __device__ __forceinline__ int lds_byte(int r, int c) { const int st = (r >> 4) * 2 + (c >> 5), rr = r & 15, cc = c & 31, ob = rr * 64 + cc * 2; return st * 1024 + (ob ^ (((ob >> 9) & 1) << 5)); }
__host__ __device__ __forceinline__ void stage_rc(int b, int& R, int& C) { const int st = b / 1024, sb = b % 1024, swz = sb ^ (((sb >> 9) & 1) << 5); R = (st >> 1) * 16 + swz / 64; C = (st & 1) * 32 + (swz % 64) / 2; }
__host__ __device__ __forceinline__ int perm32(int rho) { const int n = rho >> 4, i = rho & 15; return 8 * (i >> 2) + 4 * n + (i & 3); }
struct Unit { int pm, pn, e; };
__device__ __forceinline__ unsigned cvt_pk_bf16(float lo, float hi) { return pkbf(lo, hi); }

struct DenseSched {
    static constexpr bool GATHER = false;
    const bf16* A; const bf16* Bt; int K, nM, nN, nwg, G, c;
    __device__ void init(const bf16* A_, const bf16* Bt_, int M, int N, int K_, int G_, int c_) { A = A_; Bt = Bt_; K = K_; nM = M / BM; nN = N / BM; nwg = nM * nN; G = G_; c = c_; }
    __device__ bool next(int i, Unit& u) const {
        const long L = (long)i * G + c; if (L >= nwg) return false;
        int wgid = (int)L; { const int q = nwg / NXCD, r = nwg % NXCD, xcd = wgid % NXCD, off = wgid / NXCD; wgid = (xcd < r ? xcd * (q + 1) : r * (q + 1) + (xcd - r) * q) + off; }
        const int nig = WGM * nN, gid = wgid / nig, fm = gid * WGM, gsz = (nM - fm) < WGM ? (nM - fm) : WGM;
        u.pm = fm + ((wgid % nig) % gsz); u.pn = (wgid % nig) / gsz; u.e = 0; return true;
    }
    __device__ __forceinline__ const char* a_base(const Unit& u) const { return (const char*)A + (size_t)u.pm * BM * K * 2; }
    __device__ __forceinline__ const char* b_base(const Unit& u) const { return (const char*)Bt + (size_t)u.pn * BM * K * 2; }
    __device__ __forceinline__ void a_offs(const Unit&, const int (&R)[2], const int (&C)[2], unsigned (&o)[2][2]) const {
#pragma unroll
        for (int h = 0; h < 2; ++h)
#pragma unroll
            for (int i = 0; i < 2; ++i) o[h][i] = (unsigned)((h * HALF + R[i]) * K + C[i]) * 2u;
    }
};
template <bool GATHER_> struct GroupSched {
    static constexpr bool GATHER = GATHER_;
    const bf16* A; const bf16* Bt; const int* list_tok; const PG8_LAS int* tab; int K, ntiles, G, c;
    __device__ bool next(int i, Unit& u) const {
        long L = (long)i * G + c;
        if (G == 256 && (long)(i + 1) * 256 <= (long)ntiles * 4) { const int xc = c & 7, j = c >> 3; L = (long)i * 256 + (long)(((xc << 3) | (j >> 2)) << 2) + (j & 3); }
        if (L >= (long)ntiles * 4) return false;
        u.pm = (int)(L >> 2); u.pn = (int)(L & 3); int e = 0; while (e < 15 && u.pm * BM >= tab[e + 1]) ++e; u.e = e; return true;
    }
    __device__ __forceinline__ const char* a_base(const Unit& u) const { return GATHER ? (const char*)A : (const char*)A + (size_t)u.pm * BM * K * 2; }
    __device__ __forceinline__ const char* b_base(const Unit& u) const { return (const char*)Bt + ((size_t)u.e * 1024 + (size_t)u.pn * BM) * K * 2; }
    __device__ __forceinline__ void a_offs(const Unit& u, const int (&R)[2], const int (&C)[2], unsigned (&o)[2][2]) const {
        const int pos0 = u.pm * BM - tab[u.e], cnt = tab[32 + u.e];
#pragma unroll
        for (int h = 0; h < 2; ++h)
#pragma unroll
            for (int i = 0; i < 2; ++i) {
                int row = h * HALF + R[i];
                if (GATHER) { const int pos = pos0 + row; const int pc = pos < cnt ? pos : 0; const int tk = list_tok[u.e * 32768 + pc]; row = pos < cnt ? tk : 0; }
                o[h][i] = (unsigned)(row * K + C[i]) * 2u; }
    }
};

template <class Epi, class Sched, bool ALIGN_EPI>
__device__ __forceinline__ void gemm_phase(PG8_LAS unsigned char* lds, const Sched& S, const Epi& E, const int wave_id) {
    int ln_ = (int)__builtin_amdgcn_mbcnt_hi(~0u, __builtin_amdgcn_mbcnt_lo(~0u, 0u)); asm volatile("" : "+v"(ln_));
    const int wid = wave_id, lane = ln_, tid = wid * 64 + lane, wr = wid >> 2, wc = wid & 3, fr = lane & 15, fq = lane >> 4;
    const int K = S.K, nt = K / BK;
    int Rr[2], Cc[2]; unsigned voffB[2];
#pragma unroll
    for (int i = 0; i < 2; ++i) { stage_rc(tid * 16 + i * 8192, Rr[i], Cc[i]); const int Rb = (Rr[i] & ~31) + perm32(Rr[i] & 31); voffB[i] = (unsigned)(Rb * K + Cc[i]) * 2u; }
    const size_t kstep = (size_t)(BK * 2);
    const size_t hstep = (size_t)HALF * K * 2;
    const unsigned ldsw = (unsigned)wid * 1024u;
    const int aoff = lds_byte(wr * 64 + fr, fq * 8), boff = lds_byte(wc * 32 + fr, fq * 8);
#define PG8_SA(b, h) (((b) * 2 + (h)) * HTB)
#define PG8_SB(b, h) ((4 + (b) * 2 + (h)) * HTB)
#define PG8_STAGE(bufoff, gbase, voff) do { _Pragma("unroll") for (int _i = 0; _i < 2; ++_i) \
        __builtin_amdgcn_global_load_lds((const unsigned*)((const char*)(gbase) + (voff)[_i]), (PG8_LAS unsigned*)(lds + (bufoff) + ldsw + _i * 8192), 16, 0, 0); } while (0)
#define PG8_LDA(dst, b, h) do { _Pragma("unroll") for (int m = 0; m < 4; ++m) _Pragma("unroll") for (int k = 0; k < 2; ++k) dst[m][k] = *(const PG8_LAS bf16x8*)(lds + PG8_SA(b, h) + aoff + m * 2048 + k * 1024); } while (0)
#define PG8_LDB(dst, b, h) do { _Pragma("unroll") for (int n = 0; n < 2; ++n) _Pragma("unroll") for (int k = 0; k < 2; ++k) dst[n][k] = *(const PG8_LAS bf16x8*)(lds + PG8_SB(b, h) + boff + n * 2048 + k * 1024); } while (0)
#define PG8_MMA(ai, bj, At, Bt) do { __builtin_amdgcn_s_setprio(1); _Pragma("unroll") for (int m = 0; m < 4; ++m) _Pragma("unroll") for (int n = 0; n < 2; ++n) _Pragma("unroll") for (int k = 0; k < 2; ++k) \
        acc[ai][bj][m][n] = __builtin_amdgcn_mfma_f32_16x16x32_bf16(Bt[n][k], At[m][k], acc[ai][bj][m][n], 0, 0, 0); __builtin_amdgcn_s_setprio(0); } while (0)
#define PG8_WAIT_V(n) asm volatile("s_waitcnt vmcnt(" #n ")" ::: "memory")
#define PG8_WAIT_L(n) asm volatile("s_waitcnt lgkmcnt(" #n ")" ::: "memory")
#define PG8_BAR __builtin_amdgcn_s_barrier()
#define PG8_SCHED __builtin_amdgcn_sched_barrier(0)
    Unit cur, nxt; int ui = 0;
    if (!S.next(0, cur)) return;
    unsigned ao[2][2], nao[2][2];
    S.a_offs(cur, Rr, Cc, ao);
    f32x4 acc[2][2][4][2];
#pragma unroll
    for (int a = 0; a < 2; ++a)
#pragma unroll
        for (int b = 0; b < 2; ++b)
#pragma unroll
            for (int m = 0; m < 4; ++m)
#pragma unroll
                for (int n = 0; n < 2; ++n) acc[a][b][m][n] = (f32x4){0.f, 0.f, 0.f, 0.f};
    bf16x8 At[4][2], B0[2][2], B1[2][2];
    const char* cA = S.a_base(cur); const char* cB = S.b_base(cur);
    PG8_STAGE(PG8_SB(0, 0), cB, voffB); PG8_STAGE(PG8_SB(0, 1), cB + hstep, voffB); PG8_STAGE(PG8_SA(0, 0), cA, ao[0]); PG8_STAGE(PG8_SA(0, 1), cA, ao[1]);
    if (wr == 1) PG8_BAR;
    PG8_WAIT_V(2); PG8_BAR;
    PG8_STAGE(PG8_SB(1, 0), cB + kstep, voffB); PG8_STAGE(PG8_SA(1, 0), cA + kstep, ao[0]); PG8_STAGE(PG8_SB(1, 1), cB + hstep + kstep, voffB);
    PG8_WAIT_V(6); PG8_BAR;
    for (;;) {
        const bool has_next = S.next(ui + 1, nxt);
        if (Sched::GATHER && has_next) S.a_offs(nxt, Rr, Cc, nao);
        else {
#pragma unroll
            for (int h = 0; h < 2; ++h)
#pragma unroll
                for (int i = 0; i < 2; ++i) nao[h][i] = ao[h][i]; }
        const char* nA = has_next ? S.a_base(nxt) : cA; const char* nB = has_next ? S.b_base(nxt) : cB;
        for (int t = 0; t < nt; t += 2) {
            const bool last = (t == nt - 2);
            const char* a1 = cA + (size_t)(t + 1) * kstep;
            const char* a2 = last ? nA : cA + (size_t)(t + 2) * kstep; const char* b2 = last ? nB : cB + (size_t)(t + 2) * kstep;
            const char* a3 = a2 + kstep; const char* b3 = b2 + kstep;
            unsigned o2[2][2];
#pragma unroll
            for (int h = 0; h < 2; ++h)
#pragma unroll
                for (int i = 0; i < 2; ++i) o2[h][i] = (Sched::GATHER && last) ? nao[h][i] : ao[h][i];
            PG8_LDB(B0, 0, 0); PG8_LDB(B1, 0, 1); PG8_SCHED; PG8_LDA(At, 0, 0); PG8_STAGE(PG8_SA(1, 1), a1, ao[1]);
            PG8_WAIT_V(8); PG8_WAIT_L(0); PG8_BAR; PG8_MMA(0, 0, At, B0); PG8_MMA(0, 1, At, B1); PG8_BAR; PG8_SCHED;
            PG8_LDA(At, 0, 1); PG8_STAGE(PG8_SB(0, 0), b2, voffB); PG8_STAGE(PG8_SB(0, 1), b2 + hstep, voffB); PG8_STAGE(PG8_SA(0, 0), a2, o2[0]);
            PG8_WAIT_V(8); PG8_WAIT_L(0); PG8_BAR; PG8_MMA(1, 0, At, B0); PG8_MMA(1, 1, At, B1); PG8_BAR; PG8_SCHED;
            PG8_LDB(B0, 1, 0); PG8_LDB(B1, 1, 1); PG8_SCHED; PG8_LDA(At, 1, 0); PG8_STAGE(PG8_SA(0, 1), a2, o2[1]);
            PG8_WAIT_V(8); PG8_WAIT_L(0); PG8_BAR; PG8_MMA(0, 0, At, B0); PG8_MMA(0, 1, At, B1); PG8_BAR; PG8_SCHED;
            PG8_LDA(At, 1, 1); PG8_STAGE(PG8_SB(1, 0), b3, voffB); PG8_STAGE(PG8_SB(1, 1), b3 + hstep, voffB); PG8_STAGE(PG8_SA(1, 0), a3, o2[0]);
            PG8_WAIT_V(8); PG8_WAIT_L(0); PG8_BAR; PG8_MMA(1, 0, At, B0); PG8_MMA(1, 1, At, B1); PG8_BAR; PG8_SCHED;
        }
        if constexpr (ALIGN_EPI) { if (wr == 0) PG8_BAR; }
        { int fr_ = fr, fq_ = fq; asm volatile("" : "+v"(fr_), "+v"(fq_));
          E(acc, cur, wr, wc, fr_, fq_); }
        if (!has_next) break;
#pragma unroll
        for (int a = 0; a < 2; ++a)
#pragma unroll
            for (int b = 0; b < 2; ++b)
#pragma unroll
                for (int m = 0; m < 4; ++m)
#pragma unroll
                    for (int n = 0; n < 2; ++n) acc[a][b][m][n] = (f32x4){0.f, 0.f, 0.f, 0.f};
        cur = nxt; cA = nA; cB = nB; ++ui;
#pragma unroll
        for (int h = 0; h < 2; ++h)
#pragma unroll
            for (int i = 0; i < 2; ++i) ao[h][i] = nao[h][i];
        if constexpr (ALIGN_EPI) { if (wr == 1) PG8_BAR; }
    }
    PG8_WAIT_V(0);
    if constexpr (!ALIGN_EPI) { if (wr == 0) PG8_BAR; }
    PG8_BAR;
#undef PG8_SA
#undef PG8_SB
#undef PG8_STAGE
#undef PG8_LDA
#undef PG8_LDB
#undef PG8_MMA
#undef PG8_WAIT_V
#undef PG8_WAIT_L
#undef PG8_BAR
#undef PG8_SCHED
}
}
using pg8::Unit; using pg8::cvt_pk_bf16;

#define XB_TMO      128
#define XB_XCNT(j)  (256  + 64 * (j))
#define XB_XSUB(j)  (1280 + 64 * (j))
#define XB_XGEN(j)  (2304 + 64 * (j))
#define XB_TOP      3328
#define XB_TOPGEN   3392
#define XCD_BAR_WORDS 3456
#define XB_SPIN_CAP (1u << 18)
__device__ __forceinline__ unsigned xb_ld(unsigned* p)              { return __hip_atomic_load(p, __ATOMIC_RELAXED, __HIP_MEMORY_SCOPE_AGENT); }
__device__ __forceinline__ unsigned xb_add(unsigned* p, unsigned v) { return __hip_atomic_fetch_add(p, v, __ATOMIC_RELAXED, __HIP_MEMORY_SCOPE_AGENT); }
__device__ __forceinline__ unsigned xb_xcc_id() { return (unsigned)__builtin_amdgcn_s_getreg((3 << 11) | 20) & 0xFu; }
#define XB_SPIN(cond, bar) do { unsigned _sp = 0; while (cond) { __builtin_amdgcn_s_sleep(1); \
    if ((++_sp & 255u) == 0u) { if (xb_ld(&(bar)[XB_TMO])) break; if (_sp > XB_SPIN_CAP) { atomicAdd(&(bar)[XB_TMO], 1u); break; } } } } while (0)
struct XcdBarrier { unsigned* bar; unsigned x; volatile LAS unsigned* st; };
__device__ __forceinline__ XcdBarrier xcd_barrier_post(unsigned* bar, volatile LAS unsigned* st) {
    XcdBarrier b; b.bar = bar; b.x = xb_xcc_id(); b.st = st;
    if (threadIdx.x == 0) (void)xb_add(&bar[XB_XCNT(b.x)], 1u);
    return b;
}
__device__ __forceinline__ void xcd_barrier_complete(unsigned* bar, unsigned x, unsigned& nloc, unsigned& nx) {
    const unsigned G = gridDim.x * gridDim.y * gridDim.z;
    unsigned sum, cnt, mine, sp = 0u;
    for (;;) {
        sum = 0u; cnt = 0u; mine = 0u;
#pragma unroll
        for (unsigned j = 0; j < 16; ++j) { const unsigned c = xb_ld(&bar[XB_XCNT(j)]); sum += c; cnt += (c > 0u) ? 1u : 0u; mine = (j == x) ? c : mine; }
        if (sum == G) break;
        __builtin_amdgcn_s_sleep(1);
        if ((++sp & 255u) == 0u) { if (xb_ld(&bar[XB_TMO])) break; if (sp > XB_SPIN_CAP) { atomicAdd(&bar[XB_TMO], 1u); break; } }
    }
    nloc = mine > 0u ? mine : 1u; nx = cnt > 0u ? cnt : 1u;
}
__device__ __forceinline__ void xcd_barrier(const XcdBarrier& b, const int tid) {
    asm volatile("s_waitcnt vmcnt(0)" ::: "memory");
    __syncthreads();
    if (tid == 0) {
        unsigned* bar = b.bar;
        __builtin_amdgcn_s_waitcnt(0);
        unsigned nloc = b.st[0], nx = b.st[1];
        if (nloc == 0u) { xcd_barrier_complete(bar, b.x, nloc, nx); b.st[0] = nloc; b.st[1] = nx; }
        const unsigned old = xb_add(&bar[XB_XSUB(b.x)], 1u);
        const unsigned gen = old / nloc;
        if (old + 1u == (gen + 1u) * nloc) {
            __builtin_amdgcn_fence(__ATOMIC_RELEASE, "agent");
            asm volatile("s_waitcnt vmcnt(0)" ::: "memory");
            const unsigned og = xb_add(&bar[XB_TOP], 1u);
            const unsigned tg = og / nx;
            if (og + 1u == (tg + 1u) * nx) xb_add(&bar[XB_TOPGEN], 1u);
            else XB_SPIN(xb_ld(&bar[XB_TOPGEN]) == tg, bar);
            __builtin_amdgcn_fence(__ATOMIC_ACQUIRE, "agent");
            xb_add(&bar[XB_XGEN(b.x)], 1u);
            asm volatile("s_waitcnt vmcnt(0)" ::: "memory");
        } else {
            XB_SPIN(xb_ld(&bar[XB_XGEN(b.x)]) == gen, bar);
            __builtin_amdgcn_fence(__ATOMIC_ACQUIRE, "agent");
            asm volatile("s_waitcnt vmcnt(0)" ::: "memory");
        }
    }
    __syncthreads();
}

constexpr int RING_BYTES = 131072;
constexpr int LDS_BYTES = 147456;
constexpr int LDSCTL_OFF = LDS_BYTES - 1024, MISC_OFF = LDSCTL_OFF + 320;

struct Args { const float* in[26]; float* out; unsigned char* ws; int ph_lo, ph_hi; };
struct Frame {
    LAS unsigned char* lds; volatile LAS unsigned* MISC;
    int tid, lane, wave, G, bid;
    unsigned char* ws; float* out;
    const float *x, *c, *ctx, *c_ctx, *w_mod, *b_mod, *g_norm1, *w_in, *ml_conv, *ml_conv_b, *b_mgate, *ml_norm, *gla_w2, *gla_b2, *gla_norm,
                *w_proj_m, *w_proj_g, *w_out, *g_norm2, *w_grp, *b_grp, *w_rexp, *b_rexp, *w_up, *w_down, *g_final;
};
template <class T> __device__ __forceinline__ T* wsp(const Frame& F, size_t off) { return (T*)(F.ws + off); }

struct TItem { const float* W; bf16* WT; int Nsrc, K, k0, n0, sc; };
__device__ __forceinline__ int map_a(int n) { return n < 2048 ? n : (n < 4096 ? n + 1040 : (n < 4112 ? 3072 + (n - 4096) : (n < 4144 ? 6160 + (n - 4112) : -1))); }
__device__ __forceinline__ int map_b(int n) { return n < 1024 ? 2048 + n : (n < 2048 ? 5136 + (n - 1024) : (n < 3072 ? 6192 + (n - 2048) : 7216 + (n - 3072))); }
__device__ __forceinline__ int map_up(int n) { const int pn = n >> 8, j = n & 255; return j < 128 ? 128 * pn + j : 512 + 128 * pn + (j - 128); }
__device__ __forceinline__ void titem_load(const TItem& t, int lane, f32x4 (&v)[8]) {
    const int scc = t.sc < 0 ? 0 : t.sc;
#pragma unroll
    for (int r = 0; r < 8; ++r) v[r] = *(const f32x4*)(t.W + (size_t)(t.k0 + 8 * r + (lane >> 3)) * t.Nsrc + scc);
}
__device__ __forceinline__ void titem_store(const TItem& t, int lane, const f32x4 (&v)[8], LAS float* scr) {
    const float z = t.sc < 0 ? 0.f : 1.f;
#pragma unroll
    for (int r = 0; r < 8; ++r) { const int kk = 8 * r + (lane >> 3); LAS float* d = scr + kk * 33 + 4 * (lane & 7); d[0] = v[r][0] * z; d[1] = v[r][1] * z; d[2] = v[r][2] * z; d[3] = v[r][3] * z; }
    LDS_WAIT(); asm volatile("" ::: "memory");
    const int c = lane & 7;
#pragma unroll
    for (int j = 0; j < 4; ++j) { const int n = (lane >> 3) + 8 * j; const LAS float* s = scr + (8 * c) * 33 + n;
        u32x4 o; o.x = pk2(s[0 * 33], s[1 * 33]); o.y = pk2(s[2 * 33], s[3 * 33]); o.z = pk2(s[4 * 33], s[5 * 33]); o.w = pk2(s[6 * 33], s[7 * 33]);
        *(u32x4*)(t.WT + (size_t)(t.n0 + n) * t.K + t.k0 + 8 * c) = o; }
    LDS_WAIT(); asm volatile("" ::: "memory");
}
template <class Dec>
__device__ __forceinline__ void run_transposes(Frame& F, int nitems, Dec dec) {
    LAS float* scr = (LAS float*)(F.lds + F.wave * 16384);
    const int gw = F.bid * NW + F.wave, NGW = F.G * NW, last = nitems - 1;
    if (gw >= nitems) return;
    f32x4 va[8], vb[8]; TItem ia, ib;
    ia = dec(gw, F.lane); titem_load(ia, F.lane, va);
    for (int it = gw; it < nitems; it += 2 * NGW) {
        { const int j = it + NGW; ib = dec(j < last ? j : last, F.lane); titem_load(ib, F.lane, vb); }
        titem_store(ia, F.lane, va, scr);
        { const int j = it + 2 * NGW; ia = dec(j < last ? j : last, F.lane); titem_load(ia, F.lane, va); }
        if (it + NGW < nitems) titem_store(ib, F.lane, vb, scr);
    }
}
__device__ __forceinline__ void p0_prologue(Frame& F) {
    LAS float* scr = (LAS float*)(F.lds + F.wave * 16384);
    const int gw = F.bid * NW + F.wave, NGW = F.G * NW;
    if (F.bid < 192) {
        LAS float* red = (LAS float*)(F.lds);
        const int r = F.tid >> 3, c4 = F.tid & 7, col0 = F.bid * 32 + 4 * c4;
        f32x4 a0 = {0.f, 0.f, 0.f, 0.f}, a1 = a0, a2 = a0;
        for (int k = r; k < D; k += 64) {
            const f32x4 w = *(const f32x4*)(F.w_mod + (size_t)k * 6144 + col0);
            const float s0 = siluf(F.c[k]), s1 = siluf(F.c[D + k]), s2 = siluf(F.c_ctx[k]);
            a0 += w * s0; a1 += w * s1; a2 += w * s2; }
#pragma unroll
        for (int j = 0; j < 4; ++j) { red[r * 96 + 0 + 4 * c4 + j] = a0[j]; red[r * 96 + 32 + 4 * c4 + j] = a1[j]; red[r * 96 + 64 + 4 * c4 + j] = a2[j]; }
        __syncthreads();
        if (F.tid < 96) { float s = 0.f; for (int q = 0; q < 64; ++q) s += red[q * 96 + F.tid]; const int rr = F.tid >> 5, j = F.bid * 32 + (F.tid & 31);
            wsp<float>(F, WS_MODV)[rr * 6144 + j] = s + F.b_mod[j]; }
        __syncthreads();
    }
}
__device__ __forceinline__ void p0_weight_copies(Frame& F) {
    constexpr int I_A = (NA / 32) * 16, I_B = (NB / 32) * 16, I_P = (1024 / 32) * 16;
    const float* w_in = F.w_in; const float* wpm = F.w_proj_m; const float* wpg = F.w_proj_g; const float* wo = F.w_out; unsigned char* ws = F.ws;
    run_transposes(F, I_A + I_B + 3 * I_P, [=](int it, int lane) {
        TItem t; t.K = D; int r = it;
        const bool isA = r < I_A, isB = !isA && r < I_A + I_B; const int rp = r - I_A - I_B, pi = rp < 0 ? 0 : rp / I_P;
        const int rr = isA ? r : (isB ? r - I_A : rp - pi * I_P);
        t.k0 = 64 * (rr & 15); t.n0 = 32 * (rr >> 4); const int n = t.n0 + 4 * (lane & 7);
        t.W = (isA || isB) ? w_in : (pi == 0 ? wpm : (pi == 1 ? wpg : wo)); t.Nsrc = (isA || isB) ? IN_W : D;
        t.WT = (bf16*)(ws + (isA ? WS_WA : (isB ? WS_WB : (pi == 0 ? WS_WPM : (pi == 1 ? WS_WPG : WS_WOUT)))));
        t.sc = isA ? map_a(n) : (isB ? map_b(n) : n);
        return t; });
}
__device__ __forceinline__ void moe_weight_copies(Frame& F) {
    constexpr int I_U = (1024 / 32) * 16  , I_D = (1024 / 32) * 8;
    const float* wup = F.w_up; const float* wdn = F.w_down; unsigned char* ws = F.ws;
    run_transposes(F, NEXP * (I_U + I_D), [=](int it, int lane) {
        TItem t; const int e = it / (I_U + I_D), r = it % (I_U + I_D); const bool up = r < I_U; const int rr = up ? r : r - I_U;
        t.K = up ? 1024 : 512; t.Nsrc = 1024;
        t.k0 = up ? 64 * (rr & 15) : 64 * (rr & 7); t.n0 = up ? 32 * (rr >> 4) : 32 * (rr >> 3); const int n = t.n0 + 4 * (lane & 7);
        t.W = up ? wup + (size_t)e * 1024 * 1024 : wdn + (size_t)e * 512 * 1024;
        t.WT = up ? (bf16*)(ws + WS_WUP) + (size_t)e * 1024 * 1024 : (bf16*)(ws + WS_WDN) + (size_t)e * 1024 * 512;
        t.sc = up ? map_up(n) : n;
        return t; });
}

__device__ __forceinline__ void p1_hx(Frame& F) {
    const int gw = F.bid * NW + F.wave, NGW = F.G * NW;
    const float* modv = wsp<float>(F, WS_MODV);
    for (int m = gw; m < MT; m += 2 * NGW) {
        const int m2 = m + NGW < MT ? m + NGW : m;
        const float* src[2] = {m < M_LAT ? F.x + (size_t)m * D : F.ctx + (size_t)(m - M_LAT) * D, m2 < M_LAT ? F.x + (size_t)m2 * D : F.ctx + (size_t)(m2 - M_LAT) * D};
        const float* mv[2] = {modv + (m < M_LAT ? (m >> 13) : 2) * 6144, modv + (m2 < M_LAT ? (m2 >> 13) : 2) * 6144};
        f32x4 v[2][4]; float s[2] = {0.f, 0.f};
#pragma unroll
        for (int r = 0; r < 2; ++r)
#pragma unroll
            for (int j = 0; j < 4; ++j) v[r][j] = *(const f32x4*)(src[r] + 4 * F.lane + 256 * j);
#pragma unroll
        for (int r = 0; r < 2; ++r)
#pragma unroll
            for (int j = 0; j < 4; ++j) s[r] += (v[r][j].x * v[r][j].x + v[r][j].y * v[r][j].y) + (v[r][j].z * v[r][j].z + v[r][j].w * v[r][j].w);
#pragma unroll
        for (int r = 0; r < 2; ++r) {
            const float rstd = 1.f / sqrtf(wave_sum(s[r]) * (1.f / D) + EPS);
            bf16* o = wsp<bf16>(F, WS_HX) + (size_t)(r == 0 ? m : m2) * D;
#pragma unroll
            for (int j = 0; j < 4; ++j) { const int c = 4 * F.lane + 256 * j;
                const f32x4 g = *(const f32x4*)(F.g_norm1 + c), sh = *(const f32x4*)(mv[r] + c), sc = *(const f32x4*)(mv[r] + 1024 + c);
                const f32x4 h = (v[r][j] * rstd) * g * (sc + 1.f) + sh;
                u32x2 w; w.x = pk2(h.x, h.y); w.y = pk2(h.z, h.w); *(u32x2*)(o + c) = w; } }
    }
}

struct EpiProjA {
    unsigned char* ws; const float* b_mgate;
    __device__ __forceinline__ void operator()(const f32x4 (&acc)[2][2][4][2], const Unit& u, int wr, int wc, int fr, int fq) const {
        const int row0 = u.pm * 256 + wr * 64 + fr;
        if (u.pn < 16) {
            bf16* base = (bf16*)(ws + WS_QKM + (size_t)(u.pn >> 2) * BIG) + (u.pn & 3) * 256 + wc * 32 + 8 * fq;
#pragma unroll
            for (int ai = 0; ai < 2; ++ai)
#pragma unroll
                for (int m = 0; m < 4; ++m) { bf16* rowp = base + (size_t)(row0 + ai * 128 + m * 16) * 1024;
#pragma unroll
                    for (int bj = 0; bj < 2; ++bj) { const f32x4 v0 = acc[ai][bj][m][0], v1 = acc[ai][bj][m][1];
                        u32x4 w; w.x = cvt_pk_bf16(v0[0], v0[1]); w.y = cvt_pk_bf16(v0[2], v0[3]); w.z = cvt_pk_bf16(v1[0], v1[1]); w.w = cvt_pk_bf16(v1[2], v1[3]);
                        *(u32x4*)(rowp + bj * 128) = w; } }
        } else if (wc < 2) {
            const int col = wc * 32 + 8 * fq;
            float* g = (float*)(ws + WS_GATES);
            f32x4 b0 = {0.f, 0.f, 0.f, 0.f}, b1 = b0;
            if (col < 16) { b0 = *(const f32x4*)(b_mgate + col); b1 = *(const f32x4*)(b_mgate + col + 4); }
#pragma unroll
            for (int ai = 0; ai < 2; ++ai)
#pragma unroll
                for (int m = 0; m < 4; ++m) { float* rowp = g + (size_t)(row0 + ai * 128 + m * 16) * 64 + col;
                    *(f32x4*)rowp = acc[ai][0][m][0] + b0; *(f32x4*)(rowp + 4) = acc[ai][0][m][1] + b1; }
        }
    }
};

__device__ __forceinline__ int chunk_row0(int ci) { return ci < 256 ? (ci >> 7) * SEQ + (ci & 127) * 64 : M_LAT + ((ci - 256) >> 2) * CTXL + ((ci - 256) & 3) * 64; }
__device__ __forceinline__ bf16* qkgt_row(const Frame& F, int dir, int m) {
    return m < M_LAT ? (bf16*)F.out + ((size_t)dir * M_LAT + m) * 1024 : wsp<bf16>(F, WS_QKGTC) + ((size_t)dir * M_CTX + (m - M_LAT)) * 1024;
}
__device__ __forceinline__ float logsig_fast(float x) { return fminf(x, 0.f) - __logf(1.f + __expf(-fabsf(x))); }
__device__ __forceinline__ void unpack8(const u32x4& v, float (&f)[8]) { f[0] = bflo(v.x); f[1] = bfhi(v.x); f[2] = bflo(v.y); f[3] = bfhi(v.y); f[4] = bflo(v.z); f[5] = bfhi(v.z); f[6] = bflo(v.w); f[7] = bfhi(v.w); }
__device__ __forceinline__ void p3_prep(Frame& F) {
    const bf16* QKM = wsp<bf16>(F, WS_QKM); bf16* QKMC = wsp<bf16>(F, WS_QKMC); const float* GATES = wsp<float>(F, WS_GATES); const bf16* QKG = wsp<bf16>(F, WS_QKG);
    for (int it = F.bid; it < NCHUNK * 3; it += F.G) {
        int tidl = F.tid; asm volatile("" : "+v"(tidl));
        const int lanel = tidl & 63;
        if (it < NCHUNK) {
            const int ci = F.G == 256 ? (it < 256 ? (it & 7) * 33 + (it >> 3) : (it - 256) * 33 + 32) : it, m0 = chunk_row0(ci);
            const int cg = tidl & 127, cq = tidl >> 7, ch = 8 * cg;
            const bool lat = ci < 256; const int c = lat ? (ci & 127) : ((ci - 256) & 3);
            const bool has_up = lat && c > 0, has_dn = lat && c < 127;
            const float osc = ch >= 512 ? 0.08838834764831845f : 1.f;
            f32x4 bz0 = *(const f32x4*)(F.ml_conv_b + ch), bz1 = *(const f32x4*)(F.ml_conv_b + ch + 4);
            f32x4 cw0[9], cw1[9];
#pragma unroll
            for (int q = 0; q < 9; ++q) { cw0[q] = *(const f32x4*)(F.ml_conv + q * 1024 + ch); cw1[q] = *(const f32x4*)(F.ml_conv + q * 1024 + ch + 4); }
#pragma unroll 1
            for (int cb = 0; cb < 8; ++cb) {
                const int c0 = cq * 16 + cb * 2;
                u32x4 in[3][4];
#pragma unroll
                for (int dr = 0; dr < 3; ++dr)
#pragma unroll
                    for (int dc = 0; dc < 4; ++dc) { const int col = c0 - 1 + dc; bool ok; int m;
                        if (lat) { ok = col >= 0 && col <= 63 && (dr != 0 || has_up) && (dr != 2 || has_dn); m = m0 + (dr - 1) * 64 + col; }
                        else { const int t = c * 64 + col; ok = dr == 1 && t >= 0 && t <= 255; m = m0 + col; }
                        const int mc = ok ? m : m0;
                        const u32x4 v = *(const u32x4*)(QKM + (size_t)mc * 1024 + ch);
                        in[dr][dc] = ok ? v : (u32x4){0u, 0u, 0u, 0u}; }
                float acc[2][8];
#pragma unroll
                for (int oc = 0; oc < 2; ++oc) { acc[oc][0] = bz0[0]; acc[oc][1] = bz0[1]; acc[oc][2] = bz0[2]; acc[oc][3] = bz0[3]; acc[oc][4] = bz1[0]; acc[oc][5] = bz1[1]; acc[oc][6] = bz1[2]; acc[oc][7] = bz1[3]; }
#pragma unroll
                for (int dr = 0; dr < 3; ++dr)
#pragma unroll
                    for (int dc = 0; dc < 3; ++dc) { const f32x4 w0 = cw0[dr * 3 + dc], w1 = cw1[dr * 3 + dc];
#pragma unroll
                        for (int oc = 0; oc < 2; ++oc) { float f[8]; unpack8(in[dr][oc + dc], f);
                            acc[oc][0] += w0[0] * f[0]; acc[oc][1] += w0[1] * f[1]; acc[oc][2] += w0[2] * f[2]; acc[oc][3] += w0[3] * f[3]; acc[oc][4] += w1[0] * f[4]; acc[oc][5] += w1[1] * f[5]; acc[oc][6] += w1[2] * f[6]; acc[oc][7] += w1[3] * f[7]; } }
#pragma unroll
                for (int oc = 0; oc < 2; ++oc) { u32x4 o; o.x = pk2(siluf(acc[oc][0]) * osc, siluf(acc[oc][1]) * osc); o.y = pk2(siluf(acc[oc][2]) * osc, siluf(acc[oc][3]) * osc);
                    o.z = pk2(siluf(acc[oc][4]) * osc, siluf(acc[oc][5]) * osc); o.w = pk2(siluf(acc[oc][6]) * osc, siluf(acc[oc][7]) * osc);
                    *(u32x4*)(QKMC + (size_t)(m0 + c0 + oc) * 1024 + ch) = o; }
            }
            {
                const int dir = F.wave >> 2, h = F.wave & 3, m = m0 + lanel;
                const float ip = GATES[(size_t)m * 64 + dir * 8 + h], lf = logsig(GATES[(size_t)m * 64 + dir * 8 + 4 + h]);
                float b = lf;
#pragma unroll
                for (int o = 1; o < 64; o <<= 1) { const float t = dir == 0 ? __shfl_up(b, o) : __shfl_down(b, o); const bool ok = dir == 0 ? (lanel >= o) : (lanel + o < 64); if (ok) b += t; }
                f32x2 ab; ab.x = expf(b); ab.y = expf(ip - b);
                wsp<f32x2>(F, WS_AB)[((size_t)dir * MT + m) * 4 + h] = ab;
                if (lanel == (dir == 0 ? 63 : 0)) wsp<float>(F, WS_GENDM)[((size_t)dir * NCHUNK + ci) * 4 + h] = expf(b);
            }
        } else {
            const int gi0 = it - NCHUNK;
            const int gi = F.G == 256 ? ((((gi0 >> 4) << 3) | (gi0 & 7)) << 1) | ((gi0 >> 3) & 1) : gi0;
            const int ci = gi >> 1, dir = gi & 1, m0 = chunk_row0(ci);
            LAS float* lr = (LAS float*)F.lds;
            LAS float* Bl = (LAS float*)(F.lds + 4096);
            __syncthreads();
            for (int i = tidl; i < 1024; i += NTHR) lr[i] = GATES[(size_t)(m0 + (i >> 4)) * 64 + 16 + dir * 16 + (i & 15)];
            const int ch = tidl;
            float w2[16];
#pragma unroll
            for (int r = 0; r < 16; ++r) w2[r] = F.gla_w2[((size_t)dir * 16 + r) * 512 + ch];
            const float b2 = F.gla_b2[dir * 512 + ch];
            __syncthreads();
            float b = 0.f;
            for (int i = 0; i < 64; ++i) { const int r = dir == 0 ? i : 63 - i;
                const f32x4 l0 = *(const LAS f32x4*)(lr + r * 16), l1 = *(const LAS f32x4*)(lr + r * 16 + 4), l2 = *(const LAS f32x4*)(lr + r * 16 + 8), l3 = *(const LAS f32x4*)(lr + r * 16 + 12);
                float xg = b2 + l0[0] * w2[0] + l0[1] * w2[1] + l0[2] * w2[2] + l0[3] * w2[3] + l1[0] * w2[4] + l1[1] * w2[5] + l1[2] * w2[6] + l1[3] * w2[7]
                              + l2[0] * w2[8] + l2[1] * w2[9] + l2[2] * w2[10] + l2[3] * w2[11] + l3[0] * w2[12] + l3[1] * w2[13] + l3[2] * w2[14] + l3[3] * w2[15];
                b += logsig_fast(xg) * (1.f / 16.f);
                Bl[r * 512 + ch] = b; }
            wsp<float>(F, WS_GENDG)[((size_t)dir * NCHUNK + ci) * 512 + ch] = __expf(b);
            __syncthreads();
            u32x4 vin[16];
#pragma unroll
            for (int j = 0; j < 16; ++j) { const int pi = tidl + j * 512, r = pi >> 7, cp = pi & 127; vin[j] = *(const u32x4*)(QKG + (size_t)(m0 + r) * 1024 + cp * 8); }
#pragma unroll
            for (int j = 0; j < 16; ++j) { const int pi = tidl + j * 512, r = pi >> 7, cp = pi & 127, m = m0 + r; const bool isk = cp >= 64;
                const u32x4 v = vin[j];
                const f32x4 b0 = *(const LAS f32x4*)(Bl + r * 512 + 8 * (cp & 63)), b1 = *(const LAS f32x4*)(Bl + r * 512 + 8 * (cp & 63) + 4);
                float f[8]; unpack8(v, f); float e[8];
#pragma unroll
                for (int q = 0; q < 4; ++q) { e[q] = isk ? __expf(-b0[q]) : __expf(b0[q]) * 0.08838834764831845f; e[4 + q] = isk ? __expf(-b1[q]) : __expf(b1[q]) * 0.08838834764831845f; }
                u32x4 o; o.x = pk2(f[0] * e[0], f[1] * e[1]); o.y = pk2(f[2] * e[2], f[3] * e[3]); o.z = pk2(f[4] * e[4], f[5] * e[5]); o.w = pk2(f[6] * e[6], f[7] * e[7]);
                *(u32x4*)(qkgt_row(F, dir, m) + cp * 8) = o; }
        }
    }
}

constexpr int L_AQ = 0, L_AK = 16384, L_VP = 32768, L_P = 49152, L_S = 65536, L_N = 131072 + 1024  ;
struct ScanSrc { const bf16* q; const bf16* k; const bf16* v; const f32x2* ab; const float* gend; int gstride; };
__device__ __forceinline__ int seg_chunk(int seg, int dir, int i) {
    if (seg < 0) return dir == 0 ? i : 3 - i;
    return dir == 0 ? seg * CPS + i : (NCH_LAT - 1 - seg * CPS) - i;
}
__device__ __forceinline__ void scan_stage(Frame& F, int model, int b, int h, int dir, int half, int ci, bool need_q) {
    const int m0 = chunk_row0(ci);
    LAS float* nb = (LAS float*)(F.lds + L_N);
    if (model == 0 && F.tid < 64) { const f32x2 ab = wsp<f32x2>(F, WS_AB)[((size_t)dir * MT + m0 + F.tid) * 4 + h]; nb[256 + F.tid] = ab.y; nb[320 + F.tid] = ab.x; }
    if (F.tid >= 64 && F.tid < 192) { const int dk = F.tid - 64;
        nb[128 + dk] = model == 0 ? wsp<float>(F, WS_GENDM)[((size_t)dir * NCHUNK + ci) * 4 + h] : wsp<float>(F, WS_GENDG)[((size_t)dir * NCHUNK + ci) * 512 + h * 128 + dk]; }
#pragma unroll
    for (int i = 0; i < 2; ++i) { const int p = F.tid + i * 512, r = p >> 4, cpart = p & 15, m = m0 + r;
        const bf16* qrow; const bf16* vrow;
        if (model == 0) { qrow = wsp<bf16>(F, WS_QKMC) + (size_t)m * 1024; vrow = wsp<bf16>(F, WS_VM) + (size_t)m * 1024; }
        else { qrow = qkgt_row(F, dir, m); vrow = wsp<bf16>(F, WS_VG) + (size_t)m * 1024; }
        if (need_q) *(LAS u32x4*)(F.lds + L_AQ + r * 256 + cpart * 16) = *(const u32x4*)(qrow + h * 128 + cpart * 8);
        *(LAS u32x4*)(F.lds + L_AK + r * 256 + cpart * 16) = *(const u32x4*)(qrow + 512 + h * 128 + cpart * 8);
        u32x4 v = *(const u32x4*)(vrow + h * 256 + half * 128 + cpart * 8);
        if (model == 0) { const float be = wsp<f32x2>(F, WS_AB)[((size_t)dir * MT + m) * 4 + h].y;
            v.x = pk2(bflo(v.x) * be, bfhi(v.x) * be); v.y = pk2(bflo(v.y) * be, bfhi(v.y) * be); v.z = pk2(bflo(v.z) * be, bfhi(v.z) * be); v.w = pk2(bflo(v.w) * be, bfhi(v.w) * be); }
        *(LAS u32x4*)(F.lds + L_VP + r * 256 + cpart * 16) = v; }
}
__device__ __forceinline__ void scan_update(Frame& F, int model) {
    LAS float* S = (LAS float*)(F.lds + L_S); LAS float* nb = (LAS float*)(F.lds + L_N);
    const LAS bf16* AK = (const LAS bf16*)(F.lds + L_AK); const LAS bf16* VP = (const LAS bf16*)(F.lds + L_VP);
    const int dk = F.tid >> 2, dv0 = (F.tid & 3) * 32;
    float a[32];
#pragma unroll
    for (int j = 0; j < 32; ++j) a[j] = S[dk * 128 + dv0 + j];
    float nn = 0.f;
    for (int s = 0; s < 64; ++s) { const float k = bf2f(AK[s * 128 + dk]);
        if (model == 0) nn += k * nb[256 + s];
#pragma unroll
        for (int j = 0; j < 32; j += 2) { const unsigned v = *(const LAS unsigned*)(VP + s * 128 + dv0 + j); a[j] += k * bflo(v); a[j + 1] += k * bfhi(v); } }
    const float g = nb[128 + dk];
#pragma unroll
    for (int j = 0; j < 32; ++j) S[dk * 128 + dv0 + j] = g * a[j];
    if (model == 0 && (F.tid & 3) == 0) nb[dk] = g * (nb[dk] + nn);
}
__device__ __forceinline__ bf16* state_ptr(const Frame& F, int sc, int slot, int half) { return wsp<bf16>(F, WS_STATE) + ((size_t)(sc * 8 + slot) * 2 + half) * 16384; }

__device__ __forceinline__ void p4_scan_local(Frame& F) {
    LAS float* S = (LAS float*)(F.lds + L_S); LAS float* nb = (LAS float*)(F.lds + L_N);
    for (int it0 = F.bid; it0 < 32 * 8 * 2; it0 += F.G) {
        const int it = (F.G == 256) ? (it0 & ~255) | ((((((it0 & 255) >> 4) << 3) | (it0 & 7)) << 1) | ((it0 >> 3) & 1)) : it0;
        const int half = it & 1, slot = (it >> 1) & 7, sc = it >> 4, seg = slot - 1;
        const int dir = sc & 1, h = (sc >> 1) & 3, b = (sc >> 3) & 1, model = sc >> 4;
        for (int i = F.tid; i < 16384; i += NTHR) S[i] = 0.f;
        if (F.tid < 128) nb[F.tid] = 0.f;
        float gacc = 1.f;
        __syncthreads();
        const int nch = seg < 0 ? NCH_CTX : CPS;
        for (int i = 0; i < nch; ++i) {
            const int c = seg_chunk(seg, dir, i), ci = seg < 0 ? 256 + b * 4 + c : b * 128 + c;
            scan_stage(F, model, b, h, dir, half, ci, false);
            __syncthreads();
            if (F.tid < 128) gacc *= nb[128 + F.tid];
            scan_update(F, model);
            __syncthreads();
        }
        bf16* st = state_ptr(F, sc, slot, half);
        for (int i = F.tid; i < 8192; i += NTHR) ((unsigned*)st)[i] = pk2(S[2 * i], S[2 * i + 1]);
        if (half == 0 && F.tid < 128) { wsp<float>(F, WS_NST)[(sc * 8 + slot) * 128 + F.tid] = nb[F.tid]; wsp<float>(F, WS_GSEG)[(sc * 8 + slot) * 128 + F.tid] = gacc; }
        __syncthreads();
    }
}
__device__ __forceinline__ void p5_scan_out(Frame& F) {
    LAS float* S = (LAS float*)(F.lds + L_S); LAS float* nb = (LAS float*)(F.lds + L_N); LAS float* P = (LAS float*)(F.lds + L_P);
    const LAS bf16* AQ = (const LAS bf16*)(F.lds + L_AQ); const LAS bf16* AK = (const LAS bf16*)(F.lds + L_AK); const LAS bf16* VP = (const LAS bf16*)(F.lds + L_VP);
    for (int it0 = F.bid; it0 < 2 * 2 * 4 * 8 * 2; it0 += F.G) {
        const int it = (F.G == 256) ? ((((it0 >> 4) << 3) | (it0 & 7)) << 1) | ((it0 >> 3) & 1) : it0;
        const int half = it & 1, seg = (it >> 1) & 7, h = (it >> 4) & 3, b = (it >> 6) & 1, model = it >> 7;
        bf16* HS = wsp<bf16>(F, model == 0 ? WS_QKM : WS_QKG);
        for (int dir = 0; dir < 2; ++dir) {
            const int sc = ((model * 2 + b) * 4 + h) * 2 + dir, s = dir == 0 ? seg : 7 - seg;
            { const int dk = F.tid >> 2, dv0 = (F.tid & 3) * 32; float a[32]; float nn = 0.f;
#pragma unroll
              for (int j = 0; j < 32; ++j) a[j] = 0.f;
              for (int slot = 0; slot <= s; ++slot) {
                  const float g = slot == 0 ? 0.f : wsp<float>(F, WS_GSEG)[(sc * 8 + slot) * 128 + dk];
                  const bf16* st = state_ptr(F, sc, slot, half) + dk * 128 + dv0;
#pragma unroll
                  for (int j = 0; j < 32; j += 2) { const unsigned v = *(const unsigned*)(st + j); a[j] = g * a[j] + bflo(v); a[j + 1] = g * a[j + 1] + bfhi(v); }
                  nn = g * nn + wsp<float>(F, WS_NST)[(sc * 8 + slot) * 128 + dk]; }
#pragma unroll
              for (int j = 0; j < 32; ++j) S[dk * 128 + dv0 + j] = a[j];
              if ((F.tid & 3) == 0) nb[dk] = nn; }
            __syncthreads();
            for (int i = 0; i < CPS; ++i) {
                const int c = seg_chunk(s, dir, i), ci = b * 128 + c, m0 = chunk_row0(ci);
                scan_stage(F, model, b, h, dir, half, ci, true);
                __syncthreads();
                for (int e = F.tid; e < 4096; e += NTHR) { const int t = e >> 6, s2 = e & 63; float p = 0.f;
                    if (dir == 0 ? (s2 <= t) : (s2 >= t)) {
                        for (int d8 = 0; d8 < 16; ++d8) { const u32x4 qa = *(const LAS u32x4*)(AQ + t * 128 + d8 * 8), ka = *(const LAS u32x4*)(AK + s2 * 128 + d8 * 8);
                            p += bflo(qa.x) * bflo(ka.x) + bfhi(qa.x) * bfhi(ka.x) + bflo(qa.y) * bflo(ka.y) + bfhi(qa.y) * bfhi(ka.y)
                               + bflo(qa.z) * bflo(ka.z) + bfhi(qa.z) * bfhi(ka.z) + bflo(qa.w) * bflo(ka.w) + bfhi(qa.w) * bfhi(ka.w); } }
                    P[e] = bf2f((unsigned short)f2bf(p)); }
                __syncthreads();
                { const int t = F.tid >> 3, dv0 = (F.tid & 7) * 16; float o[16];
#pragma unroll
                  for (int j = 0; j < 16; ++j) o[j] = 0.f;
                  float den = 0.f;
                  for (int s2 = 0; s2 < 64; ++s2) { const float p = P[t * 64 + s2];
                      if (model == 0) den += p * nb[256 + s2];
                      const u32x4 v0 = *(const LAS u32x4*)(VP + s2 * 128 + dv0), v1 = *(const LAS u32x4*)(VP + s2 * 128 + dv0 + 8);
                      o[0] += p * bflo(v0.x); o[1] += p * bfhi(v0.x); o[2] += p * bflo(v0.y); o[3] += p * bfhi(v0.y); o[4] += p * bflo(v0.z); o[5] += p * bfhi(v0.z); o[6] += p * bflo(v0.w); o[7] += p * bfhi(v0.w);
                      o[8] += p * bflo(v1.x); o[9] += p * bfhi(v1.x); o[10] += p * bflo(v1.y); o[11] += p * bfhi(v1.y); o[12] += p * bflo(v1.z); o[13] += p * bfhi(v1.z); o[14] += p * bflo(v1.w); o[15] += p * bfhi(v1.w); }
                  for (int dk = 0; dk < 128; ++dk) { const float q = bf2f(AQ[t * 128 + dk]);
                      if (model == 0) den += q * nb[dk];
                      const LAS float* sr = S + dk * 128 + dv0;
#pragma unroll
                      for (int j = 0; j < 16; ++j) o[j] += q * bf2f((unsigned short)f2bf(sr[j])); }
                  float rs = 1.f;
                  if (model == 0) { const float al = nb[320 + t]; rs = al / fmaxf(al * fabsf(den), 1.f); }
                  bf16* dst = HS + (size_t)(m0 + t) * 1024 + h * 256 + half * 128 + dv0;
                  float ssq = 0.f;
                  if (dir == 0) {
                      u32x4 w0, w1; w0.x = pk2(o[0] * rs, o[1] * rs); w0.y = pk2(o[2] * rs, o[3] * rs); w0.z = pk2(o[4] * rs, o[5] * rs); w0.w = pk2(o[6] * rs, o[7] * rs);
                      w1.x = pk2(o[8] * rs, o[9] * rs); w1.y = pk2(o[10] * rs, o[11] * rs); w1.z = pk2(o[12] * rs, o[13] * rs); w1.w = pk2(o[14] * rs, o[15] * rs);
                      *(u32x4*)dst = w0; *(u32x4*)(dst + 8) = w1;
                  } else {
                      const u32x4 p0 = *(const u32x4*)dst, p1 = *(const u32x4*)(dst + 8);
                      const float f[16] = {bflo(p0.x), bfhi(p0.x), bflo(p0.y), bfhi(p0.y), bflo(p0.z), bfhi(p0.z), bflo(p0.w), bfhi(p0.w), bflo(p1.x), bfhi(p1.x), bflo(p1.y), bfhi(p1.y), bflo(p1.z), bfhi(p1.z), bflo(p1.w), bfhi(p1.w)};
                      float r[16];
#pragma unroll
                      for (int j = 0; j < 16; ++j) { r[j] = f[j] + o[j] * rs; ssq += r[j] * r[j]; }
                      u32x4 w0, w1; w0.x = pk2(r[0], r[1]); w0.y = pk2(r[2], r[3]); w0.z = pk2(r[4], r[5]); w0.w = pk2(r[6], r[7]);
                      w1.x = pk2(r[8], r[9]); w1.y = pk2(r[10], r[11]); w1.z = pk2(r[12], r[13]); w1.w = pk2(r[14], r[15]);
                      *(u32x4*)dst = w0; *(u32x4*)(dst + 8) = w1;
                      ssq += __shfl_xor(ssq, 1); ssq += __shfl_xor(ssq, 2); ssq += __shfl_xor(ssq, 4);
                      if ((F.tid & 7) == 0) wsp<float>(F, WS_SSQ)[((size_t)(m0 + t) * 8 + model * 4 + h) * 2 + half] = ssq;
                  } }
                __syncthreads();
                scan_update(F, model);
                __syncthreads();
            }
        }
    }
}

typedef short s16x4 __attribute__((ext_vector_type(4)));
__device__ __forceinline__ unsigned offb(int row, int ch) { return 256u * (unsigned)row + 16u * (unsigned)(ch ^ (((row & 3) << 2) | ((row >> 2) & 3))); }
constexpr int M_AQ = 0, M_AK = 16384, M_VP = 32768, M_P = 49152, M_O = 57344, O_LD = 132;
template <int TILE>
__device__ __forceinline__ void tr_frag2(unsigned x0, unsigned x1, bf16x8& f0, bf16x8& f1) {
    s16x4 r0, r1, r2, r3;
    asm volatile("ds_read_b64_tr_b16 %0, %4 offset:%6\n\tds_read_b64_tr_b16 %1, %5 offset:%6\n\tds_read_b64_tr_b16 %2, %4 offset:%7\n\tds_read_b64_tr_b16 %3, %5 offset:%7\n\ts_waitcnt lgkmcnt(0)"
                 : "=&v"(r0), "=&v"(r1), "=&v"(r2), "=&v"(r3) : "v"(x0), "v"(x1), "i"(TILE), "i"(TILE + 8192) : "memory");
    f0 = __builtin_shufflevector(r0, r1, 0, 1, 2, 3, 4, 5, 6, 7); f1 = __builtin_shufflevector(r2, r3, 0, 1, 2, 3, 4, 5, 6, 7);
}
template <int TILE>
__device__ __forceinline__ void tr_frag8(unsigned a0, unsigned a1, unsigned b0, unsigned b1, unsigned c0, unsigned c1, unsigned d0, unsigned d1, bf16x8 (&f)[8]) {
    s16x4 r[16];
    asm volatile("ds_read_b64_tr_b16 %0, %16 offset:%24\n\tds_read_b64_tr_b16 %1, %17 offset:%24\n\tds_read_b64_tr_b16 %2, %16 offset:%25\n\tds_read_b64_tr_b16 %3, %17 offset:%25\n\t"
                 "ds_read_b64_tr_b16 %4, %18 offset:%24\n\tds_read_b64_tr_b16 %5, %19 offset:%24\n\tds_read_b64_tr_b16 %6, %18 offset:%25\n\tds_read_b64_tr_b16 %7, %19 offset:%25\n\t"
                 "ds_read_b64_tr_b16 %8, %20 offset:%24\n\tds_read_b64_tr_b16 %9, %21 offset:%24\n\tds_read_b64_tr_b16 %10, %20 offset:%25\n\tds_read_b64_tr_b16 %11, %21 offset:%25\n\t"
                 "ds_read_b64_tr_b16 %12, %22 offset:%24\n\tds_read_b64_tr_b16 %13, %23 offset:%24\n\tds_read_b64_tr_b16 %14, %22 offset:%25\n\tds_read_b64_tr_b16 %15, %23 offset:%25\n\ts_waitcnt lgkmcnt(0)"
                 : "=&v"(r[0]), "=&v"(r[1]), "=&v"(r[2]), "=&v"(r[3]), "=&v"(r[4]), "=&v"(r[5]), "=&v"(r[6]), "=&v"(r[7]), "=&v"(r[8]), "=&v"(r[9]), "=&v"(r[10]), "=&v"(r[11]), "=&v"(r[12]), "=&v"(r[13]), "=&v"(r[14]), "=&v"(r[15])
                 : "v"(a0), "v"(a1), "v"(b0), "v"(b1), "v"(c0), "v"(c1), "v"(d0), "v"(d1), "i"(TILE), "i"(TILE + 8192) : "memory");
#pragma unroll
    for (int j = 0; j < 8; ++j) f[j] = __builtin_shufflevector(r[2 * j], r[2 * j + 1], 0, 1, 2, 3, 4, 5, 6, 7);
}
template <int TILE>
__device__ __forceinline__ void tr_frag4(unsigned x0, unsigned x1, unsigned y0, unsigned y1, bf16x8& f0, bf16x8& f1, bf16x8& f2, bf16x8& f3) {
    s16x4 r0, r1, r2, r3, r4, r5, r6, r7;
    asm volatile("ds_read_b64_tr_b16 %0, %8 offset:%12\n\tds_read_b64_tr_b16 %1, %9 offset:%12\n\tds_read_b64_tr_b16 %2, %8 offset:%13\n\tds_read_b64_tr_b16 %3, %9 offset:%13\n\t"
                 "ds_read_b64_tr_b16 %4, %10 offset:%12\n\tds_read_b64_tr_b16 %5, %11 offset:%12\n\tds_read_b64_tr_b16 %6, %10 offset:%13\n\tds_read_b64_tr_b16 %7, %11 offset:%13\n\ts_waitcnt lgkmcnt(0)"
                 : "=&v"(r0), "=&v"(r1), "=&v"(r2), "=&v"(r3), "=&v"(r4), "=&v"(r5), "=&v"(r6), "=&v"(r7) : "v"(x0), "v"(x1), "v"(y0), "v"(y1), "i"(TILE), "i"(TILE + 8192) : "memory");
    f0 = __builtin_shufflevector(r0, r1, 0, 1, 2, 3, 4, 5, 6, 7); f1 = __builtin_shufflevector(r2, r3, 0, 1, 2, 3, 4, 5, 6, 7);
    f2 = __builtin_shufflevector(r4, r5, 0, 1, 2, 3, 4, 5, 6, 7); f3 = __builtin_shufflevector(r6, r7, 0, 1, 2, 3, 4, 5, 6, 7);
}
#define MFMA16(a, b, c) __builtin_amdgcn_mfma_f32_16x16x32_bf16((a), (b), (c), 0, 0, 0)
__device__ __forceinline__ bf16* mstate_ptr(const Frame& F, int sc, int slot, int half) { return wsp<bf16>(F, WS_STATE) + ((size_t)(sc * 8 + slot) * 2 + half) * 16384; }

#define LBAR() asm volatile("s_waitcnt lgkmcnt(0)\n\ts_barrier" ::: "memory")
template <bool OUT>
__device__ __forceinline__ void mscan_run(Frame& F, int model, int b, int h, int dir, int half, int seg, f32x4 (&S)[2][8], float& gacc) {
    LAS unsigned char* lds = F.lds; LAS float* nb = (LAS float*)(F.lds + L_N);
    LAS unsigned short* nbh = (LAS unsigned short*)(F.lds + L_N + 2048);
    const unsigned lb = (unsigned)(uintptr_t)F.lds;
    const int w = F.wave, lane = F.lane, li = lane & 15, lg = lane >> 4, tq = li >> 2, tp = lane & 3;
    const bool st = w < 4; const int sw = w & 3;
    const int nch = seg < 0 ? NCH_CTX : CPS;
    bf16* HS = wsp<bf16>(F, model == 0 ? WS_QKM : WS_QKG);
    const int mli = ((li & 3) << 2) | ((li >> 2) & 3);
    const unsigned rowb = 256u * li + 16u * (lg ^ mli);
    const unsigned o2b = 256u * li + 16u * ((lg >> 1) ^ mli) + 8u * (lg & 1);
    const unsigned trb0 = 256u * (8 * lg + tq) + 16u * ((tp >> 1) ^ ((tq << 2) | ((2 * lg) & 3))) + 8u * (tp & 1);
    const unsigned trb1 = 256u * (8 * lg + 4 + tq) + 16u * ((tp >> 1) ^ ((tq << 2) | ((2 * lg + 1) & 3))) + 8u * (tp & 1);
    const unsigned pra0 = lb + M_P + (128u * li + 16u * (lg ^ (li & 7))), pra1 = lb + M_P + ((128u * li + 16u * (lg ^ (li & 7))) ^ 64u);
    const unsigned poff0 = (unsigned)((F.tid >> 4) * 1024 + (F.tid & 15) * 8) * 2u, poff1 = poff0 + 32u * 2048u;
    auto final_pass = [&](const int m0, const u32x4 (&prevh)[2]) {
        LAS float* Ol = (LAS float*)(F.lds + M_O);
#pragma unroll
        for (int i = 0; i < 2; ++i) { const int p = F.tid + i * 512, t = p >> 4, c8 = p & 15;
            const f32x4 o0 = *(const LAS f32x4*)(Ol + t * O_LD + 8 * c8), o1 = *(const LAS f32x4*)(Ol + t * O_LD + 8 * c8 + 4);
            float rs = 1.f;
            if (model == 0) rs = nb[384 + t];
            bf16* dst = (bf16*)((unsigned char*)(HS + (size_t)m0 * 1024 + h * 256 + half * 128) + (i == 0 ? poff0 : poff1));
            float r[8] = {o0[0] * rs, o0[1] * rs, o0[2] * rs, o0[3] * rs, o1[0] * rs, o1[1] * rs, o1[2] * rs, o1[3] * rs};
            if (dir == 1) { const u32x4 pv = prevh[i];
                r[0] += bflo(pv.x); r[1] += bfhi(pv.x); r[2] += bflo(pv.y); r[3] += bfhi(pv.y); r[4] += bflo(pv.z); r[5] += bfhi(pv.z); r[6] += bflo(pv.w); r[7] += bfhi(pv.w);
                float ssq = (r[0] * r[0] + r[1] * r[1]) + (r[2] * r[2] + r[3] * r[3]) + (r[4] * r[4] + r[5] * r[5]) + (r[6] * r[6] + r[7] * r[7]);
                ssq += __shfl_xor(ssq, 1); ssq += __shfl_xor(ssq, 2); ssq += __shfl_xor(ssq, 4); ssq += __shfl_xor(ssq, 8);
                if (c8 == 0) wsp<float>(F, WS_SSQ)[((size_t)(m0 + t) * 8 + model * 4 + h) * 2 + half] = ssq; }
            u32x4 wv; wv.x = pkbf(r[0], r[1]); wv.y = pkbf(r[2], r[3]); wv.z = pkbf(r[4], r[5]); wv.w = pkbf(r[6], r[7]);
            *(u32x4*)dst = wv; }
    };
    const unsigned pwb = 128u * li + 8u * (lg & 1) + 16u * ((lg >> 1) ^ (li & 7));
    auto ptile = [&](const int ti, const int sh) {
        const bool used = dir == 0 ? !(sh == 1 && ti < 2) : !(sh == 0 && ti >= 2);
        if (!used) return;
        unsigned rowl = rowb; asm volatile("" : "+v"(rowl));
        bf16x8 pa[4], pb0[4], pb1[4];
#pragma unroll
        for (int kk = 0; kk < 4; ++kk) { const unsigned ra = lb + (rowl ^ ((unsigned)kk << 6)); pa[kk] = *(const LAS bf16x8*)(uintptr_t)(ra + M_AQ + 4096u * ti); pb0[kk] = *(const LAS bf16x8*)(uintptr_t)(ra + M_AK + 8192u * sh); pb1[kk] = *(const LAS bf16x8*)(uintptr_t)(ra + M_AK + 8192u * sh + 4096u); }
        f32x4 acc0 = {0.f, 0.f, 0.f, 0.f}, acc1 = acc0;
#pragma unroll
        for (int kk = 0; kk < 4; ++kk) { acc0 = MFMA16(pb0[kk], pa[kk], acc0); acc1 = MFMA16(pb1[kk], pa[kk], acc1); }
        const int t = 16 * ti + li;
#pragma unroll
        for (int sj = 0; sj < 2; ++sj) { const f32x4 acc = sj == 0 ? acc0 : acc1; const int s0 = 16 * (2 * sh + sj) + 4 * lg; float pv[4];
#pragma unroll
            for (int r = 0; r < 4; ++r) { const bool keep = dir == 0 ? (s0 + r <= t) : (s0 + r >= t); pv[r] = keep ? acc[r] : 0.f; }
            u32x2 pw; pw.x = pkbf(pv[0], pv[1]); pw.y = pkbf(pv[2], pv[3]);
            *(LAS u32x2*)(uintptr_t)(lb + M_P + 2048u * ti + (pwb ^ ((unsigned)(4 * sh + 2 * sj) << 4))) = pw; }
    };
    auto chunk_m0 = [&](const int ic) { const int c = seg_chunk(seg, dir, ic), ci = seg < 0 ? 256 + b * 4 + c : b * 128 + c; return chunk_row0(ci); };
    if (st) {
        const unsigned ola = lb + M_O + 4u * ((4 * lg) * O_LD + 32 * sw + li);
        for (int ic = 0; ic < nch; ++ic) {
            const int m0 = chunk_m0(ic);
            LBAR();
            if (F.tid < 128) gacc *= nb[128 + F.tid];
            unsigned o2l = o2b, tr0l = trb0, tr1l = trb1; asm volatile("" : "+v"(o2l), "+v"(tr0l), "+v"(tr1l));
            bf16x8 VB[2][2];
            tr_frag4<M_VP>(lb + (tr0l ^ ((unsigned)(2 * sw) << 5)), lb + (tr1l ^ ((unsigned)(2 * sw) << 5)), lb + (tr0l ^ ((unsigned)(2 * sw + 1) << 5)), lb + (tr1l ^ ((unsigned)(2 * sw + 1) << 5)), VB[0][0], VB[0][1], VB[1][0], VB[1][1]);
            u32x4 prevh[2] = {{0u, 0u, 0u, 0u}, {0u, 0u, 0u, 0u}};
            if (OUT) {
#pragma unroll
                for (int i = 0; i < 2; ++i) prevh[i] = *(const u32x4*)((const unsigned char*)(HS + (size_t)m0 * 1024 + h * 256 + half * 128) + (i == 0 ? poff0 : poff1) * (unsigned)dir);
                ptile(sw, 1);
                f32x4 O[2][4];
#pragma unroll
                for (int j = 0; j < 2; ++j)
#pragma unroll
                    for (int q = 0; q < 4; ++q) O[j][q] = (f32x4){0.f, 0.f, 0.f, 0.f};
#pragma unroll
                for (int kh = 0; kh < 2; ++kh) {
                    u32x2 alo[2][4], ahi[2][4];
#pragma unroll
                    for (int k2 = 0; k2 < 2; ++k2)
#pragma unroll
                        for (int q = 0; q < 4; ++q) { alo[k2][q] = *(const LAS u32x2*)(uintptr_t)((o2l ^ ((unsigned)(4 * (2 * kh + k2)) << 4)) + lb + M_AQ + 4096u * q); ahi[k2][q] = *(const LAS u32x2*)(uintptr_t)((o2l ^ ((unsigned)(4 * (2 * kh + k2) + 2) << 4)) + lb + M_AQ + 4096u * q); }
#pragma unroll
                    for (int k2 = 0; k2 < 2; ++k2) { const int kk = 2 * kh + k2; bf16x8 Bk[2];
#pragma unroll
                        for (int j = 0; j < 2; ++j) { u32x4 bw; bw.x = pkbf(S[j][2 * kk][0], S[j][2 * kk][1]); bw.y = pkbf(S[j][2 * kk][2], S[j][2 * kk][3]); bw.z = pkbf(S[j][2 * kk + 1][0], S[j][2 * kk + 1][1]); bw.w = pkbf(S[j][2 * kk + 1][2], S[j][2 * kk + 1][3]); Bk[j] = __builtin_bit_cast(bf16x8, bw); }
#pragma unroll
                        for (int q = 0; q < 4; ++q) { u32x4 aw; aw.x = alo[k2][q].x; aw.y = alo[k2][q].y; aw.z = ahi[k2][q].x; aw.w = ahi[k2][q].y; const bf16x8 Af = __builtin_bit_cast(bf16x8, aw);
                            O[0][q] = MFMA16(Af, Bk[0], O[0][q]); O[1][q] = MFMA16(Af, Bk[1], O[1][q]); } }
                    asm volatile("" ::: "memory");
                }
                LBAR();
                bf16x8 p0[4], p1[4];
#pragma unroll
                for (int q = 0; q < 4; ++q) { p0[q] = *(const LAS bf16x8*)(uintptr_t)(pra0 + 2048u * q); p1[q] = *(const LAS bf16x8*)(uintptr_t)(pra1 + 2048u * q); }
#pragma unroll
                for (int q = 0; q < 4; ++q) {
                    if (dir == 0 || q < 2) { O[0][q] = MFMA16(p0[q], VB[0][0], O[0][q]); O[1][q] = MFMA16(p0[q], VB[1][0], O[1][q]); }
                    if (dir == 1 || q >= 2) { O[0][q] = MFMA16(p1[q], VB[0][1], O[0][q]); O[1][q] = MFMA16(p1[q], VB[1][1], O[1][q]); } }
#pragma unroll
                for (int j = 0; j < 2; ++j)
#pragma unroll
                    for (int q = 0; q < 4; ++q)
#pragma unroll
                        for (int r = 0; r < 4; ++r) *(LAS float*)(uintptr_t)(ola + 64u * j + 4u * (unsigned)((16 * q + r) * O_LD)) = O[j][q][r];
            }
#pragma unroll
            for (int kp = 0; kp < 4; ++kp) { bf16x8 A0, A1, A2, A3; const int kt = 2 * kp;
                const f32x4 g0 = *(const LAS f32x4*)(nb + 128 + 16 * kt + 4 * lg), g1 = *(const LAS f32x4*)(nb + 128 + 16 * (kt + 1) + 4 * lg);
                tr_frag4<M_AK>(lb + (tr0l ^ ((unsigned)kt << 5)), lb + (tr1l ^ ((unsigned)kt << 5)), lb + (tr0l ^ ((unsigned)(kt + 1) << 5)), lb + (tr1l ^ ((unsigned)(kt + 1) << 5)), A0, A1, A2, A3);
#pragma unroll
                for (int j = 0; j < 2; ++j) { S[j][kt] = MFMA16(A0, VB[j][0], S[j][kt]); S[j][kt + 1] = MFMA16(A2, VB[j][0], S[j][kt + 1]); }
#pragma unroll
                for (int j = 0; j < 2; ++j) { S[j][kt] = MFMA16(A1, VB[j][1], S[j][kt]); S[j][kt + 1] = MFMA16(A3, VB[j][1], S[j][kt + 1]); }
#pragma unroll
                for (int j = 0; j < 2; ++j) { S[j][kt] = S[j][kt] * g0; S[j][kt + 1] = S[j][kt + 1] * g1; } }
            LBAR();
            if (OUT) final_pass(m0, prevh);
        }
    } else {
        const int ht = F.tid - 256;
        const unsigned hoff = (unsigned)((ht >> 4) * 1024 + (ht & 15) * 8) * 2u;
        const unsigned aoff = (unsigned)(ht >> 4) * 32u + 4u, aoffl = (unsigned)(ht & 63) * 32u;
        const f32x2* ABd = wsp<f32x2>(F, WS_AB) + (size_t)dir * MT * 4 + h;
        const bf16* vbase = wsp<bf16>(F, model == 0 ? WS_VM : WS_VG) + h * 256 + half * 128;
        struct SR { u32x4 q[4], k[4], v[4]; float be[4]; f32x2 ab; float ge; };
        SR R;
        auto issue = [&](const int ic_) {
            const int c_ = seg_chunk(seg, dir, ic_), ci_ = seg < 0 ? 256 + b * 4 + c_ : b * 128 + c_, m0_ = chunk_row0(ci_);
            const unsigned char* abr = (const unsigned char*)(ABd + (size_t)m0_ * 4);
            { const float* abp = (const float*)(abr + aoffl); R.ab.x = abp[0]; R.ab.y = abp[1]; }
            const float* gp = model == 0 ? wsp<float>(F, WS_GENDM) + ((size_t)dir * NCHUNK + ci_) * 4 + h : wsp<float>(F, WS_GENDG) + ((size_t)dir * NCHUNK + ci_) * 512 + h * 128 + ((ht - 64) & 127);
            R.ge = *gp;
            const long long qoff = model == 0 ? (long long)WS_QKMC : (m0_ < M_LAT ? 0ll : (long long)WS_QKGTC + ((long long)dir * M_CTX - M_LAT) * 2048);
            const unsigned char* qbb = (model == 1 && m0_ < M_LAT) ? (const unsigned char*)F.out + (size_t)dir * M_LAT * 2048 : (const unsigned char*)F.ws + qoff;
            const unsigned char* qr = qbb + (size_t)m0_ * 2048 + h * 256;
            const unsigned char* vr = (const unsigned char*)(vbase + (size_t)m0_ * 1024);
#pragma unroll
            for (int i = 0; i < 4; ++i) { const unsigned o = hoff + (unsigned)i * 16u * 2048u;
                if (OUT) R.q[i] = *(const u32x4*)(qr + o);
                R.k[i] = *(const u32x4*)(qr + 1024 + o); R.v[i] = *(const u32x4*)(vr + o); R.be[i] = *(const float*)(abr + aoff + (unsigned)i * 16u * 32u); }
        };
        const int ti = sw;
        const unsigned fra = lb + L_N + 2048 + (li == 1 ? 128u : 0u) + 16u * lg;
        const unsigned nfa = lb + L_N + 2048 + 256 + (li == 1 ? 256u : 0u) + 16u * lg;
        issue(0);
        for (int ic = 0; ic < nch; ++ic) {
            const int m0 = chunk_m0(ic);
            if (model == 0 && ht < 64) { const float be = R.ab.y; nb[320 + ht] = R.ab.x;
                const unsigned hi = pkbf(be, be) & 0xffffu; nbh[ht] = (unsigned short)hi; nbh[64 + ht] = (unsigned short)(pkbf(be - bflo(hi), 0.f) & 0xffffu); }
            if (ht >= 64 && ht < 192) nb[128 + ht - 64] = R.ge;
#pragma unroll
            for (int i = 0; i < 4; ++i) { const int p = ht + i * 256, r = p >> 4, cp = p & 15;
                const unsigned o = offb(r, cp);
                if (OUT) *(LAS u32x4*)(lds + M_AQ + o) = R.q[i];
                *(LAS u32x4*)(lds + M_AK + o) = R.k[i];
                u32x4 v = R.v[i];
                if (model == 0) { const float be = R.be[i];
                    v.x = pkbf(bflo(v.x) * be, bfhi(v.x) * be); v.y = pkbf(bflo(v.y) * be, bfhi(v.y) * be); v.z = pkbf(bflo(v.z) * be, bfhi(v.z) * be); v.w = pkbf(bflo(v.w) * be, bfhi(v.w) * be); }
                *(LAS u32x4*)(lds + M_VP + o) = v; }
            LBAR();
            u32x4 prevh[2] = {{0u, 0u, 0u, 0u}, {0u, 0u, 0u, 0u}};
            if (OUT) {
#pragma unroll
                for (int i = 0; i < 2; ++i) prevh[i] = *(const u32x4*)((const unsigned char*)(HS + (size_t)m0 * 1024 + h * 256 + half * 128) + (i == 0 ? poff0 : poff1) * (unsigned)dir);
                ptile(ti, 0);
            }
            if (ic + 1 < nch) issue(ic + 1);
            unsigned rowl = rowb, tr0l = trb0, tr1l = trb1; asm volatile("" : "+v"(rowl), "+v"(tr0l), "+v"(tr1l));
            bf16x8 BB0, BB1;
            { u32x4 z = {0u, 0u, 0u, 0u}; BB0 = __builtin_bit_cast(bf16x8, z); BB1 = BB0; }
            if (model == 0) { u32x4 f0 = *(const LAS u32x4*)(uintptr_t)fra, f1 = *(const LAS u32x4*)(uintptr_t)(fra + 64u); const u32x4 z = {0u, 0u, 0u, 0u};
                if (li > 1) { f0 = z; f1 = z; } BB0 = __builtin_bit_cast(bf16x8, f0); BB1 = __builtin_bit_cast(bf16x8, f1); }
            f32x4 dq = {0.f, 0.f, 0.f, 0.f};
            if (OUT && model == 0) {
                bf16x8 pa[4]; u32x4 nf[4]; const u32x4 z = {0u, 0u, 0u, 0u};
#pragma unroll
                for (int kk = 0; kk < 4; ++kk) { pa[kk] = *(const LAS bf16x8*)(uintptr_t)(lb + (rowl ^ ((unsigned)kk << 6)) + M_AQ + 4096u * ti); nf[kk] = *(const LAS u32x4*)(uintptr_t)(nfa + 64u * kk); if (li > 1) nf[kk] = z; }
#pragma unroll
                for (int kk = 0; kk < 4; ++kk) dq = MFMA16(pa[kk], __builtin_bit_cast(bf16x8, nf[kk]), dq);
            }
            f32x4 nacc0 = {0.f, 0.f, 0.f, 0.f}, nacc1 = nacc0;
            if (model == 0) { bf16x8 A0, A1, A2, A3;
                tr_frag4<M_AK>(lb + (tr0l ^ ((unsigned)(2 * ti) << 5)), lb + (tr1l ^ ((unsigned)(2 * ti) << 5)), lb + (tr0l ^ ((unsigned)(2 * ti + 1) << 5)), lb + (tr1l ^ ((unsigned)(2 * ti + 1) << 5)), A0, A1, A2, A3);
                nacc0 = MFMA16(A0, BB0, nacc0); nacc0 = MFMA16(A1, BB1, nacc0); nacc1 = MFMA16(A2, BB0, nacc1); nacc1 = MFMA16(A3, BB1, nacc1); }
            float nnew[8] = {0.f, 0.f, 0.f, 0.f, 0.f, 0.f, 0.f, 0.f};
            if (model == 0) { const f32x4 no0 = *(const LAS f32x4*)(nb + 32 * ti + 4 * lg), no1 = *(const LAS f32x4*)(nb + 32 * ti + 16 + 4 * lg), gw0 = *(const LAS f32x4*)(nb + 128 + 32 * ti + 4 * lg), gw1 = *(const LAS f32x4*)(nb + 128 + 32 * ti + 16 + 4 * lg);
#pragma unroll
                for (int r = 0; r < 4; ++r) { nnew[r] = gw0[r] * (no0[r] + nacc0[r] + __shfl_xor(nacc0[r], 1)); nnew[4 + r] = gw1[r] * (no1[r] + nacc1[r] + __shfl_xor(nacc1[r], 1)); } }
            if (OUT) {
                LBAR();
                if (model == 0) { f32x4 dp = dq;
                    const bf16x8 p0 = *(const LAS bf16x8*)(uintptr_t)(pra0 + 2048u * ti), p1 = *(const LAS bf16x8*)(uintptr_t)(pra1 + 2048u * ti);
                    if (dir == 0 || ti < 2) dp = MFMA16(p0, BB0, dp);
                    if (dir == 1 || ti >= 2) dp = MFMA16(p1, BB1, dp);
#pragma unroll
                    for (int r = 0; r < 4; ++r) { const float v = dp[r] + __shfl_xor(dp[r], 1); const float al = nb[320 + 16 * ti + 4 * lg + r];
                        if (li == 0) nb[384 + 16 * ti + 4 * lg + r] = al / fmaxf(al * fabsf(v), 1.f); } }
            }
            LBAR();
            if (model == 0 && li == 0) {
#pragma unroll
                for (int j = 0; j < 2; ++j) { const int dk0 = 32 * ti + 16 * j + 4 * lg; const float* nn = nnew + 4 * j;
                    f32x4 nv = {nn[0], nn[1], nn[2], nn[3]}; *(LAS f32x4*)(nb + dk0) = nv;
                    u32x2 hv, lv; const unsigned h0 = pkbf(nn[0], nn[1]), h1 = pkbf(nn[2], nn[3]); hv.x = h0; hv.y = h1;
                    lv.x = pkbf(nn[0] - bflo(h0), nn[1] - bfhi(h0)); lv.y = pkbf(nn[2] - bflo(h1), nn[3] - bfhi(h1));
                    *(LAS u32x2*)(nbh + 128 + dk0) = hv; *(LAS u32x2*)(nbh + 256 + dk0) = lv; } }
            if (OUT) final_pass(m0, prevh);
        }
    }
}
__device__ __forceinline__ void p4m_scan_local(Frame& F) {
    LAS float* nb = (LAS float*)(F.lds + L_N);
    for (int it0 = F.bid; it0 < 32 * 8 * 2; it0 += F.G) {
        const int it = (F.G == 256) ? (it0 & ~255) | ((((((it0 & 255) >> 4) << 3) | (it0 & 7)) << 1) | ((it0 >> 3) & 1)) : it0;
        const int half = it & 1, slot = (it >> 1) & 7, sc = it >> 4, seg = slot - 1;
        const int dir = sc & 1, h = (sc >> 1) & 3, b = (sc >> 3) & 1, model = sc >> 4;
        f32x4 S[2][8];
#pragma unroll
        for (int j = 0; j < 2; ++j)
#pragma unroll
            for (int kt = 0; kt < 8; ++kt) S[j][kt] = (f32x4){0.f, 0.f, 0.f, 0.f};
        __syncthreads();
        if (F.tid < 128) nb[F.tid] = 0.f;
        float gacc = 1.f;
        mscan_run<false>(F, model, b, h, dir, half, seg, S, gacc);
        __syncthreads();
        if (F.wave < 4) {
#pragma unroll
            for (int j = 0; j < 2; ++j) { unsigned so = (unsigned)((2 * F.wave + j) * 512 + F.lane) * 8u; asm volatile("" : "+v"(so));
                bf16* st = (bf16*)((unsigned char*)mstate_ptr(F, sc, slot, half) + so);
#pragma unroll
                for (int kt = 0; kt < 8; ++kt) { u32x2 v; v.x = pkbf(S[j][kt][0], S[j][kt][1]); v.y = pkbf(S[j][kt][2], S[j][kt][3]); *(u32x2*)(st + kt * 256) = v; } } }
        if (half == 0 && F.tid < 128) { wsp<float>(F, WS_NST)[(sc * 8 + slot) * 128 + F.tid] = nb[F.tid]; wsp<float>(F, WS_GSEG)[(sc * 8 + slot) * 128 + F.tid] = gacc; }
    }
}
__device__ __forceinline__ void p5m_scan_out(Frame& F) {
    LAS float* nb = (LAS float*)(F.lds + L_N);
    for (int it0 = F.bid; it0 < 2 * 2 * 4 * 8 * 2; it0 += F.G) {
        const int it = (F.G == 256) ? ((((it0 >> 4) << 3) | (it0 & 7)) << 1) | ((it0 >> 3) & 1) : it0;
        const int half = it & 1, seg = (it >> 1) & 7, h = (it >> 4) & 3, b = (it >> 6) & 1, model = it >> 7;
        for (int dir = 0; dir < 2; ++dir) {
            const int sc = ((model * 2 + b) * 4 + h) * 2 + dir, s = dir == 0 ? seg : 7 - seg;
            f32x4 S[2][8];
#pragma unroll
            for (int j = 0; j < 2; ++j)
#pragma unroll
                for (int kt = 0; kt < 8; ++kt) S[j][kt] = (f32x4){0.f, 0.f, 0.f, 0.f};
            float nn = 0.f;
            for (int slot = 0; slot <= s; ++slot) {
                const float* gs = wsp<float>(F, WS_GSEG) + (sc * 8 + slot) * 128;
                const float gv = gs[F.tid & 127], nv = wsp<float>(F, WS_NST)[(sc * 8 + slot) * 128 + (F.tid & 127)];
                if (F.wave < 4) {
                    f32x4 gv4[8];
#pragma unroll
                    for (int kt = 0; kt < 8; ++kt) gv4[kt] = *(const f32x4*)(gs + 16 * kt + 4 * (F.lane >> 4));
#pragma unroll
                    for (int j = 0; j < 2; ++j) { unsigned so = (unsigned)((2 * F.wave + j) * 512 + F.lane) * 8u; asm volatile("" : "+v"(so));
                        const bf16* stp = (const bf16*)((const unsigned char*)mstate_ptr(F, sc, slot, half) + so);
                        u32x2 sv[8];
#pragma unroll
                        for (int kt = 0; kt < 8; ++kt) sv[kt] = *(const u32x2*)(stp + kt * 256);
#pragma unroll
                        for (int kt = 0; kt < 8; ++kt) { const u32x2 v = sv[kt]; f32x4 g4 = gv4[kt]; if (slot == 0) g4 = (f32x4){0.f, 0.f, 0.f, 0.f};
                            S[j][kt][0] = g4[0] * S[j][kt][0] + bflo(v.x); S[j][kt][1] = g4[1] * S[j][kt][1] + bfhi(v.x); S[j][kt][2] = g4[2] * S[j][kt][2] + bflo(v.y); S[j][kt][3] = g4[3] * S[j][kt][3] + bfhi(v.y); } } }
                nn = (slot > 0 ? gv : 0.f) * nn + nv; }
            __syncthreads();
            if (F.tid < 128) { nb[F.tid] = nn; LAS unsigned short* nbh = (LAS unsigned short*)(F.lds + L_N + 2048);
                const unsigned hi = pkbf(nn, nn) & 0xffffu; nbh[128 + F.tid] = (unsigned short)hi; nbh[256 + F.tid] = (unsigned short)(pkbf(nn - bflo(hi), 0.f) & 0xffffu); }
            float gacc = 1.f;
            mscan_run<true>(F, model, b, h, dir, half, s, S, gacc);
        }
    }
}

struct EpiProjB {
    unsigned char* ws; const float* ml_norm; const float* gla_norm;
    __device__ __forceinline__ void operator()(const f32x4 (&acc)[2][2][4][2], const Unit& u, int wr, int wc, int fr, int fq) const {
        const int row0 = u.pm * 256 + wr * 64 + fr, colt = (u.pn & 3) * 256 + wc * 32 + 8 * fq;
        if (u.pn < 8) {
            const int model = u.pn >> 2, head = u.pn & 3;
            bf16* base = (bf16*)(ws + (model == 0 ? WS_QKM : WS_QKG)) + colt;
            const float* nw = (model == 0 ? ml_norm : gla_norm) + colt;
            const float* ssq = (const float*)(ws + WS_SSQ);
            const float gsel = model == 0 ? 0.f : 1.f;
#pragma unroll
            for (int ai = 0; ai < 2; ++ai)
#pragma unroll
                for (int m = 0; m < 4; ++m) { asm volatile("" ::: "memory");
                    const int row = row0 + ai * 128 + m * 16; bf16* rowp = base + (size_t)row * 1024;
                    const f32x2 sq = *(const f32x2*)(ssq + ((size_t)row * 8 + model * 4 + head) * 2);
                    const float rstd = 1.f / sqrtf((sq.x + sq.y) * (1.f / 256.f) + EPS);
                    float one = 1.f; asm volatile("" : "+v"(one));
#pragma unroll
                    for (int bj = 0; bj < 2; ++bj) { const f32x4 a0 = acc[ai][bj][m][0] * one, a1 = acc[ai][bj][m][1] * one;
                        const u32x4 hv = *(const u32x4*)(rowp + bj * 128); const f32x4 n0 = *(const f32x4*)(nw + bj * 128), n1 = *(const f32x4*)(nw + bj * 128 + 4);
                        float hvf[8]; unpack8(hv, hvf); float o[8];
#pragma unroll
                        for (int j = 0; j < 4; ++j) { const float s0 = sigm(a0[j]), s1 = sigm(a1[j]);
                            o[j] = hvf[j] * rstd * n0[j] * (s0 + gsel * (s0 * a0[j] - s0)); o[4 + j] = hvf[4 + j] * rstd * n1[j] * (s1 + gsel * (s1 * a1[j] - s1)); }
                        u32x4 w; w.x = cvt_pk_bf16(o[0], o[1]); w.y = cvt_pk_bf16(o[2], o[3]); w.z = cvt_pk_bf16(o[4], o[5]); w.w = cvt_pk_bf16(o[6], o[7]);
                        *(u32x4*)(rowp + bj * 128) = w; } }
        } else {
            bf16* base = (bf16*)(ws + (u.pn < 12 ? WS_VG : WS_QKMC)) + colt;
#pragma unroll
            for (int ai = 0; ai < 2; ++ai)
#pragma unroll
                for (int m = 0; m < 4; ++m) { bf16* rowp = base + (size_t)(row0 + ai * 128 + m * 16) * 1024;
#pragma unroll
                    for (int bj = 0; bj < 2; ++bj) { const f32x4 a0 = acc[ai][bj][m][0], a1 = acc[ai][bj][m][1];
                        u32x4 w; w.x = pkbf(sigm(a0[0]), sigm(a0[1])); w.y = pkbf(sigm(a0[2]), sigm(a0[3])); w.z = pkbf(sigm(a1[0]), sigm(a1[1])); w.w = pkbf(sigm(a1[2]), sigm(a1[3]));
                        *(u32x4*)(rowp + bj * 128) = w; } }
        }
    }
};
template <int STEP> struct EpiGate {
    unsigned char* ws;
    __device__ __forceinline__ void operator()(const f32x4 (&acc)[2][2][4][2], const Unit& u, int wr, int wc, int fr, int fq) const {
        const int row0 = u.pm * 256 + wr * 64 + fr, colt = u.pn * 256 + wc * 32 + 8 * fq;
        const bf16* sg = (const bf16*)(ws + (STEP == 0 ? WS_VG : WS_QKMC)) + colt; bf16* ty = (bf16*)(ws + WS_VM) + colt;
#pragma unroll
        for (int ai = 0; ai < 2; ++ai)
#pragma unroll
            for (int m = 0; m < 4; ++m) { const size_t ro = (size_t)(row0 + ai * 128 + m * 16) * 1024;
#pragma unroll
                for (int bj = 0; bj < 2; ++bj) { const f32x4 a0 = acc[ai][bj][m][0], a1 = acc[ai][bj][m][1];
                    const u32x4 s = *(const u32x4*)(sg + ro + bj * 128);
                    float r[8] = {bflo(s.x) * a0[0], bfhi(s.x) * a0[1], bflo(s.y) * a0[2], bfhi(s.y) * a0[3], bflo(s.z) * a1[0], bfhi(s.z) * a1[1], bflo(s.w) * a1[2], bfhi(s.w) * a1[3]};
                    if (STEP == 1) { const u32x4 t = *(const u32x4*)(ty + ro + bj * 128);
                        r[0] += bflo(t.x); r[1] += bfhi(t.x); r[2] += bflo(t.y); r[3] += bfhi(t.y); r[4] += bflo(t.z); r[5] += bfhi(t.z); r[6] += bflo(t.w); r[7] += bfhi(t.w); }
                    u32x4 w; w.x = cvt_pk_bf16(r[0], r[1]); w.y = cvt_pk_bf16(r[2], r[3]); w.z = cvt_pk_bf16(r[4], r[5]); w.w = cvt_pk_bf16(r[6], r[7]);
                    *(u32x4*)(ty + ro + bj * 128) = w; } }
    }
};
struct EpiOut {
    const float* x; float* out; const float* modv;
    __device__ __forceinline__ void operator()(const f32x4 (&acc)[2][2][4][2], const Unit& u, int wr, int wc, int fr, int fq) const {
        const int row0 = u.pm * 256 + wr * 64 + fr, colt = u.pn * 256 + wc * 32 + 8 * fq;
        const float* gt = modv + ((u.pm * 256) >> 13) * 6144 + 2048 + colt;
#pragma unroll
        for (int bj = 0; bj < 2; ++bj) { const f32x4 g0 = *(const f32x4*)(gt + bj * 128), g1 = *(const f32x4*)(gt + bj * 128 + 4);
#pragma unroll
            for (int ai = 0; ai < 2; ++ai)
#pragma unroll
                for (int m = 0; m < 4; ++m) { const size_t off = (size_t)(row0 + ai * 128 + m * 16) * 1024 + colt + bj * 128;
                    *(f32x4*)(out + off) = *(const f32x4*)(x + off) + g0 * acc[ai][bj][m][0]; *(f32x4*)(out + off + 4) = *(const f32x4*)(x + off + 4) + g1 * acc[ai][bj][m][1]; } }
    }
};

__device__ __forceinline__ void p9_route(Frame& F) {
    const float* modv = wsp<float>(F, WS_MODV);
    constexpr int WP = 1032;
    LAS unsigned short* Wt = (LAS unsigned short*)F.lds;
    LAS float* lgs = (LAS float*)(F.lds + 40 * WP * 2) + F.wave * 512;
    LAS int* hist = (LAS int*)(F.lds + 40 * WP * 2 + 16384);
    if (F.tid < 32) hist[F.tid] = 0;
    for (int k = F.tid; k < 1024; k += NTHR) {
        const f32x4 wg = *(const f32x4*)(F.w_grp + (size_t)k * 4), w0 = *(const f32x4*)(F.w_rexp + (size_t)k * 16), w1 = *(const f32x4*)(F.w_rexp + (size_t)k * 16 + 4), w2 = *(const f32x4*)(F.w_rexp + (size_t)k * 16 + 8), w3 = *(const f32x4*)(F.w_rexp + (size_t)k * 16 + 12);
        const float wv[20] = {wg[0], wg[1], wg[2], wg[3], w0[0], w0[1], w0[2], w0[3], w1[0], w1[1], w1[2], w1[3], w2[0], w2[1], w2[2], w2[3], w3[0], w3[1], w3[2], w3[3]};
#pragma unroll
        for (int n = 0; n < 20; ++n) { const unsigned hi = pkbf(wv[n], 0.f) & 0xffffu; Wt[n * WP + k] = (unsigned short)hi; Wt[(20 + n) * WP + k] = (unsigned short)(pkbf(wv[n] - bflo(hi), 0.f) & 0xffffu); } }
    __syncthreads();
    int* rexp = (int*)(F.ws + WS_ROUTE + RT_EXP); float* rw = (float*)(F.ws + WS_ROUTE + RT_W); int* rpos = (int*)(F.ws + WS_ROUTE + RT_POS);
    const int gw = F.bid * NW + F.wave, NGW = F.G * NW, li = F.lane & 15, lg = F.lane >> 4;
    const int n1 = 16 + li < 20 ? 16 + li : 19;
    for (int t = gw; t < M_LAT / 16; t += NGW) {
        const int m = 16 * t + li; const float* src = F.out + (size_t)m * D + 8 * lg; const float* mv = modv + (m >> 13) * 6144 + 8 * lg;
        float ss = 0.f;
#pragma unroll 8
        for (int ks = 0; ks < 32; ++ks) { const f32x4 a = *(const f32x4*)(src + 32 * ks), c = *(const f32x4*)(src + 32 * ks + 4); ss += (a.x * a.x + a.y * a.y) + (a.z * a.z + a.w * a.w) + (c.x * c.x + c.y * c.y) + (c.z * c.z + c.w * c.w); }
        ss += __shfl_xor(ss, 16); ss += __shfl_xor(ss, 32);
        const float rstd = 1.f / sqrtf(ss * (1.f / D) + EPS);
        f32x4 acc0 = {0.f, 0.f, 0.f, 0.f}, acc1 = acc0;
        bf16* o = wsp<bf16>(F, WS_H2) + (size_t)m * D + 8 * lg;
#pragma unroll 4
        for (int ks = 0; ks < 32; ++ks) { const int c = 32 * ks;
            const f32x4 xa = *(const f32x4*)(src + c), xb = *(const f32x4*)(src + c + 4);
            const f32x4 ga = *(const f32x4*)(F.g_norm2 + 8 * lg + c), gb = *(const f32x4*)(F.g_norm2 + 8 * lg + c + 4);
            const f32x4 sha = *(const f32x4*)(mv + 3072 + c), shb = *(const f32x4*)(mv + 3072 + c + 4), sca = *(const f32x4*)(mv + 4096 + c), scb = *(const f32x4*)(mv + 4096 + c + 4);
            const f32x4 ha = (xa * rstd) * ga * (sca + 1.f) + sha, hb = (xb * rstd) * gb * (scb + 1.f) + shb;
            u32x4 hi; hi.x = pkbf(ha[0], ha[1]); hi.y = pkbf(ha[2], ha[3]); hi.z = pkbf(hb[0], hb[1]); hi.w = pkbf(hb[2], hb[3]);
            u32x4 lo; lo.x = pkbf(ha[0] - bflo(hi.x), ha[1] - bfhi(hi.x)); lo.y = pkbf(ha[2] - bflo(hi.y), ha[3] - bfhi(hi.y)); lo.z = pkbf(hb[0] - bflo(hi.z), hb[1] - bfhi(hi.z)); lo.w = pkbf(hb[2] - bflo(hi.w), hb[3] - bfhi(hi.w));
            *(u32x4*)(o + c) = hi;
            const bf16x8 Ah = __builtin_bit_cast(bf16x8, hi), Al = __builtin_bit_cast(bf16x8, lo);
            const bf16x8 bh0 = *(const LAS bf16x8*)(Wt + li * WP + c + 8 * lg), bh1 = *(const LAS bf16x8*)(Wt + n1 * WP + c + 8 * lg), bl0 = *(const LAS bf16x8*)(Wt + (20 + li) * WP + c + 8 * lg), bl1 = *(const LAS bf16x8*)(Wt + (20 + n1) * WP + c + 8 * lg);
            acc0 = __builtin_amdgcn_mfma_f32_16x16x32_bf16(Ah, bh0, acc0, 0, 0, 0); acc1 = __builtin_amdgcn_mfma_f32_16x16x32_bf16(Ah, bh1, acc1, 0, 0, 0);
            acc0 = __builtin_amdgcn_mfma_f32_16x16x32_bf16(Al, bh0, acc0, 0, 0, 0); acc1 = __builtin_amdgcn_mfma_f32_16x16x32_bf16(Al, bh1, acc1, 0, 0, 0);
            acc0 = __builtin_amdgcn_mfma_f32_16x16x32_bf16(Ah, bl0, acc0, 0, 0, 0); acc1 = __builtin_amdgcn_mfma_f32_16x16x32_bf16(Ah, bl1, acc1, 0, 0, 0); }
#pragma unroll
        for (int r = 0; r < 4; ++r) { lgs[(4 * lg + r) * 32 + li] = acc0[r]; lgs[(4 * lg + r) * 32 + 16 + li] = acc1[r]; }
        LDS_WAIT(); asm volatile("" ::: "memory");
        if (F.lane < 16) {
            const int mr = 16 * t + F.lane;
            const f32x4 lq0 = *(const LAS f32x4*)(lgs + F.lane * 32), lq1 = *(const LAS f32x4*)(lgs + F.lane * 32 + 4), lq2 = *(const LAS f32x4*)(lgs + F.lane * 32 + 8), lq3 = *(const LAS f32x4*)(lgs + F.lane * 32 + 12), lq4 = *(const LAS f32x4*)(lgs + F.lane * 32 + 16);
            const f32x4 bg = *(const f32x4*)F.b_grp;
            float gl[4] = {lq0[0] + bg[0], lq0[1] + bg[1], lq0[2] + bg[2], lq0[3] + bg[3]};
            int grp = 0; float gmax = gl[0];
#pragma unroll
            for (int q = 1; q < 4; ++q) if (gl[q] > gmax) { gmax = gl[q]; grp = q; }
            float gs = 0.f;
#pragma unroll
            for (int q = 0; q < 4; ++q) gs += expf(gl[q] - gmax);
            const float grp_p = 1.f / gs;
            float el[4];
#pragma unroll
            for (int q = 0; q < 4; ++q) { float v = lq1[q]; v = grp == 1 ? lq2[q] : v; v = grp == 2 ? lq3[q] : v; v = grp == 3 ? lq4[q] : v; asm volatile("" : "+v"(v)); el[q] = v + F.b_rexp[grp * 4 + q]; }
            int i0 = 0; float e0v = el[0];
#pragma unroll
            for (int q = 1; q < 4; ++q) if (el[q] > e0v) { e0v = el[q]; i0 = q; }
            int i1 = -1; float e1v = -3.0e38f;
#pragma unroll
            for (int q = 0; q < 4; ++q) if (q != i0 && el[q] > e1v) { e1v = el[q]; i1 = q; }
            const float e1 = expf(e1v - e0v); const float w0 = grp_p / (1.f + e1), w1 = grp_p * e1 / (1.f + e1);
            const int x0 = grp * 4 + i0, x1 = grp * 4 + i1;
            rexp[2 * mr] = x0; rexp[2 * mr + 1] = x1; rw[2 * mr] = w0; rw[2 * mr + 1] = w1;
            rpos[2 * mr] = __hip_atomic_fetch_add(hist + x0, 1, __ATOMIC_RELAXED, __HIP_MEMORY_SCOPE_WORKGROUP);
            rpos[2 * mr + 1] = __hip_atomic_fetch_add(hist + x1, 1, __ATOMIC_RELAXED, __HIP_MEMORY_SCOPE_WORKGROUP);
        }
        LDS_WAIT(); asm volatile("" ::: "memory");
    }
    __syncthreads();
    if (F.tid < 16) hist[16 + F.tid] = (int)__hip_atomic_fetch_add((unsigned*)(F.ws + WS_CTL) + CW_CNT + 64 * F.tid, (unsigned)hist[F.tid], __ATOMIC_RELAXED, __HIP_MEMORY_SCOPE_AGENT);
    __syncthreads();
    VM_WAIT();
    for (int t = gw; t < M_LAT / 16; t += NGW) if (F.lane < 32) { const int a = 32 * t + F.lane, e = rexp[a], pos = rpos[a] + hist[16 + e]; rpos[a] = pos;
        wsp<int>(F, WS_LTOK)[e * LCAP + pos] = a >> 1; wsp<float>(F, WS_LW)[e * LCAP + pos] = rw[a]; }
    __syncthreads();
    moe_weight_copies(F);
}
__device__ __forceinline__ void moe_layout(Frame& F) {
    LAS int* tab = (LAS int*)(F.lds + LDS_TAB);
    if (F.tid == 0) { int a = 0; for (int e = 0; e < 16; ++e) { const int c = (int)__hip_atomic_load((unsigned*)(F.ws + WS_CTL) + CW_CNT + 64 * e, __ATOMIC_RELAXED, __HIP_MEMORY_SCOPE_AGENT); tab[e] = a; tab[32 + e] = c; a += (c + 255) & ~255; } tab[16] = a; tab[17] = a >> 8; }
    __syncthreads();
}
struct EpiUp {
    unsigned char* ws;
    __device__ __forceinline__ void operator()(const f32x4 (&acc)[2][2][4][2], const Unit& u, int wr, int wc, int fr, int fq) const {
        const int row0 = u.pm * 256 + wr * 64 + fr; bf16* base = (bf16*)(ws + WS_HID) + u.pn * 128 + wc * 32 + 8 * fq;
#pragma unroll
        for (int ai = 0; ai < 2; ++ai)
#pragma unroll
            for (int m = 0; m < 4; ++m) { const f32x4 g0 = acc[ai][0][m][0], g1 = acc[ai][0][m][1], u0 = acc[ai][1][m][0], u1 = acc[ai][1][m][1];
                u32x4 w; w.x = cvt_pk_bf16(siluf(g0[0]) * u0[0], siluf(g0[1]) * u0[1]); w.y = cvt_pk_bf16(siluf(g0[2]) * u0[2], siluf(g0[3]) * u0[3]);
                w.z = cvt_pk_bf16(siluf(g1[0]) * u1[0], siluf(g1[1]) * u1[1]); w.w = cvt_pk_bf16(siluf(g1[2]) * u1[2], siluf(g1[3]) * u1[3]);
                *(u32x4*)(base + (size_t)(row0 + ai * 128 + m * 16) * 512) = w; }
    }
};
struct EpiDown {
    unsigned char* ws; const LAS int* tab;
    __device__ __forceinline__ void operator()(const f32x4 (&acc)[2][2][4][2], const Unit& u, int wr, int wc, int fr, int fq) const {
        const int row0 = u.pm * 256 + wr * 64 + fr; bf16* base = (bf16*)(ws + WS_YROWS) + u.pn * 256 + wc * 32 + 8 * fq;
        const float* lw = (const float*)(ws + WS_LW) + u.e * LCAP - tab[u.e];
#pragma unroll
        for (int ai = 0; ai < 2; ++ai)
#pragma unroll
            for (int m = 0; m < 4; ++m) { const int row = row0 + ai * 128 + m * 16; const float rwt = lw[row];
#pragma unroll
                for (int bj = 0; bj < 2; ++bj) { const f32x4 v0 = acc[ai][bj][m][0] * rwt, v1 = acc[ai][bj][m][1] * rwt;
                    u32x4 w; w.x = cvt_pk_bf16(v0[0], v0[1]); w.y = cvt_pk_bf16(v0[2], v0[3]); w.z = cvt_pk_bf16(v1[0], v1[1]); w.w = cvt_pk_bf16(v1[2], v1[3]);
                    *(u32x4*)(base + (size_t)row * 1024 + bj * 128) = w; } }
    }
};
__device__ __forceinline__ void p13_final(Frame& F) {
    moe_layout(F);
    const LAS int* tab = (const LAS int*)(F.lds + LDS_TAB);
    const float* modv = wsp<float>(F, WS_MODV); const int* rpos = (const int*)(F.ws + WS_ROUTE + RT_POS); const int* rexp = (const int*)(F.ws + WS_ROUTE + RT_EXP); const bf16* Y = wsp<bf16>(F, WS_YROWS);
    const int gw = F.bid * NW + F.wave, NGW = F.G * NW;
    for (int m = gw; m < M_LAT; m += NGW) {
        float* row = F.out + (size_t)m * D; const float* gt = modv + (m >> 13) * 6144 + 5120;
        const bf16* y0 = Y + (size_t)(tab[rexp[2 * m]] + rpos[2 * m]) * 1024; const bf16* y1 = Y + (size_t)(tab[rexp[2 * m + 1]] + rpos[2 * m + 1]) * 1024;
        f32x4 v[4]; float s = 0.f;
#pragma unroll
        for (int j = 0; j < 4; ++j) { const int c = 4 * F.lane + 256 * j; const u32x2 a = *(const u32x2*)(y0 + c), b = *(const u32x2*)(y1 + c); const f32x4 g = *(const f32x4*)(gt + c);
            f32x4 yy; yy.x = bflo(a.x) + bflo(b.x); yy.y = bfhi(a.x) + bfhi(b.x); yy.z = bflo(a.y) + bflo(b.y); yy.w = bfhi(a.y) + bfhi(b.y);
            v[j] = *(const f32x4*)(row + c) + g * yy; s += (v[j].x * v[j].x + v[j].y * v[j].y) + (v[j].z * v[j].z + v[j].w * v[j].w); }
        const float rstd = 1.f / sqrtf(wave_sum(s) * (1.f / D) + EPS);
#pragma unroll
        for (int j = 0; j < 4; ++j) { const int c = 4 * F.lane + 256 * j; *(f32x4*)(row + c) = (v[j] * rstd) * *(const f32x4*)(F.g_final + c); }
    }
}

typedef const Args __attribute__((address_space(4))) * KArgsP;
__device__ __forceinline__ void load_inputs(Frame& F) {
    KArgsP ap = (KArgsP)__builtin_amdgcn_kernarg_segment_ptr();
    asm volatile("" : "+s"(ap));
    F.x = ap->in[0]; F.c = ap->in[1]; F.ctx = ap->in[2]; F.c_ctx = ap->in[3]; F.w_mod = ap->in[4]; F.b_mod = ap->in[5]; F.g_norm1 = ap->in[6]; F.w_in = ap->in[7];
    F.ml_conv = ap->in[8]; F.ml_conv_b = ap->in[9]; F.b_mgate = ap->in[10]; F.ml_norm = ap->in[11]; F.gla_w2 = ap->in[12]; F.gla_b2 = ap->in[13]; F.gla_norm = ap->in[14];
    F.w_proj_m = ap->in[15]; F.w_proj_g = ap->in[16]; F.w_out = ap->in[17]; F.g_norm2 = ap->in[18]; F.w_grp = ap->in[19]; F.b_grp = ap->in[20]; F.w_rexp = ap->in[21]; F.b_rexp = ap->in[22];
    F.w_up = ap->in[23]; F.w_down = ap->in[24]; F.g_final = ap->in[25];
    F.ws = ap->ws; F.out = ap->out;
    int ln = (int)__builtin_amdgcn_mbcnt_hi(~0u, __builtin_amdgcn_mbcnt_lo(~0u, 0u)); asm volatile("" : "+v"(ln)); F.lane = ln; F.tid = F.wave * 64 + ln;
}
constexpr int N_PHASES = 14;
__global__ void __launch_bounds__(NTHR, 2) mk_fwd(Args args) {
    extern __shared__ __attribute__((aligned(16))) unsigned char lds[];
    Frame F;
    F.lds = (LAS unsigned char*)lds; F.MISC = (volatile LAS unsigned*)(F.lds + MISC_OFF);
    F.tid = threadIdx.x; F.lane = F.tid & 63; F.wave = __builtin_amdgcn_readfirstlane(F.tid >> 6); F.G = gridDim.x; F.bid = blockIdx.x;
    F.ws = args.ws; F.out = args.out;
    for (int u = F.tid; u < (LDS_BYTES - LDSCTL_OFF) / 4; u += NTHR) ((LAS unsigned*)(F.lds + LDSCTL_OFF))[u] = 0u;
    __syncthreads();
    const int lo = args.ph_lo, hi = args.ph_hi;
    XcdBarrier bar; bar.bar = (unsigned*)(F.ws + WS_CTL) + CW_BAR; bar.x = 0; bar.st = nullptr;
    if (hi - lo > 1) bar = xcd_barrier_post((unsigned*)(F.ws + WS_CTL) + CW_BAR, F.MISC + 8);
#ifndef PH_MASK
#define PH_MASK 0xFFFF
#endif
#define IN(k) (((PH_MASK >> (k)) & 1) && lo <= (k) && (k) < hi)
#define REPS(k) for (int rep_ = 0; rep_ < (((REP_MASK >> (k)) & 1) ? 2 : 1); ++rep_)
#define SEAM(k) do { if (IN(k) && IN((k) + 1)) xcd_barrier(bar, F.tid); } while (0)
    const int vc = (int)blockIdx.x;
    if (IN(0)) REPS(0) { load_inputs(F); p0_prologue(F); SEAM(0); }
    if (IN(1)) REPS(1) { load_inputs(F); p1_hx(F); p0_weight_copies(F); SEAM(1); }
    if (IN(2)) REPS(2) { load_inputs(F); pg8::DenseSched S; S.init(wsp<bf16>(F, WS_HX), wsp<bf16>(F, WS_WA), MT, NA, D, F.G, vc); EpiProjA E{F.ws, F.b_mgate};
        pg8::gemm_phase<EpiProjA, pg8::DenseSched, true>(F.lds, S, E, F.wave); SEAM(2); }
    if (IN(3)) REPS(3) { load_inputs(F); p3_prep(F); SEAM(3); }
#if SCAN_SCALAR
    if (IN(4)) REPS(4) { load_inputs(F); p4_scan_local(F); SEAM(4); }
    if (IN(5)) REPS(5) { load_inputs(F); p5_scan_out(F); SEAM(5); }
#else
    if (IN(4)) REPS(4) { load_inputs(F); p4m_scan_local(F); SEAM(4); }
    if (IN(5)) REPS(5) { load_inputs(F); p5m_scan_out(F); SEAM(5); }
#endif
    if (IN(6)) REPS(6) { load_inputs(F); pg8::DenseSched S; S.init(wsp<bf16>(F, WS_HX), wsp<bf16>(F, WS_WB), M_LAT, NB, D, F.G, vc); EpiProjB E{F.ws, F.ml_norm, F.gla_norm};
        pg8::gemm_phase<EpiProjB, pg8::DenseSched, true>(F.lds, S, E, F.wave); SEAM(6); }
    if (IN(7)) REPS(7) { load_inputs(F);
        { pg8::DenseSched S; S.init(wsp<bf16>(F, WS_QKM), wsp<bf16>(F, WS_WPM), M_LAT, D, D, F.G, vc); EpiGate<0> E{F.ws}; pg8::gemm_phase<EpiGate<0>, pg8::DenseSched, false>(F.lds, S, E, F.wave); }
        VM_WAIT(); __syncthreads();
        { pg8::DenseSched S; S.init(wsp<bf16>(F, WS_QKG), wsp<bf16>(F, WS_WPG), M_LAT, D, D, F.G, vc); EpiGate<1> E{F.ws}; pg8::gemm_phase<EpiGate<1>, pg8::DenseSched, false>(F.lds, S, E, F.wave); }
        SEAM(7); }
    if (IN(8)) REPS(8) { load_inputs(F); pg8::DenseSched S; S.init(wsp<bf16>(F, WS_VM), wsp<bf16>(F, WS_WOUT), M_LAT, D, D, F.G, vc); EpiOut E{F.x, F.out, wsp<float>(F, WS_MODV)};
        pg8::gemm_phase<EpiOut, pg8::DenseSched, false>(F.lds, S, E, F.wave); SEAM(8); }
    if (IN(9)) REPS(9) { load_inputs(F); p9_route(F); if (IN(9) && IN(11)) xcd_barrier(bar, F.tid); }
    if (IN(11)) REPS(11) { load_inputs(F); moe_layout(F); pg8::GroupSched<true> S; S.A = wsp<bf16>(F, WS_H2); S.Bt = wsp<bf16>(F, WS_WUP); S.list_tok = wsp<int>(F, WS_LTOK); S.tab = (const LAS int*)(F.lds + LDS_TAB);
        S.K = 1024; S.ntiles = S.tab[17]; S.G = F.G; S.c = vc; EpiUp E{F.ws};
        pg8::gemm_phase<EpiUp, pg8::GroupSched<true>, true>(F.lds, S, E, F.wave); SEAM(11); }
    if (IN(12)) REPS(12) { load_inputs(F); moe_layout(F); pg8::GroupSched<false> S; S.A = wsp<bf16>(F, WS_HID); S.Bt = wsp<bf16>(F, WS_WDN); S.list_tok = nullptr; S.tab = (const LAS int*)(F.lds + LDS_TAB);
        S.K = 512; S.ntiles = S.tab[17]; S.G = F.G; S.c = vc; EpiDown E{F.ws, (const LAS int*)(F.lds + LDS_TAB)};
        pg8::gemm_phase<EpiDown, pg8::GroupSched<false>, true>(F.lds, S, E, F.wave); SEAM(12); }
    if (IN(13)) REPS(13) { load_inputs(F); p13_final(F); }
#undef IN
#undef SEAM
}

extern "C" void kernel_launch(void* const* d_in, const int* in_sizes, int n_in, void* d_out, int out_size, void* d_ws, size_t ws_size, hipStream_t stream) {
    static int grid = 0;
    if (grid == 0) {
        if (n_in != 26 || out_size != M_LAT * D || ws_size < WS_END) { fprintf(stderr, "kernel_launch: unexpected shapes (n_in %d, out %d, ws %zu)\n", n_in, out_size, ws_size); grid = -1; return; }
        int dev = 0, cus = 0, per_cu = 0;
        if (hipGetDevice(&dev) != hipSuccess || hipDeviceGetAttribute(&cus, hipDeviceAttributeMultiprocessorCount, dev) != hipSuccess) { grid = -1; return; }
        if (hipFuncSetAttribute((const void*)mk_fwd, hipFuncAttributeMaxDynamicSharedMemorySize, LDS_BYTES) != hipSuccess) { fprintf(stderr, "kernel_launch: hipFuncSetAttribute failed\n"); grid = -1; return; }
        if (hipOccupancyMaxActiveBlocksPerMultiprocessor(&per_cu, (const void*)mk_fwd, NTHR, LDS_BYTES) != hipSuccess || per_cu < 1) fprintf(stderr, "kernel_launch: occupancy query reports %d\n", per_cu);
        (void)hipGetLastError();
        grid = cus;
    }
    if (grid < 0) return;
    (void)hipMemsetAsync((char*)d_ws + WS_CTL, 0, CTL_ZERO_BYTES, stream);
    Args a{};
    for (int i = 0; i < 26; ++i) a.in[i] = (const float*)d_in[i];
    a.out = (float*)d_out; a.ws = (unsigned char*)d_ws;
#if MK_ONE_LAUNCH
    a.ph_lo = 0; a.ph_hi = N_PHASES;
    hipLaunchKernelGGL(mk_fwd, dim3(grid), dim3(NTHR), LDS_BYTES, stream, a);
#else
    for (int p = 0; p < N_PHASES; ++p) { a.ph_lo = p; a.ph_hi = p + 1; hipLaunchKernelGGL(mk_fwd, dim3(grid), dim3(NTHR), LDS_BYTES, stream, a); }
#endif
}
```

```cpp
#include <hip/hip_runtime.h>
#include <cstdio>
#include <cstdint>

#ifndef SCAN_SCALAR
#define SCAN_SCALAR 0
#endif
#ifndef REP_MASK
#define REP_MASK 0x0
#endif
#ifndef MK_ONE_LAUNCH
#define MK_ONE_LAUNCH 1
#endif

#define LAS __attribute__((address_space(3)))
typedef unsigned short bf16;
typedef short bf16x8 __attribute__((ext_vector_type(8)));
typedef float f32x4 __attribute__((ext_vector_type(4)));
typedef float f32x2 __attribute__((ext_vector_type(2)));
typedef unsigned u32x4 __attribute__((ext_vector_type(4)));
typedef unsigned u32x2 __attribute__((ext_vector_type(2)));

constexpr int D = 1024, BATCH = 2, SEQ = 8192, CTXL = 256;
constexpr int M_LAT = BATCH * SEQ;
constexpr int M_CTX = BATCH * CTXL;
constexpr int MT = M_LAT + M_CTX;
constexpr int NW = 8, NTHR = 512;
constexpr int IN_W = 8240;
constexpr int NA = 4352;
constexpr int NB = 4096;
constexpr int CHUNK = 64, NCH_LAT = SEQ / CHUNK  , NCH_CTX = CTXL / CHUNK  ;
constexpr int NCHUNK = BATCH * NCH_LAT + BATCH * NCH_CTX;
constexpr int NSEG = 8, CPS = NCH_LAT / NSEG;
constexpr int NEXP = 16, DEXP = 512, NROWS_MAX = 36864  ;
constexpr float EPS = 1e-6f;

constexpr size_t MiB = 1u << 20;
constexpr size_t BIG = (size_t)MT * 1024 * 2;
constexpr size_t WS_CTL = 0, CTL_ZERO_BYTES = 1 * MiB;
constexpr size_t WS_MODV = 1 * MiB;
constexpr size_t WS_AB = 2 * MiB;
constexpr size_t WS_GENDM = WS_AB + 1088 * 1024;
constexpr size_t WS_GENDG = 4 * MiB;
constexpr size_t WS_SSQ = WS_GENDG + 1088 * 1024;
constexpr size_t WS_WA = 7 * MiB;
constexpr size_t WS_WB = 16 * MiB;
constexpr size_t WS_WPM = 24 * MiB, WS_WPG = 26 * MiB, WS_WOUT = 28 * MiB;
constexpr size_t WS_GATES = 30 * MiB;
constexpr size_t WS_NST = 35 * MiB;
constexpr size_t WS_GSEG = WS_NST + 256 * 1024;
constexpr size_t WS_ROUTE = 36 * MiB;
constexpr size_t WS_HX = 37 * MiB;
constexpr size_t WS_QKM = WS_HX + BIG;
constexpr size_t WS_VM = WS_QKM + BIG;
constexpr size_t WS_QKG = WS_VM + BIG;
constexpr size_t WS_VG = WS_QKG + BIG;
constexpr size_t WS_QKMC = WS_VG + BIG;
constexpr size_t WS_STATE = WS_QKMC + BIG;
constexpr size_t WS_QKGTC = WS_STATE + 16 * MiB;
constexpr size_t WS_END = WS_QKGTC + 2 * MiB;
static_assert(WS_END <= 256 * MiB, "ws map");
constexpr size_t WS_WUP = WS_HX;
constexpr size_t WS_H2 = 70 * MiB;
constexpr size_t WS_WDN = 103 * MiB;
constexpr size_t WS_HID = 136 * MiB;
constexpr size_t WS_YROWS = 172 * MiB;
constexpr size_t RT_EXP = 0;
constexpr size_t RT_W = 128 * 1024;
constexpr size_t RT_POS = 256 * 1024;
constexpr size_t RT_ROWTOK = 384 * 1024;
constexpr size_t RT_ROWW = 384 * 1024 + 144 * 1024;
constexpr size_t RT_TILE_E = 384 * 1024 + 288 * 1024;
constexpr size_t WS_LTOK = 120 * MiB, WS_LW = 122 * MiB;
constexpr int LCAP = 32768;
constexpr int LDS_TAB = 147456 - 1024 + 768;
constexpr int CW_BAR = 4096;
constexpr int CW_CNT = 8192;

#define LDS_WAIT() asm volatile("s_waitcnt lgkmcnt(0)" ::: "memory")
#define VM_WAIT() asm volatile("s_waitcnt vmcnt(0)" ::: "memory")
__device__ __forceinline__ unsigned f2bf(float f) { unsigned u = __builtin_bit_cast(unsigned, f); return (u + 0x7fffu + ((u >> 16) & 1u)) >> 16; }
typedef __bf16 bf16x2_t __attribute__((ext_vector_type(2)));
__device__ __forceinline__ unsigned pkbf(float lo, float hi) { f32x2 v = {lo, hi}; return __builtin_bit_cast(unsigned, __builtin_convertvector(v, bf16x2_t)); }
__device__ __forceinline__ unsigned pk2(float lo, float hi) { return pkbf(lo, hi); }
__device__ __forceinline__ float bf2f(unsigned short h) { return __builtin_bit_cast(float, (unsigned)h << 16); }
__device__ __forceinline__ float bflo(unsigned w) { return __builtin_bit_cast(float, w << 16); }
__device__ __forceinline__ float bfhi(unsigned w) { return __builtin_bit_cast(float, w & 0xffff0000u); }
__device__ __forceinline__ float sigm(float x) { return __builtin_amdgcn_rcpf(1.f + __expf(-x)); }
__device__ __forceinline__ float siluf(float x) { return x * __builtin_amdgcn_rcpf(1.f + __expf(-x)); }
__device__ __forceinline__ float logsig(float x) { return fminf(x, 0.f) - log1pf(expf(-fabsf(x))); }
__device__ __forceinline__ float wave_sum(float v) {
#pragma unroll
    for (int o = 1; o < 64; o <<= 1) v += __shfl_xor(v, o);
    return v;
}

namespace pg8 {
#define PG8_LAS __attribute__((address_space(3)))
constexpr int BM = 256, BK = 64, HALF = 128, HTB = HALF * BK * 2, STAGE_BYTES = 8 * HTB, NXCD = 8, WGM = 8;
__host__ __device__ __forceinline__ int lds_byte(int r, int c) { const int st = (r >> 4) * 2 + (c >> 5), rr = r & 15, cc = c & 31, ob = rr * 64 + cc * 2; return st * 1024 + (ob ^ (((ob >> 9) & 1) << 5)); }
__host__ __device__ __forceinline__ void stage_rc(int b, int& R, int& C) { const int st = b / 1024, sb = b % 1024, swz = sb ^ (((sb >> 9) & 1) << 5); R = (st >> 1) * 16 + swz / 64; C = (st & 1) * 32 + (swz % 64) / 2; }
__host__ __device__ __forceinline__ int perm32(int rho) { const int n = rho >> 4, i = rho & 15; return 8 * (i >> 2) + 4 * n + (i & 3); }
struct Unit { int pm, pn, e; };
__device__ __forceinline__ unsigned cvt_pk_bf16(float lo, float hi) { return pkbf(lo, hi); }

struct DenseSched {
    static constexpr bool GATHER = false;
    const bf16* A; const bf16* Bt; int K, nM, nN, nwg, G, c;
    __device__ void init(const bf16* A_, const bf16* Bt_, int M, int N, int K_, int G_, int c_) { A = A_; Bt = Bt_; K = K_; nM = M / BM; nN = N / BM; nwg = nM * nN; G = G_; c = c_; }
    __device__ bool next(int i, Unit& u) const {
        const long L = (long)i * G + c; if (L >= nwg) return false;
        int wgid = (int)L; { const int q = nwg / NXCD, r = nwg % NXCD, xcd = wgid % NXCD, off = wgid / NXCD; wgid = (xcd < r ? xcd * (q + 1) : r * (q + 1) + (xcd - r) * q) + off; }
        const int nig = WGM * nN, gid = wgid / nig, fm = gid * WGM, gsz = (nM - fm) < WGM ? (nM - fm) : WGM;
        u.pm = fm + ((wgid % nig) % gsz); u.pn = (wgid % nig) / gsz; u.e = 0; return true;
    }
    __device__ __forceinline__ const char* a_base(const Unit& u) const { return (const char*)A + (size_t)u.pm * BM * K * 2; }
    __device__ __forceinline__ const char* b_base(const Unit& u) const { return (const char*)Bt + (size_t)u.pn * BM * K * 2; }
    __device__ __forceinline__ void a_offs(const Unit&, const int (&R)[2], const int (&C)[2], unsigned (&o)[2][2]) const {
#pragma unroll
        for (int h = 0; h < 2; ++h)
#pragma unroll
            for (int i = 0; i < 2; ++i) o[h][i] = (unsigned)((h * HALF + R[i]) * K + C[i]) * 2u;
    }
};
template <bool GATHER_> struct GroupSched {
    static constexpr bool GATHER = GATHER_;
    const bf16* A; const bf16* Bt; const int* list_tok; const PG8_LAS int* tab; int K, ntiles, G, c;
    __device__ bool next(int i, Unit& u) const {
        long L = (long)i * G + c;
        if (G == 256 && (long)(i + 1) * 256 <= (long)ntiles * 4) { const int xc = c & 7, j = c >> 3; L = (long)i * 256 + (long)(((xc << 3) | (j >> 2)) << 2) + (j & 3); }
        if (L >= (long)ntiles * 4) return false;
        u.pm = (int)(L >> 2); u.pn = (int)(L & 3); int e = 0; while (e < 15 && u.pm * BM >= tab[e + 1]) ++e; u.e = e; return true;
    }
    __device__ __forceinline__ const char* a_base(const Unit& u) const { return GATHER ? (const char*)A : (const char*)A + (size_t)u.pm * BM * K * 2; }
    __device__ __forceinline__ const char* b_base(const Unit& u) const { return (const char*)Bt + ((size_t)u.e * 1024 + (size_t)u.pn * BM) * K * 2; }
    __device__ __forceinline__ void a_offs(const Unit& u, const int (&R)[2], const int (&C)[2], unsigned (&o)[2][2]) const {
        const int pos0 = u.pm * BM - tab[u.e], cnt = tab[32 + u.e];
#pragma unroll
        for (int h = 0; h < 2; ++h)
#pragma unroll
            for (int i = 0; i < 2; ++i) {
                int row = h * HALF + R[i];
                if (GATHER) { const int pos = pos0 + row; const int pc = pos < cnt ? pos : 0; const int tk = list_tok[u.e * 32768 + pc]; row = pos < cnt ? tk : 0; }
                o[h][i] = (unsigned)(row * K + C[i]) * 2u; }
    }
};

template <class Epi, class Sched, bool ALIGN_EPI>
__device__ __forceinline__ void gemm_phase(PG8_LAS unsigned char* lds, const Sched& S, const Epi& E, const int wave_id) {
    int ln_ = (int)__builtin_amdgcn_mbcnt_hi(~0u, __builtin_amdgcn_mbcnt_lo(~0u, 0u)); asm volatile("" : "+v"(ln_));
    const int wid = wave_id, lane = ln_, tid = wid * 64 + lane, wr = wid >> 2, wc = wid & 3, fr = lane & 15, fq = lane >> 4;
    const int K = S.K, nt = K / BK;
    int Rr[2], Cc[2]; unsigned voffB[2];
#pragma unroll
    for (int i = 0; i < 2; ++i) { stage_rc(tid * 16 + i * 8192, Rr[i], Cc[i]); const int Rb = (Rr[i] & ~31) + perm32(Rr[i] & 31); voffB[i] = (unsigned)(Rb * K + Cc[i]) * 2u; }
    const size_t kstep = (size_t)(BK * 2);
    const size_t hstep = (size_t)HALF * K * 2;
    const unsigned ldsw = (unsigned)wid * 1024u;
    const int aoff = lds_byte(wr * 64 + fr, fq * 8), boff = lds_byte(wc * 32 + fr, fq * 8);
#define PG8_SA(b, h) (((b) * 2 + (h)) * HTB)
#define PG8_SB(b, h) ((4 + (b) * 2 + (h)) * HTB)
#define PG8_STAGE(bufoff, gbase, voff) do { _Pragma("unroll") for (int _i = 0; _i < 2; ++_i) \
        __builtin_amdgcn_global_load_lds((const unsigned*)((const char*)(gbase) + (voff)[_i]), (PG8_LAS unsigned*)(lds + (bufoff) + ldsw + _i * 8192), 16, 0, 0); } while (0)
#define PG8_LDA(dst, b, h) do { _Pragma("unroll") for (int m = 0; m < 4; ++m) _Pragma("unroll") for (int k = 0; k < 2; ++k) dst[m][k] = *(const PG8_LAS bf16x8*)(lds + PG8_SA(b, h) + aoff + m * 2048 + k * 1024); } while (0)
#define PG8_LDB(dst, b, h) do { _Pragma("unroll") for (int n = 0; n < 2; ++n) _Pragma("unroll") for (int k = 0; k < 2; ++k) dst[n][k] = *(const PG8_LAS bf16x8*)(lds + PG8_SB(b, h) + boff + n * 2048 + k * 1024); } while (0)
#define PG8_MMA(ai, bj, At, Bt) do { __builtin_amdgcn_s_setprio(1); _Pragma("unroll") for (int m = 0; m < 4; ++m) _Pragma("unroll") for (int n = 0; n < 2; ++n) _Pragma("unroll") for (int k = 0; k < 2; ++k) \
        acc[ai][bj][m][n] = __builtin_amdgcn_mfma_f32_16x16x32_bf16(Bt[n][k], At[m][k], acc[ai][bj][m][n], 0, 0, 0); __builtin_amdgcn_s_setprio(0); } while (0)
#define PG8_WAIT_V(n) asm volatile("s_waitcnt vmcnt(" #n ")" ::: "memory")
#define PG8_WAIT_L(n) asm volatile("s_waitcnt lgkmcnt(" #n ")" ::: "memory")
#define PG8_BAR __builtin_amdgcn_s_barrier()
#define PG8_SCHED __builtin_amdgcn_sched_barrier(0)
    Unit cur, nxt; int ui = 0;
    if (!S.next(0, cur)) return;
    unsigned ao[2][2], nao[2][2];
    S.a_offs(cur, Rr, Cc, ao);
    f32x4 acc[2][2][4][2];
#pragma unroll
    for (int a = 0; a < 2; ++a)
#pragma unroll
        for (int b = 0; b < 2; ++b)
#pragma unroll
            for (int m = 0; m < 4; ++m)
#pragma unroll
                for (int n = 0; n < 2; ++n) acc[a][b][m][n] = (f32x4){0.f, 0.f, 0.f, 0.f};
    bf16x8 At[4][2], B0[2][2], B1[2][2];
    const char* cA = S.a_base(cur); const char* cB = S.b_base(cur);
    PG8_STAGE(PG8_SB(0, 0), cB, voffB); PG8_STAGE(PG8_SB(0, 1), cB + hstep, voffB); PG8_STAGE(PG8_SA(0, 0), cA, ao[0]); PG8_STAGE(PG8_SA(0, 1), cA, ao[1]);
    if (wr == 1) PG8_BAR;
    PG8_WAIT_V(2); PG8_BAR;
    PG8_STAGE(PG8_SB(1, 0), cB + kstep, voffB); PG8_STAGE(PG8_SA(1, 0), cA + kstep, ao[0]); PG8_STAGE(PG8_SB(1, 1), cB + hstep + kstep, voffB);
    PG8_WAIT_V(6); PG8_BAR;
    for (;;) {
        const bool has_next = S.next(ui + 1, nxt);
        if (Sched::GATHER && has_next) S.a_offs(nxt, Rr, Cc, nao);
        else {
#pragma unroll
            for (int h = 0; h < 2; ++h)
#pragma unroll
                for (int i = 0; i < 2; ++i) nao[h][i] = ao[h][i]; }
        const char* nA = has_next ? S.a_base(nxt) : cA; const char* nB = has_next ? S.b_base(nxt) : cB;
        for (int t = 0; t < nt; t += 2) {
            const bool last = (t == nt - 2);
            const char* a1 = cA + (size_t)(t + 1) * kstep;
            const char* a2 = last ? nA : cA + (size_t)(t + 2) * kstep; const char* b2 = last ? nB : cB + (size_t)(t + 2) * kstep;
            const char* a3 = a2 + kstep; const char* b3 = b2 + kstep;
            unsigned o2[2][2];
#pragma unroll
            for (int h = 0; h < 2; ++h)
#pragma unroll
                for (int i = 0; i < 2; ++i) o2[h][i] = (Sched::GATHER && last) ? nao[h][i] : ao[h][i];
            PG8_LDB(B0, 0, 0); PG8_LDB(B1, 0, 1); PG8_SCHED; PG8_LDA(At, 0, 0); PG8_STAGE(PG8_SA(1, 1), a1, ao[1]);
            PG8_WAIT_V(8); PG8_WAIT_L(0); PG8_BAR; PG8_MMA(0, 0, At, B0); PG8_MMA(0, 1, At, B1); PG8_BAR; PG8_SCHED;
            PG8_LDA(At, 0, 1); PG8_STAGE(PG8_SB(0, 0), b2, voffB); PG8_STAGE(PG8_SB(0, 1), b2 + hstep, voffB); PG8_STAGE(PG8_SA(0, 0), a2, o2[0]);
            PG8_WAIT_V(8); PG8_WAIT_L(0); PG8_BAR; PG8_MMA(1, 0, At, B0); PG8_MMA(1, 1, At, B1); PG8_BAR; PG8_SCHED;
            PG8_LDB(B0, 1, 0); PG8_LDB(B1, 1, 1); PG8_SCHED; PG8_LDA(At, 1, 0); PG8_STAGE(PG8_SA(0, 1), a2, o2[1]);
            PG8_WAIT_V(8); PG8_WAIT_L(0); PG8_BAR; PG8_MMA(0, 0, At, B0); PG8_MMA(0, 1, At, B1); PG8_BAR; PG8_SCHED;
            PG8_LDA(At, 1, 1); PG8_STAGE(PG8_SB(1, 0), b3, voffB); PG8_STAGE(PG8_SB(1, 1), b3 + hstep, voffB); PG8_STAGE(PG8_SA(1, 0), a3, o2[0]);
            PG8_WAIT_V(8); PG8_WAIT_L(0); PG8_BAR; PG8_MMA(1, 0, At, B0); PG8_MMA(1, 1, At, B1); PG8_BAR; PG8_SCHED;
        }
        if constexpr (ALIGN_EPI) { if (wr == 0) PG8_BAR; }
        { int fr_ = fr, fq_ = fq; asm volatile("" : "+v"(fr_), "+v"(fq_));
          E(acc, cur, wr, wc, fr_, fq_); }
        if (!has_next) break;
#pragma unroll
        for (int a = 0; a < 2; ++a)
#pragma unroll
            for (int b = 0; b < 2; ++b)
#pragma unroll
                for (int m = 0; m < 4; ++m)
#pragma unroll
                    for (int n = 0; n < 2; ++n) acc[a][b][m][n] = (f32x4){0.f, 0.f, 0.f, 0.f};
        cur = nxt; cA = nA; cB = nB; ++ui;
#pragma unroll
        for (int h = 0; h < 2; ++h)
#pragma unroll
            for (int i = 0; i < 2; ++i) ao[h][i] = nao[h][i];
        if constexpr (ALIGN_EPI) { if (wr == 1) PG8_BAR; }
    }
    PG8_WAIT_V(0);
    if constexpr (!ALIGN_EPI) { if (wr == 0) PG8_BAR; }
    PG8_BAR;
#undef PG8_SA
#undef PG8_SB
#undef PG8_STAGE
#undef PG8_LDA
#undef PG8_LDB
#undef PG8_MMA
#undef PG8_WAIT_V
#undef PG8_WAIT_L
#undef PG8_BAR
#undef PG8_SCHED
}
}
using pg8::Unit; using pg8::cvt_pk_bf16;

#define XB_TMO      128
#define XB_XCNT(j)  (256  + 64 * (j))
#define XB_XSUB(j)  (1280 + 64 * (j))
#define XB_XGEN(j)  (2304 + 64 * (j))
#define XB_TOP      3328
#define XB_TOPGEN   3392
#define XCD_BAR_WORDS 3456
#define XB_SPIN_CAP (1u << 18)
__device__ __forceinline__ unsigned xb_ld(unsigned* p)              { return __hip_atomic_load(p, __ATOMIC_RELAXED, __HIP_MEMORY_SCOPE_AGENT); }
__device__ __forceinline__ unsigned xb_add(unsigned* p, unsigned v) { return __hip_atomic_fetch_add(p, v, __ATOMIC_RELAXED, __HIP_MEMORY_SCOPE_AGENT); }
__device__ __forceinline__ unsigned xb_xcc_id() { return (unsigned)__builtin_amdgcn_s_getreg((3 << 11) | 20) & 0xFu; }
#define XB_SPIN(cond, bar) do { unsigned _sp = 0; while (cond) { __builtin_amdgcn_s_sleep(1); \
    if ((++_sp & 255u) == 0u) { if (xb_ld(&(bar)[XB_TMO])) break; if (_sp > XB_SPIN_CAP) { atomicAdd(&(bar)[XB_TMO], 1u); break; } } } } while (0)
struct XcdBarrier { unsigned* bar; unsigned x; volatile LAS unsigned* st; };
__device__ __forceinline__ XcdBarrier xcd_barrier_post(unsigned* bar, volatile LAS unsigned* st) {
    XcdBarrier b; b.bar = bar; b.x = xb_xcc_id(); b.st = st;
    if (threadIdx.x == 0) (void)xb_add(&bar[XB_XCNT(b.x)], 1u);
    return b;
}
__device__ __forceinline__ void xcd_barrier_complete(unsigned* bar, unsigned x, unsigned& nloc, unsigned& nx) {
    const unsigned G = gridDim.x * gridDim.y * gridDim.z;
    unsigned sum, cnt, mine, sp = 0u;
    for (;;) {
        sum = 0u; cnt = 0u; mine = 0u;
#pragma unroll
        for (unsigned j = 0; j < 16; ++j) { const unsigned c = xb_ld(&bar[XB_XCNT(j)]); sum += c; cnt += (c > 0u) ? 1u : 0u; mine = (j == x) ? c : mine; }
        if (sum == G) break;
        __builtin_amdgcn_s_sleep(1);
        if ((++sp & 255u) == 0u) { if (xb_ld(&bar[XB_TMO])) break; if (sp > XB_SPIN_CAP) { atomicAdd(&bar[XB_TMO], 1u); break; } }
    }
    nloc = mine > 0u ? mine : 1u; nx = cnt > 0u ? cnt : 1u;
}
__device__ __forceinline__ void xcd_barrier(const XcdBarrier& b, const int tid) {
    asm volatile("s_waitcnt vmcnt(0)" ::: "memory");
    __syncthreads();
    if (tid == 0) {
        unsigned* bar = b.bar;
        __builtin_amdgcn_s_waitcnt(0);
        unsigned nloc = b.st[0], nx = b.st[1];
        if (nloc == 0u) { xcd_barrier_complete(bar, b.x, nloc, nx); b.st[0] = nloc; b.st[1] = nx; }
        const unsigned old = xb_add(&bar[XB_XSUB(b.x)], 1u);
        const unsigned gen = old / nloc;
        if (old + 1u == (gen + 1u) * nloc) {
            __builtin_amdgcn_fence(__ATOMIC_RELEASE, "agent");
            asm volatile("s_waitcnt vmcnt(0)" ::: "memory");
            const unsigned og = xb_add(&bar[XB_TOP], 1u);
            const unsigned tg = og / nx;
            if (og + 1u == (tg + 1u) * nx) xb_add(&bar[XB_TOPGEN], 1u);
            else XB_SPIN(xb_ld(&bar[XB_TOPGEN]) == tg, bar);
            __builtin_amdgcn_fence(__ATOMIC_ACQUIRE, "agent");
            xb_add(&bar[XB_XGEN(b.x)], 1u);
            asm volatile("s_waitcnt vmcnt(0)" ::: "memory");
        } else {
            XB_SPIN(xb_ld(&bar[XB_XGEN(b.x)]) == gen, bar);
            __builtin_amdgcn_fence(__ATOMIC_ACQUIRE, "agent");
            asm volatile("s_waitcnt vmcnt(0)" ::: "memory");
        }
    }
    __syncthreads();
}

constexpr int RING_BYTES = 131072;
constexpr int LDS_BYTES = 147456;
constexpr int LDSCTL_OFF = LDS_BYTES - 1024, MISC_OFF = LDSCTL_OFF + 320;

struct Args { const float* in[26]; float* out; unsigned char* ws; int ph_lo, ph_hi; };
struct Frame {
    LAS unsigned char* lds; volatile LAS unsigned* MISC;
    int tid, lane, wave, G, bid;
    unsigned char* ws; float* out;
    const float *x, *c, *ctx, *c_ctx, *w_mod, *b_mod, *g_norm1, *w_in, *ml_conv, *ml_conv_b, *b_mgate, *ml_norm, *gla_w2, *gla_b2, *gla_norm,
                *w_proj_m, *w_proj_g, *w_out, *g_norm2, *w_grp, *b_grp, *w_rexp, *b_rexp, *w_up, *w_down, *g_final;
};
template <class T> __device__ __forceinline__ T* wsp(const Frame& F, size_t off) { return (T*)(F.ws + off); }

struct TItem { const float* W; bf16* WT; int Nsrc, K, k0, n0, sc; };
__device__ __forceinline__ int map_a(int n) { return n < 2048 ? n : (n < 4096 ? n + 1040 : (n < 4112 ? 3072 + (n - 4096) : (n < 4144 ? 6160 + (n - 4112) : -1))); }
__device__ __forceinline__ int map_b(int n) { return n < 1024 ? 2048 + n : (n < 2048 ? 5136 + (n - 1024) : (n < 3072 ? 6192 + (n - 2048) : 7216 + (n - 3072))); }
__device__ __forceinline__ int map_up(int n) { const int pn = n >> 8, j = n & 255; return j < 128 ? 128 * pn + j : 512 + 128 * pn + (j - 128); }
__device__ __forceinline__ void titem_load(const TItem& t, int lane, f32x4 (&v)[8]) {
    const int scc = t.sc < 0 ? 0 : t.sc;
#pragma unroll
    for (int r = 0; r < 8; ++r) v[r] = *(const f32x4*)(t.W + (size_t)(t.k0 + 8 * r + (lane >> 3)) * t.Nsrc + scc);
}
__device__ __forceinline__ void titem_store(const TItem& t, int lane, const f32x4 (&v)[8], LAS float* scr) {
    const float z = t.sc < 0 ? 0.f : 1.f;
#pragma unroll
    for (int r = 0; r < 8; ++r) { const int kk = 8 * r + (lane >> 3); LAS float* d = scr + kk * 33 + 4 * (lane & 7); d[0] = v[r][0] * z; d[1] = v[r][1] * z; d[2] = v[r][2] * z; d[3] = v[r][3] * z; }
    LDS_WAIT(); asm volatile("" ::: "memory");
    const int c = lane & 7;
#pragma unroll
    for (int j = 0; j < 4; ++j) { const int n = (lane >> 3) + 8 * j; const LAS float* s = scr + (8 * c) * 33 + n;
        u32x4 o; o.x = pk2(s[0 * 33], s[1 * 33]); o.y = pk2(s[2 * 33], s[3 * 33]); o.z = pk2(s[4 * 33], s[5 * 33]); o.w = pk2(s[6 * 33], s[7 * 33]);
        *(u32x4*)(t.WT + (size_t)(t.n0 + n) * t.K + t.k0 + 8 * c) = o; }
    LDS_WAIT(); asm volatile("" ::: "memory");
}
template <class Dec>
__device__ __forceinline__ void run_transposes(Frame& F, int nitems, Dec dec, const int skip = 0) {
    LAS float* scr = (LAS float*)(F.lds + F.wave * 16384);
    if (F.bid < skip) return;
    const int gw = (F.bid - skip) * NW + F.wave, NGW = (F.G - skip) * NW, last = nitems - 1;
    if (gw >= nitems) return;
    f32x4 va[8], vb[8]; TItem ia, ib;
    ia = dec(gw, F.lane); titem_load(ia, F.lane, va);
    for (int it = gw; it < nitems; it += 2 * NGW) {
        { const int j = it + NGW; ib = dec(j < last ? j : last, F.lane); titem_load(ib, F.lane, vb); }
        titem_store(ia, F.lane, va, scr);
        { const int j = it + 2 * NGW; ia = dec(j < last ? j : last, F.lane); titem_load(ia, F.lane, va); }
        if (it + NGW < nitems) titem_store(ib, F.lane, vb, scr);
    }
}
__device__ __forceinline__ void p0_prologue(Frame& F) {
    LAS float* scr = (LAS float*)(F.lds + F.wave * 16384);
    const int gw = F.bid * NW + F.wave, NGW = F.G * NW;
    if (F.bid < 192) {
        LAS float* red = (LAS float*)(F.lds);
        const int r = F.tid >> 3, c4 = F.tid & 7, col0 = F.bid * 32 + 4 * c4;
        f32x4 a0 = {0.f, 0.f, 0.f, 0.f}, a1 = a0, a2 = a0;
        for (int k = r; k < D; k += 64) {
            const f32x4 w = *(const f32x4*)(F.w_mod + (size_t)k * 6144 + col0);
            const float s0 = siluf(F.c[k]), s1 = siluf(F.c[D + k]), s2 = siluf(F.c_ctx[k]);
            a0 += w * s0; a1 += w * s1; a2 += w * s2; }
#pragma unroll
        for (int j = 0; j < 4; ++j) { red[r * 96 + 0 + 4 * c4 + j] = a0[j]; red[r * 96 + 32 + 4 * c4 + j] = a1[j]; red[r * 96 + 64 + 4 * c4 + j] = a2[j]; }
        __syncthreads();
        if (F.tid < 96) { float s = 0.f; for (int q = 0; q < 64; ++q) s += red[q * 96 + F.tid]; const int rr = F.tid >> 5, j = F.bid * 32 + (F.tid & 31);
            wsp<float>(F, WS_MODV)[rr * 6144 + j] = s + F.b_mod[j]; }
        __syncthreads();
    }
}
template <int PART>
__device__ __forceinline__ void p0_weight_copies(Frame& F, const int skip = 0) {
    constexpr int I_A = (NA / 32) * 16, I_B = (NB / 32) * 16, I_P = (1024 / 32) * 16;
    const float* w_in = F.w_in; const float* wpm = F.w_proj_m; const float* wpg = F.w_proj_g; const float* wo = F.w_out; unsigned char* ws = F.ws;
    run_transposes(F, PART == 0 ? I_A : I_B + 3 * I_P, [=](int it, int lane) {
        TItem t; t.K = D; const int r = PART == 0 ? it : it + I_A;
        const bool isA = r < I_A, isB = !isA && r < I_A + I_B; const int rp = r - I_A - I_B, pi = rp < 0 ? 0 : rp / I_P;
        const int rr = isA ? r : (isB ? r - I_A : rp - pi * I_P);
        t.k0 = 64 * (rr & 15); t.n0 = 32 * (rr >> 4); const int n = t.n0 + 4 * (lane & 7);
        t.W = (isA || isB) ? w_in : (pi == 0 ? wpm : (pi == 1 ? wpg : wo)); t.Nsrc = (isA || isB) ? IN_W : D;
        t.WT = (bf16*)(ws + (isA ? WS_WA : (isB ? WS_WB : (pi == 0 ? WS_WPM : (pi == 1 ? WS_WPG : WS_WOUT)))));
        t.sc = isA ? map_a(n) : (isB ? map_b(n) : n);
        return t; }, skip);
}
template <int PART>
__device__ __forceinline__ void moe_weight_copies(Frame& F, const int skip = 0) {
    constexpr int I_U = (1024 / 32) * 16  , I_D = (1024 / 32) * 8;
    const float* wup = F.w_up; const float* wdn = F.w_down; unsigned char* ws = F.ws;
    run_transposes(F, NEXP * (PART == 0 ? I_U : I_D), [=](int it, int lane) {
        TItem t; constexpr bool up = PART == 0; const int e = it / (up ? I_U : I_D), rr = it % (up ? I_U : I_D);
        t.K = up ? 1024 : 512; t.Nsrc = 1024;
        t.k0 = up ? 64 * (rr & 15) : 64 * (rr & 7); t.n0 = up ? 32 * (rr >> 4) : 32 * (rr >> 3); const int n = t.n0 + 4 * (lane & 7);
        t.W = up ? wup + (size_t)e * 1024 * 1024 : wdn + (size_t)e * 512 * 1024;
        t.WT = up ? (bf16*)(ws + WS_WUP) + (size_t)e * 1024 * 1024 : (bf16*)(ws + WS_WDN) + (size_t)e * 1024 * 512;
        t.sc = up ? map_up(n) : n;
        return t; }, skip);
}

__device__ __forceinline__ void p1_hx(Frame& F) {
    const int gw = F.bid * NW + F.wave, NGW = F.G * NW;
    const float* modv = wsp<float>(F, WS_MODV);
    for (int m = gw; m < MT; m += 2 * NGW) {
        const int m2 = m + NGW < MT ? m + NGW : m;
        const float* src[2] = {m < M_LAT ? F.x + (size_t)m * D : F.ctx + (size_t)(m - M_LAT) * D, m2 < M_LAT ? F.x + (size_t)m2 * D : F.ctx + (size_t)(m2 - M_LAT) * D};
        const float* mv[2] = {modv + (m < M_LAT ? (m >> 13) : 2) * 6144, modv + (m2 < M_LAT ? (m2 >> 13) : 2) * 6144};
        f32x4 v[2][4]; float s[2] = {0.f, 0.f};
#pragma unroll
        for (int r = 0; r < 2; ++r)
#pragma unroll
            for (int j = 0; j < 4; ++j) v[r][j] = *(const f32x4*)(src[r] + 4 * F.lane + 256 * j);
#pragma unroll
        for (int r = 0; r < 2; ++r)
#pragma unroll
            for (int j = 0; j < 4; ++j) s[r] += (v[r][j].x * v[r][j].x + v[r][j].y * v[r][j].y) + (v[r][j].z * v[r][j].z + v[r][j].w * v[r][j].w);
#pragma unroll
        for (int r = 0; r < 2; ++r) {
            const float rstd = 1.f / sqrtf(wave_sum(s[r]) * (1.f / D) + EPS);
            bf16* o = wsp<bf16>(F, WS_HX) + (size_t)(r == 0 ? m : m2) * D;
#pragma unroll
            for (int j = 0; j < 4; ++j) { const int c = 4 * F.lane + 256 * j;
                const f32x4 g = *(const f32x4*)(F.g_norm1 + c), sh = *(const f32x4*)(mv[r] + c), sc = *(const f32x4*)(mv[r] + 1024 + c);
                const f32x4 h = (v[r][j] * rstd) * g * (sc + 1.f) + sh;
                u32x2 w; w.x = pk2(h.x, h.y); w.y = pk2(h.z, h.w); *(u32x2*)(o + c) = w; } }
    }
}

struct EpiProjA {
    unsigned char* ws; const float* b_mgate;
    __device__ __forceinline__ void operator()(const f32x4 (&acc)[2][2][4][2], const Unit& u, int wr, int wc, int fr, int fq) const {
        const int row0 = u.pm * 256 + wr * 64 + fr;
        if (u.pn < 16) {
            bf16* base = (bf16*)(ws + WS_QKM + (size_t)(u.pn >> 2) * BIG) + (u.pn & 3) * 256 + wc * 32 + 8 * fq;
#pragma unroll
            for (int ai = 0; ai < 2; ++ai)
#pragma unroll
                for (int m = 0; m < 4; ++m) { bf16* rowp = base + (size_t)(row0 + ai * 128 + m * 16) * 1024;
#pragma unroll
                    for (int bj = 0; bj < 2; ++bj) { const f32x4 v0 = acc[ai][bj][m][0], v1 = acc[ai][bj][m][1];
                        u32x4 w; w.x = cvt_pk_bf16(v0[0], v0[1]); w.y = cvt_pk_bf16(v0[2], v0[3]); w.z = cvt_pk_bf16(v1[0], v1[1]); w.w = cvt_pk_bf16(v1[2], v1[3]);
                        *(u32x4*)(rowp + bj * 128) = w; } }
        } else if (wc < 2) {
            const int col = wc * 32 + 8 * fq;
            float* g = (float*)(ws + WS_GATES);
            f32x4 b0 = {0.f, 0.f, 0.f, 0.f}, b1 = b0;
            if (col < 16) { b0 = *(const f32x4*)(b_mgate + col); b1 = *(const f32x4*)(b_mgate + col + 4); }
#pragma unroll
            for (int ai = 0; ai < 2; ++ai)
#pragma unroll
                for (int m = 0; m < 4; ++m) { float* rowp = g + (size_t)(row0 + ai * 128 + m * 16) * 64 + col;
                    *(f32x4*)rowp = acc[ai][0][m][0] + b0; *(f32x4*)(rowp + 4) = acc[ai][0][m][1] + b1; }
        }
    }
};

__device__ __forceinline__ int chunk_row0(int ci) { return ci < 256 ? (ci >> 7) * SEQ + (ci & 127) * 64 : M_LAT + ((ci - 256) >> 2) * CTXL + ((ci - 256) & 3) * 64; }
__device__ __forceinline__ bf16* qkgt_row(const Frame& F, int dir, int m) {
    return m < M_LAT ? (bf16*)F.out + ((size_t)dir * M_LAT + m) * 1024 : wsp<bf16>(F, WS_QKGTC) + ((size_t)dir * M_CTX + (m - M_LAT)) * 1024;
}
__device__ __forceinline__ float logsig_fast(float x) { return fminf(x, 0.f) - __logf(1.f + __expf(-fabsf(x))); }
__device__ __forceinline__ void unpack8(const u32x4& v, float (&f)[8]) { f[0] = bflo(v.x); f[1] = bfhi(v.x); f[2] = bflo(v.y); f[3] = bfhi(v.y); f[4] = bflo(v.z); f[5] = bfhi(v.z); f[6] = bflo(v.w); f[7] = bfhi(v.w); }
__device__ __forceinline__ void p3_prep(Frame& F) {
    const bf16* QKM = wsp<bf16>(F, WS_QKM); bf16* QKMC = wsp<bf16>(F, WS_QKMC); const float* GATES = wsp<float>(F, WS_GATES); const bf16* QKG = wsp<bf16>(F, WS_QKG);
    for (int it = F.bid; it < NCHUNK * 3; it += F.G) {
        int tidl = F.tid; asm volatile("" : "+v"(tidl));
        const int lanel = tidl & 63;
        if (it < NCHUNK) {
            const int ci = F.G == 256 ? (it < 256 ? (it & 7) * 33 + (it >> 3) : (it - 256) * 33 + 32) : it, m0 = chunk_row0(ci);
            const int cg = tidl & 127, cq = tidl >> 7, ch = 8 * cg;
            const bool lat = ci < 256; const int c = lat ? (ci & 127) : ((ci - 256) & 3);
            const bool has_up = lat && c > 0, has_dn = lat && c < 127;
            const float osc = ch >= 512 ? 0.08838834764831845f : 1.f;
            f32x4 bz0 = *(const f32x4*)(F.ml_conv_b + ch), bz1 = *(const f32x4*)(F.ml_conv_b + ch + 4);
            f32x4 cw0[9], cw1[9];
#pragma unroll
            for (int q = 0; q < 9; ++q) { cw0[q] = *(const f32x4*)(F.ml_conv + q * 1024 + ch); cw1[q] = *(const f32x4*)(F.ml_conv + q * 1024 + ch + 4); }
#pragma unroll 1
            for (int cb = 0; cb < 8; ++cb) {
                const int c0 = cq * 16 + cb * 2;
                u32x4 in[3][4];
#pragma unroll
                for (int dr = 0; dr < 3; ++dr)
#pragma unroll
                    for (int dc = 0; dc < 4; ++dc) { const int col = c0 - 1 + dc; bool ok; int m;
                        if (lat) { ok = col >= 0 && col <= 63 && (dr != 0 || has_up) && (dr != 2 || has_dn); m = m0 + (dr - 1) * 64 + col; }
                        else { const int t = c * 64 + col; ok = dr == 1 && t >= 0 && t <= 255; m = m0 + col; }
                        const int mc = ok ? m : m0;
                        const u32x4 v = *(const u32x4*)(QKM + (size_t)mc * 1024 + ch);
                        in[dr][dc] = ok ? v : (u32x4){0u, 0u, 0u, 0u}; }
                float acc[2][8];
#pragma unroll
                for (int oc = 0; oc < 2; ++oc) { acc[oc][0] = bz0[0]; acc[oc][1] = bz0[1]; acc[oc][2] = bz0[2]; acc[oc][3] = bz0[3]; acc[oc][4] = bz1[0]; acc[oc][5] = bz1[1]; acc[oc][6] = bz1[2]; acc[oc][7] = bz1[3]; }
#pragma unroll
                for (int dr = 0; dr < 3; ++dr)
#pragma unroll
                    for (int dc = 0; dc < 3; ++dc) { const f32x4 w0 = cw0[dr * 3 + dc], w1 = cw1[dr * 3 + dc];
#pragma unroll
                        for (int oc = 0; oc < 2; ++oc) { float f[8]; unpack8(in[dr][oc + dc], f);
                            acc[oc][0] += w0[0] * f[0]; acc[oc][1] += w0[1] * f[1]; acc[oc][2] += w0[2] * f[2]; acc[oc][3] += w0[3] * f[3]; acc[oc][4] += w1[0] * f[4]; acc[oc][5] += w1[1] * f[5]; acc[oc][6] += w1[2] * f[6]; acc[oc][7] += w1[3] * f[7]; } }
#pragma unroll
                for (int oc = 0; oc < 2; ++oc) { u32x4 o; o.x = pk2(siluf(acc[oc][0]) * osc, siluf(acc[oc][1]) * osc); o.y = pk2(siluf(acc[oc][2]) * osc, siluf(acc[oc][3]) * osc);
                    o.z = pk2(siluf(acc[oc][4]) * osc, siluf(acc[oc][5]) * osc); o.w = pk2(siluf(acc[oc][6]) * osc, siluf(acc[oc][7]) * osc);
                    *(u32x4*)(QKMC + (size_t)(m0 + c0 + oc) * 1024 + ch) = o; }
            }
            {
                const int dir = F.wave >> 2, h = F.wave & 3, m = m0 + lanel;
                const float ip = GATES[(size_t)m * 64 + dir * 8 + h], lf = logsig(GATES[(size_t)m * 64 + dir * 8 + 4 + h]);
                float b = lf;
#pragma unroll
                for (int o = 1; o < 64; o <<= 1) { const float t = dir == 0 ? __shfl_up(b, o) : __shfl_down(b, o); const bool ok = dir == 0 ? (lanel >= o) : (lanel + o < 64); if (ok) b += t; }
                f32x2 ab; ab.x = expf(b); ab.y = expf(ip - b);
                wsp<f32x2>(F, WS_AB)[((size_t)dir * MT + m) * 4 + h] = ab;
                if (lanel == (dir == 0 ? 63 : 0)) wsp<float>(F, WS_GENDM)[((size_t)dir * NCHUNK + ci) * 4 + h] = expf(b);
            }
        } else {
            const int gi0 = it - NCHUNK;
            const int gi = F.G == 256 ? ((((gi0 >> 4) << 3) | (gi0 & 7)) << 1) | ((gi0 >> 3) & 1) : gi0;
            const int ci = gi >> 1, dir = gi & 1, m0 = chunk_row0(ci);
            LAS float* lr = (LAS float*)F.lds;
            LAS float* Bl = (LAS float*)(F.lds + 4096);
            __syncthreads();
            for (int i = tidl; i < 1024; i += NTHR) lr[i] = GATES[(size_t)(m0 + (i >> 4)) * 64 + 16 + dir * 16 + (i & 15)];
            const int ch = tidl;
            float w2[16];
#pragma unroll
            for (int r = 0; r < 16; ++r) w2[r] = F.gla_w2[((size_t)dir * 16 + r) * 512 + ch];
            const float b2 = F.gla_b2[dir * 512 + ch];
            __syncthreads();
            float b = 0.f;
            for (int i = 0; i < 64; ++i) { const int r = dir == 0 ? i : 63 - i;
                const f32x4 l0 = *(const LAS f32x4*)(lr + r * 16), l1 = *(const LAS f32x4*)(lr + r * 16 + 4), l2 = *(const LAS f32x4*)(lr + r * 16 + 8), l3 = *(const LAS f32x4*)(lr + r * 16 + 12);
                float xg = b2 + l0[0] * w2[0] + l0[1] * w2[1] + l0[2] * w2[2] + l0[3] * w2[3] + l1[0] * w2[4] + l1[1] * w2[5] + l1[2] * w2[6] + l1[3] * w2[7]
                              + l2[0] * w2[8] + l2[1] * w2[9] + l2[2] * w2[10] + l2[3] * w2[11] + l3[0] * w2[12] + l3[1] * w2[13] + l3[2] * w2[14] + l3[3] * w2[15];
                b += logsig_fast(xg) * (1.f / 16.f);
                Bl[r * 512 + ch] = b; }
            wsp<float>(F, WS_GENDG)[((size_t)dir * NCHUNK + ci) * 512 + ch] = __expf(b);
            __syncthreads();
            u32x4 vin[16];
#pragma unroll
            for (int j = 0; j < 16; ++j) { const int pi = tidl + j * 512, r = pi >> 7, cp = pi & 127; vin[j] = *(const u32x4*)(QKG + (size_t)(m0 + r) * 1024 + cp * 8); }
#pragma unroll
            for (int j = 0; j < 16; ++j) { const int pi = tidl + j * 512, r = pi >> 7, cp = pi & 127, m = m0 + r; const bool isk = cp >= 64;
                const u32x4 v = vin[j];
                const f32x4 b0 = *(const LAS f32x4*)(Bl + r * 512 + 8 * (cp & 63)), b1 = *(const LAS f32x4*)(Bl + r * 512 + 8 * (cp & 63) + 4);
                float f[8]; unpack8(v, f); float e[8];
#pragma unroll
                for (int q = 0; q < 4; ++q) { e[q] = isk ? __expf(-b0[q]) : __expf(b0[q]) * 0.08838834764831845f; e[4 + q] = isk ? __expf(-b1[q]) : __expf(b1[q]) * 0.08838834764831845f; }
                u32x4 o; o.x = pk2(f[0] * e[0], f[1] * e[1]); o.y = pk2(f[2] * e[2], f[3] * e[3]); o.z = pk2(f[4] * e[4], f[5] * e[5]); o.w = pk2(f[6] * e[6], f[7] * e[7]);
                *(u32x4*)(qkgt_row(F, dir, m) + cp * 8) = o; }
        }
    }
}

constexpr int L_AQ = 0, L_AK = 16384, L_VP = 32768, L_P = 49152, L_S = 65536, L_N = 131072 + 1024  ;
struct ScanSrc { const bf16* q; const bf16* k; const bf16* v; const f32x2* ab; const float* gend; int gstride; };
__device__ __forceinline__ int seg_chunk(int seg, int dir, int i) {
    if (seg < 0) return dir == 0 ? i : 3 - i;
    return dir == 0 ? seg * CPS + i : (NCH_LAT - 1 - seg * CPS) - i;
}
__device__ __forceinline__ void scan_stage(Frame& F, int model, int b, int h, int dir, int half, int ci, bool need_q) {
    const int m0 = chunk_row0(ci);
    LAS float* nb = (LAS float*)(F.lds + L_N);
    if (model == 0 && F.tid < 64) { const f32x2 ab = wsp<f32x2>(F, WS_AB)[((size_t)dir * MT + m0 + F.tid) * 4 + h]; nb[256 + F.tid] = ab.y; nb[320 + F.tid] = ab.x; }
    if (F.tid >= 64 && F.tid < 192) { const int dk = F.tid - 64;
        nb[128 + dk] = model == 0 ? wsp<float>(F, WS_GENDM)[((size_t)dir * NCHUNK + ci) * 4 + h] : wsp<float>(F, WS_GENDG)[((size_t)dir * NCHUNK + ci) * 512 + h * 128 + dk]; }
#pragma unroll
    for (int i = 0; i < 2; ++i) { const int p = F.tid + i * 512, r = p >> 4, cpart = p & 15, m = m0 + r;
        const bf16* qrow; const bf16* vrow;
        if (model == 0) { qrow = wsp<bf16>(F, WS_QKMC) + (size_t)m * 1024; vrow = wsp<bf16>(F, WS_VM) + (size_t)m * 1024; }
        else { qrow = qkgt_row(F, dir, m); vrow = wsp<bf16>(F, WS_VG) + (size_t)m * 1024; }
        if (need_q) *(LAS u32x4*)(F.lds + L_AQ + r * 256 + cpart * 16) = *(const u32x4*)(qrow + h * 128 + cpart * 8);
        *(LAS u32x4*)(F.lds + L_AK + r * 256 + cpart * 16) = *(const u32x4*)(qrow + 512 + h * 128 + cpart * 8);
        u32x4 v = *(const u32x4*)(vrow + h * 256 + half * 128 + cpart * 8);
        if (model == 0) { const float be = wsp<f32x2>(F, WS_AB)[((size_t)dir * MT + m) * 4 + h].y;
            v.x = pk2(bflo(v.x) * be, bfhi(v.x) * be); v.y = pk2(bflo(v.y) * be, bfhi(v.y) * be); v.z = pk2(bflo(v.z) * be, bfhi(v.z) * be); v.w = pk2(bflo(v.w) * be, bfhi(v.w) * be); }
        *(LAS u32x4*)(F.lds + L_VP + r * 256 + cpart * 16) = v; }
}
__device__ __forceinline__ void scan_update(Frame& F, int model) {
    LAS float* S = (LAS float*)(F.lds + L_S); LAS float* nb = (LAS float*)(F.lds + L_N);
    const LAS bf16* AK = (const LAS bf16*)(F.lds + L_AK); const LAS bf16* VP = (const LAS bf16*)(F.lds + L_VP);
    const int dk = F.tid >> 2, dv0 = (F.tid & 3) * 32;
    float a[32];
#pragma unroll
    for (int j = 0; j < 32; ++j) a[j] = S[dk * 128 + dv0 + j];
    float nn = 0.f;
    for (int s = 0; s < 64; ++s) { const float k = bf2f(AK[s * 128 + dk]);
        if (model == 0) nn += k * nb[256 + s];
#pragma unroll
        for (int j = 0; j < 32; j += 2) { const unsigned v = *(const LAS unsigned*)(VP + s * 128 + dv0 + j); a[j] += k * bflo(v); a[j + 1] += k * bfhi(v); } }
    const float g = nb[128 + dk];
#pragma unroll
    for (int j = 0; j < 32; ++j) S[dk * 128 + dv0 + j] = g * a[j];
    if (model == 0 && (F.tid & 3) == 0) nb[dk] = g * (nb[dk] + nn);
}
__device__ __forceinline__ bf16* state_ptr(const Frame& F, int sc, int slot, int half) { return wsp<bf16>(F, WS_STATE) + ((size_t)(sc * 8 + slot) * 2 + half) * 16384; }

__device__ __forceinline__ void p4_scan_local(Frame& F) {
    LAS float* S = (LAS float*)(F.lds + L_S); LAS float* nb = (LAS float*)(F.lds + L_N);
    for (int it0 = F.bid; it0 < 32 * 8 * 2; it0 += F.G) {
        const int it = (F.G == 256) ? (it0 & ~255) | ((((((it0 & 255) >> 4) << 3) | (it0 & 7)) << 1) | ((it0 >> 3) & 1)) : it0;
        const int half = it & 1, slot = (it >> 1) & 7, sc = it >> 4, seg = slot - 1;
        const int dir = sc & 1, h = (sc >> 1) & 3, b = (sc >> 3) & 1, model = sc >> 4;
        for (int i = F.tid; i < 16384; i += NTHR) S[i] = 0.f;
        if (F.tid < 128) nb[F.tid] = 0.f;
        float gacc = 1.f;
        __syncthreads();
        const int nch = seg < 0 ? NCH_CTX : CPS;
        for (int i = 0; i < nch; ++i) {
            const int c = seg_chunk(seg, dir, i), ci = seg < 0 ? 256 + b * 4 + c : b * 128 + c;
            scan_stage(F, model, b, h, dir, half, ci, false);
            __syncthreads();
            if (F.tid < 128) gacc *= nb[128 + F.tid];
            scan_update(F, model);
            __syncthreads();
        }
        bf16* st = state_ptr(F, sc, slot, half);
        for (int i = F.tid; i < 8192; i += NTHR) ((unsigned*)st)[i] = pk2(S[2 * i], S[2 * i + 1]);
        if (half == 0 && F.tid < 128) { wsp<float>(F, WS_NST)[(sc * 8 + slot) * 128 + F.tid] = nb[F.tid]; wsp<float>(F, WS_GSEG)[(sc * 8 + slot) * 128 + F.tid] = gacc; }
        __syncthreads();
    }
}
__device__ __forceinline__ void p5_scan_out(Frame& F) {
    LAS float* S = (LAS float*)(F.lds + L_S); LAS float* nb = (LAS float*)(F.lds + L_N); LAS float* P = (LAS float*)(F.lds + L_P);
    const LAS bf16* AQ = (const LAS bf16*)(F.lds + L_AQ); const LAS bf16* AK = (const LAS bf16*)(F.lds + L_AK); const LAS bf16* VP = (const LAS bf16*)(F.lds + L_VP);
    for (int it0 = F.bid; it0 < 2 * 2 * 4 * 8 * 2; it0 += F.G) {
        const int it = (F.G == 256) ? ((((it0 >> 4) << 3) | (it0 & 7)) << 1) | ((it0 >> 3) & 1) : it0;
        const int half = it & 1, seg = (it >> 1) & 7, h = (it >> 4) & 3, b = (it >> 6) & 1, model = it >> 7;
        bf16* HS = wsp<bf16>(F, model == 0 ? WS_QKM : WS_QKG);
        for (int dir = 0; dir < 2; ++dir) {
            const int sc = ((model * 2 + b) * 4 + h) * 2 + dir, s = dir == 0 ? seg : 7 - seg;
            { const int dk = F.tid >> 2, dv0 = (F.tid & 3) * 32; float a[32]; float nn = 0.f;
#pragma unroll
              for (int j = 0; j < 32; ++j) a[j] = 0.f;
              for (int slot = 0; slot <= s; ++slot) {
                  const float g = slot == 0 ? 0.f : wsp<float>(F, WS_GSEG)[(sc * 8 + slot) * 128 + dk];
                  const bf16* st = state_ptr(F, sc, slot, half) + dk * 128 + dv0;
#pragma unroll
                  for (int j = 0; j < 32; j += 2) { const unsigned v = *(const unsigned*)(st + j); a[j] = g * a[j] + bflo(v); a[j + 1] = g * a[j + 1] + bfhi(v); }
                  nn = g * nn + wsp<float>(F, WS_NST)[(sc * 8 + slot) * 128 + dk]; }
#pragma unroll
              for (int j = 0; j < 32; ++j) S[dk * 128 + dv0 + j] = a[j];
              if ((F.tid & 3) == 0) nb[dk] = nn; }
            __syncthreads();
            for (int i = 0; i < CPS; ++i) {
                const int c = seg_chunk(s, dir, i), ci = b * 128 + c, m0 = chunk_row0(ci);
                scan_stage(F, model, b, h, dir, half, ci, true);
                __syncthreads();
                for (int e = F.tid; e < 4096; e += NTHR) { const int t = e >> 6, s2 = e & 63; float p = 0.f;
                    if (dir == 0 ? (s2 <= t) : (s2 >= t)) {
                        for (int d8 = 0; d8 < 16; ++d8) { const u32x4 qa = *(const LAS u32x4*)(AQ + t * 128 + d8 * 8), ka = *(const LAS u32x4*)(AK + s2 * 128 + d8 * 8);
                            p += bflo(qa.x) * bflo(ka.x) + bfhi(qa.x) * bfhi(ka.x) + bflo(qa.y) * bflo(ka.y) + bfhi(qa.y) * bfhi(ka.y)
                               + bflo(qa.z) * bflo(ka.z) + bfhi(qa.z) * bfhi(ka.z) + bflo(qa.w) * bflo(ka.w) + bfhi(qa.w) * bfhi(ka.w); } }
                    P[e] = bf2f((unsigned short)f2bf(p)); }
                __syncthreads();
                { const int t = F.tid >> 3, dv0 = (F.tid & 7) * 16; float o[16];
#pragma unroll
                  for (int j = 0; j < 16; ++j) o[j] = 0.f;
                  float den = 0.f;
                  for (int s2 = 0; s2 < 64; ++s2) { const float p = P[t * 64 + s2];
                      if (model == 0) den += p * nb[256 + s2];
                      const u32x4 v0 = *(const LAS u32x4*)(VP + s2 * 128 + dv0), v1 = *(const LAS u32x4*)(VP + s2 * 128 + dv0 + 8);
                      o[0] += p * bflo(v0.x); o[1] += p * bfhi(v0.x); o[2] += p * bflo(v0.y); o[3] += p * bfhi(v0.y); o[4] += p * bflo(v0.z); o[5] += p * bfhi(v0.z); o[6] += p * bflo(v0.w); o[7] += p * bfhi(v0.w);
                      o[8] += p * bflo(v1.x); o[9] += p * bfhi(v1.x); o[10] += p * bflo(v1.y); o[11] += p * bfhi(v1.y); o[12] += p * bflo(v1.z); o[13] += p * bfhi(v1.z); o[14] += p * bflo(v1.w); o[15] += p * bfhi(v1.w); }
                  for (int dk = 0; dk < 128; ++dk) { const float q = bf2f(AQ[t * 128 + dk]);
                      if (model == 0) den += q * nb[dk];
                      const LAS float* sr = S + dk * 128 + dv0;
#pragma unroll
                      for (int j = 0; j < 16; ++j) o[j] += q * bf2f((unsigned short)f2bf(sr[j])); }
                  float rs = 1.f;
                  if (model == 0) { const float al = nb[320 + t]; rs = al / fmaxf(al * fabsf(den), 1.f); }
                  bf16* dst = HS + (size_t)(m0 + t) * 1024 + h * 256 + half * 128 + dv0;
                  float ssq = 0.f;
                  if (dir == 0) {
                      u32x4 w0, w1; w0.x = pk2(o[0] * rs, o[1] * rs); w0.y = pk2(o[2] * rs, o[3] * rs); w0.z = pk2(o[4] * rs, o[5] * rs); w0.w = pk2(o[6] * rs, o[7] * rs);
                      w1.x = pk2(o[8] * rs, o[9] * rs); w1.y = pk2(o[10] * rs, o[11] * rs); w1.z = pk2(o[12] * rs, o[13] * rs); w1.w = pk2(o[14] * rs, o[15] * rs);
                      *(u32x4*)dst = w0; *(u32x4*)(dst + 8) = w1;
                  } else {
                      const u32x4 p0 = *(const u32x4*)dst, p1 = *(const u32x4*)(dst + 8);
                      const float f[16] = {bflo(p0.x), bfhi(p0.x), bflo(p0.y), bfhi(p0.y), bflo(p0.z), bfhi(p0.z), bflo(p0.w), bfhi(p0.w), bflo(p1.x), bfhi(p1.x), bflo(p1.y), bfhi(p1.y), bflo(p1.z), bfhi(p1.z), bflo(p1.w), bfhi(p1.w)};
                      float r[16];
#pragma unroll
                      for (int j = 0; j < 16; ++j) { r[j] = f[j] + o[j] * rs; ssq += r[j] * r[j]; }
                      u32x4 w0, w1; w0.x = pk2(r[0], r[1]); w0.y = pk2(r[2], r[3]); w0.z = pk2(r[4], r[5]); w0.w = pk2(r[6], r[7]);
                      w1.x = pk2(r[8], r[9]); w1.y = pk2(r[10], r[11]); w1.z = pk2(r[12], r[13]); w1.w = pk2(r[14], r[15]);
                      *(u32x4*)dst = w0; *(u32x4*)(dst + 8) = w1;
                      ssq += __shfl_xor(ssq, 1); ssq += __shfl_xor(ssq, 2); ssq += __shfl_xor(ssq, 4);
                      if ((F.tid & 7) == 0) wsp<float>(F, WS_SSQ)[((size_t)(m0 + t) * 8 + model * 4 + h) * 2 + half] = ssq;
                  } }
                __syncthreads();
                scan_update(F, model);
                __syncthreads();
            }
        }
    }
}

typedef short s16x4 __attribute__((ext_vector_type(4)));
__device__ __forceinline__ unsigned offb(int row, int ch) { return 256u * (unsigned)row + 16u * (unsigned)(ch ^ (((row & 3) << 2) | ((row >> 2) & 3))); }
constexpr int M_AQ = 0, M_AK = 16384, M_VP = 32768, M_P = 49152, M_O = 57344, O_LD = 132;
template <int TILE>
__device__ __forceinline__ void tr_frag2(unsigned x0, unsigned x1, bf16x8& f0, bf16x8& f1) {
    s16x4 r0, r1, r2, r3;
    asm volatile("ds_read_b64_tr_b16 %0, %4 offset:%6\n\tds_read_b64_tr_b16 %1, %5 offset:%6\n\tds_read_b64_tr_b16 %2, %4 offset:%7\n\tds_read_b64_tr_b16 %3, %5 offset:%7\n\ts_waitcnt lgkmcnt(0)"
                 : "=&v"(r0), "=&v"(r1), "=&v"(r2), "=&v"(r3) : "v"(x0), "v"(x1), "i"(TILE), "i"(TILE + 8192) : "memory");
    f0 = __builtin_shufflevector(r0, r1, 0, 1, 2, 3, 4, 5, 6, 7); f1 = __builtin_shufflevector(r2, r3, 0, 1, 2, 3, 4, 5, 6, 7);
}
template <int TILE>
__device__ __forceinline__ void tr_frag8(unsigned a0, unsigned a1, unsigned b0, unsigned b1, unsigned c0, unsigned c1, unsigned d0, unsigned d1, bf16x8 (&f)[8]) {
    s16x4 r[16];
    asm volatile("ds_read_b64_tr_b16 %0, %16 offset:%24\n\tds_read_b64_tr_b16 %1, %17 offset:%24\n\tds_read_b64_tr_b16 %2, %16 offset:%25\n\tds_read_b64_tr_b16 %3, %17 offset:%25\n\t"
                 "ds_read_b64_tr_b16 %4, %18 offset:%24\n\tds_read_b64_tr_b16 %5, %19 offset:%24\n\tds_read_b64_tr_b16 %6, %18 offset:%25\n\tds_read_b64_tr_b16 %7, %19 offset:%25\n\t"
                 "ds_read_b64_tr_b16 %8, %20 offset:%24\n\tds_read_b64_tr_b16 %9, %21 offset:%24\n\tds_read_b64_tr_b16 %10, %20 offset:%25\n\tds_read_b64_tr_b16 %11, %21 offset:%25\n\t"
                 "ds_read_b64_tr_b16 %12, %22 offset:%24\n\tds_read_b64_tr_b16 %13, %23 offset:%24\n\tds_read_b64_tr_b16 %14, %22 offset:%25\n\tds_read_b64_tr_b16 %15, %23 offset:%25\n\ts_waitcnt lgkmcnt(0)"
                 : "=&v"(r[0]), "=&v"(r[1]), "=&v"(r[2]), "=&v"(r[3]), "=&v"(r[4]), "=&v"(r[5]), "=&v"(r[6]), "=&v"(r[7]), "=&v"(r[8]), "=&v"(r[9]), "=&v"(r[10]), "=&v"(r[11]), "=&v"(r[12]), "=&v"(r[13]), "=&v"(r[14]), "=&v"(r[15])
                 : "v"(a0), "v"(a1), "v"(b0), "v"(b1), "v"(c0), "v"(c1), "v"(d0), "v"(d1), "i"(TILE), "i"(TILE + 8192) : "memory");
#pragma unroll
    for (int j = 0; j < 8; ++j) f[j] = __builtin_shufflevector(r[2 * j], r[2 * j + 1], 0, 1, 2, 3, 4, 5, 6, 7);
}
template <int TILE>
__device__ __forceinline__ void tr_frag4(unsigned x0, unsigned x1, unsigned y0, unsigned y1, bf16x8& f0, bf16x8& f1, bf16x8& f2, bf16x8& f3) {
    s16x4 r0, r1, r2, r3, r4, r5, r6, r7;
    asm volatile("ds_read_b64_tr_b16 %0, %8 offset:%12\n\tds_read_b64_tr_b16 %1, %9 offset:%12\n\tds_read_b64_tr_b16 %2, %8 offset:%13\n\tds_read_b64_tr_b16 %3, %9 offset:%13\n\t"
                 "ds_read_b64_tr_b16 %4, %10 offset:%12\n\tds_read_b64_tr_b16 %5, %11 offset:%12\n\tds_read_b64_tr_b16 %6, %10 offset:%13\n\tds_read_b64_tr_b16 %7, %11 offset:%13\n\ts_waitcnt lgkmcnt(0)"
                 : "=&v"(r0), "=&v"(r1), "=&v"(r2), "=&v"(r3), "=&v"(r4), "=&v"(r5), "=&v"(r6), "=&v"(r7) : "v"(x0), "v"(x1), "v"(y0), "v"(y1), "i"(TILE), "i"(TILE + 8192) : "memory");
    f0 = __builtin_shufflevector(r0, r1, 0, 1, 2, 3, 4, 5, 6, 7); f1 = __builtin_shufflevector(r2, r3, 0, 1, 2, 3, 4, 5, 6, 7);
    f2 = __builtin_shufflevector(r4, r5, 0, 1, 2, 3, 4, 5, 6, 7); f3 = __builtin_shufflevector(r6, r7, 0, 1, 2, 3, 4, 5, 6, 7);
}
#define MFMA16(a, b, c) __builtin_amdgcn_mfma_f32_16x16x32_bf16((a), (b), (c), 0, 0, 0)
__device__ __forceinline__ bf16* mstate_ptr(const Frame& F, int sc, int slot, int half) { return wsp<bf16>(F, WS_STATE) + ((size_t)(sc * 8 + slot) * 2 + half) * 16384; }

#define LBAR() asm volatile("s_waitcnt lgkmcnt(0)\n\ts_barrier" ::: "memory")
template <bool OUT>
__device__ __forceinline__ void mscan_run(Frame& F, int model, int b, int h, int dir, int half, int seg, f32x4 (&S)[2][8], float& gacc) {
    LAS unsigned char* lds = F.lds; LAS float* nb = (LAS float*)(F.lds + L_N);
    LAS unsigned short* nbh = (LAS unsigned short*)(F.lds + L_N + 2048);
    const unsigned lb = (unsigned)(uintptr_t)F.lds;
    const int w = F.wave, lane = F.lane, li = lane & 15, lg = lane >> 4, tq = li >> 2, tp = lane & 3;
    const bool st = w < 4; const int sw = w & 3;
    const int nch = seg < 0 ? NCH_CTX : CPS;
    bf16* HS = wsp<bf16>(F, model == 0 ? WS_QKM : WS_QKG);
    const int mli = ((li & 3) << 2) | ((li >> 2) & 3);
    const unsigned rowb = 256u * li + 16u * (lg ^ mli);
    const unsigned o2b = 256u * li + 16u * ((lg >> 1) ^ mli) + 8u * (lg & 1);
    const unsigned trb0 = 256u * (8 * lg + tq) + 16u * ((tp >> 1) ^ ((tq << 2) | ((2 * lg) & 3))) + 8u * (tp & 1);
    const unsigned trb1 = 256u * (8 * lg + 4 + tq) + 16u * ((tp >> 1) ^ ((tq << 2) | ((2 * lg + 1) & 3))) + 8u * (tp & 1);
    const unsigned pra0 = lb + M_P + (128u * li + 16u * (lg ^ (li & 7))), pra1 = lb + M_P + ((128u * li + 16u * (lg ^ (li & 7))) ^ 64u);
    const unsigned poff0 = (unsigned)((F.tid >> 4) * 1024 + (F.tid & 15) * 8) * 2u, poff1 = poff0 + 32u * 2048u;
    auto final_pass = [&](const int m0, const u32x4 (&prevh)[2]) {
        LAS float* Ol = (LAS float*)(F.lds + M_O);
#pragma unroll
        for (int i = 0; i < 2; ++i) { const int p = F.tid + i * 512, t = p >> 4, c8 = p & 15;
            const f32x4 o0 = *(const LAS f32x4*)(Ol + t * O_LD + 8 * c8), o1 = *(const LAS f32x4*)(Ol + t * O_LD + 8 * c8 + 4);
            float rs = 1.f;
            if (model == 0) rs = nb[384 + t];
            bf16* dst = (bf16*)((unsigned char*)(HS + (size_t)m0 * 1024 + h * 256 + half * 128) + (i == 0 ? poff0 : poff1));
            float r[8] = {o0[0] * rs, o0[1] * rs, o0[2] * rs, o0[3] * rs, o1[0] * rs, o1[1] * rs, o1[2] * rs, o1[3] * rs};
            if (dir == 1) { const u32x4 pv = prevh[i];
                r[0] += bflo(pv.x); r[1] += bfhi(pv.x); r[2] += bflo(pv.y); r[3] += bfhi(pv.y); r[4] += bflo(pv.z); r[5] += bfhi(pv.z); r[6] += bflo(pv.w); r[7] += bfhi(pv.w);
                float ssq = (r[0] * r[0] + r[1] * r[1]) + (r[2] * r[2] + r[3] * r[3]) + (r[4] * r[4] + r[5] * r[5]) + (r[6] * r[6] + r[7] * r[7]);
                ssq += __shfl_xor(ssq, 1); ssq += __shfl_xor(ssq, 2); ssq += __shfl_xor(ssq, 4); ssq += __shfl_xor(ssq, 8);
                if (c8 == 0) wsp<float>(F, WS_SSQ)[((size_t)(m0 + t) * 8 + model * 4 + h) * 2 + half] = ssq; }
            u32x4 wv; wv.x = pkbf(r[0], r[1]); wv.y = pkbf(r[2], r[3]); wv.z = pkbf(r[4], r[5]); wv.w = pkbf(r[6], r[7]);
            *(u32x4*)dst = wv; }
    };
    const unsigned pwb = 128u * li + 8u * (lg & 1) + 16u * ((lg >> 1) ^ (li & 7));
    auto ptile = [&](const int ti, const int sh) {
        const bool used = dir == 0 ? !(sh == 1 && ti < 2) : !(sh == 0 && ti >= 2);
        if (!used) return;
        unsigned rowl = rowb; asm volatile("" : "+v"(rowl));
        bf16x8 pa[4], pb0[4], pb1[4];
#pragma unroll
        for (int kk = 0; kk < 4; ++kk) { const unsigned ra = lb + (rowl ^ ((unsigned)kk << 6)); pa[kk] = *(const LAS bf16x8*)(uintptr_t)(ra + M_AQ + 4096u * ti); pb0[kk] = *(const LAS bf16x8*)(uintptr_t)(ra + M_AK + 8192u * sh); pb1[kk] = *(const LAS bf16x8*)(uintptr_t)(ra + M_AK + 8192u * sh + 4096u); }
        f32x4 acc0 = {0.f, 0.f, 0.f, 0.f}, acc1 = acc0;
#pragma unroll
        for (int kk = 0; kk < 4; ++kk) { acc0 = MFMA16(pb0[kk], pa[kk], acc0); acc1 = MFMA16(pb1[kk], pa[kk], acc1); }
        const int t = 16 * ti + li;
#pragma unroll
        for (int sj = 0; sj < 2; ++sj) { const f32x4 acc = sj == 0 ? acc0 : acc1; const int s0 = 16 * (2 * sh + sj) + 4 * lg; float pv[4];
#pragma unroll
            for (int r = 0; r < 4; ++r) { const bool keep = dir == 0 ? (s0 + r <= t) : (s0 + r >= t); pv[r] = keep ? acc[r] : 0.f; }
            u32x2 pw; pw.x = pkbf(pv[0], pv[1]); pw.y = pkbf(pv[2], pv[3]);
            *(LAS u32x2*)(uintptr_t)(lb + M_P + 2048u * ti + (pwb ^ ((unsigned)(4 * sh + 2 * sj) << 4))) = pw; }
    };
    auto chunk_m0 = [&](const int ic) { const int c = seg_chunk(seg, dir, ic), ci = seg < 0 ? 256 + b * 4 + c : b * 128 + c; return chunk_row0(ci); };
    if (st) {
        const unsigned ola = lb + M_O + 4u * ((4 * lg) * O_LD + 32 * sw + li);
        for (int ic = 0; ic < nch; ++ic) {
            const int m0 = chunk_m0(ic);
            LBAR();
            if (F.tid < 128) gacc *= nb[128 + F.tid];
            unsigned o2l = o2b, tr0l = trb0, tr1l = trb1; asm volatile("" : "+v"(o2l), "+v"(tr0l), "+v"(tr1l));
            bf16x8 VB[2][2];
            tr_frag4<M_VP>(lb + (tr0l ^ ((unsigned)(2 * sw) << 5)), lb + (tr1l ^ ((unsigned)(2 * sw) << 5)), lb + (tr0l ^ ((unsigned)(2 * sw + 1) << 5)), lb + (tr1l ^ ((unsigned)(2 * sw + 1) << 5)), VB[0][0], VB[0][1], VB[1][0], VB[1][1]);
            u32x4 prevh[2] = {{0u, 0u, 0u, 0u}, {0u, 0u, 0u, 0u}};
            if (OUT) {
#pragma unroll
                for (int i = 0; i < 2; ++i) prevh[i] = *(const u32x4*)((const unsigned char*)(HS + (size_t)m0 * 1024 + h * 256 + half * 128) + (i == 0 ? poff0 : poff1) * (unsigned)dir);
                ptile(sw, 1);
                f32x4 O[2][4];
#pragma unroll
                for (int j = 0; j < 2; ++j)
#pragma unroll
                    for (int q = 0; q < 4; ++q) O[j][q] = (f32x4){0.f, 0.f, 0.f, 0.f};
#pragma unroll
                for (int kh = 0; kh < 2; ++kh) {
                    u32x2 alo[2][4], ahi[2][4];
#pragma unroll
                    for (int k2 = 0; k2 < 2; ++k2)
#pragma unroll
                        for (int q = 0; q < 4; ++q) { alo[k2][q] = *(const LAS u32x2*)(uintptr_t)((o2l ^ ((unsigned)(4 * (2 * kh + k2)) << 4)) + lb + M_AQ + 4096u * q); ahi[k2][q] = *(const LAS u32x2*)(uintptr_t)((o2l ^ ((unsigned)(4 * (2 * kh + k2) + 2) << 4)) + lb + M_AQ + 4096u * q); }
#pragma unroll
                    for (int k2 = 0; k2 < 2; ++k2) { const int kk = 2 * kh + k2; bf16x8 Bk[2];
#pragma unroll
                        for (int j = 0; j < 2; ++j) { u32x4 bw; bw.x = pkbf(S[j][2 * kk][0], S[j][2 * kk][1]); bw.y = pkbf(S[j][2 * kk][2], S[j][2 * kk][3]); bw.z = pkbf(S[j][2 * kk + 1][0], S[j][2 * kk + 1][1]); bw.w = pkbf(S[j][2 * kk + 1][2], S[j][2 * kk + 1][3]); Bk[j] = __builtin_bit_cast(bf16x8, bw); }
#pragma unroll
                        for (int q = 0; q < 4; ++q) { u32x4 aw; aw.x = alo[k2][q].x; aw.y = alo[k2][q].y; aw.z = ahi[k2][q].x; aw.w = ahi[k2][q].y; const bf16x8 Af = __builtin_bit_cast(bf16x8, aw);
                            O[0][q] = MFMA16(Af, Bk[0], O[0][q]); O[1][q] = MFMA16(Af, Bk[1], O[1][q]); } }
                    asm volatile("" ::: "memory");
                }
                LBAR();
                bf16x8 p0[4], p1[4];
#pragma unroll
                for (int q = 0; q < 4; ++q) { p0[q] = *(const LAS bf16x8*)(uintptr_t)(pra0 + 2048u * q); p1[q] = *(const LAS bf16x8*)(uintptr_t)(pra1 + 2048u * q); }
#pragma unroll
                for (int q = 0; q < 4; ++q) {
                    if (dir == 0 || q < 2) { O[0][q] = MFMA16(p0[q], VB[0][0], O[0][q]); O[1][q] = MFMA16(p0[q], VB[1][0], O[1][q]); }
                    if (dir == 1 || q >= 2) { O[0][q] = MFMA16(p1[q], VB[0][1], O[0][q]); O[1][q] = MFMA16(p1[q], VB[1][1], O[1][q]); } }
#pragma unroll
                for (int j = 0; j < 2; ++j)
#pragma unroll
                    for (int q = 0; q < 4; ++q)
#pragma unroll
                        for (int r = 0; r < 4; ++r) *(LAS float*)(uintptr_t)(ola + 64u * j + 4u * (unsigned)((16 * q + r) * O_LD)) = O[j][q][r];
            }
#pragma unroll
            for (int kp = 0; kp < 4; ++kp) { bf16x8 A0, A1, A2, A3; const int kt = 2 * kp;
                const f32x4 g0 = *(const LAS f32x4*)(nb + 128 + 16 * kt + 4 * lg), g1 = *(const LAS f32x4*)(nb + 128 + 16 * (kt + 1) + 4 * lg);
                tr_frag4<M_AK>(lb + (tr0l ^ ((unsigned)kt << 5)), lb + (tr1l ^ ((unsigned)kt << 5)), lb + (tr0l ^ ((unsigned)(kt + 1) << 5)), lb + (tr1l ^ ((unsigned)(kt + 1) << 5)), A0, A1, A2, A3);
#pragma unroll
                for (int j = 0; j < 2; ++j) { S[j][kt] = MFMA16(A0, VB[j][0], S[j][kt]); S[j][kt + 1] = MFMA16(A2, VB[j][0], S[j][kt + 1]); }
#pragma unroll
                for (int j = 0; j < 2; ++j) { S[j][kt] = MFMA16(A1, VB[j][1], S[j][kt]); S[j][kt + 1] = MFMA16(A3, VB[j][1], S[j][kt + 1]); }
#pragma unroll
                for (int j = 0; j < 2; ++j) { S[j][kt] = S[j][kt] * g0; S[j][kt + 1] = S[j][kt + 1] * g1; } }
            LBAR();
            if (OUT) final_pass(m0, prevh);
        }
    } else {
        const int ht = F.tid - 256;
        const unsigned hoff = (unsigned)((ht >> 4) * 1024 + (ht & 15) * 8) * 2u;
        const unsigned aoff = (unsigned)(ht >> 4) * 32u + 4u, aoffl = (unsigned)(ht & 63) * 32u;
        const f32x2* ABd = wsp<f32x2>(F, WS_AB) + (size_t)dir * MT * 4 + h;
        const bf16* vbase = wsp<bf16>(F, model == 0 ? WS_VM : WS_VG) + h * 256 + half * 128;
        struct SR { u32x4 q[4], k[4], v[4]; float be[4]; f32x2 ab; float ge; };
        SR R;
        auto issue = [&](const int ic_) {
            const int c_ = seg_chunk(seg, dir, ic_), ci_ = seg < 0 ? 256 + b * 4 + c_ : b * 128 + c_, m0_ = chunk_row0(ci_);
            const unsigned char* abr = (const unsigned char*)(ABd + (size_t)m0_ * 4);
            { const float* abp = (const float*)(abr + aoffl); R.ab.x = abp[0]; R.ab.y = abp[1]; }
            const float* gp = model == 0 ? wsp<float>(F, WS_GENDM) + ((size_t)dir * NCHUNK + ci_) * 4 + h : wsp<float>(F, WS_GENDG) + ((size_t)dir * NCHUNK + ci_) * 512 + h * 128 + ((ht - 64) & 127);
            R.ge = *gp;
            const long long qoff = model == 0 ? (long long)WS_QKMC : (m0_ < M_LAT ? 0ll : (long long)WS_QKGTC + ((long long)dir * M_CTX - M_LAT) * 2048);
            const unsigned char* qbb = (model == 1 && m0_ < M_LAT) ? (const unsigned char*)F.out + (size_t)dir * M_LAT * 2048 : (const unsigned char*)F.ws + qoff;
            const unsigned char* qr = qbb + (size_t)m0_ * 2048 + h * 256;
            const unsigned char* vr = (const unsigned char*)(vbase + (size_t)m0_ * 1024);
#pragma unroll
            for (int i = 0; i < 4; ++i) { const unsigned o = hoff + (unsigned)i * 16u * 2048u;
                if (OUT) R.q[i] = *(const u32x4*)(qr + o);
                R.k[i] = *(const u32x4*)(qr + 1024 + o); R.v[i] = *(const u32x4*)(vr + o); R.be[i] = *(const float*)(abr + aoff + (unsigned)i * 16u * 32u); }
        };
        const int ti = sw;
        const unsigned fra = lb + L_N + 2048 + (li == 1 ? 128u : 0u) + 16u * lg;
        const unsigned nfa = lb + L_N + 2048 + 256 + (li == 1 ? 256u : 0u) + 16u * lg;
        issue(0);
        for (int ic = 0; ic < nch; ++ic) {
            const int m0 = chunk_m0(ic);
            if (model == 0 && ht < 64) { const float be = R.ab.y; nb[320 + ht] = R.ab.x;
                const unsigned hi = pkbf(be, be) & 0xffffu; nbh[ht] = (unsigned short)hi; nbh[64 + ht] = (unsigned short)(pkbf(be - bflo(hi), 0.f) & 0xffffu); }
            if (ht >= 64 && ht < 192) nb[128 + ht - 64] = R.ge;
#pragma unroll
            for (int i = 0; i < 4; ++i) { const int p = ht + i * 256, r = p >> 4, cp = p & 15;
                const unsigned o = offb(r, cp);
                if (OUT) *(LAS u32x4*)(lds + M_AQ + o) = R.q[i];
                *(LAS u32x4*)(lds + M_AK + o) = R.k[i];
                u32x4 v = R.v[i];
                if (model == 0) { const float be = R.be[i];
                    v.x = pkbf(bflo(v.x) * be, bfhi(v.x) * be); v.y = pkbf(bflo(v.y) * be, bfhi(v.y) * be); v.z = pkbf(bflo(v.z) * be, bfhi(v.z) * be); v.w = pkbf(bflo(v.w) * be, bfhi(v.w) * be); }
                *(LAS u32x4*)(lds + M_VP + o) = v; }
            LBAR();
            u32x4 prevh[2] = {{0u, 0u, 0u, 0u}, {0u, 0u, 0u, 0u}};
            if (OUT) {
#pragma unroll
                for (int i = 0; i < 2; ++i) prevh[i] = *(const u32x4*)((const unsigned char*)(HS + (size_t)m0 * 1024 + h * 256 + half * 128) + (i == 0 ? poff0 : poff1) * (unsigned)dir);
                ptile(ti, 0);
            }
            if (ic + 1 < nch) issue(ic + 1);
            unsigned rowl = rowb, tr0l = trb0, tr1l = trb1; asm volatile("" : "+v"(rowl), "+v"(tr0l), "+v"(tr1l));
            bf16x8 BB0, BB1;
            { u32x4 z = {0u, 0u, 0u, 0u}; BB0 = __builtin_bit_cast(bf16x8, z); BB1 = BB0; }
            if (model == 0) { u32x4 f0 = *(const LAS u32x4*)(uintptr_t)fra, f1 = *(const LAS u32x4*)(uintptr_t)(fra + 64u); const u32x4 z = {0u, 0u, 0u, 0u};
                if (li > 1) { f0 = z; f1 = z; } BB0 = __builtin_bit_cast(bf16x8, f0); BB1 = __builtin_bit_cast(bf16x8, f1); }
            f32x4 dq = {0.f, 0.f, 0.f, 0.f};
            if (OUT && model == 0) {
                bf16x8 pa[4]; u32x4 nf[4]; const u32x4 z = {0u, 0u, 0u, 0u};
#pragma unroll
                for (int kk = 0; kk < 4; ++kk) { pa[kk] = *(const LAS bf16x8*)(uintptr_t)(lb + (rowl ^ ((unsigned)kk << 6)) + M_AQ + 4096u * ti); nf[kk] = *(const LAS u32x4*)(uintptr_t)(nfa + 64u * kk); if (li > 1) nf[kk] = z; }
#pragma unroll
                for (int kk = 0; kk < 4; ++kk) dq = MFMA16(pa[kk], __builtin_bit_cast(bf16x8, nf[kk]), dq);
            }
            f32x4 nacc0 = {0.f, 0.f, 0.f, 0.f}, nacc1 = nacc0;
            if (model == 0) { bf16x8 A0, A1, A2, A3;
                tr_frag4<M_AK>(lb + (tr0l ^ ((unsigned)(2 * ti) << 5)), lb + (tr1l ^ ((unsigned)(2 * ti) << 5)), lb + (tr0l ^ ((unsigned)(2 * ti + 1) << 5)), lb + (tr1l ^ ((unsigned)(2 * ti + 1) << 5)), A0, A1, A2, A3);
                nacc0 = MFMA16(A0, BB0, nacc0); nacc0 = MFMA16(A1, BB1, nacc0); nacc1 = MFMA16(A2, BB0, nacc1); nacc1 = MFMA16(A3, BB1, nacc1); }
            float nnew[8] = {0.f, 0.f, 0.f, 0.f, 0.f, 0.f, 0.f, 0.f};
            if (model == 0) { const f32x4 no0 = *(const LAS f32x4*)(nb + 32 * ti + 4 * lg), no1 = *(const LAS f32x4*)(nb + 32 * ti + 16 + 4 * lg), gw0 = *(const LAS f32x4*)(nb + 128 + 32 * ti + 4 * lg), gw1 = *(const LAS f32x4*)(nb + 128 + 32 * ti + 16 + 4 * lg);
#pragma unroll
                for (int r = 0; r < 4; ++r) { nnew[r] = gw0[r] * (no0[r] + nacc0[r] + __shfl_xor(nacc0[r], 1)); nnew[4 + r] = gw1[r] * (no1[r] + nacc1[r] + __shfl_xor(nacc1[r], 1)); } }
            if (OUT) {
                LBAR();
                if (model == 0) { f32x4 dp = dq;
                    const bf16x8 p0 = *(const LAS bf16x8*)(uintptr_t)(pra0 + 2048u * ti), p1 = *(const LAS bf16x8*)(uintptr_t)(pra1 + 2048u * ti);
                    if (dir == 0 || ti < 2) dp = MFMA16(p0, BB0, dp);
                    if (dir == 1 || ti >= 2) dp = MFMA16(p1, BB1, dp);
#pragma unroll
                    for (int r = 0; r < 4; ++r) { const float v = dp[r] + __shfl_xor(dp[r], 1); const float al = nb[320 + 16 * ti + 4 * lg + r];
                        if (li == 0) nb[384 + 16 * ti + 4 * lg + r] = al / fmaxf(al * fabsf(v), 1.f); } }
            }
            LBAR();
            if (model == 0 && li == 0) {
#pragma unroll
                for (int j = 0; j < 2; ++j) { const int dk0 = 32 * ti + 16 * j + 4 * lg; const float* nn = nnew + 4 * j;
                    f32x4 nv = {nn[0], nn[1], nn[2], nn[3]}; *(LAS f32x4*)(nb + dk0) = nv;
                    u32x2 hv, lv; const unsigned h0 = pkbf(nn[0], nn[1]), h1 = pkbf(nn[2], nn[3]); hv.x = h0; hv.y = h1;
                    lv.x = pkbf(nn[0] - bflo(h0), nn[1] - bfhi(h0)); lv.y = pkbf(nn[2] - bflo(h1), nn[3] - bfhi(h1));
                    *(LAS u32x2*)(nbh + 128 + dk0) = hv; *(LAS u32x2*)(nbh + 256 + dk0) = lv; } }
            if (OUT) final_pass(m0, prevh);
        }
    }
}
__device__ __forceinline__ void p4m_scan_local(Frame& F) {
    LAS float* nb = (LAS float*)(F.lds + L_N);
    for (int it0 = F.bid; it0 < 32 * 8 * 2; it0 += F.G) {
        const int it = (F.G == 256) ? (it0 & ~255) | ((((((it0 & 255) >> 4) << 3) | (it0 & 7)) << 1) | ((it0 >> 3) & 1)) : it0;
        const int half = it & 1, slot = (it >> 1) & 7, sc = it >> 4, seg = slot - 1;
        const int dir = sc & 1, h = (sc >> 1) & 3, b = (sc >> 3) & 1, model = sc >> 4;
        f32x4 S[2][8];
#pragma unroll
        for (int j = 0; j < 2; ++j)
#pragma unroll
            for (int kt = 0; kt < 8; ++kt) S[j][kt] = (f32x4){0.f, 0.f, 0.f, 0.f};
        __syncthreads();
        if (F.tid < 128) nb[F.tid] = 0.f;
        float gacc = 1.f;
        mscan_run<false>(F, model, b, h, dir, half, seg, S, gacc);
        __syncthreads();
        if (F.wave < 4) {
#pragma unroll
            for (int j = 0; j < 2; ++j) { unsigned so = (unsigned)((2 * F.wave + j) * 512 + F.lane) * 8u; asm volatile("" : "+v"(so));
                bf16* st = (bf16*)((unsigned char*)mstate_ptr(F, sc, slot, half) + so);
#pragma unroll
                for (int kt = 0; kt < 8; ++kt) { u32x2 v; v.x = pkbf(S[j][kt][0], S[j][kt][1]); v.y = pkbf(S[j][kt][2], S[j][kt][3]); *(u32x2*)(st + kt * 256) = v; } } }
        if (half == 0 && F.tid < 128) { wsp<float>(F, WS_NST)[(sc * 8 + slot) * 128 + F.tid] = nb[F.tid]; wsp<float>(F, WS_GSEG)[(sc * 8 + slot) * 128 + F.tid] = gacc; }
    }
}
__device__ __forceinline__ void p5m_scan_out(Frame& F) {
    LAS float* nb = (LAS float*)(F.lds + L_N);
    for (int it0 = F.bid; it0 < 2 * 2 * 4 * 8 * 2; it0 += F.G) {
        const int it = (F.G == 256) ? ((((it0 >> 4) << 3) | (it0 & 7)) << 1) | ((it0 >> 3) & 1) : it0;
        const int half = it & 1, seg = (it >> 1) & 7, h = (it >> 4) & 3, b = (it >> 6) & 1, model = it >> 7;
        for (int dir = 0; dir < 2; ++dir) {
            const int sc = ((model * 2 + b) * 4 + h) * 2 + dir, s = dir == 0 ? seg : 7 - seg;
            f32x4 S[2][8];
#pragma unroll
            for (int j = 0; j < 2; ++j)
#pragma unroll
                for (int kt = 0; kt < 8; ++kt) S[j][kt] = (f32x4){0.f, 0.f, 0.f, 0.f};
            float nn = 0.f;
            for (int slot = 0; slot <= s; ++slot) {
                const float* gs = wsp<float>(F, WS_GSEG) + (sc * 8 + slot) * 128;
                const float gv = gs[F.tid & 127], nv = wsp<float>(F, WS_NST)[(sc * 8 + slot) * 128 + (F.tid & 127)];
                if (F.wave < 4) {
                    f32x4 gv4[8];
#pragma unroll
                    for (int kt = 0; kt < 8; ++kt) gv4[kt] = *(const f32x4*)(gs + 16 * kt + 4 * (F.lane >> 4));
#pragma unroll
                    for (int j = 0; j < 2; ++j) { unsigned so = (unsigned)((2 * F.wave + j) * 512 + F.lane) * 8u; asm volatile("" : "+v"(so));
                        const bf16* stp = (const bf16*)((const unsigned char*)mstate_ptr(F, sc, slot, half) + so);
                        u32x2 sv[8];
#pragma unroll
                        for (int kt = 0; kt < 8; ++kt) sv[kt] = *(const u32x2*)(stp + kt * 256);
#pragma unroll
                        for (int kt = 0; kt < 8; ++kt) { const u32x2 v = sv[kt]; f32x4 g4 = gv4[kt]; if (slot == 0) g4 = (f32x4){0.f, 0.f, 0.f, 0.f};
                            S[j][kt][0] = g4[0] * S[j][kt][0] + bflo(v.x); S[j][kt][1] = g4[1] * S[j][kt][1] + bfhi(v.x); S[j][kt][2] = g4[2] * S[j][kt][2] + bflo(v.y); S[j][kt][3] = g4[3] * S[j][kt][3] + bfhi(v.y); } } }
                nn = (slot > 0 ? gv : 0.f) * nn + nv; }
            __syncthreads();
            if (F.tid < 128) { nb[F.tid] = nn; LAS unsigned short* nbh = (LAS unsigned short*)(F.lds + L_N + 2048);
                const unsigned hi = pkbf(nn, nn) & 0xffffu; nbh[128 + F.tid] = (unsigned short)hi; nbh[256 + F.tid] = (unsigned short)(pkbf(nn - bflo(hi), 0.f) & 0xffffu); }
            float gacc = 1.f;
            mscan_run<true>(F, model, b, h, dir, half, s, S, gacc);
        }
    }
}

struct EpiProjB {
    unsigned char* ws; const float* ml_norm; const float* gla_norm;
    __device__ __forceinline__ void operator()(const f32x4 (&acc)[2][2][4][2], const Unit& u, int wr, int wc, int fr, int fq) const {
        const int row0 = u.pm * 256 + wr * 64 + fr, colt = (u.pn & 3) * 256 + wc * 32 + 8 * fq;
        if (u.pn < 8) {
            const int model = u.pn >> 2, head = u.pn & 3;
            bf16* base = (bf16*)(ws + (model == 0 ? WS_QKM : WS_QKG)) + colt;
            const float* nw = (model == 0 ? ml_norm : gla_norm) + colt;
            const float* ssq = (const float*)(ws + WS_SSQ);
            const float gsel = model == 0 ? 0.f : 1.f;
#pragma unroll
            for (int ai = 0; ai < 2; ++ai)
#pragma unroll
                for (int m = 0; m < 4; ++m) { asm volatile("" ::: "memory");
                    const int row = row0 + ai * 128 + m * 16; bf16* rowp = base + (size_t)row * 1024;
                    const f32x2 sq = *(const f32x2*)(ssq + ((size_t)row * 8 + model * 4 + head) * 2);
                    const float rstd = 1.f / sqrtf((sq.x + sq.y) * (1.f / 256.f) + EPS);
                    float one = 1.f; asm volatile("" : "+v"(one));
#pragma unroll
                    for (int bj = 0; bj < 2; ++bj) { const f32x4 a0 = acc[ai][bj][m][0] * one, a1 = acc[ai][bj][m][1] * one;
                        const u32x4 hv = *(const u32x4*)(rowp + bj * 128); const f32x4 n0 = *(const f32x4*)(nw + bj * 128), n1 = *(const f32x4*)(nw + bj * 128 + 4);
                        float hvf[8]; unpack8(hv, hvf); float o[8];
#pragma unroll
                        for (int j = 0; j < 4; ++j) { const float s0 = sigm(a0[j]), s1 = sigm(a1[j]);
                            o[j] = hvf[j] * rstd * n0[j] * (s0 + gsel * (s0 * a0[j] - s0)); o[4 + j] = hvf[4 + j] * rstd * n1[j] * (s1 + gsel * (s1 * a1[j] - s1)); }
                        u32x4 w; w.x = cvt_pk_bf16(o[0], o[1]); w.y = cvt_pk_bf16(o[2], o[3]); w.z = cvt_pk_bf16(o[4], o[5]); w.w = cvt_pk_bf16(o[6], o[7]);
                        *(u32x4*)(rowp + bj * 128) = w; } }
        } else {
            bf16* base = (bf16*)(ws + (u.pn < 12 ? WS_VG : WS_QKMC)) + colt;
#pragma unroll
            for (int ai = 0; ai < 2; ++ai)
#pragma unroll
                for (int m = 0; m < 4; ++m) { bf16* rowp = base + (size_t)(row0 + ai * 128 + m * 16) * 1024;
#pragma unroll
                    for (int bj = 0; bj < 2; ++bj) { const f32x4 a0 = acc[ai][bj][m][0], a1 = acc[ai][bj][m][1];
                        u32x4 w; w.x = pkbf(sigm(a0[0]), sigm(a0[1])); w.y = pkbf(sigm(a0[2]), sigm(a0[3])); w.z = pkbf(sigm(a1[0]), sigm(a1[1])); w.w = pkbf(sigm(a1[2]), sigm(a1[3]));
                        *(u32x4*)(rowp + bj * 128) = w; } }
        }
    }
};
template <int STEP> struct EpiGate {
    unsigned char* ws;
    __device__ __forceinline__ void operator()(const f32x4 (&acc)[2][2][4][2], const Unit& u, int wr, int wc, int fr, int fq) const {
        const int row0 = u.pm * 256 + wr * 64 + fr, colt = u.pn * 256 + wc * 32 + 8 * fq;
        const bf16* sg = (const bf16*)(ws + (STEP == 0 ? WS_VG : WS_QKMC)) + colt; bf16* ty = (bf16*)(ws + WS_VM) + colt;
#pragma unroll
        for (int ai = 0; ai < 2; ++ai)
#pragma unroll
            for (int m = 0; m < 4; ++m) { const size_t ro = (size_t)(row0 + ai * 128 + m * 16) * 1024;
#pragma unroll
                for (int bj = 0; bj < 2; ++bj) { const f32x4 a0 = acc[ai][bj][m][0], a1 = acc[ai][bj][m][1];
                    const u32x4 s = *(const u32x4*)(sg + ro + bj * 128);
                    float r[8] = {bflo(s.x) * a0[0], bfhi(s.x) * a0[1], bflo(s.y) * a0[2], bfhi(s.y) * a0[3], bflo(s.z) * a1[0], bfhi(s.z) * a1[1], bflo(s.w) * a1[2], bfhi(s.w) * a1[3]};
                    if (STEP == 1) { const u32x4 t = *(const u32x4*)(ty + ro + bj * 128);
                        r[0] += bflo(t.x); r[1] += bfhi(t.x); r[2] += bflo(t.y); r[3] += bfhi(t.y); r[4] += bflo(t.z); r[5] += bfhi(t.z); r[6] += bflo(t.w); r[7] += bfhi(t.w); }
                    u32x4 w; w.x = cvt_pk_bf16(r[0], r[1]); w.y = cvt_pk_bf16(r[2], r[3]); w.z = cvt_pk_bf16(r[4], r[5]); w.w = cvt_pk_bf16(r[6], r[7]);
                    *(u32x4*)(ty + ro + bj * 128) = w; } }
    }
};
struct EpiOut {
    const float* x; float* out; const float* modv;
    __device__ __forceinline__ void operator()(const f32x4 (&acc)[2][2][4][2], const Unit& u, int wr, int wc, int fr, int fq) const {
        const int row0 = u.pm * 256 + wr * 64 + fr, colt = u.pn * 256 + wc * 32 + 8 * fq;
        const float* gt = modv + ((u.pm * 256) >> 13) * 6144 + 2048 + colt;
#pragma unroll
        for (int bj = 0; bj < 2; ++bj) { const f32x4 g0 = *(const f32x4*)(gt + bj * 128), g1 = *(const f32x4*)(gt + bj * 128 + 4);
#pragma unroll
            for (int ai = 0; ai < 2; ++ai)
#pragma unroll
                for (int m = 0; m < 4; ++m) { const size_t off = (size_t)(row0 + ai * 128 + m * 16) * 1024 + colt + bj * 128;
                    *(f32x4*)(out + off) = *(const f32x4*)(x + off) + g0 * acc[ai][bj][m][0]; *(f32x4*)(out + off + 4) = *(const f32x4*)(x + off + 4) + g1 * acc[ai][bj][m][1]; } }
    }
};

__device__ __forceinline__ void p9_route(Frame& F) {
    const float* modv = wsp<float>(F, WS_MODV);
    constexpr int WP = 1032;
    LAS unsigned short* Wt = (LAS unsigned short*)F.lds;
    LAS float* lgs = (LAS float*)(F.lds + 40 * WP * 2) + F.wave * 512;
    LAS int* hist = (LAS int*)(F.lds + 40 * WP * 2 + 16384);
    if (F.tid < 32) hist[F.tid] = 0;
    for (int k = F.tid; k < 1024; k += NTHR) {
        const f32x4 wg = *(const f32x4*)(F.w_grp + (size_t)k * 4), w0 = *(const f32x4*)(F.w_rexp + (size_t)k * 16), w1 = *(const f32x4*)(F.w_rexp + (size_t)k * 16 + 4), w2 = *(const f32x4*)(F.w_rexp + (size_t)k * 16 + 8), w3 = *(const f32x4*)(F.w_rexp + (size_t)k * 16 + 12);
        const float wv[20] = {wg[0], wg[1], wg[2], wg[3], w0[0], w0[1], w0[2], w0[3], w1[0], w1[1], w1[2], w1[3], w2[0], w2[1], w2[2], w2[3], w3[0], w3[1], w3[2], w3[3]};
#pragma unroll
        for (int n = 0; n < 20; ++n) { const unsigned hi = pkbf(wv[n], 0.f) & 0xffffu; Wt[n * WP + k] = (unsigned short)hi; Wt[(20 + n) * WP + k] = (unsigned short)(pkbf(wv[n] - bflo(hi), 0.f) & 0xffffu); } }
    __syncthreads();
    int* rexp = (int*)(F.ws + WS_ROUTE + RT_EXP); float* rw = (float*)(F.ws + WS_ROUTE + RT_W); int* rpos = (int*)(F.ws + WS_ROUTE + RT_POS);
    const int gw = F.bid * NW + F.wave, NGW = F.G * NW, li = F.lane & 15, lg = F.lane >> 4;
    const int n1 = 16 + li < 20 ? 16 + li : 19;
    for (int t = gw; t < M_LAT / 16; t += NGW) {
        const int m = 16 * t + li; const float* src = F.out + (size_t)m * D + 8 * lg; const float* mv = modv + (m >> 13) * 6144 + 8 * lg;
        float ss = 0.f;
#pragma unroll 8
        for (int ks = 0; ks < 32; ++ks) { const f32x4 a = *(const f32x4*)(src + 32 * ks), c = *(const f32x4*)(src + 32 * ks + 4); ss += (a.x * a.x + a.y * a.y) + (a.z * a.z + a.w * a.w) + (c.x * c.x + c.y * c.y) + (c.z * c.z + c.w * c.w); }
        ss += __shfl_xor(ss, 16); ss += __shfl_xor(ss, 32);
        const float rstd = 1.f / sqrtf(ss * (1.f / D) + EPS);
        f32x4 acc0 = {0.f, 0.f, 0.f, 0.f}, acc1 = acc0;
        bf16* o = wsp<bf16>(F, WS_H2) + (size_t)m * D + 8 * lg;
#pragma unroll 4
        for (int ks = 0; ks < 32; ++ks) { const int c = 32 * ks;
            const f32x4 xa = *(const f32x4*)(src + c), xb = *(const f32x4*)(src + c + 4);
            const f32x4 ga = *(const f32x4*)(F.g_norm2 + 8 * lg + c), gb = *(const f32x4*)(F.g_norm2 + 8 * lg + c + 4);
            const f32x4 sha = *(const f32x4*)(mv + 3072 + c), shb = *(const f32x4*)(mv + 3072 + c + 4), sca = *(const f32x4*)(mv + 4096 + c), scb = *(const f32x4*)(mv + 4096 + c + 4);
            const f32x4 ha = (xa * rstd) * ga * (sca + 1.f) + sha, hb = (xb * rstd) * gb * (scb + 1.f) + shb;
            u32x4 hi; hi.x = pkbf(ha[0], ha[1]); hi.y = pkbf(ha[2], ha[3]); hi.z = pkbf(hb[0], hb[1]); hi.w = pkbf(hb[2], hb[3]);
            u32x4 lo; lo.x = pkbf(ha[0] - bflo(hi.x), ha[1] - bfhi(hi.x)); lo.y = pkbf(ha[2] - bflo(hi.y), ha[3] - bfhi(hi.y)); lo.z = pkbf(hb[0] - bflo(hi.z), hb[1] - bfhi(hi.z)); lo.w = pkbf(hb[2] - bflo(hi.w), hb[3] - bfhi(hi.w));
            *(u32x4*)(o + c) = hi;
            const bf16x8 Ah = __builtin_bit_cast(bf16x8, hi), Al = __builtin_bit_cast(bf16x8, lo);
            const bf16x8 bh0 = *(const LAS bf16x8*)(Wt + li * WP + c + 8 * lg), bh1 = *(const LAS bf16x8*)(Wt + n1 * WP + c + 8 * lg), bl0 = *(const LAS bf16x8*)(Wt + (20 + li) * WP + c + 8 * lg), bl1 = *(const LAS bf16x8*)(Wt + (20 + n1) * WP + c + 8 * lg);
            acc0 = __builtin_amdgcn_mfma_f32_16x16x32_bf16(Ah, bh0, acc0, 0, 0, 0); acc1 = __builtin_amdgcn_mfma_f32_16x16x32_bf16(Ah, bh1, acc1, 0, 0, 0);
            acc0 = __builtin_amdgcn_mfma_f32_16x16x32_bf16(Al, bh0, acc0, 0, 0, 0); acc1 = __builtin_amdgcn_mfma_f32_16x16x32_bf16(Al, bh1, acc1, 0, 0, 0);
            acc0 = __builtin_amdgcn_mfma_f32_16x16x32_bf16(Ah, bl0, acc0, 0, 0, 0); acc1 = __builtin_amdgcn_mfma_f32_16x16x32_bf16(Ah, bl1, acc1, 0, 0, 0); }
#pragma unroll
        for (int r = 0; r < 4; ++r) { lgs[(4 * lg + r) * 32 + li] = acc0[r]; lgs[(4 * lg + r) * 32 + 16 + li] = acc1[r]; }
        LDS_WAIT(); asm volatile("" ::: "memory");
        if (F.lane < 16) {
            const int mr = 16 * t + F.lane;
            const f32x4 lq0 = *(const LAS f32x4*)(lgs + F.lane * 32), lq1 = *(const LAS f32x4*)(lgs + F.lane * 32 + 4), lq2 = *(const LAS f32x4*)(lgs + F.lane * 32 + 8), lq3 = *(const LAS f32x4*)(lgs + F.lane * 32 + 12), lq4 = *(const LAS f32x4*)(lgs + F.lane * 32 + 16);
            const f32x4 bg = *(const f32x4*)F.b_grp;
            float gl[4] = {lq0[0] + bg[0], lq0[1] + bg[1], lq0[2] + bg[2], lq0[3] + bg[3]};
            int grp = 0; float gmax = gl[0];
#pragma unroll
            for (int q = 1; q < 4; ++q) if (gl[q] > gmax) { gmax = gl[q]; grp = q; }
            float gs = 0.f;
#pragma unroll
            for (int q = 0; q < 4; ++q) gs += expf(gl[q] - gmax);
            const float grp_p = 1.f / gs;
            float el[4];
#pragma unroll
            for (int q = 0; q < 4; ++q) { float v = lq1[q]; v = grp == 1 ? lq2[q] : v; v = grp == 2 ? lq3[q] : v; v = grp == 3 ? lq4[q] : v; asm volatile("" : "+v"(v)); el[q] = v + F.b_rexp[grp * 4 + q]; }
            int i0 = 0; float e0v = el[0];
#pragma unroll
            for (int q = 1; q < 4; ++q) if (el[q] > e0v) { e0v = el[q]; i0 = q; }
            int i1 = -1; float e1v = -3.0e38f;
#pragma unroll
            for (int q = 0; q < 4; ++q) if (q != i0 && el[q] > e1v) { e1v = el[q]; i1 = q; }
            const float e1 = expf(e1v - e0v); const float w0 = grp_p / (1.f + e1), w1 = grp_p * e1 / (1.f + e1);
            const int x0 = grp * 4 + i0, x1 = grp * 4 + i1;
            rexp[2 * mr] = x0; rexp[2 * mr + 1] = x1; rw[2 * mr] = w0; rw[2 * mr + 1] = w1;
            rpos[2 * mr] = __hip_atomic_fetch_add(hist + x0, 1, __ATOMIC_RELAXED, __HIP_MEMORY_SCOPE_WORKGROUP);
            rpos[2 * mr + 1] = __hip_atomic_fetch_add(hist + x1, 1, __ATOMIC_RELAXED, __HIP_MEMORY_SCOPE_WORKGROUP);
        }
        LDS_WAIT(); asm volatile("" ::: "memory");
    }
    __syncthreads();
    if (F.tid < 16) hist[16 + F.tid] = (int)__hip_atomic_fetch_add((unsigned*)(F.ws + WS_CTL) + CW_CNT + 64 * F.tid, (unsigned)hist[F.tid], __ATOMIC_RELAXED, __HIP_MEMORY_SCOPE_AGENT);
    __syncthreads();
    VM_WAIT();
    for (int t = gw; t < M_LAT / 16; t += NGW) if (F.lane < 32) { const int a = 32 * t + F.lane, e = rexp[a], pos = rpos[a] + hist[16 + e]; rpos[a] = pos;
        wsp<int>(F, WS_LTOK)[e * LCAP + pos] = a >> 1; wsp<float>(F, WS_LW)[e * LCAP + pos] = rw[a]; }
    __syncthreads();
    moe_weight_copies<0>(F);
}
__device__ __forceinline__ void moe_layout(Frame& F) {
    LAS int* tab = (LAS int*)(F.lds + LDS_TAB);
    if (F.tid == 0) { int a = 0; for (int e = 0; e < 16; ++e) { const int c = (int)__hip_atomic_load((unsigned*)(F.ws + WS_CTL) + CW_CNT + 64 * e, __ATOMIC_RELAXED, __HIP_MEMORY_SCOPE_AGENT); tab[e] = a; tab[32 + e] = c; a += (c + 255) & ~255; } tab[16] = a; tab[17] = a >> 8; }
    __syncthreads();
}
struct EpiUp {
    unsigned char* ws;
    __device__ __forceinline__ void operator()(const f32x4 (&acc)[2][2][4][2], const Unit& u, int wr, int wc, int fr, int fq) const {
        const int row0 = u.pm * 256 + wr * 64 + fr; bf16* base = (bf16*)(ws + WS_HID) + u.pn * 128 + wc * 32 + 8 * fq;
#pragma unroll
        for (int ai = 0; ai < 2; ++ai)
#pragma unroll
            for (int m = 0; m < 4; ++m) { const f32x4 g0 = acc[ai][0][m][0], g1 = acc[ai][0][m][1], u0 = acc[ai][1][m][0], u1 = acc[ai][1][m][1];
                u32x4 w; w.x = cvt_pk_bf16(siluf(g0[0]) * u0[0], siluf(g0[1]) * u0[1]); w.y = cvt_pk_bf16(siluf(g0[2]) * u0[2], siluf(g0[3]) * u0[3]);
                w.z = cvt_pk_bf16(siluf(g1[0]) * u1[0], siluf(g1[1]) * u1[1]); w.w = cvt_pk_bf16(siluf(g1[2]) * u1[2], siluf(g1[3]) * u1[3]);
                *(u32x4*)(base + (size_t)(row0 + ai * 128 + m * 16) * 512) = w; }
    }
};
struct EpiDown {
    unsigned char* ws; const LAS int* tab;
    __device__ __forceinline__ void operator()(const f32x4 (&acc)[2][2][4][2], const Unit& u, int wr, int wc, int fr, int fq) const {
        const int row0 = u.pm * 256 + wr * 64 + fr; bf16* base = (bf16*)(ws + WS_YROWS) + u.pn * 256 + wc * 32 + 8 * fq;
        const float* lw = (const float*)(ws + WS_LW) + u.e * LCAP - tab[u.e];
#pragma unroll
        for (int ai = 0; ai < 2; ++ai)
#pragma unroll
            for (int m = 0; m < 4; ++m) { const int row = row0 + ai * 128 + m * 16; const float rwt = lw[row];
#pragma unroll
                for (int bj = 0; bj < 2; ++bj) { const f32x4 v0 = acc[ai][bj][m][0] * rwt, v1 = acc[ai][bj][m][1] * rwt;
                    u32x4 w; w.x = cvt_pk_bf16(v0[0], v0[1]); w.y = cvt_pk_bf16(v0[2], v0[3]); w.z = cvt_pk_bf16(v1[0], v1[1]); w.w = cvt_pk_bf16(v1[2], v1[3]);
                    *(u32x4*)(base + (size_t)row * 1024 + bj * 128) = w; } }
    }
};
__device__ __forceinline__ void p13_final(Frame& F) {
    moe_layout(F);
    const LAS int* tab = (const LAS int*)(F.lds + LDS_TAB);
    const float* modv = wsp<float>(F, WS_MODV); const int* rpos = (const int*)(F.ws + WS_ROUTE + RT_POS); const int* rexp = (const int*)(F.ws + WS_ROUTE + RT_EXP); const bf16* Y = wsp<bf16>(F, WS_YROWS);
    const int gw = F.bid * NW + F.wave, NGW = F.G * NW;
    for (int m = gw; m < M_LAT; m += NGW) {
        float* row = F.out + (size_t)m * D; const float* gt = modv + (m >> 13) * 6144 + 5120;
        const bf16* y0 = Y + (size_t)(tab[rexp[2 * m]] + rpos[2 * m]) * 1024; const bf16* y1 = Y + (size_t)(tab[rexp[2 * m + 1]] + rpos[2 * m + 1]) * 1024;
        f32x4 v[4]; float s = 0.f;
#pragma unroll
        for (int j = 0; j < 4; ++j) { const int c = 4 * F.lane + 256 * j; const u32x2 a = *(const u32x2*)(y0 + c), b = *(const u32x2*)(y1 + c); const f32x4 g = *(const f32x4*)(gt + c);
            f32x4 yy; yy.x = bflo(a.x) + bflo(b.x); yy.y = bfhi(a.x) + bfhi(b.x); yy.z = bflo(a.y) + bflo(b.y); yy.w = bfhi(a.y) + bfhi(b.y);
            v[j] = *(const f32x4*)(row + c) + g * yy; s += (v[j].x * v[j].x + v[j].y * v[j].y) + (v[j].z * v[j].z + v[j].w * v[j].w); }
        const float rstd = 1.f / sqrtf(wave_sum(s) * (1.f / D) + EPS);
#pragma unroll
        for (int j = 0; j < 4; ++j) { const int c = 4 * F.lane + 256 * j; *(f32x4*)(row + c) = (v[j] * rstd) * *(const f32x4*)(F.g_final + c); }
    }
}

typedef const Args __attribute__((address_space(4))) * KArgsP;
__device__ __forceinline__ void load_inputs(Frame& F) {
    KArgsP ap = (KArgsP)__builtin_amdgcn_kernarg_segment_ptr();
    asm volatile("" : "+s"(ap));
    F.x = ap->in[0]; F.c = ap->in[1]; F.ctx = ap->in[2]; F.c_ctx = ap->in[3]; F.w_mod = ap->in[4]; F.b_mod = ap->in[5]; F.g_norm1 = ap->in[6]; F.w_in = ap->in[7];
    F.ml_conv = ap->in[8]; F.ml_conv_b = ap->in[9]; F.b_mgate = ap->in[10]; F.ml_norm = ap->in[11]; F.gla_w2 = ap->in[12]; F.gla_b2 = ap->in[13]; F.gla_norm = ap->in[14];
    F.w_proj_m = ap->in[15]; F.w_proj_g = ap->in[16]; F.w_out = ap->in[17]; F.g_norm2 = ap->in[18]; F.w_grp = ap->in[19]; F.b_grp = ap->in[20]; F.w_rexp = ap->in[21]; F.b_rexp = ap->in[22];
    F.w_up = ap->in[23]; F.w_down = ap->in[24]; F.g_final = ap->in[25];
    F.ws = ap->ws; F.out = ap->out;
    int ln = (int)__builtin_amdgcn_mbcnt_hi(~0u, __builtin_amdgcn_mbcnt_lo(~0u, 0u)); asm volatile("" : "+v"(ln)); F.lane = ln; F.tid = F.wave * 64 + ln;
}
constexpr int N_PHASES = 14;
__global__ void __launch_bounds__(NTHR, 2) mk_fwd(Args args) {
    extern __shared__ __attribute__((aligned(16))) unsigned char lds[];
    Frame F;
    F.lds = (LAS unsigned char*)lds; F.MISC = (volatile LAS unsigned*)(F.lds + MISC_OFF);
    F.tid = threadIdx.x; F.lane = F.tid & 63; F.wave = __builtin_amdgcn_readfirstlane(F.tid >> 6); F.G = gridDim.x; F.bid = blockIdx.x;
    F.ws = args.ws; F.out = args.out;
    for (int u = F.tid; u < (LDS_BYTES - LDSCTL_OFF) / 4; u += NTHR) ((LAS unsigned*)(F.lds + LDSCTL_OFF))[u] = 0u;
    __syncthreads();
    const int lo = args.ph_lo, hi = args.ph_hi;
    XcdBarrier bar; bar.bar = (unsigned*)(F.ws + WS_CTL) + CW_BAR; bar.x = 0; bar.st = nullptr;
    if (hi - lo > 1) bar = xcd_barrier_post((unsigned*)(F.ws + WS_CTL) + CW_BAR, F.MISC + 8);
#ifndef PH_MASK
#define PH_MASK 0xFFFF
#endif
#define IN(k) (((PH_MASK >> (k)) & 1) && lo <= (k) && (k) < hi)
#define REPS(k) for (int rep_ = 0; rep_ < (((REP_MASK >> (k)) & 1) ? 2 : 1); ++rep_)
#define SEAM(k) do { if (IN(k) && IN((k) + 1)) xcd_barrier(bar, F.tid); } while (0)
    const int vc = (int)blockIdx.x;
    if (IN(0)) REPS(0) { load_inputs(F); p0_prologue(F); SEAM(0); }
    if (IN(1)) REPS(1) { load_inputs(F); p1_hx(F); p0_weight_copies<0>(F); SEAM(1); }
    if (IN(2)) REPS(2) { load_inputs(F); pg8::DenseSched S; S.init(wsp<bf16>(F, WS_HX), wsp<bf16>(F, WS_WA), MT, NA, D, F.G, vc); EpiProjA E{F.ws, F.b_mgate};
        pg8::gemm_phase<EpiProjA, pg8::DenseSched, true>(F.lds, S, E, F.wave); p0_weight_copies<1>(F, F.G == 256 ? (MT / 256) * (NA / 256) % 256 : 0); SEAM(2); }
    if (IN(3)) REPS(3) { load_inputs(F); p3_prep(F); SEAM(3); }
#if SCAN_SCALAR
    if (IN(4)) REPS(4) { load_inputs(F); p4_scan_local(F); SEAM(4); }
    if (IN(5)) REPS(5) { load_inputs(F); p5_scan_out(F); SEAM(5); }
#else
    if (IN(4)) REPS(4) { load_inputs(F); p4m_scan_local(F); SEAM(4); }
    if (IN(5)) REPS(5) { load_inputs(F); p5m_scan_out(F); SEAM(5); }
#endif
    if (IN(6)) REPS(6) { load_inputs(F); pg8::DenseSched S; S.init(wsp<bf16>(F, WS_HX), wsp<bf16>(F, WS_WB), M_LAT, NB, D, F.G, vc); EpiProjB E{F.ws, F.ml_norm, F.gla_norm};
        pg8::gemm_phase<EpiProjB, pg8::DenseSched, true>(F.lds, S, E, F.wave); SEAM(6); }
    if (IN(7)) REPS(7) { load_inputs(F);
        { pg8::DenseSched S; S.init(wsp<bf16>(F, WS_QKM), wsp<bf16>(F, WS_WPM), M_LAT, D, D, F.G, vc); EpiGate<0> E{F.ws}; pg8::gemm_phase<EpiGate<0>, pg8::DenseSched, false>(F.lds, S, E, F.wave); }
        VM_WAIT(); __syncthreads();
        { pg8::DenseSched S; S.init(wsp<bf16>(F, WS_QKG), wsp<bf16>(F, WS_WPG), M_LAT, D, D, F.G, vc); EpiGate<1> E{F.ws}; pg8::gemm_phase<EpiGate<1>, pg8::DenseSched, false>(F.lds, S, E, F.wave); }
        SEAM(7); }
    if (IN(8)) REPS(8) { load_inputs(F); pg8::DenseSched S; S.init(wsp<bf16>(F, WS_VM), wsp<bf16>(F, WS_WOUT), M_LAT, D, D, F.G, vc); EpiOut E{F.x, F.out, wsp<float>(F, WS_MODV)};
        pg8::gemm_phase<EpiOut, pg8::DenseSched, false>(F.lds, S, E, F.wave); SEAM(8); }
    if (IN(9)) REPS(9) { load_inputs(F); p9_route(F); if (IN(9) && IN(11)) xcd_barrier(bar, F.tid); }
    if (IN(11)) REPS(11) { load_inputs(F); moe_layout(F); pg8::GroupSched<true> S; S.A = wsp<bf16>(F, WS_H2); S.Bt = wsp<bf16>(F, WS_WUP); S.list_tok = wsp<int>(F, WS_LTOK); S.tab = (const LAS int*)(F.lds + LDS_TAB);
        S.K = 1024; S.ntiles = S.tab[17]; S.G = F.G; S.c = vc; EpiUp E{F.ws};
        pg8::gemm_phase<EpiUp, pg8::GroupSched<true>, true>(F.lds, S, E, F.wave); moe_weight_copies<1>(F, F.G == 256 ? (S.ntiles * 4) % 256 : 0); SEAM(11); }
    if (IN(12)) REPS(12) { load_inputs(F); moe_layout(F); pg8::GroupSched<false> S; S.A = wsp<bf16>(F, WS_HID); S.Bt = wsp<bf16>(F, WS_WDN); S.list_tok = nullptr; S.tab = (const LAS int*)(F.lds + LDS_TAB);
        S.K = 512; S.ntiles = S.tab[17]; S.G = F.G; S.c = vc; EpiDown E{F.ws, (const LAS int*)(F.lds + LDS_TAB)};
        pg8::gemm_phase<EpiDown, pg8::GroupSched<false>, true>(F.lds, S, E, F.wave); SEAM(12); }
    if (IN(13)) REPS(13) { load_inputs(F); p13_final(F); }
#undef IN
#undef SEAM
}

extern "C" void kernel_launch(void* const* d_in, const int* in_sizes, int n_in, void* d_out, int out_size, void* d_ws, size_t ws_size, hipStream_t stream) {
    static int grid = 0;
    if (grid == 0) {
        if (n_in != 26 || out_size != M_LAT * D || ws_size < WS_END) { fprintf(stderr, "kernel_launch: unexpected shapes (n_in %d, out %d, ws %zu)\n", n_in, out_size, ws_size); grid = -1; return; }
        int dev = 0, cus = 0, per_cu = 0;
        if (hipGetDevice(&dev) != hipSuccess || hipDeviceGetAttribute(&cus, hipDeviceAttributeMultiprocessorCount, dev) != hipSuccess) { grid = -1; return; }
        if (hipFuncSetAttribute((const void*)mk_fwd, hipFuncAttributeMaxDynamicSharedMemorySize, LDS_BYTES) != hipSuccess) { fprintf(stderr, "kernel_launch: hipFuncSetAttribute failed\n"); grid = -1; return; }
        if (hipOccupancyMaxActiveBlocksPerMultiprocessor(&per_cu, (const void*)mk_fwd, NTHR, LDS_BYTES) != hipSuccess || per_cu < 1) fprintf(stderr, "kernel_launch: occupancy query reports %d\n", per_cu);
        (void)hipGetLastError();
        grid = cus;
    }
    if (grid < 0) return;
    (void)hipMemsetAsync((char*)d_ws + WS_CTL, 0, CTL_ZERO_BYTES, stream);
    Args a{};
    for (int i = 0; i < 26; ++i) a.in[i] = (const float*)d_in[i];
    a.out = (float*)d_out; a.ws = (unsigned char*)d_ws;
#if MK_ONE_LAUNCH
    a.ph_lo = 0; a.ph_hi = N_PHASES;
    hipLaunchKernelGGL(mk_fwd, dim3(grid), dim3(NTHR), LDS_BYTES, stream, a);
#else
    for (int p = 0; p < N_PHASES; ++p) { a.ph_lo = p; a.ph_hi = p + 1; hipLaunchKernelGGL(mk_fwd, dim3(grid), dim3(NTHR), LDS_BYTES, stream, a); }
#endif
}
```

```cpp
#include <hip/hip_runtime.h>
#include <cstdio>
#include <cstdint>

#ifndef SCAN_SCALAR
#define SCAN_SCALAR 0
#endif
#ifndef REP_MASK
#define REP_MASK 0x0
#endif
#ifndef MK_ONE_LAUNCH
#define MK_ONE_LAUNCH 1
#endif

#define LAS __attribute__((address_space(3)))
typedef unsigned short bf16;
typedef short bf16x8 __attribute__((ext_vector_type(8)));
typedef float f32x4 __attribute__((ext_vector_type(4)));
typedef float f32x2 __attribute__((ext_vector_type(2)));
typedef unsigned u32x4 __attribute__((ext_vector_type(4)));
typedef unsigned u32x2 __attribute__((ext_vector_type(2)));

constexpr int D = 1024, BATCH = 2, SEQ = 8192, CTXL = 256;
constexpr int M_LAT = BATCH * SEQ;
constexpr int M_CTX = BATCH * CTXL;
constexpr int MT = M_LAT + M_CTX;
constexpr int NW = 8, NTHR = 512;
constexpr int IN_W = 8240;
constexpr int NA = 4352;
constexpr int NB = 4096;
constexpr int CHUNK = 64, NCH_LAT = SEQ / CHUNK  , NCH_CTX = CTXL / CHUNK  ;
constexpr int NCHUNK = BATCH * NCH_LAT + BATCH * NCH_CTX;
constexpr int NSEG = 8, CPS = NCH_LAT / NSEG;
constexpr int NEXP = 16, DEXP = 512, NROWS_MAX = 36864  ;
constexpr float EPS = 1e-6f;

constexpr size_t MiB = 1u << 20;
constexpr size_t BIG = (size_t)MT * 1024 * 2;
constexpr size_t WS_CTL = 0, CTL_ZERO_BYTES = 1 * MiB;
constexpr size_t WS_MODV = 1 * MiB;
constexpr size_t WS_AB = 2 * MiB;
constexpr size_t WS_GENDM = WS_AB + 1088 * 1024;
constexpr size_t WS_GENDG = 4 * MiB;
constexpr size_t WS_SSQ = WS_GENDG + 1088 * 1024;
constexpr size_t WS_WA = 7 * MiB;
constexpr size_t WS_WB = 16 * MiB;
constexpr size_t WS_WPM = 24 * MiB, WS_WPG = 26 * MiB, WS_WOUT = 28 * MiB;
constexpr size_t WS_GATES = 30 * MiB;
constexpr size_t WS_NST = 35 * MiB;
constexpr size_t WS_GSEG = WS_NST + 256 * 1024;
constexpr size_t WS_ROUTE = 36 * MiB;
constexpr size_t WS_HX = 37 * MiB;
constexpr size_t WS_QKM = WS_HX + BIG;
constexpr size_t WS_VM = WS_QKM + BIG;
constexpr size_t WS_QKG = WS_VM + BIG;
constexpr size_t WS_VG = WS_QKG + BIG;
constexpr size_t WS_QKMC = WS_VG + BIG;
constexpr size_t WS_STATE = WS_QKMC + BIG;
constexpr size_t WS_QKGTC = WS_STATE + 16 * MiB;
constexpr size_t WS_END = WS_QKGTC + 2 * MiB;
static_assert(WS_END <= 256 * MiB, "ws map");
constexpr size_t WS_WUP = WS_HX;
constexpr size_t WS_H2 = 70 * MiB;
constexpr size_t WS_WDN = 103 * MiB;
constexpr size_t WS_HID = 136 * MiB;
constexpr size_t WS_YROWS = 172 * MiB;
constexpr size_t RT_EXP = 0;
constexpr size_t RT_W = 128 * 1024;
constexpr size_t RT_POS = 256 * 1024;
constexpr size_t RT_ROWTOK = 384 * 1024;
constexpr size_t RT_ROWW = 384 * 1024 + 144 * 1024;
constexpr size_t RT_TILE_E = 384 * 1024 + 288 * 1024;
constexpr size_t WS_LTOK = 120 * MiB, WS_LW = 122 * MiB;
constexpr int LCAP = 32768;
constexpr int LDS_TAB = 147456 - 1024 + 768;
constexpr int CW_BAR = 4096;
constexpr int CW_CNT = 8192;

#define LDS_WAIT() asm volatile("s_waitcnt lgkmcnt(0)" ::: "memory")
#define VM_WAIT() asm volatile("s_waitcnt vmcnt(0)" ::: "memory")
__device__ __forceinline__ unsigned f2bf(float f) { unsigned u = __builtin_bit_cast(unsigned, f); return (u + 0x7fffu + ((u >> 16) & 1u)) >> 16; }
typedef __bf16 bf16x2_t __attribute__((ext_vector_type(2)));
__device__ __forceinline__ unsigned pkbf(float lo, float hi) { f32x2 v = {lo, hi}; return __builtin_bit_cast(unsigned, __builtin_convertvector(v, bf16x2_t)); }
__device__ __forceinline__ unsigned pk2(float lo, float hi) { return pkbf(lo, hi); }
__device__ __forceinline__ float bf2f(unsigned short h) { return __builtin_bit_cast(float, (unsigned)h << 16); }
__device__ __forceinline__ float bflo(unsigned w) { return __builtin_bit_cast(float, w << 16); }
__device__ __forceinline__ float bfhi(unsigned w) { return __builtin_bit_cast(float, w & 0xffff0000u); }
__device__ __forceinline__ float sigm(float x) { return __builtin_amdgcn_rcpf(1.f + __expf(-x)); }
__device__ __forceinline__ float siluf(float x) { return x * __builtin_amdgcn_rcpf(1.f + __expf(-x)); }
__device__ __forceinline__ float logsig(float x) { return fminf(x, 0.f) - log1pf(expf(-fabsf(x))); }
__device__ __forceinline__ float wave_sum(float v) {
#pragma unroll
    for (int o = 1; o < 64; o <<= 1) v += __shfl_xor(v, o);
    return v;
}

namespace pg8 {
#define PG8_LAS __attribute__((address_space(3)))
constexpr int BM = 256, BK = 64, HALF = 128, HTB = HALF * BK * 2, STAGE_BYTES = 8 * HTB, NXCD = 8, WGM = 8;
__host__ __device__ __forceinline__ int lds_byte(int r, int c) { const int st = (r >> 4) * 2 + (c >> 5), rr = r & 15, cc = c & 31, ob = rr * 64 + cc * 2; return st * 1024 + (ob ^ (((ob >> 9) & 1) << 5)); }
__host__ __device__ __forceinline__ void stage_rc(int b, int& R, int& C) { const int st = b / 1024, sb = b % 1024, swz = sb ^ (((sb >> 9) & 1) << 5); R = (st >> 1) * 16 + swz / 64; C = (st & 1) * 32 + (swz % 64) / 2; }
__host__ __device__ __forceinline__ int perm32(int rho) { const int n = rho >> 4, i = rho & 15; return 8 * (i >> 2) + 4 * n + (i & 3); }
struct Unit { int pm, pn, e; };
__device__ __forceinline__ unsigned cvt_pk_bf16(float lo, float hi) { return pkbf(lo, hi); }

struct DenseSched {
    static constexpr bool GATHER = false;
    const bf16* A; const bf16* Bt; int K, nM, nN, nwg, G, c;
    __device__ void init(const bf16* A_, const bf16* Bt_, int M, int N, int K_, int G_, int c_) { A = A_; Bt = Bt_; K = K_; nM = M / BM; nN = N / BM; nwg = nM * nN; G = G_; c = c_; }
    __device__ bool next(int i, Unit& u) const {
        const long L = (long)i * G + c; if (L >= nwg) return false;
        int wgid = (int)L; { const int q = nwg / NXCD, r = nwg % NXCD, xcd = wgid % NXCD, off = wgid / NXCD; wgid = (xcd < r ? xcd * (q + 1) : r * (q + 1) + (xcd - r) * q) + off; }
        const int nig = WGM * nN, gid = wgid / nig, fm = gid * WGM, gsz = (nM - fm) < WGM ? (nM - fm) : WGM;
        u.pm = fm + ((wgid % nig) % gsz); u.pn = (wgid % nig) / gsz; u.e = 0; return true;
    }
    __device__ __forceinline__ const char* a_base(const Unit& u) const { return (const char*)A + (size_t)u.pm * BM * K * 2; }
    __device__ __forceinline__ const char* b_base(const Unit& u) const { return (const char*)Bt + (size_t)u.pn * BM * K * 2; }
    __device__ __forceinline__ void a_offs(const Unit&, const int (&R)[2], const int (&C)[2], unsigned (&o)[2][2]) const {
#pragma unroll
        for (int h = 0; h < 2; ++h)
#pragma unroll
            for (int i = 0; i < 2; ++i) o[h][i] = (unsigned)((h * HALF + R[i]) * K + C[i]) * 2u;
    }
};
template <bool GATHER_> struct GroupSched {
    static constexpr bool GATHER = GATHER_;
    const bf16* A; const bf16* Bt; const int* list_tok; const PG8_LAS int* tab; int K, ntiles, G, c;
    __device__ bool next(int i, Unit& u) const {
        long L = (long)i * G + c;
        if (G == 256 && (long)(i + 1) * 256 <= (long)ntiles * 4) { const int xc = c & 7, j = c >> 3; L = (long)i * 256 + (long)(((xc << 3) | (j >> 2)) << 2) + (j & 3); }
        if (L >= (long)ntiles * 4) return false;
        u.pm = (int)(L >> 2); u.pn = (int)(L & 3); int e = 0; while (e < 15 && u.pm * BM >= tab[e + 1]) ++e; u.e = e; return true;
    }
    __device__ __forceinline__ const char* a_base(const Unit& u) const { return GATHER ? (const char*)A : (const char*)A + (size_t)u.pm * BM * K * 2; }
    __device__ __forceinline__ const char* b_base(const Unit& u) const { return (const char*)Bt + ((size_t)u.e * 1024 + (size_t)u.pn * BM) * K * 2; }
    __device__ __forceinline__ void a_offs(const Unit& u, const int (&R)[2], const int (&C)[2], unsigned (&o)[2][2]) const {
        const int pos0 = u.pm * BM - tab[u.e], cnt = tab[32 + u.e];
#pragma unroll
        for (int h = 0; h < 2; ++h)
#pragma unroll
            for (int i = 0; i < 2; ++i) {
                int row = h * HALF + R[i];
                if (GATHER) { const int pos = pos0 + row; const int pc = pos < cnt ? pos : 0; const int tk = list_tok[u.e * 32768 + pc]; row = pos < cnt ? tk : 0; }
                o[h][i] = (unsigned)(row * K + C[i]) * 2u; }
    }
};

template <class Epi, class Sched, bool ALIGN_EPI>
__device__ __forceinline__ void gemm_phase(PG8_LAS unsigned char* lds, const Sched& S, const Epi& E, const int wave_id) {
    int ln_ = (int)__builtin_amdgcn_mbcnt_hi(~0u, __builtin_amdgcn_mbcnt_lo(~0u, 0u)); asm volatile("" : "+v"(ln_));
    const int wid = wave_id, lane = ln_, tid = wid * 64 + lane, wr = wid >> 2, wc = wid & 3, fr = lane & 15, fq = lane >> 4;
    const int K = S.K, nt = K / BK;
    int Rr[2], Cc[2]; unsigned voffB[2];
#pragma unroll
    for (int i = 0; i < 2; ++i) { stage_rc(tid * 16 + i * 8192, Rr[i], Cc[i]); const int Rb = (Rr[i] & ~31) + perm32(Rr[i] & 31); voffB[i] = (unsigned)(Rb * K + Cc[i]) * 2u; }
    const size_t kstep = (size_t)(BK * 2);
    const size_t hstep = (size_t)HALF * K * 2;
    const unsigned ldsw = (unsigned)wid * 1024u;
    const int aoff = lds_byte(wr * 64 + fr, fq * 8), boff = lds_byte(wc * 32 + fr, fq * 8);
#define PG8_SA(b, h) (((b) * 2 + (h)) * HTB)
#define PG8_SB(b, h) ((4 + (b) * 2 + (h)) * HTB)
#define PG8_STAGE(bufoff, gbase, voff) do { _Pragma("unroll") for (int _i = 0; _i < 2; ++_i) \
        __builtin_amdgcn_global_load_lds((const unsigned*)((const char*)(gbase) + (voff)[_i]), (PG8_LAS unsigned*)(lds + (bufoff) + ldsw + _i * 8192), 16, 0, 0); } while (0)
#define PG8_LDA(dst, b, h) do { _Pragma("unroll") for (int m = 0; m < 4; ++m) _Pragma("unroll") for (int k = 0; k < 2; ++k) dst[m][k] = *(const PG8_LAS bf16x8*)(lds + PG8_SA(b, h) + aoff + m * 2048 + k * 1024); } while (0)
#define PG8_LDB(dst, b, h) do { _Pragma("unroll") for (int n = 0; n < 2; ++n) _Pragma("unroll") for (int k = 0; k < 2; ++k) dst[n][k] = *(const PG8_LAS bf16x8*)(lds + PG8_SB(b, h) + boff + n * 2048 + k * 1024); } while (0)
#define PG8_MMA(ai, bj, At, Bt) do { __builtin_amdgcn_s_setprio(1); _Pragma("unroll") for (int m = 0; m < 4; ++m) _Pragma("unroll") for (int n = 0; n < 2; ++n) _Pragma("unroll") for (int k = 0; k < 2; ++k) \
        acc[ai][bj][m][n] = __builtin_amdgcn_mfma_f32_16x16x32_bf16(Bt[n][k], At[m][k], acc[ai][bj][m][n], 0, 0, 0); __builtin_amdgcn_s_setprio(0); } while (0)
#define PG8_WAIT_V(n) asm volatile("s_waitcnt vmcnt(" #n ")" ::: "memory")
#define PG8_WAIT_L(n) asm volatile("s_waitcnt lgkmcnt(" #n ")" ::: "memory")
#define PG8_BAR __builtin_amdgcn_s_barrier()
#define PG8_SCHED __builtin_amdgcn_sched_barrier(0)
    Unit cur, nxt; int ui = 0;
    if (!S.next(0, cur)) return;
    unsigned ao[2][2], nao[2][2];
    S.a_offs(cur, Rr, Cc, ao);
    f32x4 acc[2][2][4][2];
#pragma unroll
    for (int a = 0; a < 2; ++a)
#pragma unroll
        for (int b = 0; b < 2; ++b)
#pragma unroll
            for (int m = 0; m < 4; ++m)
#pragma unroll
                for (int n = 0; n < 2; ++n) acc[a][b][m][n] = (f32x4){0.f, 0.f, 0.f, 0.f};
    bf16x8 At[4][2], B0[2][2], B1[2][2];
    const char* cA = S.a_base(cur); const char* cB = S.b_base(cur);
    PG8_STAGE(PG8_SB(0, 0), cB, voffB); PG8_STAGE(PG8_SB(0, 1), cB + hstep, voffB); PG8_STAGE(PG8_SA(0, 0), cA, ao[0]); PG8_STAGE(PG8_SA(0, 1), cA, ao[1]);
    if (wr == 1) PG8_BAR;
    PG8_WAIT_V(2); PG8_BAR;
    PG8_STAGE(PG8_SB(1, 0), cB + kstep, voffB); PG8_STAGE(PG8_SA(1, 0), cA + kstep, ao[0]); PG8_STAGE(PG8_SB(1, 1), cB + hstep + kstep, voffB);
    PG8_WAIT_V(6); PG8_BAR;
    for (;;) {
        const bool has_next = S.next(ui + 1, nxt);
        if (Sched::GATHER && has_next) S.a_offs(nxt, Rr, Cc, nao);
        else {
#pragma unroll
            for (int h = 0; h < 2; ++h)
#pragma unroll
                for (int i = 0; i < 2; ++i) nao[h][i] = ao[h][i]; }
        const char* nA = has_next ? S.a_base(nxt) : cA; const char* nB = has_next ? S.b_base(nxt) : cB;
        for (int t = 0; t < nt; t += 2) {
            const bool last = (t == nt - 2);
            const char* a1 = cA + (size_t)(t + 1) * kstep;
            const char* a2 = last ? nA : cA + (size_t)(t + 2) * kstep; const char* b2 = last ? nB : cB + (size_t)(t + 2) * kstep;
            const char* a3 = a2 + kstep; const char* b3 = b2 + kstep;
            unsigned o2[2][2];
#pragma unroll
            for (int h = 0; h < 2; ++h)
#pragma unroll
                for (int i = 0; i < 2; ++i) o2[h][i] = (Sched::GATHER && last) ? nao[h][i] : ao[h][i];
            PG8_LDB(B0, 0, 0); PG8_LDB(B1, 0, 1); PG8_SCHED; PG8_LDA(At, 0, 0); PG8_STAGE(PG8_SA(1, 1), a1, ao[1]);
            PG8_WAIT_V(8); PG8_WAIT_L(0); PG8_BAR; PG8_MMA(0, 0, At, B0); PG8_MMA(0, 1, At, B1); PG8_BAR; PG8_SCHED;
            PG8_LDA(At, 0, 1); PG8_STAGE(PG8_SB(0, 0), b2, voffB); PG8_STAGE(PG8_SB(0, 1), b2 + hstep, voffB); PG8_STAGE(PG8_SA(0, 0), a2, o2[0]);
            PG8_WAIT_V(8); PG8_WAIT_L(0); PG8_BAR; PG8_MMA(1, 0, At, B0); PG8_MMA(1, 1, At, B1); PG8_BAR; PG8_SCHED;
            PG8_LDB(B0, 1, 0); PG8_LDB(B1, 1, 1); PG8_SCHED; PG8_LDA(At, 1, 0); PG8_STAGE(PG8_SA(0, 1), a2, o2[1]);
            PG8_WAIT_V(8); PG8_WAIT_L(0); PG8_BAR; PG8_MMA(0, 0, At, B0); PG8_MMA(0, 1, At, B1); PG8_BAR; PG8_SCHED;
            PG8_LDA(At, 1, 1); PG8_STAGE(PG8_SB(1, 0), b3, voffB); PG8_STAGE(PG8_SB(1, 1), b3 + hstep, voffB); PG8_STAGE(PG8_SA(1, 0), a3, o2[0]);
            PG8_WAIT_V(8); PG8_WAIT_L(0); PG8_BAR; PG8_MMA(1, 0, At, B0); PG8_MMA(1, 1, At, B1); PG8_BAR; PG8_SCHED;
        }
        if constexpr (ALIGN_EPI) { if (wr == 0) PG8_BAR; }
        { int fr_ = fr, fq_ = fq; asm volatile("" : "+v"(fr_), "+v"(fq_));
          E(acc, cur, wr, wc, fr_, fq_); }
        if (!has_next) break;
#pragma unroll
        for (int a = 0; a < 2; ++a)
#pragma unroll
            for (int b = 0; b < 2; ++b)
#pragma unroll
                for (int m = 0; m < 4; ++m)
#pragma unroll
                    for (int n = 0; n < 2; ++n) acc[a][b][m][n] = (f32x4){0.f, 0.f, 0.f, 0.f};
        cur = nxt; cA = nA; cB = nB; ++ui;
#pragma unroll
        for (int h = 0; h < 2; ++h)
#pragma unroll
            for (int i = 0; i < 2; ++i) ao[h][i] = nao[h][i];
        if constexpr (ALIGN_EPI) { if (wr == 1) PG8_BAR; }
    }
    PG8_WAIT_V(0);
    if constexpr (!ALIGN_EPI) { if (wr == 0) PG8_BAR; }
    PG8_BAR;
#undef PG8_SA
#undef PG8_SB
#undef PG8_STAGE
#undef PG8_LDA
#undef PG8_LDB
#undef PG8_MMA
#undef PG8_WAIT_V
#undef PG8_WAIT_L
#undef PG8_BAR
#undef PG8_SCHED
}
}
using pg8::Unit; using pg8::cvt_pk_bf16;

#define XB_TMO      128
#define XB_XCNT(j)  (256  + 64 * (j))
#define XB_XSUB(j)  (1280 + 64 * (j))
#define XB_XGEN(j)  (2304 + 64 * (j))
#define XB_TOP      3328
#define XB_TOPGEN   3392
#define XCD_BAR_WORDS 3456
#define XB_SPIN_CAP (1u << 18)
__device__ __forceinline__ unsigned xb_ld(unsigned* p)              { return __hip_atomic_load(p, __ATOMIC_RELAXED, __HIP_MEMORY_SCOPE_AGENT); }
__device__ __forceinline__ unsigned xb_add(unsigned* p, unsigned v) { return __hip_atomic_fetch_add(p, v, __ATOMIC_RELAXED, __HIP_MEMORY_SCOPE_AGENT); }
__device__ __forceinline__ unsigned xb_xcc_id() { return (unsigned)__builtin_amdgcn_s_getreg((3 << 11) | 20) & 0xFu; }
#define XB_SPIN(cond, bar) do { unsigned _sp = 0; while (cond) { __builtin_amdgcn_s_sleep(1); \
    if ((++_sp & 255u) == 0u) { if (xb_ld(&(bar)[XB_TMO])) break; if (_sp > XB_SPIN_CAP) { atomicAdd(&(bar)[XB_TMO], 1u); break; } } } } while (0)
struct XcdBarrier { unsigned* bar; unsigned x; volatile LAS unsigned* st; };
__device__ __forceinline__ XcdBarrier xcd_barrier_post(unsigned* bar, volatile LAS unsigned* st) {
    XcdBarrier b; b.bar = bar; b.x = xb_xcc_id(); b.st = st;
    if (threadIdx.x == 0) (void)xb_add(&bar[XB_XCNT(b.x)], 1u);
    return b;
}
__device__ __forceinline__ void xcd_barrier_complete(unsigned* bar, unsigned x, unsigned& nloc, unsigned& nx) {
    const unsigned G = gridDim.x * gridDim.y * gridDim.z;
    unsigned sum, cnt, mine, sp = 0u;
    for (;;) {
        sum = 0u; cnt = 0u; mine = 0u;
#pragma unroll
        for (unsigned j = 0; j < 16; ++j) { const unsigned c = xb_ld(&bar[XB_XCNT(j)]); sum += c; cnt += (c > 0u) ? 1u : 0u; mine = (j == x) ? c : mine; }
        if (sum == G) break;
        __builtin_amdgcn_s_sleep(1);
        if ((++sp & 255u) == 0u) { if (xb_ld(&bar[XB_TMO])) break; if (sp > XB_SPIN_CAP) { atomicAdd(&bar[XB_TMO], 1u); break; } }
    }
    nloc = mine > 0u ? mine : 1u; nx = cnt > 0u ? cnt : 1u;
}
__device__ __forceinline__ void xcd_barrier(const XcdBarrier& b, const int tid) {
    asm volatile("s_waitcnt vmcnt(0)" ::: "memory");
    __syncthreads();
    if (tid == 0) {
        unsigned* bar = b.bar;
        __builtin_amdgcn_s_waitcnt(0);
        unsigned nloc = b.st[0], nx = b.st[1];
        if (nloc == 0u) { xcd_barrier_complete(bar, b.x, nloc, nx); b.st[0] = nloc; b.st[1] = nx; }
        const unsigned old = xb_add(&bar[XB_XSUB(b.x)], 1u);
        const unsigned gen = old / nloc;
        if (old + 1u == (gen + 1u) * nloc) {
            __builtin_amdgcn_fence(__ATOMIC_RELEASE, "agent");
            asm volatile("s_waitcnt vmcnt(0)" ::: "memory");
            const unsigned og = xb_add(&bar[XB_TOP], 1u);
            const unsigned tg = og / nx;
            if (og + 1u == (tg + 1u) * nx) xb_add(&bar[XB_TOPGEN], 1u);
            else XB_SPIN(xb_ld(&bar[XB_TOPGEN]) == tg, bar);
            __builtin_amdgcn_fence(__ATOMIC_ACQUIRE, "agent");
            xb_add(&bar[XB_XGEN(b.x)], 1u);
            asm volatile("s_waitcnt vmcnt(0)" ::: "memory");
        } else {
            XB_SPIN(xb_ld(&bar[XB_XGEN(b.x)]) == gen, bar);
            __builtin_amdgcn_fence(__ATOMIC_ACQUIRE, "agent");
            asm volatile("s_waitcnt vmcnt(0)" ::: "memory");
        }
    }
    __syncthreads();
}

constexpr int RING_BYTES = 131072;
constexpr int LDS_BYTES = 147456;
constexpr int LDSCTL_OFF = LDS_BYTES - 1024, MISC_OFF = LDSCTL_OFF + 320;

struct Args { const float* in[26]; float* out; unsigned char* ws; int ph_lo, ph_hi; };
struct Frame {
    LAS unsigned char* lds; volatile LAS unsigned* MISC;
    int tid, lane, wave, G, bid;
    unsigned char* ws; float* out;
    const float *x, *c, *ctx, *c_ctx, *w_mod, *b_mod, *g_norm1, *w_in, *ml_conv, *ml_conv_b, *b_mgate, *ml_norm, *gla_w2, *gla_b2, *gla_norm,
                *w_proj_m, *w_proj_g, *w_out, *g_norm2, *w_grp, *b_grp, *w_rexp, *b_rexp, *w_up, *w_down, *g_final;
};
template <class T> __device__ __forceinline__ T* wsp(const Frame& F, size_t off) { return (T*)(F.ws + off); }

struct TItem { const float* W; bf16* WT; int Nsrc, K, k0, n0, sc; };
__device__ __forceinline__ int map_a(int n) { return n < 2048 ? n : (n < 4096 ? n + 1040 : (n < 4112 ? 3072 + (n - 4096) : (n < 4144 ? 6160 + (n - 4112) : -1))); }
__device__ __forceinline__ int map_b(int n) { return n < 1024 ? 2048 + n : (n < 2048 ? 5136 + (n - 1024) : (n < 3072 ? 6192 + (n - 2048) : 7216 + (n - 3072))); }
__device__ __forceinline__ int map_up(int n) { const int pn = n >> 8, j = n & 255; return j < 128 ? 128 * pn + j : 512 + 128 * pn + (j - 128); }
__device__ __forceinline__ void titem_load(const TItem& t, int lane, f32x4 (&v)[8]) {
    const int scc = t.sc < 0 ? 0 : t.sc;
#pragma unroll
    for (int r = 0; r < 8; ++r) v[r] = *(const f32x4*)(t.W + (size_t)(t.k0 + 8 * r + (lane >> 3)) * t.Nsrc + scc);
}
__device__ __forceinline__ void titem_store(const TItem& t, int lane, const f32x4 (&v)[8], LAS float* scr) {
    const float z = t.sc < 0 ? 0.f : 1.f;
#pragma unroll
    for (int r = 0; r < 8; ++r) { const int kk = 8 * r + (lane >> 3); LAS float* d = scr + kk * 33 + 4 * (lane & 7); d[0] = v[r][0] * z; d[1] = v[r][1] * z; d[2] = v[r][2] * z; d[3] = v[r][3] * z; }
    LDS_WAIT(); asm volatile("" ::: "memory");
    const int c = lane & 7;
#pragma unroll
    for (int j = 0; j < 4; ++j) { const int n = (lane >> 3) + 8 * j; const LAS float* s = scr + (8 * c) * 33 + n;
        u32x4 o; o.x = pk2(s[0 * 33], s[1 * 33]); o.y = pk2(s[2 * 33], s[3 * 33]); o.z = pk2(s[4 * 33], s[5 * 33]); o.w = pk2(s[6 * 33], s[7 * 33]);
        *(u32x4*)(t.WT + (size_t)(t.n0 + n) * t.K + t.k0 + 8 * c) = o; }
    LDS_WAIT(); asm volatile("" ::: "memory");
}
template <class Dec>
__device__ __forceinline__ void run_transposes(Frame& F, int nitems, Dec dec, const int skip = 0) {
    LAS float* scr = (LAS float*)(F.lds + F.wave * 16384);
    if (F.bid < skip) return;
    const int gw = (F.bid - skip) * NW + F.wave, NGW = (F.G - skip) * NW, last = nitems - 1;
    if (gw >= nitems) return;
    f32x4 va[8], vb[8]; TItem ia, ib;
    ia = dec(gw, F.lane); titem_load(ia, F.lane, va);
    for (int it = gw; it < nitems; it += 2 * NGW) {
        { const int j = it + NGW; ib = dec(j < last ? j : last, F.lane); titem_load(ib, F.lane, vb); }
        titem_store(ia, F.lane, va, scr);
        { const int j = it + 2 * NGW; ia = dec(j < last ? j : last, F.lane); titem_load(ia, F.lane, va); }
        if (it + NGW < nitems) titem_store(ib, F.lane, vb, scr);
    }
}
__device__ __forceinline__ void p0_prologue(Frame& F) {
    LAS float* scr = (LAS float*)(F.lds + F.wave * 16384);
    const int gw = F.bid * NW + F.wave, NGW = F.G * NW;
    if (F.bid < 192) {
        LAS float* red = (LAS float*)(F.lds);
        const int r = F.tid >> 3, c4 = F.tid & 7, col0 = F.bid * 32 + 4 * c4;
        f32x4 a0 = {0.f, 0.f, 0.f, 0.f}, a1 = a0, a2 = a0;
        for (int k = r; k < D; k += 64) {
            const f32x4 w = *(const f32x4*)(F.w_mod + (size_t)k * 6144 + col0);
            const float s0 = siluf(F.c[k]), s1 = siluf(F.c[D + k]), s2 = siluf(F.c_ctx[k]);
            a0 += w * s0; a1 += w * s1; a2 += w * s2; }
#pragma unroll
        for (int j = 0; j < 4; ++j) { red[r * 96 + 0 + 4 * c4 + j] = a0[j]; red[r * 96 + 32 + 4 * c4 + j] = a1[j]; red[r * 96 + 64 + 4 * c4 + j] = a2[j]; }
        __syncthreads();
        if (F.tid < 96) { float s = 0.f; for (int q = 0; q < 64; ++q) s += red[q * 96 + F.tid]; const int rr = F.tid >> 5, j = F.bid * 32 + (F.tid & 31);
            wsp<float>(F, WS_MODV)[rr * 6144 + j] = s + F.b_mod[j]; }
        __syncthreads();
    }
}
template <int PART>
__device__ __forceinline__ void p0_weight_copies(Frame& F, const int skip = 0) {
    constexpr int I_A = (NA / 32) * 16, I_B = (NB / 32) * 16, I_P = (1024 / 32) * 16;
    const float* w_in = F.w_in; const float* wpm = F.w_proj_m; const float* wpg = F.w_proj_g; const float* wo = F.w_out; unsigned char* ws = F.ws;
    run_transposes(F, PART == 0 ? I_A : I_B + 3 * I_P, [=](int it, int lane) {
        TItem t; t.K = D; const int r = PART == 0 ? it : it + I_A;
        const bool isA = r < I_A, isB = !isA && r < I_A + I_B; const int rp = r - I_A - I_B, pi = rp < 0 ? 0 : rp / I_P;
        const int rr = isA ? r : (isB ? r - I_A : rp - pi * I_P);
        t.k0 = 64 * (rr & 15); t.n0 = 32 * (rr >> 4); const int n = t.n0 + 4 * (lane & 7);
        t.W = (isA || isB) ? w_in : (pi == 0 ? wpm : (pi == 1 ? wpg : wo)); t.Nsrc = (isA || isB) ? IN_W : D;
        t.WT = (bf16*)(ws + (isA ? WS_WA : (isB ? WS_WB : (pi == 0 ? WS_WPM : (pi == 1 ? WS_WPG : WS_WOUT)))));
        t.sc = isA ? map_a(n) : (isB ? map_b(n) : n);
        return t; }, skip);
}
template <int PART>
__device__ __forceinline__ void moe_weight_copies(Frame& F, const int skip = 0) {
    constexpr int I_U = (1024 / 32) * 16  , I_D = (1024 / 32) * 8;
    const float* wup = F.w_up; const float* wdn = F.w_down; unsigned char* ws = F.ws;
    run_transposes(F, NEXP * (PART == 0 ? I_U : I_D), [=](int it, int lane) {
        TItem t; constexpr bool up = PART == 0; const int e = it / (up ? I_U : I_D), rr = it % (up ? I_U : I_D);
        t.K = up ? 1024 : 512; t.Nsrc = 1024;
        t.k0 = up ? 64 * (rr & 15) : 64 * (rr & 7); t.n0 = up ? 32 * (rr >> 4) : 32 * (rr >> 3); const int n = t.n0 + 4 * (lane & 7);
        t.W = up ? wup + (size_t)e * 1024 * 1024 : wdn + (size_t)e * 512 * 1024;
        t.WT = up ? (bf16*)(ws + WS_WUP) + (size_t)e * 1024 * 1024 : (bf16*)(ws + WS_WDN) + (size_t)e * 1024 * 512;
        t.sc = up ? map_up(n) : n;
        return t; }, skip);
}

__device__ __forceinline__ void p1_hx(Frame& F) {
    const int gw = F.bid * NW + F.wave, NGW = F.G * NW;
    const float* modv = wsp<float>(F, WS_MODV);
    for (int m = gw; m < MT; m += 2 * NGW) {
        const int m2 = m + NGW < MT ? m + NGW : m;
        const float* src[2] = {m < M_LAT ? F.x + (size_t)m * D : F.ctx + (size_t)(m - M_LAT) * D, m2 < M_LAT ? F.x + (size_t)m2 * D : F.ctx + (size_t)(m2 - M_LAT) * D};
        const float* mv[2] = {modv + (m < M_LAT ? (m >> 13) : 2) * 6144, modv + (m2 < M_LAT ? (m2 >> 13) : 2) * 6144};
        f32x4 v[2][4]; float s[2] = {0.f, 0.f};
#pragma unroll
        for (int r = 0; r < 2; ++r)
#pragma unroll
            for (int j = 0; j < 4; ++j) v[r][j] = *(const f32x4*)(src[r] + 4 * F.lane + 256 * j);
#pragma unroll
        for (int r = 0; r < 2; ++r)
#pragma unroll
            for (int j = 0; j < 4; ++j) s[r] += (v[r][j].x * v[r][j].x + v[r][j].y * v[r][j].y) + (v[r][j].z * v[r][j].z + v[r][j].w * v[r][j].w);
#pragma unroll
        for (int r = 0; r < 2; ++r) {
            const float rstd = 1.f / sqrtf(wave_sum(s[r]) * (1.f / D) + EPS);
            bf16* o = wsp<bf16>(F, WS_HX) + (size_t)(r == 0 ? m : m2) * D;
#pragma unroll
            for (int j = 0; j < 4; ++j) { const int c = 4 * F.lane + 256 * j;
                const f32x4 g = *(const f32x4*)(F.g_norm1 + c), sh = *(const f32x4*)(mv[r] + c), sc = *(const f32x4*)(mv[r] + 1024 + c);
                const f32x4 h = (v[r][j] * rstd) * g * (sc + 1.f) + sh;
                u32x2 w; w.x = pk2(h.x, h.y); w.y = pk2(h.z, h.w); *(u32x2*)(o + c) = w; } }
    }
}

struct EpiProjA {
    unsigned char* ws; const float* b_mgate;
    __device__ __forceinline__ void operator()(const f32x4 (&acc)[2][2][4][2], const Unit& u, int wr, int wc, int fr, int fq) const {
        const int row0 = u.pm * 256 + wr * 64 + fr;
        if (u.pn < 16) {
            bf16* base = (bf16*)(ws + WS_QKM + (size_t)(u.pn >> 2) * BIG) + (u.pn & 3) * 256 + wc * 32 + 8 * fq;
#pragma unroll
            for (int ai = 0; ai < 2; ++ai)
#pragma unroll
                for (int m = 0; m < 4; ++m) { bf16* rowp = base + (size_t)(row0 + ai * 128 + m * 16) * 1024;
#pragma unroll
                    for (int bj = 0; bj < 2; ++bj) { const f32x4 v0 = acc[ai][bj][m][0], v1 = acc[ai][bj][m][1];
                        u32x4 w; w.x = cvt_pk_bf16(v0[0], v0[1]); w.y = cvt_pk_bf16(v0[2], v0[3]); w.z = cvt_pk_bf16(v1[0], v1[1]); w.w = cvt_pk_bf16(v1[2], v1[3]);
                        *(u32x4*)(rowp + bj * 128) = w; } }
        } else if (wc < 2) {
            const int col = wc * 32 + 8 * fq;
            float* g = (float*)(ws + WS_GATES);
            f32x4 b0 = {0.f, 0.f, 0.f, 0.f}, b1 = b0;
            if (col < 16) { b0 = *(const f32x4*)(b_mgate + col); b1 = *(const f32x4*)(b_mgate + col + 4); }
#pragma unroll
            for (int ai = 0; ai < 2; ++ai)
#pragma unroll
                for (int m = 0; m < 4; ++m) { float* rowp = g + (size_t)(row0 + ai * 128 + m * 16) * 64 + col;
                    *(f32x4*)rowp = acc[ai][0][m][0] + b0; *(f32x4*)(rowp + 4) = acc[ai][0][m][1] + b1; }
        }
    }
};

__device__ __forceinline__ int chunk_row0(int ci) { return ci < 256 ? (ci >> 7) * SEQ + (ci & 127) * 64 : M_LAT + ((ci - 256) >> 2) * CTXL + ((ci - 256) & 3) * 64; }
__device__ __forceinline__ bf16* qkgt_row(const Frame& F, int dir, int m) {
    return m < M_LAT ? (bf16*)F.out + ((size_t)dir * M_LAT + m) * 1024 : wsp<bf16>(F, WS_QKGTC) + ((size_t)dir * M_CTX + (m - M_LAT)) * 1024;
}
__device__ __forceinline__ float logsig_fast(float x) { return fminf(x, 0.f) - __logf(1.f + __expf(-fabsf(x))); }
__device__ __forceinline__ void unpack8(const u32x4& v, float (&f)[8]) { f[0] = bflo(v.x); f[1] = bfhi(v.x); f[2] = bflo(v.y); f[3] = bfhi(v.y); f[4] = bflo(v.z); f[5] = bfhi(v.z); f[6] = bflo(v.w); f[7] = bfhi(v.w); }
__device__ __forceinline__ void p3_prep(Frame& F) {
    const bf16* QKM = wsp<bf16>(F, WS_QKM); bf16* QKMC = wsp<bf16>(F, WS_QKMC); const float* GATES = wsp<float>(F, WS_GATES); const bf16* QKG = wsp<bf16>(F, WS_QKG);
    for (int it = F.bid; it < NCHUNK * 3; it += F.G) {
        int tidl = F.tid; asm volatile("" : "+v"(tidl));
        const int lanel = tidl & 63;
        if (it < NCHUNK) {
            const int ci = F.G == 256 ? (it < 256 ? (it & 7) * 33 + (it >> 3) : (it - 256) * 33 + 32) : it, m0 = chunk_row0(ci);
            const int cg = tidl & 127, cq = tidl >> 7, ch = 8 * cg;
            const bool lat = ci < 256; const int c = lat ? (ci & 127) : ((ci - 256) & 3);
            const bool has_up = lat && c > 0, has_dn = lat && c < 127;
            const float osc = ch >= 512 ? 0.08838834764831845f : 1.f;
            f32x4 bz0 = *(const f32x4*)(F.ml_conv_b + ch), bz1 = *(const f32x4*)(F.ml_conv_b + ch + 4);
            f32x4 cw0[9], cw1[9];
#pragma unroll
            for (int q = 0; q < 9; ++q) { cw0[q] = *(const f32x4*)(F.ml_conv + q * 1024 + ch); cw1[q] = *(const f32x4*)(F.ml_conv + q * 1024 + ch + 4); }
#pragma unroll 1
            for (int cb = 0; cb < 8; ++cb) {
                const int c0 = cq * 16 + cb * 2;
                u32x4 in[3][4];
#pragma unroll
                for (int dr = 0; dr < 3; ++dr)
#pragma unroll
                    for (int dc = 0; dc < 4; ++dc) { const int col = c0 - 1 + dc; bool ok; int m;
                        if (lat) { ok = col >= 0 && col <= 63 && (dr != 0 || has_up) && (dr != 2 || has_dn); m = m0 + (dr - 1) * 64 + col; }
                        else { const int t = c * 64 + col; ok = dr == 1 && t >= 0 && t <= 255; m = m0 + col; }
                        const int mc = ok ? m : m0;
                        const u32x4 v = *(const u32x4*)(QKM + (size_t)mc * 1024 + ch);
                        in[dr][dc] = ok ? v : (u32x4){0u, 0u, 0u, 0u}; }
                float acc[2][8];
#pragma unroll
                for (int oc = 0; oc < 2; ++oc) { acc[oc][0] = bz0[0]; acc[oc][1] = bz0[1]; acc[oc][2] = bz0[2]; acc[oc][3] = bz0[3]; acc[oc][4] = bz1[0]; acc[oc][5] = bz1[1]; acc[oc][6] = bz1[2]; acc[oc][7] = bz1[3]; }
#pragma unroll
                for (int dr = 0; dr < 3; ++dr)
#pragma unroll
                    for (int dc = 0; dc < 3; ++dc) { const f32x4 w0 = cw0[dr * 3 + dc], w1 = cw1[dr * 3 + dc];
#pragma unroll
                        for (int oc = 0; oc < 2; ++oc) { float f[8]; unpack8(in[dr][oc + dc], f);
                            acc[oc][0] += w0[0] * f[0]; acc[oc][1] += w0[1] * f[1]; acc[oc][2] += w0[2] * f[2]; acc[oc][3] += w0[3] * f[3]; acc[oc][4] += w1[0] * f[4]; acc[oc][5] += w1[1] * f[5]; acc[oc][6] += w1[2] * f[6]; acc[oc][7] += w1[3] * f[7]; } }
#pragma unroll
                for (int oc = 0; oc < 2; ++oc) { u32x4 o; o.x = pk2(siluf(acc[oc][0]) * osc, siluf(acc[oc][1]) * osc); o.y = pk2(siluf(acc[oc][2]) * osc, siluf(acc[oc][3]) * osc);
                    o.z = pk2(siluf(acc[oc][4]) * osc, siluf(acc[oc][5]) * osc); o.w = pk2(siluf(acc[oc][6]) * osc, siluf(acc[oc][7]) * osc);
                    *(u32x4*)(QKMC + (size_t)(m0 + c0 + oc) * 1024 + ch) = o; }
            }
            {
                const int dir = F.wave >> 2, h = F.wave & 3, m = m0 + lanel;
                const float ip = GATES[(size_t)m * 64 + dir * 8 + h], lf = logsig(GATES[(size_t)m * 64 + dir * 8 + 4 + h]);
                float b = lf;
#pragma unroll
                for (int o = 1; o < 64; o <<= 1) { const float t = dir == 0 ? __shfl_up(b, o) : __shfl_down(b, o); const bool ok = dir == 0 ? (lanel >= o) : (lanel + o < 64); if (ok) b += t; }
                f32x2 ab; ab.x = expf(b); ab.y = expf(ip - b);
                wsp<f32x2>(F, WS_AB)[((size_t)dir * MT + m) * 4 + h] = ab;
                if (lanel == (dir == 0 ? 63 : 0)) wsp<float>(F, WS_GENDM)[((size_t)dir * NCHUNK + ci) * 4 + h] = expf(b);
            }
        } else {
            const int gi0 = it - NCHUNK;
            const int gi = F.G == 256 ? ((((gi0 >> 4) << 3) | (gi0 & 7)) << 1) | ((gi0 >> 3) & 1) : gi0;
            const int ci = gi >> 1, dir = gi & 1, m0 = chunk_row0(ci);
            LAS float* lr = (LAS float*)F.lds;
            LAS float* Bl = (LAS float*)(F.lds + 4096);
            __syncthreads();
            for (int i = tidl; i < 1024; i += NTHR) lr[i] = GATES[(size_t)(m0 + (i >> 4)) * 64 + 16 + dir * 16 + (i & 15)];
            const int ch = tidl;
            f32x2 w2p[8];
#pragma unroll
            for (int r = 0; r < 8; ++r) { w2p[r].x = F.gla_w2[((size_t)dir * 16 + 2 * r) * 512 + ch]; w2p[r].y = F.gla_w2[((size_t)dir * 16 + 2 * r + 1) * 512 + ch]; }
            const float b2 = F.gla_b2[dir * 512 + ch];
            __syncthreads();
            float b = 0.f;
#pragma unroll 1
            for (int i0 = 0; i0 < 64; i0 += 4) {
                f32x4 l[4][4];
#pragma unroll
                for (int u = 0; u < 4; ++u) { const int r = dir == 0 ? i0 + u : 63 - i0 - u;
#pragma unroll
                    for (int q = 0; q < 4; ++q) l[u][q] = *(const LAS f32x4*)(lr + r * 16 + 4 * q); }
                float ls[4];
#pragma unroll
                for (int u = 0; u < 4; ++u) {
                    f32x2 a2 = {b2, 0.f};
#pragma unroll
                    for (int q = 0; q < 4; ++q) { a2 = __builtin_elementwise_fma((f32x2){l[u][q][0], l[u][q][1]}, w2p[2 * q], a2); a2 = __builtin_elementwise_fma((f32x2){l[u][q][2], l[u][q][3]}, w2p[2 * q + 1], a2); }
                    const float xg = a2.x + a2.y;
                    ls[u] = fminf(xg, 0.f) - 0.6931471805599453f * __builtin_amdgcn_logf(1.f + __builtin_amdgcn_exp2f(-1.4426950408889634f * fabsf(xg))); }
#pragma unroll
                for (int u = 0; u < 4; ++u) { const int r = dir == 0 ? i0 + u : 63 - i0 - u; b += ls[u] * (1.f / 16.f); Bl[r * 512 + ch] = b; }
            }
            wsp<float>(F, WS_GENDG)[((size_t)dir * NCHUNK + ci) * 512 + ch] = __expf(b);
            __syncthreads();
            u32x4 vin[16];
            const int cp = tidl & 127, r0 = tidl >> 7; const bool isk = cp >= 64;
            const float sg = isk ? -1.4426950408889634f : 1.4426950408889634f, eoff = isk ? 0.f : -3.5f;
            const bf16* irow = QKG + (size_t)(m0 + r0) * 1024 + cp * 8; bf16* orow = qkgt_row(F, dir, m0) + (size_t)r0 * 1024 + cp * 8;
            const LAS float* brow = Bl + r0 * 512 + 8 * (cp & 63);
#pragma unroll
            for (int j = 0; j < 16; ++j) vin[j] = *(const u32x4*)(irow + (size_t)j * 4096);
#pragma unroll
            for (int j = 0; j < 16; ++j) {
                const u32x4 v = vin[j];
                const f32x4 b0 = *(const LAS f32x4*)(brow + j * 2048), b1 = *(const LAS f32x4*)(brow + j * 2048 + 4);
                float f[8]; unpack8(v, f); float e[8];
#pragma unroll
                for (int q = 0; q < 4; ++q) { e[q] = __builtin_amdgcn_exp2f(__builtin_fmaf(b0[q], sg, eoff)); e[4 + q] = __builtin_amdgcn_exp2f(__builtin_fmaf(b1[q], sg, eoff)); }
                u32x4 o; o.x = pk2(f[0] * e[0], f[1] * e[1]); o.y = pk2(f[2] * e[2], f[3] * e[3]); o.z = pk2(f[4] * e[4], f[5] * e[5]); o.w = pk2(f[6] * e[6], f[7] * e[7]);
                *(u32x4*)(orow + (size_t)j * 4096) = o; }
        }
    }
}

constexpr int L_AQ = 0, L_AK = 16384, L_VP = 32768, L_P = 49152, L_S = 65536, L_N = 131072 + 1024  ;
struct ScanSrc { const bf16* q; const bf16* k; const bf16* v; const f32x2* ab; const float* gend; int gstride; };
__device__ __forceinline__ int seg_chunk(int seg, int dir, int i) {
    if (seg < 0) return dir == 0 ? i : 3 - i;
    return dir == 0 ? seg * CPS + i : (NCH_LAT - 1 - seg * CPS) - i;
}
__device__ __forceinline__ void scan_stage(Frame& F, int model, int b, int h, int dir, int half, int ci, bool need_q) {
    const int m0 = chunk_row0(ci);
    LAS float* nb = (LAS float*)(F.lds + L_N);
    if (model == 0 && F.tid < 64) { const f32x2 ab = wsp<f32x2>(F, WS_AB)[((size_t)dir * MT + m0 + F.tid) * 4 + h]; nb[256 + F.tid] = ab.y; nb[320 + F.tid] = ab.x; }
    if (F.tid >= 64 && F.tid < 192) { const int dk = F.tid - 64;
        nb[128 + dk] = model == 0 ? wsp<float>(F, WS_GENDM)[((size_t)dir * NCHUNK + ci) * 4 + h] : wsp<float>(F, WS_GENDG)[((size_t)dir * NCHUNK + ci) * 512 + h * 128 + dk]; }
#pragma unroll
    for (int i = 0; i < 2; ++i) { const int p = F.tid + i * 512, r = p >> 4, cpart = p & 15, m = m0 + r;
        const bf16* qrow; const bf16* vrow;
        if (model == 0) { qrow = wsp<bf16>(F, WS_QKMC) + (size_t)m * 1024; vrow = wsp<bf16>(F, WS_VM) + (size_t)m * 1024; }
        else { qrow = qkgt_row(F, dir, m); vrow = wsp<bf16>(F, WS_VG) + (size_t)m * 1024; }
        if (need_q) *(LAS u32x4*)(F.lds + L_AQ + r * 256 + cpart * 16) = *(const u32x4*)(qrow + h * 128 + cpart * 8);
        *(LAS u32x4*)(F.lds + L_AK + r * 256 + cpart * 16) = *(const u32x4*)(qrow + 512 + h * 128 + cpart * 8);
        u32x4 v = *(const u32x4*)(vrow + h * 256 + half * 128 + cpart * 8);
        if (model == 0) { const float be = wsp<f32x2>(F, WS_AB)[((size_t)dir * MT + m) * 4 + h].y;
            v.x = pk2(bflo(v.x) * be, bfhi(v.x) * be); v.y = pk2(bflo(v.y) * be, bfhi(v.y) * be); v.z = pk2(bflo(v.z) * be, bfhi(v.z) * be); v.w = pk2(bflo(v.w) * be, bfhi(v.w) * be); }
        *(LAS u32x4*)(F.lds + L_VP + r * 256 + cpart * 16) = v; }
}
__device__ __forceinline__ void scan_update(Frame& F, int model) {
    LAS float* S = (LAS float*)(F.lds + L_S); LAS float* nb = (LAS float*)(F.lds + L_N);
    const LAS bf16* AK = (const LAS bf16*)(F.lds + L_AK); const LAS bf16* VP = (const LAS bf16*)(F.lds + L_VP);
    const int dk = F.tid >> 2, dv0 = (F.tid & 3) * 32;
    float a[32];
#pragma unroll
    for (int j = 0; j < 32; ++j) a[j] = S[dk * 128 + dv0 + j];
    float nn = 0.f;
    for (int s = 0; s < 64; ++s) { const float k = bf2f(AK[s * 128 + dk]);
        if (model == 0) nn += k * nb[256 + s];
#pragma unroll
        for (int j = 0; j < 32; j += 2) { const unsigned v = *(const LAS unsigned*)(VP + s * 128 + dv0 + j); a[j] += k * bflo(v); a[j + 1] += k * bfhi(v); } }
    const float g = nb[128 + dk];
#pragma unroll
    for (int j = 0; j < 32; ++j) S[dk * 128 + dv0 + j] = g * a[j];
    if (model == 0 && (F.tid & 3) == 0) nb[dk] = g * (nb[dk] + nn);
}
__device__ __forceinline__ bf16* state_ptr(const Frame& F, int sc, int slot, int half) { return wsp<bf16>(F, WS_STATE) + ((size_t)(sc * 8 + slot) * 2 + half) * 16384; }

__device__ __forceinline__ void p4_scan_local(Frame& F) {
    LAS float* S = (LAS float*)(F.lds + L_S); LAS float* nb = (LAS float*)(F.lds + L_N);
    for (int it0 = F.bid; it0 < 32 * 8 * 2; it0 += F.G) {
        const int it = (F.G == 256) ? (it0 & ~255) | ((((((it0 & 255) >> 4) << 3) | (it0 & 7)) << 1) | ((it0 >> 3) & 1)) : it0;
        const int half = it & 1, slot = (it >> 1) & 7, sc = it >> 4, seg = slot - 1;
        const int dir = sc & 1, h = (sc >> 1) & 3, b = (sc >> 3) & 1, model = sc >> 4;
        for (int i = F.tid; i < 16384; i += NTHR) S[i] = 0.f;
        if (F.tid < 128) nb[F.tid] = 0.f;
        float gacc = 1.f;
        __syncthreads();
        const int nch = seg < 0 ? NCH_CTX : CPS;
        for (int i = 0; i < nch; ++i) {
            const int c = seg_chunk(seg, dir, i), ci = seg < 0 ? 256 + b * 4 + c : b * 128 + c;
            scan_stage(F, model, b, h, dir, half, ci, false);
            __syncthreads();
            if (F.tid < 128) gacc *= nb[128 + F.tid];
            scan_update(F, model);
            __syncthreads();
        }
        bf16* st = state_ptr(F, sc, slot, half);
        for (int i = F.tid; i < 8192; i += NTHR) ((unsigned*)st)[i] = pk2(S[2 * i], S[2 * i + 1]);
        if (half == 0 && F.tid < 128) { wsp<float>(F, WS_NST)[(sc * 8 + slot) * 128 + F.tid] = nb[F.tid]; wsp<float>(F, WS_GSEG)[(sc * 8 + slot) * 128 + F.tid] = gacc; }
        __syncthreads();
    }
}
__device__ __forceinline__ void p5_scan_out(Frame& F) {
    LAS float* S = (LAS float*)(F.lds + L_S); LAS float* nb = (LAS float*)(F.lds + L_N); LAS float* P = (LAS float*)(F.lds + L_P);
    const LAS bf16* AQ = (const LAS bf16*)(F.lds + L_AQ); const LAS bf16* AK = (const LAS bf16*)(F.lds + L_AK); const LAS bf16* VP = (const LAS bf16*)(F.lds + L_VP);
    for (int it0 = F.bid; it0 < 2 * 2 * 4 * 8 * 2; it0 += F.G) {
        const int it = (F.G == 256) ? ((((it0 >> 4) << 3) | (it0 & 7)) << 1) | ((it0 >> 3) & 1) : it0;
        const int half = it & 1, seg = (it >> 1) & 7, h = (it >> 4) & 3, b = (it >> 6) & 1, model = it >> 7;
        bf16* HS = wsp<bf16>(F, model == 0 ? WS_QKM : WS_QKG);
        for (int dir = 0; dir < 2; ++dir) {
            const int sc = ((model * 2 + b) * 4 + h) * 2 + dir, s = dir == 0 ? seg : 7 - seg;
            { const int dk = F.tid >> 2, dv0 = (F.tid & 3) * 32; float a[32]; float nn = 0.f;
#pragma unroll
              for (int j = 0; j < 32; ++j) a[j] = 0.f;
              for (int slot = 0; slot <= s; ++slot) {
                  const float g = slot == 0 ? 0.f : wsp<float>(F, WS_GSEG)[(sc * 8 + slot) * 128 + dk];
                  const bf16* st = state_ptr(F, sc, slot, half) + dk * 128 + dv0;
#pragma unroll
                  for (int j = 0; j < 32; j += 2) { const unsigned v = *(const unsigned*)(st + j); a[j] = g * a[j] + bflo(v); a[j + 1] = g * a[j + 1] + bfhi(v); }
                  nn = g * nn + wsp<float>(F, WS_NST)[(sc * 8 + slot) * 128 + dk]; }
#pragma unroll
              for (int j = 0; j < 32; ++j) S[dk * 128 + dv0 + j] = a[j];
              if ((F.tid & 3) == 0) nb[dk] = nn; }
            __syncthreads();
            for (int i = 0; i < CPS; ++i) {
                const int c = seg_chunk(s, dir, i), ci = b * 128 + c, m0 = chunk_row0(ci);
                scan_stage(F, model, b, h, dir, half, ci, true);
                __syncthreads();
                for (int e = F.tid; e < 4096; e += NTHR) { const int t = e >> 6, s2 = e & 63; float p = 0.f;
                    if (dir == 0 ? (s2 <= t) : (s2 >= t)) {
                        for (int d8 = 0; d8 < 16; ++d8) { const u32x4 qa = *(const LAS u32x4*)(AQ + t * 128 + d8 * 8), ka = *(const LAS u32x4*)(AK + s2 * 128 + d8 * 8);
                            p += bflo(qa.x) * bflo(ka.x) + bfhi(qa.x) * bfhi(ka.x) + bflo(qa.y) * bflo(ka.y) + bfhi(qa.y) * bfhi(ka.y)
                               + bflo(qa.z) * bflo(ka.z) + bfhi(qa.z) * bfhi(ka.z) + bflo(qa.w) * bflo(ka.w) + bfhi(qa.w) * bfhi(ka.w); } }
                    P[e] = bf2f((unsigned short)f2bf(p)); }
                __syncthreads();
                { const int t = F.tid >> 3, dv0 = (F.tid & 7) * 16; float o[16];
#pragma unroll
                  for (int j = 0; j < 16; ++j) o[j] = 0.f;
                  float den = 0.f;
                  for (int s2 = 0; s2 < 64; ++s2) { const float p = P[t * 64 + s2];
                      if (model == 0) den += p * nb[256 + s2];
                      const u32x4 v0 = *(const LAS u32x4*)(VP + s2 * 128 + dv0), v1 = *(const LAS u32x4*)(VP + s2 * 128 + dv0 + 8);
                      o[0] += p * bflo(v0.x); o[1] += p * bfhi(v0.x); o[2] += p * bflo(v0.y); o[3] += p * bfhi(v0.y); o[4] += p * bflo(v0.z); o[5] += p * bfhi(v0.z); o[6] += p * bflo(v0.w); o[7] += p * bfhi(v0.w);
                      o[8] += p * bflo(v1.x); o[9] += p * bfhi(v1.x); o[10] += p * bflo(v1.y); o[11] += p * bfhi(v1.y); o[12] += p * bflo(v1.z); o[13] += p * bfhi(v1.z); o[14] += p * bflo(v1.w); o[15] += p * bfhi(v1.w); }
                  for (int dk = 0; dk < 128; ++dk) { const float q = bf2f(AQ[t * 128 + dk]);
                      if (model == 0) den += q * nb[dk];
                      const LAS float* sr = S + dk * 128 + dv0;
#pragma unroll
                      for (int j = 0; j < 16; ++j) o[j] += q * bf2f((unsigned short)f2bf(sr[j])); }
                  float rs = 1.f;
                  if (model == 0) { const float al = nb[320 + t]; rs = al / fmaxf(al * fabsf(den), 1.f); }
                  bf16* dst = HS + (size_t)(m0 + t) * 1024 + h * 256 + half * 128 + dv0;
                  float ssq = 0.f;
                  if (dir == 0) {
                      u32x4 w0, w1; w0.x = pk2(o[0] * rs, o[1] * rs); w0.y = pk2(o[2] * rs, o[3] * rs); w0.z = pk2(o[4] * rs, o[5] * rs); w0.w = pk2(o[6] * rs, o[7] * rs);
                      w1.x = pk2(o[8] * rs, o[9] * rs); w1.y = pk2(o[10] * rs, o[11] * rs); w1.z = pk2(o[12] * rs, o[13] * rs); w1.w = pk2(o[14] * rs, o[15] * rs);
                      *(u32x4*)dst = w0; *(u32x4*)(dst + 8) = w1;
                  } else {
                      const u32x4 p0 = *(const u32x4*)dst, p1 = *(const u32x4*)(dst + 8);
                      const float f[16] = {bflo(p0.x), bfhi(p0.x), bflo(p0.y), bfhi(p0.y), bflo(p0.z), bfhi(p0.z), bflo(p0.w), bfhi(p0.w), bflo(p1.x), bfhi(p1.x), bflo(p1.y), bfhi(p1.y), bflo(p1.z), bfhi(p1.z), bflo(p1.w), bfhi(p1.w)};
                      float r[16];
#pragma unroll
                      for (int j = 0; j < 16; ++j) { r[j] = f[j] + o[j] * rs; ssq += r[j] * r[j]; }
                      u32x4 w0, w1; w0.x = pk2(r[0], r[1]); w0.y = pk2(r[2], r[3]); w0.z = pk2(r[4], r[5]); w0.w = pk2(r[6], r[7]);
                      w1.x = pk2(r[8], r[9]); w1.y = pk2(r[10], r[11]); w1.z = pk2(r[12], r[13]); w1.w = pk2(r[14], r[15]);
                      *(u32x4*)dst = w0; *(u32x4*)(dst + 8) = w1;
                      ssq += __shfl_xor(ssq, 1); ssq += __shfl_xor(ssq, 2); ssq += __shfl_xor(ssq, 4);
                      if ((F.tid & 7) == 0) wsp<float>(F, WS_SSQ)[((size_t)(m0 + t) * 8 + model * 4 + h) * 2 + half] = ssq;
                  } }
                __syncthreads();
                scan_update(F, model);
                __syncthreads();
            }
        }
    }
}

typedef short s16x4 __attribute__((ext_vector_type(4)));
__device__ __forceinline__ unsigned offb(int row, int ch) { return 256u * (unsigned)row + 16u * (unsigned)(ch ^ (((row & 3) << 2) | ((row >> 2) & 3))); }
constexpr int M_AQ = 0, M_AK = 16384, M_VP = 32768, M_P = 49152, M_O = 57344, O_LD = 132;
template <int TILE>
__device__ __forceinline__ void tr_frag2(unsigned x0, unsigned x1, bf16x8& f0, bf16x8& f1) {
    s16x4 r0, r1, r2, r3;
    asm volatile("ds_read_b64_tr_b16 %0, %4 offset:%6\n\tds_read_b64_tr_b16 %1, %5 offset:%6\n\tds_read_b64_tr_b16 %2, %4 offset:%7\n\tds_read_b64_tr_b16 %3, %5 offset:%7\n\ts_waitcnt lgkmcnt(0)"
                 : "=&v"(r0), "=&v"(r1), "=&v"(r2), "=&v"(r3) : "v"(x0), "v"(x1), "i"(TILE), "i"(TILE + 8192) : "memory");
    f0 = __builtin_shufflevector(r0, r1, 0, 1, 2, 3, 4, 5, 6, 7); f1 = __builtin_shufflevector(r2, r3, 0, 1, 2, 3, 4, 5, 6, 7);
}
template <int TILE>
__device__ __forceinline__ void tr_frag8(unsigned a0, unsigned a1, unsigned b0, unsigned b1, unsigned c0, unsigned c1, unsigned d0, unsigned d1, bf16x8 (&f)[8]) {
    s16x4 r[16];
    asm volatile("ds_read_b64_tr_b16 %0, %16 offset:%24\n\tds_read_b64_tr_b16 %1, %17 offset:%24\n\tds_read_b64_tr_b16 %2, %16 offset:%25\n\tds_read_b64_tr_b16 %3, %17 offset:%25\n\t"
                 "ds_read_b64_tr_b16 %4, %18 offset:%24\n\tds_read_b64_tr_b16 %5, %19 offset:%24\n\tds_read_b64_tr_b16 %6, %18 offset:%25\n\tds_read_b64_tr_b16 %7, %19 offset:%25\n\t"
                 "ds_read_b64_tr_b16 %8, %20 offset:%24\n\tds_read_b64_tr_b16 %9, %21 offset:%24\n\tds_read_b64_tr_b16 %10, %20 offset:%25\n\tds_read_b64_tr_b16 %11, %21 offset:%25\n\t"
                 "ds_read_b64_tr_b16 %12, %22 offset:%24\n\tds_read_b64_tr_b16 %13, %23 offset:%24\n\tds_read_b64_tr_b16 %14, %22 offset:%25\n\tds_read_b64_tr_b16 %15, %23 offset:%25\n\ts_waitcnt lgkmcnt(0)"
                 : "=&v"(r[0]), "=&v"(r[1]), "=&v"(r[2]), "=&v"(r[3]), "=&v"(r[4]), "=&v"(r[5]), "=&v"(r[6]), "=&v"(r[7]), "=&v"(r[8]), "=&v"(r[9]), "=&v"(r[10]), "=&v"(r[11]), "=&v"(r[12]), "=&v"(r[13]), "=&v"(r[14]), "=&v"(r[15])
                 : "v"(a0), "v"(a1), "v"(b0), "v"(b1), "v"(c0), "v"(c1), "v"(d0), "v"(d1), "i"(TILE), "i"(TILE + 8192) : "memory");
#pragma unroll
    for (int j = 0; j < 8; ++j) f[j] = __builtin_shufflevector(r[2 * j], r[2 * j + 1], 0, 1, 2, 3, 4, 5, 6, 7);
}
template <int TILE>
__device__ __forceinline__ void tr_frag4(unsigned x0, unsigned x1, unsigned y0, unsigned y1, bf16x8& f0, bf16x8& f1, bf16x8& f2, bf16x8& f3) {
    s16x4 r0, r1, r2, r3, r4, r5, r6, r7;
    asm volatile("ds_read_b64_tr_b16 %0, %8 offset:%12\n\tds_read_b64_tr_b16 %1, %9 offset:%12\n\tds_read_b64_tr_b16 %2, %8 offset:%13\n\tds_read_b64_tr_b16 %3, %9 offset:%13\n\t"
                 "ds_read_b64_tr_b16 %4, %10 offset:%12\n\tds_read_b64_tr_b16 %5, %11 offset:%12\n\tds_read_b64_tr_b16 %6, %10 offset:%13\n\tds_read_b64_tr_b16 %7, %11 offset:%13\n\ts_waitcnt lgkmcnt(0)"
                 : "=&v"(r0), "=&v"(r1), "=&v"(r2), "=&v"(r3), "=&v"(r4), "=&v"(r5), "=&v"(r6), "=&v"(r7) : "v"(x0), "v"(x1), "v"(y0), "v"(y1), "i"(TILE), "i"(TILE + 8192) : "memory");
    f0 = __builtin_shufflevector(r0, r1, 0, 1, 2, 3, 4, 5, 6, 7); f1 = __builtin_shufflevector(r2, r3, 0, 1, 2, 3, 4, 5, 6, 7);
    f2 = __builtin_shufflevector(r4, r5, 0, 1, 2, 3, 4, 5, 6, 7); f3 = __builtin_shufflevector(r6, r7, 0, 1, 2, 3, 4, 5, 6, 7);
}
#define MFMA16(a, b, c) __builtin_amdgcn_mfma_f32_16x16x32_bf16((a), (b), (c), 0, 0, 0)
__device__ __forceinline__ bf16* mstate_ptr(const Frame& F, int sc, int slot, int half) { return wsp<bf16>(F, WS_STATE) + ((size_t)(sc * 8 + slot) * 2 + half) * 16384; }

#define LBAR() asm volatile("s_waitcnt lgkmcnt(0)\n\ts_barrier" ::: "memory")
template <bool OUT>
__device__ __forceinline__ void mscan_run(Frame& F, int model, int b, int h, int dir, int half, int seg, f32x4 (&S)[2][8], float& gacc) {
    LAS unsigned char* lds = F.lds; LAS float* nb = (LAS float*)(F.lds + L_N);
    LAS unsigned short* nbh = (LAS unsigned short*)(F.lds + L_N + 2048);
    const unsigned lb = (unsigned)(uintptr_t)F.lds;
    const int w = F.wave, lane = F.lane, li = lane & 15, lg = lane >> 4, tq = li >> 2, tp = lane & 3;
    const bool st = w < 4; const int sw = w & 3;
    const int nch = seg < 0 ? NCH_CTX : CPS;
    bf16* HS = wsp<bf16>(F, model == 0 ? WS_QKM : WS_QKG);
    const int mli = ((li & 3) << 2) | ((li >> 2) & 3);
    const unsigned rowb = 256u * li + 16u * (lg ^ mli);
    const unsigned o2b = 256u * li + 16u * ((lg >> 1) ^ mli) + 8u * (lg & 1);
    const unsigned trb0 = 256u * (8 * lg + tq) + 16u * ((tp >> 1) ^ ((tq << 2) | ((2 * lg) & 3))) + 8u * (tp & 1);
    const unsigned trb1 = 256u * (8 * lg + 4 + tq) + 16u * ((tp >> 1) ^ ((tq << 2) | ((2 * lg + 1) & 3))) + 8u * (tp & 1);
    const unsigned pra0 = lb + M_P + (128u * li + 16u * (lg ^ (li & 7))), pra1 = lb + M_P + ((128u * li + 16u * (lg ^ (li & 7))) ^ 64u);
    const unsigned poff0 = (unsigned)((F.tid >> 4) * 1024 + (F.tid & 15) * 8) * 2u, poff1 = poff0 + 32u * 2048u;
    auto final_pass = [&](const int m0, const u32x4 (&prevh)[2]) {
        LAS float* Ol = (LAS float*)(F.lds + M_O);
#pragma unroll
        for (int i = 0; i < 2; ++i) { const int p = F.tid + i * 512, t = p >> 4, c8 = p & 15;
            const f32x4 o0 = *(const LAS f32x4*)(Ol + t * O_LD + 8 * c8), o1 = *(const LAS f32x4*)(Ol + t * O_LD + 8 * c8 + 4);
            float rs = 1.f;
            if (model == 0) rs = nb[384 + t];
            bf16* dst = (bf16*)((unsigned char*)(HS + (size_t)m0 * 1024 + h * 256 + half * 128) + (i == 0 ? poff0 : poff1));
            float r[8] = {o0[0] * rs, o0[1] * rs, o0[2] * rs, o0[3] * rs, o1[0] * rs, o1[1] * rs, o1[2] * rs, o1[3] * rs};
            if (dir == 1) { const u32x4 pv = prevh[i];
                r[0] += bflo(pv.x); r[1] += bfhi(pv.x); r[2] += bflo(pv.y); r[3] += bfhi(pv.y); r[4] += bflo(pv.z); r[5] += bfhi(pv.z); r[6] += bflo(pv.w); r[7] += bfhi(pv.w);
                float ssq = (r[0] * r[0] + r[1] * r[1]) + (r[2] * r[2] + r[3] * r[3]) + (r[4] * r[4] + r[5] * r[5]) + (r[6] * r[6] + r[7] * r[7]);
                ssq += __shfl_xor(ssq, 1); ssq += __shfl_xor(ssq, 2); ssq += __shfl_xor(ssq, 4); ssq += __shfl_xor(ssq, 8);
                if (c8 == 0) wsp<float>(F, WS_SSQ)[((size_t)(m0 + t) * 8 + model * 4 + h) * 2 + half] = ssq; }
            u32x4 wv; wv.x = pkbf(r[0], r[1]); wv.y = pkbf(r[2], r[3]); wv.z = pkbf(r[4], r[5]); wv.w = pkbf(r[6], r[7]);
            *(u32x4*)dst = wv; }
    };
    const unsigned pwb = 128u * li + 8u * (lg & 1) + 16u * ((lg >> 1) ^ (li & 7));
    auto ptile = [&](const int ti, const int sh) {
        const bool used = dir == 0 ? !(sh == 1 && ti < 2) : !(sh == 0 && ti >= 2);
        if (!used) return;
        unsigned rowl = rowb; asm volatile("" : "+v"(rowl));
        bf16x8 pa[4], pb0[4], pb1[4];
#pragma unroll
        for (int kk = 0; kk < 4; ++kk) { const unsigned ra = lb + (rowl ^ ((unsigned)kk << 6)); pa[kk] = *(const LAS bf16x8*)(uintptr_t)(ra + M_AQ + 4096u * ti); pb0[kk] = *(const LAS bf16x8*)(uintptr_t)(ra + M_AK + 8192u * sh); pb1[kk] = *(const LAS bf16x8*)(uintptr_t)(ra + M_AK + 8192u * sh + 4096u); }
        f32x4 acc0 = {0.f, 0.f, 0.f, 0.f}, acc1 = acc0;
#pragma unroll
        for (int kk = 0; kk < 4; ++kk) { acc0 = MFMA16(pb0[kk], pa[kk], acc0); acc1 = MFMA16(pb1[kk], pa[kk], acc1); }
        const int t = 16 * ti + li;
#pragma unroll
        for (int sj = 0; sj < 2; ++sj) { const f32x4 acc = sj == 0 ? acc0 : acc1; const int s0 = 16 * (2 * sh + sj) + 4 * lg; float pv[4];
#pragma unroll
            for (int r = 0; r < 4; ++r) { const bool keep = dir == 0 ? (s0 + r <= t) : (s0 + r >= t); pv[r] = keep ? acc[r] : 0.f; }
            u32x2 pw; pw.x = pkbf(pv[0], pv[1]); pw.y = pkbf(pv[2], pv[3]);
            *(LAS u32x2*)(uintptr_t)(lb + M_P + 2048u * ti + (pwb ^ ((unsigned)(4 * sh + 2 * sj) << 4))) = pw; }
    };
    auto chunk_m0 = [&](const int ic) { const int c = seg_chunk(seg, dir, ic), ci = seg < 0 ? 256 + b * 4 + c : b * 128 + c; return chunk_row0(ci); };
    if (st) {
        const unsigned ola = lb + M_O + 4u * ((4 * lg) * O_LD + 32 * sw + li);
        for (int ic = 0; ic < nch; ++ic) {
            const int m0 = chunk_m0(ic);
            LBAR();
            if (F.tid < 128) gacc *= nb[128 + F.tid];
            unsigned o2l = o2b, tr0l = trb0, tr1l = trb1; asm volatile("" : "+v"(o2l), "+v"(tr0l), "+v"(tr1l));
            bf16x8 VB[2][2];
            tr_frag4<M_VP>(lb + (tr0l ^ ((unsigned)(2 * sw) << 5)), lb + (tr1l ^ ((unsigned)(2 * sw) << 5)), lb + (tr0l ^ ((unsigned)(2 * sw + 1) << 5)), lb + (tr1l ^ ((unsigned)(2 * sw + 1) << 5)), VB[0][0], VB[0][1], VB[1][0], VB[1][1]);
            u32x4 prevh[2] = {{0u, 0u, 0u, 0u}, {0u, 0u, 0u, 0u}};
            if (OUT) {
#pragma unroll
                for (int i = 0; i < 2; ++i) prevh[i] = *(const u32x4*)((const unsigned char*)(HS + (size_t)m0 * 1024 + h * 256 + half * 128) + (i == 0 ? poff0 : poff1) * (unsigned)dir);
                ptile(sw, 1);
                f32x4 O[2][4];
#pragma unroll
                for (int j = 0; j < 2; ++j)
#pragma unroll
                    for (int q = 0; q < 4; ++q) O[j][q] = (f32x4){0.f, 0.f, 0.f, 0.f};
#pragma unroll
                for (int kh = 0; kh < 2; ++kh) {
                    u32x2 alo[2][4], ahi[2][4];
#pragma unroll
                    for (int k2 = 0; k2 < 2; ++k2)
#pragma unroll
                        for (int q = 0; q < 4; ++q) { alo[k2][q] = *(const LAS u32x2*)(uintptr_t)((o2l ^ ((unsigned)(4 * (2 * kh + k2)) << 4)) + lb + M_AQ + 4096u * q); ahi[k2][q] = *(const LAS u32x2*)(uintptr_t)((o2l ^ ((unsigned)(4 * (2 * kh + k2) + 2) << 4)) + lb + M_AQ + 4096u * q); }
#pragma unroll
                    for (int k2 = 0; k2 < 2; ++k2) { const int kk = 2 * kh + k2; bf16x8 Bk[2];
#pragma unroll
                        for (int j = 0; j < 2; ++j) { u32x4 bw; bw.x = pkbf(S[j][2 * kk][0], S[j][2 * kk][1]); bw.y = pkbf(S[j][2 * kk][2], S[j][2 * kk][3]); bw.z = pkbf(S[j][2 * kk + 1][0], S[j][2 * kk + 1][1]); bw.w = pkbf(S[j][2 * kk + 1][2], S[j][2 * kk + 1][3]); Bk[j] = __builtin_bit_cast(bf16x8, bw); }
#pragma unroll
                        for (int q = 0; q < 4; ++q) { u32x4 aw; aw.x = alo[k2][q].x; aw.y = alo[k2][q].y; aw.z = ahi[k2][q].x; aw.w = ahi[k2][q].y; const bf16x8 Af = __builtin_bit_cast(bf16x8, aw);
                            O[0][q] = MFMA16(Af, Bk[0], O[0][q]); O[1][q] = MFMA16(Af, Bk[1], O[1][q]); } }
                    asm volatile("" ::: "memory");
                }
                LBAR();
                bf16x8 p0[4], p1[4];
#pragma unroll
                for (int q = 0; q < 4; ++q) { p0[q] = *(const LAS bf16x8*)(uintptr_t)(pra0 + 2048u * q); p1[q] = *(const LAS bf16x8*)(uintptr_t)(pra1 + 2048u * q); }
#pragma unroll
                for (int q = 0; q < 4; ++q) {
                    if (dir == 0 || q < 2) { O[0][q] = MFMA16(p0[q], VB[0][0], O[0][q]); O[1][q] = MFMA16(p0[q], VB[1][0], O[1][q]); }
                    if (dir == 1 || q >= 2) { O[0][q] = MFMA16(p1[q], VB[0][1], O[0][q]); O[1][q] = MFMA16(p1[q], VB[1][1], O[1][q]); } }
#pragma unroll
                for (int j = 0; j < 2; ++j)
#pragma unroll
                    for (int q = 0; q < 4; ++q)
#pragma unroll
                        for (int r = 0; r < 4; ++r) *(LAS float*)(uintptr_t)(ola + 64u * j + 4u * (unsigned)((16 * q + r) * O_LD)) = O[j][q][r];
            }
#pragma unroll
            for (int kp = 0; kp < 4; ++kp) { bf16x8 A0, A1, A2, A3; const int kt = 2 * kp;
                const f32x4 g0 = *(const LAS f32x4*)(nb + 128 + 16 * kt + 4 * lg), g1 = *(const LAS f32x4*)(nb + 128 + 16 * (kt + 1) + 4 * lg);
                tr_frag4<M_AK>(lb + (tr0l ^ ((unsigned)kt << 5)), lb + (tr1l ^ ((unsigned)kt << 5)), lb + (tr0l ^ ((unsigned)(kt + 1) << 5)), lb + (tr1l ^ ((unsigned)(kt + 1) << 5)), A0, A1, A2, A3);
#pragma unroll
                for (int j = 0; j < 2; ++j) { S[j][kt] = MFMA16(A0, VB[j][0], S[j][kt]); S[j][kt + 1] = MFMA16(A2, VB[j][0], S[j][kt + 1]); }
#pragma unroll
                for (int j = 0; j < 2; ++j) { S[j][kt] = MFMA16(A1, VB[j][1], S[j][kt]); S[j][kt + 1] = MFMA16(A3, VB[j][1], S[j][kt + 1]); }
#pragma unroll
                for (int j = 0; j < 2; ++j) { S[j][kt] = S[j][kt] * g0; S[j][kt + 1] = S[j][kt + 1] * g1; } }
            LBAR();
            if (OUT) final_pass(m0, prevh);
        }
    } else {
        const int ht = F.tid - 256;
        const unsigned hoff = (unsigned)((ht >> 4) * 1024 + (ht & 15) * 8) * 2u;
        const unsigned aoff = (unsigned)(ht >> 4) * 32u + 4u, aoffl = (unsigned)(ht & 63) * 32u;
        const f32x2* ABd = wsp<f32x2>(F, WS_AB) + (size_t)dir * MT * 4 + h;
        const bf16* vbase = wsp<bf16>(F, model == 0 ? WS_VM : WS_VG) + h * 256 + half * 128;
        struct SR { u32x4 q[4], k[4], v[4]; float be[4]; f32x2 ab; float ge; };
        SR R;
        auto issue = [&](const int ic_) {
            const int c_ = seg_chunk(seg, dir, ic_), ci_ = seg < 0 ? 256 + b * 4 + c_ : b * 128 + c_, m0_ = chunk_row0(ci_);
            const unsigned char* abr = (const unsigned char*)(ABd + (size_t)m0_ * 4);
            { const float* abp = (const float*)(abr + aoffl); R.ab.x = abp[0]; R.ab.y = abp[1]; }
            const float* gp = model == 0 ? wsp<float>(F, WS_GENDM) + ((size_t)dir * NCHUNK + ci_) * 4 + h : wsp<float>(F, WS_GENDG) + ((size_t)dir * NCHUNK + ci_) * 512 + h * 128 + ((ht - 64) & 127);
            R.ge = *gp;
            const long long qoff = model == 0 ? (long long)WS_QKMC : (m0_ < M_LAT ? 0ll : (long long)WS_QKGTC + ((long long)dir * M_CTX - M_LAT) * 2048);
            const unsigned char* qbb = (model == 1 && m0_ < M_LAT) ? (const unsigned char*)F.out + (size_t)dir * M_LAT * 2048 : (const unsigned char*)F.ws + qoff;
            const unsigned char* qr = qbb + (size_t)m0_ * 2048 + h * 256;
            const unsigned char* vr = (const unsigned char*)(vbase + (size_t)m0_ * 1024);
#pragma unroll
            for (int i = 0; i < 4; ++i) { const unsigned o = hoff + (unsigned)i * 16u * 2048u;
                if (OUT) R.q[i] = *(const u32x4*)(qr + o);
                R.k[i] = *(const u32x4*)(qr + 1024 + o); R.v[i] = *(const u32x4*)(vr + o); R.be[i] = *(const float*)(abr + aoff + (unsigned)i * 16u * 32u); }
        };
        const int ti = sw;
        const unsigned fra = lb + L_N + 2048 + (li == 1 ? 128u : 0u) + 16u * lg;
        const unsigned nfa = lb + L_N + 2048 + 256 + (li == 1 ? 256u : 0u) + 16u * lg;
        issue(0);
        for (int ic = 0; ic < nch; ++ic) {
            const int m0 = chunk_m0(ic);
            if (model == 0 && ht < 64) { const float be = R.ab.y; nb[320 + ht] = R.ab.x;
                const unsigned hi = pkbf(be, be) & 0xffffu; nbh[ht] = (unsigned short)hi; nbh[64 + ht] = (unsigned short)(pkbf(be - bflo(hi), 0.f) & 0xffffu); }
            if (ht >= 64 && ht < 192) nb[128 + ht - 64] = R.ge;
#pragma unroll
            for (int i = 0; i < 4; ++i) { const int p = ht + i * 256, r = p >> 4, cp = p & 15;
                const unsigned o = offb(r, cp);
                if (OUT) *(LAS u32x4*)(lds + M_AQ + o) = R.q[i];
                *(LAS u32x4*)(lds + M_AK + o) = R.k[i];
                u32x4 v = R.v[i];
                if (model == 0) { const float be = R.be[i];
                    v.x = pkbf(bflo(v.x) * be, bfhi(v.x) * be); v.y = pkbf(bflo(v.y) * be, bfhi(v.y) * be); v.z = pkbf(bflo(v.z) * be, bfhi(v.z) * be); v.w = pkbf(bflo(v.w) * be, bfhi(v.w) * be); }
                *(LAS u32x4*)(lds + M_VP + o) = v; }
            LBAR();
            u32x4 prevh[2] = {{0u, 0u, 0u, 0u}, {0u, 0u, 0u, 0u}};
            if (OUT) {
#pragma unroll
                for (int i = 0; i < 2; ++i) prevh[i] = *(const u32x4*)((const unsigned char*)(HS + (size_t)m0 * 1024 + h * 256 + half * 128) + (i == 0 ? poff0 : poff1) * (unsigned)dir);
                ptile(ti, 0);
            }
            if (ic + 1 < nch) issue(ic + 1);
            unsigned rowl = rowb, tr0l = trb0, tr1l = trb1; asm volatile("" : "+v"(rowl), "+v"(tr0l), "+v"(tr1l));
            bf16x8 BB0, BB1;
            { u32x4 z = {0u, 0u, 0u, 0u}; BB0 = __builtin_bit_cast(bf16x8, z); BB1 = BB0; }
            if (model == 0) { u32x4 f0 = *(const LAS u32x4*)(uintptr_t)fra, f1 = *(const LAS u32x4*)(uintptr_t)(fra + 64u); const u32x4 z = {0u, 0u, 0u, 0u};
                if (li > 1) { f0 = z; f1 = z; } BB0 = __builtin_bit_cast(bf16x8, f0); BB1 = __builtin_bit_cast(bf16x8, f1); }
            f32x4 dq = {0.f, 0.f, 0.f, 0.f};
            if (OUT && model == 0) {
                bf16x8 pa[4]; u32x4 nf[4]; const u32x4 z = {0u, 0u, 0u, 0u};
#pragma unroll
                for (int kk = 0; kk < 4; ++kk) { pa[kk] = *(const LAS bf16x8*)(uintptr_t)(lb + (rowl ^ ((unsigned)kk << 6)) + M_AQ + 4096u * ti); nf[kk] = *(const LAS u32x4*)(uintptr_t)(nfa + 64u * kk); if (li > 1) nf[kk] = z; }
#pragma unroll
                for (int kk = 0; kk < 4; ++kk) dq = MFMA16(pa[kk], __builtin_bit_cast(bf16x8, nf[kk]), dq);
            }
            f32x4 nacc0 = {0.f, 0.f, 0.f, 0.f}, nacc1 = nacc0;
            if (model == 0) { bf16x8 A0, A1, A2, A3;
                tr_frag4<M_AK>(lb + (tr0l ^ ((unsigned)(2 * ti) << 5)), lb + (tr1l ^ ((unsigned)(2 * ti) << 5)), lb + (tr0l ^ ((unsigned)(2 * ti + 1) << 5)), lb + (tr1l ^ ((unsigned)(2 * ti + 1) << 5)), A0, A1, A2, A3);
                nacc0 = MFMA16(A0, BB0, nacc0); nacc0 = MFMA16(A1, BB1, nacc0); nacc1 = MFMA16(A2, BB0, nacc1); nacc1 = MFMA16(A3, BB1, nacc1); }
            float nnew[8] = {0.f, 0.f, 0.f, 0.f, 0.f, 0.f, 0.f, 0.f};
            if (model == 0) { const f32x4 no0 = *(const LAS f32x4*)(nb + 32 * ti + 4 * lg), no1 = *(const LAS f32x4*)(nb + 32 * ti + 16 + 4 * lg), gw0 = *(const LAS f32x4*)(nb + 128 + 32 * ti + 4 * lg), gw1 = *(const LAS f32x4*)(nb + 128 + 32 * ti + 16 + 4 * lg);
#pragma unroll
                for (int r = 0; r < 4; ++r) { nnew[r] = gw0[r] * (no0[r] + nacc0[r] + __shfl_xor(nacc0[r], 1)); nnew[4 + r] = gw1[r] * (no1[r] + nacc1[r] + __shfl_xor(nacc1[r], 1)); } }
            if (OUT) {
                LBAR();
                if (model == 0) { f32x4 dp = dq;
                    const bf16x8 p0 = *(const LAS bf16x8*)(uintptr_t)(pra0 + 2048u * ti), p1 = *(const LAS bf16x8*)(uintptr_t)(pra1 + 2048u * ti);
                    if (dir == 0 || ti < 2) dp = MFMA16(p0, BB0, dp);
                    if (dir == 1 || ti >= 2) dp = MFMA16(p1, BB1, dp);
#pragma unroll
                    for (int r = 0; r < 4; ++r) { const float v = dp[r] + __shfl_xor(dp[r], 1); const float al = nb[320 + 16 * ti + 4 * lg + r];
                        if (li == 0) nb[384 + 16 * ti + 4 * lg + r] = al / fmaxf(al * fabsf(v), 1.f); } }
            }
            LBAR();
            if (model == 0 && li == 0) {
#pragma unroll
                for (int j = 0; j < 2; ++j) { const int dk0 = 32 * ti + 16 * j + 4 * lg; const float* nn = nnew + 4 * j;
                    f32x4 nv = {nn[0], nn[1], nn[2], nn[3]}; *(LAS f32x4*)(nb + dk0) = nv;
                    u32x2 hv, lv; const unsigned h0 = pkbf(nn[0], nn[1]), h1 = pkbf(nn[2], nn[3]); hv.x = h0; hv.y = h1;
                    lv.x = pkbf(nn[0] - bflo(h0), nn[1] - bfhi(h0)); lv.y = pkbf(nn[2] - bflo(h1), nn[3] - bfhi(h1));
                    *(LAS u32x2*)(nbh + 128 + dk0) = hv; *(LAS u32x2*)(nbh + 256 + dk0) = lv; } }
            if (OUT) final_pass(m0, prevh);
        }
    }
}
__device__ __forceinline__ void p4m_scan_local(Frame& F) {
    LAS float* nb = (LAS float*)(F.lds + L_N);
    for (int it0 = F.bid; it0 < 32 * 8 * 2; it0 += F.G) {
        const int it = (F.G == 256) ? (it0 & ~255) | ((((((it0 & 255) >> 4) << 3) | (it0 & 7)) << 1) | ((it0 >> 3) & 1)) : it0;
        const int half = it & 1, slot = (it >> 1) & 7, sc = it >> 4, seg = slot - 1;
        const int dir = sc & 1, h = (sc >> 1) & 3, b = (sc >> 3) & 1, model = sc >> 4;
        f32x4 S[2][8];
#pragma unroll
        for (int j = 0; j < 2; ++j)
#pragma unroll
            for (int kt = 0; kt < 8; ++kt) S[j][kt] = (f32x4){0.f, 0.f, 0.f, 0.f};
        __syncthreads();
        if (F.tid < 128) nb[F.tid] = 0.f;
        float gacc = 1.f;
        mscan_run<false>(F, model, b, h, dir, half, seg, S, gacc);
        __syncthreads();
        if (F.wave < 4) {
#pragma unroll
            for (int j = 0; j < 2; ++j) { unsigned so = (unsigned)((2 * F.wave + j) * 512 + F.lane) * 8u; asm volatile("" : "+v"(so));
                bf16* st = (bf16*)((unsigned char*)mstate_ptr(F, sc, slot, half) + so);
#pragma unroll
                for (int kt = 0; kt < 8; ++kt) { u32x2 v; v.x = pkbf(S[j][kt][0], S[j][kt][1]); v.y = pkbf(S[j][kt][2], S[j][kt][3]); *(u32x2*)(st + kt * 256) = v; } } }
        if (half == 0 && F.tid < 128) { wsp<float>(F, WS_NST)[(sc * 8 + slot) * 128 + F.tid] = nb[F.tid]; wsp<float>(F, WS_GSEG)[(sc * 8 + slot) * 128 + F.tid] = gacc; }
    }
}
__device__ __forceinline__ void p5m_scan_out(Frame& F) {
    LAS float* nb = (LAS float*)(F.lds + L_N);
    for (int it0 = F.bid; it0 < 2 * 2 * 4 * 8 * 2; it0 += F.G) {
        const int it = (F.G == 256) ? ((((it0 >> 4) << 3) | (it0 & 7)) << 1) | ((it0 >> 3) & 1) : it0;
        const int half = it & 1, seg = (it >> 1) & 7, h = (it >> 4) & 3, b = (it >> 6) & 1, model = it >> 7;
        for (int dir = 0; dir < 2; ++dir) {
            const int sc = ((model * 2 + b) * 4 + h) * 2 + dir, s = dir == 0 ? seg : 7 - seg;
            f32x4 S[2][8];
#pragma unroll
            for (int j = 0; j < 2; ++j)
#pragma unroll
                for (int kt = 0; kt < 8; ++kt) S[j][kt] = (f32x4){0.f, 0.f, 0.f, 0.f};
            float nn = 0.f;
            for (int slot = 0; slot <= s; ++slot) {
                const float* gs = wsp<float>(F, WS_GSEG) + (sc * 8 + slot) * 128;
                const float gv = gs[F.tid & 127], nv = wsp<float>(F, WS_NST)[(sc * 8 + slot) * 128 + (F.tid & 127)];
                if (F.wave < 4) {
                    f32x4 gv4[8];
#pragma unroll
                    for (int kt = 0; kt < 8; ++kt) gv4[kt] = *(const f32x4*)(gs + 16 * kt + 4 * (F.lane >> 4));
#pragma unroll
                    for (int j = 0; j < 2; ++j) { unsigned so = (unsigned)((2 * F.wave + j) * 512 + F.lane) * 8u; asm volatile("" : "+v"(so));
                        const bf16* stp = (const bf16*)((const unsigned char*)mstate_ptr(F, sc, slot, half) + so);
                        u32x2 sv[8];
#pragma unroll
                        for (int kt = 0; kt < 8; ++kt) sv[kt] = *(const u32x2*)(stp + kt * 256);
#pragma unroll
                        for (int kt = 0; kt < 8; ++kt) { const u32x2 v = sv[kt]; f32x4 g4 = gv4[kt]; if (slot == 0) g4 = (f32x4){0.f, 0.f, 0.f, 0.f};
                            S[j][kt][0] = g4[0] * S[j][kt][0] + bflo(v.x); S[j][kt][1] = g4[1] * S[j][kt][1] + bfhi(v.x); S[j][kt][2] = g4[2] * S[j][kt][2] + bflo(v.y); S[j][kt][3] = g4[3] * S[j][kt][3] + bfhi(v.y); } } }
                nn = (slot > 0 ? gv : 0.f) * nn + nv; }
            __syncthreads();
            if (F.tid < 128) { nb[F.tid] = nn; LAS unsigned short* nbh = (LAS unsigned short*)(F.lds + L_N + 2048);
                const unsigned hi = pkbf(nn, nn) & 0xffffu; nbh[128 + F.tid] = (unsigned short)hi; nbh[256 + F.tid] = (unsigned short)(pkbf(nn - bflo(hi), 0.f) & 0xffffu); }
            float gacc = 1.f;
            mscan_run<true>(F, model, b, h, dir, half, s, S, gacc);
        }
    }
}

struct EpiProjB {
    unsigned char* ws; const float* ml_norm; const float* gla_norm;
    __device__ __forceinline__ void operator()(const f32x4 (&acc)[2][2][4][2], const Unit& u, int wr, int wc, int fr, int fq) const {
        const int row0 = u.pm * 256 + wr * 64 + fr, colt = (u.pn & 3) * 256 + wc * 32 + 8 * fq;
        if (u.pn < 8) {
            const int model = u.pn >> 2, head = u.pn & 3;
            bf16* base = (bf16*)(ws + (model == 0 ? WS_QKM : WS_QKG)) + colt;
            const float* nw = (model == 0 ? ml_norm : gla_norm) + colt;
            const float* ssq = (const float*)(ws + WS_SSQ);
            const float gsel = model == 0 ? 0.f : 1.f;
#pragma unroll
            for (int ai = 0; ai < 2; ++ai)
#pragma unroll
                for (int m = 0; m < 4; ++m) { asm volatile("" ::: "memory");
                    const int row = row0 + ai * 128 + m * 16; bf16* rowp = base + (size_t)row * 1024;
                    const f32x2 sq = *(const f32x2*)(ssq + ((size_t)row * 8 + model * 4 + head) * 2);
                    const float rstd = 1.f / sqrtf((sq.x + sq.y) * (1.f / 256.f) + EPS);
                    float one = 1.f; asm volatile("" : "+v"(one));
#pragma unroll
                    for (int bj = 0; bj < 2; ++bj) { const f32x4 a0 = acc[ai][bj][m][0] * one, a1 = acc[ai][bj][m][1] * one;
                        const u32x4 hv = *(const u32x4*)(rowp + bj * 128); const f32x4 n0 = *(const f32x4*)(nw + bj * 128), n1 = *(const f32x4*)(nw + bj * 128 + 4);
                        float hvf[8]; unpack8(hv, hvf); float o[8];
#pragma unroll
                        for (int j = 0; j < 4; ++j) { const float s0 = sigm(a0[j]), s1 = sigm(a1[j]);
                            o[j] = hvf[j] * rstd * n0[j] * (s0 + gsel * (s0 * a0[j] - s0)); o[4 + j] = hvf[4 + j] * rstd * n1[j] * (s1 + gsel * (s1 * a1[j] - s1)); }
                        u32x4 w; w.x = cvt_pk_bf16(o[0], o[1]); w.y = cvt_pk_bf16(o[2], o[3]); w.z = cvt_pk_bf16(o[4], o[5]); w.w = cvt_pk_bf16(o[6], o[7]);
                        *(u32x4*)(rowp + bj * 128) = w; } }
        } else {
            bf16* base = (bf16*)(ws + (u.pn < 12 ? WS_VG : WS_QKMC)) + colt;
#pragma unroll
            for (int ai = 0; ai < 2; ++ai)
#pragma unroll
                for (int m = 0; m < 4; ++m) { bf16* rowp = base + (size_t)(row0 + ai * 128 + m * 16) * 1024;
#pragma unroll
                    for (int bj = 0; bj < 2; ++bj) { const f32x4 a0 = acc[ai][bj][m][0], a1 = acc[ai][bj][m][1];
                        u32x4 w; w.x = pkbf(sigm(a0[0]), sigm(a0[1])); w.y = pkbf(sigm(a0[2]), sigm(a0[3])); w.z = pkbf(sigm(a1[0]), sigm(a1[1])); w.w = pkbf(sigm(a1[2]), sigm(a1[3]));
                        *(u32x4*)(rowp + bj * 128) = w; } }
        }
    }
};
template <int STEP> struct EpiGate {
    unsigned char* ws;
    __device__ __forceinline__ void operator()(const f32x4 (&acc)[2][2][4][2], const Unit& u, int wr, int wc, int fr, int fq) const {
        const int row0 = u.pm * 256 + wr * 64 + fr, colt = u.pn * 256 + wc * 32 + 8 * fq;
        const bf16* sg = (const bf16*)(ws + (STEP == 0 ? WS_VG : WS_QKMC)) + colt; bf16* ty = (bf16*)(ws + WS_VM) + colt;
#pragma unroll
        for (int ai = 0; ai < 2; ++ai)
#pragma unroll
            for (int m = 0; m < 4; ++m) { const size_t ro = (size_t)(row0 + ai * 128 + m * 16) * 1024;
#pragma unroll
                for (int bj = 0; bj < 2; ++bj) { const f32x4 a0 = acc[ai][bj][m][0], a1 = acc[ai][bj][m][1];
                    const u32x4 s = *(const u32x4*)(sg + ro + bj * 128);
                    float r[8] = {bflo(s.x) * a0[0], bfhi(s.x) * a0[1], bflo(s.y) * a0[2], bfhi(s.y) * a0[3], bflo(s.z) * a1[0], bfhi(s.z) * a1[1], bflo(s.w) * a1[2], bfhi(s.w) * a1[3]};
                    if (STEP == 1) { const u32x4 t = *(const u32x4*)(ty + ro + bj * 128);
                        r[0] += bflo(t.x); r[1] += bfhi(t.x); r[2] += bflo(t.y); r[3] += bfhi(t.y); r[4] += bflo(t.z); r[5] += bfhi(t.z); r[6] += bflo(t.w); r[7] += bfhi(t.w); }
                    u32x4 w; w.x = cvt_pk_bf16(r[0], r[1]); w.y = cvt_pk_bf16(r[2], r[3]); w.z = cvt_pk_bf16(r[4], r[5]); w.w = cvt_pk_bf16(r[6], r[7]);
                    *(u32x4*)(ty + ro + bj * 128) = w; } }
    }
};
struct EpiOut {
    const float* x; float* out; const float* modv;
    __device__ __forceinline__ void operator()(const f32x4 (&acc)[2][2][4][2], const Unit& u, int wr, int wc, int fr, int fq) const {
        const int row0 = u.pm * 256 + wr * 64 + fr, colt = u.pn * 256 + wc * 32 + 8 * fq;
        const float* gt = modv + ((u.pm * 256) >> 13) * 6144 + 2048 + colt;
#pragma unroll
        for (int bj = 0; bj < 2; ++bj) { const f32x4 g0 = *(const f32x4*)(gt + bj * 128), g1 = *(const f32x4*)(gt + bj * 128 + 4);
#pragma unroll
            for (int ai = 0; ai < 2; ++ai)
#pragma unroll
                for (int m = 0; m < 4; ++m) { const size_t off = (size_t)(row0 + ai * 128 + m * 16) * 1024 + colt + bj * 128;
                    *(f32x4*)(out + off) = *(const f32x4*)(x + off) + g0 * acc[ai][bj][m][0]; *(f32x4*)(out + off + 4) = *(const f32x4*)(x + off + 4) + g1 * acc[ai][bj][m][1]; } }
    }
};

__device__ __forceinline__ void p9_route(Frame& F) {
    const float* modv = wsp<float>(F, WS_MODV);
    constexpr int WP = 1032;
    LAS unsigned short* Wt = (LAS unsigned short*)F.lds;
    LAS float* lgs = (LAS float*)(F.lds + 40 * WP * 2) + F.wave * 512;
    LAS int* hist = (LAS int*)(F.lds + 40 * WP * 2 + 16384);
    if (F.tid < 32) hist[F.tid] = 0;
    for (int k = F.tid; k < 1024; k += NTHR) {
        const f32x4 wg = *(const f32x4*)(F.w_grp + (size_t)k * 4), w0 = *(const f32x4*)(F.w_rexp + (size_t)k * 16), w1 = *(const f32x4*)(F.w_rexp + (size_t)k * 16 + 4), w2 = *(const f32x4*)(F.w_rexp + (size_t)k * 16 + 8), w3 = *(const f32x4*)(F.w_rexp + (size_t)k * 16 + 12);
        const float wv[20] = {wg[0], wg[1], wg[2], wg[3], w0[0], w0[1], w0[2], w0[3], w1[0], w1[1], w1[2], w1[3], w2[0], w2[1], w2[2], w2[3], w3[0], w3[1], w3[2], w3[3]};
#pragma unroll
        for (int n = 0; n < 20; ++n) { const unsigned hi = pkbf(wv[n], 0.f) & 0xffffu; Wt[n * WP + k] = (unsigned short)hi; Wt[(20 + n) * WP + k] = (unsigned short)(pkbf(wv[n] - bflo(hi), 0.f) & 0xffffu); } }
    __syncthreads();
    int* rexp = (int*)(F.ws + WS_ROUTE + RT_EXP); float* rw = (float*)(F.ws + WS_ROUTE + RT_W); int* rpos = (int*)(F.ws + WS_ROUTE + RT_POS);
    const int gw = F.bid * NW + F.wave, NGW = F.G * NW, li = F.lane & 15, lg = F.lane >> 4;
    const int n1 = 16 + li < 20 ? 16 + li : 19;
    for (int t = gw; t < M_LAT / 16; t += NGW) {
        const int m = 16 * t + li; const float* src = F.out + (size_t)m * D + 8 * lg; const float* mv = modv + (m >> 13) * 6144 + 8 * lg;
        float ss = 0.f;
#pragma unroll 8
        for (int ks = 0; ks < 32; ++ks) { const f32x4 a = *(const f32x4*)(src + 32 * ks), c = *(const f32x4*)(src + 32 * ks + 4); ss += (a.x * a.x + a.y * a.y) + (a.z * a.z + a.w * a.w) + (c.x * c.x + c.y * c.y) + (c.z * c.z + c.w * c.w); }
        ss += __shfl_xor(ss, 16); ss += __shfl_xor(ss, 32);
        const float rstd = 1.f / sqrtf(ss * (1.f / D) + EPS);
        f32x4 acc0 = {0.f, 0.f, 0.f, 0.f}, acc1 = acc0;
        bf16* o = wsp<bf16>(F, WS_H2) + (size_t)m * D + 8 * lg;
#pragma unroll 4
        for (int ks = 0; ks < 32; ++ks) { const int c = 32 * ks;
            const f32x4 xa = *(const f32x4*)(src + c), xb = *(const f32x4*)(src + c + 4);
            const f32x4 ga = *(const f32x4*)(F.g_norm2 + 8 * lg + c), gb = *(const f32x4*)(F.g_norm2 + 8 * lg + c + 4);
            const f32x4 sha = *(const f32x4*)(mv + 3072 + c), shb = *(const f32x4*)(mv + 3072 + c + 4), sca = *(const f32x4*)(mv + 4096 + c), scb = *(const f32x4*)(mv + 4096 + c + 4);
            const f32x4 ha = (xa * rstd) * ga * (sca + 1.f) + sha, hb = (xb * rstd) * gb * (scb + 1.f) + shb;
            u32x4 hi; hi.x = pkbf(ha[0], ha[1]); hi.y = pkbf(ha[2], ha[3]); hi.z = pkbf(hb[0], hb[1]); hi.w = pkbf(hb[2], hb[3]);
            u32x4 lo; lo.x = pkbf(ha[0] - bflo(hi.x), ha[1] - bfhi(hi.x)); lo.y = pkbf(ha[2] - bflo(hi.y), ha[3] - bfhi(hi.y)); lo.z = pkbf(hb[0] - bflo(hi.z), hb[1] - bfhi(hi.z)); lo.w = pkbf(hb[2] - bflo(hi.w), hb[3] - bfhi(hi.w));
            *(u32x4*)(o + c) = hi;
            const bf16x8 Ah = __builtin_bit_cast(bf16x8, hi), Al = __builtin_bit_cast(bf16x8, lo);
            const bf16x8 bh0 = *(const LAS bf16x8*)(Wt + li * WP + c + 8 * lg), bh1 = *(const LAS bf16x8*)(Wt + n1 * WP + c + 8 * lg), bl0 = *(const LAS bf16x8*)(Wt + (20 + li) * WP + c + 8 * lg), bl1 = *(const LAS bf16x8*)(Wt + (20 + n1) * WP + c + 8 * lg);
            acc0 = __builtin_amdgcn_mfma_f32_16x16x32_bf16(Ah, bh0, acc0, 0, 0, 0); acc1 = __builtin_amdgcn_mfma_f32_16x16x32_bf16(Ah, bh1, acc1, 0, 0, 0);
            acc0 = __builtin_amdgcn_mfma_f32_16x16x32_bf16(Al, bh0, acc0, 0, 0, 0); acc1 = __builtin_amdgcn_mfma_f32_16x16x32_bf16(Al, bh1, acc1, 0, 0, 0);
            acc0 = __builtin_amdgcn_mfma_f32_16x16x32_bf16(Ah, bl0, acc0, 0, 0, 0); acc1 = __builtin_amdgcn_mfma_f32_16x16x32_bf16(Ah, bl1, acc1, 0, 0, 0); }
#pragma unroll
        for (int r = 0; r < 4; ++r) { lgs[(4 * lg + r) * 32 + li] = acc0[r]; lgs[(4 * lg + r) * 32 + 16 + li] = acc1[r]; }
        LDS_WAIT(); asm volatile("" ::: "memory");
        if (F.lane < 16) {
            const int mr = 16 * t + F.lane;
            const f32x4 lq0 = *(const LAS f32x4*)(lgs + F.lane * 32), lq1 = *(const LAS f32x4*)(lgs + F.lane * 32 + 4), lq2 = *(const LAS f32x4*)(lgs + F.lane * 32 + 8), lq3 = *(const LAS f32x4*)(lgs + F.lane * 32 + 12), lq4 = *(const LAS f32x4*)(lgs + F.lane * 32 + 16);
            const f32x4 bg = *(const f32x4*)F.b_grp;
            float gl[4] = {lq0[0] + bg[0], lq0[1] + bg[1], lq0[2] + bg[2], lq0[3] + bg[3]};
            int grp = 0; float gmax = gl[0];
#pragma unroll
            for (int q = 1; q < 4; ++q) if (gl[q] > gmax) { gmax = gl[q]; grp = q; }
            float gs = 0.f;
#pragma unroll
            for (int q = 0; q < 4; ++q) gs += expf(gl[q] - gmax);
            const float grp_p = 1.f / gs;
            float el[4];
#pragma unroll
            for (int q = 0; q < 4; ++q) { float v = lq1[q]; v = grp == 1 ? lq2[q] : v; v = grp == 2 ? lq3[q] : v; v = grp == 3 ? lq4[q] : v; asm volatile("" : "+v"(v)); el[q] = v + F.b_rexp[grp * 4 + q]; }
            int i0 = 0; float e0v = el[0];
#pragma unroll
            for (int q = 1; q < 4; ++q) if (el[q] > e0v) { e0v = el[q]; i0 = q; }
            int i1 = -1; float e1v = -3.0e38f;
#pragma unroll
            for (int q = 0; q < 4; ++q) if (q != i0 && el[q] > e1v) { e1v = el[q]; i1 = q; }
            const float e1 = expf(e1v - e0v); const float w0 = grp_p / (1.f + e1), w1 = grp_p * e1 / (1.f + e1);
            const int x0 = grp * 4 + i0, x1 = grp * 4 + i1;
            rexp[2 * mr] = x0; rexp[2 * mr + 1] = x1; rw[2 * mr] = w0; rw[2 * mr + 1] = w1;
            rpos[2 * mr] = __hip_atomic_fetch_add(hist + x0, 1, __ATOMIC_RELAXED, __HIP_MEMORY_SCOPE_WORKGROUP);
            rpos[2 * mr + 1] = __hip_atomic_fetch_add(hist + x1, 1, __ATOMIC_RELAXED, __HIP_MEMORY_SCOPE_WORKGROUP);
        }
        LDS_WAIT(); asm volatile("" ::: "memory");
    }
    __syncthreads();
    if (F.tid < 16) hist[16 + F.tid] = (int)__hip_atomic_fetch_add((unsigned*)(F.ws + WS_CTL) + CW_CNT + 64 * F.tid, (unsigned)hist[F.tid], __ATOMIC_RELAXED, __HIP_MEMORY_SCOPE_AGENT);
    __syncthreads();
    VM_WAIT();
    for (int t = gw; t < M_LAT / 16; t += NGW) if (F.lane < 32) { const int a = 32 * t + F.lane, e = rexp[a], pos = rpos[a] + hist[16 + e]; rpos[a] = pos;
        wsp<int>(F, WS_LTOK)[e * LCAP + pos] = a >> 1; wsp<float>(F, WS_LW)[e * LCAP + pos] = rw[a]; }
    __syncthreads();
    moe_weight_copies<0>(F);
}
__device__ __forceinline__ void moe_layout(Frame& F) {
    LAS int* tab = (LAS int*)(F.lds + LDS_TAB);
    if (F.tid == 0) { int a = 0; for (int e = 0; e < 16; ++e) { const int c = (int)__hip_atomic_load((unsigned*)(F.ws + WS_CTL) + CW_CNT + 64 * e, __ATOMIC_RELAXED, __HIP_MEMORY_SCOPE_AGENT); tab[e] = a; tab[32 + e] = c; a += (c + 255) & ~255; } tab[16] = a; tab[17] = a >> 8; }
    __syncthreads();
}
struct EpiUp {
    unsigned char* ws;
    __device__ __forceinline__ void operator()(const f32x4 (&acc)[2][2][4][2], const Unit& u, int wr, int wc, int fr, int fq) const {
        const int row0 = u.pm * 256 + wr * 64 + fr; bf16* base = (bf16*)(ws + WS_HID) + u.pn * 128 + wc * 32 + 8 * fq;
#pragma unroll
        for (int ai = 0; ai < 2; ++ai)
#pragma unroll
            for (int m = 0; m < 4; ++m) { const f32x4 g0 = acc[ai][0][m][0], g1 = acc[ai][0][m][1], u0 = acc[ai][1][m][0], u1 = acc[ai][1][m][1];
                u32x4 w; w.x = cvt_pk_bf16(siluf(g0[0]) * u0[0], siluf(g0[1]) * u0[1]); w.y = cvt_pk_bf16(siluf(g0[2]) * u0[2], siluf(g0[3]) * u0[3]);
                w.z = cvt_pk_bf16(siluf(g1[0]) * u1[0], siluf(g1[1]) * u1[1]); w.w = cvt_pk_bf16(siluf(g1[2]) * u1[2], siluf(g1[3]) * u1[3]);
                *(u32x4*)(base + (size_t)(row0 + ai * 128 + m * 16) * 512) = w; }
    }
};
struct EpiDown {
    unsigned char* ws; const LAS int* tab;
    __device__ __forceinline__ void operator()(const f32x4 (&acc)[2][2][4][2], const Unit& u, int wr, int wc, int fr, int fq) const {
        const int row0 = u.pm * 256 + wr * 64 + fr; bf16* base = (bf16*)(ws + WS_YROWS) + u.pn * 256 + wc * 32 + 8 * fq;
        const float* lw = (const float*)(ws + WS_LW) + u.e * LCAP - tab[u.e];
#pragma unroll
        for (int ai = 0; ai < 2; ++ai)
#pragma unroll
            for (int m = 0; m < 4; ++m) { const int row = row0 + ai * 128 + m * 16; const float rwt = lw[row];
#pragma unroll
                for (int bj = 0; bj < 2; ++bj) { const f32x4 v0 = acc[ai][bj][m][0] * rwt, v1 = acc[ai][bj][m][1] * rwt;
                    u32x4 w; w.x = cvt_pk_bf16(v0[0], v0[1]); w.y = cvt_pk_bf16(v0[2], v0[3]); w.z = cvt_pk_bf16(v1[0], v1[1]); w.w = cvt_pk_bf16(v1[2], v1[3]);
                    *(u32x4*)(base + (size_t)row * 1024 + bj * 128) = w; } }
    }
};
__device__ __forceinline__ void p13_final(Frame& F) {
    moe_layout(F);
    const LAS int* tab = (const LAS int*)(F.lds + LDS_TAB);
    const float* modv = wsp<float>(F, WS_MODV); const int* rpos = (const int*)(F.ws + WS_ROUTE + RT_POS); const int* rexp = (const int*)(F.ws + WS_ROUTE + RT_EXP); const bf16* Y = wsp<bf16>(F, WS_YROWS);
    const int gw = F.bid * NW + F.wave, NGW = F.G * NW;
    for (int m = gw; m < M_LAT; m += NGW) {
        float* row = F.out + (size_t)m * D; const float* gt = modv + (m >> 13) * 6144 + 5120;
        const bf16* y0 = Y + (size_t)(tab[rexp[2 * m]] + rpos[2 * m]) * 1024; const bf16* y1 = Y + (size_t)(tab[rexp[2 * m + 1]] + rpos[2 * m + 1]) * 1024;
        f32x4 v[4]; float s = 0.f;
#pragma unroll
        for (int j = 0; j < 4; ++j) { const int c = 4 * F.lane + 256 * j; const u32x2 a = *(const u32x2*)(y0 + c), b = *(const u32x2*)(y1 + c); const f32x4 g = *(const f32x4*)(gt + c);
            f32x4 yy; yy.x = bflo(a.x) + bflo(b.x); yy.y = bfhi(a.x) + bfhi(b.x); yy.z = bflo(a.y) + bflo(b.y); yy.w = bfhi(a.y) + bfhi(b.y);
            v[j] = *(const f32x4*)(row + c) + g * yy; s += (v[j].x * v[j].x + v[j].y * v[j].y) + (v[j].z * v[j].z + v[j].w * v[j].w); }
        const float rstd = 1.f / sqrtf(wave_sum(s) * (1.f / D) + EPS);
#pragma unroll
        for (int j = 0; j < 4; ++j) { const int c = 4 * F.lane + 256 * j; *(f32x4*)(row + c) = (v[j] * rstd) * *(const f32x4*)(F.g_final + c); }
    }
}

typedef const Args __attribute__((address_space(4))) * KArgsP;
__device__ __forceinline__ void load_inputs(Frame& F) {
    KArgsP ap = (KArgsP)__builtin_amdgcn_kernarg_segment_ptr();
    asm volatile("" : "+s"(ap));
    F.x = ap->in[0]; F.c = ap->in[1]; F.ctx = ap->in[2]; F.c_ctx = ap->in[3]; F.w_mod = ap->in[4]; F.b_mod = ap->in[5]; F.g_norm1 = ap->in[6]; F.w_in = ap->in[7];
    F.ml_conv = ap->in[8]; F.ml_conv_b = ap->in[9]; F.b_mgate = ap->in[10]; F.ml_norm = ap->in[11]; F.gla_w2 = ap->in[12]; F.gla_b2 = ap->in[13]; F.gla_norm = ap->in[14];
    F.w_proj_m = ap->in[15]; F.w_proj_g = ap->in[16]; F.w_out = ap->in[17]; F.g_norm2 = ap->in[18]; F.w_grp = ap->in[19]; F.b_grp = ap->in[20]; F.w_rexp = ap->in[21]; F.b_rexp = ap->in[22];
    F.w_up = ap->in[23]; F.w_down = ap->in[24]; F.g_final = ap->in[25];
    F.ws = ap->ws; F.out = ap->out;
    int ln = (int)__builtin_amdgcn_mbcnt_hi(~0u, __builtin_amdgcn_mbcnt_lo(~0u, 0u)); asm volatile("" : "+v"(ln)); F.lane = ln; F.tid = F.wave * 64 + ln;
}
constexpr int N_PHASES = 14;
__global__ void __launch_bounds__(NTHR, 2) mk_fwd(Args args) {
    extern __shared__ __attribute__((aligned(16))) unsigned char lds[];
    Frame F;
    F.lds = (LAS unsigned char*)lds; F.MISC = (volatile LAS unsigned*)(F.lds + MISC_OFF);
    F.tid = threadIdx.x; F.lane = F.tid & 63; F.wave = __builtin_amdgcn_readfirstlane(F.tid >> 6); F.G = gridDim.x; F.bid = blockIdx.x;
    F.ws = args.ws; F.out = args.out;
    for (int u = F.tid; u < (LDS_BYTES - LDSCTL_OFF) / 4; u += NTHR) ((LAS unsigned*)(F.lds + LDSCTL_OFF))[u] = 0u;
    __syncthreads();
    const int lo = args.ph_lo, hi = args.ph_hi;
    XcdBarrier bar; bar.bar = (unsigned*)(F.ws + WS_CTL) + CW_BAR; bar.x = 0; bar.st = nullptr;
    if (hi - lo > 1) bar = xcd_barrier_post((unsigned*)(F.ws + WS_CTL) + CW_BAR, F.MISC + 8);
#ifndef PH_MASK
#define PH_MASK 0xFFFF
#endif
#define IN(k) (((PH_MASK >> (k)) & 1) && lo <= (k) && (k) < hi)
#define REPS(k) for (int rep_ = 0; rep_ < (((REP_MASK >> (k)) & 1) ? 2 : 1); ++rep_)
#define SEAM(k) do { if (IN(k) && IN((k) + 1)) xcd_barrier(bar, F.tid); } while (0)
    const int vc = (int)blockIdx.x;
    if (IN(0)) REPS(0) { load_inputs(F); p0_prologue(F); SEAM(0); }
    if (IN(1)) REPS(1) { load_inputs(F); p1_hx(F); p0_weight_copies<0>(F); SEAM(1); }
    if (IN(2)) REPS(2) { load_inputs(F); pg8::DenseSched S; S.init(wsp<bf16>(F, WS_HX), wsp<bf16>(F, WS_WA), MT, NA, D, F.G, vc); EpiProjA E{F.ws, F.b_mgate};
        pg8::gemm_phase<EpiProjA, pg8::DenseSched, true>(F.lds, S, E, F.wave); p0_weight_copies<1>(F, F.G == 256 ? (MT / 256) * (NA / 256) % 256 : 0); SEAM(2); }
    if (IN(3)) REPS(3) { load_inputs(F); p3_prep(F); SEAM(3); }
#if SCAN_SCALAR
    if (IN(4)) REPS(4) { load_inputs(F); p4_scan_local(F); SEAM(4); }
    if (IN(5)) REPS(5) { load_inputs(F); p5_scan_out(F); SEAM(5); }
#else
    if (IN(4)) REPS(4) { load_inputs(F); p4m_scan_local(F); SEAM(4); }
    if (IN(5)) REPS(5) { load_inputs(F); p5m_scan_out(F); SEAM(5); }
#endif
    if (IN(6)) REPS(6) { load_inputs(F); pg8::DenseSched S; S.init(wsp<bf16>(F, WS_HX), wsp<bf16>(F, WS_WB), M_LAT, NB, D, F.G, vc); EpiProjB E{F.ws, F.ml_norm, F.gla_norm};
        pg8::gemm_phase<EpiProjB, pg8::DenseSched, true>(F.lds, S, E, F.wave); SEAM(6); }
    if (IN(7)) REPS(7) { load_inputs(F);
        { pg8::DenseSched S; S.init(wsp<bf16>(F, WS_QKM), wsp<bf16>(F, WS_WPM), M_LAT, D, D, F.G, vc); EpiGate<0> E{F.ws}; pg8::gemm_phase<EpiGate<0>, pg8::DenseSched, false>(F.lds, S, E, F.wave); }
        VM_WAIT(); __syncthreads();
        { pg8::DenseSched S; S.init(wsp<bf16>(F, WS_QKG), wsp<bf16>(F, WS_WPG), M_LAT, D, D, F.G, vc); EpiGate<1> E{F.ws}; pg8::gemm_phase<EpiGate<1>, pg8::DenseSched, false>(F.lds, S, E, F.wave); }
        SEAM(7); }
    if (IN(8)) REPS(8) { load_inputs(F); pg8::DenseSched S; S.init(wsp<bf16>(F, WS_VM), wsp<bf16>(F, WS_WOUT), M_LAT, D, D, F.G, vc); EpiOut E{F.x, F.out, wsp<float>(F, WS_MODV)};
        pg8::gemm_phase<EpiOut, pg8::DenseSched, false>(F.lds, S, E, F.wave); SEAM(8); }
    if (IN(9)) REPS(9) { load_inputs(F); p9_route(F); if (IN(9) && IN(11)) xcd_barrier(bar, F.tid); }
    if (IN(11)) REPS(11) { load_inputs(F); moe_layout(F); pg8::GroupSched<true> S; S.A = wsp<bf16>(F, WS_H2); S.Bt = wsp<bf16>(F, WS_WUP); S.list_tok = wsp<int>(F, WS_LTOK); S.tab = (const LAS int*)(F.lds + LDS_TAB);
        S.K = 1024; S.ntiles = S.tab[17]; S.G = F.G; S.c = vc; EpiUp E{F.ws};
        pg8::gemm_phase<EpiUp, pg8::GroupSched<true>, true>(F.lds, S, E, F.wave); moe_weight_copies<1>(F, F.G == 256 ? (S.ntiles * 4) % 256 : 0); SEAM(11); }
    if (IN(12)) REPS(12) { load_inputs(F); moe_layout(F); pg8::GroupSched<false> S; S.A = wsp<bf16>(F, WS_HID); S.Bt = wsp<bf16>(F, WS_WDN); S.list_tok = nullptr; S.tab = (const LAS int*)(F.lds + LDS_TAB);
        S.K = 512; S.ntiles = S.tab[17]; S.G = F.G; S.c = vc; EpiDown E{F.ws, (const LAS int*)(F.lds + LDS_TAB)};
        pg8::gemm_phase<EpiDown, pg8::GroupSched<false>, true>(F.lds, S, E, F.wave); SEAM(12); }
    if (IN(13)) REPS(13) { load_inputs(F); p13_final(F); }
#undef IN
#undef SEAM
}

extern "C" void kernel_launch(void* const* d_in, const int* in_sizes, int n_in, void* d_out, int out_size, void* d_ws, size_t ws_size, hipStream_t stream) {
    static int grid = 0;
    if (grid == 0) {
        if (n_in != 26 || out_size != M_LAT * D || ws_size < WS_END) { fprintf(stderr, "kernel_launch: unexpected shapes (n_in %d, out %d, ws %zu)\n", n_in, out_size, ws_size); grid = -1; return; }
        int dev = 0, cus = 0, per_cu = 0;
        if (hipGetDevice(&dev) != hipSuccess || hipDeviceGetAttribute(&cus, hipDeviceAttributeMultiprocessorCount, dev) != hipSuccess) { grid = -1; return; }
        if (hipFuncSetAttribute((const void*)mk_fwd, hipFuncAttributeMaxDynamicSharedMemorySize, LDS_BYTES) != hipSuccess) { fprintf(stderr, "kernel_launch: hipFuncSetAttribute failed\n"); grid = -1; return; }
        if (hipOccupancyMaxActiveBlocksPerMultiprocessor(&per_cu, (const void*)mk_fwd, NTHR, LDS_BYTES) != hipSuccess || per_cu < 1) fprintf(stderr, "kernel_launch: occupancy query reports %d\n", per_cu);
        (void)hipGetLastError();
        grid = cus;
    }
    if (grid < 0) return;
    (void)hipMemsetAsync((char*)d_ws + WS_CTL, 0, CTL_ZERO_BYTES, stream);
    Args a{};
    for (int i = 0; i < 26; ++i) a.in[i] = (const float*)d_in[i];
    a.out = (float*)d_out; a.ws = (unsigned char*)d_ws;
#if MK_ONE_LAUNCH
    a.ph_lo = 0; a.ph_hi = N_PHASES;
    hipLaunchKernelGGL(mk_fwd, dim3(grid), dim3(NTHR), LDS_BYTES, stream, a);
#else
    for (int p = 0; p < N_PHASES; ++p) { a.ph_lo = p; a.ph_hi = p + 1; hipLaunchKernelGGL(mk_fwd, dim3(grid), dim3(NTHR), LDS_BYTES, stream, a); }
#endif
}
```

```cpp
#include <hip/hip_runtime.h>
#include <cstdio>
#include <cstdint>

#ifndef SCAN_SCALAR
#define SCAN_SCALAR 0
#endif
#ifndef REP_MASK
#define REP_MASK 0x0
#endif
#ifndef MK_ONE_LAUNCH
#define MK_ONE_LAUNCH 1
#endif

#define LAS __attribute__((address_space(3)))
typedef unsigned short bf16;
typedef short bf16x8 __attribute__((ext_vector_type(8)));
typedef float f32x4 __attribute__((ext_vector_type(4)));
typedef float f32x2 __attribute__((ext_vector_type(2)));
typedef unsigned u32x4 __attribute__((ext_vector_type(4)));
typedef unsigned u32x2 __attribute__((ext_vector_type(2)));

constexpr int D = 1024, BATCH = 2, SEQ = 8192, CTXL = 256;
constexpr int M_LAT = BATCH * SEQ;
constexpr int M_CTX = BATCH * CTXL;
constexpr int MT = M_LAT + M_CTX;
constexpr int NW = 8, NTHR = 512;
constexpr int IN_W = 8240;
constexpr int NA = 4352;
constexpr int NB = 4096;
constexpr int CHUNK = 64, NCH_LAT = SEQ / CHUNK  , NCH_CTX = CTXL / CHUNK  ;
constexpr int NCHUNK = BATCH * NCH_LAT + BATCH * NCH_CTX;
constexpr int NSEG = 8, CPS = NCH_LAT / NSEG;
constexpr int NEXP = 16, DEXP = 512, NROWS_MAX = 36864  ;
constexpr float EPS = 1e-6f;

constexpr size_t MiB = 1u << 20;
constexpr size_t BIG = (size_t)MT * 1024 * 2;
constexpr size_t WS_CTL = 0, CTL_ZERO_BYTES = 1 * MiB;
constexpr size_t WS_MODV = 1 * MiB;
constexpr size_t WS_AB = 2 * MiB;
constexpr size_t WS_GENDM = WS_AB + 1088 * 1024;
constexpr size_t WS_GENDG = 4 * MiB;
constexpr size_t WS_SSQ = WS_GENDG + 1088 * 1024;
constexpr size_t WS_WA = 7 * MiB;
constexpr size_t WS_WB = 16 * MiB;
constexpr size_t WS_WPM = 24 * MiB, WS_WPG = 26 * MiB, WS_WOUT = 28 * MiB;
constexpr size_t WS_GATES = 30 * MiB;
constexpr size_t WS_NST = 35 * MiB;
constexpr size_t WS_GSEG = WS_NST + 256 * 1024;
constexpr size_t WS_ROUTE = 36 * MiB;
constexpr size_t WS_HX = 37 * MiB;
constexpr size_t WS_QKM = WS_HX + BIG;
constexpr size_t WS_VM = WS_QKM + BIG;
constexpr size_t WS_QKG = WS_VM + BIG;
constexpr size_t WS_VG = WS_QKG + BIG;
constexpr size_t WS_QKMC = WS_VG + BIG;
constexpr size_t WS_STATE = WS_QKMC + BIG;
constexpr size_t WS_QKGTC = WS_STATE + 16 * MiB;
constexpr size_t WS_END = WS_QKGTC + 2 * MiB;
static_assert(WS_END <= 256 * MiB, "ws map");
constexpr size_t WS_WUP = WS_HX;
constexpr size_t WS_H2 = 70 * MiB;
constexpr size_t WS_WDN = 103 * MiB;
constexpr size_t WS_HID = 136 * MiB;
constexpr size_t WS_YROWS = 172 * MiB;
constexpr size_t RT_EXP = 0;
constexpr size_t RT_W = 128 * 1024;
constexpr size_t RT_POS = 256 * 1024;
constexpr size_t RT_ROWTOK = 384 * 1024;
constexpr size_t RT_ROWW = 384 * 1024 + 144 * 1024;
constexpr size_t RT_TILE_E = 384 * 1024 + 288 * 1024;
constexpr size_t WS_LTOK = 120 * MiB, WS_LW = 122 * MiB;
constexpr int LCAP = 32768;
constexpr int LDS_TAB = 147456 - 1024 + 768;
constexpr int CW_BAR = 4096;
constexpr int CW_CNT = 8192;

#define LDS_WAIT() asm volatile("s_waitcnt lgkmcnt(0)" ::: "memory")
#define VM_WAIT() asm volatile("s_waitcnt vmcnt(0)" ::: "memory")
__device__ __forceinline__ unsigned f2bf(float f) { unsigned u = __builtin_bit_cast(unsigned, f); return (u + 0x7fffu + ((u >> 16) & 1u)) >> 16; }
typedef __bf16 bf16x2_t __attribute__((ext_vector_type(2)));
__device__ __forceinline__ unsigned pkbf(float lo, float hi) { f32x2 v = {lo, hi}; return __builtin_bit_cast(unsigned, __builtin_convertvector(v, bf16x2_t)); }
__device__ __forceinline__ unsigned pk2(float lo, float hi) { return pkbf(lo, hi); }
__device__ __forceinline__ float bf2f(unsigned short h) { return __builtin_bit_cast(float, (unsigned)h << 16); }
__device__ __forceinline__ float bflo(unsigned w) { return __builtin_bit_cast(float, w << 16); }
__device__ __forceinline__ float bfhi(unsigned w) { return __builtin_bit_cast(float, w & 0xffff0000u); }
__device__ __forceinline__ float sigm(float x) { return __builtin_amdgcn_rcpf(1.f + __expf(-x)); }
__device__ __forceinline__ float siluf(float x) { return x * __builtin_amdgcn_rcpf(1.f + __expf(-x)); }
__device__ __forceinline__ float logsig(float x) { return fminf(x, 0.f) - log1pf(expf(-fabsf(x))); }
__device__ __forceinline__ float wave_sum(float v) {
#pragma unroll
    for (int o = 1; o < 64; o <<= 1) v += __shfl_xor(v, o);
    return v;
}

namespace pg8 {
#define PG8_LAS __attribute__((address_space(3)))
constexpr int BM = 256, BK = 64, HALF = 128, HTB = HALF * BK * 2, STAGE_BYTES = 8 * HTB, NXCD = 8, WGM = 8;
__host__ __device__ __forceinline__ int lds_byte(int r, int c) { const int st = (r >> 4) * 2 + (c >> 5), rr = r & 15, cc = c & 31, ob = rr * 64 + cc * 2; return st * 1024 + (ob ^ (((ob >> 9) & 1) << 5)); }
__host__ __device__ __forceinline__ void stage_rc(int b, int& R, int& C) { const int st = b / 1024, sb = b % 1024, swz = sb ^ (((sb >> 9) & 1) << 5); R = (st >> 1) * 16 + swz / 64; C = (st & 1) * 32 + (swz % 64) / 2; }
__host__ __device__ __forceinline__ int perm32(int rho) { const int n = rho >> 4, i = rho & 15; return 8 * (i >> 2) + 4 * n + (i & 3); }
struct Unit { int pm, pn, e; };
__device__ __forceinline__ unsigned cvt_pk_bf16(float lo, float hi) { return pkbf(lo, hi); }

struct DenseSched {
    static constexpr bool GATHER = false;
    const bf16* A; const bf16* Bt; int K, nM, nN, nwg, G, c;
    __device__ void init(const bf16* A_, const bf16* Bt_, int M, int N, int K_, int G_, int c_) { A = A_; Bt = Bt_; K = K_; nM = M / BM; nN = N / BM; nwg = nM * nN; G = G_; c = c_; }
    __device__ bool next(int i, Unit& u) const {
        const long L = (long)i * G + c; if (L >= nwg) return false;
        int wgid = (int)L; { const int q = nwg / NXCD, r = nwg % NXCD, xcd = wgid % NXCD, off = wgid / NXCD; wgid = (xcd < r ? xcd * (q + 1) : r * (q + 1) + (xcd - r) * q) + off; }
        const int nig = WGM * nN, gid = wgid / nig, fm = gid * WGM, gsz = (nM - fm) < WGM ? (nM - fm) : WGM;
        u.pm = fm + ((wgid % nig) % gsz); u.pn = (wgid % nig) / gsz; u.e = 0; return true;
    }
    __device__ __forceinline__ const char* a_base(const Unit& u) const { return (const char*)A + (size_t)u.pm * BM * K * 2; }
    __device__ __forceinline__ const char* b_base(const Unit& u) const { return (const char*)Bt + (size_t)u.pn * BM * K * 2; }
    __device__ __forceinline__ void a_offs(const Unit&, const int (&R)[2], const int (&C)[2], unsigned (&o)[2][2]) const {
#pragma unroll
        for (int h = 0; h < 2; ++h)
#pragma unroll
            for (int i = 0; i < 2; ++i) o[h][i] = (unsigned)((h * HALF + R[i]) * K + C[i]) * 2u;
    }
};
template <bool GATHER_> struct GroupSched {
    static constexpr bool GATHER = GATHER_;
    const bf16* A; const bf16* Bt; const int* list_tok; const PG8_LAS int* tab; int K, ntiles, G, c;
    __device__ bool next(int i, Unit& u) const {
        long L = (long)i * G + c;
        if (G == 256 && (long)(i + 1) * 256 <= (long)ntiles * 4) { const int xc = c & 7, j = c >> 3; L = (long)i * 256 + (long)(((xc << 3) | (j >> 2)) << 2) + (j & 3); }
        if (L >= (long)ntiles * 4) return false;
        u.pm = (int)(L >> 2); u.pn = (int)(L & 3); int e = 0; while (e < 15 && u.pm * BM >= tab[e + 1]) ++e; u.e = e; return true;
    }
    __device__ __forceinline__ const char* a_base(const Unit& u) const { return GATHER ? (const char*)A : (const char*)A + (size_t)u.pm * BM * K * 2; }
    __device__ __forceinline__ const char* b_base(const Unit& u) const { return (const char*)Bt + ((size_t)u.e * 1024 + (size_t)u.pn * BM) * K * 2; }
    __device__ __forceinline__ void a_offs(const Unit& u, const int (&R)[2], const int (&C)[2], unsigned (&o)[2][2]) const {
        const int pos0 = u.pm * BM - tab[u.e], cnt = tab[32 + u.e];
#pragma unroll
        for (int h = 0; h < 2; ++h)
#pragma unroll
            for (int i = 0; i < 2; ++i) {
                int row = h * HALF + R[i];
                if (GATHER) { const int pos = pos0 + row; const int pc = pos < cnt ? pos : 0; const int tk = list_tok[u.e * 32768 + pc]; row = pos < cnt ? tk : 0; }
                o[h][i] = (unsigned)(row * K + C[i]) * 2u; }
    }
};

template <class Epi, class Sched, bool ALIGN_EPI>
__device__ __forceinline__ void gemm_phase(PG8_LAS unsigned char* lds, const Sched& S, const Epi& E, const int wave_id) {
    int ln_ = (int)__builtin_amdgcn_mbcnt_hi(~0u, __builtin_amdgcn_mbcnt_lo(~0u, 0u)); asm volatile("" : "+v"(ln_));
    const int wid = wave_id, lane = ln_, tid = wid * 64 + lane, wr = wid >> 2, wc = wid & 3, fr = lane & 15, fq = lane >> 4;
    const int K = S.K, nt = K / BK;
    int Rr[2], Cc[2]; unsigned voffB[2];
#pragma unroll
    for (int i = 0; i < 2; ++i) { stage_rc(tid * 16 + i * 8192, Rr[i], Cc[i]); const int Rb = (Rr[i] & ~31) + perm32(Rr[i] & 31); voffB[i] = (unsigned)(Rb * K + Cc[i]) * 2u; }
    const size_t kstep = (size_t)(BK * 2);
    const size_t hstep = (size_t)HALF * K * 2;
    const unsigned ldsw = (unsigned)wid * 1024u;
    const int aoff = lds_byte(wr * 64 + fr, fq * 8), boff = lds_byte(wc * 32 + fr, fq * 8);
#define PG8_SA(b, h) (((b) * 2 + (h)) * HTB)
#define PG8_SB(b, h) ((4 + (b) * 2 + (h)) * HTB)
#define PG8_STAGE(bufoff, gbase, voff) do { _Pragma("unroll") for (int _i = 0; _i < 2; ++_i) \
        __builtin_amdgcn_global_load_lds((const unsigned*)((const char*)(gbase) + (voff)[_i]), (PG8_LAS unsigned*)(lds + (bufoff) + ldsw + _i * 8192), 16, 0, 0); } while (0)
#define PG8_LDA(dst, b, h) do { _Pragma("unroll") for (int m = 0; m < 4; ++m) _Pragma("unroll") for (int k = 0; k < 2; ++k) dst[m][k] = *(const PG8_LAS bf16x8*)(lds + PG8_SA(b, h) + aoff + m * 2048 + k * 1024); } while (0)
#define PG8_LDB(dst, b, h) do { _Pragma("unroll") for (int n = 0; n < 2; ++n) _Pragma("unroll") for (int k = 0; k < 2; ++k) dst[n][k] = *(const PG8_LAS bf16x8*)(lds + PG8_SB(b, h) + boff + n * 2048 + k * 1024); } while (0)
#define PG8_MMA(ai, bj, At, Bt) do { __builtin_amdgcn_s_setprio(1); _Pragma("unroll") for (int m = 0; m < 4; ++m) _Pragma("unroll") for (int n = 0; n < 2; ++n) _Pragma("unroll") for (int k = 0; k < 2; ++k) \
        acc[ai][bj][m][n] = __builtin_amdgcn_mfma_f32_16x16x32_bf16(Bt[n][k], At[m][k], acc[ai][bj][m][n], 0, 0, 0); __builtin_amdgcn_s_setprio(0); } while (0)
#define PG8_WAIT_V(n) asm volatile("s_waitcnt vmcnt(" #n ")" ::: "memory")
#define PG8_WAIT_L(n) asm volatile("s_waitcnt lgkmcnt(" #n ")" ::: "memory")
#define PG8_BAR __builtin_amdgcn_s_barrier()
#define PG8_SCHED __builtin_amdgcn_sched_barrier(0)
    Unit cur, nxt; int ui = 0;
    if (!S.next(0, cur)) return;
    unsigned ao[2][2], nao[2][2];
    S.a_offs(cur, Rr, Cc, ao);
    f32x4 acc[2][2][4][2];
#pragma unroll
    for (int a = 0; a < 2; ++a)
#pragma unroll
        for (int b = 0; b < 2; ++b)
#pragma unroll
            for (int m = 0; m < 4; ++m)
#pragma unroll
                for (int n = 0; n < 2; ++n) acc[a][b][m][n] = (f32x4){0.f, 0.f, 0.f, 0.f};
    bf16x8 At[4][2], B0[2][2], B1[2][2];
    const char* cA = S.a_base(cur); const char* cB = S.b_base(cur);
    PG8_STAGE(PG8_SB(0, 0), cB, voffB); PG8_STAGE(PG8_SB(0, 1), cB + hstep, voffB); PG8_STAGE(PG8_SA(0, 0), cA, ao[0]); PG8_STAGE(PG8_SA(0, 1), cA, ao[1]);
    if (wr == 1) PG8_BAR;
    PG8_WAIT_V(2); PG8_BAR;
    PG8_STAGE(PG8_SB(1, 0), cB + kstep, voffB); PG8_STAGE(PG8_SA(1, 0), cA + kstep, ao[0]); PG8_STAGE(PG8_SB(1, 1), cB + hstep + kstep, voffB);
    PG8_WAIT_V(6); PG8_BAR;
    for (;;) {
        const bool has_next = S.next(ui + 1, nxt);
        if (Sched::GATHER && has_next) S.a_offs(nxt, Rr, Cc, nao);
        else {
#pragma unroll
            for (int h = 0; h < 2; ++h)
#pragma unroll
                for (int i = 0; i < 2; ++i) nao[h][i] = ao[h][i]; }
        const char* nA = has_next ? S.a_base(nxt) : cA; const char* nB = has_next ? S.b_base(nxt) : cB;
        for (int t = 0; t < nt; t += 2) {
            const bool last = (t == nt - 2);
            const char* a1 = cA + (size_t)(t + 1) * kstep;
            const char* a2 = last ? nA : cA + (size_t)(t + 2) * kstep; const char* b2 = last ? nB : cB + (size_t)(t + 2) * kstep;
            const char* a3 = a2 + kstep; const char* b3 = b2 + kstep;
            unsigned o2[2][2];
#pragma unroll
            for (int h = 0; h < 2; ++h)
#pragma unroll
                for (int i = 0; i < 2; ++i) o2[h][i] = (Sched::GATHER && last) ? nao[h][i] : ao[h][i];
            PG8_LDB(B0, 0, 0); PG8_LDB(B1, 0, 1); PG8_SCHED; PG8_LDA(At, 0, 0); PG8_STAGE(PG8_SA(1, 1), a1, ao[1]);
            PG8_WAIT_V(8); PG8_WAIT_L(0); PG8_BAR; PG8_MMA(0, 0, At, B0); PG8_MMA(0, 1, At, B1); PG8_BAR; PG8_SCHED;
            PG8_LDA(At, 0, 1); PG8_STAGE(PG8_SB(0, 0), b2, voffB); PG8_STAGE(PG8_SB(0, 1), b2 + hstep, voffB); PG8_STAGE(PG8_SA(0, 0), a2, o2[0]);
            PG8_WAIT_V(8); PG8_WAIT_L(0); PG8_BAR; PG8_MMA(1, 0, At, B0); PG8_MMA(1, 1, At, B1); PG8_BAR; PG8_SCHED;
            PG8_LDB(B0, 1, 0); PG8_LDB(B1, 1, 1); PG8_SCHED; PG8_LDA(At, 1, 0); PG8_STAGE(PG8_SA(0, 1), a2, o2[1]);
            PG8_WAIT_V(8); PG8_WAIT_L(0); PG8_BAR; PG8_MMA(0, 0, At, B0); PG8_MMA(0, 1, At, B1); PG8_BAR; PG8_SCHED;
            PG8_LDA(At, 1, 1); PG8_STAGE(PG8_SB(1, 0), b3, voffB); PG8_STAGE(PG8_SB(1, 1), b3 + hstep, voffB); PG8_STAGE(PG8_SA(1, 0), a3, o2[0]);
            PG8_WAIT_V(8); PG8_WAIT_L(0); PG8_BAR; PG8_MMA(1, 0, At, B0); PG8_MMA(1, 1, At, B1); PG8_BAR; PG8_SCHED;
        }
        if constexpr (ALIGN_EPI) { if (wr == 0) PG8_BAR; }
        { int fr_ = fr, fq_ = fq; asm volatile("" : "+v"(fr_), "+v"(fq_));
          E(acc, cur, wr, wc, fr_, fq_); }
        if (!has_next) break;
#pragma unroll
        for (int a = 0; a < 2; ++a)
#pragma unroll
            for (int b = 0; b < 2; ++b)
#pragma unroll
                for (int m = 0; m < 4; ++m)
#pragma unroll
                    for (int n = 0; n < 2; ++n) acc[a][b][m][n] = (f32x4){0.f, 0.f, 0.f, 0.f};
        cur = nxt; cA = nA; cB = nB; ++ui;
#pragma unroll
        for (int h = 0; h < 2; ++h)
#pragma unroll
            for (int i = 0; i < 2; ++i) ao[h][i] = nao[h][i];
        if constexpr (ALIGN_EPI) { if (wr == 1) PG8_BAR; }
    }
    PG8_WAIT_V(0);
    if constexpr (!ALIGN_EPI) { if (wr == 0) PG8_BAR; }
    PG8_BAR;
#undef PG8_SA
#undef PG8_SB
#undef PG8_STAGE
#undef PG8_LDA
#undef PG8_LDB
#undef PG8_MMA
#undef PG8_WAIT_V
#undef PG8_WAIT_L
#undef PG8_BAR
#undef PG8_SCHED
}
}
using pg8::Unit; using pg8::cvt_pk_bf16;

#define XB_TMO      128
#define XB_XCNT(j)  (256  + 64 * (j))
#define XB_XSUB(j)  (1280 + 64 * (j))
#define XB_XGEN(j)  (2304 + 64 * (j))
#define XB_TOP      3328
#define XB_TOPGEN   3392
#define XCD_BAR_WORDS 3456
#define XB_SPIN_CAP (1u << 18)
__device__ __forceinline__ unsigned xb_ld(unsigned* p)              { return __hip_atomic_load(p, __ATOMIC_RELAXED, __HIP_MEMORY_SCOPE_AGENT); }
__device__ __forceinline__ unsigned xb_add(unsigned* p, unsigned v) { return __hip_atomic_fetch_add(p, v, __ATOMIC_RELAXED, __HIP_MEMORY_SCOPE_AGENT); }
__device__ __forceinline__ unsigned xb_xcc_id() { return (unsigned)__builtin_amdgcn_s_getreg((3 << 11) | 20) & 0xFu; }
#define XB_SPIN(cond, bar) do { unsigned _sp = 0; while (cond) { __builtin_amdgcn_s_sleep(1); \
    if ((++_sp & 255u) == 0u) { if (xb_ld(&(bar)[XB_TMO])) break; if (_sp > XB_SPIN_CAP) { atomicAdd(&(bar)[XB_TMO], 1u); break; } } } } while (0)
struct XcdBarrier { unsigned* bar; unsigned x; volatile LAS unsigned* st; };
__device__ __forceinline__ XcdBarrier xcd_barrier_post(unsigned* bar, volatile LAS unsigned* st) {
    XcdBarrier b; b.bar = bar; b.x = xb_xcc_id(); b.st = st;
    if (threadIdx.x == 0) (void)xb_add(&bar[XB_XCNT(b.x)], 1u);
    return b;
}
__device__ __forceinline__ void xcd_barrier_complete(unsigned* bar, unsigned x, unsigned& nloc, unsigned& nx) {
    const unsigned G = gridDim.x * gridDim.y * gridDim.z;
    unsigned sum, cnt, mine, sp = 0u;
    for (;;) {
        sum = 0u; cnt = 0u; mine = 0u;
#pragma unroll
        for (unsigned j = 0; j < 16; ++j) { const unsigned c = xb_ld(&bar[XB_XCNT(j)]); sum += c; cnt += (c > 0u) ? 1u : 0u; mine = (j == x) ? c : mine; }
        if (sum == G) break;
        __builtin_amdgcn_s_sleep(1);
        if ((++sp & 255u) == 0u) { if (xb_ld(&bar[XB_TMO])) break; if (sp > XB_SPIN_CAP) { atomicAdd(&bar[XB_TMO], 1u); break; } }
    }
    nloc = mine > 0u ? mine : 1u; nx = cnt > 0u ? cnt : 1u;
}
__device__ __forceinline__ void xcd_barrier(const XcdBarrier& b, const int tid) {
    asm volatile("s_waitcnt vmcnt(0)" ::: "memory");
    __syncthreads();
    if (tid == 0) {
        unsigned* bar = b.bar;
        __builtin_amdgcn_s_waitcnt(0);
        unsigned nloc = b.st[0], nx = b.st[1];
        if (nloc == 0u) { xcd_barrier_complete(bar, b.x, nloc, nx); b.st[0] = nloc; b.st[1] = nx; }
        const unsigned old = xb_add(&bar[XB_XSUB(b.x)], 1u);
        const unsigned gen = old / nloc;
        if (old + 1u == (gen + 1u) * nloc) {
            __builtin_amdgcn_fence(__ATOMIC_RELEASE, "agent");
            asm volatile("s_waitcnt vmcnt(0)" ::: "memory");
            const unsigned og = xb_add(&bar[XB_TOP], 1u);
            const unsigned tg = og / nx;
            if (og + 1u == (tg + 1u) * nx) xb_add(&bar[XB_TOPGEN], 1u);
            else XB_SPIN(xb_ld(&bar[XB_TOPGEN]) == tg, bar);
            __builtin_amdgcn_fence(__ATOMIC_ACQUIRE, "agent");
            xb_add(&bar[XB_XGEN(b.x)], 1u);
            asm volatile("s_waitcnt vmcnt(0)" ::: "memory");
        } else {
            XB_SPIN(xb_ld(&bar[XB_XGEN(b.x)]) == gen, bar);
            __builtin_amdgcn_fence(__ATOMIC_ACQUIRE, "agent");
            asm volatile("s_waitcnt vmcnt(0)" ::: "memory");
        }
    }
    __syncthreads();
}

constexpr int RING_BYTES = 131072;
constexpr int LDS_BYTES = 147456;
constexpr int LDSCTL_OFF = LDS_BYTES - 1024, MISC_OFF = LDSCTL_OFF + 320;

struct Args { const float* in[26]; float* out; unsigned char* ws; int ph_lo, ph_hi; };
struct Frame {
    LAS unsigned char* lds; volatile LAS unsigned* MISC;
    int tid, lane, wave, G, bid;
    unsigned char* ws; float* out;
    const float *x, *c, *ctx, *c_ctx, *w_mod, *b_mod, *g_norm1, *w_in, *ml_conv, *ml_conv_b, *b_mgate, *ml_norm, *gla_w2, *gla_b2, *gla_norm,
                *w_proj_m, *w_proj_g, *w_out, *g_norm2, *w_grp, *b_grp, *w_rexp, *b_rexp, *w_up, *w_down, *g_final;
};
template <class T> __device__ __forceinline__ T* wsp(const Frame& F, size_t off) { return (T*)(F.ws + off); }

struct TItem { const float* W; bf16* WT; int Nsrc, K, k0, n0, sc; };
__device__ __forceinline__ int map_a(int n) { return n < 2048 ? n : (n < 4096 ? n + 1040 : (n < 4112 ? 3072 + (n - 4096) : (n < 4144 ? 6160 + (n - 4112) : -1))); }
__device__ __forceinline__ int map_b(int n) { return n < 1024 ? 2048 + n : (n < 2048 ? 5136 + (n - 1024) : (n < 3072 ? 6192 + (n - 2048) : 7216 + (n - 3072))); }
__device__ __forceinline__ int map_up(int n) { const int pn = n >> 8, j = n & 255; return j < 128 ? 128 * pn + j : 512 + 128 * pn + (j - 128); }
__device__ __forceinline__ void titem_load(const TItem& t, int lane, f32x4 (&v)[8]) {
    const int scc = t.sc < 0 ? 0 : t.sc;
#pragma unroll
    for (int r = 0; r < 8; ++r) v[r] = *(const f32x4*)(t.W + (size_t)(t.k0 + 8 * r + (lane >> 3)) * t.Nsrc + scc);
}
__device__ __forceinline__ void titem_store(const TItem& t, int lane, const f32x4 (&v)[8], LAS float* scr) {
    const float z = t.sc < 0 ? 0.f : 1.f;
#pragma unroll
    for (int r = 0; r < 8; ++r) { const int kk = 8 * r + (lane >> 3); LAS float* d = scr + kk * 33 + 4 * (lane & 7); d[0] = v[r][0] * z; d[1] = v[r][1] * z; d[2] = v[r][2] * z; d[3] = v[r][3] * z; }
    LDS_WAIT(); asm volatile("" ::: "memory");
    const int c = lane & 7;
#pragma unroll
    for (int j = 0; j < 4; ++j) { const int n = (lane >> 3) + 8 * j; const LAS float* s = scr + (8 * c) * 33 + n;
        u32x4 o; o.x = pk2(s[0 * 33], s[1 * 33]); o.y = pk2(s[2 * 33], s[3 * 33]); o.z = pk2(s[4 * 33], s[5 * 33]); o.w = pk2(s[6 * 33], s[7 * 33]);
        *(u32x4*)(t.WT + (size_t)(t.n0 + n) * t.K + t.k0 + 8 * c) = o; }
    LDS_WAIT(); asm volatile("" ::: "memory");
}
template <class Dec>
__device__ __forceinline__ void run_transposes(Frame& F, int nitems, Dec dec, const int skip = 0) {
    LAS float* scr = (LAS float*)(F.lds + F.wave * 16384);
    if (F.bid < skip) return;
    const int gw = (F.bid - skip) * NW + F.wave, NGW = (F.G - skip) * NW, last = nitems - 1;
    if (gw >= nitems) return;
    f32x4 va[8], vb[8]; TItem ia, ib;
    ia = dec(gw, F.lane); titem_load(ia, F.lane, va);
    for (int it = gw; it < nitems; it += 2 * NGW) {
        { const int j = it + NGW; ib = dec(j < last ? j : last, F.lane); titem_load(ib, F.lane, vb); }
        titem_store(ia, F.lane, va, scr);
        { const int j = it + 2 * NGW; ia = dec(j < last ? j : last, F.lane); titem_load(ia, F.lane, va); }
        if (it + NGW < nitems) titem_store(ib, F.lane, vb, scr);
    }
}
__device__ __forceinline__ void p0_prologue(Frame& F) {
    LAS float* scr = (LAS float*)(F.lds + F.wave * 16384);
    const int gw = F.bid * NW + F.wave, NGW = F.G * NW;
    if (F.bid < 192) {
        LAS float* red = (LAS float*)(F.lds);
        const int r = F.tid >> 3, c4 = F.tid & 7, col0 = F.bid * 32 + 4 * c4;
        f32x4 a0 = {0.f, 0.f, 0.f, 0.f}, a1 = a0, a2 = a0;
        for (int k = r; k < D; k += 64) {
            const f32x4 w = *(const f32x4*)(F.w_mod + (size_t)k * 6144 + col0);
            const float s0 = siluf(F.c[k]), s1 = siluf(F.c[D + k]), s2 = siluf(F.c_ctx[k]);
            a0 += w * s0; a1 += w * s1; a2 += w * s2; }
#pragma unroll
        for (int j = 0; j < 4; ++j) { red[r * 96 + 0 + 4 * c4 + j] = a0[j]; red[r * 96 + 32 + 4 * c4 + j] = a1[j]; red[r * 96 + 64 + 4 * c4 + j] = a2[j]; }
        __syncthreads();
        if (F.tid < 96) { float s = 0.f; for (int q = 0; q < 64; ++q) s += red[q * 96 + F.tid]; const int rr = F.tid >> 5, j = F.bid * 32 + (F.tid & 31);
            wsp<float>(F, WS_MODV)[rr * 6144 + j] = s + F.b_mod[j]; }
        __syncthreads();
    }
}
template <int PART>
__device__ __forceinline__ void p0_weight_copies(Frame& F, const int skip = 0) {
    constexpr int I_A = (NA / 32) * 16, I_B = (NB / 32) * 16, I_P = (1024 / 32) * 16;
    const float* w_in = F.w_in; const float* wpm = F.w_proj_m; const float* wpg = F.w_proj_g; const float* wo = F.w_out; unsigned char* ws = F.ws;
    run_transposes(F, PART == 0 ? I_A : I_B + 3 * I_P, [=](int it, int lane) {
        TItem t; t.K = D; const int r = PART == 0 ? it : it + I_A;
        const bool isA = r < I_A, isB = !isA && r < I_A + I_B; const int rp = r - I_A - I_B, pi = rp < 0 ? 0 : rp / I_P;
        const int rr = isA ? r : (isB ? r - I_A : rp - pi * I_P);
        t.k0 = 64 * (rr & 15); t.n0 = 32 * (rr >> 4); const int n = t.n0 + 4 * (lane & 7);
        t.W = (isA || isB) ? w_in : (pi == 0 ? wpm : (pi == 1 ? wpg : wo)); t.Nsrc = (isA || isB) ? IN_W : D;
        t.WT = (bf16*)(ws + (isA ? WS_WA : (isB ? WS_WB : (pi == 0 ? WS_WPM : (pi == 1 ? WS_WPG : WS_WOUT)))));
        t.sc = isA ? map_a(n) : (isB ? map_b(n) : n);
        return t; }, skip);
}
template <int PART>
__device__ __forceinline__ void moe_weight_copies(Frame& F, const int skip = 0) {
    constexpr int I_U = (1024 / 32) * 16  , I_D = (1024 / 32) * 8;
    const float* wup = F.w_up; const float* wdn = F.w_down; unsigned char* ws = F.ws;
    run_transposes(F, NEXP * (PART == 0 ? I_U : I_D), [=](int it, int lane) {
        TItem t; constexpr bool up = PART == 0; const int e = it / (up ? I_U : I_D), rr = it % (up ? I_U : I_D);
        t.K = up ? 1024 : 512; t.Nsrc = 1024;
        t.k0 = up ? 64 * (rr & 15) : 64 * (rr & 7); t.n0 = up ? 32 * (rr >> 4) : 32 * (rr >> 3); const int n = t.n0 + 4 * (lane & 7);
        t.W = up ? wup + (size_t)e * 1024 * 1024 : wdn + (size_t)e * 512 * 1024;
        t.WT = up ? (bf16*)(ws + WS_WUP) + (size_t)e * 1024 * 1024 : (bf16*)(ws + WS_WDN) + (size_t)e * 1024 * 512;
        t.sc = up ? map_up(n) : n;
        return t; }, skip);
}

__device__ __forceinline__ void p1_hx(Frame& F) {
    const int gw = F.bid * NW + F.wave, NGW = F.G * NW;
    const float* modv = wsp<float>(F, WS_MODV);
    for (int m = gw; m < MT; m += 2 * NGW) {
        const int m2 = m + NGW < MT ? m + NGW : m;
        const float* src[2] = {m < M_LAT ? F.x + (size_t)m * D : F.ctx + (size_t)(m - M_LAT) * D, m2 < M_LAT ? F.x + (size_t)m2 * D : F.ctx + (size_t)(m2 - M_LAT) * D};
        const float* mv[2] = {modv + (m < M_LAT ? (m >> 13) : 2) * 6144, modv + (m2 < M_LAT ? (m2 >> 13) : 2) * 6144};
        f32x4 v[2][4]; float s[2] = {0.f, 0.f};
#pragma unroll
        for (int r = 0; r < 2; ++r)
#pragma unroll
            for (int j = 0; j < 4; ++j) v[r][j] = *(const f32x4*)(src[r] + 4 * F.lane + 256 * j);
#pragma unroll
        for (int r = 0; r < 2; ++r)
#pragma unroll
            for (int j = 0; j < 4; ++j) s[r] += (v[r][j].x * v[r][j].x + v[r][j].y * v[r][j].y) + (v[r][j].z * v[r][j].z + v[r][j].w * v[r][j].w);
#pragma unroll
        for (int r = 0; r < 2; ++r) {
            const float rstd = 1.f / sqrtf(wave_sum(s[r]) * (1.f / D) + EPS);
            bf16* o = wsp<bf16>(F, WS_HX) + (size_t)(r == 0 ? m : m2) * D;
#pragma unroll
            for (int j = 0; j < 4; ++j) { const int c = 4 * F.lane + 256 * j;
                const f32x4 g = *(const f32x4*)(F.g_norm1 + c), sh = *(const f32x4*)(mv[r] + c), sc = *(const f32x4*)(mv[r] + 1024 + c);
                const f32x4 h = (v[r][j] * rstd) * g * (sc + 1.f) + sh;
                u32x2 w; w.x = pk2(h.x, h.y); w.y = pk2(h.z, h.w); *(u32x2*)(o + c) = w; } }
    }
}

struct EpiProjA {
    unsigned char* ws; const float* b_mgate;
    __device__ __forceinline__ void operator()(const f32x4 (&acc)[2][2][4][2], const Unit& u, int wr, int wc, int fr, int fq) const {
        const int row0 = u.pm * 256 + wr * 64 + fr;
        if (u.pn < 16) {
            bf16* base = (bf16*)(ws + WS_QKM + (size_t)(u.pn >> 2) * BIG) + (u.pn & 3) * 256 + wc * 32 + 8 * fq;
#pragma unroll
            for (int ai = 0; ai < 2; ++ai)
#pragma unroll
                for (int m = 0; m < 4; ++m) { bf16* rowp = base + (size_t)(row0 + ai * 128 + m * 16) * 1024;
#pragma unroll
                    for (int bj = 0; bj < 2; ++bj) { const f32x4 v0 = acc[ai][bj][m][0], v1 = acc[ai][bj][m][1];
                        u32x4 w; w.x = cvt_pk_bf16(v0[0], v0[1]); w.y = cvt_pk_bf16(v0[2], v0[3]); w.z = cvt_pk_bf16(v1[0], v1[1]); w.w = cvt_pk_bf16(v1[2], v1[3]);
                        *(u32x4*)(rowp + bj * 128) = w; } }
        } else if (wc < 2) {
            const int col = wc * 32 + 8 * fq;
            float* g = (float*)(ws + WS_GATES);
            f32x4 b0 = {0.f, 0.f, 0.f, 0.f}, b1 = b0;
            if (col < 16) { b0 = *(const f32x4*)(b_mgate + col); b1 = *(const f32x4*)(b_mgate + col + 4); }
#pragma unroll
            for (int ai = 0; ai < 2; ++ai)
#pragma unroll
                for (int m = 0; m < 4; ++m) { float* rowp = g + (size_t)(row0 + ai * 128 + m * 16) * 64 + col;
                    *(f32x4*)rowp = acc[ai][0][m][0] + b0; *(f32x4*)(rowp + 4) = acc[ai][0][m][1] + b1; }
        }
    }
};

__device__ __forceinline__ int chunk_row0(int ci) { return ci < 256 ? (ci >> 7) * SEQ + (ci & 127) * 64 : M_LAT + ((ci - 256) >> 2) * CTXL + ((ci - 256) & 3) * 64; }
__device__ __forceinline__ bf16* qkgt_row(const Frame& F, int dir, int m) {
    return m < M_LAT ? (bf16*)F.out + ((size_t)dir * M_LAT + m) * 1024 : wsp<bf16>(F, WS_QKGTC) + ((size_t)dir * M_CTX + (m - M_LAT)) * 1024;
}
__device__ __forceinline__ float logsig_fast(float x) { return fminf(x, 0.f) - __logf(1.f + __expf(-fabsf(x))); }
__device__ __forceinline__ void unpack8(const u32x4& v, float (&f)[8]) { f[0] = bflo(v.x); f[1] = bfhi(v.x); f[2] = bflo(v.y); f[3] = bfhi(v.y); f[4] = bflo(v.z); f[5] = bfhi(v.z); f[6] = bflo(v.w); f[7] = bfhi(v.w); }
__device__ __forceinline__ void p3_prep(Frame& F) {
    const bf16* QKM = wsp<bf16>(F, WS_QKM); bf16* QKMC = wsp<bf16>(F, WS_QKMC); const float* GATES = wsp<float>(F, WS_GATES); const bf16* QKG = wsp<bf16>(F, WS_QKG);
    for (int it = F.bid; it < NCHUNK * 3; it += F.G) {
        int tidl = F.tid; asm volatile("" : "+v"(tidl));
        const int lanel = tidl & 63;
        if (it < NCHUNK) {
            const int ci = F.G == 256 ? (it < 256 ? (it & 7) * 33 + (it >> 3) : (it - 256) * 33 + 32) : it, m0 = chunk_row0(ci);
            const int cg = tidl & 127, cq = tidl >> 7, ch = 8 * cg;
            const bool lat = ci < 256; const int c = lat ? (ci & 127) : ((ci - 256) & 3);
            const bool has_up = lat && c > 0, has_dn = lat && c < 127;
            const float osc = ch >= 512 ? 0.08838834764831845f : 1.f;
            f32x4 bz0 = *(const f32x4*)(F.ml_conv_b + ch), bz1 = *(const f32x4*)(F.ml_conv_b + ch + 4);
            f32x4 cw0[9], cw1[9];
#pragma unroll
            for (int q = 0; q < 9; ++q) { cw0[q] = *(const f32x4*)(F.ml_conv + q * 1024 + ch); cw1[q] = *(const f32x4*)(F.ml_conv + q * 1024 + ch + 4); }
            const f32x4 z4 = {0.f, 0.f, 0.f, 0.f};
#pragma unroll
            for (int q = 0; q < 3; ++q) { if (!has_up) { cw0[q] = z4; cw1[q] = z4; } if (!has_dn) { cw0[6 + q] = z4; cw1[6 + q] = z4; } }
            const int collo = lat ? 0 : (c == 0 ? 0 : -1), colhi = lat ? 63 : (c == 3 ? 63 : 64);
            const bf16* rb0 = QKM + (size_t)(has_up ? m0 - 64 : m0) * 1024 + ch; const bf16* rb1 = QKM + (size_t)m0 * 1024 + ch; const bf16* rb2 = QKM + (size_t)(has_dn ? m0 + 64 : m0) * 1024 + ch;
            auto ldc = [&](int dr, int col) -> u32x4 { const int cc = min(max(col, collo), colhi); const bf16* rb = dr == 0 ? rb0 : dr == 1 ? rb1 : rb2; return *(const u32x4*)(rb + (ptrdiff_t)cc * 1024); };
            const u32x4 zu = {0u, 0u, 0u, 0u};
            int cc = cq * 16;
            u32x4 w0[3], w1[3], n0[3], n1[3];
#pragma unroll
            for (int dr = 0; dr < 3; ++dr) { const u32x4 v = ldc(dr, cc - 1); w0[dr] = cc - 1 >= collo ? v : zu; w1[dr] = ldc(dr, cc); n0[dr] = ldc(dr, cc + 1); n1[dr] = ldc(dr, cc + 2); }
#pragma unroll 1
            for (int cb = 0; cb < 8; ++cb, cc += 2) {
                u32x4 p0[3], p1[3];
#pragma unroll
                for (int dr = 0; dr < 3; ++dr) { p0[dr] = ldc(dr, cc + 3); p1[dr] = ldc(dr, cc + 4); }
                __builtin_amdgcn_sched_barrier(0);
                float acc[2][8];
#pragma unroll
                for (int oc = 0; oc < 2; ++oc) { acc[oc][0] = bz0[0]; acc[oc][1] = bz0[1]; acc[oc][2] = bz0[2]; acc[oc][3] = bz0[3]; acc[oc][4] = bz1[0]; acc[oc][5] = bz1[1]; acc[oc][6] = bz1[2]; acc[oc][7] = bz1[3]; }
#pragma unroll
                for (int dr = 0; dr < 3; ++dr)
#pragma unroll
                    for (int dc = 0; dc < 4; ++dc) { float f[8]; unpack8(dc == 0 ? w0[dr] : dc == 1 ? w1[dr] : dc == 2 ? n0[dr] : n1[dr], f);
#pragma unroll
                        for (int oc = 0; oc < 2; ++oc) { const int t = dc - oc; if (t < 0 || t > 2) continue; const f32x4 k0 = cw0[dr * 3 + t], k1 = cw1[dr * 3 + t];
                            acc[oc][0] += k0[0] * f[0]; acc[oc][1] += k0[1] * f[1]; acc[oc][2] += k0[2] * f[2]; acc[oc][3] += k0[3] * f[3]; acc[oc][4] += k1[0] * f[4]; acc[oc][5] += k1[1] * f[5]; acc[oc][6] += k1[2] * f[6]; acc[oc][7] += k1[3] * f[7]; } }
#pragma unroll
                for (int oc = 0; oc < 2; ++oc) { u32x4 o; o.x = pk2(siluf(acc[oc][0]) * osc, siluf(acc[oc][1]) * osc); o.y = pk2(siluf(acc[oc][2]) * osc, siluf(acc[oc][3]) * osc);
                    o.z = pk2(siluf(acc[oc][4]) * osc, siluf(acc[oc][5]) * osc); o.w = pk2(siluf(acc[oc][6]) * osc, siluf(acc[oc][7]) * osc);
                    *(u32x4*)(QKMC + (size_t)(m0 + cc + oc) * 1024 + ch) = o; }
                __builtin_amdgcn_sched_barrier(0);
                const bool k0 = cc + 3 <= colhi, k1 = cc + 4 <= colhi;
#pragma unroll
                for (int dr = 0; dr < 3; ++dr) { w0[dr] = n0[dr]; w1[dr] = n1[dr]; n0[dr] = k0 ? p0[dr] : zu; n1[dr] = k1 ? p1[dr] : zu; }
            }
            {
                const int dir = F.wave >> 2, h = F.wave & 3, m = m0 + lanel;
                const float ip = GATES[(size_t)m * 64 + dir * 8 + h], lf = logsig(GATES[(size_t)m * 64 + dir * 8 + 4 + h]);
                float b = lf;
#pragma unroll
                for (int o = 1; o < 64; o <<= 1) { const float t = dir == 0 ? __shfl_up(b, o) : __shfl_down(b, o); const bool ok = dir == 0 ? (lanel >= o) : (lanel + o < 64); if (ok) b += t; }
                f32x2 ab; ab.x = expf(b); ab.y = expf(ip - b);
                wsp<f32x2>(F, WS_AB)[((size_t)dir * MT + m) * 4 + h] = ab;
                if (lanel == (dir == 0 ? 63 : 0)) wsp<float>(F, WS_GENDM)[((size_t)dir * NCHUNK + ci) * 4 + h] = expf(b);
            }
        } else {
            const int gi0 = it - NCHUNK;
            const int gi = F.G == 256 ? ((((gi0 >> 4) << 3) | (gi0 & 7)) << 1) | ((gi0 >> 3) & 1) : gi0;
            const int ci = gi >> 1, dir = gi & 1, m0 = chunk_row0(ci);
            LAS float* lr = (LAS float*)F.lds;
            LAS float* Bl = (LAS float*)(F.lds + 4096);
            __syncthreads();
            for (int i = tidl; i < 1024; i += NTHR) lr[i] = GATES[(size_t)(m0 + (i >> 4)) * 64 + 16 + dir * 16 + (i & 15)];
            const int ch = tidl;
            f32x2 w2p[8];
#pragma unroll
            for (int r = 0; r < 8; ++r) { w2p[r].x = F.gla_w2[((size_t)dir * 16 + 2 * r) * 512 + ch]; w2p[r].y = F.gla_w2[((size_t)dir * 16 + 2 * r + 1) * 512 + ch]; }
            const float b2 = F.gla_b2[dir * 512 + ch];
            __syncthreads();
            float b = 0.f;
#pragma unroll 1
            for (int i0 = 0; i0 < 64; i0 += 4) {
                f32x4 l[4][4];
#pragma unroll
                for (int u = 0; u < 4; ++u) { const int r = dir == 0 ? i0 + u : 63 - i0 - u;
#pragma unroll
                    for (int q = 0; q < 4; ++q) l[u][q] = *(const LAS f32x4*)(lr + r * 16 + 4 * q); }
                float ls[4];
#pragma unroll
                for (int u = 0; u < 4; ++u) {
                    f32x2 a2 = {b2, 0.f};
#pragma unroll
                    for (int q = 0; q < 4; ++q) { a2 = __builtin_elementwise_fma((f32x2){l[u][q][0], l[u][q][1]}, w2p[2 * q], a2); a2 = __builtin_elementwise_fma((f32x2){l[u][q][2], l[u][q][3]}, w2p[2 * q + 1], a2); }
                    const float xg = a2.x + a2.y;
                    ls[u] = fminf(xg, 0.f) - 0.6931471805599453f * __builtin_amdgcn_logf(1.f + __builtin_amdgcn_exp2f(-1.4426950408889634f * fabsf(xg))); }
#pragma unroll
                for (int u = 0; u < 4; ++u) { const int r = dir == 0 ? i0 + u : 63 - i0 - u; b += ls[u] * (1.f / 16.f); Bl[r * 512 + ch] = b; }
            }
            wsp<float>(F, WS_GENDG)[((size_t)dir * NCHUNK + ci) * 512 + ch] = __expf(b);
            __syncthreads();
            u32x4 vin[16];
            const int cp = tidl & 127, r0 = tidl >> 7; const bool isk = cp >= 64;
            const float sg = isk ? -1.4426950408889634f : 1.4426950408889634f, eoff = isk ? 0.f : -3.5f;
            const bf16* irow = QKG + (size_t)(m0 + r0) * 1024 + cp * 8; bf16* orow = qkgt_row(F, dir, m0) + (size_t)r0 * 1024 + cp * 8;
            const LAS float* brow = Bl + r0 * 512 + 8 * (cp & 63);
#pragma unroll
            for (int j = 0; j < 16; ++j) vin[j] = *(const u32x4*)(irow + (size_t)j * 4096);
#pragma unroll
            for (int j = 0; j < 16; ++j) {
                const u32x4 v = vin[j];
                const f32x4 b0 = *(const LAS f32x4*)(brow + j * 2048), b1 = *(const LAS f32x4*)(brow + j * 2048 + 4);
                float f[8]; unpack8(v, f); float e[8];
#pragma unroll
                for (int q = 0; q < 4; ++q) { e[q] = __builtin_amdgcn_exp2f(__builtin_fmaf(b0[q], sg, eoff)); e[4 + q] = __builtin_amdgcn_exp2f(__builtin_fmaf(b1[q], sg, eoff)); }
                u32x4 o; o.x = pk2(f[0] * e[0], f[1] * e[1]); o.y = pk2(f[2] * e[2], f[3] * e[3]); o.z = pk2(f[4] * e[4], f[5] * e[5]); o.w = pk2(f[6] * e[6], f[7] * e[7]);
                *(u32x4*)(orow + (size_t)j * 4096) = o; }
        }
    }
}

constexpr int L_AQ = 0, L_AK = 16384, L_VP = 32768, L_P = 49152, L_S = 65536, L_N = 131072 + 1024  ;
struct ScanSrc { const bf16* q; const bf16* k; const bf16* v; const f32x2* ab; const float* gend; int gstride; };
__device__ __forceinline__ int seg_chunk(int seg, int dir, int i) {
    if (seg < 0) return dir == 0 ? i : 3 - i;
    return dir == 0 ? seg * CPS + i : (NCH_LAT - 1 - seg * CPS) - i;
}
__device__ __forceinline__ void scan_stage(Frame& F, int model, int b, int h, int dir, int half, int ci, bool need_q) {
    const int m0 = chunk_row0(ci);
    LAS float* nb = (LAS float*)(F.lds + L_N);
    if (model == 0 && F.tid < 64) { const f32x2 ab = wsp<f32x2>(F, WS_AB)[((size_t)dir * MT + m0 + F.tid) * 4 + h]; nb[256 + F.tid] = ab.y; nb[320 + F.tid] = ab.x; }
    if (F.tid >= 64 && F.tid < 192) { const int dk = F.tid - 64;
        nb[128 + dk] = model == 0 ? wsp<float>(F, WS_GENDM)[((size_t)dir * NCHUNK + ci) * 4 + h] : wsp<float>(F, WS_GENDG)[((size_t)dir * NCHUNK + ci) * 512 + h * 128 + dk]; }
#pragma unroll
    for (int i = 0; i < 2; ++i) { const int p = F.tid + i * 512, r = p >> 4, cpart = p & 15, m = m0 + r;
        const bf16* qrow; const bf16* vrow;
        if (model == 0) { qrow = wsp<bf16>(F, WS_QKMC) + (size_t)m * 1024; vrow = wsp<bf16>(F, WS_VM) + (size_t)m * 1024; }
        else { qrow = qkgt_row(F, dir, m); vrow = wsp<bf16>(F, WS_VG) + (size_t)m * 1024; }
        if (need_q) *(LAS u32x4*)(F.lds + L_AQ + r * 256 + cpart * 16) = *(const u32x4*)(qrow + h * 128 + cpart * 8);
        *(LAS u32x4*)(F.lds + L_AK + r * 256 + cpart * 16) = *(const u32x4*)(qrow + 512 + h * 128 + cpart * 8);
        u32x4 v = *(const u32x4*)(vrow + h * 256 + half * 128 + cpart * 8);
        if (model == 0) { const float be = wsp<f32x2>(F, WS_AB)[((size_t)dir * MT + m) * 4 + h].y;
            v.x = pk2(bflo(v.x) * be, bfhi(v.x) * be); v.y = pk2(bflo(v.y) * be, bfhi(v.y) * be); v.z = pk2(bflo(v.z) * be, bfhi(v.z) * be); v.w = pk2(bflo(v.w) * be, bfhi(v.w) * be); }
        *(LAS u32x4*)(F.lds + L_VP + r * 256 + cpart * 16) = v; }
}
__device__ __forceinline__ void scan_update(Frame& F, int model) {
    LAS float* S = (LAS float*)(F.lds + L_S); LAS float* nb = (LAS float*)(F.lds + L_N);
    const LAS bf16* AK = (const LAS bf16*)(F.lds + L_AK); const LAS bf16* VP = (const LAS bf16*)(F.lds + L_VP);
    const int dk = F.tid >> 2, dv0 = (F.tid & 3) * 32;
    float a[32];
#pragma unroll
    for (int j = 0; j < 32; ++j) a[j] = S[dk * 128 + dv0 + j];
    float nn = 0.f;
    for (int s = 0; s < 64; ++s) { const float k = bf2f(AK[s * 128 + dk]);
        if (model == 0) nn += k * nb[256 + s];
#pragma unroll
        for (int j = 0; j < 32; j += 2) { const unsigned v = *(const LAS unsigned*)(VP + s * 128 + dv0 + j); a[j] += k * bflo(v); a[j + 1] += k * bfhi(v); } }
    const float g = nb[128 + dk];
#pragma unroll
    for (int j = 0; j < 32; ++j) S[dk * 128 + dv0 + j] = g * a[j];
    if (model == 0 && (F.tid & 3) == 0) nb[dk] = g * (nb[dk] + nn);
}
__device__ __forceinline__ bf16* state_ptr(const Frame& F, int sc, int slot, int half) { return wsp<bf16>(F, WS_STATE) + ((size_t)(sc * 8 + slot) * 2 + half) * 16384; }

__device__ __forceinline__ void p4_scan_local(Frame& F) {
    LAS float* S = (LAS float*)(F.lds + L_S); LAS float* nb = (LAS float*)(F.lds + L_N);
    for (int it0 = F.bid; it0 < 32 * 8 * 2; it0 += F.G) {
        const int it = (F.G == 256) ? (it0 & ~255) | ((((((it0 & 255) >> 4) << 3) | (it0 & 7)) << 1) | ((it0 >> 3) & 1)) : it0;
        const int half = it & 1, slot = (it >> 1) & 7, sc = it >> 4, seg = slot - 1;
        const int dir = sc & 1, h = (sc >> 1) & 3, b = (sc >> 3) & 1, model = sc >> 4;
        for (int i = F.tid; i < 16384; i += NTHR) S[i] = 0.f;
        if (F.tid < 128) nb[F.tid] = 0.f;
        float gacc = 1.f;
        __syncthreads();
        const int nch = seg < 0 ? NCH_CTX : CPS;
        for (int i = 0; i < nch; ++i) {
            const int c = seg_chunk(seg, dir, i), ci = seg < 0 ? 256 + b * 4 + c : b * 128 + c;
            scan_stage(F, model, b, h, dir, half, ci, false);
            __syncthreads();
            if (F.tid < 128) gacc *= nb[128 + F.tid];
            scan_update(F, model);
            __syncthreads();
        }
        bf16* st = state_ptr(F, sc, slot, half);
        for (int i = F.tid; i < 8192; i += NTHR) ((unsigned*)st)[i] = pk2(S[2 * i], S[2 * i + 1]);
        if (half == 0 && F.tid < 128) { wsp<float>(F, WS_NST)[(sc * 8 + slot) * 128 + F.tid] = nb[F.tid]; wsp<float>(F, WS_GSEG)[(sc * 8 + slot) * 128 + F.tid] = gacc; }
        __syncthreads();
    }
}
__device__ __forceinline__ void p5_scan_out(Frame& F) {
    LAS float* S = (LAS float*)(F.lds + L_S); LAS float* nb = (LAS float*)(F.lds + L_N); LAS float* P = (LAS float*)(F.lds + L_P);
    const LAS bf16* AQ = (const LAS bf16*)(F.lds + L_AQ); const LAS bf16* AK = (const LAS bf16*)(F.lds + L_AK); const LAS bf16* VP = (const LAS bf16*)(F.lds + L_VP);
    for (int it0 = F.bid; it0 < 2 * 2 * 4 * 8 * 2; it0 += F.G) {
        const int it = (F.G == 256) ? ((((it0 >> 4) << 3) | (it0 & 7)) << 1) | ((it0 >> 3) & 1) : it0;
        const int half = it & 1, seg = (it >> 1) & 7, h = (it >> 4) & 3, b = (it >> 6) & 1, model = it >> 7;
        bf16* HS = wsp<bf16>(F, model == 0 ? WS_QKM : WS_QKG);
        for (int dir = 0; dir < 2; ++dir) {
            const int sc = ((model * 2 + b) * 4 + h) * 2 + dir, s = dir == 0 ? seg : 7 - seg;
            { const int dk = F.tid >> 2, dv0 = (F.tid & 3) * 32; float a[32]; float nn = 0.f;
#pragma unroll
              for (int j = 0; j < 32; ++j) a[j] = 0.f;
              for (int slot = 0; slot <= s; ++slot) {
                  const float g = slot == 0 ? 0.f : wsp<float>(F, WS_GSEG)[(sc * 8 + slot) * 128 + dk];
                  const bf16* st = state_ptr(F, sc, slot, half) + dk * 128 + dv0;
#pragma unroll
                  for (int j = 0; j < 32; j += 2) { const unsigned v = *(const unsigned*)(st + j); a[j] = g * a[j] + bflo(v); a[j + 1] = g * a[j + 1] + bfhi(v); }
                  nn = g * nn + wsp<float>(F, WS_NST)[(sc * 8 + slot) * 128 + dk]; }
#pragma unroll
              for (int j = 0; j < 32; ++j) S[dk * 128 + dv0 + j] = a[j];
              if ((F.tid & 3) == 0) nb[dk] = nn; }
            __syncthreads();
            for (int i = 0; i < CPS; ++i) {
                const int c = seg_chunk(s, dir, i), ci = b * 128 + c, m0 = chunk_row0(ci);
                scan_stage(F, model, b, h, dir, half, ci, true);
                __syncthreads();
                for (int e = F.tid; e < 4096; e += NTHR) { const int t = e >> 6, s2 = e & 63; float p = 0.f;
                    if (dir == 0 ? (s2 <= t) : (s2 >= t)) {
                        for (int d8 = 0; d8 < 16; ++d8) { const u32x4 qa = *(const LAS u32x4*)(AQ + t * 128 + d8 * 8), ka = *(const LAS u32x4*)(AK + s2 * 128 + d8 * 8);
                            p += bflo(qa.x) * bflo(ka.x) + bfhi(qa.x) * bfhi(ka.x) + bflo(qa.y) * bflo(ka.y) + bfhi(qa.y) * bfhi(ka.y)
                               + bflo(qa.z) * bflo(ka.z) + bfhi(qa.z) * bfhi(ka.z) + bflo(qa.w) * bflo(ka.w) + bfhi(qa.w) * bfhi(ka.w); } }
                    P[e] = bf2f((unsigned short)f2bf(p)); }
                __syncthreads();
                { const int t = F.tid >> 3, dv0 = (F.tid & 7) * 16; float o[16];
#pragma unroll
                  for (int j = 0; j < 16; ++j) o[j] = 0.f;
                  float den = 0.f;
                  for (int s2 = 0; s2 < 64; ++s2) { const float p = P[t * 64 + s2];
                      if (model == 0) den += p * nb[256 + s2];
                      const u32x4 v0 = *(const LAS u32x4*)(VP + s2 * 128 + dv0), v1 = *(const LAS u32x4*)(VP + s2 * 128 + dv0 + 8);
                      o[0] += p * bflo(v0.x); o[1] += p * bfhi(v0.x); o[2] += p * bflo(v0.y); o[3] += p * bfhi(v0.y); o[4] += p * bflo(v0.z); o[5] += p * bfhi(v0.z); o[6] += p * bflo(v0.w); o[7] += p * bfhi(v0.w);
                      o[8] += p * bflo(v1.x); o[9] += p * bfhi(v1.x); o[10] += p * bflo(v1.y); o[11] += p * bfhi(v1.y); o[12] += p * bflo(v1.z); o[13] += p * bfhi(v1.z); o[14] += p * bflo(v1.w); o[15] += p * bfhi(v1.w); }
                  for (int dk = 0; dk < 128; ++dk) { const float q = bf2f(AQ[t * 128 + dk]);
                      if (model == 0) den += q * nb[dk];
                      const LAS float* sr = S + dk * 128 + dv0;
#pragma unroll
                      for (int j = 0; j < 16; ++j) o[j] += q * bf2f((unsigned short)f2bf(sr[j])); }
                  float rs = 1.f;
                  if (model == 0) { const float al = nb[320 + t]; rs = al / fmaxf(al * fabsf(den), 1.f); }
                  bf16* dst = HS + (size_t)(m0 + t) * 1024 + h * 256 + half * 128 + dv0;
                  float ssq = 0.f;
                  if (dir == 0) {
                      u32x4 w0, w1; w0.x = pk2(o[0] * rs, o[1] * rs); w0.y = pk2(o[2] * rs, o[3] * rs); w0.z = pk2(o[4] * rs, o[5] * rs); w0.w = pk2(o[6] * rs, o[7] * rs);
                      w1.x = pk2(o[8] * rs, o[9] * rs); w1.y = pk2(o[10] * rs, o[11] * rs); w1.z = pk2(o[12] * rs, o[13] * rs); w1.w = pk2(o[14] * rs, o[15] * rs);
                      *(u32x4*)dst = w0; *(u32x4*)(dst + 8) = w1;
                  } else {
                      const u32x4 p0 = *(const u32x4*)dst, p1 = *(const u32x4*)(dst + 8);
                      const float f[16] = {bflo(p0.x), bfhi(p0.x), bflo(p0.y), bfhi(p0.y), bflo(p0.z), bfhi(p0.z), bflo(p0.w), bfhi(p0.w), bflo(p1.x), bfhi(p1.x), bflo(p1.y), bfhi(p1.y), bflo(p1.z), bfhi(p1.z), bflo(p1.w), bfhi(p1.w)};
                      float r[16];
#pragma unroll
                      for (int j = 0; j < 16; ++j) { r[j] = f[j] + o[j] * rs; ssq += r[j] * r[j]; }
                      u32x4 w0, w1; w0.x = pk2(r[0], r[1]); w0.y = pk2(r[2], r[3]); w0.z = pk2(r[4], r[5]); w0.w = pk2(r[6], r[7]);
                      w1.x = pk2(r[8], r[9]); w1.y = pk2(r[10], r[11]); w1.z = pk2(r[12], r[13]); w1.w = pk2(r[14], r[15]);
                      *(u32x4*)dst = w0; *(u32x4*)(dst + 8) = w1;
                      ssq += __shfl_xor(ssq, 1); ssq += __shfl_xor(ssq, 2); ssq += __shfl_xor(ssq, 4);
                      if ((F.tid & 7) == 0) wsp<float>(F, WS_SSQ)[((size_t)(m0 + t) * 8 + model * 4 + h) * 2 + half] = ssq;
                  } }
                __syncthreads();
                scan_update(F, model);
                __syncthreads();
            }
        }
    }
}

typedef short s16x4 __attribute__((ext_vector_type(4)));
__device__ __forceinline__ unsigned offb(int row, int ch) { return 256u * (unsigned)row + 16u * (unsigned)(ch ^ (((row & 3) << 2) | ((row >> 2) & 3))); }
constexpr int M_AQ = 0, M_AK = 16384, M_VP = 32768, M_P = 49152, M_O = 57344, O_LD = 132;
template <int TILE>
__device__ __forceinline__ void tr_frag2(unsigned x0, unsigned x1, bf16x8& f0, bf16x8& f1) {
    s16x4 r0, r1, r2, r3;
    asm volatile("ds_read_b64_tr_b16 %0, %4 offset:%6\n\tds_read_b64_tr_b16 %1, %5 offset:%6\n\tds_read_b64_tr_b16 %2, %4 offset:%7\n\tds_read_b64_tr_b16 %3, %5 offset:%7\n\ts_waitcnt lgkmcnt(0)"
                 : "=&v"(r0), "=&v"(r1), "=&v"(r2), "=&v"(r3) : "v"(x0), "v"(x1), "i"(TILE), "i"(TILE + 8192) : "memory");
    f0 = __builtin_shufflevector(r0, r1, 0, 1, 2, 3, 4, 5, 6, 7); f1 = __builtin_shufflevector(r2, r3, 0, 1, 2, 3, 4, 5, 6, 7);
}
template <int TILE>
__device__ __forceinline__ void tr_frag8(unsigned a0, unsigned a1, unsigned b0, unsigned b1, unsigned c0, unsigned c1, unsigned d0, unsigned d1, bf16x8 (&f)[8]) {
    s16x4 r[16];
    asm volatile("ds_read_b64_tr_b16 %0, %16 offset:%24\n\tds_read_b64_tr_b16 %1, %17 offset:%24\n\tds_read_b64_tr_b16 %2, %16 offset:%25\n\tds_read_b64_tr_b16 %3, %17 offset:%25\n\t"
                 "ds_read_b64_tr_b16 %4, %18 offset:%24\n\tds_read_b64_tr_b16 %5, %19 offset:%24\n\tds_read_b64_tr_b16 %6, %18 offset:%25\n\tds_read_b64_tr_b16 %7, %19 offset:%25\n\t"
                 "ds_read_b64_tr_b16 %8, %20 offset:%24\n\tds_read_b64_tr_b16 %9, %21 offset:%24\n\tds_read_b64_tr_b16 %10, %20 offset:%25\n\tds_read_b64_tr_b16 %11, %21 offset:%25\n\t"
                 "ds_read_b64_tr_b16 %12, %22 offset:%24\n\tds_read_b64_tr_b16 %13, %23 offset:%24\n\tds_read_b64_tr_b16 %14, %22 offset:%25\n\tds_read_b64_tr_b16 %15, %23 offset:%25\n\ts_waitcnt lgkmcnt(0)"
                 : "=&v"(r[0]), "=&v"(r[1]), "=&v"(r[2]), "=&v"(r[3]), "=&v"(r[4]), "=&v"(r[5]), "=&v"(r[6]), "=&v"(r[7]), "=&v"(r[8]), "=&v"(r[9]), "=&v"(r[10]), "=&v"(r[11]), "=&v"(r[12]), "=&v"(r[13]), "=&v"(r[14]), "=&v"(r[15])
                 : "v"(a0), "v"(a1), "v"(b0), "v"(b1), "v"(c0), "v"(c1), "v"(d0), "v"(d1), "i"(TILE), "i"(TILE + 8192) : "memory");
#pragma unroll
    for (int j = 0; j < 8; ++j) f[j] = __builtin_shufflevector(r[2 * j], r[2 * j + 1], 0, 1, 2, 3, 4, 5, 6, 7);
}
template <int TILE>
__device__ __forceinline__ void tr_frag4(unsigned x0, unsigned x1, unsigned y0, unsigned y1, bf16x8& f0, bf16x8& f1, bf16x8& f2, bf16x8& f3) {
    s16x4 r0, r1, r2, r3, r4, r5, r6, r7;
    asm volatile("ds_read_b64_tr_b16 %0, %8 offset:%12\n\tds_read_b64_tr_b16 %1, %9 offset:%12\n\tds_read_b64_tr_b16 %2, %8 offset:%13\n\tds_read_b64_tr_b16 %3, %9 offset:%13\n\t"
                 "ds_read_b64_tr_b16 %4, %10 offset:%12\n\tds_read_b64_tr_b16 %5, %11 offset:%12\n\tds_read_b64_tr_b16 %6, %10 offset:%13\n\tds_read_b64_tr_b16 %7, %11 offset:%13\n\ts_waitcnt lgkmcnt(0)"
                 : "=&v"(r0), "=&v"(r1), "=&v"(r2), "=&v"(r3), "=&v"(r4), "=&v"(r5), "=&v"(r6), "=&v"(r7) : "v"(x0), "v"(x1), "v"(y0), "v"(y1), "i"(TILE), "i"(TILE + 8192) : "memory");
    f0 = __builtin_shufflevector(r0, r1, 0, 1, 2, 3, 4, 5, 6, 7); f1 = __builtin_shufflevector(r2, r3, 0, 1, 2, 3, 4, 5, 6, 7);
    f2 = __builtin_shufflevector(r4, r5, 0, 1, 2, 3, 4, 5, 6, 7); f3 = __builtin_shufflevector(r6, r7, 0, 1, 2, 3, 4, 5, 6, 7);
}
#define MFMA16(a, b, c) __builtin_amdgcn_mfma_f32_16x16x32_bf16((a), (b), (c), 0, 0, 0)
__device__ __forceinline__ bf16* mstate_ptr(const Frame& F, int sc, int slot, int half) { return wsp<bf16>(F, WS_STATE) + ((size_t)(sc * 8 + slot) * 2 + half) * 16384; }

#define LBAR() asm volatile("s_waitcnt lgkmcnt(0)\n\ts_barrier" ::: "memory")
template <bool OUT>
__device__ __forceinline__ void mscan_run(Frame& F, int model, int b, int h, int dir, int half, int seg, f32x4 (&S)[2][8], float& gacc) {
    LAS unsigned char* lds = F.lds; LAS float* nb = (LAS float*)(F.lds + L_N);
    LAS unsigned short* nbh = (LAS unsigned short*)(F.lds + L_N + 2048);
    const unsigned lb = (unsigned)(uintptr_t)F.lds;
    const int w = F.wave, lane = F.lane, li = lane & 15, lg = lane >> 4, tq = li >> 2, tp = lane & 3;
    const bool st = w < 4; const int sw = w & 3;
    const int nch = seg < 0 ? NCH_CTX : CPS;
    bf16* HS = wsp<bf16>(F, model == 0 ? WS_QKM : WS_QKG);
    const int mli = ((li & 3) << 2) | ((li >> 2) & 3);
    const unsigned rowb = 256u * li + 16u * (lg ^ mli);
    const unsigned o2b = 256u * li + 16u * ((lg >> 1) ^ mli) + 8u * (lg & 1);
    const unsigned trb0 = 256u * (8 * lg + tq) + 16u * ((tp >> 1) ^ ((tq << 2) | ((2 * lg) & 3))) + 8u * (tp & 1);
    const unsigned trb1 = 256u * (8 * lg + 4 + tq) + 16u * ((tp >> 1) ^ ((tq << 2) | ((2 * lg + 1) & 3))) + 8u * (tp & 1);
    const unsigned pra0 = lb + M_P + (128u * li + 16u * (lg ^ (li & 7))), pra1 = lb + M_P + ((128u * li + 16u * (lg ^ (li & 7))) ^ 64u);
    const unsigned poff0 = (unsigned)((F.tid >> 4) * 1024 + (F.tid & 15) * 8) * 2u, poff1 = poff0 + 32u * 2048u;
    auto final_pass = [&](const int m0, const u32x4 (&prevh)[2]) {
        LAS float* Ol = (LAS float*)(F.lds + M_O);
#pragma unroll
        for (int i = 0; i < 2; ++i) { const int p = F.tid + i * 512, t = p >> 4, c8 = p & 15;
            const f32x4 o0 = *(const LAS f32x4*)(Ol + t * O_LD + 8 * c8), o1 = *(const LAS f32x4*)(Ol + t * O_LD + 8 * c8 + 4);
            float rs = 1.f;
            if (model == 0) rs = nb[384 + t];
            bf16* dst = (bf16*)((unsigned char*)(HS + (size_t)m0 * 1024 + h * 256 + half * 128) + (i == 0 ? poff0 : poff1));
            float r[8] = {o0[0] * rs, o0[1] * rs, o0[2] * rs, o0[3] * rs, o1[0] * rs, o1[1] * rs, o1[2] * rs, o1[3] * rs};
            if (dir == 1) { const u32x4 pv = prevh[i];
                r[0] += bflo(pv.x); r[1] += bfhi(pv.x); r[2] += bflo(pv.y); r[3] += bfhi(pv.y); r[4] += bflo(pv.z); r[5] += bfhi(pv.z); r[6] += bflo(pv.w); r[7] += bfhi(pv.w);
                float ssq = (r[0] * r[0] + r[1] * r[1]) + (r[2] * r[2] + r[3] * r[3]) + (r[4] * r[4] + r[5] * r[5]) + (r[6] * r[6] + r[7] * r[7]);
                ssq += __shfl_xor(ssq, 1); ssq += __shfl_xor(ssq, 2); ssq += __shfl_xor(ssq, 4); ssq += __shfl_xor(ssq, 8);
                if (c8 == 0) wsp<float>(F, WS_SSQ)[((size_t)(m0 + t) * 8 + model * 4 + h) * 2 + half] = ssq; }
            u32x4 wv; wv.x = pkbf(r[0], r[1]); wv.y = pkbf(r[2], r[3]); wv.z = pkbf(r[4], r[5]); wv.w = pkbf(r[6], r[7]);
            *(u32x4*)dst = wv; }
    };
    const unsigned pwb = 128u * li + 8u * (lg & 1) + 16u * ((lg >> 1) ^ (li & 7));
    auto ptile = [&](const int ti, const int sh) {
        const bool used = dir == 0 ? !(sh == 1 && ti < 2) : !(sh == 0 && ti >= 2);
        if (!used) return;
        unsigned rowl = rowb; asm volatile("" : "+v"(rowl));
        bf16x8 pa[4], pb0[4], pb1[4];
#pragma unroll
        for (int kk = 0; kk < 4; ++kk) { const unsigned ra = lb + (rowl ^ ((unsigned)kk << 6)); pa[kk] = *(const LAS bf16x8*)(uintptr_t)(ra + M_AQ + 4096u * ti); pb0[kk] = *(const LAS bf16x8*)(uintptr_t)(ra + M_AK + 8192u * sh); pb1[kk] = *(const LAS bf16x8*)(uintptr_t)(ra + M_AK + 8192u * sh + 4096u); }
        f32x4 acc0 = {0.f, 0.f, 0.f, 0.f}, acc1 = acc0;
#pragma unroll
        for (int kk = 0; kk < 4; ++kk) { acc0 = MFMA16(pb0[kk], pa[kk], acc0); acc1 = MFMA16(pb1[kk], pa[kk], acc1); }
        const int t = 16 * ti + li;
#pragma unroll
        for (int sj = 0; sj < 2; ++sj) { const f32x4 acc = sj == 0 ? acc0 : acc1; const int s0 = 16 * (2 * sh + sj) + 4 * lg; float pv[4];
#pragma unroll
            for (int r = 0; r < 4; ++r) { const bool keep = dir == 0 ? (s0 + r <= t) : (s0 + r >= t); pv[r] = keep ? acc[r] : 0.f; }
            u32x2 pw; pw.x = pkbf(pv[0], pv[1]); pw.y = pkbf(pv[2], pv[3]);
            *(LAS u32x2*)(uintptr_t)(lb + M_P + 2048u * ti + (pwb ^ ((unsigned)(4 * sh + 2 * sj) << 4))) = pw; }
    };
    auto chunk_m0 = [&](const int ic) { const int c = seg_chunk(seg, dir, ic), ci = seg < 0 ? 256 + b * 4 + c : b * 128 + c; return chunk_row0(ci); };
    if (st) {
        const unsigned ola = lb + M_O + 4u * ((4 * lg) * O_LD + 32 * sw + li);
        for (int ic = 0; ic < nch; ++ic) {
            const int m0 = chunk_m0(ic);
            LBAR();
            if (F.tid < 128) gacc *= nb[128 + F.tid];
            unsigned o2l = o2b, tr0l = trb0, tr1l = trb1; asm volatile("" : "+v"(o2l), "+v"(tr0l), "+v"(tr1l));
            bf16x8 VB[2][2];
            tr_frag4<M_VP>(lb + (tr0l ^ ((unsigned)(2 * sw) << 5)), lb + (tr1l ^ ((unsigned)(2 * sw) << 5)), lb + (tr0l ^ ((unsigned)(2 * sw + 1) << 5)), lb + (tr1l ^ ((unsigned)(2 * sw + 1) << 5)), VB[0][0], VB[0][1], VB[1][0], VB[1][1]);
            u32x4 prevh[2] = {{0u, 0u, 0u, 0u}, {0u, 0u, 0u, 0u}};
            if (OUT) {
#pragma unroll
                for (int i = 0; i < 2; ++i) prevh[i] = *(const u32x4*)((const unsigned char*)(HS + (size_t)m0 * 1024 + h * 256 + half * 128) + (i == 0 ? poff0 : poff1) * (unsigned)dir);
                ptile(sw, 1);
                f32x4 O[2][4];
#pragma unroll
                for (int j = 0; j < 2; ++j)
#pragma unroll
                    for (int q = 0; q < 4; ++q) O[j][q] = (f32x4){0.f, 0.f, 0.f, 0.f};
#pragma unroll
                for (int kh = 0; kh < 2; ++kh) {
                    u32x2 alo[2][4], ahi[2][4];
#pragma unroll
                    for (int k2 = 0; k2 < 2; ++k2)
#pragma unroll
                        for (int q = 0; q < 4; ++q) { alo[k2][q] = *(const LAS u32x2*)(uintptr_t)((o2l ^ ((unsigned)(4 * (2 * kh + k2)) << 4)) + lb + M_AQ + 4096u * q); ahi[k2][q] = *(const LAS u32x2*)(uintptr_t)((o2l ^ ((unsigned)(4 * (2 * kh + k2) + 2) << 4)) + lb + M_AQ + 4096u * q); }
#pragma unroll
                    for (int k2 = 0; k2 < 2; ++k2) { const int kk = 2 * kh + k2; bf16x8 Bk[2];
#pragma unroll
                        for (int j = 0; j < 2; ++j) { u32x4 bw; bw.x = pkbf(S[j][2 * kk][0], S[j][2 * kk][1]); bw.y = pkbf(S[j][2 * kk][2], S[j][2 * kk][3]); bw.z = pkbf(S[j][2 * kk + 1][0], S[j][2 * kk + 1][1]); bw.w = pkbf(S[j][2 * kk + 1][2], S[j][2 * kk + 1][3]); Bk[j] = __builtin_bit_cast(bf16x8, bw); }
#pragma unroll
                        for (int q = 0; q < 4; ++q) { u32x4 aw; aw.x = alo[k2][q].x; aw.y = alo[k2][q].y; aw.z = ahi[k2][q].x; aw.w = ahi[k2][q].y; const bf16x8 Af = __builtin_bit_cast(bf16x8, aw);
                            O[0][q] = MFMA16(Af, Bk[0], O[0][q]); O[1][q] = MFMA16(Af, Bk[1], O[1][q]); } }
                    asm volatile("" ::: "memory");
                }
                LBAR();
                bf16x8 p0[4], p1[4];
#pragma unroll
                for (int q = 0; q < 4; ++q) { p0[q] = *(const LAS bf16x8*)(uintptr_t)(pra0 + 2048u * q); p1[q] = *(const LAS bf16x8*)(uintptr_t)(pra1 + 2048u * q); }
#pragma unroll
                for (int q = 0; q < 4; ++q) {
                    if (dir == 0 || q < 2) { O[0][q] = MFMA16(p0[q], VB[0][0], O[0][q]); O[1][q] = MFMA16(p0[q], VB[1][0], O[1][q]); }
                    if (dir == 1 || q >= 2) { O[0][q] = MFMA16(p1[q], VB[0][1], O[0][q]); O[1][q] = MFMA16(p1[q], VB[1][1], O[1][q]); } }
#pragma unroll
                for (int j = 0; j < 2; ++j)
#pragma unroll
                    for (int q = 0; q < 4; ++q)
#pragma unroll
                        for (int r = 0; r < 4; ++r) *(LAS float*)(uintptr_t)(ola + 64u * j + 4u * (unsigned)((16 * q + r) * O_LD)) = O[j][q][r];
            }
#pragma unroll
            for (int kp = 0; kp < 4; ++kp) { bf16x8 A0, A1, A2, A3; const int kt = 2 * kp;
                const f32x4 g0 = *(const LAS f32x4*)(nb + 128 + 16 * kt + 4 * lg), g1 = *(const LAS f32x4*)(nb + 128 + 16 * (kt + 1) + 4 * lg);
                tr_frag4<M_AK>(lb + (tr0l ^ ((unsigned)kt << 5)), lb + (tr1l ^ ((unsigned)kt << 5)), lb + (tr0l ^ ((unsigned)(kt + 1) << 5)), lb + (tr1l ^ ((unsigned)(kt + 1) << 5)), A0, A1, A2, A3);
#pragma unroll
                for (int j = 0; j < 2; ++j) { S[j][kt] = MFMA16(A0, VB[j][0], S[j][kt]); S[j][kt + 1] = MFMA16(A2, VB[j][0], S[j][kt + 1]); }
#pragma unroll
                for (int j = 0; j < 2; ++j) { S[j][kt] = MFMA16(A1, VB[j][1], S[j][kt]); S[j][kt + 1] = MFMA16(A3, VB[j][1], S[j][kt + 1]); }
#pragma unroll
                for (int j = 0; j < 2; ++j) { S[j][kt] = S[j][kt] * g0; S[j][kt + 1] = S[j][kt + 1] * g1; } }
            LBAR();
            if (OUT) final_pass(m0, prevh);
        }
    } else {
        const int ht = F.tid - 256;
        const unsigned hoff = (unsigned)((ht >> 4) * 1024 + (ht & 15) * 8) * 2u;
        const unsigned aoff = (unsigned)(ht >> 4) * 32u + 4u, aoffl = (unsigned)(ht & 63) * 32u;
        const f32x2* ABd = wsp<f32x2>(F, WS_AB) + (size_t)dir * MT * 4 + h;
        const bf16* vbase = wsp<bf16>(F, model == 0 ? WS_VM : WS_VG) + h * 256 + half * 128;
        struct SR { u32x4 q[4], k[4], v[4]; float be[4]; f32x2 ab; float ge; };
        SR R;
        auto issue = [&](const int ic_) {
            const int c_ = seg_chunk(seg, dir, ic_), ci_ = seg < 0 ? 256 + b * 4 + c_ : b * 128 + c_, m0_ = chunk_row0(ci_);
            const unsigned char* abr = (const unsigned char*)(ABd + (size_t)m0_ * 4);
            { const float* abp = (const float*)(abr + aoffl); R.ab.x = abp[0]; R.ab.y = abp[1]; }
            const float* gp = model == 0 ? wsp<float>(F, WS_GENDM) + ((size_t)dir * NCHUNK + ci_) * 4 + h : wsp<float>(F, WS_GENDG) + ((size_t)dir * NCHUNK + ci_) * 512 + h * 128 + ((ht - 64) & 127);
            R.ge = *gp;
            const long long qoff = model == 0 ? (long long)WS_QKMC : (m0_ < M_LAT ? 0ll : (long long)WS_QKGTC + ((long long)dir * M_CTX - M_LAT) * 2048);
            const unsigned char* qbb = (model == 1 && m0_ < M_LAT) ? (const unsigned char*)F.out + (size_t)dir * M_LAT * 2048 : (const unsigned char*)F.ws + qoff;
            const unsigned char* qr = qbb + (size_t)m0_ * 2048 + h * 256;
            const unsigned char* vr = (const unsigned char*)(vbase + (size_t)m0_ * 1024);
#pragma unroll
            for (int i = 0; i < 4; ++i) { const unsigned o = hoff + (unsigned)i * 16u * 2048u;
                if (OUT) R.q[i] = *(const u32x4*)(qr + o);
                R.k[i] = *(const u32x4*)(qr + 1024 + o); R.v[i] = *(const u32x4*)(vr + o); R.be[i] = *(const float*)(abr + aoff + (unsigned)i * 16u * 32u); }
        };
        const int ti = sw;
        const unsigned fra = lb + L_N + 2048 + (li == 1 ? 128u : 0u) + 16u * lg;
        const unsigned nfa = lb + L_N + 2048 + 256 + (li == 1 ? 256u : 0u) + 16u * lg;
        issue(0);
        for (int ic = 0; ic < nch; ++ic) {
            const int m0 = chunk_m0(ic);
            if (model == 0 && ht < 64) { const float be = R.ab.y; nb[320 + ht] = R.ab.x;
                const unsigned hi = pkbf(be, be) & 0xffffu; nbh[ht] = (unsigned short)hi; nbh[64 + ht] = (unsigned short)(pkbf(be - bflo(hi), 0.f) & 0xffffu); }
            if (ht >= 64 && ht < 192) nb[128 + ht - 64] = R.ge;
#pragma unroll
            for (int i = 0; i < 4; ++i) { const int p = ht + i * 256, r = p >> 4, cp = p & 15;
                const unsigned o = offb(r, cp);
                if (OUT) *(LAS u32x4*)(lds + M_AQ + o) = R.q[i];
                *(LAS u32x4*)(lds + M_AK + o) = R.k[i];
                u32x4 v = R.v[i];
                if (model == 0) { const float be = R.be[i];
                    v.x = pkbf(bflo(v.x) * be, bfhi(v.x) * be); v.y = pkbf(bflo(v.y) * be, bfhi(v.y) * be); v.z = pkbf(bflo(v.z) * be, bfhi(v.z) * be); v.w = pkbf(bflo(v.w) * be, bfhi(v.w) * be); }
                *(LAS u32x4*)(lds + M_VP + o) = v; }
            LBAR();
            u32x4 prevh[2] = {{0u, 0u, 0u, 0u}, {0u, 0u, 0u, 0u}};
            if (OUT) {
#pragma unroll
                for (int i = 0; i < 2; ++i) prevh[i] = *(const u32x4*)((const unsigned char*)(HS + (size_t)m0 * 1024 + h * 256 + half * 128) + (i == 0 ? poff0 : poff1) * (unsigned)dir);
                ptile(ti, 0);
            }
            if (ic + 1 < nch) issue(ic + 1);
            unsigned rowl = rowb, tr0l = trb0, tr1l = trb1; asm volatile("" : "+v"(rowl), "+v"(tr0l), "+v"(tr1l));
            bf16x8 BB0, BB1;
            { u32x4 z = {0u, 0u, 0u, 0u}; BB0 = __builtin_bit_cast(bf16x8, z); BB1 = BB0; }
            if (model == 0) { u32x4 f0 = *(const LAS u32x4*)(uintptr_t)fra, f1 = *(const LAS u32x4*)(uintptr_t)(fra + 64u); const u32x4 z = {0u, 0u, 0u, 0u};
                if (li > 1) { f0 = z; f1 = z; } BB0 = __builtin_bit_cast(bf16x8, f0); BB1 = __builtin_bit_cast(bf16x8, f1); }
            f32x4 dq = {0.f, 0.f, 0.f, 0.f};
            if (OUT && model == 0) {
                bf16x8 pa[4]; u32x4 nf[4]; const u32x4 z = {0u, 0u, 0u, 0u};
#pragma unroll
                for (int kk = 0; kk < 4; ++kk) { pa[kk] = *(const LAS bf16x8*)(uintptr_t)(lb + (rowl ^ ((unsigned)kk << 6)) + M_AQ + 4096u * ti); nf[kk] = *(const LAS u32x4*)(uintptr_t)(nfa + 64u * kk); if (li > 1) nf[kk] = z; }
#pragma unroll
                for (int kk = 0; kk < 4; ++kk) dq = MFMA16(pa[kk], __builtin_bit_cast(bf16x8, nf[kk]), dq);
            }
            f32x4 nacc0 = {0.f, 0.f, 0.f, 0.f}, nacc1 = nacc0;
            if (model == 0) { bf16x8 A0, A1, A2, A3;
                tr_frag4<M_AK>(lb + (tr0l ^ ((unsigned)(2 * ti) << 5)), lb + (tr1l ^ ((unsigned)(2 * ti) << 5)), lb + (tr0l ^ ((unsigned)(2 * ti + 1) << 5)), lb + (tr1l ^ ((unsigned)(2 * ti + 1) << 5)), A0, A1, A2, A3);
                nacc0 = MFMA16(A0, BB0, nacc0); nacc0 = MFMA16(A1, BB1, nacc0); nacc1 = MFMA16(A2, BB0, nacc1); nacc1 = MFMA16(A3, BB1, nacc1); }
            float nnew[8] = {0.f, 0.f, 0.f, 0.f, 0.f, 0.f, 0.f, 0.f};
            if (model == 0) { const f32x4 no0 = *(const LAS f32x4*)(nb + 32 * ti + 4 * lg), no1 = *(const LAS f32x4*)(nb + 32 * ti + 16 + 4 * lg), gw0 = *(const LAS f32x4*)(nb + 128 + 32 * ti + 4 * lg), gw1 = *(const LAS f32x4*)(nb + 128 + 32 * ti + 16 + 4 * lg);
#pragma unroll
                for (int r = 0; r < 4; ++r) { nnew[r] = gw0[r] * (no0[r] + nacc0[r] + __shfl_xor(nacc0[r], 1)); nnew[4 + r] = gw1[r] * (no1[r] + nacc1[r] + __shfl_xor(nacc1[r], 1)); } }
            if (OUT) {
                LBAR();
                if (model == 0) { f32x4 dp = dq;
                    const bf16x8 p0 = *(const LAS bf16x8*)(uintptr_t)(pra0 + 2048u * ti), p1 = *(const LAS bf16x8*)(uintptr_t)(pra1 + 2048u * ti);
                    if (dir == 0 || ti < 2) dp = MFMA16(p0, BB0, dp);
                    if (dir == 1 || ti >= 2) dp = MFMA16(p1, BB1, dp);
#pragma unroll
                    for (int r = 0; r < 4; ++r) { const float v = dp[r] + __shfl_xor(dp[r], 1); const float al = nb[320 + 16 * ti + 4 * lg + r];
                        if (li == 0) nb[384 + 16 * ti + 4 * lg + r] = al / fmaxf(al * fabsf(v), 1.f); } }
            }
            LBAR();
            if (model == 0 && li == 0) {
#pragma unroll
                for (int j = 0; j < 2; ++j) { const int dk0 = 32 * ti + 16 * j + 4 * lg; const float* nn = nnew + 4 * j;
                    f32x4 nv = {nn[0], nn[1], nn[2], nn[3]}; *(LAS f32x4*)(nb + dk0) = nv;
                    u32x2 hv, lv; const unsigned h0 = pkbf(nn[0], nn[1]), h1 = pkbf(nn[2], nn[3]); hv.x = h0; hv.y = h1;
                    lv.x = pkbf(nn[0] - bflo(h0), nn[1] - bfhi(h0)); lv.y = pkbf(nn[2] - bflo(h1), nn[3] - bfhi(h1));
                    *(LAS u32x2*)(nbh + 128 + dk0) = hv; *(LAS u32x2*)(nbh + 256 + dk0) = lv; } }
            if (OUT) final_pass(m0, prevh);
        }
    }
}
__device__ __forceinline__ void p4m_scan_local(Frame& F) {
    LAS float* nb = (LAS float*)(F.lds + L_N);
    for (int it0 = F.bid; it0 < 32 * 8 * 2; it0 += F.G) {
        const int it = (F.G == 256) ? (it0 & ~255) | ((((((it0 & 255) >> 4) << 3) | (it0 & 7)) << 1) | ((it0 >> 3) & 1)) : it0;
        const int half = it & 1, slot = (it >> 1) & 7, sc = it >> 4, seg = slot - 1;
        const int dir = sc & 1, h = (sc >> 1) & 3, b = (sc >> 3) & 1, model = sc >> 4;
        f32x4 S[2][8];
#pragma unroll
        for (int j = 0; j < 2; ++j)
#pragma unroll
            for (int kt = 0; kt < 8; ++kt) S[j][kt] = (f32x4){0.f, 0.f, 0.f, 0.f};
        __syncthreads();
        if (F.tid < 128) nb[F.tid] = 0.f;
        float gacc = 1.f;
        mscan_run<false>(F, model, b, h, dir, half, seg, S, gacc);
        __syncthreads();
        if (F.wave < 4) {
#pragma unroll
            for (int j = 0; j < 2; ++j) { unsigned so = (unsigned)((2 * F.wave + j) * 512 + F.lane) * 8u; asm volatile("" : "+v"(so));
                bf16* st = (bf16*)((unsigned char*)mstate_ptr(F, sc, slot, half) + so);
#pragma unroll
                for (int kt = 0; kt < 8; ++kt) { u32x2 v; v.x = pkbf(S[j][kt][0], S[j][kt][1]); v.y = pkbf(S[j][kt][2], S[j][kt][3]); *(u32x2*)(st + kt * 256) = v; } } }
        if (half == 0 && F.tid < 128) { wsp<float>(F, WS_NST)[(sc * 8 + slot) * 128 + F.tid] = nb[F.tid]; wsp<float>(F, WS_GSEG)[(sc * 8 + slot) * 128 + F.tid] = gacc; }
    }
}
__device__ __forceinline__ void p5m_scan_out(Frame& F) {
    LAS float* nb = (LAS float*)(F.lds + L_N);
    for (int it0 = F.bid; it0 < 2 * 2 * 4 * 8 * 2; it0 += F.G) {
        const int it = (F.G == 256) ? ((((it0 >> 4) << 3) | (it0 & 7)) << 1) | ((it0 >> 3) & 1) : it0;
        const int half = it & 1, seg = (it >> 1) & 7, h = (it >> 4) & 3, b = (it >> 6) & 1, model = it >> 7;
        for (int dir = 0; dir < 2; ++dir) {
            const int sc = ((model * 2 + b) * 4 + h) * 2 + dir, s = dir == 0 ? seg : 7 - seg;
            f32x4 S[2][8];
#pragma unroll
            for (int j = 0; j < 2; ++j)
#pragma unroll
                for (int kt = 0; kt < 8; ++kt) S[j][kt] = (f32x4){0.f, 0.f, 0.f, 0.f};
            float nn = 0.f;
            for (int slot = 0; slot <= s; ++slot) {
                const float* gs = wsp<float>(F, WS_GSEG) + (sc * 8 + slot) * 128;
                const float gv = gs[F.tid & 127], nv = wsp<float>(F, WS_NST)[(sc * 8 + slot) * 128 + (F.tid & 127)];
                if (F.wave < 4) {
                    f32x4 gv4[8];
#pragma unroll
                    for (int kt = 0; kt < 8; ++kt) gv4[kt] = *(const f32x4*)(gs + 16 * kt + 4 * (F.lane >> 4));
#pragma unroll
                    for (int j = 0; j < 2; ++j) { unsigned so = (unsigned)((2 * F.wave + j) * 512 + F.lane) * 8u; asm volatile("" : "+v"(so));
                        const bf16* stp = (const bf16*)((const unsigned char*)mstate_ptr(F, sc, slot, half) + so);
                        u32x2 sv[8];
#pragma unroll
                        for (int kt = 0; kt < 8; ++kt) sv[kt] = *(const u32x2*)(stp + kt * 256);
#pragma unroll
                        for (int kt = 0; kt < 8; ++kt) { const u32x2 v = sv[kt]; f32x4 g4 = gv4[kt]; if (slot == 0) g4 = (f32x4){0.f, 0.f, 0.f, 0.f};
                            S[j][kt][0] = g4[0] * S[j][kt][0] + bflo(v.x); S[j][kt][1] = g4[1] * S[j][kt][1] + bfhi(v.x); S[j][kt][2] = g4[2] * S[j][kt][2] + bflo(v.y); S[j][kt][3] = g4[3] * S[j][kt][3] + bfhi(v.y); } } }
                nn = (slot > 0 ? gv : 0.f) * nn + nv; }
            __syncthreads();
            if (F.tid < 128) { nb[F.tid] = nn; LAS unsigned short* nbh = (LAS unsigned short*)(F.lds + L_N + 2048);
                const unsigned hi = pkbf(nn, nn) & 0xffffu; nbh[128 + F.tid] = (unsigned short)hi; nbh[256 + F.tid] = (unsigned short)(pkbf(nn - bflo(hi), 0.f) & 0xffffu); }
            float gacc = 1.f;
            mscan_run<true>(F, model, b, h, dir, half, s, S, gacc);
        }
    }
}

struct EpiProjB {
    unsigned char* ws; const float* ml_norm; const float* gla_norm;
    __device__ __forceinline__ void operator()(const f32x4 (&acc)[2][2][4][2], const Unit& u, int wr, int wc, int fr, int fq) const {
        const int row0 = u.pm * 256 + wr * 64 + fr, colt = (u.pn & 3) * 256 + wc * 32 + 8 * fq;
        if (u.pn < 8) {
            const int model = u.pn >> 2, head = u.pn & 3;
            bf16* base = (bf16*)(ws + (model == 0 ? WS_QKM : WS_QKG)) + colt;
            const float* nw = (model == 0 ? ml_norm : gla_norm) + colt;
            const float* ssq = (const float*)(ws + WS_SSQ);
            const float gsel = model == 0 ? 0.f : 1.f;
#pragma unroll
            for (int ai = 0; ai < 2; ++ai)
#pragma unroll
                for (int m = 0; m < 4; ++m) { asm volatile("" ::: "memory");
                    const int row = row0 + ai * 128 + m * 16; bf16* rowp = base + (size_t)row * 1024;
                    const f32x2 sq = *(const f32x2*)(ssq + ((size_t)row * 8 + model * 4 + head) * 2);
                    const float rstd = 1.f / sqrtf((sq.x + sq.y) * (1.f / 256.f) + EPS);
                    float one = 1.f; asm volatile("" : "+v"(one));
#pragma unroll
                    for (int bj = 0; bj < 2; ++bj) { const f32x4 a0 = acc[ai][bj][m][0] * one, a1 = acc[ai][bj][m][1] * one;
                        const u32x4 hv = *(const u32x4*)(rowp + bj * 128); const f32x4 n0 = *(const f32x4*)(nw + bj * 128), n1 = *(const f32x4*)(nw + bj * 128 + 4);
                        float hvf[8]; unpack8(hv, hvf); float o[8];
#pragma unroll
                        for (int j = 0; j < 4; ++j) { const float s0 = sigm(a0[j]), s1 = sigm(a1[j]);
                            o[j] = hvf[j] * rstd * n0[j] * (s0 + gsel * (s0 * a0[j] - s0)); o[4 + j] = hvf[4 + j] * rstd * n1[j] * (s1 + gsel * (s1 * a1[j] - s1)); }
                        u32x4 w; w.x = cvt_pk_bf16(o[0], o[1]); w.y = cvt_pk_bf16(o[2], o[3]); w.z = cvt_pk_bf16(o[4], o[5]); w.w = cvt_pk_bf16(o[6], o[7]);
                        *(u32x4*)(rowp + bj * 128) = w; } }
        } else {
            bf16* base = (bf16*)(ws + (u.pn < 12 ? WS_VG : WS_QKMC)) + colt;
#pragma unroll
            for (int ai = 0; ai < 2; ++ai)
#pragma unroll
                for (int m = 0; m < 4; ++m) { bf16* rowp = base + (size_t)(row0 + ai * 128 + m * 16) * 1024;
#pragma unroll
                    for (int bj = 0; bj < 2; ++bj) { const f32x4 a0 = acc[ai][bj][m][0], a1 = acc[ai][bj][m][1];
                        u32x4 w; w.x = pkbf(sigm(a0[0]), sigm(a0[1])); w.y = pkbf(sigm(a0[2]), sigm(a0[3])); w.z = pkbf(sigm(a1[0]), sigm(a1[1])); w.w = pkbf(sigm(a1[2]), sigm(a1[3]));
                        *(u32x4*)(rowp + bj * 128) = w; } }
        }
    }
};
template <int STEP> struct EpiGate {
    unsigned char* ws;
    __device__ __forceinline__ void operator()(const f32x4 (&acc)[2][2][4][2], const Unit& u, int wr, int wc, int fr, int fq) const {
        const int row0 = u.pm * 256 + wr * 64 + fr, colt = u.pn * 256 + wc * 32 + 8 * fq;
        const bf16* sg = (const bf16*)(ws + (STEP == 0 ? WS_VG : WS_QKMC)) + colt; bf16* ty = (bf16*)(ws + WS_VM) + colt;
#pragma unroll
        for (int ai = 0; ai < 2; ++ai)
#pragma unroll
            for (int m = 0; m < 4; ++m) { const size_t ro = (size_t)(row0 + ai * 128 + m * 16) * 1024;
#pragma unroll
                for (int bj = 0; bj < 2; ++bj) { const f32x4 a0 = acc[ai][bj][m][0], a1 = acc[ai][bj][m][1];
                    const u32x4 s = *(const u32x4*)(sg + ro + bj * 128);
                    float r[8] = {bflo(s.x) * a0[0], bfhi(s.x) * a0[1], bflo(s.y) * a0[2], bfhi(s.y) * a0[3], bflo(s.z) * a1[0], bfhi(s.z) * a1[1], bflo(s.w) * a1[2], bfhi(s.w) * a1[3]};
                    if (STEP == 1) { const u32x4 t = *(const u32x4*)(ty + ro + bj * 128);
                        r[0] += bflo(t.x); r[1] += bfhi(t.x); r[2] += bflo(t.y); r[3] += bfhi(t.y); r[4] += bflo(t.z); r[5] += bfhi(t.z); r[6] += bflo(t.w); r[7] += bfhi(t.w); }
                    u32x4 w; w.x = cvt_pk_bf16(r[0], r[1]); w.y = cvt_pk_bf16(r[2], r[3]); w.z = cvt_pk_bf16(r[4], r[5]); w.w = cvt_pk_bf16(r[6], r[7]);
                    *(u32x4*)(ty + ro + bj * 128) = w; } }
    }
};
struct EpiOut {
    const float* x; float* out; const float* modv;
    __device__ __forceinline__ void operator()(const f32x4 (&acc)[2][2][4][2], const Unit& u, int wr, int wc, int fr, int fq) const {
        const int row0 = u.pm * 256 + wr * 64 + fr, colt = u.pn * 256 + wc * 32 + 8 * fq;
        const float* gt = modv + ((u.pm * 256) >> 13) * 6144 + 2048 + colt;
#pragma unroll
        for (int bj = 0; bj < 2; ++bj) { const f32x4 g0 = *(const f32x4*)(gt + bj * 128), g1 = *(const f32x4*)(gt + bj * 128 + 4);
#pragma unroll
            for (int ai = 0; ai < 2; ++ai)
#pragma unroll
                for (int m = 0; m < 4; ++m) { const size_t off = (size_t)(row0 + ai * 128 + m * 16) * 1024 + colt + bj * 128;
                    *(f32x4*)(out + off) = *(const f32x4*)(x + off) + g0 * acc[ai][bj][m][0]; *(f32x4*)(out + off + 4) = *(const f32x4*)(x + off + 4) + g1 * acc[ai][bj][m][1]; } }
    }
};

__device__ __forceinline__ void p9_route(Frame& F) {
    const float* modv = wsp<float>(F, WS_MODV);
    constexpr int WP = 1032;
    LAS unsigned short* Wt = (LAS unsigned short*)F.lds;
    LAS float* lgs = (LAS float*)(F.lds + 40 * WP * 2) + F.wave * 512;
    LAS int* hist = (LAS int*)(F.lds + 40 * WP * 2 + 16384);
    if (F.tid < 32) hist[F.tid] = 0;
    for (int k = F.tid; k < 1024; k += NTHR) {
        const f32x4 wg = *(const f32x4*)(F.w_grp + (size_t)k * 4), w0 = *(const f32x4*)(F.w_rexp + (size_t)k * 16), w1 = *(const f32x4*)(F.w_rexp + (size_t)k * 16 + 4), w2 = *(const f32x4*)(F.w_rexp + (size_t)k * 16 + 8), w3 = *(const f32x4*)(F.w_rexp + (size_t)k * 16 + 12);
        const float wv[20] = {wg[0], wg[1], wg[2], wg[3], w0[0], w0[1], w0[2], w0[3], w1[0], w1[1], w1[2], w1[3], w2[0], w2[1], w2[2], w2[3], w3[0], w3[1], w3[2], w3[3]};
#pragma unroll
        for (int n = 0; n < 20; ++n) { const unsigned hi = pkbf(wv[n], 0.f) & 0xffffu; Wt[n * WP + k] = (unsigned short)hi; Wt[(20 + n) * WP + k] = (unsigned short)(pkbf(wv[n] - bflo(hi), 0.f) & 0xffffu); } }
    __syncthreads();
    int* rexp = (int*)(F.ws + WS_ROUTE + RT_EXP); float* rw = (float*)(F.ws + WS_ROUTE + RT_W); int* rpos = (int*)(F.ws + WS_ROUTE + RT_POS);
    const int gw = F.bid * NW + F.wave, NGW = F.G * NW, li = F.lane & 15, lg = F.lane >> 4;
    const int n1 = 16 + li < 20 ? 16 + li : 19;
    for (int t = gw; t < M_LAT / 16; t += NGW) {
        const int m = 16 * t + li; const float* src = F.out + (size_t)m * D + 8 * lg; const float* mv = modv + (m >> 13) * 6144 + 8 * lg;
        float ss = 0.f;
#pragma unroll 8
        for (int ks = 0; ks < 32; ++ks) { const f32x4 a = *(const f32x4*)(src + 32 * ks), c = *(const f32x4*)(src + 32 * ks + 4); ss += (a.x * a.x + a.y * a.y) + (a.z * a.z + a.w * a.w) + (c.x * c.x + c.y * c.y) + (c.z * c.z + c.w * c.w); }
        ss += __shfl_xor(ss, 16); ss += __shfl_xor(ss, 32);
        const float rstd = 1.f / sqrtf(ss * (1.f / D) + EPS);
        f32x4 acc0 = {0.f, 0.f, 0.f, 0.f}, acc1 = acc0;
        bf16* o = wsp<bf16>(F, WS_H2) + (size_t)m * D + 8 * lg;
#pragma unroll 4
        for (int ks = 0; ks < 32; ++ks) { const int c = 32 * ks;
            const f32x4 xa = *(const f32x4*)(src + c), xb = *(const f32x4*)(src + c + 4);
            const f32x4 ga = *(const f32x4*)(F.g_norm2 + 8 * lg + c), gb = *(const f32x4*)(F.g_norm2 + 8 * lg + c + 4);
            const f32x4 sha = *(const f32x4*)(mv + 3072 + c), shb = *(const f32x4*)(mv + 3072 + c + 4), sca = *(const f32x4*)(mv + 4096 + c), scb = *(const f32x4*)(mv + 4096 + c + 4);
            const f32x4 ha = (xa * rstd) * ga * (sca + 1.f) + sha, hb = (xb * rstd) * gb * (scb + 1.f) + shb;
            u32x4 hi; hi.x = pkbf(ha[0], ha[1]); hi.y = pkbf(ha[2], ha[3]); hi.z = pkbf(hb[0], hb[1]); hi.w = pkbf(hb[2], hb[3]);
            u32x4 lo; lo.x = pkbf(ha[0] - bflo(hi.x), ha[1] - bfhi(hi.x)); lo.y = pkbf(ha[2] - bflo(hi.y), ha[3] - bfhi(hi.y)); lo.z = pkbf(hb[0] - bflo(hi.z), hb[1] - bfhi(hi.z)); lo.w = pkbf(hb[2] - bflo(hi.w), hb[3] - bfhi(hi.w));
            *(u32x4*)(o + c) = hi;
            const bf16x8 Ah = __builtin_bit_cast(bf16x8, hi), Al = __builtin_bit_cast(bf16x8, lo);
            const bf16x8 bh0 = *(const LAS bf16x8*)(Wt + li * WP + c + 8 * lg), bh1 = *(const LAS bf16x8*)(Wt + n1 * WP + c + 8 * lg), bl0 = *(const LAS bf16x8*)(Wt + (20 + li) * WP + c + 8 * lg), bl1 = *(const LAS bf16x8*)(Wt + (20 + n1) * WP + c + 8 * lg);
            acc0 = __builtin_amdgcn_mfma_f32_16x16x32_bf16(Ah, bh0, acc0, 0, 0, 0); acc1 = __builtin_amdgcn_mfma_f32_16x16x32_bf16(Ah, bh1, acc1, 0, 0, 0);
            acc0 = __builtin_amdgcn_mfma_f32_16x16x32_bf16(Al, bh0, acc0, 0, 0, 0); acc1 = __builtin_amdgcn_mfma_f32_16x16x32_bf16(Al, bh1, acc1, 0, 0, 0);
            acc0 = __builtin_amdgcn_mfma_f32_16x16x32_bf16(Ah, bl0, acc0, 0, 0, 0); acc1 = __builtin_amdgcn_mfma_f32_16x16x32_bf16(Ah, bl1, acc1, 0, 0, 0); }
#pragma unroll
        for (int r = 0; r < 4; ++r) { lgs[(4 * lg + r) * 32 + li] = acc0[r]; lgs[(4 * lg + r) * 32 + 16 + li] = acc1[r]; }
        LDS_WAIT(); asm volatile("" ::: "memory");
        if (F.lane < 16) {
            const int mr = 16 * t + F.lane;
            const f32x4 lq0 = *(const LAS f32x4*)(lgs + F.lane * 32), lq1 = *(const LAS f32x4*)(lgs + F.lane * 32 + 4), lq2 = *(const LAS f32x4*)(lgs + F.lane * 32 + 8), lq3 = *(const LAS f32x4*)(lgs + F.lane * 32 + 12), lq4 = *(const LAS f32x4*)(lgs + F.lane * 32 + 16);
            const f32x4 bg = *(const f32x4*)F.b_grp;
            float gl[4] = {lq0[0] + bg[0], lq0[1] + bg[1], lq0[2] + bg[2], lq0[3] + bg[3]};
            int grp = 0; float gmax = gl[0];
#pragma unroll
            for (int q = 1; q < 4; ++q) if (gl[q] > gmax) { gmax = gl[q]; grp = q; }
            float gs = 0.f;
#pragma unroll
            for (int q = 0; q < 4; ++q) gs += expf(gl[q] - gmax);
            const float grp_p = 1.f / gs;
            float el[4];
#pragma unroll
            for (int q = 0; q < 4; ++q) { float v = lq1[q]; v = grp == 1 ? lq2[q] : v; v = grp == 2 ? lq3[q] : v; v = grp == 3 ? lq4[q] : v; asm volatile("" : "+v"(v)); el[q] = v + F.b_rexp[grp * 4 + q]; }
            int i0 = 0; float e0v = el[0];
#pragma unroll
            for (int q = 1; q < 4; ++q) if (el[q] > e0v) { e0v = el[q]; i0 = q; }
            int i1 = -1; float e1v = -3.0e38f;
#pragma unroll
            for (int q = 0; q < 4; ++q) if (q != i0 && el[q] > e1v) { e1v = el[q]; i1 = q; }
            const float e1 = expf(e1v - e0v); const float w0 = grp_p / (1.f + e1), w1 = grp_p * e1 / (1.f + e1);
            const int x0 = grp * 4 + i0, x1 = grp * 4 + i1;
            rexp[2 * mr] = x0; rexp[2 * mr + 1] = x1; rw[2 * mr] = w0; rw[2 * mr + 1] = w1;
            rpos[2 * mr] = __hip_atomic_fetch_add(hist + x0, 1, __ATOMIC_RELAXED, __HIP_MEMORY_SCOPE_WORKGROUP);
            rpos[2 * mr + 1] = __hip_atomic_fetch_add(hist + x1, 1, __ATOMIC_RELAXED, __HIP_MEMORY_SCOPE_WORKGROUP);
        }
        LDS_WAIT(); asm volatile("" ::: "memory");
    }
    __syncthreads();
    if (F.tid < 16) hist[16 + F.tid] = (int)__hip_atomic_fetch_add((unsigned*)(F.ws + WS_CTL) + CW_CNT + 64 * F.tid, (unsigned)hist[F.tid], __ATOMIC_RELAXED, __HIP_MEMORY_SCOPE_AGENT);
    __syncthreads();
    VM_WAIT();
    for (int t = gw; t < M_LAT / 16; t += NGW) if (F.lane < 32) { const int a = 32 * t + F.lane, e = rexp[a], pos = rpos[a] + hist[16 + e]; rpos[a] = pos;
        wsp<int>(F, WS_LTOK)[e * LCAP + pos] = a >> 1; wsp<float>(F, WS_LW)[e * LCAP + pos] = rw[a]; }
    __syncthreads();
    moe_weight_copies<0>(F);
}
__device__ __forceinline__ void moe_layout(Frame& F) {
    LAS int* tab = (LAS int*)(F.lds + LDS_TAB);
    if (F.tid == 0) { int a = 0; for (int e = 0; e < 16; ++e) { const int c = (int)__hip_atomic_load((unsigned*)(F.ws + WS_CTL) + CW_CNT + 64 * e, __ATOMIC_RELAXED, __HIP_MEMORY_SCOPE_AGENT); tab[e] = a; tab[32 + e] = c; a += (c + 255) & ~255; } tab[16] = a; tab[17] = a >> 8; }
    __syncthreads();
}
struct EpiUp {
    unsigned char* ws;
    __device__ __forceinline__ void operator()(const f32x4 (&acc)[2][2][4][2], const Unit& u, int wr, int wc, int fr, int fq) const {
        const int row0 = u.pm * 256 + wr * 64 + fr; bf16* base = (bf16*)(ws + WS_HID) + u.pn * 128 + wc * 32 + 8 * fq;
#pragma unroll
        for (int ai = 0; ai < 2; ++ai)
#pragma unroll
            for (int m = 0; m < 4; ++m) { const f32x4 g0 = acc[ai][0][m][0], g1 = acc[ai][0][m][1], u0 = acc[ai][1][m][0], u1 = acc[ai][1][m][1];
                u32x4 w; w.x = cvt_pk_bf16(siluf(g0[0]) * u0[0], siluf(g0[1]) * u0[1]); w.y = cvt_pk_bf16(siluf(g0[2]) * u0[2], siluf(g0[3]) * u0[3]);
                w.z = cvt_pk_bf16(siluf(g1[0]) * u1[0], siluf(g1[1]) * u1[1]); w.w = cvt_pk_bf16(siluf(g1[2]) * u1[2], siluf(g1[3]) * u1[3]);
                *(u32x4*)(base + (size_t)(row0 + ai * 128 + m * 16) * 512) = w; }
    }
};
struct EpiDown {
    unsigned char* ws; const LAS int* tab;
    __device__ __forceinline__ void operator()(const f32x4 (&acc)[2][2][4][2], const Unit& u, int wr, int wc, int fr, int fq) const {
        const int row0 = u.pm * 256 + wr * 64 + fr; bf16* base = (bf16*)(ws + WS_YROWS) + u.pn * 256 + wc * 32 + 8 * fq;
        const float* lw = (const float*)(ws + WS_LW) + u.e * LCAP - tab[u.e];
#pragma unroll
        for (int ai = 0; ai < 2; ++ai)
#pragma unroll
            for (int m = 0; m < 4; ++m) { const int row = row0 + ai * 128 + m * 16; const float rwt = lw[row];
#pragma unroll
                for (int bj = 0; bj < 2; ++bj) { const f32x4 v0 = acc[ai][bj][m][0] * rwt, v1 = acc[ai][bj][m][1] * rwt;
                    u32x4 w; w.x = cvt_pk_bf16(v0[0], v0[1]); w.y = cvt_pk_bf16(v0[2], v0[3]); w.z = cvt_pk_bf16(v1[0], v1[1]); w.w = cvt_pk_bf16(v1[2], v1[3]);
                    *(u32x4*)(base + (size_t)row * 1024 + bj * 128) = w; } }
    }
};
__device__ __forceinline__ void p13_final(Frame& F) {
    moe_layout(F);
    const LAS int* tab = (const LAS int*)(F.lds + LDS_TAB);
    const float* modv = wsp<float>(F, WS_MODV); const int* rpos = (const int*)(F.ws + WS_ROUTE + RT_POS); const int* rexp = (const int*)(F.ws + WS_ROUTE + RT_EXP); const bf16* Y = wsp<bf16>(F, WS_YROWS);
    const int gw = F.bid * NW + F.wave, NGW = F.G * NW;
    for (int m = gw; m < M_LAT; m += NGW) {
        float* row = F.out + (size_t)m * D; const float* gt = modv + (m >> 13) * 6144 + 5120;
        const bf16* y0 = Y + (size_t)(tab[rexp[2 * m]] + rpos[2 * m]) * 1024; const bf16* y1 = Y + (size_t)(tab[rexp[2 * m + 1]] + rpos[2 * m + 1]) * 1024;
        f32x4 v[4]; float s = 0.f;
#pragma unroll
        for (int j = 0; j < 4; ++j) { const int c = 4 * F.lane + 256 * j; const u32x2 a = *(const u32x2*)(y0 + c), b = *(const u32x2*)(y1 + c); const f32x4 g = *(const f32x4*)(gt + c);
            f32x4 yy; yy.x = bflo(a.x) + bflo(b.x); yy.y = bfhi(a.x) + bfhi(b.x); yy.z = bflo(a.y) + bflo(b.y); yy.w = bfhi(a.y) + bfhi(b.y);
            v[j] = *(const f32x4*)(row + c) + g * yy; s += (v[j].x * v[j].x + v[j].y * v[j].y) + (v[j].z * v[j].z + v[j].w * v[j].w); }
        const float rstd = 1.f / sqrtf(wave_sum(s) * (1.f / D) + EPS);
#pragma unroll
        for (int j = 0; j < 4; ++j) { const int c = 4 * F.lane + 256 * j; *(f32x4*)(row + c) = (v[j] * rstd) * *(const f32x4*)(F.g_final + c); }
    }
}

typedef const Args __attribute__((address_space(4))) * KArgsP;
__device__ __forceinline__ void load_inputs(Frame& F) {
    KArgsP ap = (KArgsP)__builtin_amdgcn_kernarg_segment_ptr();
    asm volatile("" : "+s"(ap));
    F.x = ap->in[0]; F.c = ap->in[1]; F.ctx = ap->in[2]; F.c_ctx = ap->in[3]; F.w_mod = ap->in[4]; F.b_mod = ap->in[5]; F.g_norm1 = ap->in[6]; F.w_in = ap->in[7];
    F.ml_conv = ap->in[8]; F.ml_conv_b = ap->in[9]; F.b_mgate = ap->in[10]; F.ml_norm = ap->in[11]; F.gla_w2 = ap->in[12]; F.gla_b2 = ap->in[13]; F.gla_norm = ap->in[14];
    F.w_proj_m = ap->in[15]; F.w_proj_g = ap->in[16]; F.w_out = ap->in[17]; F.g_norm2 = ap->in[18]; F.w_grp = ap->in[19]; F.b_grp = ap->in[20]; F.w_rexp = ap->in[21]; F.b_rexp = ap->in[22];
    F.w_up = ap->in[23]; F.w_down = ap->in[24]; F.g_final = ap->in[25];
    F.ws = ap->ws; F.out = ap->out;
    int ln = (int)__builtin_amdgcn_mbcnt_hi(~0u, __builtin_amdgcn_mbcnt_lo(~0u, 0u)); asm volatile("" : "+v"(ln)); F.lane = ln; F.tid = F.wave * 64 + ln;
}
constexpr int N_PHASES = 14;
__global__ void __launch_bounds__(NTHR, 2) mk_fwd(Args args) {
    extern __shared__ __attribute__((aligned(16))) unsigned char lds[];
    Frame F;
    F.lds = (LAS unsigned char*)lds; F.MISC = (volatile LAS unsigned*)(F.lds + MISC_OFF);
    F.tid = threadIdx.x; F.lane = F.tid & 63; F.wave = __builtin_amdgcn_readfirstlane(F.tid >> 6); F.G = gridDim.x; F.bid = blockIdx.x;
    F.ws = args.ws; F.out = args.out;
    for (int u = F.tid; u < (LDS_BYTES - LDSCTL_OFF) / 4; u += NTHR) ((LAS unsigned*)(F.lds + LDSCTL_OFF))[u] = 0u;
    __syncthreads();
    const int lo = args.ph_lo, hi = args.ph_hi;
    XcdBarrier bar; bar.bar = (unsigned*)(F.ws + WS_CTL) + CW_BAR; bar.x = 0; bar.st = nullptr;
    if (hi - lo > 1) bar = xcd_barrier_post((unsigned*)(F.ws + WS_CTL) + CW_BAR, F.MISC + 8);
#ifndef PH_MASK
#define PH_MASK 0xFFFF
#endif
#define IN(k) (((PH_MASK >> (k)) & 1) && lo <= (k) && (k) < hi)
#define REPS(k) for (int rep_ = 0; rep_ < (((REP_MASK >> (k)) & 1) ? 2 : 1); ++rep_)
#define SEAM(k) do { if (IN(k) && IN((k) + 1)) xcd_barrier(bar, F.tid); } while (0)
    const int vc = (int)blockIdx.x;
    if (IN(0)) REPS(0) { load_inputs(F); p0_prologue(F); SEAM(0); }
    if (IN(1)) REPS(1) { load_inputs(F); p1_hx(F); p0_weight_copies<0>(F); SEAM(1); }
    if (IN(2)) REPS(2) { load_inputs(F); pg8::DenseSched S; S.init(wsp<bf16>(F, WS_HX), wsp<bf16>(F, WS_WA), MT, NA, D, F.G, vc); EpiProjA E{F.ws, F.b_mgate};
        pg8::gemm_phase<EpiProjA, pg8::DenseSched, true>(F.lds, S, E, F.wave); p0_weight_copies<1>(F, F.G == 256 ? (MT / 256) * (NA / 256) % 256 : 0); SEAM(2); }
    if (IN(3)) REPS(3) { load_inputs(F); p3_prep(F); SEAM(3); }
#if SCAN_SCALAR
    if (IN(4)) REPS(4) { load_inputs(F); p4_scan_local(F); SEAM(4); }
    if (IN(5)) REPS(5) { load_inputs(F); p5_scan_out(F); SEAM(5); }
#else
    if (IN(4)) REPS(4) { load_inputs(F); p4m_scan_local(F); SEAM(4); }
    if (IN(5)) REPS(5) { load_inputs(F); p5m_scan_out(F); SEAM(5); }
#endif
    if (IN(6)) REPS(6) { load_inputs(F); pg8::DenseSched S; S.init(wsp<bf16>(F, WS_HX), wsp<bf16>(F, WS_WB), M_LAT, NB, D, F.G, vc); EpiProjB E{F.ws, F.ml_norm, F.gla_norm};
        pg8::gemm_phase<EpiProjB, pg8::DenseSched, true>(F.lds, S, E, F.wave); SEAM(6); }
    if (IN(7)) REPS(7) { load_inputs(F);
        { pg8::DenseSched S; S.init(wsp<bf16>(F, WS_QKM), wsp<bf16>(F, WS_WPM), M_LAT, D, D, F.G, vc); EpiGate<0> E{F.ws}; pg8::gemm_phase<EpiGate<0>, pg8::DenseSched, false>(F.lds, S, E, F.wave); }
        VM_WAIT(); __syncthreads();
        { pg8::DenseSched S; S.init(wsp<bf16>(F, WS_QKG), wsp<bf16>(F, WS_WPG), M_LAT, D, D, F.G, vc); EpiGate<1> E{F.ws}; pg8::gemm_phase<EpiGate<1>, pg8::DenseSched, false>(F.lds, S, E, F.wave); }
        SEAM(7); }
    if (IN(8)) REPS(8) { load_inputs(F); pg8::DenseSched S; S.init(wsp<bf16>(F, WS_VM), wsp<bf16>(F, WS_WOUT), M_LAT, D, D, F.G, vc); EpiOut E{F.x, F.out, wsp<float>(F, WS_MODV)};
        pg8::gemm_phase<EpiOut, pg8::DenseSched, false>(F.lds, S, E, F.wave); SEAM(8); }
    if (IN(9)) REPS(9) { load_inputs(F); p9_route(F); if (IN(9) && IN(11)) xcd_barrier(bar, F.tid); }
    if (IN(11)) REPS(11) { load_inputs(F); moe_layout(F); pg8::GroupSched<true> S; S.A = wsp<bf16>(F, WS_H2); S.Bt = wsp<bf16>(F, WS_WUP); S.list_tok = wsp<int>(F, WS_LTOK); S.tab = (const LAS int*)(F.lds + LDS_TAB);
        S.K = 1024; S.ntiles = S.tab[17]; S.G = F.G; S.c = vc; EpiUp E{F.ws};
        pg8::gemm_phase<EpiUp, pg8::GroupSched<true>, true>(F.lds, S, E, F.wave); moe_weight_copies<1>(F, F.G == 256 ? (S.ntiles * 4) % 256 : 0); SEAM(11); }
    if (IN(12)) REPS(12) { load_inputs(F); moe_layout(F); pg8::GroupSched<false> S; S.A = wsp<bf16>(F, WS_HID); S.Bt = wsp<bf16>(F, WS_WDN); S.list_tok = nullptr; S.tab = (const LAS int*)(F.lds + LDS_TAB);
        S.K = 512; S.ntiles = S.tab[17]; S.G = F.G; S.c = vc; EpiDown E{F.ws, (const LAS int*)(F.lds + LDS_TAB)};
        pg8::gemm_phase<EpiDown, pg8::GroupSched<false>, true>(F.lds, S, E, F.wave); SEAM(12); }
    if (IN(13)) REPS(13) { load_inputs(F); p13_final(F); }
#undef IN
#undef SEAM
}

extern "C" void kernel_launch(void* const* d_in, const int* in_sizes, int n_in, void* d_out, int out_size, void* d_ws, size_t ws_size, hipStream_t stream) {
    static int grid = 0;
    if (grid == 0) {
        if (n_in != 26 || out_size != M_LAT * D || ws_size < WS_END) { fprintf(stderr, "kernel_launch: unexpected shapes (n_in %d, out %d, ws %zu)\n", n_in, out_size, ws_size); grid = -1; return; }
        int dev = 0, cus = 0, per_cu = 0;
        if (hipGetDevice(&dev) != hipSuccess || hipDeviceGetAttribute(&cus, hipDeviceAttributeMultiprocessorCount, dev) != hipSuccess) { grid = -1; return; }
        if (hipFuncSetAttribute((const void*)mk_fwd, hipFuncAttributeMaxDynamicSharedMemorySize, LDS_BYTES) != hipSuccess) { fprintf(stderr, "kernel_launch: hipFuncSetAttribute failed\n"); grid = -1; return; }
        if (hipOccupancyMaxActiveBlocksPerMultiprocessor(&per_cu, (const void*)mk_fwd, NTHR, LDS_BYTES) != hipSuccess || per_cu < 1) fprintf(stderr, "kernel_launch: occupancy query reports %d\n", per_cu);
        (void)hipGetLastError();
        grid = cus;
    }
    if (grid < 0) return;
    (void)hipMemsetAsync((char*)d_ws + WS_CTL, 0, CTL_ZERO_BYTES, stream);
    Args a{};
    for (int i = 0; i < 26; ++i) a.in[i] = (const float*)d_in[i];
    a.out = (float*)d_out; a.ws = (unsigned char*)d_ws;
#if MK_ONE_LAUNCH
    a.ph_lo = 0; a.ph_hi = N_PHASES;
    hipLaunchKernelGGL(mk_fwd, dim3(grid), dim3(NTHR), LDS_BYTES, stream, a);
#else
    for (int p = 0; p < N_PHASES; ++p) { a.ph_lo = p; a.ph_hi = p + 1; hipLaunchKernelGGL(mk_fwd, dim3(grid), dim3(NTHR), LDS_BYTES, stream, a); }
#endif
}
```

```cpp
#include <hip/hip_runtime.h>
#include <cstdio>
#include <cstdint>

#ifndef SCAN_SCALAR
#define SCAN_SCALAR 0
#endif
#ifndef REP_MASK
#define REP_MASK 0x0
#endif
#ifndef MK_ONE_LAUNCH
#define MK_ONE_LAUNCH 1
#endif

#define LAS __attribute__((address_space(3)))
typedef unsigned short bf16;
typedef short bf16x8 __attribute__((ext_vector_type(8)));
typedef float f32x4 __attribute__((ext_vector_type(4)));
typedef float f32x2 __attribute__((ext_vector_type(2)));
typedef unsigned u32x4 __attribute__((ext_vector_type(4)));
typedef unsigned u32x2 __attribute__((ext_vector_type(2)));

constexpr int D = 1024, BATCH = 2, SEQ = 8192, CTXL = 256;
constexpr int M_LAT = BATCH * SEQ;
constexpr int M_CTX = BATCH * CTXL;
constexpr int MT = M_LAT + M_CTX;
constexpr int NW = 8, NTHR = 512;
constexpr int IN_W = 8240;
constexpr int NA = 4352;
constexpr int NB = 4096;
constexpr int CHUNK = 64, NCH_LAT = SEQ / CHUNK  , NCH_CTX = CTXL / CHUNK  ;
constexpr int NCHUNK = BATCH * NCH_LAT + BATCH * NCH_CTX;
constexpr int NSEG = 8, CPS = NCH_LAT / NSEG;
constexpr int NEXP = 16, DEXP = 512, NROWS_MAX = 36864  ;
constexpr float EPS = 1e-6f;

constexpr size_t MiB = 1u << 20;
constexpr size_t BIG = (size_t)MT * 1024 * 2;
constexpr size_t WS_CTL = 0, CTL_ZERO_BYTES = 1 * MiB;
constexpr size_t WS_MODV = 1 * MiB;
constexpr size_t WS_AB = 2 * MiB;
constexpr size_t WS_GENDM = WS_AB + 1088 * 1024;
constexpr size_t WS_GENDG = 4 * MiB;
constexpr size_t WS_SSQ = WS_GENDG + 1088 * 1024;
constexpr size_t WS_WA = 7 * MiB;
constexpr size_t WS_WB = 16 * MiB;
constexpr size_t WS_WPM = 24 * MiB, WS_WPG = 26 * MiB, WS_WOUT = 28 * MiB;
constexpr size_t WS_GATES = 30 * MiB;
constexpr size_t WS_NST = 35 * MiB;
constexpr size_t WS_GSEG = WS_NST + 256 * 1024;
constexpr size_t WS_ROUTE = 36 * MiB;
constexpr size_t WS_HX = 37 * MiB;
constexpr size_t WS_QKM = WS_HX + BIG;
constexpr size_t WS_VM = WS_QKM + BIG;
constexpr size_t WS_QKG = WS_VM + BIG;
constexpr size_t WS_VG = WS_QKG + BIG;
constexpr size_t WS_QKMC = WS_VG + BIG;
constexpr size_t WS_STATE = WS_QKMC + BIG;
constexpr size_t WS_QKGTC = WS_STATE + 16 * MiB;
constexpr size_t WS_END = WS_QKGTC + 2 * MiB;
static_assert(WS_END <= 256 * MiB, "ws map");
constexpr size_t WS_WUP = WS_HX;
constexpr size_t WS_H2 = 70 * MiB;
constexpr size_t WS_WDN = 103 * MiB;
constexpr size_t WS_HID = 136 * MiB;
constexpr size_t WS_YROWS = 172 * MiB;
constexpr size_t RT_EXP = 0;
constexpr size_t RT_W = 128 * 1024;
constexpr size_t RT_POS = 256 * 1024;
constexpr size_t RT_ROWTOK = 384 * 1024;
constexpr size_t RT_ROWW = 384 * 1024 + 144 * 1024;
constexpr size_t RT_TILE_E = 384 * 1024 + 288 * 1024;
constexpr size_t WS_LTOK = 120 * MiB, WS_LW = 122 * MiB;
constexpr int LCAP = 32768;
constexpr int LDS_TAB = 147456 - 1024 + 768;
constexpr int CW_BAR = 4096;
constexpr int CW_CNT = 8192;

#define LDS_WAIT() asm volatile("s_waitcnt lgkmcnt(0)" ::: "memory")
#define VM_WAIT() asm volatile("s_waitcnt vmcnt(0)" ::: "memory")
__device__ __forceinline__ unsigned f2bf(float f) { unsigned u = __builtin_bit_cast(unsigned, f); return (u + 0x7fffu + ((u >> 16) & 1u)) >> 16; }
typedef __bf16 bf16x2_t __attribute__((ext_vector_type(2)));
__device__ __forceinline__ unsigned pkbf(float lo, float hi) { f32x2 v = {lo, hi}; return __builtin_bit_cast(unsigned, __builtin_convertvector(v, bf16x2_t)); }
__device__ __forceinline__ unsigned pk2(float lo, float hi) { return pkbf(lo, hi); }
__device__ __forceinline__ float bf2f(unsigned short h) { return __builtin_bit_cast(float, (unsigned)h << 16); }
__device__ __forceinline__ float bflo(unsigned w) { return __builtin_bit_cast(float, w << 16); }
__device__ __forceinline__ float bfhi(unsigned w) { return __builtin_bit_cast(float, w & 0xffff0000u); }
__device__ __forceinline__ float sigm(float x) { return __builtin_amdgcn_rcpf(1.f + __expf(-x)); }
__device__ __forceinline__ float siluf(float x) { return x * __builtin_amdgcn_rcpf(1.f + __expf(-x)); }
__device__ __forceinline__ float logsig(float x) { return fminf(x, 0.f) - log1pf(expf(-fabsf(x))); }
__device__ __forceinline__ float wave_sum(float v) {
#pragma unroll
    for (int o = 1; o < 64; o <<= 1) v += __shfl_xor(v, o);
    return v;
}

namespace pg8 {
#define PG8_LAS __attribute__((address_space(3)))
constexpr int BM = 256, BK = 64, HALF = 128, HTB = HALF * BK * 2, STAGE_BYTES = 8 * HTB, NXCD = 8, WGM = 8;
__host__ __device__ __forceinline__ int lds_byte(int r, int c) { const int st = (r >> 4) * 2 + (c >> 5), rr = r & 15, cc = c & 31, ob = rr * 64 + cc * 2; return st * 1024 + (ob ^ (((ob >> 9) & 1) << 5)); }
__host__ __device__ __forceinline__ void stage_rc(int b, int& R, int& C) { const int st = b / 1024, sb = b % 1024, swz = sb ^ (((sb >> 9) & 1) << 5); R = (st >> 1) * 16 + swz / 64; C = (st & 1) * 32 + (swz % 64) / 2; }
__host__ __device__ __forceinline__ int perm32(int rho) { const int n = rho >> 4, i = rho & 15; return 8 * (i >> 2) + 4 * n + (i & 3); }
struct Unit { int pm, pn, e; };
__device__ __forceinline__ unsigned cvt_pk_bf16(float lo, float hi) { return pkbf(lo, hi); }

struct DenseSched {
    static constexpr bool GATHER = false;
    const bf16* A; const bf16* Bt; int K, nM, nN, nwg, G, c;
    __device__ void init(const bf16* A_, const bf16* Bt_, int M, int N, int K_, int G_, int c_) { A = A_; Bt = Bt_; K = K_; nM = M / BM; nN = N / BM; nwg = nM * nN; G = G_; c = c_; }
    __device__ bool next(int i, Unit& u) const {
        const long L = (long)i * G + c; if (L >= nwg) return false;
        int wgid = (int)L; { const int q = nwg / NXCD, r = nwg % NXCD, xcd = wgid % NXCD, off = wgid / NXCD; wgid = (xcd < r ? xcd * (q + 1) : r * (q + 1) + (xcd - r) * q) + off; }
        const int nig = WGM * nN, gid = wgid / nig, fm = gid * WGM, gsz = (nM - fm) < WGM ? (nM - fm) : WGM;
        u.pm = fm + ((wgid % nig) % gsz); u.pn = (wgid % nig) / gsz; u.e = 0; return true;
    }
    __device__ __forceinline__ const char* a_base(const Unit& u) const { return (const char*)A + (size_t)u.pm * BM * K * 2; }
    __device__ __forceinline__ const char* b_base(const Unit& u) const { return (const char*)Bt + (size_t)u.pn * BM * K * 2; }
    __device__ __forceinline__ void a_offs(const Unit&, const int (&R)[2], const int (&C)[2], unsigned (&o)[2][2]) const {
#pragma unroll
        for (int h = 0; h < 2; ++h)
#pragma unroll
            for (int i = 0; i < 2; ++i) o[h][i] = (unsigned)((h * HALF + R[i]) * K + C[i]) * 2u;
    }
};
template <bool GATHER_> struct GroupSched {
    static constexpr bool GATHER = GATHER_;
    const bf16* A; const bf16* Bt; const int* list_tok; const PG8_LAS int* tab; int K, ntiles, G, c;
    __device__ bool next(int i, Unit& u) const {
        long L = (long)i * G + c;
        if (G == 256 && (long)(i + 1) * 256 <= (long)ntiles * 4) { const int xc = c & 7, j = c >> 3; L = (long)i * 256 + (long)(((xc << 3) | (j >> 2)) << 2) + (j & 3); }
        if (L >= (long)ntiles * 4) return false;
        u.pm = (int)(L >> 2); u.pn = (int)(L & 3); int e = 0; while (e < 15 && u.pm * BM >= tab[e + 1]) ++e; u.e = e; return true;
    }
    __device__ __forceinline__ const char* a_base(const Unit& u) const { return GATHER ? (const char*)A : (const char*)A + (size_t)u.pm * BM * K * 2; }
    __device__ __forceinline__ const char* b_base(const Unit& u) const { return (const char*)Bt + ((size_t)u.e * 1024 + (size_t)u.pn * BM) * K * 2; }
    __device__ __forceinline__ void a_offs(const Unit& u, const int (&R)[2], const int (&C)[2], unsigned (&o)[2][2]) const {
        const int pos0 = u.pm * BM - tab[u.e], cnt = tab[32 + u.e];
#pragma unroll
        for (int h = 0; h < 2; ++h)
#pragma unroll
            for (int i = 0; i < 2; ++i) {
                int row = h * HALF + R[i];
                if (GATHER) { const int pos = pos0 + row; const int pc = pos < cnt ? pos : 0; const int tk = list_tok[u.e * 32768 + pc]; row = pos < cnt ? tk : 0; }
                o[h][i] = (unsigned)(row * K + C[i]) * 2u; }
    }
};

template <class Epi, class Sched, bool ALIGN_EPI>
__device__ __forceinline__ void gemm_phase(PG8_LAS unsigned char* lds, const Sched& S, const Epi& E, const int wave_id) {
    int ln_ = (int)__builtin_amdgcn_mbcnt_hi(~0u, __builtin_amdgcn_mbcnt_lo(~0u, 0u)); asm volatile("" : "+v"(ln_));
    const int wid = wave_id, lane = ln_, tid = wid * 64 + lane, wr = wid >> 2, wc = wid & 3, fr = lane & 15, fq = lane >> 4;
    const int K = S.K, nt = K / BK;
    int Rr[2], Cc[2]; unsigned voffB[2];
#pragma unroll
    for (int i = 0; i < 2; ++i) { stage_rc(tid * 16 + i * 8192, Rr[i], Cc[i]); const int Rb = (Rr[i] & ~31) + perm32(Rr[i] & 31); voffB[i] = (unsigned)(Rb * K + Cc[i]) * 2u; }
    const size_t kstep = (size_t)(BK * 2);
    const size_t hstep = (size_t)HALF * K * 2;
    const unsigned ldsw = (unsigned)wid * 1024u;
    const int aoff = lds_byte(wr * 64 + fr, fq * 8), boff = lds_byte(wc * 32 + fr, fq * 8);
#define PG8_SA(b, h) (((b) * 2 + (h)) * HTB)
#define PG8_SB(b, h) ((4 + (b) * 2 + (h)) * HTB)
#define PG8_STAGE(bufoff, gbase, voff) do { _Pragma("unroll") for (int _i = 0; _i < 2; ++_i) \
        __builtin_amdgcn_global_load_lds((const unsigned*)((const char*)(gbase) + (voff)[_i]), (PG8_LAS unsigned*)(lds + (bufoff) + ldsw + _i * 8192), 16, 0, 0); } while (0)
#define PG8_LDA(dst, b, h) do { _Pragma("unroll") for (int m = 0; m < 4; ++m) _Pragma("unroll") for (int k = 0; k < 2; ++k) dst[m][k] = *(const PG8_LAS bf16x8*)(lds + PG8_SA(b, h) + aoff + m * 2048 + k * 1024); } while (0)
#define PG8_LDB(dst, b, h) do { _Pragma("unroll") for (int n = 0; n < 2; ++n) _Pragma("unroll") for (int k = 0; k < 2; ++k) dst[n][k] = *(const PG8_LAS bf16x8*)(lds + PG8_SB(b, h) + boff + n * 2048 + k * 1024); } while (0)
#define PG8_MMA(ai, bj, At, Bt) do { __builtin_amdgcn_s_setprio(1); _Pragma("unroll") for (int m = 0; m < 4; ++m) _Pragma("unroll") for (int n = 0; n < 2; ++n) _Pragma("unroll") for (int k = 0; k < 2; ++k) \
        acc[ai][bj][m][n] = __builtin_amdgcn_mfma_f32_16x16x32_bf16(Bt[n][k], At[m][k], acc[ai][bj][m][n], 0, 0, 0); __builtin_amdgcn_s_setprio(0); } while (0)
#define PG8_WAIT_V(n) asm volatile("s_waitcnt vmcnt(" #n ")" ::: "memory")
#define PG8_WAIT_L(n) asm volatile("s_waitcnt lgkmcnt(" #n ")" ::: "memory")
#define PG8_BAR __builtin_amdgcn_s_barrier()
#define PG8_SCHED __builtin_amdgcn_sched_barrier(0)
    Unit cur, nxt; int ui = 0;
    if (!S.next(0, cur)) return;
    unsigned ao[2][2], nao[2][2];
    S.a_offs(cur, Rr, Cc, ao);
    f32x4 acc[2][2][4][2];
#pragma unroll
    for (int a = 0; a < 2; ++a)
#pragma unroll
        for (int b = 0; b < 2; ++b)
#pragma unroll
            for (int m = 0; m < 4; ++m)
#pragma unroll
                for (int n = 0; n < 2; ++n) acc[a][b][m][n] = (f32x4){0.f, 0.f, 0.f, 0.f};
    bf16x8 At[4][2], B0[2][2], B1[2][2];
    const char* cA = S.a_base(cur); const char* cB = S.b_base(cur);
    PG8_STAGE(PG8_SB(0, 0), cB, voffB); PG8_STAGE(PG8_SB(0, 1), cB + hstep, voffB); PG8_STAGE(PG8_SA(0, 0), cA, ao[0]); PG8_STAGE(PG8_SA(0, 1), cA, ao[1]);
    if (wr == 1) PG8_BAR;
    PG8_WAIT_V(2); PG8_BAR;
    PG8_STAGE(PG8_SB(1, 0), cB + kstep, voffB); PG8_STAGE(PG8_SA(1, 0), cA + kstep, ao[0]); PG8_STAGE(PG8_SB(1, 1), cB + hstep + kstep, voffB);
    PG8_WAIT_V(6); PG8_BAR;
    for (;;) {
        const bool has_next = S.next(ui + 1, nxt);
        if (Sched::GATHER && has_next) S.a_offs(nxt, Rr, Cc, nao);
        else {
#pragma unroll
            for (int h = 0; h < 2; ++h)
#pragma unroll
                for (int i = 0; i < 2; ++i) nao[h][i] = ao[h][i]; }
        const char* nA = has_next ? S.a_base(nxt) : cA; const char* nB = has_next ? S.b_base(nxt) : cB;
        for (int t = 0; t < nt; t += 2) {
            const bool last = (t == nt - 2);
            const char* a1 = cA + (size_t)(t + 1) * kstep;
            const char* a2 = last ? nA : cA + (size_t)(t + 2) * kstep; const char* b2 = last ? nB : cB + (size_t)(t + 2) * kstep;
            const char* a3 = a2 + kstep; const char* b3 = b2 + kstep;
            unsigned o2[2][2];
#pragma unroll
            for (int h = 0; h < 2; ++h)
#pragma unroll
                for (int i = 0; i < 2; ++i) o2[h][i] = (Sched::GATHER && last) ? nao[h][i] : ao[h][i];
            PG8_LDB(B0, 0, 0); PG8_LDB(B1, 0, 1); PG8_SCHED; PG8_LDA(At, 0, 0); PG8_STAGE(PG8_SA(1, 1), a1, ao[1]);
            PG8_WAIT_V(8); PG8_WAIT_L(0); PG8_BAR; PG8_MMA(0, 0, At, B0); PG8_MMA(0, 1, At, B1); PG8_BAR; PG8_SCHED;
            PG8_LDA(At, 0, 1); PG8_STAGE(PG8_SB(0, 0), b2, voffB); PG8_STAGE(PG8_SB(0, 1), b2 + hstep, voffB); PG8_STAGE(PG8_SA(0, 0), a2, o2[0]);
            PG8_WAIT_V(8); PG8_WAIT_L(0); PG8_BAR; PG8_MMA(1, 0, At, B0); PG8_MMA(1, 1, At, B1); PG8_BAR; PG8_SCHED;
            PG8_LDB(B0, 1, 0); PG8_LDB(B1, 1, 1); PG8_SCHED; PG8_LDA(At, 1, 0); PG8_STAGE(PG8_SA(0, 1), a2, o2[1]);
            PG8_WAIT_V(8); PG8_WAIT_L(0); PG8_BAR; PG8_MMA(0, 0, At, B0); PG8_MMA(0, 1, At, B1); PG8_BAR; PG8_SCHED;
            PG8_LDA(At, 1, 1); PG8_STAGE(PG8_SB(1, 0), b3, voffB); PG8_STAGE(PG8_SB(1, 1), b3 + hstep, voffB); PG8_STAGE(PG8_SA(1, 0), a3, o2[0]);
            PG8_WAIT_V(8); PG8_WAIT_L(0); PG8_BAR; PG8_MMA(1, 0, At, B0); PG8_MMA(1, 1, At, B1); PG8_BAR; PG8_SCHED;
        }
        if constexpr (ALIGN_EPI) { if (wr == 0) PG8_BAR; }
        { int fr_ = fr, fq_ = fq; asm volatile("" : "+v"(fr_), "+v"(fq_));
          E(acc, cur, wr, wc, fr_, fq_); }
        if (!has_next) break;
#pragma unroll
        for (int a = 0; a < 2; ++a)
#pragma unroll
            for (int b = 0; b < 2; ++b)
#pragma unroll
                for (int m = 0; m < 4; ++m)
#pragma unroll
                    for (int n = 0; n < 2; ++n) acc[a][b][m][n] = (f32x4){0.f, 0.f, 0.f, 0.f};
        cur = nxt; cA = nA; cB = nB; ++ui;
#pragma unroll
        for (int h = 0; h < 2; ++h)
#pragma unroll
            for (int i = 0; i < 2; ++i) ao[h][i] = nao[h][i];
        if constexpr (ALIGN_EPI) { if (wr == 1) PG8_BAR; }
    }
    PG8_WAIT_V(0);
    if constexpr (!ALIGN_EPI) { if (wr == 0) PG8_BAR; }
    PG8_BAR;
#undef PG8_SA
#undef PG8_SB
#undef PG8_STAGE
#undef PG8_LDA
#undef PG8_LDB
#undef PG8_MMA
#undef PG8_WAIT_V
#undef PG8_WAIT_L
#undef PG8_BAR
#undef PG8_SCHED
}
}
using pg8::Unit; using pg8::cvt_pk_bf16;

#define XB_TMO      128
#define XB_XCNT(j)  (256  + 64 * (j))
#define XB_XSUB(j)  (1280 + 64 * (j))
#define XB_XGEN(j)  (2304 + 64 * (j))
#define XB_TOP      3328
#define XB_TOPGEN   3392
#define XCD_BAR_WORDS 3456
#define XB_SPIN_CAP (1u << 18)
__device__ __forceinline__ unsigned xb_ld(unsigned* p)              { return __hip_atomic_load(p, __ATOMIC_RELAXED, __HIP_MEMORY_SCOPE_AGENT); }
__device__ __forceinline__ unsigned xb_add(unsigned* p, unsigned v) { return __hip_atomic_fetch_add(p, v, __ATOMIC_RELAXED, __HIP_MEMORY_SCOPE_AGENT); }
__device__ __forceinline__ unsigned xb_xcc_id() { return (unsigned)__builtin_amdgcn_s_getreg((3 << 11) | 20) & 0xFu; }
#define XB_SPIN(cond, bar) do { unsigned _sp = 0; while (cond) { __builtin_amdgcn_s_sleep(1); \
    if ((++_sp & 255u) == 0u) { if (xb_ld(&(bar)[XB_TMO])) break; if (_sp > XB_SPIN_CAP) { atomicAdd(&(bar)[XB_TMO], 1u); break; } } } } while (0)
struct XcdBarrier { unsigned* bar; unsigned x; volatile LAS unsigned* st; };
__device__ __forceinline__ XcdBarrier xcd_barrier_post(unsigned* bar, volatile LAS unsigned* st) {
    XcdBarrier b; b.bar = bar; b.x = xb_xcc_id(); b.st = st;
    if (threadIdx.x == 0) (void)xb_add(&bar[XB_XCNT(b.x)], 1u);
    return b;
}
__device__ __forceinline__ void xcd_barrier_complete(unsigned* bar, unsigned x, unsigned& nloc, unsigned& nx) {
    const unsigned G = gridDim.x * gridDim.y * gridDim.z;
    unsigned sum, cnt, mine, sp = 0u;
    for (;;) {
        sum = 0u; cnt = 0u; mine = 0u;
#pragma unroll
        for (unsigned j = 0; j < 16; ++j) { const unsigned c = xb_ld(&bar[XB_XCNT(j)]); sum += c; cnt += (c > 0u) ? 1u : 0u; mine = (j == x) ? c : mine; }
        if (sum == G) break;
        __builtin_amdgcn_s_sleep(1);
        if ((++sp & 255u) == 0u) { if (xb_ld(&bar[XB_TMO])) break; if (sp > XB_SPIN_CAP) { atomicAdd(&bar[XB_TMO], 1u); break; } }
    }
    nloc = mine > 0u ? mine : 1u; nx = cnt > 0u ? cnt : 1u;
}
__device__ __forceinline__ void xcd_barrier(const XcdBarrier& b, const int tid) {
    asm volatile("s_waitcnt vmcnt(0)" ::: "memory");
    __syncthreads();
    if (tid == 0) {
        unsigned* bar = b.bar;
        __builtin_amdgcn_s_waitcnt(0);
        unsigned nloc = b.st[0], nx = b.st[1];
        if (nloc == 0u) { xcd_barrier_complete(bar, b.x, nloc, nx); b.st[0] = nloc; b.st[1] = nx; }
        const unsigned old = xb_add(&bar[XB_XSUB(b.x)], 1u);
        const unsigned gen = old / nloc;
        if (old + 1u == (gen + 1u) * nloc) {
            __builtin_amdgcn_fence(__ATOMIC_RELEASE, "agent");
            asm volatile("s_waitcnt vmcnt(0)" ::: "memory");
            const unsigned og = xb_add(&bar[XB_TOP], 1u);
            const unsigned tg = og / nx;
            if (og + 1u == (tg + 1u) * nx) xb_add(&bar[XB_TOPGEN], 1u);
            else XB_SPIN(xb_ld(&bar[XB_TOPGEN]) == tg, bar);
            __builtin_amdgcn_fence(__ATOMIC_ACQUIRE, "agent");
            xb_add(&bar[XB_XGEN(b.x)], 1u);
            asm volatile("s_waitcnt vmcnt(0)" ::: "memory");
        } else {
            XB_SPIN(xb_ld(&bar[XB_XGEN(b.x)]) == gen, bar);
            __builtin_amdgcn_fence(__ATOMIC_ACQUIRE, "agent");
            asm volatile("s_waitcnt vmcnt(0)" ::: "memory");
        }
    }
    __syncthreads();
}

constexpr int RING_BYTES = 131072;
constexpr int LDS_BYTES = 147456;
constexpr int LDSCTL_OFF = LDS_BYTES - 1024, MISC_OFF = LDSCTL_OFF + 320;

struct Args { const float* in[26]; float* out; unsigned char* ws; int ph_lo, ph_hi; };
struct Frame {
    LAS unsigned char* lds; volatile LAS unsigned* MISC;
    int tid, lane, wave, G, bid;
    unsigned char* ws; float* out;
    const float *x, *c, *ctx, *c_ctx, *w_mod, *b_mod, *g_norm1, *w_in, *ml_conv, *ml_conv_b, *b_mgate, *ml_norm, *gla_w2, *gla_b2, *gla_norm,
                *w_proj_m, *w_proj_g, *w_out, *g_norm2, *w_grp, *b_grp, *w_rexp, *b_rexp, *w_up, *w_down, *g_final;
};
template <class T> __device__ __forceinline__ T* wsp(const Frame& F, size_t off) { return (T*)(F.ws + off); }

struct TItem { const float* W; bf16* WT; int Nsrc, K, k0, n0, sc; };
__device__ __forceinline__ int map_a(int n) { return n < 2048 ? n : (n < 4096 ? n + 1040 : (n < 4112 ? 3072 + (n - 4096) : (n < 4144 ? 6160 + (n - 4112) : -1))); }
__device__ __forceinline__ int map_b(int n) { return n < 1024 ? 2048 + n : (n < 2048 ? 5136 + (n - 1024) : (n < 3072 ? 6192 + (n - 2048) : 7216 + (n - 3072))); }
__device__ __forceinline__ int map_up(int n) { const int pn = n >> 8, j = n & 255; return j < 128 ? 128 * pn + j : 512 + 128 * pn + (j - 128); }
__device__ __forceinline__ void titem_load(const TItem& t, int lane, f32x4 (&v)[8]) {
    const int scc = t.sc < 0 ? 0 : t.sc;
#pragma unroll
    for (int r = 0; r < 8; ++r) v[r] = *(const f32x4*)(t.W + (size_t)(t.k0 + 8 * r + (lane >> 3)) * t.Nsrc + scc);
}
__device__ __forceinline__ void titem_store(const TItem& t, int lane, const f32x4 (&v)[8], LAS float* scr) {
    const float z = t.sc < 0 ? 0.f : 1.f;
#pragma unroll
    for (int r = 0; r < 8; ++r) { const int kk = 8 * r + (lane >> 3); LAS float* d = scr + kk * 33 + 4 * (lane & 7); d[0] = v[r][0] * z; d[1] = v[r][1] * z; d[2] = v[r][2] * z; d[3] = v[r][3] * z; }
    LDS_WAIT(); asm volatile("" ::: "memory");
    const int c = lane & 7;
#pragma unroll
    for (int j = 0; j < 4; ++j) { const int n = (lane >> 3) + 8 * j; const LAS float* s = scr + (8 * c) * 33 + n;
        u32x4 o; o.x = pk2(s[0 * 33], s[1 * 33]); o.y = pk2(s[2 * 33], s[3 * 33]); o.z = pk2(s[4 * 33], s[5 * 33]); o.w = pk2(s[6 * 33], s[7 * 33]);
        *(u32x4*)(t.WT + (size_t)(t.n0 + n) * t.K + t.k0 + 8 * c) = o; }
    LDS_WAIT(); asm volatile("" ::: "memory");
}
template <class Dec>
__device__ __forceinline__ void run_transposes(Frame& F, int nitems, Dec dec, const int skip = 0) {
    LAS float* scr = (LAS float*)(F.lds + F.wave * 16384);
    if (F.bid < skip) return;
    const int gw = (F.bid - skip) * NW + F.wave, NGW = (F.G - skip) * NW, last = nitems - 1;
    if (gw >= nitems) return;
    f32x4 va[8], vb[8]; TItem ia, ib;
    ia = dec(gw, F.lane); titem_load(ia, F.lane, va);
    for (int it = gw; it < nitems; it += 2 * NGW) {
        { const int j = it + NGW; ib = dec(j < last ? j : last, F.lane); titem_load(ib, F.lane, vb); }
        titem_store(ia, F.lane, va, scr);
        { const int j = it + 2 * NGW; ia = dec(j < last ? j : last, F.lane); titem_load(ia, F.lane, va); }
        if (it + NGW < nitems) titem_store(ib, F.lane, vb, scr);
    }
}
__device__ __forceinline__ void p0_prologue(Frame& F) {
    LAS float* scr = (LAS float*)(F.lds + F.wave * 16384);
    const int gw = F.bid * NW + F.wave, NGW = F.G * NW;
    if (F.bid < 192) {
        LAS float* red = (LAS float*)(F.lds);
        const int r = F.tid >> 3, c4 = F.tid & 7, col0 = F.bid * 32 + 4 * c4;
        f32x4 a0 = {0.f, 0.f, 0.f, 0.f}, a1 = a0, a2 = a0;
        for (int k = r; k < D; k += 64) {
            const f32x4 w = *(const f32x4*)(F.w_mod + (size_t)k * 6144 + col0);
            const float s0 = siluf(F.c[k]), s1 = siluf(F.c[D + k]), s2 = siluf(F.c_ctx[k]);
            a0 += w * s0; a1 += w * s1; a2 += w * s2; }
#pragma unroll
        for (int j = 0; j < 4; ++j) { red[r * 96 + 0 + 4 * c4 + j] = a0[j]; red[r * 96 + 32 + 4 * c4 + j] = a1[j]; red[r * 96 + 64 + 4 * c4 + j] = a2[j]; }
        __syncthreads();
        if (F.tid < 96) { float s = 0.f; for (int q = 0; q < 64; ++q) s += red[q * 96 + F.tid]; const int rr = F.tid >> 5, j = F.bid * 32 + (F.tid & 31);
            wsp<float>(F, WS_MODV)[rr * 6144 + j] = s + F.b_mod[j]; }
        __syncthreads();
    }
}
template <int PART>
__device__ __forceinline__ void p0_weight_copies(Frame& F, const int skip = 0) {
    constexpr int I_A = (NA / 32) * 16, I_B = (NB / 32) * 16, I_P = (1024 / 32) * 16;
    const float* w_in = F.w_in; const float* wpm = F.w_proj_m; const float* wpg = F.w_proj_g; const float* wo = F.w_out; unsigned char* ws = F.ws;
    run_transposes(F, PART == 0 ? I_A : I_B + 3 * I_P, [=](int it, int lane) {
        TItem t; t.K = D; const int r = PART == 0 ? it : it + I_A;
        const bool isA = r < I_A, isB = !isA && r < I_A + I_B; const int rp = r - I_A - I_B, pi = rp < 0 ? 0 : rp / I_P;
        const int rr = isA ? r : (isB ? r - I_A : rp - pi * I_P);
        t.k0 = 64 * (rr & 15); t.n0 = 32 * (rr >> 4); const int n = t.n0 + 4 * (lane & 7);
        t.W = (isA || isB) ? w_in : (pi == 0 ? wpm : (pi == 1 ? wpg : wo)); t.Nsrc = (isA || isB) ? IN_W : D;
        t.WT = (bf16*)(ws + (isA ? WS_WA : (isB ? WS_WB : (pi == 0 ? WS_WPM : (pi == 1 ? WS_WPG : WS_WOUT)))));
        t.sc = isA ? map_a(n) : (isB ? map_b(n) : n);
        return t; }, skip);
}
template <int PART>
__device__ __forceinline__ void moe_weight_copies(Frame& F, const int skip = 0) {
    constexpr int I_U = (1024 / 32) * 16  , I_D = (1024 / 32) * 8;
    const float* wup = F.w_up; const float* wdn = F.w_down; unsigned char* ws = F.ws;
    run_transposes(F, NEXP * (PART == 0 ? I_U : I_D), [=](int it, int lane) {
        TItem t; constexpr bool up = PART == 0; const int e = it / (up ? I_U : I_D), rr = it % (up ? I_U : I_D);
        t.K = up ? 1024 : 512; t.Nsrc = 1024;
        t.k0 = up ? 64 * (rr & 15) : 64 * (rr & 7); t.n0 = up ? 32 * (rr >> 4) : 32 * (rr >> 3); const int n = t.n0 + 4 * (lane & 7);
        t.W = up ? wup + (size_t)e * 1024 * 1024 : wdn + (size_t)e * 512 * 1024;
        t.WT = up ? (bf16*)(ws + WS_WUP) + (size_t)e * 1024 * 1024 : (bf16*)(ws + WS_WDN) + (size_t)e * 1024 * 512;
        t.sc = up ? map_up(n) : n;
        return t; }, skip);
}

__device__ __forceinline__ void p1_hx(Frame& F) {
    const int gw = F.bid * NW + F.wave, NGW = F.G * NW;
    const float* modv = wsp<float>(F, WS_MODV);
    for (int m = gw; m < MT; m += 2 * NGW) {
        const int m2 = m + NGW < MT ? m + NGW : m;
        const float* src[2] = {m < M_LAT ? F.x + (size_t)m * D : F.ctx + (size_t)(m - M_LAT) * D, m2 < M_LAT ? F.x + (size_t)m2 * D : F.ctx + (size_t)(m2 - M_LAT) * D};
        const float* mv[2] = {modv + (m < M_LAT ? (m >> 13) : 2) * 6144, modv + (m2 < M_LAT ? (m2 >> 13) : 2) * 6144};
        f32x4 v[2][4]; float s[2] = {0.f, 0.f};
#pragma unroll
        for (int r = 0; r < 2; ++r)
#pragma unroll
            for (int j = 0; j < 4; ++j) v[r][j] = *(const f32x4*)(src[r] + 4 * F.lane + 256 * j);
#pragma unroll
        for (int r = 0; r < 2; ++r)
#pragma unroll
            for (int j = 0; j < 4; ++j) s[r] += (v[r][j].x * v[r][j].x + v[r][j].y * v[r][j].y) + (v[r][j].z * v[r][j].z + v[r][j].w * v[r][j].w);
#pragma unroll
        for (int r = 0; r < 2; ++r) {
            const float rstd = 1.f / sqrtf(wave_sum(s[r]) * (1.f / D) + EPS);
            bf16* o = wsp<bf16>(F, WS_HX) + (size_t)(r == 0 ? m : m2) * D;
#pragma unroll
            for (int j = 0; j < 4; ++j) { const int c = 4 * F.lane + 256 * j;
                const f32x4 g = *(const f32x4*)(F.g_norm1 + c), sh = *(const f32x4*)(mv[r] + c), sc = *(const f32x4*)(mv[r] + 1024 + c);
                const f32x4 h = (v[r][j] * rstd) * g * (sc + 1.f) + sh;
                u32x2 w; w.x = pk2(h.x, h.y); w.y = pk2(h.z, h.w); *(u32x2*)(o + c) = w; } }
    }
}

struct EpiProjA {
    unsigned char* ws; const float* b_mgate;
    __device__ __forceinline__ void operator()(const f32x4 (&acc)[2][2][4][2], const Unit& u, int wr, int wc, int fr, int fq) const {
        const int row0 = u.pm * 256 + wr * 64 + fr;
        if (u.pn < 16) {
            bf16* base = (bf16*)(ws + WS_QKM + (size_t)(u.pn >> 2) * BIG) + (u.pn & 3) * 256 + wc * 32 + 8 * fq;
#pragma unroll
            for (int ai = 0; ai < 2; ++ai)
#pragma unroll
                for (int m = 0; m < 4; ++m) { bf16* rowp = base + (size_t)(row0 + ai * 128 + m * 16) * 1024;
#pragma unroll
                    for (int bj = 0; bj < 2; ++bj) { const f32x4 v0 = acc[ai][bj][m][0], v1 = acc[ai][bj][m][1];
                        u32x4 w; w.x = cvt_pk_bf16(v0[0], v0[1]); w.y = cvt_pk_bf16(v0[2], v0[3]); w.z = cvt_pk_bf16(v1[0], v1[1]); w.w = cvt_pk_bf16(v1[2], v1[3]);
                        *(u32x4*)(rowp + bj * 128) = w; } }
        } else if (wc < 2) {
            const int col = wc * 32 + 8 * fq;
            float* g = (float*)(ws + WS_GATES);
            f32x4 b0 = {0.f, 0.f, 0.f, 0.f}, b1 = b0;
            if (col < 16) { b0 = *(const f32x4*)(b_mgate + col); b1 = *(const f32x4*)(b_mgate + col + 4); }
#pragma unroll
            for (int ai = 0; ai < 2; ++ai)
#pragma unroll
                for (int m = 0; m < 4; ++m) { float* rowp = g + (size_t)(row0 + ai * 128 + m * 16) * 64 + col;
                    *(f32x4*)rowp = acc[ai][0][m][0] + b0; *(f32x4*)(rowp + 4) = acc[ai][0][m][1] + b1; }
        }
    }
};

__device__ __forceinline__ int chunk_row0(int ci) { return ci < 256 ? (ci >> 7) * SEQ + (ci & 127) * 64 : M_LAT + ((ci - 256) >> 2) * CTXL + ((ci - 256) & 3) * 64; }
__device__ __forceinline__ bf16* qkgt_row(const Frame& F, int dir, int m) {
    return m < M_LAT ? (bf16*)F.out + ((size_t)dir * M_LAT + m) * 1024 : wsp<bf16>(F, WS_QKGTC) + ((size_t)dir * M_CTX + (m - M_LAT)) * 1024;
}
__device__ __forceinline__ float logsig_fast(float x) { return fminf(x, 0.f) - __logf(1.f + __expf(-fabsf(x))); }
__device__ __forceinline__ void unpack8(const u32x4& v, float (&f)[8]) { f[0] = bflo(v.x); f[1] = bfhi(v.x); f[2] = bflo(v.y); f[3] = bfhi(v.y); f[4] = bflo(v.z); f[5] = bfhi(v.z); f[6] = bflo(v.w); f[7] = bfhi(v.w); }
__device__ __forceinline__ void p3_prep(Frame& F) {
    const bf16* QKM = wsp<bf16>(F, WS_QKM); bf16* QKMC = wsp<bf16>(F, WS_QKMC); const float* GATES = wsp<float>(F, WS_GATES); const bf16* QKG = wsp<bf16>(F, WS_QKG);
    for (int it = F.bid; it < NCHUNK * 3; it += F.G) {
        int tidl = F.tid; asm volatile("" : "+v"(tidl));
        const int lanel = tidl & 63;
        if (it < NCHUNK) {
            const int ci = F.G == 256 ? (it < 256 ? (it & 7) * 33 + (it >> 3) : (it - 256) * 33 + 32) : it, m0 = chunk_row0(ci);
            const int cg = tidl & 127, cq = tidl >> 7, ch = 8 * cg;
            const bool lat = ci < 256; const int c = lat ? (ci & 127) : ((ci - 256) & 3);
            const bool has_up = lat && c > 0, has_dn = lat && c < 127;
            const float osc = ch >= 512 ? 0.08838834764831845f : 1.f;
            f32x4 bz0 = *(const f32x4*)(F.ml_conv_b + ch), bz1 = *(const f32x4*)(F.ml_conv_b + ch + 4);
            f32x4 cw0[9], cw1[9];
#pragma unroll
            for (int q = 0; q < 9; ++q) { cw0[q] = *(const f32x4*)(F.ml_conv + q * 1024 + ch); cw1[q] = *(const f32x4*)(F.ml_conv + q * 1024 + ch + 4); }
            const f32x4 z4 = {0.f, 0.f, 0.f, 0.f};
#pragma unroll
            for (int q = 0; q < 3; ++q) { if (!has_up) { cw0[q] = z4; cw1[q] = z4; } if (!has_dn) { cw0[6 + q] = z4; cw1[6 + q] = z4; } }
            const int collo = lat ? 0 : (c == 0 ? 0 : -1), colhi = lat ? 63 : (c == 3 ? 63 : 64);
            const bf16* rb0 = QKM + (size_t)(has_up ? m0 - 64 : m0) * 1024 + ch; const bf16* rb1 = QKM + (size_t)m0 * 1024 + ch; const bf16* rb2 = QKM + (size_t)(has_dn ? m0 + 64 : m0) * 1024 + ch;
            auto ldc = [&](int dr, int col) -> u32x4 { const int cc = min(max(col, collo), colhi); const bf16* rb = dr == 0 ? rb0 : dr == 1 ? rb1 : rb2; return *(const u32x4*)(rb + (ptrdiff_t)cc * 1024); };
            const u32x4 zu = {0u, 0u, 0u, 0u};
            int cc = cq * 16;
            u32x4 w0[3], w1[3], n0[3], n1[3];
#pragma unroll
            for (int dr = 0; dr < 3; ++dr) { const u32x4 v = ldc(dr, cc - 1); w0[dr] = cc - 1 >= collo ? v : zu; w1[dr] = ldc(dr, cc); n0[dr] = ldc(dr, cc + 1); n1[dr] = ldc(dr, cc + 2); }
#pragma unroll 1
            for (int cb = 0; cb < 8; ++cb, cc += 2) {
                u32x4 p0[3], p1[3];
#pragma unroll
                for (int dr = 0; dr < 3; ++dr) { p0[dr] = ldc(dr, cc + 3); p1[dr] = ldc(dr, cc + 4); }
                __builtin_amdgcn_sched_barrier(0);
                float acc[2][8];
#pragma unroll
                for (int oc = 0; oc < 2; ++oc) { acc[oc][0] = bz0[0]; acc[oc][1] = bz0[1]; acc[oc][2] = bz0[2]; acc[oc][3] = bz0[3]; acc[oc][4] = bz1[0]; acc[oc][5] = bz1[1]; acc[oc][6] = bz1[2]; acc[oc][7] = bz1[3]; }
#pragma unroll
                for (int dr = 0; dr < 3; ++dr)
#pragma unroll
                    for (int dc = 0; dc < 4; ++dc) { float f[8]; unpack8(dc == 0 ? w0[dr] : dc == 1 ? w1[dr] : dc == 2 ? n0[dr] : n1[dr], f);
#pragma unroll
                        for (int oc = 0; oc < 2; ++oc) { const int t = dc - oc; if (t < 0 || t > 2) continue; const f32x4 k0 = cw0[dr * 3 + t], k1 = cw1[dr * 3 + t];
                            acc[oc][0] += k0[0] * f[0]; acc[oc][1] += k0[1] * f[1]; acc[oc][2] += k0[2] * f[2]; acc[oc][3] += k0[3] * f[3]; acc[oc][4] += k1[0] * f[4]; acc[oc][5] += k1[1] * f[5]; acc[oc][6] += k1[2] * f[6]; acc[oc][7] += k1[3] * f[7]; } }
#pragma unroll
                for (int oc = 0; oc < 2; ++oc) { u32x4 o; o.x = pk2(siluf(acc[oc][0]) * osc, siluf(acc[oc][1]) * osc); o.y = pk2(siluf(acc[oc][2]) * osc, siluf(acc[oc][3]) * osc);
                    o.z = pk2(siluf(acc[oc][4]) * osc, siluf(acc[oc][5]) * osc); o.w = pk2(siluf(acc[oc][6]) * osc, siluf(acc[oc][7]) * osc);
                    *(u32x4*)(QKMC + (size_t)(m0 + cc + oc) * 1024 + ch) = o; }
                __builtin_amdgcn_sched_barrier(0);
                const bool k0 = cc + 3 <= colhi, k1 = cc + 4 <= colhi;
#pragma unroll
                for (int dr = 0; dr < 3; ++dr) { w0[dr] = n0[dr]; w1[dr] = n1[dr]; n0[dr] = k0 ? p0[dr] : zu; n1[dr] = k1 ? p1[dr] : zu; }
            }
            {
                const int dir = F.wave >> 2, h = F.wave & 3, m = m0 + lanel;
                const float ip = GATES[(size_t)m * 64 + dir * 8 + h], lf = logsig(GATES[(size_t)m * 64 + dir * 8 + 4 + h]);
                float b = lf;
#pragma unroll
                for (int o = 1; o < 64; o <<= 1) { const float t = dir == 0 ? __shfl_up(b, o) : __shfl_down(b, o); const bool ok = dir == 0 ? (lanel >= o) : (lanel + o < 64); if (ok) b += t; }
                f32x2 ab; ab.x = expf(b); ab.y = expf(ip - b);
                wsp<f32x2>(F, WS_AB)[((size_t)dir * MT + m) * 4 + h] = ab;
                if (lanel == (dir == 0 ? 63 : 0)) wsp<float>(F, WS_GENDM)[((size_t)dir * NCHUNK + ci) * 4 + h] = expf(b);
            }
        } else {
            const int gi0 = it - NCHUNK;
            const int gi = F.G == 256 ? ((((gi0 >> 4) << 3) | (gi0 & 7)) << 1) | ((gi0 >> 3) & 1) : gi0;
            const int ci = gi >> 1, dir = gi & 1, m0 = chunk_row0(ci);
            LAS float* lr = (LAS float*)F.lds;
            LAS float* Bl = (LAS float*)(F.lds + 4096);
            __syncthreads();
            for (int i = tidl; i < 1024; i += NTHR) lr[i] = GATES[(size_t)(m0 + (i >> 4)) * 64 + 16 + dir * 16 + (i & 15)];
            const int ch = tidl;
            f32x2 w2p[8];
#pragma unroll
            for (int r = 0; r < 8; ++r) { w2p[r].x = F.gla_w2[((size_t)dir * 16 + 2 * r) * 512 + ch]; w2p[r].y = F.gla_w2[((size_t)dir * 16 + 2 * r + 1) * 512 + ch]; }
            const float b2 = F.gla_b2[dir * 512 + ch];
            __syncthreads();
            float b = 0.f;
#pragma unroll 1
            for (int i0 = 0; i0 < 64; i0 += 4) {
                f32x4 l[4][4];
#pragma unroll
                for (int u = 0; u < 4; ++u) { const int r = dir == 0 ? i0 + u : 63 - i0 - u;
#pragma unroll
                    for (int q = 0; q < 4; ++q) l[u][q] = *(const LAS f32x4*)(lr + r * 16 + 4 * q); }
                float ls[4];
#pragma unroll
                for (int u = 0; u < 4; ++u) {
                    f32x2 a2 = {b2, 0.f};
#pragma unroll
                    for (int q = 0; q < 4; ++q) { a2 = __builtin_elementwise_fma((f32x2){l[u][q][0], l[u][q][1]}, w2p[2 * q], a2); a2 = __builtin_elementwise_fma((f32x2){l[u][q][2], l[u][q][3]}, w2p[2 * q + 1], a2); }
                    const float xg = a2.x + a2.y;
                    ls[u] = fminf(xg, 0.f) - 0.6931471805599453f * __builtin_amdgcn_logf(1.f + __builtin_amdgcn_exp2f(-1.4426950408889634f * fabsf(xg))); }
#pragma unroll
                for (int u = 0; u < 4; ++u) { const int r = dir == 0 ? i0 + u : 63 - i0 - u; b += ls[u] * (1.f / 16.f); Bl[r * 512 + ch] = b; }
            }
            wsp<float>(F, WS_GENDG)[((size_t)dir * NCHUNK + ci) * 512 + ch] = __expf(b);
            __syncthreads();
            u32x4 vin[16];
            const int cp = tidl & 127, r0 = tidl >> 7; const bool isk = cp >= 64;
            const float sg = isk ? -1.4426950408889634f : 1.4426950408889634f, eoff = isk ? 0.f : -3.5f;
            const bf16* irow = QKG + (size_t)(m0 + r0) * 1024 + cp * 8; bf16* orow = qkgt_row(F, dir, m0) + (size_t)r0 * 1024 + cp * 8;
            const LAS float* brow = Bl + r0 * 512 + 8 * (cp & 63);
#pragma unroll
            for (int j = 0; j < 16; ++j) vin[j] = *(const u32x4*)(irow + (size_t)j * 4096);
#pragma unroll
            for (int j = 0; j < 16; ++j) {
                const u32x4 v = vin[j];
                const f32x4 b0 = *(const LAS f32x4*)(brow + j * 2048), b1 = *(const LAS f32x4*)(brow + j * 2048 + 4);
                float f[8]; unpack8(v, f); float e[8];
#pragma unroll
                for (int q = 0; q < 4; ++q) { e[q] = __builtin_amdgcn_exp2f(__builtin_fmaf(b0[q], sg, eoff)); e[4 + q] = __builtin_amdgcn_exp2f(__builtin_fmaf(b1[q], sg, eoff)); }
                u32x4 o; o.x = pk2(f[0] * e[0], f[1] * e[1]); o.y = pk2(f[2] * e[2], f[3] * e[3]); o.z = pk2(f[4] * e[4], f[5] * e[5]); o.w = pk2(f[6] * e[6], f[7] * e[7]);
                *(u32x4*)(orow + (size_t)j * 4096) = o; }
        }
    }
}

constexpr int L_AQ = 0, L_AK = 16384, L_VP = 32768, L_P = 49152, L_S = 65536, L_N = 131072 + 1024  ;
struct ScanSrc { const bf16* q; const bf16* k; const bf16* v; const f32x2* ab; const float* gend; int gstride; };
__device__ __forceinline__ int seg_chunk(int seg, int dir, int i) {
    if (seg < 0) return dir == 0 ? i : 3 - i;
    return dir == 0 ? seg * CPS + i : (NCH_LAT - 1 - seg * CPS) - i;
}
__device__ __forceinline__ void scan_stage(Frame& F, int model, int b, int h, int dir, int half, int ci, bool need_q) {
    const int m0 = chunk_row0(ci);
    LAS float* nb = (LAS float*)(F.lds + L_N);
    if (model == 0 && F.tid < 64) { const f32x2 ab = wsp<f32x2>(F, WS_AB)[((size_t)dir * MT + m0 + F.tid) * 4 + h]; nb[256 + F.tid] = ab.y; nb[320 + F.tid] = ab.x; }
    if (F.tid >= 64 && F.tid < 192) { const int dk = F.tid - 64;
        nb[128 + dk] = model == 0 ? wsp<float>(F, WS_GENDM)[((size_t)dir * NCHUNK + ci) * 4 + h] : wsp<float>(F, WS_GENDG)[((size_t)dir * NCHUNK + ci) * 512 + h * 128 + dk]; }
#pragma unroll
    for (int i = 0; i < 2; ++i) { const int p = F.tid + i * 512, r = p >> 4, cpart = p & 15, m = m0 + r;
        const bf16* qrow; const bf16* vrow;
        if (model == 0) { qrow = wsp<bf16>(F, WS_QKMC) + (size_t)m * 1024; vrow = wsp<bf16>(F, WS_VM) + (size_t)m * 1024; }
        else { qrow = qkgt_row(F, dir, m); vrow = wsp<bf16>(F, WS_VG) + (size_t)m * 1024; }
        if (need_q) *(LAS u32x4*)(F.lds + L_AQ + r * 256 + cpart * 16) = *(const u32x4*)(qrow + h * 128 + cpart * 8);
        *(LAS u32x4*)(F.lds + L_AK + r * 256 + cpart * 16) = *(const u32x4*)(qrow + 512 + h * 128 + cpart * 8);
        u32x4 v = *(const u32x4*)(vrow + h * 256 + half * 128 + cpart * 8);
        if (model == 0) { const float be = wsp<f32x2>(F, WS_AB)[((size_t)dir * MT + m) * 4 + h].y;
            v.x = pk2(bflo(v.x) * be, bfhi(v.x) * be); v.y = pk2(bflo(v.y) * be, bfhi(v.y) * be); v.z = pk2(bflo(v.z) * be, bfhi(v.z) * be); v.w = pk2(bflo(v.w) * be, bfhi(v.w) * be); }
        *(LAS u32x4*)(F.lds + L_VP + r * 256 + cpart * 16) = v; }
}
__device__ __forceinline__ void scan_update(Frame& F, int model) {
    LAS float* S = (LAS float*)(F.lds + L_S); LAS float* nb = (LAS float*)(F.lds + L_N);
    const LAS bf16* AK = (const LAS bf16*)(F.lds + L_AK); const LAS bf16* VP = (const LAS bf16*)(F.lds + L_VP);
    const int dk = F.tid >> 2, dv0 = (F.tid & 3) * 32;
    float a[32];
#pragma unroll
    for (int j = 0; j < 32; ++j) a[j] = S[dk * 128 + dv0 + j];
    float nn = 0.f;
    for (int s = 0; s < 64; ++s) { const float k = bf2f(AK[s * 128 + dk]);
        if (model == 0) nn += k * nb[256 + s];
#pragma unroll
        for (int j = 0; j < 32; j += 2) { const unsigned v = *(const LAS unsigned*)(VP + s * 128 + dv0 + j); a[j] += k * bflo(v); a[j + 1] += k * bfhi(v); } }
    const float g = nb[128 + dk];
#pragma unroll
    for (int j = 0; j < 32; ++j) S[dk * 128 + dv0 + j] = g * a[j];
    if (model == 0 && (F.tid & 3) == 0) nb[dk] = g * (nb[dk] + nn);
}
__device__ __forceinline__ bf16* state_ptr(const Frame& F, int sc, int slot, int half) { return wsp<bf16>(F, WS_STATE) + ((size_t)(sc * 8 + slot) * 2 + half) * 16384; }

__device__ __forceinline__ void p4_scan_local(Frame& F) {
    LAS float* S = (LAS float*)(F.lds + L_S); LAS float* nb = (LAS float*)(F.lds + L_N);
    for (int it0 = F.bid; it0 < 32 * 8 * 2; it0 += F.G) {
        const int it = (F.G == 256) ? (it0 & ~255) | ((((((it0 & 255) >> 4) << 3) | (it0 & 7)) << 1) | ((it0 >> 3) & 1)) : it0;
        const int half = it & 1, slot = (it >> 1) & 7, sc = it >> 4, seg = slot - 1;
        const int dir = sc & 1, h = (sc >> 1) & 3, b = (sc >> 3) & 1, model = sc >> 4;
        for (int i = F.tid; i < 16384; i += NTHR) S[i] = 0.f;
        if (F.tid < 128) nb[F.tid] = 0.f;
        float gacc = 1.f;
        __syncthreads();
        const int nch = seg < 0 ? NCH_CTX : CPS;
        for (int i = 0; i < nch; ++i) {
            const int c = seg_chunk(seg, dir, i), ci = seg < 0 ? 256 + b * 4 + c : b * 128 + c;
            scan_stage(F, model, b, h, dir, half, ci, false);
            __syncthreads();
            if (F.tid < 128) gacc *= nb[128 + F.tid];
            scan_update(F, model);
            __syncthreads();
        }
        bf16* st = state_ptr(F, sc, slot, half);
        for (int i = F.tid; i < 8192; i += NTHR) ((unsigned*)st)[i] = pk2(S[2 * i], S[2 * i + 1]);
        if (half == 0 && F.tid < 128) { wsp<float>(F, WS_NST)[(sc * 8 + slot) * 128 + F.tid] = nb[F.tid]; wsp<float>(F, WS_GSEG)[(sc * 8 + slot) * 128 + F.tid] = gacc; }
        __syncthreads();
    }
}
__device__ __forceinline__ void p5_scan_out(Frame& F) {
    LAS float* S = (LAS float*)(F.lds + L_S); LAS float* nb = (LAS float*)(F.lds + L_N); LAS float* P = (LAS float*)(F.lds + L_P);
    const LAS bf16* AQ = (const LAS bf16*)(F.lds + L_AQ); const LAS bf16* AK = (const LAS bf16*)(F.lds + L_AK); const LAS bf16* VP = (const LAS bf16*)(F.lds + L_VP);
    for (int it0 = F.bid; it0 < 2 * 2 * 4 * 8 * 2; it0 += F.G) {
        const int it = (F.G == 256) ? ((((it0 >> 4) << 3) | (it0 & 7)) << 1) | ((it0 >> 3) & 1) : it0;
        const int half = it & 1, seg = (it >> 1) & 7, h = (it >> 4) & 3, b = (it >> 6) & 1, model = it >> 7;
        bf16* HS = wsp<bf16>(F, model == 0 ? WS_QKM : WS_QKG);
        for (int dir = 0; dir < 2; ++dir) {
            const int sc = ((model * 2 + b) * 4 + h) * 2 + dir, s = dir == 0 ? seg : 7 - seg;
            { const int dk = F.tid >> 2, dv0 = (F.tid & 3) * 32; float a[32]; float nn = 0.f;
#pragma unroll
              for (int j = 0; j < 32; ++j) a[j] = 0.f;
              for (int slot = 0; slot <= s; ++slot) {
                  const float g = slot == 0 ? 0.f : wsp<float>(F, WS_GSEG)[(sc * 8 + slot) * 128 + dk];
                  const bf16* st = state_ptr(F, sc, slot, half) + dk * 128 + dv0;
#pragma unroll
                  for (int j = 0; j < 32; j += 2) { const unsigned v = *(const unsigned*)(st + j); a[j] = g * a[j] + bflo(v); a[j + 1] = g * a[j + 1] + bfhi(v); }
                  nn = g * nn + wsp<float>(F, WS_NST)[(sc * 8 + slot) * 128 + dk]; }
#pragma unroll
              for (int j = 0; j < 32; ++j) S[dk * 128 + dv0 + j] = a[j];
              if ((F.tid & 3) == 0) nb[dk] = nn; }
            __syncthreads();
            for (int i = 0; i < CPS; ++i) {
                const int c = seg_chunk(s, dir, i), ci = b * 128 + c, m0 = chunk_row0(ci);
                scan_stage(F, model, b, h, dir, half, ci, true);
                __syncthreads();
                for (int e = F.tid; e < 4096; e += NTHR) { const int t = e >> 6, s2 = e & 63; float p = 0.f;
                    if (dir == 0 ? (s2 <= t) : (s2 >= t)) {
                        for (int d8 = 0; d8 < 16; ++d8) { const u32x4 qa = *(const LAS u32x4*)(AQ + t * 128 + d8 * 8), ka = *(const LAS u32x4*)(AK + s2 * 128 + d8 * 8);
                            p += bflo(qa.x) * bflo(ka.x) + bfhi(qa.x) * bfhi(ka.x) + bflo(qa.y) * bflo(ka.y) + bfhi(qa.y) * bfhi(ka.y)
                               + bflo(qa.z) * bflo(ka.z) + bfhi(qa.z) * bfhi(ka.z) + bflo(qa.w) * bflo(ka.w) + bfhi(qa.w) * bfhi(ka.w); } }
                    P[e] = bf2f((unsigned short)f2bf(p)); }
                __syncthreads();
                { const int t = F.tid >> 3, dv0 = (F.tid & 7) * 16; float o[16];
#pragma unroll
                  for (int j = 0; j < 16; ++j) o[j] = 0.f;
                  float den = 0.f;
                  for (int s2 = 0; s2 < 64; ++s2) { const float p = P[t * 64 + s2];
                      if (model == 0) den += p * nb[256 + s2];
                      const u32x4 v0 = *(const LAS u32x4*)(VP + s2 * 128 + dv0), v1 = *(const LAS u32x4*)(VP + s2 * 128 + dv0 + 8);
                      o[0] += p * bflo(v0.x); o[1] += p * bfhi(v0.x); o[2] += p * bflo(v0.y); o[3] += p * bfhi(v0.y); o[4] += p * bflo(v0.z); o[5] += p * bfhi(v0.z); o[6] += p * bflo(v0.w); o[7] += p * bfhi(v0.w);
                      o[8] += p * bflo(v1.x); o[9] += p * bfhi(v1.x); o[10] += p * bflo(v1.y); o[11] += p * bfhi(v1.y); o[12] += p * bflo(v1.z); o[13] += p * bfhi(v1.z); o[14] += p * bflo(v1.w); o[15] += p * bfhi(v1.w); }
                  for (int dk = 0; dk < 128; ++dk) { const float q = bf2f(AQ[t * 128 + dk]);
                      if (model == 0) den += q * nb[dk];
                      const LAS float* sr = S + dk * 128 + dv0;
#pragma unroll
                      for (int j = 0; j < 16; ++j) o[j] += q * bf2f((unsigned short)f2bf(sr[j])); }
                  float rs = 1.f;
                  if (model == 0) { const float al = nb[320 + t]; rs = al / fmaxf(al * fabsf(den), 1.f); }
                  bf16* dst = HS + (size_t)(m0 + t) * 1024 + h * 256 + half * 128 + dv0;
                  float ssq = 0.f;
                  if (dir == 0) {
                      u32x4 w0, w1; w0.x = pk2(o[0] * rs, o[1] * rs); w0.y = pk2(o[2] * rs, o[3] * rs); w0.z = pk2(o[4] * rs, o[5] * rs); w0.w = pk2(o[6] * rs, o[7] * rs);
                      w1.x = pk2(o[8] * rs, o[9] * rs); w1.y = pk2(o[10] * rs, o[11] * rs); w1.z = pk2(o[12] * rs, o[13] * rs); w1.w = pk2(o[14] * rs, o[15] * rs);
                      *(u32x4*)dst = w0; *(u32x4*)(dst + 8) = w1;
                  } else {
                      const u32x4 p0 = *(const u32x4*)dst, p1 = *(const u32x4*)(dst + 8);
                      const float f[16] = {bflo(p0.x), bfhi(p0.x), bflo(p0.y), bfhi(p0.y), bflo(p0.z), bfhi(p0.z), bflo(p0.w), bfhi(p0.w), bflo(p1.x), bfhi(p1.x), bflo(p1.y), bfhi(p1.y), bflo(p1.z), bfhi(p1.z), bflo(p1.w), bfhi(p1.w)};
                      float r[16];
#pragma unroll
                      for (int j = 0; j < 16; ++j) { r[j] = f[j] + o[j] * rs; ssq += r[j] * r[j]; }
                      u32x4 w0, w1; w0.x = pk2(r[0], r[1]); w0.y = pk2(r[2], r[3]); w0.z = pk2(r[4], r[5]); w0.w = pk2(r[6], r[7]);
                      w1.x = pk2(r[8], r[9]); w1.y = pk2(r[10], r[11]); w1.z = pk2(r[12], r[13]); w1.w = pk2(r[14], r[15]);
                      *(u32x4*)dst = w0; *(u32x4*)(dst + 8) = w1;
                      ssq += __shfl_xor(ssq, 1); ssq += __shfl_xor(ssq, 2); ssq += __shfl_xor(ssq, 4);
                      if ((F.tid & 7) == 0) wsp<float>(F, WS_SSQ)[((size_t)(m0 + t) * 8 + model * 4 + h) * 2 + half] = ssq;
                  } }
                __syncthreads();
                scan_update(F, model);
                __syncthreads();
            }
        }
    }
}

typedef short s16x4 __attribute__((ext_vector_type(4)));
__device__ __forceinline__ unsigned offb(int row, int ch) { return 256u * (unsigned)row + 16u * (unsigned)(ch ^ (((row & 3) << 2) | ((row >> 2) & 3))); }
constexpr int M_AQ = 0, M_AK = 16384, M_VP = 32768, M_P = 49152, M_O = 57344, O_LD = 132;
template <int TILE>
__device__ __forceinline__ void tr_frag2(unsigned x0, unsigned x1, bf16x8& f0, bf16x8& f1) {
    s16x4 r0, r1, r2, r3;
    asm volatile("ds_read_b64_tr_b16 %0, %4 offset:%6\n\tds_read_b64_tr_b16 %1, %5 offset:%6\n\tds_read_b64_tr_b16 %2, %4 offset:%7\n\tds_read_b64_tr_b16 %3, %5 offset:%7\n\ts_waitcnt lgkmcnt(0)"
                 : "=&v"(r0), "=&v"(r1), "=&v"(r2), "=&v"(r3) : "v"(x0), "v"(x1), "i"(TILE), "i"(TILE + 8192) : "memory");
    f0 = __builtin_shufflevector(r0, r1, 0, 1, 2, 3, 4, 5, 6, 7); f1 = __builtin_shufflevector(r2, r3, 0, 1, 2, 3, 4, 5, 6, 7);
}
template <int TILE>
__device__ __forceinline__ void tr_frag8(unsigned a0, unsigned a1, unsigned b0, unsigned b1, unsigned c0, unsigned c1, unsigned d0, unsigned d1, bf16x8 (&f)[8]) {
    s16x4 r[16];
    asm volatile("ds_read_b64_tr_b16 %0, %16 offset:%24\n\tds_read_b64_tr_b16 %1, %17 offset:%24\n\tds_read_b64_tr_b16 %2, %16 offset:%25\n\tds_read_b64_tr_b16 %3, %17 offset:%25\n\t"
                 "ds_read_b64_tr_b16 %4, %18 offset:%24\n\tds_read_b64_tr_b16 %5, %19 offset:%24\n\tds_read_b64_tr_b16 %6, %18 offset:%25\n\tds_read_b64_tr_b16 %7, %19 offset:%25\n\t"
                 "ds_read_b64_tr_b16 %8, %20 offset:%24\n\tds_read_b64_tr_b16 %9, %21 offset:%24\n\tds_read_b64_tr_b16 %10, %20 offset:%25\n\tds_read_b64_tr_b16 %11, %21 offset:%25\n\t"
                 "ds_read_b64_tr_b16 %12, %22 offset:%24\n\tds_read_b64_tr_b16 %13, %23 offset:%24\n\tds_read_b64_tr_b16 %14, %22 offset:%25\n\tds_read_b64_tr_b16 %15, %23 offset:%25\n\ts_waitcnt lgkmcnt(0)"
                 : "=&v"(r[0]), "=&v"(r[1]), "=&v"(r[2]), "=&v"(r[3]), "=&v"(r[4]), "=&v"(r[5]), "=&v"(r[6]), "=&v"(r[7]), "=&v"(r[8]), "=&v"(r[9]), "=&v"(r[10]), "=&v"(r[11]), "=&v"(r[12]), "=&v"(r[13]), "=&v"(r[14]), "=&v"(r[15])
                 : "v"(a0), "v"(a1), "v"(b0), "v"(b1), "v"(c0), "v"(c1), "v"(d0), "v"(d1), "i"(TILE), "i"(TILE + 8192) : "memory");
#pragma unroll
    for (int j = 0; j < 8; ++j) f[j] = __builtin_shufflevector(r[2 * j], r[2 * j + 1], 0, 1, 2, 3, 4, 5, 6, 7);
}
template <int TILE>
__device__ __forceinline__ void tr_frag4(unsigned x0, unsigned x1, unsigned y0, unsigned y1, bf16x8& f0, bf16x8& f1, bf16x8& f2, bf16x8& f3) {
    s16x4 r0, r1, r2, r3, r4, r5, r6, r7;
    asm volatile("ds_read_b64_tr_b16 %0, %8 offset:%12\n\tds_read_b64_tr_b16 %1, %9 offset:%12\n\tds_read_b64_tr_b16 %2, %8 offset:%13\n\tds_read_b64_tr_b16 %3, %9 offset:%13\n\t"
                 "ds_read_b64_tr_b16 %4, %10 offset:%12\n\tds_read_b64_tr_b16 %5, %11 offset:%12\n\tds_read_b64_tr_b16 %6, %10 offset:%13\n\tds_read_b64_tr_b16 %7, %11 offset:%13\n\ts_waitcnt lgkmcnt(0)"
                 : "=&v"(r0), "=&v"(r1), "=&v"(r2), "=&v"(r3), "=&v"(r4), "=&v"(r5), "=&v"(r6), "=&v"(r7) : "v"(x0), "v"(x1), "v"(y0), "v"(y1), "i"(TILE), "i"(TILE + 8192) : "memory");
    f0 = __builtin_shufflevector(r0, r1, 0, 1, 2, 3, 4, 5, 6, 7); f1 = __builtin_shufflevector(r2, r3, 0, 1, 2, 3, 4, 5, 6, 7);
    f2 = __builtin_shufflevector(r4, r5, 0, 1, 2, 3, 4, 5, 6, 7); f3 = __builtin_shufflevector(r6, r7, 0, 1, 2, 3, 4, 5, 6, 7);
}
#define MFMA16(a, b, c) __builtin_amdgcn_mfma_f32_16x16x32_bf16((a), (b), (c), 0, 0, 0)
__device__ __forceinline__ bf16* mstate_ptr(const Frame& F, int sc, int slot, int half) { return wsp<bf16>(F, WS_STATE) + ((size_t)(sc * 8 + slot) * 2 + half) * 16384; }

#define LBAR() asm volatile("s_waitcnt lgkmcnt(0)\n\ts_barrier" ::: "memory")
template <bool OUT>
__device__ __forceinline__ void mscan_run(Frame& F, int model, int b, int h, int dir, int half, int seg, f32x4 (&S)[2][8], float& gacc) {
    LAS unsigned char* lds = F.lds; LAS float* nb = (LAS float*)(F.lds + L_N);
    LAS unsigned short* nbh = (LAS unsigned short*)(F.lds + L_N + 2048);
    const unsigned lb = (unsigned)(uintptr_t)F.lds;
    const int w = F.wave, lane = F.lane, li = lane & 15, lg = lane >> 4, tq = li >> 2, tp = lane & 3;
    const bool st = w < 4; const int sw = w & 3;
    const int nch = seg < 0 ? NCH_CTX : CPS;
    bf16* HS = wsp<bf16>(F, model == 0 ? WS_QKM : WS_QKG);
    const int mli = ((li & 3) << 2) | ((li >> 2) & 3);
    const unsigned rowb = 256u * li + 16u * (lg ^ mli);
    const unsigned o2b = 256u * li + 16u * ((lg >> 1) ^ mli) + 8u * (lg & 1);
    const unsigned trb0 = 256u * (8 * lg + tq) + 16u * ((tp >> 1) ^ ((tq << 2) | ((2 * lg) & 3))) + 8u * (tp & 1);
    const unsigned trb1 = 256u * (8 * lg + 4 + tq) + 16u * ((tp >> 1) ^ ((tq << 2) | ((2 * lg + 1) & 3))) + 8u * (tp & 1);
    const unsigned pra0 = lb + M_P + (128u * li + 16u * (lg ^ (li & 7))), pra1 = lb + M_P + ((128u * li + 16u * (lg ^ (li & 7))) ^ 64u);
    const unsigned poff0 = (unsigned)((F.tid >> 4) * 1024 + (F.tid & 15) * 8) * 2u, poff1 = poff0 + 32u * 2048u;
    auto final_pass = [&](const int m0, const u32x4 (&prevh)[2]) {
        LAS float* Ol = (LAS float*)(F.lds + M_O);
#pragma unroll
        for (int i = 0; i < 2; ++i) { const int p = F.tid + i * 512, t = p >> 4, c8 = p & 15;
            const f32x4 o0 = *(const LAS f32x4*)(Ol + t * O_LD + 8 * c8), o1 = *(const LAS f32x4*)(Ol + t * O_LD + 8 * c8 + 4);
            float rs = 1.f;
            if (model == 0) rs = nb[384 + t];
            bf16* dst = (bf16*)((unsigned char*)(HS + (size_t)m0 * 1024 + h * 256 + half * 128) + (i == 0 ? poff0 : poff1));
            float r[8] = {o0[0] * rs, o0[1] * rs, o0[2] * rs, o0[3] * rs, o1[0] * rs, o1[1] * rs, o1[2] * rs, o1[3] * rs};
            if (dir == 1) { const u32x4 pv = prevh[i];
                r[0] += bflo(pv.x); r[1] += bfhi(pv.x); r[2] += bflo(pv.y); r[3] += bfhi(pv.y); r[4] += bflo(pv.z); r[5] += bfhi(pv.z); r[6] += bflo(pv.w); r[7] += bfhi(pv.w);
                float ssq = (r[0] * r[0] + r[1] * r[1]) + (r[2] * r[2] + r[3] * r[3]) + (r[4] * r[4] + r[5] * r[5]) + (r[6] * r[6] + r[7] * r[7]);
                ssq += __shfl_xor(ssq, 1); ssq += __shfl_xor(ssq, 2); ssq += __shfl_xor(ssq, 4); ssq += __shfl_xor(ssq, 8);
                if (c8 == 0) wsp<float>(F, WS_SSQ)[((size_t)(m0 + t) * 8 + model * 4 + h) * 2 + half] = ssq; }
            u32x4 wv; wv.x = pkbf(r[0], r[1]); wv.y = pkbf(r[2], r[3]); wv.z = pkbf(r[4], r[5]); wv.w = pkbf(r[6], r[7]);
            *(u32x4*)dst = wv; }
    };
    const unsigned pwb = 128u * li + 8u * (lg & 1) + 16u * ((lg >> 1) ^ (li & 7));
    auto ptile = [&](const int ti, const int sh) {
        const bool used = dir == 0 ? !(sh == 1 && ti < 2) : !(sh == 0 && ti >= 2);
        if (!used) return;
        unsigned rowl = rowb; asm volatile("" : "+v"(rowl));
        bf16x8 pa[4], pb0[4], pb1[4];
#pragma unroll
        for (int kk = 0; kk < 4; ++kk) { const unsigned ra = lb + (rowl ^ ((unsigned)kk << 6)); pa[kk] = *(const LAS bf16x8*)(uintptr_t)(ra + M_AQ + 4096u * ti); pb0[kk] = *(const LAS bf16x8*)(uintptr_t)(ra + M_AK + 8192u * sh); pb1[kk] = *(const LAS bf16x8*)(uintptr_t)(ra + M_AK + 8192u * sh + 4096u); }
        f32x4 acc0 = {0.f, 0.f, 0.f, 0.f}, acc1 = acc0;
#pragma unroll
        for (int kk = 0; kk < 4; ++kk) { acc0 = MFMA16(pb0[kk], pa[kk], acc0); acc1 = MFMA16(pb1[kk], pa[kk], acc1); }
        const int t = 16 * ti + li;
#pragma unroll
        for (int sj = 0; sj < 2; ++sj) { const f32x4 acc = sj == 0 ? acc0 : acc1; const int s0 = 16 * (2 * sh + sj) + 4 * lg; float pv[4];
#pragma unroll
            for (int r = 0; r < 4; ++r) { const bool keep = dir == 0 ? (s0 + r <= t) : (s0 + r >= t); pv[r] = keep ? acc[r] : 0.f; }
            u32x2 pw; pw.x = pkbf(pv[0], pv[1]); pw.y = pkbf(pv[2], pv[3]);
            *(LAS u32x2*)(uintptr_t)(lb + M_P + 2048u * ti + (pwb ^ ((unsigned)(4 * sh + 2 * sj) << 4))) = pw; }
    };
    auto chunk_m0 = [&](const int ic) { const int c = seg_chunk(seg, dir, ic), ci = seg < 0 ? 256 + b * 4 + c : b * 128 + c; return chunk_row0(ci); };
    if (st) {
        const unsigned ola = lb + M_O + 4u * ((4 * lg) * O_LD + 32 * sw + li);
        for (int ic = 0; ic < nch; ++ic) {
            const int m0 = chunk_m0(ic);
            LBAR();
            if (F.tid < 128) gacc *= nb[128 + F.tid];
            unsigned o2l = o2b, tr0l = trb0, tr1l = trb1; asm volatile("" : "+v"(o2l), "+v"(tr0l), "+v"(tr1l));
            bf16x8 VB[2][2];
            tr_frag4<M_VP>(lb + (tr0l ^ ((unsigned)(2 * sw) << 5)), lb + (tr1l ^ ((unsigned)(2 * sw) << 5)), lb + (tr0l ^ ((unsigned)(2 * sw + 1) << 5)), lb + (tr1l ^ ((unsigned)(2 * sw + 1) << 5)), VB[0][0], VB[0][1], VB[1][0], VB[1][1]);
            u32x4 prevh[2] = {{0u, 0u, 0u, 0u}, {0u, 0u, 0u, 0u}};
            if (OUT) {
#pragma unroll
                for (int i = 0; i < 2; ++i) prevh[i] = *(const u32x4*)((const unsigned char*)(HS + (size_t)m0 * 1024 + h * 256 + half * 128) + (i == 0 ? poff0 : poff1) * (unsigned)dir);
                ptile(sw, 1);
                f32x4 O[2][4];
#pragma unroll
                for (int j = 0; j < 2; ++j)
#pragma unroll
                    for (int q = 0; q < 4; ++q) O[j][q] = (f32x4){0.f, 0.f, 0.f, 0.f};
#pragma unroll
                for (int kh = 0; kh < 2; ++kh) {
                    u32x2 alo[2][4], ahi[2][4];
#pragma unroll
                    for (int k2 = 0; k2 < 2; ++k2)
#pragma unroll
                        for (int q = 0; q < 4; ++q) { alo[k2][q] = *(const LAS u32x2*)(uintptr_t)((o2l ^ ((unsigned)(4 * (2 * kh + k2)) << 4)) + lb + M_AQ + 4096u * q); ahi[k2][q] = *(const LAS u32x2*)(uintptr_t)((o2l ^ ((unsigned)(4 * (2 * kh + k2) + 2) << 4)) + lb + M_AQ + 4096u * q); }
#pragma unroll
                    for (int k2 = 0; k2 < 2; ++k2) { const int kk = 2 * kh + k2; bf16x8 Bk[2];
#pragma unroll
                        for (int j = 0; j < 2; ++j) { u32x4 bw; bw.x = pkbf(S[j][2 * kk][0], S[j][2 * kk][1]); bw.y = pkbf(S[j][2 * kk][2], S[j][2 * kk][3]); bw.z = pkbf(S[j][2 * kk + 1][0], S[j][2 * kk + 1][1]); bw.w = pkbf(S[j][2 * kk + 1][2], S[j][2 * kk + 1][3]); Bk[j] = __builtin_bit_cast(bf16x8, bw); }
#pragma unroll
                        for (int q = 0; q < 4; ++q) { u32x4 aw; aw.x = alo[k2][q].x; aw.y = alo[k2][q].y; aw.z = ahi[k2][q].x; aw.w = ahi[k2][q].y; const bf16x8 Af = __builtin_bit_cast(bf16x8, aw);
                            O[0][q] = MFMA16(Af, Bk[0], O[0][q]); O[1][q] = MFMA16(Af, Bk[1], O[1][q]); } }
                    asm volatile("" ::: "memory");
                }
                LBAR();
                bf16x8 p0[4], p1[4];
#pragma unroll
                for (int q = 0; q < 4; ++q) { p0[q] = *(const LAS bf16x8*)(uintptr_t)(pra0 + 2048u * q); p1[q] = *(const LAS bf16x8*)(uintptr_t)(pra1 + 2048u * q); }
#pragma unroll
                for (int q = 0; q < 4; ++q) {
                    if (dir == 0 || q < 2) { O[0][q] = MFMA16(p0[q], VB[0][0], O[0][q]); O[1][q] = MFMA16(p0[q], VB[1][0], O[1][q]); }
                    if (dir == 1 || q >= 2) { O[0][q] = MFMA16(p1[q], VB[0][1], O[0][q]); O[1][q] = MFMA16(p1[q], VB[1][1], O[1][q]); } }
#pragma unroll
                for (int j = 0; j < 2; ++j)
#pragma unroll
                    for (int q = 0; q < 4; ++q)
#pragma unroll
                        for (int r = 0; r < 4; ++r) *(LAS float*)(uintptr_t)(ola + 64u * j + 4u * (unsigned)((16 * q + r) * O_LD)) = O[j][q][r];
            }
#pragma unroll
            for (int kp = 0; kp < 4; ++kp) { bf16x8 A0, A1, A2, A3; const int kt = 2 * kp;
                const f32x4 g0 = *(const LAS f32x4*)(nb + 128 + 16 * kt + 4 * lg), g1 = *(const LAS f32x4*)(nb + 128 + 16 * (kt + 1) + 4 * lg);
                tr_frag4<M_AK>(lb + (tr0l ^ ((unsigned)kt << 5)), lb + (tr1l ^ ((unsigned)kt << 5)), lb + (tr0l ^ ((unsigned)(kt + 1) << 5)), lb + (tr1l ^ ((unsigned)(kt + 1) << 5)), A0, A1, A2, A3);
#pragma unroll
                for (int j = 0; j < 2; ++j) { S[j][kt] = MFMA16(A0, VB[j][0], S[j][kt]); S[j][kt + 1] = MFMA16(A2, VB[j][0], S[j][kt + 1]); }
#pragma unroll
                for (int j = 0; j < 2; ++j) { S[j][kt] = MFMA16(A1, VB[j][1], S[j][kt]); S[j][kt + 1] = MFMA16(A3, VB[j][1], S[j][kt + 1]); }
#pragma unroll
                for (int j = 0; j < 2; ++j) { S[j][kt] = S[j][kt] * g0; S[j][kt + 1] = S[j][kt + 1] * g1; } }
            LBAR();
            if (OUT) final_pass(m0, prevh);
        }
    } else {
        const int ht = F.tid - 256;
        const unsigned hoff = (unsigned)((ht >> 4) * 1024 + (ht & 15) * 8) * 2u;
        const unsigned aoff = (unsigned)(ht >> 4) * 32u + 4u, aoffl = (unsigned)(ht & 63) * 32u;
        const f32x2* ABd = wsp<f32x2>(F, WS_AB) + (size_t)dir * MT * 4 + h;
        const bf16* vbase = wsp<bf16>(F, model == 0 ? WS_VM : WS_VG) + h * 256 + half * 128;
        struct SR { u32x4 q[4], k[4], v[4]; float be[4]; f32x2 ab; float ge; };
        SR R;
        auto issue = [&](const int ic_) {
            const int c_ = seg_chunk(seg, dir, ic_), ci_ = seg < 0 ? 256 + b * 4 + c_ : b * 128 + c_, m0_ = chunk_row0(ci_);
            const unsigned char* abr = (const unsigned char*)(ABd + (size_t)m0_ * 4);
            { const float* abp = (const float*)(abr + aoffl); R.ab.x = abp[0]; R.ab.y = abp[1]; }
            const float* gp = model == 0 ? wsp<float>(F, WS_GENDM) + ((size_t)dir * NCHUNK + ci_) * 4 + h : wsp<float>(F, WS_GENDG) + ((size_t)dir * NCHUNK + ci_) * 512 + h * 128 + ((ht - 64) & 127);
            R.ge = *gp;
            const long long qoff = model == 0 ? (long long)WS_QKMC : (m0_ < M_LAT ? 0ll : (long long)WS_QKGTC + ((long long)dir * M_CTX - M_LAT) * 2048);
            const unsigned char* qbb = (model == 1 && m0_ < M_LAT) ? (const unsigned char*)F.out + (size_t)dir * M_LAT * 2048 : (const unsigned char*)F.ws + qoff;
            const unsigned char* qr = qbb + (size_t)m0_ * 2048 + h * 256;
            const unsigned char* vr = (const unsigned char*)(vbase + (size_t)m0_ * 1024);
#pragma unroll
            for (int i = 0; i < 4; ++i) { const unsigned o = hoff + (unsigned)i * 16u * 2048u;
                if (OUT) R.q[i] = *(const u32x4*)(qr + o);
                R.k[i] = *(const u32x4*)(qr + 1024 + o); R.v[i] = *(const u32x4*)(vr + o); R.be[i] = *(const float*)(abr + aoff + (unsigned)i * 16u * 32u); }
        };
        const int ti = sw;
        const unsigned fra = lb + L_N + 2048 + (li == 1 ? 128u : 0u) + 16u * lg;
        const unsigned nfa = lb + L_N + 2048 + 256 + (li == 1 ? 256u : 0u) + 16u * lg;
        issue(0);
        for (int ic = 0; ic < nch; ++ic) {
            const int m0 = chunk_m0(ic);
            if (model == 0 && ht < 64) { const float be = R.ab.y; nb[320 + ht] = R.ab.x;
                const unsigned hi = pkbf(be, be) & 0xffffu; nbh[ht] = (unsigned short)hi; nbh[64 + ht] = (unsigned short)(pkbf(be - bflo(hi), 0.f) & 0xffffu); }
            if (ht >= 64 && ht < 192) nb[128 + ht - 64] = R.ge;
#pragma unroll
            for (int i = 0; i < 4; ++i) { const int p = ht + i * 256, r = p >> 4, cp = p & 15;
                const unsigned o = offb(r, cp);
                if (OUT) *(LAS u32x4*)(lds + M_AQ + o) = R.q[i];
                *(LAS u32x4*)(lds + M_AK + o) = R.k[i];
                u32x4 v = R.v[i];
                if (model == 0) { const float be = R.be[i];
                    v.x = pkbf(bflo(v.x) * be, bfhi(v.x) * be); v.y = pkbf(bflo(v.y) * be, bfhi(v.y) * be); v.z = pkbf(bflo(v.z) * be, bfhi(v.z) * be); v.w = pkbf(bflo(v.w) * be, bfhi(v.w) * be); }
                *(LAS u32x4*)(lds + M_VP + o) = v; }
            LBAR();
            u32x4 prevh[2] = {{0u, 0u, 0u, 0u}, {0u, 0u, 0u, 0u}};
            if (OUT) {
#pragma unroll
                for (int i = 0; i < 2; ++i) prevh[i] = *(const u32x4*)((const unsigned char*)(HS + (size_t)m0 * 1024 + h * 256 + half * 128) + (i == 0 ? poff0 : poff1) * (unsigned)dir);
                ptile(ti, 0);
            }
            if (ic + 1 < nch) issue(ic + 1);
            unsigned rowl = rowb, tr0l = trb0, tr1l = trb1; asm volatile("" : "+v"(rowl), "+v"(tr0l), "+v"(tr1l));
            bf16x8 BB0, BB1;
            { u32x4 z = {0u, 0u, 0u, 0u}; BB0 = __builtin_bit_cast(bf16x8, z); BB1 = BB0; }
            if (model == 0) { u32x4 f0 = *(const LAS u32x4*)(uintptr_t)fra, f1 = *(const LAS u32x4*)(uintptr_t)(fra + 64u); const u32x4 z = {0u, 0u, 0u, 0u};
                if (li > 1) { f0 = z; f1 = z; } BB0 = __builtin_bit_cast(bf16x8, f0); BB1 = __builtin_bit_cast(bf16x8, f1); }
            f32x4 dq = {0.f, 0.f, 0.f, 0.f};
            if (OUT && model == 0) {
                bf16x8 pa[4]; u32x4 nf[4]; const u32x4 z = {0u, 0u, 0u, 0u};
#pragma unroll
                for (int kk = 0; kk < 4; ++kk) { pa[kk] = *(const LAS bf16x8*)(uintptr_t)(lb + (rowl ^ ((unsigned)kk << 6)) + M_AQ + 4096u * ti); nf[kk] = *(const LAS u32x4*)(uintptr_t)(nfa + 64u * kk); if (li > 1) nf[kk] = z; }
#pragma unroll
                for (int kk = 0; kk < 4; ++kk) dq = MFMA16(pa[kk], __builtin_bit_cast(bf16x8, nf[kk]), dq);
            }
            f32x4 nacc0 = {0.f, 0.f, 0.f, 0.f}, nacc1 = nacc0;
            if (model == 0) { bf16x8 A0, A1, A2, A3;
                tr_frag4<M_AK>(lb + (tr0l ^ ((unsigned)(2 * ti) << 5)), lb + (tr1l ^ ((unsigned)(2 * ti) << 5)), lb + (tr0l ^ ((unsigned)(2 * ti + 1) << 5)), lb + (tr1l ^ ((unsigned)(2 * ti + 1) << 5)), A0, A1, A2, A3);
                nacc0 = MFMA16(A0, BB0, nacc0); nacc0 = MFMA16(A1, BB1, nacc0); nacc1 = MFMA16(A2, BB0, nacc1); nacc1 = MFMA16(A3, BB1, nacc1); }
            float nnew[8] = {0.f, 0.f, 0.f, 0.f, 0.f, 0.f, 0.f, 0.f};
            if (model == 0) { const f32x4 no0 = *(const LAS f32x4*)(nb + 32 * ti + 4 * lg), no1 = *(const LAS f32x4*)(nb + 32 * ti + 16 + 4 * lg), gw0 = *(const LAS f32x4*)(nb + 128 + 32 * ti + 4 * lg), gw1 = *(const LAS f32x4*)(nb + 128 + 32 * ti + 16 + 4 * lg);
#pragma unroll
                for (int r = 0; r < 4; ++r) { nnew[r] = gw0[r] * (no0[r] + nacc0[r] + __shfl_xor(nacc0[r], 1)); nnew[4 + r] = gw1[r] * (no1[r] + nacc1[r] + __shfl_xor(nacc1[r], 1)); } }
            if (OUT) {
                LBAR();
                if (model == 0) { f32x4 dp = dq;
                    const bf16x8 p0 = *(const LAS bf16x8*)(uintptr_t)(pra0 + 2048u * ti), p1 = *(const LAS bf16x8*)(uintptr_t)(pra1 + 2048u * ti);
                    if (dir == 0 || ti < 2) dp = MFMA16(p0, BB0, dp);
                    if (dir == 1 || ti >= 2) dp = MFMA16(p1, BB1, dp);
#pragma unroll
                    for (int r = 0; r < 4; ++r) { const float v = dp[r] + __shfl_xor(dp[r], 1); const float al = nb[320 + 16 * ti + 4 * lg + r];
                        if (li == 0) nb[384 + 16 * ti + 4 * lg + r] = al / fmaxf(al * fabsf(v), 1.f); } }
            }
            LBAR();
            if (model == 0 && li == 0) {
#pragma unroll
                for (int j = 0; j < 2; ++j) { const int dk0 = 32 * ti + 16 * j + 4 * lg; const float* nn = nnew + 4 * j;
                    f32x4 nv = {nn[0], nn[1], nn[2], nn[3]}; *(LAS f32x4*)(nb + dk0) = nv;
                    u32x2 hv, lv; const unsigned h0 = pkbf(nn[0], nn[1]), h1 = pkbf(nn[2], nn[3]); hv.x = h0; hv.y = h1;
                    lv.x = pkbf(nn[0] - bflo(h0), nn[1] - bfhi(h0)); lv.y = pkbf(nn[2] - bflo(h1), nn[3] - bfhi(h1));
                    *(LAS u32x2*)(nbh + 128 + dk0) = hv; *(LAS u32x2*)(nbh + 256 + dk0) = lv; } }
            if (OUT) final_pass(m0, prevh);
        }
    }
}
__device__ __forceinline__ void p4m_scan_local(Frame& F) {
    LAS float* nb = (LAS float*)(F.lds + L_N);
    for (int it0 = F.bid; it0 < 32 * 8 * 2; it0 += F.G) {
        const int it = (F.G == 256) ? (it0 & ~255) | ((((((it0 & 255) >> 4) << 3) | (it0 & 7)) << 1) | ((it0 >> 3) & 1)) : it0;
        const int half = it & 1, slot = (it >> 1) & 7, sc = it >> 4, seg = slot - 1;
        const int dir = sc & 1, h = (sc >> 1) & 3, b = (sc >> 3) & 1, model = sc >> 4;
        f32x4 S[2][8];
#pragma unroll
        for (int j = 0; j < 2; ++j)
#pragma unroll
            for (int kt = 0; kt < 8; ++kt) S[j][kt] = (f32x4){0.f, 0.f, 0.f, 0.f};
        __syncthreads();
        if (F.tid < 128) nb[F.tid] = 0.f;
        float gacc = 1.f;
        mscan_run<false>(F, model, b, h, dir, half, seg, S, gacc);
        __syncthreads();
        if (F.wave < 4) {
#pragma unroll
            for (int j = 0; j < 2; ++j) { unsigned so = (unsigned)((2 * F.wave + j) * 512 + F.lane) * 8u; asm volatile("" : "+v"(so));
                bf16* st = (bf16*)((unsigned char*)mstate_ptr(F, sc, slot, half) + so);
#pragma unroll
                for (int kt = 0; kt < 8; ++kt) { u32x2 v; v.x = pkbf(S[j][kt][0], S[j][kt][1]); v.y = pkbf(S[j][kt][2], S[j][kt][3]); *(u32x2*)(st + kt * 256) = v; } } }
        if (half == 0 && F.tid < 128) { wsp<float>(F, WS_NST)[(sc * 8 + slot) * 128 + F.tid] = nb[F.tid]; wsp<float>(F, WS_GSEG)[(sc * 8 + slot) * 128 + F.tid] = gacc; }
    }
}
__device__ __forceinline__ void p5m_scan_out(Frame& F) {
    LAS float* nb = (LAS float*)(F.lds + L_N);
    for (int it0 = F.bid; it0 < 2 * 2 * 4 * 8 * 2; it0 += F.G) {
        const int it = (F.G == 256) ? ((((it0 >> 4) << 3) | (it0 & 7)) << 1) | ((it0 >> 3) & 1) : it0;
        const int half = it & 1, seg = (it >> 1) & 7, h = (it >> 4) & 3, b = (it >> 6) & 1, model = it >> 7;
        for (int dir = 0; dir < 2; ++dir) {
            const int sc = ((model * 2 + b) * 4 + h) * 2 + dir, s = dir == 0 ? seg : 7 - seg;
            f32x4 S[2][8];
#pragma unroll
            for (int j = 0; j < 2; ++j)
#pragma unroll
                for (int kt = 0; kt < 8; ++kt) S[j][kt] = (f32x4){0.f, 0.f, 0.f, 0.f};
            float nn = 0.f;
            for (int slot = 0; slot <= s; ++slot) {
                const float* gs = wsp<float>(F, WS_GSEG) + (sc * 8 + slot) * 128;
                const float gv = gs[F.tid & 127], nv = wsp<float>(F, WS_NST)[(sc * 8 + slot) * 128 + (F.tid & 127)];
                if (F.wave < 4) {
                    f32x4 gv4[8];
#pragma unroll
                    for (int kt = 0; kt < 8; ++kt) gv4[kt] = *(const f32x4*)(gs + 16 * kt + 4 * (F.lane >> 4));
#pragma unroll
                    for (int j = 0; j < 2; ++j) { unsigned so = (unsigned)((2 * F.wave + j) * 512 + F.lane) * 8u; asm volatile("" : "+v"(so));
                        const bf16* stp = (const bf16*)((const unsigned char*)mstate_ptr(F, sc, slot, half) + so);
                        u32x2 sv[8];
#pragma unroll
                        for (int kt = 0; kt < 8; ++kt) sv[kt] = *(const u32x2*)(stp + kt * 256);
#pragma unroll
                        for (int kt = 0; kt < 8; ++kt) { const u32x2 v = sv[kt]; f32x4 g4 = gv4[kt]; if (slot == 0) g4 = (f32x4){0.f, 0.f, 0.f, 0.f};
                            S[j][kt][0] = g4[0] * S[j][kt][0] + bflo(v.x); S[j][kt][1] = g4[1] * S[j][kt][1] + bfhi(v.x); S[j][kt][2] = g4[2] * S[j][kt][2] + bflo(v.y); S[j][kt][3] = g4[3] * S[j][kt][3] + bfhi(v.y); } } }
                nn = (slot > 0 ? gv : 0.f) * nn + nv; }
            __syncthreads();
            if (F.tid < 128) { nb[F.tid] = nn; LAS unsigned short* nbh = (LAS unsigned short*)(F.lds + L_N + 2048);
                const unsigned hi = pkbf(nn, nn) & 0xffffu; nbh[128 + F.tid] = (unsigned short)hi; nbh[256 + F.tid] = (unsigned short)(pkbf(nn - bflo(hi), 0.f) & 0xffffu); }
            float gacc = 1.f;
            mscan_run<true>(F, model, b, h, dir, half, s, S, gacc);
        }
    }
}

struct EpiProjB {
    unsigned char* ws; const float* ml_norm; const float* gla_norm;
    __device__ __forceinline__ void operator()(const f32x4 (&acc)[2][2][4][2], const Unit& u, int wr, int wc, int fr, int fq) const {
        const int row0 = u.pm * 256 + wr * 64 + fr, colt = (u.pn & 3) * 256 + wc * 32 + 8 * fq;
        if (u.pn < 8) {
            const int model = u.pn >> 2, head = u.pn & 3;
            bf16* base = (bf16*)(ws + (model == 0 ? WS_QKM : WS_QKG)) + colt;
            const float* nw = (model == 0 ? ml_norm : gla_norm) + colt;
            const float* ssq = (const float*)(ws + WS_SSQ);
            const float gsel = model == 0 ? 0.f : 1.f;
            f32x4 nwv[2][2];
#pragma unroll
            for (int bj = 0; bj < 2; ++bj) { nwv[bj][0] = *(const f32x4*)(nw + bj * 128); nwv[bj][1] = *(const f32x4*)(nw + bj * 128 + 4); }
            u32x4 hvq[8][2]; f32x2 sqq[8];
#define EPB_ISSUE(g) do { const int row_ = row0 + ((g) >> 2) * 128 + ((g) & 3) * 16; const bf16* rp_ = base + (size_t)row_ * 1024; hvq[g][0] = *(const u32x4*)rp_; hvq[g][1] = *(const u32x4*)(rp_ + 128); \
                sqq[g] = *(const f32x2*)(ssq + ((size_t)row_ * 8 + model * 4 + head) * 2); } while (0)
            EPB_ISSUE(0); EPB_ISSUE(1); EPB_ISSUE(2); EPB_ISSUE(3);
#pragma unroll
            for (int g = 0; g < 8; ++g) { const int ai = g >> 2, m = g & 3;
                __builtin_amdgcn_sched_barrier(0);
                if (g == 1) { EPB_ISSUE(4); EPB_ISSUE(5); }
                if (g == 2) { EPB_ISSUE(6); EPB_ISSUE(7); }
                __builtin_amdgcn_sched_barrier(0);
                const int row = row0 + ai * 128 + m * 16; bf16* rowp = base + (size_t)row * 1024;
                const float rstd = 1.f / sqrtf((sqq[g].x + sqq[g].y) * (1.f / 256.f) + EPS);
                float one = 1.f; asm volatile("" : "+v"(one));
#pragma unroll
                for (int bj = 0; bj < 2; ++bj) { const f32x4 a0 = acc[ai][bj][m][0] * one, a1 = acc[ai][bj][m][1] * one;
                    const f32x4 n0 = nwv[bj][0], n1 = nwv[bj][1];
                    float hvf[8]; unpack8(hvq[g][bj], hvf); float o[8];
#pragma unroll
                    for (int j = 0; j < 4; ++j) { const float s0 = sigm(a0[j]), s1 = sigm(a1[j]);
                        o[j] = hvf[j] * rstd * n0[j] * (s0 + gsel * (s0 * a0[j] - s0)); o[4 + j] = hvf[4 + j] * rstd * n1[j] * (s1 + gsel * (s1 * a1[j] - s1)); }
                    u32x4 w; w.x = cvt_pk_bf16(o[0], o[1]); w.y = cvt_pk_bf16(o[2], o[3]); w.z = cvt_pk_bf16(o[4], o[5]); w.w = cvt_pk_bf16(o[6], o[7]);
                    *(u32x4*)(rowp + bj * 128) = w; } }
#undef EPB_ISSUE
        } else {
            bf16* base = (bf16*)(ws + (u.pn < 12 ? WS_VG : WS_QKMC)) + colt;
#pragma unroll
            for (int ai = 0; ai < 2; ++ai)
#pragma unroll
                for (int m = 0; m < 4; ++m) { bf16* rowp = base + (size_t)(row0 + ai * 128 + m * 16) * 1024;
#pragma unroll
                    for (int bj = 0; bj < 2; ++bj) { const f32x4 a0 = acc[ai][bj][m][0], a1 = acc[ai][bj][m][1];
                        u32x4 w; w.x = pkbf(sigm(a0[0]), sigm(a0[1])); w.y = pkbf(sigm(a0[2]), sigm(a0[3])); w.z = pkbf(sigm(a1[0]), sigm(a1[1])); w.w = pkbf(sigm(a1[2]), sigm(a1[3]));
                        *(u32x4*)(rowp + bj * 128) = w; } }
        }
    }
};
template <int STEP> struct EpiGate {
    unsigned char* ws;
    __device__ __forceinline__ void operator()(const f32x4 (&acc)[2][2][4][2], const Unit& u, int wr, int wc, int fr, int fq) const {
        const int row0 = u.pm * 256 + wr * 64 + fr, colt = u.pn * 256 + wc * 32 + 8 * fq;
        const bf16* sg = (const bf16*)(ws + (STEP == 0 ? WS_VG : WS_QKMC)) + colt; bf16* ty = (bf16*)(ws + WS_VM) + colt;
#pragma unroll
        for (int ai = 0; ai < 2; ++ai)
#pragma unroll
            for (int m = 0; m < 4; ++m) { const size_t ro = (size_t)(row0 + ai * 128 + m * 16) * 1024;
#pragma unroll
                for (int bj = 0; bj < 2; ++bj) { const f32x4 a0 = acc[ai][bj][m][0], a1 = acc[ai][bj][m][1];
                    const u32x4 s = *(const u32x4*)(sg + ro + bj * 128);
                    float r[8] = {bflo(s.x) * a0[0], bfhi(s.x) * a0[1], bflo(s.y) * a0[2], bfhi(s.y) * a0[3], bflo(s.z) * a1[0], bfhi(s.z) * a1[1], bflo(s.w) * a1[2], bfhi(s.w) * a1[3]};
                    if (STEP == 1) { const u32x4 t = *(const u32x4*)(ty + ro + bj * 128);
                        r[0] += bflo(t.x); r[1] += bfhi(t.x); r[2] += bflo(t.y); r[3] += bfhi(t.y); r[4] += bflo(t.z); r[5] += bfhi(t.z); r[6] += bflo(t.w); r[7] += bfhi(t.w); }
                    u32x4 w; w.x = cvt_pk_bf16(r[0], r[1]); w.y = cvt_pk_bf16(r[2], r[3]); w.z = cvt_pk_bf16(r[4], r[5]); w.w = cvt_pk_bf16(r[6], r[7]);
                    *(u32x4*)(ty + ro + bj * 128) = w; } }
    }
};
struct EpiOut {
    const float* x; float* out; const float* modv;
    __device__ __forceinline__ void operator()(const f32x4 (&acc)[2][2][4][2], const Unit& u, int wr, int wc, int fr, int fq) const {
        const int row0 = u.pm * 256 + wr * 64 + fr, colt = u.pn * 256 + wc * 32 + 8 * fq;
        const float* gt = modv + ((u.pm * 256) >> 13) * 6144 + 2048 + colt;
#pragma unroll
        for (int bj = 0; bj < 2; ++bj) { const f32x4 g0 = *(const f32x4*)(gt + bj * 128), g1 = *(const f32x4*)(gt + bj * 128 + 4);
#pragma unroll
            for (int ai = 0; ai < 2; ++ai)
#pragma unroll
                for (int m = 0; m < 4; ++m) { const size_t off = (size_t)(row0 + ai * 128 + m * 16) * 1024 + colt + bj * 128;
                    *(f32x4*)(out + off) = *(const f32x4*)(x + off) + g0 * acc[ai][bj][m][0]; *(f32x4*)(out + off + 4) = *(const f32x4*)(x + off + 4) + g1 * acc[ai][bj][m][1]; } }
    }
};

__device__ __forceinline__ void p9_route(Frame& F) {
    const float* modv = wsp<float>(F, WS_MODV);
    constexpr int WP = 1032;
    LAS unsigned short* Wt = (LAS unsigned short*)F.lds;
    LAS float* lgs = (LAS float*)(F.lds + 40 * WP * 2) + F.wave * 512;
    LAS int* hist = (LAS int*)(F.lds + 40 * WP * 2 + 16384);
    if (F.tid < 32) hist[F.tid] = 0;
    for (int k = F.tid; k < 1024; k += NTHR) {
        const f32x4 wg = *(const f32x4*)(F.w_grp + (size_t)k * 4), w0 = *(const f32x4*)(F.w_rexp + (size_t)k * 16), w1 = *(const f32x4*)(F.w_rexp + (size_t)k * 16 + 4), w2 = *(const f32x4*)(F.w_rexp + (size_t)k * 16 + 8), w3 = *(const f32x4*)(F.w_rexp + (size_t)k * 16 + 12);
        const float wv[20] = {wg[0], wg[1], wg[2], wg[3], w0[0], w0[1], w0[2], w0[3], w1[0], w1[1], w1[2], w1[3], w2[0], w2[1], w2[2], w2[3], w3[0], w3[1], w3[2], w3[3]};
#pragma unroll
        for (int n = 0; n < 20; ++n) { const unsigned hi = pkbf(wv[n], 0.f) & 0xffffu; Wt[n * WP + k] = (unsigned short)hi; Wt[(20 + n) * WP + k] = (unsigned short)(pkbf(wv[n] - bflo(hi), 0.f) & 0xffffu); } }
    __syncthreads();
    int* rexp = (int*)(F.ws + WS_ROUTE + RT_EXP); float* rw = (float*)(F.ws + WS_ROUTE + RT_W); int* rpos = (int*)(F.ws + WS_ROUTE + RT_POS);
    const int gw = F.bid * NW + F.wave, NGW = F.G * NW, li = F.lane & 15, lg = F.lane >> 4;
    const int n1 = 16 + li < 20 ? 16 + li : 19;
    for (int t = gw; t < M_LAT / 16; t += NGW) {
        const int m = 16 * t + li; const float* src = F.out + (size_t)m * D + 8 * lg; const float* mv = modv + (m >> 13) * 6144 + 8 * lg;
        float ss = 0.f;
#pragma unroll 8
        for (int ks = 0; ks < 32; ++ks) { const f32x4 a = *(const f32x4*)(src + 32 * ks), c = *(const f32x4*)(src + 32 * ks + 4); ss += (a.x * a.x + a.y * a.y) + (a.z * a.z + a.w * a.w) + (c.x * c.x + c.y * c.y) + (c.z * c.z + c.w * c.w); }
        ss += __shfl_xor(ss, 16); ss += __shfl_xor(ss, 32);
        const float rstd = 1.f / sqrtf(ss * (1.f / D) + EPS);
        f32x4 acc0 = {0.f, 0.f, 0.f, 0.f}, acc1 = acc0;
        bf16* o = wsp<bf16>(F, WS_H2) + (size_t)m * D + 8 * lg;
#pragma unroll 4
        for (int ks = 0; ks < 32; ++ks) { const int c = 32 * ks;
            const f32x4 xa = *(const f32x4*)(src + c), xb = *(const f32x4*)(src + c + 4);
            const f32x4 ga = *(const f32x4*)(F.g_norm2 + 8 * lg + c), gb = *(const f32x4*)(F.g_norm2 + 8 * lg + c + 4);
            const f32x4 sha = *(const f32x4*)(mv + 3072 + c), shb = *(const f32x4*)(mv + 3072 + c + 4), sca = *(const f32x4*)(mv + 4096 + c), scb = *(const f32x4*)(mv + 4096 + c + 4);
            const f32x4 ha = (xa * rstd) * ga * (sca + 1.f) + sha, hb = (xb * rstd) * gb * (scb + 1.f) + shb;
            u32x4 hi; hi.x = pkbf(ha[0], ha[1]); hi.y = pkbf(ha[2], ha[3]); hi.z = pkbf(hb[0], hb[1]); hi.w = pkbf(hb[2], hb[3]);
            u32x4 lo; lo.x = pkbf(ha[0] - bflo(hi.x), ha[1] - bfhi(hi.x)); lo.y = pkbf(ha[2] - bflo(hi.y), ha[3] - bfhi(hi.y)); lo.z = pkbf(hb[0] - bflo(hi.z), hb[1] - bfhi(hi.z)); lo.w = pkbf(hb[2] - bflo(hi.w), hb[3] - bfhi(hi.w));
            *(u32x4*)(o + c) = hi;
            const bf16x8 Ah = __builtin_bit_cast(bf16x8, hi), Al = __builtin_bit_cast(bf16x8, lo);
            const bf16x8 bh0 = *(const LAS bf16x8*)(Wt + li * WP + c + 8 * lg), bh1 = *(const LAS bf16x8*)(Wt + n1 * WP + c + 8 * lg), bl0 = *(const LAS bf16x8*)(Wt + (20 + li) * WP + c + 8 * lg), bl1 = *(const LAS bf16x8*)(Wt + (20 + n1) * WP + c + 8 * lg);
            acc0 = __builtin_amdgcn_mfma_f32_16x16x32_bf16(Ah, bh0, acc0, 0, 0, 0); acc1 = __builtin_amdgcn_mfma_f32_16x16x32_bf16(Ah, bh1, acc1, 0, 0, 0);
            acc0 = __builtin_amdgcn_mfma_f32_16x16x32_bf16(Al, bh0, acc0, 0, 0, 0); acc1 = __builtin_amdgcn_mfma_f32_16x16x32_bf16(Al, bh1, acc1, 0, 0, 0);
            acc0 = __builtin_amdgcn_mfma_f32_16x16x32_bf16(Ah, bl0, acc0, 0, 0, 0); acc1 = __builtin_amdgcn_mfma_f32_16x16x32_bf16(Ah, bl1, acc1, 0, 0, 0); }
#pragma unroll
        for (int r = 0; r < 4; ++r) { lgs[(4 * lg + r) * 32 + li] = acc0[r]; lgs[(4 * lg + r) * 32 + 16 + li] = acc1[r]; }
        LDS_WAIT(); asm volatile("" ::: "memory");
        if (F.lane < 16) {
            const int mr = 16 * t + F.lane;
            const f32x4 lq0 = *(const LAS f32x4*)(lgs + F.lane * 32), lq1 = *(const LAS f32x4*)(lgs + F.lane * 32 + 4), lq2 = *(const LAS f32x4*)(lgs + F.lane * 32 + 8), lq3 = *(const LAS f32x4*)(lgs + F.lane * 32 + 12), lq4 = *(const LAS f32x4*)(lgs + F.lane * 32 + 16);
            const f32x4 bg = *(const f32x4*)F.b_grp;
            float gl[4] = {lq0[0] + bg[0], lq0[1] + bg[1], lq0[2] + bg[2], lq0[3] + bg[3]};
            int grp = 0; float gmax = gl[0];
#pragma unroll
            for (int q = 1; q < 4; ++q) if (gl[q] > gmax) { gmax = gl[q]; grp = q; }
            float gs = 0.f;
#pragma unroll
            for (int q = 0; q < 4; ++q) gs += expf(gl[q] - gmax);
            const float grp_p = 1.f / gs;
            float el[4];
#pragma unroll
            for (int q = 0; q < 4; ++q) { float v = lq1[q]; v = grp == 1 ? lq2[q] : v; v = grp == 2 ? lq3[q] : v; v = grp == 3 ? lq4[q] : v; asm volatile("" : "+v"(v)); el[q] = v + F.b_rexp[grp * 4 + q]; }
            int i0 = 0; float e0v = el[0];
#pragma unroll
            for (int q = 1; q < 4; ++q) if (el[q] > e0v) { e0v = el[q]; i0 = q; }
            int i1 = -1; float e1v = -3.0e38f;
#pragma unroll
            for (int q = 0; q < 4; ++q) if (q != i0 && el[q] > e1v) { e1v = el[q]; i1 = q; }
            const float e1 = expf(e1v - e0v); const float w0 = grp_p / (1.f + e1), w1 = grp_p * e1 / (1.f + e1);
            const int x0 = grp * 4 + i0, x1 = grp * 4 + i1;
            rexp[2 * mr] = x0; rexp[2 * mr + 1] = x1; rw[2 * mr] = w0; rw[2 * mr + 1] = w1;
            rpos[2 * mr] = __hip_atomic_fetch_add(hist + x0, 1, __ATOMIC_RELAXED, __HIP_MEMORY_SCOPE_WORKGROUP);
            rpos[2 * mr + 1] = __hip_atomic_fetch_add(hist + x1, 1, __ATOMIC_RELAXED, __HIP_MEMORY_SCOPE_WORKGROUP);
        }
        LDS_WAIT(); asm volatile("" ::: "memory");
    }
    __syncthreads();
    if (F.tid < 16) hist[16 + F.tid] = (int)__hip_atomic_fetch_add((unsigned*)(F.ws + WS_CTL) + CW_CNT + 64 * F.tid, (unsigned)hist[F.tid], __ATOMIC_RELAXED, __HIP_MEMORY_SCOPE_AGENT);
    __syncthreads();
    VM_WAIT();
    for (int t = gw; t < M_LAT / 16; t += NGW) if (F.lane < 32) { const int a = 32 * t + F.lane, e = rexp[a], pos = rpos[a] + hist[16 + e]; rpos[a] = pos;
        wsp<int>(F, WS_LTOK)[e * LCAP + pos] = a >> 1; wsp<float>(F, WS_LW)[e * LCAP + pos] = rw[a]; }
    __syncthreads();
    moe_weight_copies<0>(F);
}
__device__ __forceinline__ void moe_layout(Frame& F) {
    LAS int* tab = (LAS int*)(F.lds + LDS_TAB);
    if (F.tid == 0) { int a = 0; for (int e = 0; e < 16; ++e) { const int c = (int)__hip_atomic_load((unsigned*)(F.ws + WS_CTL) + CW_CNT + 64 * e, __ATOMIC_RELAXED, __HIP_MEMORY_SCOPE_AGENT); tab[e] = a; tab[32 + e] = c; a += (c + 255) & ~255; } tab[16] = a; tab[17] = a >> 8; }
    __syncthreads();
}
struct EpiUp {
    unsigned char* ws;
    __device__ __forceinline__ void operator()(const f32x4 (&acc)[2][2][4][2], const Unit& u, int wr, int wc, int fr, int fq) const {
        const int row0 = u.pm * 256 + wr * 64 + fr; bf16* base = (bf16*)(ws + WS_HID) + u.pn * 128 + wc * 32 + 8 * fq;
#pragma unroll
        for (int ai = 0; ai < 2; ++ai)
#pragma unroll
            for (int m = 0; m < 4; ++m) { const f32x4 g0 = acc[ai][0][m][0], g1 = acc[ai][0][m][1], u0 = acc[ai][1][m][0], u1 = acc[ai][1][m][1];
                u32x4 w; w.x = cvt_pk_bf16(siluf(g0[0]) * u0[0], siluf(g0[1]) * u0[1]); w.y = cvt_pk_bf16(siluf(g0[2]) * u0[2], siluf(g0[3]) * u0[3]);
                w.z = cvt_pk_bf16(siluf(g1[0]) * u1[0], siluf(g1[1]) * u1[1]); w.w = cvt_pk_bf16(siluf(g1[2]) * u1[2], siluf(g1[3]) * u1[3]);
                *(u32x4*)(base + (size_t)(row0 + ai * 128 + m * 16) * 512) = w; }
    }
};
struct EpiDown {
    unsigned char* ws; const LAS int* tab;
    __device__ __forceinline__ void operator()(const f32x4 (&acc)[2][2][4][2], const Unit& u, int wr, int wc, int fr, int fq) const {
        const int row0 = u.pm * 256 + wr * 64 + fr; bf16* base = (bf16*)(ws + WS_YROWS) + u.pn * 256 + wc * 32 + 8 * fq;
        const float* lw = (const float*)(ws + WS_LW) + u.e * LCAP - tab[u.e];
#pragma unroll
        for (int ai = 0; ai < 2; ++ai)
#pragma unroll
            for (int m = 0; m < 4; ++m) { const int row = row0 + ai * 128 + m * 16; const float rwt = lw[row];
#pragma unroll
                for (int bj = 0; bj < 2; ++bj) { const f32x4 v0 = acc[ai][bj][m][0] * rwt, v1 = acc[ai][bj][m][1] * rwt;
                    u32x4 w; w.x = cvt_pk_bf16(v0[0], v0[1]); w.y = cvt_pk_bf16(v0[2], v0[3]); w.z = cvt_pk_bf16(v1[0], v1[1]); w.w = cvt_pk_bf16(v1[2], v1[3]);
                    *(u32x4*)(base + (size_t)row * 1024 + bj * 128) = w; } }
    }
};
__device__ __forceinline__ void p13_final(Frame& F) {
    moe_layout(F);
    const LAS int* tab = (const LAS int*)(F.lds + LDS_TAB);
    const float* modv = wsp<float>(F, WS_MODV); const int* rpos = (const int*)(F.ws + WS_ROUTE + RT_POS); const int* rexp = (const int*)(F.ws + WS_ROUTE + RT_EXP); const bf16* Y = wsp<bf16>(F, WS_YROWS);
    const int gw = F.bid * NW + F.wave, NGW = F.G * NW;
    for (int m = gw; m < M_LAT; m += NGW) {
        float* row = F.out + (size_t)m * D; const float* gt = modv + (m >> 13) * 6144 + 5120;
        const bf16* y0 = Y + (size_t)(tab[rexp[2 * m]] + rpos[2 * m]) * 1024; const bf16* y1 = Y + (size_t)(tab[rexp[2 * m + 1]] + rpos[2 * m + 1]) * 1024;
        f32x4 v[4]; float s = 0.f;
#pragma unroll
        for (int j = 0; j < 4; ++j) { const int c = 4 * F.lane + 256 * j; const u32x2 a = *(const u32x2*)(y0 + c), b = *(const u32x2*)(y1 + c); const f32x4 g = *(const f32x4*)(gt + c);
            f32x4 yy; yy.x = bflo(a.x) + bflo(b.x); yy.y = bfhi(a.x) + bfhi(b.x); yy.z = bflo(a.y) + bflo(b.y); yy.w = bfhi(a.y) + bfhi(b.y);
            v[j] = *(const f32x4*)(row + c) + g * yy; s += (v[j].x * v[j].x + v[j].y * v[j].y) + (v[j].z * v[j].z + v[j].w * v[j].w); }
        const float rstd = 1.f / sqrtf(wave_sum(s) * (1.f / D) + EPS);
#pragma unroll
        for (int j = 0; j < 4; ++j) { const int c = 4 * F.lane + 256 * j; *(f32x4*)(row + c) = (v[j] * rstd) * *(const f32x4*)(F.g_final + c); }
    }
}

typedef const Args __attribute__((address_space(4))) * KArgsP;
__device__ __forceinline__ void load_inputs(Frame& F) {
    KArgsP ap = (KArgsP)__builtin_amdgcn_kernarg_segment_ptr();
    asm volatile("" : "+s"(ap));
    F.x = ap->in[0]; F.c = ap->in[1]; F.ctx = ap->in[2]; F.c_ctx = ap->in[3]; F.w_mod = ap->in[4]; F.b_mod = ap->in[5]; F.g_norm1 = ap->in[6]; F.w_in = ap->in[7];
    F.ml_conv = ap->in[8]; F.ml_conv_b = ap->in[9]; F.b_mgate = ap->in[10]; F.ml_norm = ap->in[11]; F.gla_w2 = ap->in[12]; F.gla_b2 = ap->in[13]; F.gla_norm = ap->in[14];
    F.w_proj_m = ap->in[15]; F.w_proj_g = ap->in[16]; F.w_out = ap->in[17]; F.g_norm2 = ap->in[18]; F.w_grp = ap->in[19]; F.b_grp = ap->in[20]; F.w_rexp = ap->in[21]; F.b_rexp = ap->in[22];
    F.w_up = ap->in[23]; F.w_down = ap->in[24]; F.g_final = ap->in[25];
    F.ws = ap->ws; F.out = ap->out;
    int ln = (int)__builtin_amdgcn_mbcnt_hi(~0u, __builtin_amdgcn_mbcnt_lo(~0u, 0u)); asm volatile("" : "+v"(ln)); F.lane = ln; F.tid = F.wave * 64 + ln;
}
constexpr int N_PHASES = 14;
__global__ void __launch_bounds__(NTHR, 2) mk_fwd(Args args) {
    extern __shared__ __attribute__((aligned(16))) unsigned char lds[];
    Frame F;
    F.lds = (LAS unsigned char*)lds; F.MISC = (volatile LAS unsigned*)(F.lds + MISC_OFF);
    F.tid = threadIdx.x; F.lane = F.tid & 63; F.wave = __builtin_amdgcn_readfirstlane(F.tid >> 6); F.G = gridDim.x; F.bid = blockIdx.x;
    F.ws = args.ws; F.out = args.out;
    for (int u = F.tid; u < (LDS_BYTES - LDSCTL_OFF) / 4; u += NTHR) ((LAS unsigned*)(F.lds + LDSCTL_OFF))[u] = 0u;
    __syncthreads();
    const int lo = args.ph_lo, hi = args.ph_hi;
    XcdBarrier bar; bar.bar = (unsigned*)(F.ws + WS_CTL) + CW_BAR; bar.x = 0; bar.st = nullptr;
    if (hi - lo > 1) bar = xcd_barrier_post((unsigned*)(F.ws + WS_CTL) + CW_BAR, F.MISC + 8);
#ifndef PH_MASK
#define PH_MASK 0xFFFF
#endif
#define IN(k) (((PH_MASK >> (k)) & 1) && lo <= (k) && (k) < hi)
#define REPS(k) for (int rep_ = 0; rep_ < (((REP_MASK >> (k)) & 1) ? 2 : 1); ++rep_)
#define SEAM(k) do { if (IN(k) && IN((k) + 1)) xcd_barrier(bar, F.tid); } while (0)
    const int vc = (int)blockIdx.x;
    if (IN(0)) REPS(0) { load_inputs(F); p0_prologue(F); SEAM(0); }
    if (IN(1)) REPS(1) { load_inputs(F); p1_hx(F); p0_weight_copies<0>(F); SEAM(1); }
    if (IN(2)) REPS(2) { load_inputs(F); pg8::DenseSched S; S.init(wsp<bf16>(F, WS_HX), wsp<bf16>(F, WS_WA), MT, NA, D, F.G, vc); EpiProjA E{F.ws, F.b_mgate};
        pg8::gemm_phase<EpiProjA, pg8::DenseSched, true>(F.lds, S, E, F.wave); p0_weight_copies<1>(F, F.G == 256 ? (MT / 256) * (NA / 256) % 256 : 0); SEAM(2); }
    if (IN(3)) REPS(3) { load_inputs(F); p3_prep(F); SEAM(3); }
#if SCAN_SCALAR
    if (IN(4)) REPS(4) { load_inputs(F); p4_scan_local(F); SEAM(4); }
    if (IN(5)) REPS(5) { load_inputs(F); p5_scan_out(F); SEAM(5); }
#else
    if (IN(4)) REPS(4) { load_inputs(F); p4m_scan_local(F); SEAM(4); }
    if (IN(5)) REPS(5) { load_inputs(F); p5m_scan_out(F); SEAM(5); }
#endif
    if (IN(6)) REPS(6) { load_inputs(F); pg8::DenseSched S; S.init(wsp<bf16>(F, WS_HX), wsp<bf16>(F, WS_WB), M_LAT, NB, D, F.G, vc); EpiProjB E{F.ws, F.ml_norm, F.gla_norm};
        pg8::gemm_phase<EpiProjB, pg8::DenseSched, true>(F.lds, S, E, F.wave); SEAM(6); }
    if (IN(7)) REPS(7) { load_inputs(F);
        { pg8::DenseSched S; S.init(wsp<bf16>(F, WS_QKM), wsp<bf16>(F, WS_WPM), M_LAT, D, D, F.G, vc); EpiGate<0> E{F.ws}; pg8::gemm_phase<EpiGate<0>, pg8::DenseSched, false>(F.lds, S, E, F.wave); }
        VM_WAIT(); __syncthreads();
        { pg8::DenseSched S; S.init(wsp<bf16>(F, WS_QKG), wsp<bf16>(F, WS_WPG), M_LAT, D, D, F.G, vc); EpiGate<1> E{F.ws}; pg8::gemm_phase<EpiGate<1>, pg8::DenseSched, false>(F.lds, S, E, F.wave); }
        SEAM(7); }
    if (IN(8)) REPS(8) { load_inputs(F); pg8::DenseSched S; S.init(wsp<bf16>(F, WS_VM), wsp<bf16>(F, WS_WOUT), M_LAT, D, D, F.G, vc); EpiOut E{F.x, F.out, wsp<float>(F, WS_MODV)};
        pg8::gemm_phase<EpiOut, pg8::DenseSched, false>(F.lds, S, E, F.wave); SEAM(8); }
    if (IN(9)) REPS(9) { load_inputs(F); p9_route(F); if (IN(9) && IN(11)) xcd_barrier(bar, F.tid); }
    if (IN(11)) REPS(11) { load_inputs(F); moe_layout(F); pg8::GroupSched<true> S; S.A = wsp<bf16>(F, WS_H2); S.Bt = wsp<bf16>(F, WS_WUP); S.list_tok = wsp<int>(F, WS_LTOK); S.tab = (const LAS int*)(F.lds + LDS_TAB);
        S.K = 1024; S.ntiles = S.tab[17]; S.G = F.G; S.c = vc; EpiUp E{F.ws};
        pg8::gemm_phase<EpiUp, pg8::GroupSched<true>, true>(F.lds, S, E, F.wave); moe_weight_copies<1>(F, F.G == 256 ? (S.ntiles * 4) % 256 : 0); SEAM(11); }
    if (IN(12)) REPS(12) { load_inputs(F); moe_layout(F); pg8::GroupSched<false> S; S.A = wsp<bf16>(F, WS_HID); S.Bt = wsp<bf16>(F, WS_WDN); S.list_tok = nullptr; S.tab = (const LAS int*)(F.lds + LDS_TAB);
        S.K = 512; S.ntiles = S.tab[17]; S.G = F.G; S.c = vc; EpiDown E{F.ws, (const LAS int*)(F.lds + LDS_TAB)};
        pg8::gemm_phase<EpiDown, pg8::GroupSched<false>, true>(F.lds, S, E, F.wave); SEAM(12); }
    if (IN(13)) REPS(13) { load_inputs(F); p13_final(F); }
#undef IN
#undef SEAM
}

extern "C" void kernel_launch(void* const* d_in, const int* in_sizes, int n_in, void* d_out, int out_size, void* d_ws, size_t ws_size, hipStream_t stream) {
    static int grid = 0;
    if (grid == 0) {
        if (n_in != 26 || out_size != M_LAT * D || ws_size < WS_END) { fprintf(stderr, "kernel_launch: unexpected shapes (n_in %d, out %d, ws %zu)\n", n_in, out_size, ws_size); grid = -1; return; }
        int dev = 0, cus = 0, per_cu = 0;
        if (hipGetDevice(&dev) != hipSuccess || hipDeviceGetAttribute(&cus, hipDeviceAttributeMultiprocessorCount, dev) != hipSuccess) { grid = -1; return; }
        if (hipFuncSetAttribute((const void*)mk_fwd, hipFuncAttributeMaxDynamicSharedMemorySize, LDS_BYTES) != hipSuccess) { fprintf(stderr, "kernel_launch: hipFuncSetAttribute failed\n"); grid = -1; return; }
        if (hipOccupancyMaxActiveBlocksPerMultiprocessor(&per_cu, (const void*)mk_fwd, NTHR, LDS_BYTES) != hipSuccess || per_cu < 1) fprintf(stderr, "kernel_launch: occupancy query reports %d\n", per_cu);
        (void)hipGetLastError();
        grid = cus;
    }
    if (grid < 0) return;
    (void)hipMemsetAsync((char*)d_ws + WS_CTL, 0, CTL_ZERO_BYTES, stream);
    Args a{};
    for (int i = 0; i < 26; ++i) a.in[i] = (const float*)d_in[i];
    a.out = (float*)d_out; a.ws = (unsigned char*)d_ws;
#if MK_ONE_LAUNCH
    a.ph_lo = 0; a.ph_hi = N_PHASES;
    hipLaunchKernelGGL(mk_fwd, dim3(grid), dim3(NTHR), LDS_BYTES, stream, a);
#else
    for (int p = 0; p < N_PHASES; ++p) { a.ph_lo = p; a.ph_hi = p + 1; hipLaunchKernelGGL(mk_fwd, dim3(grid), dim3(NTHR), LDS_BYTES, stream, a); }
#endif
}
```

```cpp
#include <hip/hip_runtime.h>
#include <cstdio>
#include <cstdint>

#ifndef SCAN_SCALAR
#define SCAN_SCALAR 0
#endif
#ifndef REP_MASK
#define REP_MASK 0x0
#endif
#ifndef MK_ONE_LAUNCH
#define MK_ONE_LAUNCH 1
#endif

#define LAS __attribute__((address_space(3)))
typedef unsigned short bf16;
typedef short bf16x8 __attribute__((ext_vector_type(8)));
typedef float f32x4 __attribute__((ext_vector_type(4)));
typedef float f32x2 __attribute__((ext_vector_type(2)));
typedef unsigned u32x4 __attribute__((ext_vector_type(4)));
typedef unsigned u32x2 __attribute__((ext_vector_type(2)));

constexpr int D = 1024, BATCH = 2, SEQ = 8192, CTXL = 256;
constexpr int M_LAT = BATCH * SEQ;
constexpr int M_CTX = BATCH * CTXL;
constexpr int MT = M_LAT + M_CTX;
constexpr int NW = 8, NTHR = 512;
constexpr int IN_W = 8240;
constexpr int NA = 4352;
constexpr int NB = 4096;
constexpr int CHUNK = 64, NCH_LAT = SEQ / CHUNK  , NCH_CTX = CTXL / CHUNK  ;
constexpr int NCHUNK = BATCH * NCH_LAT + BATCH * NCH_CTX;
constexpr int NSEG = 8, CPS = NCH_LAT / NSEG;
constexpr int NEXP = 16, DEXP = 512, NROWS_MAX = 36864  ;
constexpr float EPS = 1e-6f;

constexpr size_t MiB = 1u << 20;
constexpr size_t BIG = (size_t)MT * 1024 * 2;
constexpr size_t WS_CTL = 0, CTL_ZERO_BYTES = 1 * MiB;
constexpr size_t WS_MODV = 1 * MiB;
constexpr size_t WS_AB = 2 * MiB;
constexpr size_t WS_GENDM = WS_AB + 1088 * 1024;
constexpr size_t WS_GENDG = 4 * MiB;
constexpr size_t WS_SSQ = WS_GENDG + 1088 * 1024;
constexpr size_t WS_WA = 7 * MiB;
constexpr size_t WS_WB = 16 * MiB;
constexpr size_t WS_WPM = 24 * MiB, WS_WPG = 26 * MiB, WS_WOUT = 28 * MiB;
constexpr size_t WS_GATES = 30 * MiB;
constexpr size_t WS_NST = 35 * MiB;
constexpr size_t WS_GSEG = WS_NST + 256 * 1024;
constexpr size_t WS_ROUTE = 36 * MiB;
constexpr size_t WS_HX = 37 * MiB;
constexpr size_t WS_QKM = WS_HX + BIG;
constexpr size_t WS_VM = WS_QKM + BIG;
constexpr size_t WS_QKG = WS_VM + BIG;
constexpr size_t WS_VG = WS_QKG + BIG;
constexpr size_t WS_QKMC = WS_VG + BIG;
constexpr size_t WS_STATE = WS_QKMC + BIG;
constexpr size_t WS_QKGTC = WS_STATE + 16 * MiB;
constexpr size_t WS_END = WS_QKGTC + 2 * MiB;
static_assert(WS_END <= 256 * MiB, "ws map");
constexpr size_t WS_WUP = WS_HX;
constexpr size_t WS_H2 = 70 * MiB;
constexpr size_t WS_WDN = 103 * MiB;
constexpr size_t WS_HID = 136 * MiB;
constexpr size_t WS_YROWS = 172 * MiB;
constexpr size_t RT_EXP = 0;
constexpr size_t RT_W = 128 * 1024;
constexpr size_t RT_POS = 256 * 1024;
constexpr size_t RT_ROWTOK = 384 * 1024;
constexpr size_t RT_ROWW = 384 * 1024 + 144 * 1024;
constexpr size_t RT_TILE_E = 384 * 1024 + 288 * 1024;
constexpr size_t WS_LTOK = 120 * MiB, WS_LW = 122 * MiB;
constexpr int LCAP = 32768;
constexpr int LDS_TAB = 147456 - 1024 + 768;
constexpr int CW_BAR = 4096;
constexpr int CW_CNT = 8192;

#ifdef PROBE_SEL
#ifndef PROBE_WG
#define PROBE_WG 0
#endif
#define PMARK0(id) unsigned long long pm0_##id = 0; if (PROBE_SEL == (id)) pm0_##id = __builtin_amdgcn_s_memrealtime();
#define PMARK1(id) if (PROBE_SEL == (id) && F.tid == 0) F.MISC[65] += (unsigned)(__builtin_amdgcn_s_memrealtime() - pm0_##id);
#else
#define PMARK0(id)
#define PMARK1(id)
#endif
#define LDS_WAIT() asm volatile("s_waitcnt lgkmcnt(0)" ::: "memory")
#define VM_WAIT() asm volatile("s_waitcnt vmcnt(0)" ::: "memory")
__device__ __forceinline__ unsigned f2bf(float f) { unsigned u = __builtin_bit_cast(unsigned, f); return (u + 0x7fffu + ((u >> 16) & 1u)) >> 16; }
typedef __bf16 bf16x2_t __attribute__((ext_vector_type(2)));
__device__ __forceinline__ unsigned pkbf(float lo, float hi) { f32x2 v = {lo, hi}; return __builtin_bit_cast(unsigned, __builtin_convertvector(v, bf16x2_t)); }
__device__ __forceinline__ unsigned pk2(float lo, float hi) { return pkbf(lo, hi); }
__device__ __forceinline__ float bf2f(unsigned short h) { return __builtin_bit_cast(float, (unsigned)h << 16); }
__device__ __forceinline__ float bflo(unsigned w) { return __builtin_bit_cast(float, w << 16); }
__device__ __forceinline__ float bfhi(unsigned w) { return __builtin_bit_cast(float, w & 0xffff0000u); }
__device__ __forceinline__ float sigm(float x) { return __builtin_amdgcn_rcpf(1.f + __expf(-x)); }
__device__ __forceinline__ float siluf(float x) { return x * __builtin_amdgcn_rcpf(1.f + __expf(-x)); }
__device__ __forceinline__ float logsig(float x) { return fminf(x, 0.f) - log1pf(expf(-fabsf(x))); }
__device__ __forceinline__ float wave_sum(float v) {
#pragma unroll
    for (int o = 1; o < 64; o <<= 1) v += __shfl_xor(v, o);
    return v;
}

namespace pg8 {
#define PG8_LAS __attribute__((address_space(3)))
constexpr int BM = 256, BK = 64, HALF = 128, HTB = HALF * BK * 2, STAGE_BYTES = 8 * HTB, NXCD = 8, WGM = 8;
__host__ __device__ __forceinline__ int lds_byte(int r, int c) { const int st = (r >> 4) * 2 + (c >> 5), rr = r & 15, cc = c & 31, ob = rr * 64 + cc * 2; return st * 1024 + (ob ^ (((ob >> 9) & 1) << 5)); }
__host__ __device__ __forceinline__ void stage_rc(int b, int& R, int& C) { const int st = b / 1024, sb = b % 1024, swz = sb ^ (((sb >> 9) & 1) << 5); R = (st >> 1) * 16 + swz / 64; C = (st & 1) * 32 + (swz % 64) / 2; }
__host__ __device__ __forceinline__ int perm32(int rho) { const int n = rho >> 4, i = rho & 15; return 8 * (i >> 2) + 4 * n + (i & 3); }
struct Unit { int pm, pn, e; };
__device__ __forceinline__ unsigned cvt_pk_bf16(float lo, float hi) { return pkbf(lo, hi); }

struct DenseSched {
    static constexpr bool GATHER = false;
    const bf16* A; const bf16* Bt; int K, nM, nN, nwg, G, c;
    __device__ void init(const bf16* A_, const bf16* Bt_, int M, int N, int K_, int G_, int c_) { A = A_; Bt = Bt_; K = K_; nM = M / BM; nN = N / BM; nwg = nM * nN; G = G_; c = c_; }
    __device__ bool next(int i, Unit& u) const {
        const long L = (long)i * G + c; if (L >= nwg) return false;
        int wgid = (int)L; { const int q = nwg / NXCD, r = nwg % NXCD, xcd = wgid % NXCD, off = wgid / NXCD; wgid = (xcd < r ? xcd * (q + 1) : r * (q + 1) + (xcd - r) * q) + off; }
        const int nig = WGM * nN, gid = wgid / nig, fm = gid * WGM, gsz = (nM - fm) < WGM ? (nM - fm) : WGM;
        u.pm = fm + ((wgid % nig) % gsz); u.pn = (wgid % nig) / gsz; u.e = 0; return true;
    }
    __device__ __forceinline__ const char* a_base(const Unit& u) const { return (const char*)A + (size_t)u.pm * BM * K * 2; }
    __device__ __forceinline__ const char* b_base(const Unit& u) const { return (const char*)Bt + (size_t)u.pn * BM * K * 2; }
    __device__ __forceinline__ void a_offs(const Unit&, const int (&R)[2], const int (&C)[2], unsigned (&o)[2][2]) const {
#pragma unroll
        for (int h = 0; h < 2; ++h)
#pragma unroll
            for (int i = 0; i < 2; ++i) o[h][i] = (unsigned)((h * HALF + R[i]) * K + C[i]) * 2u;
    }
};
template <bool GATHER_> struct GroupSched {
    static constexpr bool GATHER = GATHER_;
    const bf16* A; const bf16* Bt; const int* list_tok; const PG8_LAS int* tab; int K, ntiles, G, c;
    __device__ bool next(int i, Unit& u) const {
        long L = (long)i * G + c;
        if (G == 256 && (long)(i + 1) * 256 <= (long)ntiles * 4) { const int xc = c & 7, j = c >> 3; L = (long)i * 256 + (long)(((xc << 3) | (j >> 2)) << 2) + (j & 3); }
        if (L >= (long)ntiles * 4) return false;
        u.pm = (int)(L >> 2); u.pn = (int)(L & 3); int e = 0; while (e < 15 && u.pm * BM >= tab[e + 1]) ++e; u.e = e; return true;
    }
    __device__ __forceinline__ const char* a_base(const Unit& u) const { return GATHER ? (const char*)A : (const char*)A + (size_t)u.pm * BM * K * 2; }
    __device__ __forceinline__ const char* b_base(const Unit& u) const { return (const char*)Bt + ((size_t)u.e * 1024 + (size_t)u.pn * BM) * K * 2; }
    __device__ __forceinline__ void a_offs(const Unit& u, const int (&R)[2], const int (&C)[2], unsigned (&o)[2][2]) const {
        const int pos0 = u.pm * BM - tab[u.e], cnt = tab[32 + u.e];
#pragma unroll
        for (int h = 0; h < 2; ++h)
#pragma unroll
            for (int i = 0; i < 2; ++i) {
                int row = h * HALF + R[i];
                if (GATHER) { const int pos = pos0 + row; const int pc = pos < cnt ? pos : 0; const int tk = list_tok[u.e * 32768 + pc]; row = pos < cnt ? tk : 0; }
                o[h][i] = (unsigned)(row * K + C[i]) * 2u; }
    }
};

template <class Epi, class Sched, bool ALIGN_EPI>
__device__ __forceinline__ void gemm_phase(PG8_LAS unsigned char* lds, const Sched& S, const Epi& E, const int wave_id) {
    int ln_ = (int)__builtin_amdgcn_mbcnt_hi(~0u, __builtin_amdgcn_mbcnt_lo(~0u, 0u)); asm volatile("" : "+v"(ln_));
    const int wid = wave_id, lane = ln_, tid = wid * 64 + lane, wr = wid >> 2, wc = wid & 3, fr = lane & 15, fq = lane >> 4;
    const int K = S.K, nt = K / BK;
    int Rr[2], Cc[2]; unsigned voffB[2];
#pragma unroll
    for (int i = 0; i < 2; ++i) { stage_rc(tid * 16 + i * 8192, Rr[i], Cc[i]); const int Rb = (Rr[i] & ~31) + perm32(Rr[i] & 31); voffB[i] = (unsigned)(Rb * K + Cc[i]) * 2u; }
    const size_t kstep = (size_t)(BK * 2);
    const size_t hstep = (size_t)HALF * K * 2;
    const unsigned ldsw = (unsigned)wid * 1024u;
    const int aoff = lds_byte(wr * 64 + fr, fq * 8), boff = lds_byte(wc * 32 + fr, fq * 8);
#define PG8_SA(b, h) (((b) * 2 + (h)) * HTB)
#define PG8_SB(b, h) ((4 + (b) * 2 + (h)) * HTB)
#define PG8_STAGE(bufoff, gbase, voff) do { _Pragma("unroll") for (int _i = 0; _i < 2; ++_i) \
        __builtin_amdgcn_global_load_lds((const unsigned*)((const char*)(gbase) + (voff)[_i]), (PG8_LAS unsigned*)(lds + (bufoff) + ldsw + _i * 8192), 16, 0, 0); } while (0)
#define PG8_LDA(dst, b, h) do { _Pragma("unroll") for (int m = 0; m < 4; ++m) _Pragma("unroll") for (int k = 0; k < 2; ++k) dst[m][k] = *(const PG8_LAS bf16x8*)(lds + PG8_SA(b, h) + aoff + m * 2048 + k * 1024); } while (0)
#define PG8_LDB(dst, b, h) do { _Pragma("unroll") for (int n = 0; n < 2; ++n) _Pragma("unroll") for (int k = 0; k < 2; ++k) dst[n][k] = *(const PG8_LAS bf16x8*)(lds + PG8_SB(b, h) + boff + n * 2048 + k * 1024); } while (0)
#define PG8_MMA(ai, bj, At, Bt) do { __builtin_amdgcn_s_setprio(1); _Pragma("unroll") for (int m = 0; m < 4; ++m) _Pragma("unroll") for (int n = 0; n < 2; ++n) _Pragma("unroll") for (int k = 0; k < 2; ++k) \
        acc[ai][bj][m][n] = __builtin_amdgcn_mfma_f32_16x16x32_bf16(Bt[n][k], At[m][k], acc[ai][bj][m][n], 0, 0, 0); __builtin_amdgcn_s_setprio(0); } while (0)
#define PG8_WAIT_V(n) asm volatile("s_waitcnt vmcnt(" #n ")" ::: "memory")
#define PG8_WAIT_L(n) asm volatile("s_waitcnt lgkmcnt(" #n ")" ::: "memory")
#define PG8_BAR __builtin_amdgcn_s_barrier()
#define PG8_SCHED __builtin_amdgcn_sched_barrier(0)
    Unit cur, nxt; int ui = 0;
    if (!S.next(0, cur)) return;
    unsigned ao[2][2], nao[2][2];
    S.a_offs(cur, Rr, Cc, ao);
    f32x4 acc[2][2][4][2];
#pragma unroll
    for (int a = 0; a < 2; ++a)
#pragma unroll
        for (int b = 0; b < 2; ++b)
#pragma unroll
            for (int m = 0; m < 4; ++m)
#pragma unroll
                for (int n = 0; n < 2; ++n) acc[a][b][m][n] = (f32x4){0.f, 0.f, 0.f, 0.f};
    bf16x8 At[4][2], B0[2][2], B1[2][2];
    const char* cA = S.a_base(cur); const char* cB = S.b_base(cur);
    PG8_STAGE(PG8_SB(0, 0), cB, voffB); PG8_STAGE(PG8_SB(0, 1), cB + hstep, voffB); PG8_STAGE(PG8_SA(0, 0), cA, ao[0]); PG8_STAGE(PG8_SA(0, 1), cA, ao[1]);
    if (wr == 1) PG8_BAR;
    PG8_WAIT_V(2); PG8_BAR;
    PG8_STAGE(PG8_SB(1, 0), cB + kstep, voffB); PG8_STAGE(PG8_SA(1, 0), cA + kstep, ao[0]); PG8_STAGE(PG8_SB(1, 1), cB + hstep + kstep, voffB);
    PG8_WAIT_V(6); PG8_BAR;
    for (;;) {
        const bool has_next = S.next(ui + 1, nxt);
        if (Sched::GATHER && has_next) S.a_offs(nxt, Rr, Cc, nao);
        else {
#pragma unroll
            for (int h = 0; h < 2; ++h)
#pragma unroll
                for (int i = 0; i < 2; ++i) nao[h][i] = ao[h][i]; }
        const char* nA = has_next ? S.a_base(nxt) : cA; const char* nB = has_next ? S.b_base(nxt) : cB;
        for (int t = 0; t < nt; t += 2) {
            const bool last = (t == nt - 2);
            const char* a1 = cA + (size_t)(t + 1) * kstep;
            const char* a2 = last ? nA : cA + (size_t)(t + 2) * kstep; const char* b2 = last ? nB : cB + (size_t)(t + 2) * kstep;
            const char* a3 = a2 + kstep; const char* b3 = b2 + kstep;
            unsigned o2[2][2];
#pragma unroll
            for (int h = 0; h < 2; ++h)
#pragma unroll
                for (int i = 0; i < 2; ++i) o2[h][i] = (Sched::GATHER && last) ? nao[h][i] : ao[h][i];
            PG8_LDB(B0, 0, 0); PG8_LDB(B1, 0, 1); PG8_SCHED; PG8_LDA(At, 0, 0); PG8_STAGE(PG8_SA(1, 1), a1, ao[1]);
            PG8_WAIT_V(8); PG8_WAIT_L(0); PG8_BAR; PG8_MMA(0, 0, At, B0); PG8_MMA(0, 1, At, B1); PG8_BAR; PG8_SCHED;
            PG8_LDA(At, 0, 1); PG8_STAGE(PG8_SB(0, 0), b2, voffB); PG8_STAGE(PG8_SB(0, 1), b2 + hstep, voffB); PG8_STAGE(PG8_SA(0, 0), a2, o2[0]);
            PG8_WAIT_V(8); PG8_WAIT_L(0); PG8_BAR; PG8_MMA(1, 0, At, B0); PG8_MMA(1, 1, At, B1); PG8_BAR; PG8_SCHED;
            PG8_LDB(B0, 1, 0); PG8_LDB(B1, 1, 1); PG8_SCHED; PG8_LDA(At, 1, 0); PG8_STAGE(PG8_SA(0, 1), a2, o2[1]);
            PG8_WAIT_V(8); PG8_WAIT_L(0); PG8_BAR; PG8_MMA(0, 0, At, B0); PG8_MMA(0, 1, At, B1); PG8_BAR; PG8_SCHED;
            PG8_LDA(At, 1, 1); PG8_STAGE(PG8_SB(1, 0), b3, voffB); PG8_STAGE(PG8_SB(1, 1), b3 + hstep, voffB); PG8_STAGE(PG8_SA(1, 0), a3, o2[0]);
            PG8_WAIT_V(8); PG8_WAIT_L(0); PG8_BAR; PG8_MMA(1, 0, At, B0); PG8_MMA(1, 1, At, B1); PG8_BAR; PG8_SCHED;
        }
        if constexpr (ALIGN_EPI) { if (wr == 0) PG8_BAR; }
#ifdef PROBE_SEL
        const unsigned long long pe0_ = __builtin_amdgcn_s_memrealtime();
#endif
        { int fr_ = fr, fq_ = fq; asm volatile("" : "+v"(fr_), "+v"(fq_));
          E(acc, cur, wr, wc, fr_, fq_); }
#ifdef PROBE_SEL
        { const unsigned long long pe1_ = __builtin_amdgcn_s_memrealtime(); volatile PG8_LAS unsigned* M_ = (volatile PG8_LAS unsigned*)(lds + 147456 - 1024 + 320); if (tid == 0 && M_[64] && PROBE_SEL < 40) M_[65] += (unsigned)(pe1_ - pe0_); }
#endif
        if (!has_next) break;
#pragma unroll
        for (int a = 0; a < 2; ++a)
#pragma unroll
            for (int b = 0; b < 2; ++b)
#pragma unroll
                for (int m = 0; m < 4; ++m)
#pragma unroll
                    for (int n = 0; n < 2; ++n) acc[a][b][m][n] = (f32x4){0.f, 0.f, 0.f, 0.f};
        cur = nxt; cA = nA; cB = nB; ++ui;
#pragma unroll
        for (int h = 0; h < 2; ++h)
#pragma unroll
            for (int i = 0; i < 2; ++i) ao[h][i] = nao[h][i];
        if constexpr (ALIGN_EPI) { if (wr == 1) PG8_BAR; }
    }
    PG8_WAIT_V(0);
    if constexpr (!ALIGN_EPI) { if (wr == 0) PG8_BAR; }
    PG8_BAR;
#undef PG8_SA
#undef PG8_SB
#undef PG8_STAGE
#undef PG8_LDA
#undef PG8_LDB
#undef PG8_MMA
#undef PG8_WAIT_V
#undef PG8_WAIT_L
#undef PG8_BAR
#undef PG8_SCHED
}
}
using pg8::Unit; using pg8::cvt_pk_bf16;

#define XB_TMO      128
#define XB_XCNT(j)  (256  + 64 * (j))
#define XB_XSUB(j)  (1280 + 64 * (j))
#define XB_XGEN(j)  (2304 + 64 * (j))
#define XB_TOP      3328
#define XB_TOPGEN   3392
#define XCD_BAR_WORDS 3456
#define XB_SPIN_CAP (1u << 18)
__device__ __forceinline__ unsigned xb_ld(unsigned* p)              { return __hip_atomic_load(p, __ATOMIC_RELAXED, __HIP_MEMORY_SCOPE_AGENT); }
__device__ __forceinline__ unsigned xb_add(unsigned* p, unsigned v) { return __hip_atomic_fetch_add(p, v, __ATOMIC_RELAXED, __HIP_MEMORY_SCOPE_AGENT); }
__device__ __forceinline__ unsigned xb_xcc_id() { return (unsigned)__builtin_amdgcn_s_getreg((3 << 11) | 20) & 0xFu; }
#define XB_SPIN(cond, bar) do { unsigned _sp = 0; while (cond) { __builtin_amdgcn_s_sleep(1); \
    if ((++_sp & 255u) == 0u) { if (xb_ld(&(bar)[XB_TMO])) break; if (_sp > XB_SPIN_CAP) { atomicAdd(&(bar)[XB_TMO], 1u); break; } } } } while (0)
struct XcdBarrier { unsigned* bar; unsigned x; volatile LAS unsigned* st; };
__device__ __forceinline__ XcdBarrier xcd_barrier_post(unsigned* bar, volatile LAS unsigned* st) {
    XcdBarrier b; b.bar = bar; b.x = xb_xcc_id(); b.st = st;
    if (threadIdx.x == 0) (void)xb_add(&bar[XB_XCNT(b.x)], 1u);
    return b;
}
__device__ __forceinline__ void xcd_barrier_complete(unsigned* bar, unsigned x, unsigned& nloc, unsigned& nx) {
    const unsigned G = gridDim.x * gridDim.y * gridDim.z;
    unsigned sum, cnt, mine, sp = 0u;
    for (;;) {
        sum = 0u; cnt = 0u; mine = 0u;
#pragma unroll
        for (unsigned j = 0; j < 16; ++j) { const unsigned c = xb_ld(&bar[XB_XCNT(j)]); sum += c; cnt += (c > 0u) ? 1u : 0u; mine = (j == x) ? c : mine; }
        if (sum == G) break;
        __builtin_amdgcn_s_sleep(1);
        if ((++sp & 255u) == 0u) { if (xb_ld(&bar[XB_TMO])) break; if (sp > XB_SPIN_CAP) { atomicAdd(&bar[XB_TMO], 1u); break; } }
    }
    nloc = mine > 0u ? mine : 1u; nx = cnt > 0u ? cnt : 1u;
}
__device__ __forceinline__ void xcd_barrier(const XcdBarrier& b, const int tid) {
    asm volatile("s_waitcnt vmcnt(0)" ::: "memory");
    __syncthreads();
    if (tid == 0) {
        unsigned* bar = b.bar;
        __builtin_amdgcn_s_waitcnt(0);
        unsigned nloc = b.st[0], nx = b.st[1];
        if (nloc == 0u) { xcd_barrier_complete(bar, b.x, nloc, nx); b.st[0] = nloc; b.st[1] = nx; }
        const unsigned old = xb_add(&bar[XB_XSUB(b.x)], 1u);
        const unsigned gen = old / nloc;
        if (old + 1u == (gen + 1u) * nloc) {
            __builtin_amdgcn_fence(__ATOMIC_RELEASE, "agent");
            asm volatile("s_waitcnt vmcnt(0)" ::: "memory");
            const unsigned og = xb_add(&bar[XB_TOP], 1u);
            const unsigned tg = og / nx;
            if (og + 1u == (tg + 1u) * nx) xb_add(&bar[XB_TOPGEN], 1u);
            else XB_SPIN(xb_ld(&bar[XB_TOPGEN]) == tg, bar);
            __builtin_amdgcn_fence(__ATOMIC_ACQUIRE, "agent");
            xb_add(&bar[XB_XGEN(b.x)], 1u);
            asm volatile("s_waitcnt vmcnt(0)" ::: "memory");
        } else {
            XB_SPIN(xb_ld(&bar[XB_XGEN(b.x)]) == gen, bar);
            __builtin_amdgcn_fence(__ATOMIC_ACQUIRE, "agent");
            asm volatile("s_waitcnt vmcnt(0)" ::: "memory");
        }
    }
    __syncthreads();
}

constexpr int RING_BYTES = 131072;
constexpr int LDS_BYTES = 147456;
constexpr int LDSCTL_OFF = LDS_BYTES - 1024, MISC_OFF = LDSCTL_OFF + 320;

struct Args { const float* in[26]; float* out; unsigned char* ws; int ph_lo, ph_hi; };
struct Frame {
    LAS unsigned char* lds; volatile LAS unsigned* MISC;
    int tid, lane, wave, G, bid;
    unsigned char* ws; float* out;
    const float *x, *c, *ctx, *c_ctx, *w_mod, *b_mod, *g_norm1, *w_in, *ml_conv, *ml_conv_b, *b_mgate, *ml_norm, *gla_w2, *gla_b2, *gla_norm,
                *w_proj_m, *w_proj_g, *w_out, *g_norm2, *w_grp, *b_grp, *w_rexp, *b_rexp, *w_up, *w_down, *g_final;
};
template <class T> __device__ __forceinline__ T* wsp(const Frame& F, size_t off) { return (T*)(F.ws + off); }

struct TItem { const float* W; bf16* WT; int Nsrc, K, k0, n0, sc; };
__device__ __forceinline__ int map_a(int n) { return n < 2048 ? n : (n < 4096 ? n + 1040 : (n < 4112 ? 3072 + (n - 4096) : (n < 4144 ? 6160 + (n - 4112) : -1))); }
__device__ __forceinline__ int map_b(int n) { return n < 1024 ? 2048 + n : (n < 2048 ? 5136 + (n - 1024) : (n < 3072 ? 6192 + (n - 2048) : 7216 + (n - 3072))); }
__device__ __forceinline__ int map_up(int n) { const int pn = n >> 8, j = n & 255; return j < 128 ? 128 * pn + j : 512 + 128 * pn + (j - 128); }
__device__ __forceinline__ void titem_load(const TItem& t, int lane, f32x4 (&v)[8]) {
    const int scc = t.sc < 0 ? 0 : t.sc;
#pragma unroll
    for (int r = 0; r < 8; ++r) v[r] = *(const f32x4*)(t.W + (size_t)(t.k0 + 8 * r + (lane >> 3)) * t.Nsrc + scc);
}
__device__ __forceinline__ void titem_store(const TItem& t, int lane, const f32x4 (&v)[8], LAS float* scr) {
    const float z = t.sc < 0 ? 0.f : 1.f;
#pragma unroll
    for (int r = 0; r < 8; ++r) { const int kk = 8 * r + (lane >> 3); LAS float* d = scr + kk * 33 + 4 * (lane & 7); d[0] = v[r][0] * z; d[1] = v[r][1] * z; d[2] = v[r][2] * z; d[3] = v[r][3] * z; }
    LDS_WAIT(); asm volatile("" ::: "memory");
    const int c = lane & 7;
#pragma unroll
    for (int j = 0; j < 4; ++j) { const int n = (lane >> 3) + 8 * j; const LAS float* s = scr + (8 * c) * 33 + n;
        u32x4 o; o.x = pk2(s[0 * 33], s[1 * 33]); o.y = pk2(s[2 * 33], s[3 * 33]); o.z = pk2(s[4 * 33], s[5 * 33]); o.w = pk2(s[6 * 33], s[7 * 33]);
        *(u32x4*)(t.WT + (size_t)(t.n0 + n) * t.K + t.k0 + 8 * c) = o; }
    LDS_WAIT(); asm volatile("" ::: "memory");
}
template <class Dec>
__device__ __forceinline__ void run_transposes(Frame& F, int nitems, Dec dec, const int skip = 0) {
    LAS float* scr = (LAS float*)(F.lds + F.wave * 16384);
    if (F.bid < skip) return;
    const int gw = (F.bid - skip) * NW + F.wave, NGW = (F.G - skip) * NW, last = nitems - 1;
    if (gw >= nitems) return;
    f32x4 va[8], vb[8]; TItem ia, ib;
    ia = dec(gw, F.lane); titem_load(ia, F.lane, va);
    for (int it = gw; it < nitems; it += 2 * NGW) {
        { const int j = it + NGW; ib = dec(j < last ? j : last, F.lane); titem_load(ib, F.lane, vb); }
        titem_store(ia, F.lane, va, scr);
        { const int j = it + 2 * NGW; ia = dec(j < last ? j : last, F.lane); titem_load(ia, F.lane, va); }
        if (it + NGW < nitems) titem_store(ib, F.lane, vb, scr);
    }
}
__device__ __forceinline__ void p0_prologue(Frame& F) {
    LAS float* scr = (LAS float*)(F.lds + F.wave * 16384);
    const int gw = F.bid * NW + F.wave, NGW = F.G * NW;
    if (F.bid < 192) {
        LAS float* red = (LAS float*)(F.lds);
        const int r = F.tid >> 3, c4 = F.tid & 7, col0 = F.bid * 32 + 4 * c4;
        f32x4 a0 = {0.f, 0.f, 0.f, 0.f}, a1 = a0, a2 = a0;
        for (int k = r; k < D; k += 64) {
            const f32x4 w = *(const f32x4*)(F.w_mod + (size_t)k * 6144 + col0);
            const float s0 = siluf(F.c[k]), s1 = siluf(F.c[D + k]), s2 = siluf(F.c_ctx[k]);
            a0 += w * s0; a1 += w * s1; a2 += w * s2; }
#pragma unroll
        for (int j = 0; j < 4; ++j) { red[r * 96 + 0 + 4 * c4 + j] = a0[j]; red[r * 96 + 32 + 4 * c4 + j] = a1[j]; red[r * 96 + 64 + 4 * c4 + j] = a2[j]; }
        __syncthreads();
        if (F.tid < 96) { float s = 0.f; for (int q = 0; q < 64; ++q) s += red[q * 96 + F.tid]; const int rr = F.tid >> 5, j = F.bid * 32 + (F.tid & 31);
            wsp<float>(F, WS_MODV)[rr * 6144 + j] = s + F.b_mod[j]; }
        __syncthreads();
    }
}
template <int PART>
__device__ __forceinline__ void p0_weight_copies(Frame& F, const int skip = 0) {
    constexpr int I_A = (NA / 32) * 16, I_B = (NB / 32) * 16, I_P = (1024 / 32) * 16;
    const float* w_in = F.w_in; const float* wpm = F.w_proj_m; const float* wpg = F.w_proj_g; const float* wo = F.w_out; unsigned char* ws = F.ws;
    run_transposes(F, PART == 0 ? I_A : I_B + 3 * I_P, [=](int it, int lane) {
        TItem t; t.K = D; const int r = PART == 0 ? it : it + I_A;
        const bool isA = r < I_A, isB = !isA && r < I_A + I_B; const int rp = r - I_A - I_B, pi = rp < 0 ? 0 : rp / I_P;
        const int rr = isA ? r : (isB ? r - I_A : rp - pi * I_P);
        t.k0 = 64 * (rr & 15); t.n0 = 32 * (rr >> 4); const int n = t.n0 + 4 * (lane & 7);
        t.W = (isA || isB) ? w_in : (pi == 0 ? wpm : (pi == 1 ? wpg : wo)); t.Nsrc = (isA || isB) ? IN_W : D;
        t.WT = (bf16*)(ws + (isA ? WS_WA : (isB ? WS_WB : (pi == 0 ? WS_WPM : (pi == 1 ? WS_WPG : WS_WOUT)))));
        t.sc = isA ? map_a(n) : (isB ? map_b(n) : n);
        return t; }, skip);
}
template <int PART>
__device__ __forceinline__ void moe_weight_copies(Frame& F, const int skip = 0) {
    constexpr int I_U = (1024 / 32) * 16  , I_D = (1024 / 32) * 8;
    const float* wup = F.w_up; const float* wdn = F.w_down; unsigned char* ws = F.ws;
    run_transposes(F, NEXP * (PART == 0 ? I_U : I_D), [=](int it, int lane) {
        TItem t; constexpr bool up = PART == 0; const int e = it / (up ? I_U : I_D), rr = it % (up ? I_U : I_D);
        t.K = up ? 1024 : 512; t.Nsrc = 1024;
        t.k0 = up ? 64 * (rr & 15) : 64 * (rr & 7); t.n0 = up ? 32 * (rr >> 4) : 32 * (rr >> 3); const int n = t.n0 + 4 * (lane & 7);
        t.W = up ? wup + (size_t)e * 1024 * 1024 : wdn + (size_t)e * 512 * 1024;
        t.WT = up ? (bf16*)(ws + WS_WUP) + (size_t)e * 1024 * 1024 : (bf16*)(ws + WS_WDN) + (size_t)e * 1024 * 512;
        t.sc = up ? map_up(n) : n;
        return t; }, skip);
}

__device__ __forceinline__ void p1_hx(Frame& F) {
    const int gw = F.bid * NW + F.wave, NGW = F.G * NW;
    const float* modv = wsp<float>(F, WS_MODV);
    for (int m = gw; m < MT; m += 2 * NGW) {
        const int m2 = m + NGW < MT ? m + NGW : m;
        const float* src[2] = {m < M_LAT ? F.x + (size_t)m * D : F.ctx + (size_t)(m - M_LAT) * D, m2 < M_LAT ? F.x + (size_t)m2 * D : F.ctx + (size_t)(m2 - M_LAT) * D};
        const float* mv[2] = {modv + (m < M_LAT ? (m >> 13) : 2) * 6144, modv + (m2 < M_LAT ? (m2 >> 13) : 2) * 6144};
        f32x4 v[2][4]; float s[2] = {0.f, 0.f};
#pragma unroll
        for (int r = 0; r < 2; ++r)
#pragma unroll
            for (int j = 0; j < 4; ++j) v[r][j] = *(const f32x4*)(src[r] + 4 * F.lane + 256 * j);
#pragma unroll
        for (int r = 0; r < 2; ++r)
#pragma unroll
            for (int j = 0; j < 4; ++j) s[r] += (v[r][j].x * v[r][j].x + v[r][j].y * v[r][j].y) + (v[r][j].z * v[r][j].z + v[r][j].w * v[r][j].w);
#pragma unroll
        for (int r = 0; r < 2; ++r) {
            const float rstd = 1.f / sqrtf(wave_sum(s[r]) * (1.f / D) + EPS);
            bf16* o = wsp<bf16>(F, WS_HX) + (size_t)(r == 0 ? m : m2) * D;
#pragma unroll
            for (int j = 0; j < 4; ++j) { const int c = 4 * F.lane + 256 * j;
                const f32x4 g = *(const f32x4*)(F.g_norm1 + c), sh = *(const f32x4*)(mv[r] + c), sc = *(const f32x4*)(mv[r] + 1024 + c);
                const f32x4 h = (v[r][j] * rstd) * g * (sc + 1.f) + sh;
                u32x2 w; w.x = pk2(h.x, h.y); w.y = pk2(h.z, h.w); *(u32x2*)(o + c) = w; } }
    }
}

struct EpiProjA {
    unsigned char* ws; const float* b_mgate;
    __device__ __forceinline__ void operator()(const f32x4 (&acc)[2][2][4][2], const Unit& u, int wr, int wc, int fr, int fq) const {
        const int row0 = u.pm * 256 + wr * 64 + fr;
        if (u.pn < 16) {
            bf16* base = (bf16*)(ws + WS_QKM + (size_t)(u.pn >> 2) * BIG) + (u.pn & 3) * 256 + wc * 32 + 8 * fq;
#pragma unroll
            for (int ai = 0; ai < 2; ++ai)
#pragma unroll
                for (int m = 0; m < 4; ++m) { bf16* rowp = base + (size_t)(row0 + ai * 128 + m * 16) * 1024;
#pragma unroll
                    for (int bj = 0; bj < 2; ++bj) { const f32x4 v0 = acc[ai][bj][m][0], v1 = acc[ai][bj][m][1];
                        u32x4 w; w.x = cvt_pk_bf16(v0[0], v0[1]); w.y = cvt_pk_bf16(v0[2], v0[3]); w.z = cvt_pk_bf16(v1[0], v1[1]); w.w = cvt_pk_bf16(v1[2], v1[3]);
                        *(u32x4*)(rowp + bj * 128) = w; } }
        } else if (wc < 2) {
            const int col = wc * 32 + 8 * fq;
            float* g = (float*)(ws + WS_GATES);
            f32x4 b0 = {0.f, 0.f, 0.f, 0.f}, b1 = b0;
            if (col < 16) { b0 = *(const f32x4*)(b_mgate + col); b1 = *(const f32x4*)(b_mgate + col + 4); }
#pragma unroll
            for (int ai = 0; ai < 2; ++ai)
#pragma unroll
                for (int m = 0; m < 4; ++m) { float* rowp = g + (size_t)(row0 + ai * 128 + m * 16) * 64 + col;
                    *(f32x4*)rowp = acc[ai][0][m][0] + b0; *(f32x4*)(rowp + 4) = acc[ai][0][m][1] + b1; }
        }
    }
};

__device__ __forceinline__ int chunk_row0(int ci) { return ci < 256 ? (ci >> 7) * SEQ + (ci & 127) * 64 : M_LAT + ((ci - 256) >> 2) * CTXL + ((ci - 256) & 3) * 64; }
__device__ __forceinline__ bf16* qkgt_row(const Frame& F, int dir, int m) {
    return m < M_LAT ? (bf16*)F.out + ((size_t)dir * M_LAT + m) * 1024 : wsp<bf16>(F, WS_QKGTC) + ((size_t)dir * M_CTX + (m - M_LAT)) * 1024;
}
__device__ __forceinline__ float logsig_fast(float x) { return fminf(x, 0.f) - __logf(1.f + __expf(-fabsf(x))); }
__device__ __forceinline__ void unpack8(const u32x4& v, float (&f)[8]) { f[0] = bflo(v.x); f[1] = bfhi(v.x); f[2] = bflo(v.y); f[3] = bfhi(v.y); f[4] = bflo(v.z); f[5] = bfhi(v.z); f[6] = bflo(v.w); f[7] = bfhi(v.w); }
__device__ __forceinline__ void p3_prep(Frame& F) {
    const bf16* QKM = wsp<bf16>(F, WS_QKM); bf16* QKMC = wsp<bf16>(F, WS_QKMC); const float* GATES = wsp<float>(F, WS_GATES); const bf16* QKG = wsp<bf16>(F, WS_QKG);
    for (int it = F.bid; it < NCHUNK * 3; it += F.G) {
        int tidl = F.tid; asm volatile("" : "+v"(tidl));
        const int lanel = tidl & 63;
        if (it < NCHUNK) {
            const int ci = F.G == 256 ? (it < 256 ? (it & 7) * 33 + (it >> 3) : (it - 256) * 33 + 32) : it, m0 = chunk_row0(ci);
            const int cg = tidl & 127, cq = tidl >> 7, ch = 8 * cg;
            const bool lat = ci < 256; const int c = lat ? (ci & 127) : ((ci - 256) & 3);
            const bool has_up = lat && c > 0, has_dn = lat && c < 127;
            const float osc = ch >= 512 ? 0.08838834764831845f : 1.f;
            f32x4 bz0 = *(const f32x4*)(F.ml_conv_b + ch), bz1 = *(const f32x4*)(F.ml_conv_b + ch + 4);
            f32x4 cw0[9], cw1[9];
#pragma unroll
            for (int q = 0; q < 9; ++q) { cw0[q] = *(const f32x4*)(F.ml_conv + q * 1024 + ch); cw1[q] = *(const f32x4*)(F.ml_conv + q * 1024 + ch + 4); }
            const f32x4 z4 = {0.f, 0.f, 0.f, 0.f};
#pragma unroll
            for (int q = 0; q < 3; ++q) { if (!has_up) { cw0[q] = z4; cw1[q] = z4; } if (!has_dn) { cw0[6 + q] = z4; cw1[6 + q] = z4; } }
            const int collo = lat ? 0 : (c == 0 ? 0 : -1), colhi = lat ? 63 : (c == 3 ? 63 : 64);
            const bf16* rb0 = QKM + (size_t)(has_up ? m0 - 64 : m0) * 1024 + ch; const bf16* rb1 = QKM + (size_t)m0 * 1024 + ch; const bf16* rb2 = QKM + (size_t)(has_dn ? m0 + 64 : m0) * 1024 + ch;
            auto ldc = [&](int dr, int col) -> u32x4 { const int cc = min(max(col, collo), colhi); const bf16* rb = dr == 0 ? rb0 : dr == 1 ? rb1 : rb2; return *(const u32x4*)(rb + (ptrdiff_t)cc * 1024); };
            const u32x4 zu = {0u, 0u, 0u, 0u};
            int cc = cq * 16;
            u32x4 w0[3], w1[3], n0[3], n1[3];
#pragma unroll
            for (int dr = 0; dr < 3; ++dr) { const u32x4 v = ldc(dr, cc - 1); w0[dr] = cc - 1 >= collo ? v : zu; w1[dr] = ldc(dr, cc); n0[dr] = ldc(dr, cc + 1); n1[dr] = ldc(dr, cc + 2); }
#pragma unroll 1
            for (int cb = 0; cb < 8; ++cb, cc += 2) {
                u32x4 p0[3], p1[3];
#pragma unroll
                for (int dr = 0; dr < 3; ++dr) { p0[dr] = ldc(dr, cc + 3); p1[dr] = ldc(dr, cc + 4); }
                __builtin_amdgcn_sched_barrier(0);
                float acc[2][8];
#pragma unroll
                for (int oc = 0; oc < 2; ++oc) { acc[oc][0] = bz0[0]; acc[oc][1] = bz0[1]; acc[oc][2] = bz0[2]; acc[oc][3] = bz0[3]; acc[oc][4] = bz1[0]; acc[oc][5] = bz1[1]; acc[oc][6] = bz1[2]; acc[oc][7] = bz1[3]; }
#pragma unroll
                for (int dr = 0; dr < 3; ++dr)
#pragma unroll
                    for (int dc = 0; dc < 4; ++dc) { float f[8]; unpack8(dc == 0 ? w0[dr] : dc == 1 ? w1[dr] : dc == 2 ? n0[dr] : n1[dr], f);
#pragma unroll
                        for (int oc = 0; oc < 2; ++oc) { const int t = dc - oc; if (t < 0 || t > 2) continue; const f32x4 k0 = cw0[dr * 3 + t], k1 = cw1[dr * 3 + t];
                            acc[oc][0] += k0[0] * f[0]; acc[oc][1] += k0[1] * f[1]; acc[oc][2] += k0[2] * f[2]; acc[oc][3] += k0[3] * f[3]; acc[oc][4] += k1[0] * f[4]; acc[oc][5] += k1[1] * f[5]; acc[oc][6] += k1[2] * f[6]; acc[oc][7] += k1[3] * f[7]; } }
#pragma unroll
                for (int oc = 0; oc < 2; ++oc) { u32x4 o; o.x = pk2(siluf(acc[oc][0]) * osc, siluf(acc[oc][1]) * osc); o.y = pk2(siluf(acc[oc][2]) * osc, siluf(acc[oc][3]) * osc);
                    o.z = pk2(siluf(acc[oc][4]) * osc, siluf(acc[oc][5]) * osc); o.w = pk2(siluf(acc[oc][6]) * osc, siluf(acc[oc][7]) * osc);
                    *(u32x4*)(QKMC + (size_t)(m0 + cc + oc) * 1024 + ch) = o; }
                __builtin_amdgcn_sched_barrier(0);
                const bool k0 = cc + 3 <= colhi, k1 = cc + 4 <= colhi;
#pragma unroll
                for (int dr = 0; dr < 3; ++dr) { w0[dr] = n0[dr]; w1[dr] = n1[dr]; n0[dr] = k0 ? p0[dr] : zu; n1[dr] = k1 ? p1[dr] : zu; }
            }
            {
                const int dir = F.wave >> 2, h = F.wave & 3, m = m0 + lanel;
                const float ip = GATES[(size_t)m * 64 + dir * 8 + h], lf = logsig(GATES[(size_t)m * 64 + dir * 8 + 4 + h]);
                float b = lf;
#pragma unroll
                for (int o = 1; o < 64; o <<= 1) { const float t = dir == 0 ? __shfl_up(b, o) : __shfl_down(b, o); const bool ok = dir == 0 ? (lanel >= o) : (lanel + o < 64); if (ok) b += t; }
                f32x2 ab; ab.x = expf(b); ab.y = expf(ip - b);
                wsp<f32x2>(F, WS_AB)[((size_t)dir * MT + m) * 4 + h] = ab;
                if (lanel == (dir == 0 ? 63 : 0)) wsp<float>(F, WS_GENDM)[((size_t)dir * NCHUNK + ci) * 4 + h] = expf(b);
            }
        } else {
            const int gi0 = it - NCHUNK;
            const int gi = F.G == 256 ? ((((gi0 >> 4) << 3) | (gi0 & 7)) << 1) | ((gi0 >> 3) & 1) : gi0;
            const int ci = gi >> 1, dir = gi & 1, m0 = chunk_row0(ci);
            LAS float* lr = (LAS float*)F.lds;
            LAS float* Bl = (LAS float*)(F.lds + 4096);
            __syncthreads();
            for (int i = tidl; i < 1024; i += NTHR) lr[i] = GATES[(size_t)(m0 + (i >> 4)) * 64 + 16 + dir * 16 + (i & 15)];
            const int ch = tidl;
            f32x2 w2p[8];
#pragma unroll
            for (int r = 0; r < 8; ++r) { w2p[r].x = F.gla_w2[((size_t)dir * 16 + 2 * r) * 512 + ch]; w2p[r].y = F.gla_w2[((size_t)dir * 16 + 2 * r + 1) * 512 + ch]; }
            const float b2 = F.gla_b2[dir * 512 + ch];
            __syncthreads();
            float b = 0.f;
#pragma unroll 1
            for (int i0 = 0; i0 < 64; i0 += 4) {
                f32x4 l[4][4];
#pragma unroll
                for (int u = 0; u < 4; ++u) { const int r = dir == 0 ? i0 + u : 63 - i0 - u;
#pragma unroll
                    for (int q = 0; q < 4; ++q) l[u][q] = *(const LAS f32x4*)(lr + r * 16 + 4 * q); }
                float ls[4];
#pragma unroll
                for (int u = 0; u < 4; ++u) {
                    f32x2 a2 = {b2, 0.f};
#pragma unroll
                    for (int q = 0; q < 4; ++q) { a2 = __builtin_elementwise_fma((f32x2){l[u][q][0], l[u][q][1]}, w2p[2 * q], a2); a2 = __builtin_elementwise_fma((f32x2){l[u][q][2], l[u][q][3]}, w2p[2 * q + 1], a2); }
                    const float xg = a2.x + a2.y;
                    ls[u] = fminf(xg, 0.f) - 0.6931471805599453f * __builtin_amdgcn_logf(1.f + __builtin_amdgcn_exp2f(-1.4426950408889634f * fabsf(xg))); }
#pragma unroll
                for (int u = 0; u < 4; ++u) { const int r = dir == 0 ? i0 + u : 63 - i0 - u; b += ls[u] * (1.f / 16.f); Bl[r * 512 + ch] = b; }
            }
            wsp<float>(F, WS_GENDG)[((size_t)dir * NCHUNK + ci) * 512 + ch] = __expf(b);
            __syncthreads();
            u32x4 vin[16];
            const int cp = tidl & 127, r0 = tidl >> 7; const bool isk = cp >= 64;
            const float sg = isk ? -1.4426950408889634f : 1.4426950408889634f, eoff = isk ? 0.f : -3.5f;
            const bf16* irow = QKG + (size_t)(m0 + r0) * 1024 + cp * 8; bf16* orow = qkgt_row(F, dir, m0) + (size_t)r0 * 1024 + cp * 8;
            const LAS float* brow = Bl + r0 * 512 + 8 * (cp & 63);
#pragma unroll
            for (int j = 0; j < 16; ++j) vin[j] = *(const u32x4*)(irow + (size_t)j * 4096);
#pragma unroll
            for (int j = 0; j < 16; ++j) {
                const u32x4 v = vin[j];
                const f32x4 b0 = *(const LAS f32x4*)(brow + j * 2048), b1 = *(const LAS f32x4*)(brow + j * 2048 + 4);
                float f[8]; unpack8(v, f); float e[8];
#pragma unroll
                for (int q = 0; q < 4; ++q) { e[q] = __builtin_amdgcn_exp2f(__builtin_fmaf(b0[q], sg, eoff)); e[4 + q] = __builtin_amdgcn_exp2f(__builtin_fmaf(b1[q], sg, eoff)); }
                u32x4 o; o.x = pk2(f[0] * e[0], f[1] * e[1]); o.y = pk2(f[2] * e[2], f[3] * e[3]); o.z = pk2(f[4] * e[4], f[5] * e[5]); o.w = pk2(f[6] * e[6], f[7] * e[7]);
                *(u32x4*)(orow + (size_t)j * 4096) = o; }
        }
    }
}

constexpr int L_AQ = 0, L_AK = 16384, L_VP = 32768, L_P = 49152, L_S = 65536, L_N = 131072 + 1024  ;
struct ScanSrc { const bf16* q; const bf16* k; const bf16* v; const f32x2* ab; const float* gend; int gstride; };
__device__ __forceinline__ int seg_chunk(int seg, int dir, int i) {
    if (seg < 0) return dir == 0 ? i : 3 - i;
    return dir == 0 ? seg * CPS + i : (NCH_LAT - 1 - seg * CPS) - i;
}
__device__ __forceinline__ void scan_stage(Frame& F, int model, int b, int h, int dir, int half, int ci, bool need_q) {
    const int m0 = chunk_row0(ci);
    LAS float* nb = (LAS float*)(F.lds + L_N);
    if (model == 0 && F.tid < 64) { const f32x2 ab = wsp<f32x2>(F, WS_AB)[((size_t)dir * MT + m0 + F.tid) * 4 + h]; nb[256 + F.tid] = ab.y; nb[320 + F.tid] = ab.x; }
    if (F.tid >= 64 && F.tid < 192) { const int dk = F.tid - 64;
        nb[128 + dk] = model == 0 ? wsp<float>(F, WS_GENDM)[((size_t)dir * NCHUNK + ci) * 4 + h] : wsp<float>(F, WS_GENDG)[((size_t)dir * NCHUNK + ci) * 512 + h * 128 + dk]; }
#pragma unroll
    for (int i = 0; i < 2; ++i) { const int p = F.tid + i * 512, r = p >> 4, cpart = p & 15, m = m0 + r;
        const bf16* qrow; const bf16* vrow;
        if (model == 0) { qrow = wsp<bf16>(F, WS_QKMC) + (size_t)m * 1024; vrow = wsp<bf16>(F, WS_VM) + (size_t)m * 1024; }
        else { qrow = qkgt_row(F, dir, m); vrow = wsp<bf16>(F, WS_VG) + (size_t)m * 1024; }
        if (need_q) *(LAS u32x4*)(F.lds + L_AQ + r * 256 + cpart * 16) = *(const u32x4*)(qrow + h * 128 + cpart * 8);
        *(LAS u32x4*)(F.lds + L_AK + r * 256 + cpart * 16) = *(const u32x4*)(qrow + 512 + h * 128 + cpart * 8);
        u32x4 v = *(const u32x4*)(vrow + h * 256 + half * 128 + cpart * 8);
        if (model == 0) { const float be = wsp<f32x2>(F, WS_AB)[((size_t)dir * MT + m) * 4 + h].y;
            v.x = pk2(bflo(v.x) * be, bfhi(v.x) * be); v.y = pk2(bflo(v.y) * be, bfhi(v.y) * be); v.z = pk2(bflo(v.z) * be, bfhi(v.z) * be); v.w = pk2(bflo(v.w) * be, bfhi(v.w) * be); }
        *(LAS u32x4*)(F.lds + L_VP + r * 256 + cpart * 16) = v; }
}
__device__ __forceinline__ void scan_update(Frame& F, int model) {
    LAS float* S = (LAS float*)(F.lds + L_S); LAS float* nb = (LAS float*)(F.lds + L_N);
    const LAS bf16* AK = (const LAS bf16*)(F.lds + L_AK); const LAS bf16* VP = (const LAS bf16*)(F.lds + L_VP);
    const int dk = F.tid >> 2, dv0 = (F.tid & 3) * 32;
    float a[32];
#pragma unroll
    for (int j = 0; j < 32; ++j) a[j] = S[dk * 128 + dv0 + j];
    float nn = 0.f;
    for (int s = 0; s < 64; ++s) { const float k = bf2f(AK[s * 128 + dk]);
        if (model == 0) nn += k * nb[256 + s];
#pragma unroll
        for (int j = 0; j < 32; j += 2) { const unsigned v = *(const LAS unsigned*)(VP + s * 128 + dv0 + j); a[j] += k * bflo(v); a[j + 1] += k * bfhi(v); } }
    const float g = nb[128 + dk];
#pragma unroll
    for (int j = 0; j < 32; ++j) S[dk * 128 + dv0 + j] = g * a[j];
    if (model == 0 && (F.tid & 3) == 0) nb[dk] = g * (nb[dk] + nn);
}
__device__ __forceinline__ bf16* state_ptr(const Frame& F, int sc, int slot, int half) { return wsp<bf16>(F, WS_STATE) + ((size_t)(sc * 8 + slot) * 2 + half) * 16384; }

__device__ __forceinline__ void p4_scan_local(Frame& F) {
    LAS float* S = (LAS float*)(F.lds + L_S); LAS float* nb = (LAS float*)(F.lds + L_N);
    for (int it0 = F.bid; it0 < 32 * 8 * 2; it0 += F.G) {
        const int it = (F.G == 256) ? (it0 & ~255) | ((((((it0 & 255) >> 4) << 3) | (it0 & 7)) << 1) | ((it0 >> 3) & 1)) : it0;
        const int half = it & 1, slot = (it >> 1) & 7, sc = it >> 4, seg = slot - 1;
        const int dir = sc & 1, h = (sc >> 1) & 3, b = (sc >> 3) & 1, model = sc >> 4;
        for (int i = F.tid; i < 16384; i += NTHR) S[i] = 0.f;
        if (F.tid < 128) nb[F.tid] = 0.f;
        float gacc = 1.f;
        __syncthreads();
        const int nch = seg < 0 ? NCH_CTX : CPS;
        for (int i = 0; i < nch; ++i) {
            const int c = seg_chunk(seg, dir, i), ci = seg < 0 ? 256 + b * 4 + c : b * 128 + c;
            scan_stage(F, model, b, h, dir, half, ci, false);
            __syncthreads();
            if (F.tid < 128) gacc *= nb[128 + F.tid];
            scan_update(F, model);
            __syncthreads();
        }
        bf16* st = state_ptr(F, sc, slot, half);
        for (int i = F.tid; i < 8192; i += NTHR) ((unsigned*)st)[i] = pk2(S[2 * i], S[2 * i + 1]);
        if (half == 0 && F.tid < 128) { wsp<float>(F, WS_NST)[(sc * 8 + slot) * 128 + F.tid] = nb[F.tid]; wsp<float>(F, WS_GSEG)[(sc * 8 + slot) * 128 + F.tid] = gacc; }
        __syncthreads();
    }
}
__device__ __forceinline__ void p5_scan_out(Frame& F) {
    LAS float* S = (LAS float*)(F.lds + L_S); LAS float* nb = (LAS float*)(F.lds + L_N); LAS float* P = (LAS float*)(F.lds + L_P);
    const LAS bf16* AQ = (const LAS bf16*)(F.lds + L_AQ); const LAS bf16* AK = (const LAS bf16*)(F.lds + L_AK); const LAS bf16* VP = (const LAS bf16*)(F.lds + L_VP);
    for (int it0 = F.bid; it0 < 2 * 2 * 4 * 8 * 2; it0 += F.G) {
        const int it = (F.G == 256) ? ((((it0 >> 4) << 3) | (it0 & 7)) << 1) | ((it0 >> 3) & 1) : it0;
        const int half = it & 1, seg = (it >> 1) & 7, h = (it >> 4) & 3, b = (it >> 6) & 1, model = it >> 7;
        bf16* HS = wsp<bf16>(F, model == 0 ? WS_QKM : WS_QKG);
        for (int dir = 0; dir < 2; ++dir) {
            const int sc = ((model * 2 + b) * 4 + h) * 2 + dir, s = dir == 0 ? seg : 7 - seg;
            { const int dk = F.tid >> 2, dv0 = (F.tid & 3) * 32; float a[32]; float nn = 0.f;
#pragma unroll
              for (int j = 0; j < 32; ++j) a[j] = 0.f;
              for (int slot = 0; slot <= s; ++slot) {
                  const float g = slot == 0 ? 0.f : wsp<float>(F, WS_GSEG)[(sc * 8 + slot) * 128 + dk];
                  const bf16* st = state_ptr(F, sc, slot, half) + dk * 128 + dv0;
#pragma unroll
                  for (int j = 0; j < 32; j += 2) { const unsigned v = *(const unsigned*)(st + j); a[j] = g * a[j] + bflo(v); a[j + 1] = g * a[j + 1] + bfhi(v); }
                  nn = g * nn + wsp<float>(F, WS_NST)[(sc * 8 + slot) * 128 + dk]; }
#pragma unroll
              for (int j = 0; j < 32; ++j) S[dk * 128 + dv0 + j] = a[j];
              if ((F.tid & 3) == 0) nb[dk] = nn; }
            __syncthreads();
            for (int i = 0; i < CPS; ++i) {
                const int c = seg_chunk(s, dir, i), ci = b * 128 + c, m0 = chunk_row0(ci);
                scan_stage(F, model, b, h, dir, half, ci, true);
                __syncthreads();
                for (int e = F.tid; e < 4096; e += NTHR) { const int t = e >> 6, s2 = e & 63; float p = 0.f;
                    if (dir == 0 ? (s2 <= t) : (s2 >= t)) {
                        for (int d8 = 0; d8 < 16; ++d8) { const u32x4 qa = *(const LAS u32x4*)(AQ + t * 128 + d8 * 8), ka = *(const LAS u32x4*)(AK + s2 * 128 + d8 * 8);
                            p += bflo(qa.x) * bflo(ka.x) + bfhi(qa.x) * bfhi(ka.x) + bflo(qa.y) * bflo(ka.y) + bfhi(qa.y) * bfhi(ka.y)
                               + bflo(qa.z) * bflo(ka.z) + bfhi(qa.z) * bfhi(ka.z) + bflo(qa.w) * bflo(ka.w) + bfhi(qa.w) * bfhi(ka.w); } }
                    P[e] = bf2f((unsigned short)f2bf(p)); }
                __syncthreads();
                { const int t = F.tid >> 3, dv0 = (F.tid & 7) * 16; float o[16];
#pragma unroll
                  for (int j = 0; j < 16; ++j) o[j] = 0.f;
                  float den = 0.f;
                  for (int s2 = 0; s2 < 64; ++s2) { const float p = P[t * 64 + s2];
                      if (model == 0) den += p * nb[256 + s2];
                      const u32x4 v0 = *(const LAS u32x4*)(VP + s2 * 128 + dv0), v1 = *(const LAS u32x4*)(VP + s2 * 128 + dv0 + 8);
                      o[0] += p * bflo(v0.x); o[1] += p * bfhi(v0.x); o[2] += p * bflo(v0.y); o[3] += p * bfhi(v0.y); o[4] += p * bflo(v0.z); o[5] += p * bfhi(v0.z); o[6] += p * bflo(v0.w); o[7] += p * bfhi(v0.w);
                      o[8] += p * bflo(v1.x); o[9] += p * bfhi(v1.x); o[10] += p * bflo(v1.y); o[11] += p * bfhi(v1.y); o[12] += p * bflo(v1.z); o[13] += p * bfhi(v1.z); o[14] += p * bflo(v1.w); o[15] += p * bfhi(v1.w); }
                  for (int dk = 0; dk < 128; ++dk) { const float q = bf2f(AQ[t * 128 + dk]);
                      if (model == 0) den += q * nb[dk];
                      const LAS float* sr = S + dk * 128 + dv0;
#pragma unroll
                      for (int j = 0; j < 16; ++j) o[j] += q * bf2f((unsigned short)f2bf(sr[j])); }
                  float rs = 1.f;
                  if (model == 0) { const float al = nb[320 + t]; rs = al / fmaxf(al * fabsf(den), 1.f); }
                  bf16* dst = HS + (size_t)(m0 + t) * 1024 + h * 256 + half * 128 + dv0;
                  float ssq = 0.f;
                  if (dir == 0) {
                      u32x4 w0, w1; w0.x = pk2(o[0] * rs, o[1] * rs); w0.y = pk2(o[2] * rs, o[3] * rs); w0.z = pk2(o[4] * rs, o[5] * rs); w0.w = pk2(o[6] * rs, o[7] * rs);
                      w1.x = pk2(o[8] * rs, o[9] * rs); w1.y = pk2(o[10] * rs, o[11] * rs); w1.z = pk2(o[12] * rs, o[13] * rs); w1.w = pk2(o[14] * rs, o[15] * rs);
                      *(u32x4*)dst = w0; *(u32x4*)(dst + 8) = w1;
                  } else {
                      const u32x4 p0 = *(const u32x4*)dst, p1 = *(const u32x4*)(dst + 8);
                      const float f[16] = {bflo(p0.x), bfhi(p0.x), bflo(p0.y), bfhi(p0.y), bflo(p0.z), bfhi(p0.z), bflo(p0.w), bfhi(p0.w), bflo(p1.x), bfhi(p1.x), bflo(p1.y), bfhi(p1.y), bflo(p1.z), bfhi(p1.z), bflo(p1.w), bfhi(p1.w)};
                      float r[16];
#pragma unroll
                      for (int j = 0; j < 16; ++j) { r[j] = f[j] + o[j] * rs; ssq += r[j] * r[j]; }
                      u32x4 w0, w1; w0.x = pk2(r[0], r[1]); w0.y = pk2(r[2], r[3]); w0.z = pk2(r[4], r[5]); w0.w = pk2(r[6], r[7]);
                      w1.x = pk2(r[8], r[9]); w1.y = pk2(r[10], r[11]); w1.z = pk2(r[12], r[13]); w1.w = pk2(r[14], r[15]);
                      *(u32x4*)dst = w0; *(u32x4*)(dst + 8) = w1;
                      ssq += __shfl_xor(ssq, 1); ssq += __shfl_xor(ssq, 2); ssq += __shfl_xor(ssq, 4);
                      if ((F.tid & 7) == 0) wsp<float>(F, WS_SSQ)[((size_t)(m0 + t) * 8 + model * 4 + h) * 2 + half] = ssq;
                  } }
                __syncthreads();
                scan_update(F, model);
                __syncthreads();
            }
        }
    }
}

typedef short s16x4 __attribute__((ext_vector_type(4)));
__device__ __forceinline__ unsigned offb(int row, int ch) { return 256u * (unsigned)row + 16u * (unsigned)(ch ^ (((row & 3) << 2) | ((row >> 2) & 3))); }
constexpr int M_AQ = 0, M_AK = 16384, M_VP = 32768, M_P = 49152, M_O = 57344, O_LD = 132;
template <int TILE>
__device__ __forceinline__ void tr_frag2(unsigned x0, unsigned x1, bf16x8& f0, bf16x8& f1) {
    s16x4 r0, r1, r2, r3;
    asm volatile("ds_read_b64_tr_b16 %0, %4 offset:%6\n\tds_read_b64_tr_b16 %1, %5 offset:%6\n\tds_read_b64_tr_b16 %2, %4 offset:%7\n\tds_read_b64_tr_b16 %3, %5 offset:%7\n\ts_waitcnt lgkmcnt(0)"
                 : "=&v"(r0), "=&v"(r1), "=&v"(r2), "=&v"(r3) : "v"(x0), "v"(x1), "i"(TILE), "i"(TILE + 8192) : "memory");
    f0 = __builtin_shufflevector(r0, r1, 0, 1, 2, 3, 4, 5, 6, 7); f1 = __builtin_shufflevector(r2, r3, 0, 1, 2, 3, 4, 5, 6, 7);
}
template <int TILE>
__device__ __forceinline__ void tr_frag8(unsigned a0, unsigned a1, unsigned b0, unsigned b1, unsigned c0, unsigned c1, unsigned d0, unsigned d1, bf16x8 (&f)[8]) {
    s16x4 r[16];
    asm volatile("ds_read_b64_tr_b16 %0, %16 offset:%24\n\tds_read_b64_tr_b16 %1, %17 offset:%24\n\tds_read_b64_tr_b16 %2, %16 offset:%25\n\tds_read_b64_tr_b16 %3, %17 offset:%25\n\t"
                 "ds_read_b64_tr_b16 %4, %18 offset:%24\n\tds_read_b64_tr_b16 %5, %19 offset:%24\n\tds_read_b64_tr_b16 %6, %18 offset:%25\n\tds_read_b64_tr_b16 %7, %19 offset:%25\n\t"
                 "ds_read_b64_tr_b16 %8, %20 offset:%24\n\tds_read_b64_tr_b16 %9, %21 offset:%24\n\tds_read_b64_tr_b16 %10, %20 offset:%25\n\tds_read_b64_tr_b16 %11, %21 offset:%25\n\t"
                 "ds_read_b64_tr_b16 %12, %22 offset:%24\n\tds_read_b64_tr_b16 %13, %23 offset:%24\n\tds_read_b64_tr_b16 %14, %22 offset:%25\n\tds_read_b64_tr_b16 %15, %23 offset:%25\n\ts_waitcnt lgkmcnt(0)"
                 : "=&v"(r[0]), "=&v"(r[1]), "=&v"(r[2]), "=&v"(r[3]), "=&v"(r[4]), "=&v"(r[5]), "=&v"(r[6]), "=&v"(r[7]), "=&v"(r[8]), "=&v"(r[9]), "=&v"(r[10]), "=&v"(r[11]), "=&v"(r[12]), "=&v"(r[13]), "=&v"(r[14]), "=&v"(r[15])
                 : "v"(a0), "v"(a1), "v"(b0), "v"(b1), "v"(c0), "v"(c1), "v"(d0), "v"(d1), "i"(TILE), "i"(TILE + 8192) : "memory");
#pragma unroll
    for (int j = 0; j < 8; ++j) f[j] = __builtin_shufflevector(r[2 * j], r[2 * j + 1], 0, 1, 2, 3, 4, 5, 6, 7);
}
template <int TILE>
__device__ __forceinline__ void tr_frag4(unsigned x0, unsigned x1, unsigned y0, unsigned y1, bf16x8& f0, bf16x8& f1, bf16x8& f2, bf16x8& f3) {
    s16x4 r0, r1, r2, r3, r4, r5, r6, r7;
    asm volatile("ds_read_b64_tr_b16 %0, %8 offset:%12\n\tds_read_b64_tr_b16 %1, %9 offset:%12\n\tds_read_b64_tr_b16 %2, %8 offset:%13\n\tds_read_b64_tr_b16 %3, %9 offset:%13\n\t"
                 "ds_read_b64_tr_b16 %4, %10 offset:%12\n\tds_read_b64_tr_b16 %5, %11 offset:%12\n\tds_read_b64_tr_b16 %6, %10 offset:%13\n\tds_read_b64_tr_b16 %7, %11 offset:%13\n\ts_waitcnt lgkmcnt(0)"
                 : "=&v"(r0), "=&v"(r1), "=&v"(r2), "=&v"(r3), "=&v"(r4), "=&v"(r5), "=&v"(r6), "=&v"(r7) : "v"(x0), "v"(x1), "v"(y0), "v"(y1), "i"(TILE), "i"(TILE + 8192) : "memory");
    f0 = __builtin_shufflevector(r0, r1, 0, 1, 2, 3, 4, 5, 6, 7); f1 = __builtin_shufflevector(r2, r3, 0, 1, 2, 3, 4, 5, 6, 7);
    f2 = __builtin_shufflevector(r4, r5, 0, 1, 2, 3, 4, 5, 6, 7); f3 = __builtin_shufflevector(r6, r7, 0, 1, 2, 3, 4, 5, 6, 7);
}
#define MFMA16(a, b, c) __builtin_amdgcn_mfma_f32_16x16x32_bf16((a), (b), (c), 0, 0, 0)
__device__ __forceinline__ bf16* mstate_ptr(const Frame& F, int sc, int slot, int half) { return wsp<bf16>(F, WS_STATE) + ((size_t)(sc * 8 + slot) * 2 + half) * 16384; }

#define LBAR() asm volatile("s_waitcnt lgkmcnt(0)\n\ts_barrier" ::: "memory")
template <bool OUT>
__device__ __forceinline__ void mscan_run(Frame& F, int model, int b, int h, int dir, int half, int seg, f32x4 (&S)[2][8], float& gacc) {
    LAS unsigned char* lds = F.lds; LAS float* nb = (LAS float*)(F.lds + L_N);
    LAS unsigned short* nbh = (LAS unsigned short*)(F.lds + L_N + 2048);
    const unsigned lb = (unsigned)(uintptr_t)F.lds;
    const int w = F.wave, lane = F.lane, li = lane & 15, lg = lane >> 4, tq = li >> 2, tp = lane & 3;
    const bool st = w < 4; const int sw = w & 3;
    const int nch = seg < 0 ? NCH_CTX : CPS;
    bf16* HS = wsp<bf16>(F, model == 0 ? WS_QKM : WS_QKG);
    const int mli = ((li & 3) << 2) | ((li >> 2) & 3);
    const unsigned rowb = 256u * li + 16u * (lg ^ mli);
    const unsigned o2b = 256u * li + 16u * ((lg >> 1) ^ mli) + 8u * (lg & 1);
    const unsigned trb0 = 256u * (8 * lg + tq) + 16u * ((tp >> 1) ^ ((tq << 2) | ((2 * lg) & 3))) + 8u * (tp & 1);
    const unsigned trb1 = 256u * (8 * lg + 4 + tq) + 16u * ((tp >> 1) ^ ((tq << 2) | ((2 * lg + 1) & 3))) + 8u * (tp & 1);
    const unsigned pra0 = lb + M_P + (128u * li + 16u * (lg ^ (li & 7))), pra1 = lb + M_P + ((128u * li + 16u * (lg ^ (li & 7))) ^ 64u);
    const unsigned poff0 = (unsigned)((F.tid >> 4) * 1024 + (F.tid & 15) * 8) * 2u, poff1 = poff0 + 32u * 2048u;
    auto final_pass = [&](const int m0, const u32x4 (&prevh)[2]) {
        LAS float* Ol = (LAS float*)(F.lds + M_O);
#pragma unroll
        for (int i = 0; i < 2; ++i) { const int p = F.tid + i * 512, t = p >> 4, c8 = p & 15;
            const f32x4 o0 = *(const LAS f32x4*)(Ol + t * O_LD + 8 * c8), o1 = *(const LAS f32x4*)(Ol + t * O_LD + 8 * c8 + 4);
            float rs = 1.f;
            if (model == 0) rs = nb[384 + t];
            bf16* dst = (bf16*)((unsigned char*)(HS + (size_t)m0 * 1024 + h * 256 + half * 128) + (i == 0 ? poff0 : poff1));
            float r[8] = {o0[0] * rs, o0[1] * rs, o0[2] * rs, o0[3] * rs, o1[0] * rs, o1[1] * rs, o1[2] * rs, o1[3] * rs};
            if (dir == 1) { const u32x4 pv = prevh[i];
                r[0] += bflo(pv.x); r[1] += bfhi(pv.x); r[2] += bflo(pv.y); r[3] += bfhi(pv.y); r[4] += bflo(pv.z); r[5] += bfhi(pv.z); r[6] += bflo(pv.w); r[7] += bfhi(pv.w);
                float ssq = (r[0] * r[0] + r[1] * r[1]) + (r[2] * r[2] + r[3] * r[3]) + (r[4] * r[4] + r[5] * r[5]) + (r[6] * r[6] + r[7] * r[7]);
                ssq += __shfl_xor(ssq, 1); ssq += __shfl_xor(ssq, 2); ssq += __shfl_xor(ssq, 4); ssq += __shfl_xor(ssq, 8);
                if (c8 == 0) wsp<float>(F, WS_SSQ)[((size_t)(m0 + t) * 8 + model * 4 + h) * 2 + half] = ssq; }
            u32x4 wv; wv.x = pkbf(r[0], r[1]); wv.y = pkbf(r[2], r[3]); wv.z = pkbf(r[4], r[5]); wv.w = pkbf(r[6], r[7]);
            *(u32x4*)dst = wv; }
    };
    const unsigned pwb = 128u * li + 8u * (lg & 1) + 16u * ((lg >> 1) ^ (li & 7));
    auto ptile = [&](const int ti, const int sh) {
        const bool used = dir == 0 ? !(sh == 1 && ti < 2) : !(sh == 0 && ti >= 2);
        if (!used) return;
        unsigned rowl = rowb; asm volatile("" : "+v"(rowl));
        bf16x8 pa[4], pb0[4], pb1[4];
#pragma unroll
        for (int kk = 0; kk < 4; ++kk) { const unsigned ra = lb + (rowl ^ ((unsigned)kk << 6)); pa[kk] = *(const LAS bf16x8*)(uintptr_t)(ra + M_AQ + 4096u * ti); pb0[kk] = *(const LAS bf16x8*)(uintptr_t)(ra + M_AK + 8192u * sh); pb1[kk] = *(const LAS bf16x8*)(uintptr_t)(ra + M_AK + 8192u * sh + 4096u); }
        f32x4 acc0 = {0.f, 0.f, 0.f, 0.f}, acc1 = acc0;
#pragma unroll
        for (int kk = 0; kk < 4; ++kk) { acc0 = MFMA16(pb0[kk], pa[kk], acc0); acc1 = MFMA16(pb1[kk], pa[kk], acc1); }
        const int t = 16 * ti + li;
#pragma unroll
        for (int sj = 0; sj < 2; ++sj) { const f32x4 acc = sj == 0 ? acc0 : acc1; const int s0 = 16 * (2 * sh + sj) + 4 * lg; float pv[4];
#pragma unroll
            for (int r = 0; r < 4; ++r) { const bool keep = dir == 0 ? (s0 + r <= t) : (s0 + r >= t); pv[r] = keep ? acc[r] : 0.f; }
            u32x2 pw; pw.x = pkbf(pv[0], pv[1]); pw.y = pkbf(pv[2], pv[3]);
            *(LAS u32x2*)(uintptr_t)(lb + M_P + 2048u * ti + (pwb ^ ((unsigned)(4 * sh + 2 * sj) << 4))) = pw; }
    };
    auto chunk_m0 = [&](const int ic) { const int c = seg_chunk(seg, dir, ic), ci = seg < 0 ? 256 + b * 4 + c : b * 128 + c; return chunk_row0(ci); };
    if (st) {
        const unsigned ola = lb + M_O + 4u * ((4 * lg) * O_LD + 32 * sw + li);
        for (int ic = 0; ic < nch; ++ic) {
            const int m0 = chunk_m0(ic);
            LBAR();
            if (F.tid < 128) gacc *= nb[128 + F.tid];
            unsigned o2l = o2b, tr0l = trb0, tr1l = trb1; asm volatile("" : "+v"(o2l), "+v"(tr0l), "+v"(tr1l));
            bf16x8 VB[2][2];
            tr_frag4<M_VP>(lb + (tr0l ^ ((unsigned)(2 * sw) << 5)), lb + (tr1l ^ ((unsigned)(2 * sw) << 5)), lb + (tr0l ^ ((unsigned)(2 * sw + 1) << 5)), lb + (tr1l ^ ((unsigned)(2 * sw + 1) << 5)), VB[0][0], VB[0][1], VB[1][0], VB[1][1]);
            u32x4 prevh[2] = {{0u, 0u, 0u, 0u}, {0u, 0u, 0u, 0u}};
            if (OUT) {
#pragma unroll
                for (int i = 0; i < 2; ++i) prevh[i] = *(const u32x4*)((const unsigned char*)(HS + (size_t)m0 * 1024 + h * 256 + half * 128) + (i == 0 ? poff0 : poff1) * (unsigned)dir);
                ptile(sw, 1);
                f32x4 O[2][4];
#pragma unroll
                for (int j = 0; j < 2; ++j)
#pragma unroll
                    for (int q = 0; q < 4; ++q) O[j][q] = (f32x4){0.f, 0.f, 0.f, 0.f};
#pragma unroll
                for (int kh = 0; kh < 2; ++kh) {
                    u32x2 alo[2][4], ahi[2][4];
#pragma unroll
                    for (int k2 = 0; k2 < 2; ++k2)
#pragma unroll
                        for (int q = 0; q < 4; ++q) { alo[k2][q] = *(const LAS u32x2*)(uintptr_t)((o2l ^ ((unsigned)(4 * (2 * kh + k2)) << 4)) + lb + M_AQ + 4096u * q); ahi[k2][q] = *(const LAS u32x2*)(uintptr_t)((o2l ^ ((unsigned)(4 * (2 * kh + k2) + 2) << 4)) + lb + M_AQ + 4096u * q); }
#pragma unroll
                    for (int k2 = 0; k2 < 2; ++k2) { const int kk = 2 * kh + k2; bf16x8 Bk[2];
#pragma unroll
                        for (int j = 0; j < 2; ++j) { u32x4 bw; bw.x = pkbf(S[j][2 * kk][0], S[j][2 * kk][1]); bw.y = pkbf(S[j][2 * kk][2], S[j][2 * kk][3]); bw.z = pkbf(S[j][2 * kk + 1][0], S[j][2 * kk + 1][1]); bw.w = pkbf(S[j][2 * kk + 1][2], S[j][2 * kk + 1][3]); Bk[j] = __builtin_bit_cast(bf16x8, bw); }
#pragma unroll
                        for (int q = 0; q < 4; ++q) { u32x4 aw; aw.x = alo[k2][q].x; aw.y = alo[k2][q].y; aw.z = ahi[k2][q].x; aw.w = ahi[k2][q].y; const bf16x8 Af = __builtin_bit_cast(bf16x8, aw);
                            O[0][q] = MFMA16(Af, Bk[0], O[0][q]); O[1][q] = MFMA16(Af, Bk[1], O[1][q]); } }
                    asm volatile("" ::: "memory");
                }
                LBAR();
                bf16x8 p0[4], p1[4];
#pragma unroll
                for (int q = 0; q < 4; ++q) { p0[q] = *(const LAS bf16x8*)(uintptr_t)(pra0 + 2048u * q); p1[q] = *(const LAS bf16x8*)(uintptr_t)(pra1 + 2048u * q); }
#pragma unroll
                for (int q = 0; q < 4; ++q) {
                    if (dir == 0 || q < 2) { O[0][q] = MFMA16(p0[q], VB[0][0], O[0][q]); O[1][q] = MFMA16(p0[q], VB[1][0], O[1][q]); }
                    if (dir == 1 || q >= 2) { O[0][q] = MFMA16(p1[q], VB[0][1], O[0][q]); O[1][q] = MFMA16(p1[q], VB[1][1], O[1][q]); } }
#pragma unroll
                for (int j = 0; j < 2; ++j)
#pragma unroll
                    for (int q = 0; q < 4; ++q)
#pragma unroll
                        for (int r = 0; r < 4; ++r) *(LAS float*)(uintptr_t)(ola + 64u * j + 4u * (unsigned)((16 * q + r) * O_LD)) = O[j][q][r];
            }
#pragma unroll
            for (int kp = 0; kp < 4; ++kp) { bf16x8 A0, A1, A2, A3; const int kt = 2 * kp;
                const f32x4 g0 = *(const LAS f32x4*)(nb + 128 + 16 * kt + 4 * lg), g1 = *(const LAS f32x4*)(nb + 128 + 16 * (kt + 1) + 4 * lg);
                tr_frag4<M_AK>(lb + (tr0l ^ ((unsigned)kt << 5)), lb + (tr1l ^ ((unsigned)kt << 5)), lb + (tr0l ^ ((unsigned)(kt + 1) << 5)), lb + (tr1l ^ ((unsigned)(kt + 1) << 5)), A0, A1, A2, A3);
#pragma unroll
                for (int j = 0; j < 2; ++j) { S[j][kt] = MFMA16(A0, VB[j][0], S[j][kt]); S[j][kt + 1] = MFMA16(A2, VB[j][0], S[j][kt + 1]); }
#pragma unroll
                for (int j = 0; j < 2; ++j) { S[j][kt] = MFMA16(A1, VB[j][1], S[j][kt]); S[j][kt + 1] = MFMA16(A3, VB[j][1], S[j][kt + 1]); }
#pragma unroll
                for (int j = 0; j < 2; ++j) { S[j][kt] = S[j][kt] * g0; S[j][kt + 1] = S[j][kt + 1] * g1; } }
            LBAR();
            if (OUT) final_pass(m0, prevh);
        }
    } else {
        const int ht = F.tid - 256;
        const unsigned hoff = (unsigned)((ht >> 4) * 1024 + (ht & 15) * 8) * 2u;
        const unsigned aoff = (unsigned)(ht >> 4) * 32u + 4u, aoffl = (unsigned)(ht & 63) * 32u;
        const f32x2* ABd = wsp<f32x2>(F, WS_AB) + (size_t)dir * MT * 4 + h;
        const bf16* vbase = wsp<bf16>(F, model == 0 ? WS_VM : WS_VG) + h * 256 + half * 128;
        struct SR { u32x4 q[4], k[4], v[4]; float be[4]; f32x2 ab; float ge; };
        SR R;
        auto issue = [&](const int ic_) {
            const int c_ = seg_chunk(seg, dir, ic_), ci_ = seg < 0 ? 256 + b * 4 + c_ : b * 128 + c_, m0_ = chunk_row0(ci_);
            const unsigned char* abr = (const unsigned char*)(ABd + (size_t)m0_ * 4);
            { const float* abp = (const float*)(abr + aoffl); R.ab.x = abp[0]; R.ab.y = abp[1]; }
            const float* gp = model == 0 ? wsp<float>(F, WS_GENDM) + ((size_t)dir * NCHUNK + ci_) * 4 + h : wsp<float>(F, WS_GENDG) + ((size_t)dir * NCHUNK + ci_) * 512 + h * 128 + ((ht - 64) & 127);
            R.ge = *gp;
            const long long qoff = model == 0 ? (long long)WS_QKMC : (m0_ < M_LAT ? 0ll : (long long)WS_QKGTC + ((long long)dir * M_CTX - M_LAT) * 2048);
            const unsigned char* qbb = (model == 1 && m0_ < M_LAT) ? (const unsigned char*)F.out + (size_t)dir * M_LAT * 2048 : (const unsigned char*)F.ws + qoff;
            const unsigned char* qr = qbb + (size_t)m0_ * 2048 + h * 256;
            const unsigned char* vr = (const unsigned char*)(vbase + (size_t)m0_ * 1024);
#pragma unroll
            for (int i = 0; i < 4; ++i) { const unsigned o = hoff + (unsigned)i * 16u * 2048u;
                if (OUT) R.q[i] = *(const u32x4*)(qr + o);
                R.k[i] = *(const u32x4*)(qr + 1024 + o); R.v[i] = *(const u32x4*)(vr + o); R.be[i] = *(const float*)(abr + aoff + (unsigned)i * 16u * 32u); }
        };
        const int ti = sw;
        const unsigned fra = lb + L_N + 2048 + (li == 1 ? 128u : 0u) + 16u * lg;
        const unsigned nfa = lb + L_N + 2048 + 256 + (li == 1 ? 256u : 0u) + 16u * lg;
        issue(0);
        for (int ic = 0; ic < nch; ++ic) {
            const int m0 = chunk_m0(ic);
            if (model == 0 && ht < 64) { const float be = R.ab.y; nb[320 + ht] = R.ab.x;
                const unsigned hi = pkbf(be, be) & 0xffffu; nbh[ht] = (unsigned short)hi; nbh[64 + ht] = (unsigned short)(pkbf(be - bflo(hi), 0.f) & 0xffffu); }
            if (ht >= 64 && ht < 192) nb[128 + ht - 64] = R.ge;
#pragma unroll
            for (int i = 0; i < 4; ++i) { const int p = ht + i * 256, r = p >> 4, cp = p & 15;
                const unsigned o = offb(r, cp);
                if (OUT) *(LAS u32x4*)(lds + M_AQ + o) = R.q[i];
                *(LAS u32x4*)(lds + M_AK + o) = R.k[i];
                u32x4 v = R.v[i];
                if (model == 0) { const float be = R.be[i];
                    v.x = pkbf(bflo(v.x) * be, bfhi(v.x) * be); v.y = pkbf(bflo(v.y) * be, bfhi(v.y) * be); v.z = pkbf(bflo(v.z) * be, bfhi(v.z) * be); v.w = pkbf(bflo(v.w) * be, bfhi(v.w) * be); }
                *(LAS u32x4*)(lds + M_VP + o) = v; }
            LBAR();
            u32x4 prevh[2] = {{0u, 0u, 0u, 0u}, {0u, 0u, 0u, 0u}};
            if (OUT) {
#pragma unroll
                for (int i = 0; i < 2; ++i) prevh[i] = *(const u32x4*)((const unsigned char*)(HS + (size_t)m0 * 1024 + h * 256 + half * 128) + (i == 0 ? poff0 : poff1) * (unsigned)dir);
                ptile(ti, 0);
            }
            if (ic + 1 < nch) issue(ic + 1);
            unsigned rowl = rowb, tr0l = trb0, tr1l = trb1; asm volatile("" : "+v"(rowl), "+v"(tr0l), "+v"(tr1l));
            bf16x8 BB0, BB1;
            { u32x4 z = {0u, 0u, 0u, 0u}; BB0 = __builtin_bit_cast(bf16x8, z); BB1 = BB0; }
            if (model == 0) { u32x4 f0 = *(const LAS u32x4*)(uintptr_t)fra, f1 = *(const LAS u32x4*)(uintptr_t)(fra + 64u); const u32x4 z = {0u, 0u, 0u, 0u};
                if (li > 1) { f0 = z; f1 = z; } BB0 = __builtin_bit_cast(bf16x8, f0); BB1 = __builtin_bit_cast(bf16x8, f1); }
            f32x4 dq = {0.f, 0.f, 0.f, 0.f};
            if (OUT && model == 0) {
                bf16x8 pa[4]; u32x4 nf[4]; const u32x4 z = {0u, 0u, 0u, 0u};
#pragma unroll
                for (int kk = 0; kk < 4; ++kk) { pa[kk] = *(const LAS bf16x8*)(uintptr_t)(lb + (rowl ^ ((unsigned)kk << 6)) + M_AQ + 4096u * ti); nf[kk] = *(const LAS u32x4*)(uintptr_t)(nfa + 64u * kk); if (li > 1) nf[kk] = z; }
#pragma unroll
                for (int kk = 0; kk < 4; ++kk) dq = MFMA16(pa[kk], __builtin_bit_cast(bf16x8, nf[kk]), dq);
            }
            f32x4 nacc0 = {0.f, 0.f, 0.f, 0.f}, nacc1 = nacc0;
            if (model == 0) { bf16x8 A0, A1, A2, A3;
                tr_frag4<M_AK>(lb + (tr0l ^ ((unsigned)(2 * ti) << 5)), lb + (tr1l ^ ((unsigned)(2 * ti) << 5)), lb + (tr0l ^ ((unsigned)(2 * ti + 1) << 5)), lb + (tr1l ^ ((unsigned)(2 * ti + 1) << 5)), A0, A1, A2, A3);
                nacc0 = MFMA16(A0, BB0, nacc0); nacc0 = MFMA16(A1, BB1, nacc0); nacc1 = MFMA16(A2, BB0, nacc1); nacc1 = MFMA16(A3, BB1, nacc1); }
            float nnew[8] = {0.f, 0.f, 0.f, 0.f, 0.f, 0.f, 0.f, 0.f};
            if (model == 0) { const f32x4 no0 = *(const LAS f32x4*)(nb + 32 * ti + 4 * lg), no1 = *(const LAS f32x4*)(nb + 32 * ti + 16 + 4 * lg), gw0 = *(const LAS f32x4*)(nb + 128 + 32 * ti + 4 * lg), gw1 = *(const LAS f32x4*)(nb + 128 + 32 * ti + 16 + 4 * lg);
#pragma unroll
                for (int r = 0; r < 4; ++r) { nnew[r] = gw0[r] * (no0[r] + nacc0[r] + __shfl_xor(nacc0[r], 1)); nnew[4 + r] = gw1[r] * (no1[r] + nacc1[r] + __shfl_xor(nacc1[r], 1)); } }
            if (OUT) {
                LBAR();
                if (model == 0) { f32x4 dp = dq;
                    const bf16x8 p0 = *(const LAS bf16x8*)(uintptr_t)(pra0 + 2048u * ti), p1 = *(const LAS bf16x8*)(uintptr_t)(pra1 + 2048u * ti);
                    if (dir == 0 || ti < 2) dp = MFMA16(p0, BB0, dp);
                    if (dir == 1 || ti >= 2) dp = MFMA16(p1, BB1, dp);
#pragma unroll
                    for (int r = 0; r < 4; ++r) { const float v = dp[r] + __shfl_xor(dp[r], 1); const float al = nb[320 + 16 * ti + 4 * lg + r];
                        if (li == 0) nb[384 + 16 * ti + 4 * lg + r] = al / fmaxf(al * fabsf(v), 1.f); } }
            }
            LBAR();
            if (model == 0 && li == 0) {
#pragma unroll
                for (int j = 0; j < 2; ++j) { const int dk0 = 32 * ti + 16 * j + 4 * lg; const float* nn = nnew + 4 * j;
                    f32x4 nv = {nn[0], nn[1], nn[2], nn[3]}; *(LAS f32x4*)(nb + dk0) = nv;
                    u32x2 hv, lv; const unsigned h0 = pkbf(nn[0], nn[1]), h1 = pkbf(nn[2], nn[3]); hv.x = h0; hv.y = h1;
                    lv.x = pkbf(nn[0] - bflo(h0), nn[1] - bfhi(h0)); lv.y = pkbf(nn[2] - bflo(h1), nn[3] - bfhi(h1));
                    *(LAS u32x2*)(nbh + 128 + dk0) = hv; *(LAS u32x2*)(nbh + 256 + dk0) = lv; } }
            if (OUT) final_pass(m0, prevh);
        }
    }
}
__device__ __forceinline__ void p4m_scan_local(Frame& F) {
    LAS float* nb = (LAS float*)(F.lds + L_N);
    for (int it0 = F.bid; it0 < 32 * 8 * 2; it0 += F.G) {
        const int it = (F.G == 256) ? (it0 & ~255) | ((((((it0 & 255) >> 4) << 3) | (it0 & 7)) << 1) | ((it0 >> 3) & 1)) : it0;
        const int half = it & 1, slot = (it >> 1) & 7, sc = it >> 4, seg = slot - 1;
        const int dir = sc & 1, h = (sc >> 1) & 3, b = (sc >> 3) & 1, model = sc >> 4;
        f32x4 S[2][8];
#pragma unroll
        for (int j = 0; j < 2; ++j)
#pragma unroll
            for (int kt = 0; kt < 8; ++kt) S[j][kt] = (f32x4){0.f, 0.f, 0.f, 0.f};
        __syncthreads();
        if (F.tid < 128) nb[F.tid] = 0.f;
        float gacc = 1.f;
        mscan_run<false>(F, model, b, h, dir, half, seg, S, gacc);
        __syncthreads();
        if (F.wave < 4) {
#pragma unroll
            for (int j = 0; j < 2; ++j) { unsigned so = (unsigned)((2 * F.wave + j) * 512 + F.lane) * 8u; asm volatile("" : "+v"(so));
                bf16* st = (bf16*)((unsigned char*)mstate_ptr(F, sc, slot, half) + so);
#pragma unroll
                for (int kt = 0; kt < 8; ++kt) { u32x2 v; v.x = pkbf(S[j][kt][0], S[j][kt][1]); v.y = pkbf(S[j][kt][2], S[j][kt][3]); *(u32x2*)(st + kt * 256) = v; } } }
        if (half == 0 && F.tid < 128) { wsp<float>(F, WS_NST)[(sc * 8 + slot) * 128 + F.tid] = nb[F.tid]; wsp<float>(F, WS_GSEG)[(sc * 8 + slot) * 128 + F.tid] = gacc; }
    }
}
__device__ __forceinline__ void p5m_scan_out(Frame& F) {
    LAS float* nb = (LAS float*)(F.lds + L_N);
    for (int it0 = F.bid; it0 < 2 * 2 * 4 * 8 * 2; it0 += F.G) {
        const int it = (F.G == 256) ? ((((it0 >> 4) << 3) | (it0 & 7)) << 1) | ((it0 >> 3) & 1) : it0;
        const int half = it & 1, seg = (it >> 1) & 7, h = (it >> 4) & 3, b = (it >> 6) & 1, model = it >> 7;
        for (int dir = 0; dir < 2; ++dir) {
            const int sc = ((model * 2 + b) * 4 + h) * 2 + dir, s = dir == 0 ? seg : 7 - seg;
            f32x4 S[2][8];
#pragma unroll
            for (int j = 0; j < 2; ++j)
#pragma unroll
                for (int kt = 0; kt < 8; ++kt) S[j][kt] = (f32x4){0.f, 0.f, 0.f, 0.f};
            float nn = 0.f;
            for (int slot = 0; slot <= s; ++slot) {
                const float* gs = wsp<float>(F, WS_GSEG) + (sc * 8 + slot) * 128;
                const float gv = gs[F.tid & 127], nv = wsp<float>(F, WS_NST)[(sc * 8 + slot) * 128 + (F.tid & 127)];
                if (F.wave < 4) {
                    f32x4 gv4[8];
#pragma unroll
                    for (int kt = 0; kt < 8; ++kt) gv4[kt] = *(const f32x4*)(gs + 16 * kt + 4 * (F.lane >> 4));
#pragma unroll
                    for (int j = 0; j < 2; ++j) { unsigned so = (unsigned)((2 * F.wave + j) * 512 + F.lane) * 8u; asm volatile("" : "+v"(so));
                        const bf16* stp = (const bf16*)((const unsigned char*)mstate_ptr(F, sc, slot, half) + so);
                        u32x2 sv[8];
#pragma unroll
                        for (int kt = 0; kt < 8; ++kt) sv[kt] = *(const u32x2*)(stp + kt * 256);
#pragma unroll
                        for (int kt = 0; kt < 8; ++kt) { const u32x2 v = sv[kt]; f32x4 g4 = gv4[kt]; if (slot == 0) g4 = (f32x4){0.f, 0.f, 0.f, 0.f};
                            S[j][kt][0] = g4[0] * S[j][kt][0] + bflo(v.x); S[j][kt][1] = g4[1] * S[j][kt][1] + bfhi(v.x); S[j][kt][2] = g4[2] * S[j][kt][2] + bflo(v.y); S[j][kt][3] = g4[3] * S[j][kt][3] + bfhi(v.y); } } }
                nn = (slot > 0 ? gv : 0.f) * nn + nv; }
            __syncthreads();
            if (F.tid < 128) { nb[F.tid] = nn; LAS unsigned short* nbh = (LAS unsigned short*)(F.lds + L_N + 2048);
                const unsigned hi = pkbf(nn, nn) & 0xffffu; nbh[128 + F.tid] = (unsigned short)hi; nbh[256 + F.tid] = (unsigned short)(pkbf(nn - bflo(hi), 0.f) & 0xffffu); }
            float gacc = 1.f;
            mscan_run<true>(F, model, b, h, dir, half, s, S, gacc);
        }
    }
}

struct EpiProjB {
    unsigned char* ws; const float* ml_norm; const float* gla_norm;
    __device__ __forceinline__ void operator()(const f32x4 (&acc)[2][2][4][2], const Unit& u, int wr, int wc, int fr, int fq) const {
        const int row0 = u.pm * 256 + wr * 64 + fr, colt = (u.pn & 3) * 256 + wc * 32 + 8 * fq;
        if (u.pn < 8) {
            const int model = u.pn >> 2, head = u.pn & 3;
            bf16* base = (bf16*)(ws + (model == 0 ? WS_QKM : WS_QKG)) + colt;
            const float* nw = (model == 0 ? ml_norm : gla_norm) + colt;
            const float* ssq = (const float*)(ws + WS_SSQ);
            const float gsel = model == 0 ? 0.f : 1.f;
            f32x4 nwv[2][2];
#pragma unroll
            for (int bj = 0; bj < 2; ++bj) { nwv[bj][0] = *(const f32x4*)(nw + bj * 128); nwv[bj][1] = *(const f32x4*)(nw + bj * 128 + 4); }
            u32x4 hvq[8][2]; f32x2 sqq[8];
#define EPB_ISSUE(g) do { const int row_ = row0 + ((g) >> 2) * 128 + ((g) & 3) * 16; const bf16* rp_ = base + (size_t)row_ * 1024; hvq[g][0] = *(const u32x4*)rp_; hvq[g][1] = *(const u32x4*)(rp_ + 128); \
                sqq[g] = *(const f32x2*)(ssq + ((size_t)row_ * 8 + model * 4 + head) * 2); } while (0)
            EPB_ISSUE(0); EPB_ISSUE(1); EPB_ISSUE(2); EPB_ISSUE(3);
#pragma unroll
            for (int g = 0; g < 8; ++g) { const int ai = g >> 2, m = g & 3;
                __builtin_amdgcn_sched_barrier(0);
                if (g == 1) { EPB_ISSUE(4); EPB_ISSUE(5); }
                if (g == 2) { EPB_ISSUE(6); EPB_ISSUE(7); }
                __builtin_amdgcn_sched_barrier(0);
                const int row = row0 + ai * 128 + m * 16; bf16* rowp = base + (size_t)row * 1024;
                const float rstd = 1.f / sqrtf((sqq[g].x + sqq[g].y) * (1.f / 256.f) + EPS);
                float one = 1.f; asm volatile("" : "+v"(one));
#pragma unroll
                for (int bj = 0; bj < 2; ++bj) { const f32x4 a0 = acc[ai][bj][m][0] * one, a1 = acc[ai][bj][m][1] * one;
                    const f32x4 n0 = nwv[bj][0], n1 = nwv[bj][1];
                    float hvf[8]; unpack8(hvq[g][bj], hvf); float o[8];
#pragma unroll
                    for (int j = 0; j < 4; ++j) { const float s0 = sigm(a0[j]), s1 = sigm(a1[j]);
                        o[j] = hvf[j] * rstd * n0[j] * (s0 + gsel * (s0 * a0[j] - s0)); o[4 + j] = hvf[4 + j] * rstd * n1[j] * (s1 + gsel * (s1 * a1[j] - s1)); }
                    u32x4 w; w.x = cvt_pk_bf16(o[0], o[1]); w.y = cvt_pk_bf16(o[2], o[3]); w.z = cvt_pk_bf16(o[4], o[5]); w.w = cvt_pk_bf16(o[6], o[7]);
                    *(u32x4*)(rowp + bj * 128) = w; } }
#undef EPB_ISSUE
        } else {
            bf16* base = (bf16*)(ws + (u.pn < 12 ? WS_VG : WS_QKMC)) + colt;
#pragma unroll
            for (int ai = 0; ai < 2; ++ai)
#pragma unroll
                for (int m = 0; m < 4; ++m) { bf16* rowp = base + (size_t)(row0 + ai * 128 + m * 16) * 1024;
#pragma unroll
                    for (int bj = 0; bj < 2; ++bj) { const f32x4 a0 = acc[ai][bj][m][0], a1 = acc[ai][bj][m][1];
                        u32x4 w; w.x = pkbf(sigm(a0[0]), sigm(a0[1])); w.y = pkbf(sigm(a0[2]), sigm(a0[3])); w.z = pkbf(sigm(a1[0]), sigm(a1[1])); w.w = pkbf(sigm(a1[2]), sigm(a1[3]));
                        *(u32x4*)(rowp + bj * 128) = w; } }
        }
    }
};
template <int STEP> struct EpiGate {
    unsigned char* ws;
    __device__ __forceinline__ void operator()(const f32x4 (&acc)[2][2][4][2], const Unit& u, int wr, int wc, int fr, int fq) const {
        const int row0 = u.pm * 256 + wr * 64 + fr, colt = u.pn * 256 + wc * 32 + 8 * fq;
        const bf16* sg = (const bf16*)(ws + (STEP == 0 ? WS_VG : WS_QKMC)) + colt; bf16* ty = (bf16*)(ws + WS_VM) + colt;
#pragma unroll
        for (int ai = 0; ai < 2; ++ai)
#pragma unroll
            for (int m = 0; m < 4; ++m) { const size_t ro = (size_t)(row0 + ai * 128 + m * 16) * 1024;
#pragma unroll
                for (int bj = 0; bj < 2; ++bj) { const f32x4 a0 = acc[ai][bj][m][0], a1 = acc[ai][bj][m][1];
                    const u32x4 s = *(const u32x4*)(sg + ro + bj * 128);
                    float r[8] = {bflo(s.x) * a0[0], bfhi(s.x) * a0[1], bflo(s.y) * a0[2], bfhi(s.y) * a0[3], bflo(s.z) * a1[0], bfhi(s.z) * a1[1], bflo(s.w) * a1[2], bfhi(s.w) * a1[3]};
                    if (STEP == 1) { const u32x4 t = *(const u32x4*)(ty + ro + bj * 128);
                        r[0] += bflo(t.x); r[1] += bfhi(t.x); r[2] += bflo(t.y); r[3] += bfhi(t.y); r[4] += bflo(t.z); r[5] += bfhi(t.z); r[6] += bflo(t.w); r[7] += bfhi(t.w); }
                    u32x4 w; w.x = cvt_pk_bf16(r[0], r[1]); w.y = cvt_pk_bf16(r[2], r[3]); w.z = cvt_pk_bf16(r[4], r[5]); w.w = cvt_pk_bf16(r[6], r[7]);
                    *(u32x4*)(ty + ro + bj * 128) = w; } }
    }
};
struct EpiOut {
    const float* x; float* out; const float* modv;
    __device__ __forceinline__ void operator()(const f32x4 (&acc)[2][2][4][2], const Unit& u, int wr, int wc, int fr, int fq) const {
        const int row0 = u.pm * 256 + wr * 64 + fr, colt = u.pn * 256 + wc * 32 + 8 * fq;
        const float* gt = modv + ((u.pm * 256) >> 13) * 6144 + 2048 + colt;
#pragma unroll
        for (int bj = 0; bj < 2; ++bj) { const f32x4 g0 = *(const f32x4*)(gt + bj * 128), g1 = *(const f32x4*)(gt + bj * 128 + 4);
#pragma unroll
            for (int ai = 0; ai < 2; ++ai)
#pragma unroll
                for (int m = 0; m < 4; ++m) { const size_t off = (size_t)(row0 + ai * 128 + m * 16) * 1024 + colt + bj * 128;
                    *(f32x4*)(out + off) = *(const f32x4*)(x + off) + g0 * acc[ai][bj][m][0]; *(f32x4*)(out + off + 4) = *(const f32x4*)(x + off + 4) + g1 * acc[ai][bj][m][1]; } }
    }
};

__device__ __forceinline__ void p9_route(Frame& F) {
    PMARK0(40)
    const float* modv = wsp<float>(F, WS_MODV);
    constexpr int WP = 1032;
    LAS unsigned short* Wt = (LAS unsigned short*)F.lds;
    LAS int* hist = (LAS int*)(F.lds + 40 * WP * 2 + 16384);
    if (F.tid < 32) hist[F.tid] = 0;
    for (int k = F.tid; k < 1024; k += NTHR) {
        const f32x4 wg = *(const f32x4*)(F.w_grp + (size_t)k * 4), w0 = *(const f32x4*)(F.w_rexp + (size_t)k * 16), w1 = *(const f32x4*)(F.w_rexp + (size_t)k * 16 + 4), w2 = *(const f32x4*)(F.w_rexp + (size_t)k * 16 + 8), w3 = *(const f32x4*)(F.w_rexp + (size_t)k * 16 + 12);
        const float wv[20] = {wg[0], wg[1], wg[2], wg[3], w0[0], w0[1], w0[2], w0[3], w1[0], w1[1], w1[2], w1[3], w2[0], w2[1], w2[2], w2[3], w3[0], w3[1], w3[2], w3[3]};
#pragma unroll
        for (int n = 0; n < 20; ++n) { const unsigned hi = pkbf(wv[n], 0.f) & 0xffffu; Wt[n * WP + k] = (unsigned short)hi; Wt[(20 + n) * WP + k] = (unsigned short)(pkbf(wv[n] - bflo(hi), 0.f) & 0xffffu); } }
    __syncthreads();
    int* rexp = (int*)(F.ws + WS_ROUTE + RT_EXP); float* rw = (float*)(F.ws + WS_ROUTE + RT_W); int* rpos = (int*)(F.ws + WS_ROUTE + RT_POS);
    const int li = F.lane & 15, lg = F.lane >> 4;
    const int n1 = 16 + li < 20 ? 16 + li : 19;
    LAS float* gco = (LAS float*)(F.lds + 40 * WP * 2 + 16384 + 256);
    LAS float* shv = gco + 1024;
    LAS float* ssh = shv + 1024;
    LAS float* lgall = (LAS float*)(F.lds + 40 * WP * 2);
    const int tp = F.wave >> 1, hf = F.wave & 1;
    for (int tg = F.bid; tg < M_LAT / 64; tg += F.G) {
        const int mrow0 = 64 * tg, m = mrow0 + 16 * tp + li;
        const float* mvb = modv + (mrow0 >> 13) * 6144;
        __syncthreads();
        for (int c = F.tid; c < 1024; c += NTHR) { gco[c] = F.g_norm2[c] * (mvb[4096 + c] + 1.f); shv[c] = mvb[3072 + c]; }
        const float* src = F.out + (size_t)m * D + hf * 512 + 8 * lg;
        f32x4 xa[16], xb[16];
#pragma unroll
        for (int ks = 0; ks < 16; ++ks) { xa[ks] = *(const f32x4*)(src + 32 * ks); xb[ks] = *(const f32x4*)(src + 32 * ks + 4); }
        float ss = 0.f;
#pragma unroll
        for (int ks = 0; ks < 16; ++ks) { const f32x4 a = xa[ks], c = xb[ks]; ss += (a.x * a.x + a.y * a.y) + (a.z * a.z + a.w * a.w) + (c.x * c.x + c.y * c.y) + (c.z * c.z + c.w * c.w); }
        ss += __shfl_xor(ss, 16); ss += __shfl_xor(ss, 32);
        if (lg == 0) ssh[F.wave * 16 + li] = ss;
        __syncthreads();
        const float rstd = 1.f / sqrtf((ssh[F.wave * 16 + li] + ssh[(F.wave ^ 1) * 16 + li]) * (1.f / D) + EPS);
        f32x4 acc0 = {0.f, 0.f, 0.f, 0.f}, acc1 = acc0;
        bf16* o = wsp<bf16>(F, WS_H2) + (size_t)m * D + hf * 512 + 8 * lg;
#pragma unroll
        for (int ks = 0; ks < 16; ++ks) { const int c = hf * 512 + 32 * ks + 8 * lg;
            const f32x4 ga = *(const LAS f32x4*)(gco + c), gb = *(const LAS f32x4*)(gco + c + 4), sha = *(const LAS f32x4*)(shv + c), shb = *(const LAS f32x4*)(shv + c + 4);
            const f32x4 ha = (xa[ks] * rstd) * ga + sha, hb = (xb[ks] * rstd) * gb + shb;
            u32x4 hi; hi.x = pkbf(ha[0], ha[1]); hi.y = pkbf(ha[2], ha[3]); hi.z = pkbf(hb[0], hb[1]); hi.w = pkbf(hb[2], hb[3]);
            u32x4 lo; lo.x = pkbf(ha[0] - bflo(hi.x), ha[1] - bfhi(hi.x)); lo.y = pkbf(ha[2] - bflo(hi.y), ha[3] - bfhi(hi.y)); lo.z = pkbf(hb[0] - bflo(hi.z), hb[1] - bfhi(hi.z)); lo.w = pkbf(hb[2] - bflo(hi.w), hb[3] - bfhi(hi.w));
            *(u32x4*)(o + 32 * ks) = hi;
            const bf16x8 Ah = __builtin_bit_cast(bf16x8, hi), Al = __builtin_bit_cast(bf16x8, lo);
            const bf16x8 bh0 = *(const LAS bf16x8*)(Wt + li * WP + c), bh1 = *(const LAS bf16x8*)(Wt + n1 * WP + c), bl0 = *(const LAS bf16x8*)(Wt + (20 + li) * WP + c), bl1 = *(const LAS bf16x8*)(Wt + (20 + n1) * WP + c);
            acc0 = __builtin_amdgcn_mfma_f32_16x16x32_bf16(Ah, bh0, acc0, 0, 0, 0); acc1 = __builtin_amdgcn_mfma_f32_16x16x32_bf16(Ah, bh1, acc1, 0, 0, 0);
            acc0 = __builtin_amdgcn_mfma_f32_16x16x32_bf16(Al, bh0, acc0, 0, 0, 0); acc1 = __builtin_amdgcn_mfma_f32_16x16x32_bf16(Al, bh1, acc1, 0, 0, 0);
            acc0 = __builtin_amdgcn_mfma_f32_16x16x32_bf16(Ah, bl0, acc0, 0, 0, 0); acc1 = __builtin_amdgcn_mfma_f32_16x16x32_bf16(Ah, bl1, acc1, 0, 0, 0); }
        LAS float* lgs = lgall + F.wave * 512;
#pragma unroll
        for (int r = 0; r < 4; ++r) { lgs[(4 * lg + r) * 32 + li] = acc0[r]; lgs[(4 * lg + r) * 32 + 16 + li] = acc1[r]; }
        __syncthreads();
        if (hf == 0 && F.lane < 16) {
            const int mr = mrow0 + 16 * tp + F.lane;
            const LAS float* l0 = lgs + F.lane * 32; const LAS float* l1 = l0 + 512;
            const f32x4 lq0 = *(const LAS f32x4*)(l0) + *(const LAS f32x4*)(l1), lq1 = *(const LAS f32x4*)(l0 + 4) + *(const LAS f32x4*)(l1 + 4), lq2 = *(const LAS f32x4*)(l0 + 8) + *(const LAS f32x4*)(l1 + 8),
                        lq3 = *(const LAS f32x4*)(l0 + 12) + *(const LAS f32x4*)(l1 + 12), lq4 = *(const LAS f32x4*)(l0 + 16) + *(const LAS f32x4*)(l1 + 16);
            const f32x4 bg = *(const f32x4*)F.b_grp;
            float gl[4] = {lq0[0] + bg[0], lq0[1] + bg[1], lq0[2] + bg[2], lq0[3] + bg[3]};
            int grp = 0; float gmax = gl[0];
#pragma unroll
            for (int q = 1; q < 4; ++q) if (gl[q] > gmax) { gmax = gl[q]; grp = q; }
            float gs = 0.f;
#pragma unroll
            for (int q = 0; q < 4; ++q) gs += expf(gl[q] - gmax);
            const float grp_p = 1.f / gs;
            float el[4];
#pragma unroll
            for (int q = 0; q < 4; ++q) { float v = lq1[q]; v = grp == 1 ? lq2[q] : v; v = grp == 2 ? lq3[q] : v; v = grp == 3 ? lq4[q] : v; asm volatile("" : "+v"(v)); el[q] = v + F.b_rexp[grp * 4 + q]; }
            int i0 = 0; float e0v = el[0];
#pragma unroll
            for (int q = 1; q < 4; ++q) if (el[q] > e0v) { e0v = el[q]; i0 = q; }
            int i1 = -1; float e1v = -3.0e38f;
#pragma unroll
            for (int q = 0; q < 4; ++q) if (q != i0 && el[q] > e1v) { e1v = el[q]; i1 = q; }
            const float e1 = expf(e1v - e0v); const float w0 = grp_p / (1.f + e1), w1 = grp_p * e1 / (1.f + e1);
            const int x0 = grp * 4 + i0, x1 = grp * 4 + i1;
            rexp[2 * mr] = x0; rexp[2 * mr + 1] = x1; rw[2 * mr] = w0; rw[2 * mr + 1] = w1;
            rpos[2 * mr] = __hip_atomic_fetch_add(hist + x0, 1, __ATOMIC_RELAXED, __HIP_MEMORY_SCOPE_WORKGROUP);
            rpos[2 * mr + 1] = __hip_atomic_fetch_add(hist + x1, 1, __ATOMIC_RELAXED, __HIP_MEMORY_SCOPE_WORKGROUP);
        }
    }
    __syncthreads();
    if (F.tid < 16) hist[16 + F.tid] = (int)__hip_atomic_fetch_add((unsigned*)(F.ws + WS_CTL) + CW_CNT + 64 * F.tid, (unsigned)hist[F.tid], __ATOMIC_RELAXED, __HIP_MEMORY_SCOPE_AGENT);
    __syncthreads();
    VM_WAIT();
    for (int tg = F.bid; tg < M_LAT / 64; tg += F.G) if (F.tid < 128) { const int a = 128 * tg + F.tid, e = rexp[a], pos = rpos[a] + hist[16 + e]; rpos[a] = pos;
        wsp<int>(F, WS_LTOK)[e * LCAP + pos] = a >> 1; wsp<float>(F, WS_LW)[e * LCAP + pos] = rw[a]; }
    __syncthreads();
    PMARK1(40)
    PMARK0(41)
    moe_weight_copies<0>(F);
    PMARK1(41)
}
__device__ __forceinline__ void moe_layout(Frame& F) {
    LAS int* tab = (LAS int*)(F.lds + LDS_TAB);
    if (F.tid == 0) { int a = 0; for (int e = 0; e < 16; ++e) { const int c = (int)__hip_atomic_load((unsigned*)(F.ws + WS_CTL) + CW_CNT + 64 * e, __ATOMIC_RELAXED, __HIP_MEMORY_SCOPE_AGENT); tab[e] = a; tab[32 + e] = c; a += (c + 255) & ~255; } tab[16] = a; tab[17] = a >> 8; }
    __syncthreads();
}
struct EpiUp {
    unsigned char* ws;
    __device__ __forceinline__ void operator()(const f32x4 (&acc)[2][2][4][2], const Unit& u, int wr, int wc, int fr, int fq) const {
        const int row0 = u.pm * 256 + wr * 64 + fr; bf16* base = (bf16*)(ws + WS_HID) + u.pn * 128 + wc * 32 + 8 * fq;
#pragma unroll
        for (int ai = 0; ai < 2; ++ai)
#pragma unroll
            for (int m = 0; m < 4; ++m) { const f32x4 g0 = acc[ai][0][m][0], g1 = acc[ai][0][m][1], u0 = acc[ai][1][m][0], u1 = acc[ai][1][m][1];
                u32x4 w; w.x = cvt_pk_bf16(siluf(g0[0]) * u0[0], siluf(g0[1]) * u0[1]); w.y = cvt_pk_bf16(siluf(g0[2]) * u0[2], siluf(g0[3]) * u0[3]);
                w.z = cvt_pk_bf16(siluf(g1[0]) * u1[0], siluf(g1[1]) * u1[1]); w.w = cvt_pk_bf16(siluf(g1[2]) * u1[2], siluf(g1[3]) * u1[3]);
                *(u32x4*)(base + (size_t)(row0 + ai * 128 + m * 16) * 512) = w; }
    }
};
struct EpiDown {
    unsigned char* ws; const LAS int* tab;
    __device__ __forceinline__ void operator()(const f32x4 (&acc)[2][2][4][2], const Unit& u, int wr, int wc, int fr, int fq) const {
        const int row0 = u.pm * 256 + wr * 64 + fr; bf16* base = (bf16*)(ws + WS_YROWS) + u.pn * 256 + wc * 32 + 8 * fq;
        const float* lw = (const float*)(ws + WS_LW) + u.e * LCAP - tab[u.e];
#pragma unroll
        for (int ai = 0; ai < 2; ++ai)
#pragma unroll
            for (int m = 0; m < 4; ++m) { const int row = row0 + ai * 128 + m * 16; const float rwt = lw[row];
#pragma unroll
                for (int bj = 0; bj < 2; ++bj) { const f32x4 v0 = acc[ai][bj][m][0] * rwt, v1 = acc[ai][bj][m][1] * rwt;
                    u32x4 w; w.x = cvt_pk_bf16(v0[0], v0[1]); w.y = cvt_pk_bf16(v0[2], v0[3]); w.z = cvt_pk_bf16(v1[0], v1[1]); w.w = cvt_pk_bf16(v1[2], v1[3]);
                    *(u32x4*)(base + (size_t)row * 1024 + bj * 128) = w; } }
    }
};
__device__ __forceinline__ void p13_final(Frame& F) {
    moe_layout(F);
    const LAS int* tab = (const LAS int*)(F.lds + LDS_TAB);
    const float* modv = wsp<float>(F, WS_MODV); const int* rpos = (const int*)(F.ws + WS_ROUTE + RT_POS); const int* rexp = (const int*)(F.ws + WS_ROUTE + RT_EXP); const bf16* Y = wsp<bf16>(F, WS_YROWS);
    const int gw = F.bid * NW + F.wave, NGW = F.G * NW;
    for (int m = gw; m < M_LAT; m += NGW) {
        float* row = F.out + (size_t)m * D; const float* gt = modv + (m >> 13) * 6144 + 5120;
        const bf16* y0 = Y + (size_t)(tab[rexp[2 * m]] + rpos[2 * m]) * 1024; const bf16* y1 = Y + (size_t)(tab[rexp[2 * m + 1]] + rpos[2 * m + 1]) * 1024;
        f32x4 v[4]; float s = 0.f;
#pragma unroll
        for (int j = 0; j < 4; ++j) { const int c = 4 * F.lane + 256 * j; const u32x2 a = *(const u32x2*)(y0 + c), b = *(const u32x2*)(y1 + c); const f32x4 g = *(const f32x4*)(gt + c);
            f32x4 yy; yy.x = bflo(a.x) + bflo(b.x); yy.y = bfhi(a.x) + bfhi(b.x); yy.z = bflo(a.y) + bflo(b.y); yy.w = bfhi(a.y) + bfhi(b.y);
            v[j] = *(const f32x4*)(row + c) + g * yy; s += (v[j].x * v[j].x + v[j].y * v[j].y) + (v[j].z * v[j].z + v[j].w * v[j].w); }
        const float rstd = 1.f / sqrtf(wave_sum(s) * (1.f / D) + EPS);
#pragma unroll
        for (int j = 0; j < 4; ++j) { const int c = 4 * F.lane + 256 * j; *(f32x4*)(row + c) = (v[j] * rstd) * *(const f32x4*)(F.g_final + c); }
    }
}

typedef const Args __attribute__((address_space(4))) * KArgsP;
__device__ __forceinline__ void load_inputs(Frame& F) {
    KArgsP ap = (KArgsP)__builtin_amdgcn_kernarg_segment_ptr();
    asm volatile("" : "+s"(ap));
    F.x = ap->in[0]; F.c = ap->in[1]; F.ctx = ap->in[2]; F.c_ctx = ap->in[3]; F.w_mod = ap->in[4]; F.b_mod = ap->in[5]; F.g_norm1 = ap->in[6]; F.w_in = ap->in[7];
    F.ml_conv = ap->in[8]; F.ml_conv_b = ap->in[9]; F.b_mgate = ap->in[10]; F.ml_norm = ap->in[11]; F.gla_w2 = ap->in[12]; F.gla_b2 = ap->in[13]; F.gla_norm = ap->in[14];
    F.w_proj_m = ap->in[15]; F.w_proj_g = ap->in[16]; F.w_out = ap->in[17]; F.g_norm2 = ap->in[18]; F.w_grp = ap->in[19]; F.b_grp = ap->in[20]; F.w_rexp = ap->in[21]; F.b_rexp = ap->in[22];
    F.w_up = ap->in[23]; F.w_down = ap->in[24]; F.g_final = ap->in[25];
    F.ws = ap->ws; F.out = ap->out;
    int ln = (int)__builtin_amdgcn_mbcnt_hi(~0u, __builtin_amdgcn_mbcnt_lo(~0u, 0u)); asm volatile("" : "+v"(ln)); F.lane = ln; F.tid = F.wave * 64 + ln;
}
constexpr int N_PHASES = 14;
__global__ void __launch_bounds__(NTHR, 2) mk_fwd(Args args) {
    extern __shared__ __attribute__((aligned(16))) unsigned char lds[];
    Frame F;
    F.lds = (LAS unsigned char*)lds; F.MISC = (volatile LAS unsigned*)(F.lds + MISC_OFF);
    F.tid = threadIdx.x; F.lane = F.tid & 63; F.wave = __builtin_amdgcn_readfirstlane(F.tid >> 6); F.G = gridDim.x; F.bid = blockIdx.x;
    F.ws = args.ws; F.out = args.out;
    for (int u = F.tid; u < (LDS_BYTES - LDSCTL_OFF) / 4; u += NTHR) ((LAS unsigned*)(F.lds + LDSCTL_OFF))[u] = 0u;
    __syncthreads();
    const int lo = args.ph_lo, hi = args.ph_hi;
    XcdBarrier bar; bar.bar = (unsigned*)(F.ws + WS_CTL) + CW_BAR; bar.x = 0; bar.st = nullptr;
    if (hi - lo > 1) bar = xcd_barrier_post((unsigned*)(F.ws + WS_CTL) + CW_BAR, F.MISC + 8);
#ifndef PH_MASK
#define PH_MASK 0xFFFF
#endif
#define IN(k) (((PH_MASK >> (k)) & 1) && lo <= (k) && (k) < hi)
#define REPS(k) for (int rep_ = 0; rep_ < (((REP_MASK >> (k)) & 1) ? 2 : 1); ++rep_)
#define SEAM(k) do { if (IN(k) && IN((k) + 1)) xcd_barrier(bar, F.tid); } while (0)
    const int vc = (int)blockIdx.x;
#ifdef PROBE_SEL
    unsigned long long pt0_ = 0, pdur_ = 0;
#define PH_BEGIN(k) do { if ((k) == PROBE_SEL % 20) pt0_ = __builtin_amdgcn_s_memrealtime(); if (F.tid == 0) { F.MISC[64] = ((k) == PROBE_SEL % 20) ? 1u : 0u; if ((k) == 0) F.MISC[65] = 0u; } } while (0)
#define PH_END(k) do { if ((k) == PROBE_SEL % 20) pdur_ = __builtin_amdgcn_s_memrealtime() - pt0_; } while (0)
#else
#define PH_BEGIN(k) do { } while (0)
#define PH_END(k) do { } while (0)
#endif
    if (IN(0)) REPS(0) { load_inputs(F); PH_BEGIN(0); p0_prologue(F); SEAM(0); PH_END(0); }
    if (IN(1)) REPS(1) { load_inputs(F); PH_BEGIN(1); p1_hx(F); p0_weight_copies<0>(F); SEAM(1); PH_END(1); }
    if (IN(2)) REPS(2) { load_inputs(F); PH_BEGIN(2); pg8::DenseSched S; S.init(wsp<bf16>(F, WS_HX), wsp<bf16>(F, WS_WA), MT, NA, D, F.G, vc); EpiProjA E{F.ws, F.b_mgate};
        pg8::gemm_phase<EpiProjA, pg8::DenseSched, true>(F.lds, S, E, F.wave); p0_weight_copies<1>(F, F.G == 256 ? (MT / 256) * (NA / 256) % 256 : 0); SEAM(2); PH_END(2); }
    if (IN(3)) REPS(3) { load_inputs(F); PH_BEGIN(3); p3_prep(F); SEAM(3); PH_END(3); }
#if SCAN_SCALAR
    if (IN(4)) REPS(4) { load_inputs(F); PH_BEGIN(4); p4_scan_local(F); SEAM(4); PH_END(4); }
    if (IN(5)) REPS(5) { load_inputs(F); PH_BEGIN(5); p5_scan_out(F); SEAM(5); PH_END(5); }
#else
    if (IN(4)) REPS(4) { load_inputs(F); PH_BEGIN(4); p4m_scan_local(F); SEAM(4); PH_END(4); }
    if (IN(5)) REPS(5) { load_inputs(F); PH_BEGIN(5); p5m_scan_out(F); SEAM(5); PH_END(5); }
#endif
    if (IN(6)) REPS(6) { load_inputs(F); PH_BEGIN(6); pg8::DenseSched S; S.init(wsp<bf16>(F, WS_HX), wsp<bf16>(F, WS_WB), M_LAT, NB, D, F.G, vc); EpiProjB E{F.ws, F.ml_norm, F.gla_norm};
        pg8::gemm_phase<EpiProjB, pg8::DenseSched, true>(F.lds, S, E, F.wave); SEAM(6); PH_END(6); }
    if (IN(7)) REPS(7) { load_inputs(F); PH_BEGIN(7);
        { pg8::DenseSched S; S.init(wsp<bf16>(F, WS_QKM), wsp<bf16>(F, WS_WPM), M_LAT, D, D, F.G, vc); EpiGate<0> E{F.ws}; pg8::gemm_phase<EpiGate<0>, pg8::DenseSched, false>(F.lds, S, E, F.wave); }
        VM_WAIT(); __syncthreads();
        { pg8::DenseSched S; S.init(wsp<bf16>(F, WS_QKG), wsp<bf16>(F, WS_WPG), M_LAT, D, D, F.G, vc); EpiGate<1> E{F.ws}; pg8::gemm_phase<EpiGate<1>, pg8::DenseSched, false>(F.lds, S, E, F.wave); }
        SEAM(7); PH_END(7); }
    if (IN(8)) REPS(8) { load_inputs(F); PH_BEGIN(8); pg8::DenseSched S; S.init(wsp<bf16>(F, WS_VM), wsp<bf16>(F, WS_WOUT), M_LAT, D, D, F.G, vc); EpiOut E{F.x, F.out, wsp<float>(F, WS_MODV)};
        pg8::gemm_phase<EpiOut, pg8::DenseSched, false>(F.lds, S, E, F.wave); SEAM(8); PH_END(8); }
    if (IN(9)) REPS(9) { load_inputs(F); PH_BEGIN(9); p9_route(F); if (IN(9) && IN(11)) xcd_barrier(bar, F.tid); PH_END(9); }
    if (IN(11)) REPS(11) { load_inputs(F); PH_BEGIN(11); moe_layout(F); pg8::GroupSched<true> S; S.A = wsp<bf16>(F, WS_H2); S.Bt = wsp<bf16>(F, WS_WUP); S.list_tok = wsp<int>(F, WS_LTOK); S.tab = (const LAS int*)(F.lds + LDS_TAB);
        S.K = 1024; S.ntiles = S.tab[17]; S.G = F.G; S.c = vc; EpiUp E{F.ws};
        pg8::gemm_phase<EpiUp, pg8::GroupSched<true>, true>(F.lds, S, E, F.wave); moe_weight_copies<1>(F, F.G == 256 ? (S.ntiles * 4) % 256 : 0); SEAM(11); PH_END(11); }
    if (IN(12)) REPS(12) { load_inputs(F); PH_BEGIN(12); moe_layout(F); pg8::GroupSched<false> S; S.A = wsp<bf16>(F, WS_HID); S.Bt = wsp<bf16>(F, WS_WDN); S.list_tok = nullptr; S.tab = (const LAS int*)(F.lds + LDS_TAB);
        S.K = 512; S.ntiles = S.tab[17]; S.G = F.G; S.c = vc; EpiDown E{F.ws, (const LAS int*)(F.lds + LDS_TAB)};
        pg8::gemm_phase<EpiDown, pg8::GroupSched<false>, true>(F.lds, S, E, F.wave); SEAM(12); PH_END(12); }
    if (IN(13)) REPS(13) { load_inputs(F); PH_BEGIN(13); p13_final(F); PH_END(13); }
#ifdef PROBE_SEL
    if (F.bid == PROBE_WG && F.tid == 0) { const unsigned long long d_ = PROBE_SEL < 20 ? pdur_ : (unsigned long long)F.MISC[65]; const unsigned long long te_ = __builtin_amdgcn_s_memrealtime() + 4ull * d_;
        while (__builtin_amdgcn_s_memrealtime() < te_) __builtin_amdgcn_s_sleep(8); }
#endif
#undef IN
#undef SEAM
}

extern "C" void kernel_launch(void* const* d_in, const int* in_sizes, int n_in, void* d_out, int out_size, void* d_ws, size_t ws_size, hipStream_t stream) {
    static int grid = 0;
    if (grid == 0) {
        if (n_in != 26 || out_size != M_LAT * D || ws_size < WS_END) { fprintf(stderr, "kernel_launch: unexpected shapes (n_in %d, out %d, ws %zu)\n", n_in, out_size, ws_size); grid = -1; return; }
        int dev = 0, cus = 0, per_cu = 0;
        if (hipGetDevice(&dev) != hipSuccess || hipDeviceGetAttribute(&cus, hipDeviceAttributeMultiprocessorCount, dev) != hipSuccess) { grid = -1; return; }
        if (hipFuncSetAttribute((const void*)mk_fwd, hipFuncAttributeMaxDynamicSharedMemorySize, LDS_BYTES) != hipSuccess) { fprintf(stderr, "kernel_launch: hipFuncSetAttribute failed\n"); grid = -1; return; }
        if (hipOccupancyMaxActiveBlocksPerMultiprocessor(&per_cu, (const void*)mk_fwd, NTHR, LDS_BYTES) != hipSuccess || per_cu < 1) fprintf(stderr, "kernel_launch: occupancy query reports %d\n", per_cu);
        (void)hipGetLastError();
        grid = cus;
    }
    if (grid < 0) return;
    (void)hipMemsetAsync((char*)d_ws + WS_CTL, 0, CTL_ZERO_BYTES, stream);
    Args a{};
    for (int i = 0; i < 26; ++i) a.in[i] = (const float*)d_in[i];
    a.out = (float*)d_out; a.ws = (unsigned char*)d_ws;
#if MK_ONE_LAUNCH
    a.ph_lo = 0; a.ph_hi = N_PHASES;
    hipLaunchKernelGGL(mk_fwd, dim3(grid), dim3(NTHR), LDS_BYTES, stream, a);
#else
    for (int p = 0; p < N_PHASES; ++p) { a.ph_lo = p; a.ph_hi = p + 1; hipLaunchKernelGGL(mk_fwd, dim3(grid), dim3(NTHR), LDS_BYTES, stream, a); }
#endif
}
```

```cpp
#include <hip/hip_runtime.h>
#include <cstdio>
#include <cstdint>

#ifndef SCAN_SCALAR
#define SCAN_SCALAR 0
#endif
#ifndef REP_MASK
#define REP_MASK 0x0
#endif
#ifndef MK_ONE_LAUNCH
#define MK_ONE_LAUNCH 1
#endif

#define LAS __attribute__((address_space(3)))
typedef unsigned short bf16;
typedef short bf16x8 __attribute__((ext_vector_type(8)));
typedef float f32x4 __attribute__((ext_vector_type(4)));
typedef float f32x2 __attribute__((ext_vector_type(2)));
typedef unsigned u32x4 __attribute__((ext_vector_type(4)));
typedef unsigned u32x2 __attribute__((ext_vector_type(2)));

constexpr int D = 1024, BATCH = 2, SEQ = 8192, CTXL = 256;
constexpr int M_LAT = BATCH * SEQ;
constexpr int M_CTX = BATCH * CTXL;
constexpr int MT = M_LAT + M_CTX;
constexpr int NW = 8, NTHR = 512;
constexpr int IN_W = 8240;
constexpr int NA = 4352;
constexpr int NB = 4096;
constexpr int CHUNK = 64, NCH_LAT = SEQ / CHUNK  , NCH_CTX = CTXL / CHUNK  ;
constexpr int NCHUNK = BATCH * NCH_LAT + BATCH * NCH_CTX;
constexpr int NSEG = 8, CPS = NCH_LAT / NSEG;
constexpr int NEXP = 16, DEXP = 512, NROWS_MAX = 36864  ;
constexpr float EPS = 1e-6f;

constexpr size_t MiB = 1u << 20;
constexpr size_t BIG = (size_t)MT * 1024 * 2;
constexpr size_t WS_CTL = 0, CTL_ZERO_BYTES = 1 * MiB;
constexpr size_t WS_MODV = 1 * MiB;
constexpr size_t WS_AB = 2 * MiB;
constexpr size_t WS_GENDM = WS_AB + 1088 * 1024;
constexpr size_t WS_GENDG = 4 * MiB;
constexpr size_t WS_SSQ = WS_GENDG + 1088 * 1024;
constexpr size_t WS_WA = 7 * MiB;
constexpr size_t WS_WB = 16 * MiB;
constexpr size_t WS_WPM = 24 * MiB, WS_WPG = 26 * MiB, WS_WOUT = 28 * MiB;
constexpr size_t WS_GATES = 30 * MiB;
constexpr size_t WS_NST = 35 * MiB;
constexpr size_t WS_GSEG = WS_NST + 256 * 1024;
constexpr size_t WS_ROUTE = 36 * MiB;
constexpr size_t WS_HX = 37 * MiB;
constexpr size_t WS_QKM = WS_HX + BIG;
constexpr size_t WS_VM = WS_QKM + BIG;
constexpr size_t WS_QKG = WS_VM + BIG;
constexpr size_t WS_VG = WS_QKG + BIG;
constexpr size_t WS_QKMC = WS_VG + BIG;
constexpr size_t WS_STATE = WS_QKMC + BIG;
constexpr size_t WS_QKGTC = WS_STATE + 16 * MiB;
constexpr size_t WS_END = WS_QKGTC + 2 * MiB;
static_assert(WS_END <= 256 * MiB, "ws map");
constexpr size_t WS_WUP = WS_HX;
constexpr size_t WS_H2 = 70 * MiB;
constexpr size_t WS_WDN = 103 * MiB;
constexpr size_t WS_HID = 136 * MiB;
constexpr size_t WS_YROWS = 172 * MiB;
constexpr size_t RT_EXP = 0;
constexpr size_t RT_W = 128 * 1024;
constexpr size_t RT_POS = 256 * 1024;
constexpr size_t RT_ROWTOK = 384 * 1024;
constexpr size_t RT_ROWW = 384 * 1024 + 144 * 1024;
constexpr size_t RT_TILE_E = 384 * 1024 + 288 * 1024;
constexpr size_t WS_LTOK = 120 * MiB, WS_LW = 122 * MiB;
constexpr int LCAP = 32768;
constexpr int LDS_TAB = 147456 - 1024 + 768;
constexpr int CW_BAR = 4096;
constexpr int CW_CNT = 8192;

#ifdef PROBE_SEL
#ifndef PROBE_WG
#define PROBE_WG 0
#endif
#define PMARK0(id) unsigned long long pm0_##id = 0; if (PROBE_SEL == (id)) pm0_##id = __builtin_amdgcn_s_memrealtime();
#define PMARK1(id) if (PROBE_SEL == (id) && F.tid == 0) F.MISC[65] += (unsigned)(__builtin_amdgcn_s_memrealtime() - pm0_##id);
#else
#define PMARK0(id)
#define PMARK1(id)
#endif
#define LDS_WAIT() asm volatile("s_waitcnt lgkmcnt(0)" ::: "memory")
#define VM_WAIT() asm volatile("s_waitcnt vmcnt(0)" ::: "memory")
__device__ __forceinline__ unsigned f2bf(float f) { unsigned u = __builtin_bit_cast(unsigned, f); return (u + 0x7fffu + ((u >> 16) & 1u)) >> 16; }
typedef __bf16 bf16x2_t __attribute__((ext_vector_type(2)));
__device__ __forceinline__ unsigned pkbf(float lo, float hi) { f32x2 v = {lo, hi}; return __builtin_bit_cast(unsigned, __builtin_convertvector(v, bf16x2_t)); }
__device__ __forceinline__ unsigned pk2(float lo, float hi) { return pkbf(lo, hi); }
__device__ __forceinline__ float bf2f(unsigned short h) { return __builtin_bit_cast(float, (unsigned)h << 16); }
__device__ __forceinline__ float bflo(unsigned w) { return __builtin_bit_cast(float, w << 16); }
__device__ __forceinline__ float bfhi(unsigned w) { return __builtin_bit_cast(float, w & 0xffff0000u); }
__device__ __forceinline__ float sigm(float x) { return __builtin_amdgcn_rcpf(1.f + __expf(-x)); }
__device__ __forceinline__ float siluf(float x) { return x * __builtin_amdgcn_rcpf(1.f + __expf(-x)); }
__device__ __forceinline__ float logsig(float x) { return fminf(x, 0.f) - log1pf(expf(-fabsf(x))); }
__device__ __forceinline__ float wave_sum(float v) {
#pragma unroll
    for (int o = 1; o < 64; o <<= 1) v += __shfl_xor(v, o);
    return v;
}

namespace pg8 {
#define PG8_LAS __attribute__((address_space(3)))
constexpr int BM = 256, BK = 64, HALF = 128, HTB = HALF * BK * 2, STAGE_BYTES = 8 * HTB, NXCD = 8, WGM = 8;
__host__ __device__ __forceinline__ int lds_byte(int r, int c) { const int st = (r >> 4) * 2 + (c >> 5), rr = r & 15, cc = c & 31, ob = rr * 64 + cc * 2; return st * 1024 + (ob ^ (((ob >> 9) & 1) << 5)); }
__host__ __device__ __forceinline__ void stage_rc(int b, int& R, int& C) { const int st = b / 1024, sb = b % 1024, swz = sb ^ (((sb >> 9) & 1) << 5); R = (st >> 1) * 16 + swz / 64; C = (st & 1) * 32 + (swz % 64) / 2; }
__host__ __device__ __forceinline__ int perm32(int rho) { const int n = rho >> 4, i = rho & 15; return 8 * (i >> 2) + 4 * n + (i & 3); }
struct Unit { int pm, pn, e; };
__device__ __forceinline__ unsigned cvt_pk_bf16(float lo, float hi) { return pkbf(lo, hi); }

struct DenseSched {
    static constexpr bool GATHER = false;
    const bf16* A; const bf16* Bt; int K, nM, nN, nwg, G, c;
    __device__ void init(const bf16* A_, const bf16* Bt_, int M, int N, int K_, int G_, int c_) { A = A_; Bt = Bt_; K = K_; nM = M / BM; nN = N / BM; nwg = nM * nN; G = G_; c = c_; }
    __device__ bool next(int i, Unit& u) const {
        const long L = (long)i * G + c; if (L >= nwg) return false;
        int wgid = (int)L; { const int q = nwg / NXCD, r = nwg % NXCD, xcd = wgid % NXCD, off = wgid / NXCD; wgid = (xcd < r ? xcd * (q + 1) : r * (q + 1) + (xcd - r) * q) + off; }
        const int nig = WGM * nN, gid = wgid / nig, fm = gid * WGM, gsz = (nM - fm) < WGM ? (nM - fm) : WGM;
        u.pm = fm + ((wgid % nig) % gsz); u.pn = (wgid % nig) / gsz; u.e = 0; return true;
    }
    __device__ __forceinline__ const char* a_base(const Unit& u) const { return (const char*)A + (size_t)u.pm * BM * K * 2; }
    __device__ __forceinline__ const char* b_base(const Unit& u) const { return (const char*)Bt + (size_t)u.pn * BM * K * 2; }
    __device__ __forceinline__ void a_offs(const Unit&, const int (&R)[2], const int (&C)[2], unsigned (&o)[2][2]) const {
#pragma unroll
        for (int h = 0; h < 2; ++h)
#pragma unroll
            for (int i = 0; i < 2; ++i) o[h][i] = (unsigned)((h * HALF + R[i]) * K + C[i]) * 2u;
    }
};
template <bool GATHER_> struct GroupSched {
    static constexpr bool GATHER = GATHER_;
    const bf16* A; const bf16* Bt; const int* list_tok; const PG8_LAS int* tab; int K, ntiles, G, c;
    __device__ bool next(int i, Unit& u) const {
        long L = (long)i * G + c;
        if (G == 256 && (long)(i + 1) * 256 <= (long)ntiles * 4) { const int xc = c & 7, j = c >> 3; L = (long)i * 256 + (long)(((xc << 3) | (j >> 2)) << 2) + (j & 3); }
        if (L >= (long)ntiles * 4) return false;
        u.pm = (int)(L >> 2); u.pn = (int)(L & 3); int e = 0; while (e < 15 && u.pm * BM >= tab[e + 1]) ++e; u.e = e; return true;
    }
    __device__ __forceinline__ const char* a_base(const Unit& u) const { return GATHER ? (const char*)A : (const char*)A + (size_t)u.pm * BM * K * 2; }
    __device__ __forceinline__ const char* b_base(const Unit& u) const { return (const char*)Bt + ((size_t)u.e * 1024 + (size_t)u.pn * BM) * K * 2; }
    __device__ __forceinline__ void a_offs(const Unit& u, const int (&R)[2], const int (&C)[2], unsigned (&o)[2][2]) const {
        const int pos0 = u.pm * BM - tab[u.e], cnt = tab[32 + u.e];
#pragma unroll
        for (int h = 0; h < 2; ++h)
#pragma unroll
            for (int i = 0; i < 2; ++i) {
                int row = h * HALF + R[i];
                if (GATHER) { const int pos = pos0 + row; const int pc = pos < cnt ? pos : 0; const int tk = list_tok[u.e * 32768 + pc]; row = pos < cnt ? tk : 0; }
                o[h][i] = (unsigned)(row * K + C[i]) * 2u; }
    }
};

template <class Epi, class Sched, bool ALIGN_EPI>
__device__ __forceinline__ void gemm_phase(PG8_LAS unsigned char* lds, const Sched& S, const Epi& E, const int wave_id) {
    int ln_ = (int)__builtin_amdgcn_mbcnt_hi(~0u, __builtin_amdgcn_mbcnt_lo(~0u, 0u)); asm volatile("" : "+v"(ln_));
    const int wid = wave_id, lane = ln_, tid = wid * 64 + lane, wr = wid >> 2, wc = wid & 3, fr = lane & 15, fq = lane >> 4;
    const int K = S.K, nt = K / BK;
    int Rr[2], Cc[2]; unsigned voffB[2];
#pragma unroll
    for (int i = 0; i < 2; ++i) { stage_rc(tid * 16 + i * 8192, Rr[i], Cc[i]); const int Rb = (Rr[i] & ~31) + perm32(Rr[i] & 31); voffB[i] = (unsigned)(Rb * K + Cc[i]) * 2u; }
    const size_t kstep = (size_t)(BK * 2);
    const size_t hstep = (size_t)HALF * K * 2;
    const unsigned ldsw = (unsigned)wid * 1024u;
    const int aoff = lds_byte(wr * 64 + fr, fq * 8), boff = lds_byte(wc * 32 + fr, fq * 8);
#define PG8_SA(b, h) (((b) * 2 + (h)) * HTB)
#define PG8_SB(b, h) ((4 + (b) * 2 + (h)) * HTB)
#define PG8_STAGE(bufoff, gbase, voff) do { _Pragma("unroll") for (int _i = 0; _i < 2; ++_i) \
        __builtin_amdgcn_global_load_lds((const unsigned*)((const char*)(gbase) + (voff)[_i]), (PG8_LAS unsigned*)(lds + (bufoff) + ldsw + _i * 8192), 16, 0, 0); } while (0)
#define PG8_LDA(dst, b, h) do { _Pragma("unroll") for (int m = 0; m < 4; ++m) _Pragma("unroll") for (int k = 0; k < 2; ++k) dst[m][k] = *(const PG8_LAS bf16x8*)(lds + PG8_SA(b, h) + aoff + m * 2048 + k * 1024); } while (0)
#define PG8_LDB(dst, b, h) do { _Pragma("unroll") for (int n = 0; n < 2; ++n) _Pragma("unroll") for (int k = 0; k < 2; ++k) dst[n][k] = *(const PG8_LAS bf16x8*)(lds + PG8_SB(b, h) + boff + n * 2048 + k * 1024); } while (0)
#define PG8_MMA(ai, bj, At, Bt) do { __builtin_amdgcn_s_setprio(1); _Pragma("unroll") for (int m = 0; m < 4; ++m) _Pragma("unroll") for (int n = 0; n < 2; ++n) _Pragma("unroll") for (int k = 0; k < 2; ++k) \
        acc[ai][bj][m][n] = __builtin_amdgcn_mfma_f32_16x16x32_bf16(Bt[n][k], At[m][k], acc[ai][bj][m][n], 0, 0, 0); __builtin_amdgcn_s_setprio(0); } while (0)
#define PG8_WAIT_V(n) asm volatile("s_waitcnt vmcnt(" #n ")" ::: "memory")
#define PG8_WAIT_L(n) asm volatile("s_waitcnt lgkmcnt(" #n ")" ::: "memory")
#define PG8_BAR __builtin_amdgcn_s_barrier()
#define PG8_SCHED __builtin_amdgcn_sched_barrier(0)
    Unit cur, nxt; int ui = 0;
    if (!S.next(0, cur)) return;
    unsigned ao[2][2], nao[2][2];
    S.a_offs(cur, Rr, Cc, ao);
    f32x4 acc[2][2][4][2];
#pragma unroll
    for (int a = 0; a < 2; ++a)
#pragma unroll
        for (int b = 0; b < 2; ++b)
#pragma unroll
            for (int m = 0; m < 4; ++m)
#pragma unroll
                for (int n = 0; n < 2; ++n) acc[a][b][m][n] = (f32x4){0.f, 0.f, 0.f, 0.f};
    bf16x8 At[4][2], B0[2][2], B1[2][2];
    const char* cA = S.a_base(cur); const char* cB = S.b_base(cur);
    PG8_STAGE(PG8_SB(0, 0), cB, voffB); PG8_STAGE(PG8_SB(0, 1), cB + hstep, voffB); PG8_STAGE(PG8_SA(0, 0), cA, ao[0]); PG8_STAGE(PG8_SA(0, 1), cA, ao[1]);
    if (wr == 1) PG8_BAR;
    PG8_WAIT_V(2); PG8_BAR;
    PG8_STAGE(PG8_SB(1, 0), cB + kstep, voffB); PG8_STAGE(PG8_SA(1, 0), cA + kstep, ao[0]); PG8_STAGE(PG8_SB(1, 1), cB + hstep + kstep, voffB);
    PG8_WAIT_V(6); PG8_BAR;
    for (;;) {
        const bool has_next = S.next(ui + 1, nxt);
        if (Sched::GATHER && has_next) S.a_offs(nxt, Rr, Cc, nao);
        else {
#pragma unroll
            for (int h = 0; h < 2; ++h)
#pragma unroll
                for (int i = 0; i < 2; ++i) nao[h][i] = ao[h][i]; }
        const char* nA = has_next ? S.a_base(nxt) : cA; const char* nB = has_next ? S.b_base(nxt) : cB;
        for (int t = 0; t < nt; t += 2) {
            const bool last = (t == nt - 2);
            const char* a1 = cA + (size_t)(t + 1) * kstep;
            const char* a2 = last ? nA : cA + (size_t)(t + 2) * kstep; const char* b2 = last ? nB : cB + (size_t)(t + 2) * kstep;
            const char* a3 = a2 + kstep; const char* b3 = b2 + kstep;
            unsigned o2[2][2];
#pragma unroll
            for (int h = 0; h < 2; ++h)
#pragma unroll
                for (int i = 0; i < 2; ++i) o2[h][i] = (Sched::GATHER && last) ? nao[h][i] : ao[h][i];
            PG8_LDB(B0, 0, 0); PG8_LDB(B1, 0, 1); PG8_SCHED; PG8_LDA(At, 0, 0); PG8_STAGE(PG8_SA(1, 1), a1, ao[1]);
            PG8_WAIT_V(8); PG8_WAIT_L(0); PG8_BAR; PG8_MMA(0, 0, At, B0); PG8_MMA(0, 1, At, B1); PG8_BAR; PG8_SCHED;
            PG8_LDA(At, 0, 1); PG8_STAGE(PG8_SB(0, 0), b2, voffB); PG8_STAGE(PG8_SB(0, 1), b2 + hstep, voffB); PG8_STAGE(PG8_SA(0, 0), a2, o2[0]);
            PG8_WAIT_V(8); PG8_WAIT_L(0); PG8_BAR; PG8_MMA(1, 0, At, B0); PG8_MMA(1, 1, At, B1); PG8_BAR; PG8_SCHED;
            PG8_LDB(B0, 1, 0); PG8_LDB(B1, 1, 1); PG8_SCHED; PG8_LDA(At, 1, 0); PG8_STAGE(PG8_SA(0, 1), a2, o2[1]);
            PG8_WAIT_V(8); PG8_WAIT_L(0); PG8_BAR; PG8_MMA(0, 0, At, B0); PG8_MMA(0, 1, At, B1); PG8_BAR; PG8_SCHED;
            PG8_LDA(At, 1, 1); PG8_STAGE(PG8_SB(1, 0), b3, voffB); PG8_STAGE(PG8_SB(1, 1), b3 + hstep, voffB); PG8_STAGE(PG8_SA(1, 0), a3, o2[0]);
            PG8_WAIT_V(8); PG8_WAIT_L(0); PG8_BAR; PG8_MMA(1, 0, At, B0); PG8_MMA(1, 1, At, B1); PG8_BAR; PG8_SCHED;
        }
        if constexpr (ALIGN_EPI) { if (wr == 0) PG8_BAR; }
#ifdef PROBE_SEL
        const unsigned long long pe0_ = __builtin_amdgcn_s_memrealtime();
#endif
        { int fr_ = fr, fq_ = fq; asm volatile("" : "+v"(fr_), "+v"(fq_));
          E(acc, cur, wr, wc, fr_, fq_); }
#ifdef PROBE_SEL
        { const unsigned long long pe1_ = __builtin_amdgcn_s_memrealtime(); volatile PG8_LAS unsigned* M_ = (volatile PG8_LAS unsigned*)(lds + 147456 - 1024 + 320); if (tid == 0 && M_[64] && PROBE_SEL < 40) M_[65] += (unsigned)(pe1_ - pe0_); }
#endif
        if (!has_next) break;
#pragma unroll
        for (int a = 0; a < 2; ++a)
#pragma unroll
            for (int b = 0; b < 2; ++b)
#pragma unroll
                for (int m = 0; m < 4; ++m)
#pragma unroll
                    for (int n = 0; n < 2; ++n) acc[a][b][m][n] = (f32x4){0.f, 0.f, 0.f, 0.f};
        cur = nxt; cA = nA; cB = nB; ++ui;
#pragma unroll
        for (int h = 0; h < 2; ++h)
#pragma unroll
            for (int i = 0; i < 2; ++i) ao[h][i] = nao[h][i];
        if constexpr (ALIGN_EPI) { if (wr == 1) PG8_BAR; }
    }
    PG8_WAIT_V(0);
    if constexpr (!ALIGN_EPI) { if (wr == 0) PG8_BAR; }
    PG8_BAR;
#undef PG8_SA
#undef PG8_SB
#undef PG8_STAGE
#undef PG8_LDA
#undef PG8_LDB
#undef PG8_MMA
#undef PG8_WAIT_V
#undef PG8_WAIT_L
#undef PG8_BAR
#undef PG8_SCHED
}
}
using pg8::Unit; using pg8::cvt_pk_bf16;

#define XB_TMO      128
#define XB_XCNT(j)  (256  + 64 * (j))
#define XB_XSUB(j)  (1280 + 64 * (j))
#define XB_XGEN(j)  (2304 + 64 * (j))
#define XB_TOP      3328
#define XB_TOPGEN   3392
#define XCD_BAR_WORDS 3456
#define XB_SPIN_CAP (1u << 18)
__device__ __forceinline__ unsigned xb_ld(unsigned* p)              { return __hip_atomic_load(p, __ATOMIC_RELAXED, __HIP_MEMORY_SCOPE_AGENT); }
__device__ __forceinline__ unsigned xb_add(unsigned* p, unsigned v) { return __hip_atomic_fetch_add(p, v, __ATOMIC_RELAXED, __HIP_MEMORY_SCOPE_AGENT); }
__device__ __forceinline__ unsigned xb_xcc_id() { return (unsigned)__builtin_amdgcn_s_getreg((3 << 11) | 20) & 0xFu; }
#define XB_SPIN(cond, bar) do { unsigned _sp = 0; while (cond) { __builtin_amdgcn_s_sleep(1); \
    if ((++_sp & 255u) == 0u) { if (xb_ld(&(bar)[XB_TMO])) break; if (_sp > XB_SPIN_CAP) { atomicAdd(&(bar)[XB_TMO], 1u); break; } } } } while (0)
struct XcdBarrier { unsigned* bar; unsigned x; volatile LAS unsigned* st; };
__device__ __forceinline__ XcdBarrier xcd_barrier_post(unsigned* bar, volatile LAS unsigned* st) {
    XcdBarrier b; b.bar = bar; b.x = xb_xcc_id(); b.st = st;
    if (threadIdx.x == 0) (void)xb_add(&bar[XB_XCNT(b.x)], 1u);
    return b;
}
__device__ __forceinline__ void xcd_barrier_complete(unsigned* bar, unsigned x, unsigned& nloc, unsigned& nx) {
    const unsigned G = gridDim.x * gridDim.y * gridDim.z;
    unsigned sum, cnt, mine, sp = 0u;
    for (;;) {
        sum = 0u; cnt = 0u; mine = 0u;
#pragma unroll
        for (unsigned j = 0; j < 16; ++j) { const unsigned c = xb_ld(&bar[XB_XCNT(j)]); sum += c; cnt += (c > 0u) ? 1u : 0u; mine = (j == x) ? c : mine; }
        if (sum == G) break;
        __builtin_amdgcn_s_sleep(1);
        if ((++sp & 255u) == 0u) { if (xb_ld(&bar[XB_TMO])) break; if (sp > XB_SPIN_CAP) { atomicAdd(&bar[XB_TMO], 1u); break; } }
    }
    nloc = mine > 0u ? mine : 1u; nx = cnt > 0u ? cnt : 1u;
}
__device__ __forceinline__ void xcd_barrier(const XcdBarrier& b, const int tid) {
    asm volatile("s_waitcnt vmcnt(0)" ::: "memory");
    __syncthreads();
    if (tid == 0) {
        unsigned* bar = b.bar;
        __builtin_amdgcn_s_waitcnt(0);
        unsigned nloc = b.st[0], nx = b.st[1];
        if (nloc == 0u) { xcd_barrier_complete(bar, b.x, nloc, nx); b.st[0] = nloc; b.st[1] = nx; }
        const unsigned old = xb_add(&bar[XB_XSUB(b.x)], 1u);
        const unsigned gen = old / nloc;
        if (old + 1u == (gen + 1u) * nloc) {
            __builtin_amdgcn_fence(__ATOMIC_RELEASE, "agent");
            asm volatile("s_waitcnt vmcnt(0)" ::: "memory");
            const unsigned og = xb_add(&bar[XB_TOP], 1u);
            const unsigned tg = og / nx;
            if (og + 1u == (tg + 1u) * nx) xb_add(&bar[XB_TOPGEN], 1u);
            else XB_SPIN(xb_ld(&bar[XB_TOPGEN]) == tg, bar);
            __builtin_amdgcn_fence(__ATOMIC_ACQUIRE, "agent");
            xb_add(&bar[XB_XGEN(b.x)], 1u);
            asm volatile("s_waitcnt vmcnt(0)" ::: "memory");
        } else {
            XB_SPIN(xb_ld(&bar[XB_XGEN(b.x)]) == gen, bar);
            __builtin_amdgcn_fence(__ATOMIC_ACQUIRE, "agent");
            asm volatile("s_waitcnt vmcnt(0)" ::: "memory");
        }
    }
    __syncthreads();
}

constexpr int RING_BYTES = 131072;
constexpr int LDS_BYTES = 147456;
constexpr int LDSCTL_OFF = LDS_BYTES - 1024, MISC_OFF = LDSCTL_OFF + 320;

struct Args { const float* in[26]; float* out; unsigned char* ws; int ph_lo, ph_hi; };
struct Frame {
    LAS unsigned char* lds; volatile LAS unsigned* MISC;
    int tid, lane, wave, G, bid;
    unsigned char* ws; float* out;
    const float *x, *c, *ctx, *c_ctx, *w_mod, *b_mod, *g_norm1, *w_in, *ml_conv, *ml_conv_b, *b_mgate, *ml_norm, *gla_w2, *gla_b2, *gla_norm,
                *w_proj_m, *w_proj_g, *w_out, *g_norm2, *w_grp, *b_grp, *w_rexp, *b_rexp, *w_up, *w_down, *g_final;
};
template <class T> __device__ __forceinline__ T* wsp(const Frame& F, size_t off) { return (T*)(F.ws + off); }

struct TItem { const float* W; bf16* WT; int Nsrc, K, k0, n0, sc; };
__device__ __forceinline__ int map_a(int n) { return n < 2048 ? n : (n < 4096 ? n + 1040 : (n < 4112 ? 3072 + (n - 4096) : (n < 4144 ? 6160 + (n - 4112) : -1))); }
__device__ __forceinline__ int map_b(int n) { return n < 1024 ? 2048 + n : (n < 2048 ? 5136 + (n - 1024) : (n < 3072 ? 6192 + (n - 2048) : 7216 + (n - 3072))); }
__device__ __forceinline__ int map_up(int n) { const int pn = n >> 8, j = n & 255; return j < 128 ? 128 * pn + j : 512 + 128 * pn + (j - 128); }
__device__ __forceinline__ void titem_load(const TItem& t, int lane, f32x4 (&v)[8]) {
    const int scc = t.sc < 0 ? 0 : t.sc;
#pragma unroll
    for (int r = 0; r < 8; ++r) v[r] = *(const f32x4*)(t.W + (size_t)(t.k0 + 8 * r + (lane >> 3)) * t.Nsrc + scc);
}
__device__ __forceinline__ void titem_store(const TItem& t, int lane, const f32x4 (&v)[8], LAS float* scr) {
    const float z = t.sc < 0 ? 0.f : 1.f;
#pragma unroll
    for (int r = 0; r < 8; ++r) { const int kk = 8 * r + (lane >> 3); LAS float* d = scr + kk * 33 + 4 * (lane & 7); d[0] = v[r][0] * z; d[1] = v[r][1] * z; d[2] = v[r][2] * z; d[3] = v[r][3] * z; }
    LDS_WAIT(); asm volatile("" ::: "memory");
    const int c = lane & 7;
#pragma unroll
    for (int j = 0; j < 4; ++j) { const int n = (lane >> 3) + 8 * j; const LAS float* s = scr + (8 * c) * 33 + n;
        u32x4 o; o.x = pk2(s[0 * 33], s[1 * 33]); o.y = pk2(s[2 * 33], s[3 * 33]); o.z = pk2(s[4 * 33], s[5 * 33]); o.w = pk2(s[6 * 33], s[7 * 33]);
        *(u32x4*)(t.WT + (size_t)(t.n0 + n) * t.K + t.k0 + 8 * c) = o; }
    LDS_WAIT(); asm volatile("" ::: "memory");
}
template <class Dec>
__device__ __forceinline__ void run_transposes(Frame& F, int nitems, Dec dec, const int skip = 0) {
    LAS float* scr = (LAS float*)(F.lds + F.wave * 16384);
    if (F.bid < skip) return;
    const int gw = (F.bid - skip) * NW + F.wave, NGW = (F.G - skip) * NW, last = nitems - 1;
    if (gw >= nitems) return;
    f32x4 va[8], vb[8]; TItem ia, ib;
    ia = dec(gw, F.lane); titem_load(ia, F.lane, va);
    for (int it = gw; it < nitems; it += 2 * NGW) {
        { const int j = it + NGW; ib = dec(j < last ? j : last, F.lane); titem_load(ib, F.lane, vb); }
        titem_store(ia, F.lane, va, scr);
        { const int j = it + 2 * NGW; ia = dec(j < last ? j : last, F.lane); titem_load(ia, F.lane, va); }
        if (it + NGW < nitems) titem_store(ib, F.lane, vb, scr);
    }
}
__device__ __forceinline__ void p0_prologue(Frame& F) {
    LAS float* scr = (LAS float*)(F.lds + F.wave * 16384);
    const int gw = F.bid * NW + F.wave, NGW = F.G * NW;
    if (F.bid < 192) {
        LAS float* red = (LAS float*)(F.lds);
        const int r = F.tid >> 3, c4 = F.tid & 7, col0 = F.bid * 32 + 4 * c4;
        f32x4 a0 = {0.f, 0.f, 0.f, 0.f}, a1 = a0, a2 = a0;
        for (int k = r; k < D; k += 64) {
            const f32x4 w = *(const f32x4*)(F.w_mod + (size_t)k * 6144 + col0);
            const float s0 = siluf(F.c[k]), s1 = siluf(F.c[D + k]), s2 = siluf(F.c_ctx[k]);
            a0 += w * s0; a1 += w * s1; a2 += w * s2; }
#pragma unroll
        for (int j = 0; j < 4; ++j) { red[r * 96 + 0 + 4 * c4 + j] = a0[j]; red[r * 96 + 32 + 4 * c4 + j] = a1[j]; red[r * 96 + 64 + 4 * c4 + j] = a2[j]; }
        __syncthreads();
        if (F.tid < 96) { float s = 0.f; for (int q = 0; q < 64; ++q) s += red[q * 96 + F.tid]; const int rr = F.tid >> 5, j = F.bid * 32 + (F.tid & 31);
            wsp<float>(F, WS_MODV)[rr * 6144 + j] = s + F.b_mod[j]; }
        __syncthreads();
    }
}
template <int PART>
__device__ __forceinline__ void p0_weight_copies(Frame& F, const int skip = 0) {
    constexpr int I_A = (NA / 32) * 16, I_B = (NB / 32) * 16, I_P = (1024 / 32) * 16;
    const float* w_in = F.w_in; const float* wpm = F.w_proj_m; const float* wpg = F.w_proj_g; const float* wo = F.w_out; unsigned char* ws = F.ws;
    run_transposes(F, PART == 0 ? I_A : I_B + 3 * I_P, [=](int it, int lane) {
        TItem t; t.K = D; const int r = PART == 0 ? it : it + I_A;
        const bool isA = r < I_A, isB = !isA && r < I_A + I_B; const int rp = r - I_A - I_B, pi = rp < 0 ? 0 : rp / I_P;
        const int rr = isA ? r : (isB ? r - I_A : rp - pi * I_P);
        t.k0 = 64 * (rr & 15); t.n0 = 32 * (rr >> 4); const int n = t.n0 + 4 * (lane & 7);
        t.W = (isA || isB) ? w_in : (pi == 0 ? wpm : (pi == 1 ? wpg : wo)); t.Nsrc = (isA || isB) ? IN_W : D;
        t.WT = (bf16*)(ws + (isA ? WS_WA : (isB ? WS_WB : (pi == 0 ? WS_WPM : (pi == 1 ? WS_WPG : WS_WOUT)))));
        t.sc = isA ? map_a(n) : (isB ? map_b(n) : n);
        return t; }, skip);
}
template <int PART>
__device__ __forceinline__ void moe_weight_copies(Frame& F, const int skip = 0) {
    constexpr int I_U = (1024 / 32) * 16  , I_D = (1024 / 32) * 8;
    const float* wup = F.w_up; const float* wdn = F.w_down; unsigned char* ws = F.ws;
    run_transposes(F, NEXP * (PART == 0 ? I_U : I_D), [=](int it, int lane) {
        TItem t; constexpr bool up = PART == 0; const int e = it / (up ? I_U : I_D), rr = it % (up ? I_U : I_D);
        t.K = up ? 1024 : 512; t.Nsrc = 1024;
        t.k0 = up ? 64 * (rr & 15) : 64 * (rr & 7); t.n0 = up ? 32 * (rr >> 4) : 32 * (rr >> 3); const int n = t.n0 + 4 * (lane & 7);
        t.W = up ? wup + (size_t)e * 1024 * 1024 : wdn + (size_t)e * 512 * 1024;
        t.WT = up ? (bf16*)(ws + WS_WUP) + (size_t)e * 1024 * 1024 : (bf16*)(ws + WS_WDN) + (size_t)e * 1024 * 512;
        t.sc = up ? map_up(n) : n;
        return t; }, skip);
}

__device__ __forceinline__ void p1_hx(Frame& F) {
    const int gw = F.bid * NW + F.wave, NGW = F.G * NW;
    const float* modv = wsp<float>(F, WS_MODV);
    LAS float* co = (LAS float*)F.lds; LAS float* shl = co + 3072;
    for (int i = F.tid; i < 3072; i += NTHR) { const int bsel = i >> 10, c = i & 1023; co[i] = F.g_norm1[c] * (modv[bsel * 6144 + 1024 + c] + 1.f); shl[i] = modv[bsel * 6144 + c]; }
    __syncthreads();
    constexpr int RPT = 9;
    for (int m0 = gw; m0 < MT; m0 += RPT * NGW) {
        f32x4 v[RPT][4];
#pragma unroll
        for (int k = 0; k < RPT; ++k) { const int m = m0 + k * NGW < MT ? m0 + k * NGW : m0;
            const float* src = m < M_LAT ? F.x + (size_t)m * D : F.ctx + (size_t)(m - M_LAT) * D;
#pragma unroll
            for (int j = 0; j < 4; ++j) v[k][j] = *(const f32x4*)(src + 4 * F.lane + 256 * j); }
        __builtin_amdgcn_sched_barrier(0);
#pragma unroll
        for (int k = 0; k < RPT; ++k) { const int m = m0 + k * NGW;
            if (m < MT) {
                float ssq = 0.f;
#pragma unroll
                for (int j = 0; j < 4; ++j) ssq += (v[k][j].x * v[k][j].x + v[k][j].y * v[k][j].y) + (v[k][j].z * v[k][j].z + v[k][j].w * v[k][j].w);
                const float rstd = 1.f / sqrtf(wave_sum(ssq) * (1.f / D) + EPS);
                const int bsel = m < M_LAT ? (m >> 13) : 2;
                bf16* o = wsp<bf16>(F, WS_HX) + (size_t)m * D;
#pragma unroll
                for (int j = 0; j < 4; ++j) { const int c = 4 * F.lane + 256 * j;
                    const f32x4 g = *(const LAS f32x4*)(co + bsel * 1024 + c), sh = *(const LAS f32x4*)(shl + bsel * 1024 + c);
                    const f32x4 h = (v[k][j] * rstd) * g + sh;
                    u32x2 w; w.x = pk2(h.x, h.y); w.y = pk2(h.z, h.w); *(u32x2*)(o + c) = w; } } }
    }
    __syncthreads();
}

struct EpiProjA {
    unsigned char* ws; const float* b_mgate;
    __device__ __forceinline__ void operator()(const f32x4 (&acc)[2][2][4][2], const Unit& u, int wr, int wc, int fr, int fq) const {
        const int row0 = u.pm * 256 + wr * 64 + fr;
        if (u.pn < 16) {
            bf16* base = (bf16*)(ws + WS_QKM + (size_t)(u.pn >> 2) * BIG) + (u.pn & 3) * 256 + wc * 32 + 8 * fq;
#pragma unroll
            for (int ai = 0; ai < 2; ++ai)
#pragma unroll
                for (int m = 0; m < 4; ++m) { bf16* rowp = base + (size_t)(row0 + ai * 128 + m * 16) * 1024;
#pragma unroll
                    for (int bj = 0; bj < 2; ++bj) { const f32x4 v0 = acc[ai][bj][m][0], v1 = acc[ai][bj][m][1];
                        u32x4 w; w.x = cvt_pk_bf16(v0[0], v0[1]); w.y = cvt_pk_bf16(v0[2], v0[3]); w.z = cvt_pk_bf16(v1[0], v1[1]); w.w = cvt_pk_bf16(v1[2], v1[3]);
                        *(u32x4*)(rowp + bj * 128) = w; } }
        } else if (wc < 2) {
            const int col = wc * 32 + 8 * fq;
            float* g = (float*)(ws + WS_GATES);
            f32x4 b0 = {0.f, 0.f, 0.f, 0.f}, b1 = b0;
            if (col < 16) { b0 = *(const f32x4*)(b_mgate + col); b1 = *(const f32x4*)(b_mgate + col + 4); }
#pragma unroll
            for (int ai = 0; ai < 2; ++ai)
#pragma unroll
                for (int m = 0; m < 4; ++m) { float* rowp = g + (size_t)(row0 + ai * 128 + m * 16) * 64 + col;
                    *(f32x4*)rowp = acc[ai][0][m][0] + b0; *(f32x4*)(rowp + 4) = acc[ai][0][m][1] + b1; }
        }
    }
};

__device__ __forceinline__ int chunk_row0(int ci) { return ci < 256 ? (ci >> 7) * SEQ + (ci & 127) * 64 : M_LAT + ((ci - 256) >> 2) * CTXL + ((ci - 256) & 3) * 64; }
__device__ __forceinline__ bf16* qkgt_row(const Frame& F, int dir, int m) {
    return m < M_LAT ? (bf16*)F.out + ((size_t)dir * M_LAT + m) * 1024 : wsp<bf16>(F, WS_QKGTC) + ((size_t)dir * M_CTX + (m - M_LAT)) * 1024;
}
__device__ __forceinline__ float logsig_fast(float x) { return fminf(x, 0.f) - __logf(1.f + __expf(-fabsf(x))); }
__device__ __forceinline__ void unpack8(const u32x4& v, float (&f)[8]) { f[0] = bflo(v.x); f[1] = bfhi(v.x); f[2] = bflo(v.y); f[3] = bfhi(v.y); f[4] = bflo(v.z); f[5] = bfhi(v.z); f[6] = bflo(v.w); f[7] = bfhi(v.w); }
__device__ __forceinline__ void p3_prep(Frame& F) {
    const bf16* QKM = wsp<bf16>(F, WS_QKM); bf16* QKMC = wsp<bf16>(F, WS_QKMC); const float* GATES = wsp<float>(F, WS_GATES); const bf16* QKG = wsp<bf16>(F, WS_QKG);
    for (int it = F.bid; it < NCHUNK * 3; it += F.G) {
        int tidl = F.tid; asm volatile("" : "+v"(tidl));
        const int lanel = tidl & 63;
        if (it < NCHUNK) {
            const int ci = F.G == 256 ? (it < 256 ? (it & 7) * 33 + (it >> 3) : (it - 256) * 33 + 32) : it, m0 = chunk_row0(ci);
            const int cg = tidl & 127, cq = tidl >> 7, ch = 8 * cg;
            const bool lat = ci < 256; const int c = lat ? (ci & 127) : ((ci - 256) & 3);
            const bool has_up = lat && c > 0, has_dn = lat && c < 127;
            const float osc = ch >= 512 ? 0.08838834764831845f : 1.f;
            f32x4 bz0 = *(const f32x4*)(F.ml_conv_b + ch), bz1 = *(const f32x4*)(F.ml_conv_b + ch + 4);
            f32x4 cw0[9], cw1[9];
#pragma unroll
            for (int q = 0; q < 9; ++q) { cw0[q] = *(const f32x4*)(F.ml_conv + q * 1024 + ch); cw1[q] = *(const f32x4*)(F.ml_conv + q * 1024 + ch + 4); }
            const f32x4 z4 = {0.f, 0.f, 0.f, 0.f};
#pragma unroll
            for (int q = 0; q < 3; ++q) { if (!has_up) { cw0[q] = z4; cw1[q] = z4; } if (!has_dn) { cw0[6 + q] = z4; cw1[6 + q] = z4; } }
            const int collo = lat ? 0 : (c == 0 ? 0 : -1), colhi = lat ? 63 : (c == 3 ? 63 : 64);
            const bf16* rb0 = QKM + (size_t)(has_up ? m0 - 64 : m0) * 1024 + ch; const bf16* rb1 = QKM + (size_t)m0 * 1024 + ch; const bf16* rb2 = QKM + (size_t)(has_dn ? m0 + 64 : m0) * 1024 + ch;
            auto ldc = [&](int dr, int col) -> u32x4 { const int cc = min(max(col, collo), colhi); const bf16* rb = dr == 0 ? rb0 : dr == 1 ? rb1 : rb2; return *(const u32x4*)(rb + (ptrdiff_t)cc * 1024); };
            const u32x4 zu = {0u, 0u, 0u, 0u};
            int cc = cq * 16;
            u32x4 w0[3], w1[3], n0[3], n1[3];
#pragma unroll
            for (int dr = 0; dr < 3; ++dr) { const u32x4 v = ldc(dr, cc - 1); w0[dr] = cc - 1 >= collo ? v : zu; w1[dr] = ldc(dr, cc); n0[dr] = ldc(dr, cc + 1); n1[dr] = ldc(dr, cc + 2); }
#pragma unroll 1
            for (int cb = 0; cb < 8; ++cb, cc += 2) {
                u32x4 p0[3], p1[3];
#pragma unroll
                for (int dr = 0; dr < 3; ++dr) { p0[dr] = ldc(dr, cc + 3); p1[dr] = ldc(dr, cc + 4); }
                __builtin_amdgcn_sched_barrier(0);
                float acc[2][8];
#pragma unroll
                for (int oc = 0; oc < 2; ++oc) { acc[oc][0] = bz0[0]; acc[oc][1] = bz0[1]; acc[oc][2] = bz0[2]; acc[oc][3] = bz0[3]; acc[oc][4] = bz1[0]; acc[oc][5] = bz1[1]; acc[oc][6] = bz1[2]; acc[oc][7] = bz1[3]; }
#pragma unroll
                for (int dr = 0; dr < 3; ++dr)
#pragma unroll
                    for (int dc = 0; dc < 4; ++dc) { float f[8]; unpack8(dc == 0 ? w0[dr] : dc == 1 ? w1[dr] : dc == 2 ? n0[dr] : n1[dr], f);
#pragma unroll
                        for (int oc = 0; oc < 2; ++oc) { const int t = dc - oc; if (t < 0 || t > 2) continue; const f32x4 k0 = cw0[dr * 3 + t], k1 = cw1[dr * 3 + t];
                            acc[oc][0] += k0[0] * f[0]; acc[oc][1] += k0[1] * f[1]; acc[oc][2] += k0[2] * f[2]; acc[oc][3] += k0[3] * f[3]; acc[oc][4] += k1[0] * f[4]; acc[oc][5] += k1[1] * f[5]; acc[oc][6] += k1[2] * f[6]; acc[oc][7] += k1[3] * f[7]; } }
#pragma unroll
                for (int oc = 0; oc < 2; ++oc) { u32x4 o; o.x = pk2(siluf(acc[oc][0]) * osc, siluf(acc[oc][1]) * osc); o.y = pk2(siluf(acc[oc][2]) * osc, siluf(acc[oc][3]) * osc);
                    o.z = pk2(siluf(acc[oc][4]) * osc, siluf(acc[oc][5]) * osc); o.w = pk2(siluf(acc[oc][6]) * osc, siluf(acc[oc][7]) * osc);
                    *(u32x4*)(QKMC + (size_t)(m0 + cc + oc) * 1024 + ch) = o; }
                __builtin_amdgcn_sched_barrier(0);
                const bool k0 = cc + 3 <= colhi, k1 = cc + 4 <= colhi;
#pragma unroll
                for (int dr = 0; dr < 3; ++dr) { w0[dr] = n0[dr]; w1[dr] = n1[dr]; n0[dr] = k0 ? p0[dr] : zu; n1[dr] = k1 ? p1[dr] : zu; }
            }
            {
                const int dir = F.wave >> 2, h = F.wave & 3, m = m0 + lanel;
                const float ip = GATES[(size_t)m * 64 + dir * 8 + h], lf = logsig(GATES[(size_t)m * 64 + dir * 8 + 4 + h]);
                float b = lf;
#pragma unroll
                for (int o = 1; o < 64; o <<= 1) { const float t = dir == 0 ? __shfl_up(b, o) : __shfl_down(b, o); const bool ok = dir == 0 ? (lanel >= o) : (lanel + o < 64); if (ok) b += t; }
                f32x2 ab; ab.x = expf(b); ab.y = expf(ip - b);
                wsp<f32x2>(F, WS_AB)[((size_t)dir * MT + m) * 4 + h] = ab;
                if (lanel == (dir == 0 ? 63 : 0)) wsp<float>(F, WS_GENDM)[((size_t)dir * NCHUNK + ci) * 4 + h] = expf(b);
            }
        } else {
            const int gi0 = it - NCHUNK;
            const int gi = F.G == 256 ? ((((gi0 >> 4) << 3) | (gi0 & 7)) << 1) | ((gi0 >> 3) & 1) : gi0;
            const int ci = gi >> 1, dir = gi & 1, m0 = chunk_row0(ci);
            LAS float* lr = (LAS float*)F.lds;
            LAS float* Bl = (LAS float*)(F.lds + 4096);
            __syncthreads();
            for (int i = tidl; i < 1024; i += NTHR) lr[i] = GATES[(size_t)(m0 + (i >> 4)) * 64 + 16 + dir * 16 + (i & 15)];
            const int ch = tidl;
            f32x2 w2p[8];
#pragma unroll
            for (int r = 0; r < 8; ++r) { w2p[r].x = F.gla_w2[((size_t)dir * 16 + 2 * r) * 512 + ch]; w2p[r].y = F.gla_w2[((size_t)dir * 16 + 2 * r + 1) * 512 + ch]; }
            const float b2 = F.gla_b2[dir * 512 + ch];
            __syncthreads();
            float b = 0.f;
#pragma unroll 1
            for (int i0 = 0; i0 < 64; i0 += 4) {
                f32x4 l[4][4];
#pragma unroll
                for (int u = 0; u < 4; ++u) { const int r = dir == 0 ? i0 + u : 63 - i0 - u;
#pragma unroll
                    for (int q = 0; q < 4; ++q) l[u][q] = *(const LAS f32x4*)(lr + r * 16 + 4 * q); }
                float ls[4];
#pragma unroll
                for (int u = 0; u < 4; ++u) {
                    f32x2 a2 = {b2, 0.f};
#pragma unroll
                    for (int q = 0; q < 4; ++q) { a2 = __builtin_elementwise_fma((f32x2){l[u][q][0], l[u][q][1]}, w2p[2 * q], a2); a2 = __builtin_elementwise_fma((f32x2){l[u][q][2], l[u][q][3]}, w2p[2 * q + 1], a2); }
                    const float xg = a2.x + a2.y;
                    ls[u] = fminf(xg, 0.f) - 0.6931471805599453f * __builtin_amdgcn_logf(1.f + __builtin_amdgcn_exp2f(-1.4426950408889634f * fabsf(xg))); }
#pragma unroll
                for (int u = 0; u < 4; ++u) { const int r = dir == 0 ? i0 + u : 63 - i0 - u; b += ls[u] * (1.f / 16.f); Bl[r * 512 + ch] = b; }
            }
            wsp<float>(F, WS_GENDG)[((size_t)dir * NCHUNK + ci) * 512 + ch] = __expf(b);
            __syncthreads();
            u32x4 vin[16];
            const int cp = tidl & 127, r0 = tidl >> 7; const bool isk = cp >= 64;
            const float sg = isk ? -1.4426950408889634f : 1.4426950408889634f, eoff = isk ? 0.f : -3.5f;
            const bf16* irow = QKG + (size_t)(m0 + r0) * 1024 + cp * 8; bf16* orow = qkgt_row(F, dir, m0) + (size_t)r0 * 1024 + cp * 8;
            const LAS float* brow = Bl + r0 * 512 + 8 * (cp & 63);
#pragma unroll
            for (int j = 0; j < 16; ++j) vin[j] = *(const u32x4*)(irow + (size_t)j * 4096);
#pragma unroll
            for (int j = 0; j < 16; ++j) {
                const u32x4 v = vin[j];
                const f32x4 b0 = *(const LAS f32x4*)(brow + j * 2048), b1 = *(const LAS f32x4*)(brow + j * 2048 + 4);
                float f[8]; unpack8(v, f); float e[8];
#pragma unroll
                for (int q = 0; q < 4; ++q) { e[q] = __builtin_amdgcn_exp2f(__builtin_fmaf(b0[q], sg, eoff)); e[4 + q] = __builtin_amdgcn_exp2f(__builtin_fmaf(b1[q], sg, eoff)); }
                u32x4 o; o.x = pk2(f[0] * e[0], f[1] * e[1]); o.y = pk2(f[2] * e[2], f[3] * e[3]); o.z = pk2(f[4] * e[4], f[5] * e[5]); o.w = pk2(f[6] * e[6], f[7] * e[7]);
                *(u32x4*)(orow + (size_t)j * 4096) = o; }
        }
    }
}

constexpr int L_AQ = 0, L_AK = 16384, L_VP = 32768, L_P = 49152, L_S = 65536, L_N = 131072 + 1024  ;
struct ScanSrc { const bf16* q; const bf16* k; const bf16* v; const f32x2* ab; const float* gend; int gstride; };
__device__ __forceinline__ int seg_chunk(int seg, int dir, int i) {
    if (seg < 0) return dir == 0 ? i : 3 - i;
    return dir == 0 ? seg * CPS + i : (NCH_LAT - 1 - seg * CPS) - i;
}
__device__ __forceinline__ void scan_stage(Frame& F, int model, int b, int h, int dir, int half, int ci, bool need_q) {
    const int m0 = chunk_row0(ci);
    LAS float* nb = (LAS float*)(F.lds + L_N);
    if (model == 0 && F.tid < 64) { const f32x2 ab = wsp<f32x2>(F, WS_AB)[((size_t)dir * MT + m0 + F.tid) * 4 + h]; nb[256 + F.tid] = ab.y; nb[320 + F.tid] = ab.x; }
    if (F.tid >= 64 && F.tid < 192) { const int dk = F.tid - 64;
        nb[128 + dk] = model == 0 ? wsp<float>(F, WS_GENDM)[((size_t)dir * NCHUNK + ci) * 4 + h] : wsp<float>(F, WS_GENDG)[((size_t)dir * NCHUNK + ci) * 512 + h * 128 + dk]; }
#pragma unroll
    for (int i = 0; i < 2; ++i) { const int p = F.tid + i * 512, r = p >> 4, cpart = p & 15, m = m0 + r;
        const bf16* qrow; const bf16* vrow;
        if (model == 0) { qrow = wsp<bf16>(F, WS_QKMC) + (size_t)m * 1024; vrow = wsp<bf16>(F, WS_VM) + (size_t)m * 1024; }
        else { qrow = qkgt_row(F, dir, m); vrow = wsp<bf16>(F, WS_VG) + (size_t)m * 1024; }
        if (need_q) *(LAS u32x4*)(F.lds + L_AQ + r * 256 + cpart * 16) = *(const u32x4*)(qrow + h * 128 + cpart * 8);
        *(LAS u32x4*)(F.lds + L_AK + r * 256 + cpart * 16) = *(const u32x4*)(qrow + 512 + h * 128 + cpart * 8);
        u32x4 v = *(const u32x4*)(vrow + h * 256 + half * 128 + cpart * 8);
        if (model == 0) { const float be = wsp<f32x2>(F, WS_AB)[((size_t)dir * MT + m) * 4 + h].y;
            v.x = pk2(bflo(v.x) * be, bfhi(v.x) * be); v.y = pk2(bflo(v.y) * be, bfhi(v.y) * be); v.z = pk2(bflo(v.z) * be, bfhi(v.z) * be); v.w = pk2(bflo(v.w) * be, bfhi(v.w) * be); }
        *(LAS u32x4*)(F.lds + L_VP + r * 256 + cpart * 16) = v; }
}
__device__ __forceinline__ void scan_update(Frame& F, int model) {
    LAS float* S = (LAS float*)(F.lds + L_S); LAS float* nb = (LAS float*)(F.lds + L_N);
    const LAS bf16* AK = (const LAS bf16*)(F.lds + L_AK); const LAS bf16* VP = (const LAS bf16*)(F.lds + L_VP);
    const int dk = F.tid >> 2, dv0 = (F.tid & 3) * 32;
    float a[32];
#pragma unroll
    for (int j = 0; j < 32; ++j) a[j] = S[dk * 128 + dv0 + j];
    float nn = 0.f;
    for (int s = 0; s < 64; ++s) { const float k = bf2f(AK[s * 128 + dk]);
        if (model == 0) nn += k * nb[256 + s];
#pragma unroll
        for (int j = 0; j < 32; j += 2) { const unsigned v = *(const LAS unsigned*)(VP + s * 128 + dv0 + j); a[j] += k * bflo(v); a[j + 1] += k * bfhi(v); } }
    const float g = nb[128 + dk];
#pragma unroll
    for (int j = 0; j < 32; ++j) S[dk * 128 + dv0 + j] = g * a[j];
    if (model == 0 && (F.tid & 3) == 0) nb[dk] = g * (nb[dk] + nn);
}
__device__ __forceinline__ bf16* state_ptr(const Frame& F, int sc, int slot, int half) { return wsp<bf16>(F, WS_STATE) + ((size_t)(sc * 8 + slot) * 2 + half) * 16384; }

__device__ __forceinline__ void p4_scan_local(Frame& F) {
    LAS float* S = (LAS float*)(F.lds + L_S); LAS float* nb = (LAS float*)(F.lds + L_N);
    for (int it0 = F.bid; it0 < 32 * 8 * 2; it0 += F.G) {
        const int it = (F.G == 256) ? (it0 & ~255) | ((((((it0 & 255) >> 4) << 3) | (it0 & 7)) << 1) | ((it0 >> 3) & 1)) : it0;
        const int half = it & 1, slot = (it >> 1) & 7, sc = it >> 4, seg = slot - 1;
        const int dir = sc & 1, h = (sc >> 1) & 3, b = (sc >> 3) & 1, model = sc >> 4;
        for (int i = F.tid; i < 16384; i += NTHR) S[i] = 0.f;
        if (F.tid < 128) nb[F.tid] = 0.f;
        float gacc = 1.f;
        __syncthreads();
        const int nch = seg < 0 ? NCH_CTX : CPS;
        for (int i = 0; i < nch; ++i) {
            const int c = seg_chunk(seg, dir, i), ci = seg < 0 ? 256 + b * 4 + c : b * 128 + c;
            scan_stage(F, model, b, h, dir, half, ci, false);
            __syncthreads();
            if (F.tid < 128) gacc *= nb[128 + F.tid];
            scan_update(F, model);
            __syncthreads();
        }
        bf16* st = state_ptr(F, sc, slot, half);
        for (int i = F.tid; i < 8192; i += NTHR) ((unsigned*)st)[i] = pk2(S[2 * i], S[2 * i + 1]);
        if (half == 0 && F.tid < 128) { wsp<float>(F, WS_NST)[(sc * 8 + slot) * 128 + F.tid] = nb[F.tid]; wsp<float>(F, WS_GSEG)[(sc * 8 + slot) * 128 + F.tid] = gacc; }
        __syncthreads();
    }
}
__device__ __forceinline__ void p5_scan_out(Frame& F) {
    LAS float* S = (LAS float*)(F.lds + L_S); LAS float* nb = (LAS float*)(F.lds + L_N); LAS float* P = (LAS float*)(F.lds + L_P);
    const LAS bf16* AQ = (const LAS bf16*)(F.lds + L_AQ); const LAS bf16* AK = (const LAS bf16*)(F.lds + L_AK); const LAS bf16* VP = (const LAS bf16*)(F.lds + L_VP);
    for (int it0 = F.bid; it0 < 2 * 2 * 4 * 8 * 2; it0 += F.G) {
        const int it = (F.G == 256) ? ((((it0 >> 4) << 3) | (it0 & 7)) << 1) | ((it0 >> 3) & 1) : it0;
        const int half = it & 1, seg = (it >> 1) & 7, h = (it >> 4) & 3, b = (it >> 6) & 1, model = it >> 7;
        bf16* HS = wsp<bf16>(F, model == 0 ? WS_QKM : WS_QKG);
        for (int dir = 0; dir < 2; ++dir) {
            const int sc = ((model * 2 + b) * 4 + h) * 2 + dir, s = dir == 0 ? seg : 7 - seg;
            { const int dk = F.tid >> 2, dv0 = (F.tid & 3) * 32; float a[32]; float nn = 0.f;
#pragma unroll
              for (int j = 0; j < 32; ++j) a[j] = 0.f;
              for (int slot = 0; slot <= s; ++slot) {
                  const float g = slot == 0 ? 0.f : wsp<float>(F, WS_GSEG)[(sc * 8 + slot) * 128 + dk];
                  const bf16* st = state_ptr(F, sc, slot, half) + dk * 128 + dv0;
#pragma unroll
                  for (int j = 0; j < 32; j += 2) { const unsigned v = *(const unsigned*)(st + j); a[j] = g * a[j] + bflo(v); a[j + 1] = g * a[j + 1] + bfhi(v); }
                  nn = g * nn + wsp<float>(F, WS_NST)[(sc * 8 + slot) * 128 + dk]; }
#pragma unroll
              for (int j = 0; j < 32; ++j) S[dk * 128 + dv0 + j] = a[j];
              if ((F.tid & 3) == 0) nb[dk] = nn; }
            __syncthreads();
            for (int i = 0; i < CPS; ++i) {
                const int c = seg_chunk(s, dir, i), ci = b * 128 + c, m0 = chunk_row0(ci);
                scan_stage(F, model, b, h, dir, half, ci, true);
                __syncthreads();
                for (int e = F.tid; e < 4096; e += NTHR) { const int t = e >> 6, s2 = e & 63; float p = 0.f;
                    if (dir == 0 ? (s2 <= t) : (s2 >= t)) {
                        for (int d8 = 0; d8 < 16; ++d8) { const u32x4 qa = *(const LAS u32x4*)(AQ + t * 128 + d8 * 8), ka = *(const LAS u32x4*)(AK + s2 * 128 + d8 * 8);
                            p += bflo(qa.x) * bflo(ka.x) + bfhi(qa.x) * bfhi(ka.x) + bflo(qa.y) * bflo(ka.y) + bfhi(qa.y) * bfhi(ka.y)
                               + bflo(qa.z) * bflo(ka.z) + bfhi(qa.z) * bfhi(ka.z) + bflo(qa.w) * bflo(ka.w) + bfhi(qa.w) * bfhi(ka.w); } }
                    P[e] = bf2f((unsigned short)f2bf(p)); }
                __syncthreads();
                { const int t = F.tid >> 3, dv0 = (F.tid & 7) * 16; float o[16];
#pragma unroll
                  for (int j = 0; j < 16; ++j) o[j] = 0.f;
                  float den = 0.f;
                  for (int s2 = 0; s2 < 64; ++s2) { const float p = P[t * 64 + s2];
                      if (model == 0) den += p * nb[256 + s2];
                      const u32x4 v0 = *(const LAS u32x4*)(VP + s2 * 128 + dv0), v1 = *(const LAS u32x4*)(VP + s2 * 128 + dv0 + 8);
                      o[0] += p * bflo(v0.x); o[1] += p * bfhi(v0.x); o[2] += p * bflo(v0.y); o[3] += p * bfhi(v0.y); o[4] += p * bflo(v0.z); o[5] += p * bfhi(v0.z); o[6] += p * bflo(v0.w); o[7] += p * bfhi(v0.w);
                      o[8] += p * bflo(v1.x); o[9] += p * bfhi(v1.x); o[10] += p * bflo(v1.y); o[11] += p * bfhi(v1.y); o[12] += p * bflo(v1.z); o[13] += p * bfhi(v1.z); o[14] += p * bflo(v1.w); o[15] += p * bfhi(v1.w); }
                  for (int dk = 0; dk < 128; ++dk) { const float q = bf2f(AQ[t * 128 + dk]);
                      if (model == 0) den += q * nb[dk];
                      const LAS float* sr = S + dk * 128 + dv0;
#pragma unroll
                      for (int j = 0; j < 16; ++j) o[j] += q * bf2f((unsigned short)f2bf(sr[j])); }
                  float rs = 1.f;
                  if (model == 0) { const float al = nb[320 + t]; rs = al / fmaxf(al * fabsf(den), 1.f); }
                  bf16* dst = HS + (size_t)(m0 + t) * 1024 + h * 256 + half * 128 + dv0;
                  float ssq = 0.f;
                  if (dir == 0) {
                      u32x4 w0, w1; w0.x = pk2(o[0] * rs, o[1] * rs); w0.y = pk2(o[2] * rs, o[3] * rs); w0.z = pk2(o[4] * rs, o[5] * rs); w0.w = pk2(o[6] * rs, o[7] * rs);
                      w1.x = pk2(o[8] * rs, o[9] * rs); w1.y = pk2(o[10] * rs, o[11] * rs); w1.z = pk2(o[12] * rs, o[13] * rs); w1.w = pk2(o[14] * rs, o[15] * rs);
                      *(u32x4*)dst = w0; *(u32x4*)(dst + 8) = w1;
                  } else {
                      const u32x4 p0 = *(const u32x4*)dst, p1 = *(const u32x4*)(dst + 8);
                      const float f[16] = {bflo(p0.x), bfhi(p0.x), bflo(p0.y), bfhi(p0.y), bflo(p0.z), bfhi(p0.z), bflo(p0.w), bfhi(p0.w), bflo(p1.x), bfhi(p1.x), bflo(p1.y), bfhi(p1.y), bflo(p1.z), bfhi(p1.z), bflo(p1.w), bfhi(p1.w)};
                      float r[16];
#pragma unroll
                      for (int j = 0; j < 16; ++j) { r[j] = f[j] + o[j] * rs; ssq += r[j] * r[j]; }
                      u32x4 w0, w1; w0.x = pk2(r[0], r[1]); w0.y = pk2(r[2], r[3]); w0.z = pk2(r[4], r[5]); w0.w = pk2(r[6], r[7]);
                      w1.x = pk2(r[8], r[9]); w1.y = pk2(r[10], r[11]); w1.z = pk2(r[12], r[13]); w1.w = pk2(r[14], r[15]);
                      *(u32x4*)dst = w0; *(u32x4*)(dst + 8) = w1;
                      ssq += __shfl_xor(ssq, 1); ssq += __shfl_xor(ssq, 2); ssq += __shfl_xor(ssq, 4);
                      if ((F.tid & 7) == 0) wsp<float>(F, WS_SSQ)[((size_t)(m0 + t) * 8 + model * 4 + h) * 2 + half] = ssq;
                  } }
                __syncthreads();
                scan_update(F, model);
                __syncthreads();
            }
        }
    }
}

typedef short s16x4 __attribute__((ext_vector_type(4)));
__device__ __forceinline__ unsigned offb(int row, int ch) { return 256u * (unsigned)row + 16u * (unsigned)(ch ^ (((row & 3) << 2) | ((row >> 2) & 3))); }
constexpr int M_AQ = 0, M_AK = 16384, M_VP = 32768, M_P = 49152, M_O = 57344, O_LD = 132;
template <int TILE>
__device__ __forceinline__ void tr_frag2(unsigned x0, unsigned x1, bf16x8& f0, bf16x8& f1) {
    s16x4 r0, r1, r2, r3;
    asm volatile("ds_read_b64_tr_b16 %0, %4 offset:%6\n\tds_read_b64_tr_b16 %1, %5 offset:%6\n\tds_read_b64_tr_b16 %2, %4 offset:%7\n\tds_read_b64_tr_b16 %3, %5 offset:%7\n\ts_waitcnt lgkmcnt(0)"
                 : "=&v"(r0), "=&v"(r1), "=&v"(r2), "=&v"(r3) : "v"(x0), "v"(x1), "i"(TILE), "i"(TILE + 8192) : "memory");
    f0 = __builtin_shufflevector(r0, r1, 0, 1, 2, 3, 4, 5, 6, 7); f1 = __builtin_shufflevector(r2, r3, 0, 1, 2, 3, 4, 5, 6, 7);
}
template <int TILE>
__device__ __forceinline__ void tr_frag8(unsigned a0, unsigned a1, unsigned b0, unsigned b1, unsigned c0, unsigned c1, unsigned d0, unsigned d1, bf16x8 (&f)[8]) {
    s16x4 r[16];
    asm volatile("ds_read_b64_tr_b16 %0, %16 offset:%24\n\tds_read_b64_tr_b16 %1, %17 offset:%24\n\tds_read_b64_tr_b16 %2, %16 offset:%25\n\tds_read_b64_tr_b16 %3, %17 offset:%25\n\t"
                 "ds_read_b64_tr_b16 %4, %18 offset:%24\n\tds_read_b64_tr_b16 %5, %19 offset:%24\n\tds_read_b64_tr_b16 %6, %18 offset:%25\n\tds_read_b64_tr_b16 %7, %19 offset:%25\n\t"
                 "ds_read_b64_tr_b16 %8, %20 offset:%24\n\tds_read_b64_tr_b16 %9, %21 offset:%24\n\tds_read_b64_tr_b16 %10, %20 offset:%25\n\tds_read_b64_tr_b16 %11, %21 offset:%25\n\t"
                 "ds_read_b64_tr_b16 %12, %22 offset:%24\n\tds_read_b64_tr_b16 %13, %23 offset:%24\n\tds_read_b64_tr_b16 %14, %22 offset:%25\n\tds_read_b64_tr_b16 %15, %23 offset:%25\n\ts_waitcnt lgkmcnt(0)"
                 : "=&v"(r[0]), "=&v"(r[1]), "=&v"(r[2]), "=&v"(r[3]), "=&v"(r[4]), "=&v"(r[5]), "=&v"(r[6]), "=&v"(r[7]), "=&v"(r[8]), "=&v"(r[9]), "=&v"(r[10]), "=&v"(r[11]), "=&v"(r[12]), "=&v"(r[13]), "=&v"(r[14]), "=&v"(r[15])
                 : "v"(a0), "v"(a1), "v"(b0), "v"(b1), "v"(c0), "v"(c1), "v"(d0), "v"(d1), "i"(TILE), "i"(TILE + 8192) : "memory");
#pragma unroll
    for (int j = 0; j < 8; ++j) f[j] = __builtin_shufflevector(r[2 * j], r[2 * j + 1], 0, 1, 2, 3, 4, 5, 6, 7);
}
template <int TILE>
__device__ __forceinline__ void tr_frag4(unsigned x0, unsigned x1, unsigned y0, unsigned y1, bf16x8& f0, bf16x8& f1, bf16x8& f2, bf16x8& f3) {
    s16x4 r0, r1, r2, r3, r4, r5, r6, r7;
    asm volatile("ds_read_b64_tr_b16 %0, %8 offset:%12\n\tds_read_b64_tr_b16 %1, %9 offset:%12\n\tds_read_b64_tr_b16 %2, %8 offset:%13\n\tds_read_b64_tr_b16 %3, %9 offset:%13\n\t"
                 "ds_read_b64_tr_b16 %4, %10 offset:%12\n\tds_read_b64_tr_b16 %5, %11 offset:%12\n\tds_read_b64_tr_b16 %6, %10 offset:%13\n\tds_read_b64_tr_b16 %7, %11 offset:%13\n\ts_waitcnt lgkmcnt(0)"
                 : "=&v"(r0), "=&v"(r1), "=&v"(r2), "=&v"(r3), "=&v"(r4), "=&v"(r5), "=&v"(r6), "=&v"(r7) : "v"(x0), "v"(x1), "v"(y0), "v"(y1), "i"(TILE), "i"(TILE + 8192) : "memory");
    f0 = __builtin_shufflevector(r0, r1, 0, 1, 2, 3, 4, 5, 6, 7); f1 = __builtin_shufflevector(r2, r3, 0, 1, 2, 3, 4, 5, 6, 7);
    f2 = __builtin_shufflevector(r4, r5, 0, 1, 2, 3, 4, 5, 6, 7); f3 = __builtin_shufflevector(r6, r7, 0, 1, 2, 3, 4, 5, 6, 7);
}
#define MFMA16(a, b, c) __builtin_amdgcn_mfma_f32_16x16x32_bf16((a), (b), (c), 0, 0, 0)
__device__ __forceinline__ bf16* mstate_ptr(const Frame& F, int sc, int slot, int half) { return wsp<bf16>(F, WS_STATE) + ((size_t)(sc * 8 + slot) * 2 + half) * 16384; }

#define LBAR() asm volatile("s_waitcnt lgkmcnt(0)\n\ts_barrier" ::: "memory")
template <bool OUT>
__device__ __forceinline__ void mscan_run(Frame& F, int model, int b, int h, int dir, int half, int seg, f32x4 (&S)[2][8], float& gacc) {
    LAS unsigned char* lds = F.lds; LAS float* nb = (LAS float*)(F.lds + L_N);
    LAS unsigned short* nbh = (LAS unsigned short*)(F.lds + L_N + 2048);
    const unsigned lb = (unsigned)(uintptr_t)F.lds;
    const int w = F.wave, lane = F.lane, li = lane & 15, lg = lane >> 4, tq = li >> 2, tp = lane & 3;
    const bool st = w < 4; const int sw = w & 3;
    const int nch = seg < 0 ? NCH_CTX : CPS;
    bf16* HS = wsp<bf16>(F, model == 0 ? WS_QKM : WS_QKG);
    const int mli = ((li & 3) << 2) | ((li >> 2) & 3);
    const unsigned rowb = 256u * li + 16u * (lg ^ mli);
    const unsigned o2b = 256u * li + 16u * ((lg >> 1) ^ mli) + 8u * (lg & 1);
    const unsigned trb0 = 256u * (8 * lg + tq) + 16u * ((tp >> 1) ^ ((tq << 2) | ((2 * lg) & 3))) + 8u * (tp & 1);
    const unsigned trb1 = 256u * (8 * lg + 4 + tq) + 16u * ((tp >> 1) ^ ((tq << 2) | ((2 * lg + 1) & 3))) + 8u * (tp & 1);
    const unsigned pra0 = lb + M_P + (128u * li + 16u * (lg ^ (li & 7))), pra1 = lb + M_P + ((128u * li + 16u * (lg ^ (li & 7))) ^ 64u);
    const unsigned poff0 = (unsigned)((F.tid >> 4) * 1024 + (F.tid & 15) * 8) * 2u, poff1 = poff0 + 32u * 2048u;
    auto final_pass = [&](const int m0, const u32x4 (&prevh)[2]) {
        LAS float* Ol = (LAS float*)(F.lds + M_O);
#pragma unroll
        for (int i = 0; i < 2; ++i) { const int p = F.tid + i * 512, t = p >> 4, c8 = p & 15;
            const f32x4 o0 = *(const LAS f32x4*)(Ol + t * O_LD + 8 * c8), o1 = *(const LAS f32x4*)(Ol + t * O_LD + 8 * c8 + 4);
            float rs = 1.f;
            if (model == 0) rs = nb[384 + t];
            bf16* dst = (bf16*)((unsigned char*)(HS + (size_t)m0 * 1024 + h * 256 + half * 128) + (i == 0 ? poff0 : poff1));
            float r[8] = {o0[0] * rs, o0[1] * rs, o0[2] * rs, o0[3] * rs, o1[0] * rs, o1[1] * rs, o1[2] * rs, o1[3] * rs};
            if (dir == 1) { const u32x4 pv = prevh[i];
                r[0] += bflo(pv.x); r[1] += bfhi(pv.x); r[2] += bflo(pv.y); r[3] += bfhi(pv.y); r[4] += bflo(pv.z); r[5] += bfhi(pv.z); r[6] += bflo(pv.w); r[7] += bfhi(pv.w);
                float ssq = (r[0] * r[0] + r[1] * r[1]) + (r[2] * r[2] + r[3] * r[3]) + (r[4] * r[4] + r[5] * r[5]) + (r[6] * r[6] + r[7] * r[7]);
                ssq += __shfl_xor(ssq, 1); ssq += __shfl_xor(ssq, 2); ssq += __shfl_xor(ssq, 4); ssq += __shfl_xor(ssq, 8);
                if (c8 == 0) wsp<float>(F, WS_SSQ)[((size_t)(m0 + t) * 8 + model * 4 + h) * 2 + half] = ssq; }
            u32x4 wv; wv.x = pkbf(r[0], r[1]); wv.y = pkbf(r[2], r[3]); wv.z = pkbf(r[4], r[5]); wv.w = pkbf(r[6], r[7]);
            *(u32x4*)dst = wv; }
    };
    const unsigned pwb = 128u * li + 8u * (lg & 1) + 16u * ((lg >> 1) ^ (li & 7));
    auto ptile = [&](const int ti, const int sh) {
        const bool used = dir == 0 ? !(sh == 1 && ti < 2) : !(sh == 0 && ti >= 2);
        if (!used) return;
        unsigned rowl = rowb; asm volatile("" : "+v"(rowl));
        bf16x8 pa[4], pb0[4], pb1[4];
#pragma unroll
        for (int kk = 0; kk < 4; ++kk) { const unsigned ra = lb + (rowl ^ ((unsigned)kk << 6)); pa[kk] = *(const LAS bf16x8*)(uintptr_t)(ra + M_AQ + 4096u * ti); pb0[kk] = *(const LAS bf16x8*)(uintptr_t)(ra + M_AK + 8192u * sh); pb1[kk] = *(const LAS bf16x8*)(uintptr_t)(ra + M_AK + 8192u * sh + 4096u); }
        f32x4 acc0 = {0.f, 0.f, 0.f, 0.f}, acc1 = acc0;
#pragma unroll
        for (int kk = 0; kk < 4; ++kk) { acc0 = MFMA16(pb0[kk], pa[kk], acc0); acc1 = MFMA16(pb1[kk], pa[kk], acc1); }
        const int t = 16 * ti + li;
#pragma unroll
        for (int sj = 0; sj < 2; ++sj) { const f32x4 acc = sj == 0 ? acc0 : acc1; const int s0 = 16 * (2 * sh + sj) + 4 * lg; float pv[4];
#pragma unroll
            for (int r = 0; r < 4; ++r) { const bool keep = dir == 0 ? (s0 + r <= t) : (s0 + r >= t); pv[r] = keep ? acc[r] : 0.f; }
            u32x2 pw; pw.x = pkbf(pv[0], pv[1]); pw.y = pkbf(pv[2], pv[3]);
            *(LAS u32x2*)(uintptr_t)(lb + M_P + 2048u * ti + (pwb ^ ((unsigned)(4 * sh + 2 * sj) << 4))) = pw; }
    };
    auto chunk_m0 = [&](const int ic) { const int c = seg_chunk(seg, dir, ic), ci = seg < 0 ? 256 + b * 4 + c : b * 128 + c; return chunk_row0(ci); };
    if (st) {
        const unsigned ola = lb + M_O + 4u * ((4 * lg) * O_LD + 32 * sw + li);
        for (int ic = 0; ic < nch; ++ic) {
            const int m0 = chunk_m0(ic);
            LBAR();
            if (F.tid < 128) gacc *= nb[128 + F.tid];
            unsigned o2l = o2b, tr0l = trb0, tr1l = trb1; asm volatile("" : "+v"(o2l), "+v"(tr0l), "+v"(tr1l));
            bf16x8 VB[2][2];
            tr_frag4<M_VP>(lb + (tr0l ^ ((unsigned)(2 * sw) << 5)), lb + (tr1l ^ ((unsigned)(2 * sw) << 5)), lb + (tr0l ^ ((unsigned)(2 * sw + 1) << 5)), lb + (tr1l ^ ((unsigned)(2 * sw + 1) << 5)), VB[0][0], VB[0][1], VB[1][0], VB[1][1]);
            u32x4 prevh[2] = {{0u, 0u, 0u, 0u}, {0u, 0u, 0u, 0u}};
            if (OUT) {
#pragma unroll
                for (int i = 0; i < 2; ++i) prevh[i] = *(const u32x4*)((const unsigned char*)(HS + (size_t)m0 * 1024 + h * 256 + half * 128) + (i == 0 ? poff0 : poff1) * (unsigned)dir);
                ptile(sw, 1);
                f32x4 O[2][4];
#pragma unroll
                for (int j = 0; j < 2; ++j)
#pragma unroll
                    for (int q = 0; q < 4; ++q) O[j][q] = (f32x4){0.f, 0.f, 0.f, 0.f};
#pragma unroll
                for (int kh = 0; kh < 2; ++kh) {
                    u32x2 alo[2][4], ahi[2][4];
#pragma unroll
                    for (int k2 = 0; k2 < 2; ++k2)
#pragma unroll
                        for (int q = 0; q < 4; ++q) { alo[k2][q] = *(const LAS u32x2*)(uintptr_t)((o2l ^ ((unsigned)(4 * (2 * kh + k2)) << 4)) + lb + M_AQ + 4096u * q); ahi[k2][q] = *(const LAS u32x2*)(uintptr_t)((o2l ^ ((unsigned)(4 * (2 * kh + k2) + 2) << 4)) + lb + M_AQ + 4096u * q); }
#pragma unroll
                    for (int k2 = 0; k2 < 2; ++k2) { const int kk = 2 * kh + k2; bf16x8 Bk[2];
#pragma unroll
                        for (int j = 0; j < 2; ++j) { u32x4 bw; bw.x = pkbf(S[j][2 * kk][0], S[j][2 * kk][1]); bw.y = pkbf(S[j][2 * kk][2], S[j][2 * kk][3]); bw.z = pkbf(S[j][2 * kk + 1][0], S[j][2 * kk + 1][1]); bw.w = pkbf(S[j][2 * kk + 1][2], S[j][2 * kk + 1][3]); Bk[j] = __builtin_bit_cast(bf16x8, bw); }
#pragma unroll
                        for (int q = 0; q < 4; ++q) { u32x4 aw; aw.x = alo[k2][q].x; aw.y = alo[k2][q].y; aw.z = ahi[k2][q].x; aw.w = ahi[k2][q].y; const bf16x8 Af = __builtin_bit_cast(bf16x8, aw);
                            O[0][q] = MFMA16(Af, Bk[0], O[0][q]); O[1][q] = MFMA16(Af, Bk[1], O[1][q]); } }
                    asm volatile("" ::: "memory");
                }
                LBAR();
                bf16x8 p0[4], p1[4];
#pragma unroll
                for (int q = 0; q < 4; ++q) { p0[q] = *(const LAS bf16x8*)(uintptr_t)(pra0 + 2048u * q); p1[q] = *(const LAS bf16x8*)(uintptr_t)(pra1 + 2048u * q); }
#pragma unroll
                for (int q = 0; q < 4; ++q) {
                    if (dir == 0 || q < 2) { O[0][q] = MFMA16(p0[q], VB[0][0], O[0][q]); O[1][q] = MFMA16(p0[q], VB[1][0], O[1][q]); }
                    if (dir == 1 || q >= 2) { O[0][q] = MFMA16(p1[q], VB[0][1], O[0][q]); O[1][q] = MFMA16(p1[q], VB[1][1], O[1][q]); } }
#pragma unroll
                for (int j = 0; j < 2; ++j)
#pragma unroll
                    for (int q = 0; q < 4; ++q)
#pragma unroll
                        for (int r = 0; r < 4; ++r) *(LAS float*)(uintptr_t)(ola + 64u * j + 4u * (unsigned)((16 * q + r) * O_LD)) = O[j][q][r];
            }
#pragma unroll
            for (int kp = 0; kp < 4; ++kp) { bf16x8 A0, A1, A2, A3; const int kt = 2 * kp;
                const f32x4 g0 = *(const LAS f32x4*)(nb + 128 + 16 * kt + 4 * lg), g1 = *(const LAS f32x4*)(nb + 128 + 16 * (kt + 1) + 4 * lg);
                tr_frag4<M_AK>(lb + (tr0l ^ ((unsigned)kt << 5)), lb + (tr1l ^ ((unsigned)kt << 5)), lb + (tr0l ^ ((unsigned)(kt + 1) << 5)), lb + (tr1l ^ ((unsigned)(kt + 1) << 5)), A0, A1, A2, A3);
#pragma unroll
                for (int j = 0; j < 2; ++j) { S[j][kt] = MFMA16(A0, VB[j][0], S[j][kt]); S[j][kt + 1] = MFMA16(A2, VB[j][0], S[j][kt + 1]); }
#pragma unroll
                for (int j = 0; j < 2; ++j) { S[j][kt] = MFMA16(A1, VB[j][1], S[j][kt]); S[j][kt + 1] = MFMA16(A3, VB[j][1], S[j][kt + 1]); }
#pragma unroll
                for (int j = 0; j < 2; ++j) { S[j][kt] = S[j][kt] * g0; S[j][kt + 1] = S[j][kt + 1] * g1; } }
            LBAR();
            if (OUT) final_pass(m0, prevh);
        }
    } else {
        const int ht = F.tid - 256;
        const unsigned hoff = (unsigned)((ht >> 4) * 1024 + (ht & 15) * 8) * 2u;
        const unsigned aoff = (unsigned)(ht >> 4) * 32u + 4u, aoffl = (unsigned)(ht & 63) * 32u;
        const f32x2* ABd = wsp<f32x2>(F, WS_AB) + (size_t)dir * MT * 4 + h;
        const bf16* vbase = wsp<bf16>(F, model == 0 ? WS_VM : WS_VG) + h * 256 + half * 128;
        struct SR { u32x4 q[4], k[4], v[4]; float be[4]; f32x2 ab; float ge; };
        SR R;
        auto issue = [&](const int ic_) {
            const int c_ = seg_chunk(seg, dir, ic_), ci_ = seg < 0 ? 256 + b * 4 + c_ : b * 128 + c_, m0_ = chunk_row0(ci_);
            const unsigned char* abr = (const unsigned char*)(ABd + (size_t)m0_ * 4);
            { const float* abp = (const float*)(abr + aoffl); R.ab.x = abp[0]; R.ab.y = abp[1]; }
            const float* gp = model == 0 ? wsp<float>(F, WS_GENDM) + ((size_t)dir * NCHUNK + ci_) * 4 + h : wsp<float>(F, WS_GENDG) + ((size_t)dir * NCHUNK + ci_) * 512 + h * 128 + ((ht - 64) & 127);
            R.ge = *gp;
            const long long qoff = model == 0 ? (long long)WS_QKMC : (m0_ < M_LAT ? 0ll : (long long)WS_QKGTC + ((long long)dir * M_CTX - M_LAT) * 2048);
            const unsigned char* qbb = (model == 1 && m0_ < M_LAT) ? (const unsigned char*)F.out + (size_t)dir * M_LAT * 2048 : (const unsigned char*)F.ws + qoff;
            const unsigned char* qr = qbb + (size_t)m0_ * 2048 + h * 256;
            const unsigned char* vr = (const unsigned char*)(vbase + (size_t)m0_ * 1024);
#pragma unroll
            for (int i = 0; i < 4; ++i) { const unsigned o = hoff + (unsigned)i * 16u * 2048u;
                if (OUT) R.q[i] = *(const u32x4*)(qr + o);
                R.k[i] = *(const u32x4*)(qr + 1024 + o); R.v[i] = *(const u32x4*)(vr + o); R.be[i] = *(const float*)(abr + aoff + (unsigned)i * 16u * 32u); }
        };
        const int ti = sw;
        const unsigned fra = lb + L_N + 2048 + (li == 1 ? 128u : 0u) + 16u * lg;
        const unsigned nfa = lb + L_N + 2048 + 256 + (li == 1 ? 256u : 0u) + 16u * lg;
        issue(0);
        for (int ic = 0; ic < nch; ++ic) {
            const int m0 = chunk_m0(ic);
            if (model == 0 && ht < 64) { const float be = R.ab.y; nb[320 + ht] = R.ab.x;
                const unsigned hi = pkbf(be, be) & 0xffffu; nbh[ht] = (unsigned short)hi; nbh[64 + ht] = (unsigned short)(pkbf(be - bflo(hi), 0.f) & 0xffffu); }
            if (ht >= 64 && ht < 192) nb[128 + ht - 64] = R.ge;
#pragma unroll
            for (int i = 0; i < 4; ++i) { const int p = ht + i * 256, r = p >> 4, cp = p & 15;
                const unsigned o = offb(r, cp);
                if (OUT) *(LAS u32x4*)(lds + M_AQ + o) = R.q[i];
                *(LAS u32x4*)(lds + M_AK + o) = R.k[i];
                u32x4 v = R.v[i];
                if (model == 0) { const float be = R.be[i];
                    v.x = pkbf(bflo(v.x) * be, bfhi(v.x) * be); v.y = pkbf(bflo(v.y) * be, bfhi(v.y) * be); v.z = pkbf(bflo(v.z) * be, bfhi(v.z) * be); v.w = pkbf(bflo(v.w) * be, bfhi(v.w) * be); }
                *(LAS u32x4*)(lds + M_VP + o) = v; }
            LBAR();
            u32x4 prevh[2] = {{0u, 0u, 0u, 0u}, {0u, 0u, 0u, 0u}};
            if (OUT) {
#pragma unroll
                for (int i = 0; i < 2; ++i) prevh[i] = *(const u32x4*)((const unsigned char*)(HS + (size_t)m0 * 1024 + h * 256 + half * 128) + (i == 0 ? poff0 : poff1) * (unsigned)dir);
                ptile(ti, 0);
            }
            if (ic + 1 < nch) issue(ic + 1);
            unsigned rowl = rowb, tr0l = trb0, tr1l = trb1; asm volatile("" : "+v"(rowl), "+v"(tr0l), "+v"(tr1l));
            bf16x8 BB0, BB1;
            { u32x4 z = {0u, 0u, 0u, 0u}; BB0 = __builtin_bit_cast(bf16x8, z); BB1 = BB0; }
            if (model == 0) { u32x4 f0 = *(const LAS u32x4*)(uintptr_t)fra, f1 = *(const LAS u32x4*)(uintptr_t)(fra + 64u); const u32x4 z = {0u, 0u, 0u, 0u};
                if (li > 1) { f0 = z; f1 = z; } BB0 = __builtin_bit_cast(bf16x8, f0); BB1 = __builtin_bit_cast(bf16x8, f1); }
            f32x4 dq = {0.f, 0.f, 0.f, 0.f};
            if (OUT && model == 0) {
                bf16x8 pa[4]; u32x4 nf[4]; const u32x4 z = {0u, 0u, 0u, 0u};
#pragma unroll
                for (int kk = 0; kk < 4; ++kk) { pa[kk] = *(const LAS bf16x8*)(uintptr_t)(lb + (rowl ^ ((unsigned)kk << 6)) + M_AQ + 4096u * ti); nf[kk] = *(const LAS u32x4*)(uintptr_t)(nfa + 64u * kk); if (li > 1) nf[kk] = z; }
#pragma unroll
                for (int kk = 0; kk < 4; ++kk) dq = MFMA16(pa[kk], __builtin_bit_cast(bf16x8, nf[kk]), dq);
            }
            f32x4 nacc0 = {0.f, 0.f, 0.f, 0.f}, nacc1 = nacc0;
            if (model == 0) { bf16x8 A0, A1, A2, A3;
                tr_frag4<M_AK>(lb + (tr0l ^ ((unsigned)(2 * ti) << 5)), lb + (tr1l ^ ((unsigned)(2 * ti) << 5)), lb + (tr0l ^ ((unsigned)(2 * ti + 1) << 5)), lb + (tr1l ^ ((unsigned)(2 * ti + 1) << 5)), A0, A1, A2, A3);
                nacc0 = MFMA16(A0, BB0, nacc0); nacc0 = MFMA16(A1, BB1, nacc0); nacc1 = MFMA16(A2, BB0, nacc1); nacc1 = MFMA16(A3, BB1, nacc1); }
            float nnew[8] = {0.f, 0.f, 0.f, 0.f, 0.f, 0.f, 0.f, 0.f};
            if (model == 0) { const f32x4 no0 = *(const LAS f32x4*)(nb + 32 * ti + 4 * lg), no1 = *(const LAS f32x4*)(nb + 32 * ti + 16 + 4 * lg), gw0 = *(const LAS f32x4*)(nb + 128 + 32 * ti + 4 * lg), gw1 = *(const LAS f32x4*)(nb + 128 + 32 * ti + 16 + 4 * lg);
#pragma unroll
                for (int r = 0; r < 4; ++r) { nnew[r] = gw0[r] * (no0[r] + nacc0[r] + __shfl_xor(nacc0[r], 1)); nnew[4 + r] = gw1[r] * (no1[r] + nacc1[r] + __shfl_xor(nacc1[r], 1)); } }
            if (OUT) {
                LBAR();
                if (model == 0) { f32x4 dp = dq;
                    const bf16x8 p0 = *(const LAS bf16x8*)(uintptr_t)(pra0 + 2048u * ti), p1 = *(const LAS bf16x8*)(uintptr_t)(pra1 + 2048u * ti);
                    if (dir == 0 || ti < 2) dp = MFMA16(p0, BB0, dp);
                    if (dir == 1 || ti >= 2) dp = MFMA16(p1, BB1, dp);
#pragma unroll
                    for (int r = 0; r < 4; ++r) { const float v = dp[r] + __shfl_xor(dp[r], 1); const float al = nb[320 + 16 * ti + 4 * lg + r];
                        if (li == 0) nb[384 + 16 * ti + 4 * lg + r] = al / fmaxf(al * fabsf(v), 1.f); } }
            }
            LBAR();
            if (model == 0 && li == 0) {
#pragma unroll
                for (int j = 0; j < 2; ++j) { const int dk0 = 32 * ti + 16 * j + 4 * lg; const float* nn = nnew + 4 * j;
                    f32x4 nv = {nn[0], nn[1], nn[2], nn[3]}; *(LAS f32x4*)(nb + dk0) = nv;
                    u32x2 hv, lv; const unsigned h0 = pkbf(nn[0], nn[1]), h1 = pkbf(nn[2], nn[3]); hv.x = h0; hv.y = h1;
                    lv.x = pkbf(nn[0] - bflo(h0), nn[1] - bfhi(h0)); lv.y = pkbf(nn[2] - bflo(h1), nn[3] - bfhi(h1));
                    *(LAS u32x2*)(nbh + 128 + dk0) = hv; *(LAS u32x2*)(nbh + 256 + dk0) = lv; } }
            if (OUT) final_pass(m0, prevh);
        }
    }
}
__device__ __forceinline__ void p4m_scan_local(Frame& F) {
    LAS float* nb = (LAS float*)(F.lds + L_N);
    for (int it0 = F.bid; it0 < 32 * 8 * 2; it0 += F.G) {
        const int it = (F.G == 256) ? (it0 & ~255) | ((((((it0 & 255) >> 4) << 3) | (it0 & 7)) << 1) | ((it0 >> 3) & 1)) : it0;
        const int half = it & 1, slot = (it >> 1) & 7, sc = it >> 4, seg = slot - 1;
        const int dir = sc & 1, h = (sc >> 1) & 3, b = (sc >> 3) & 1, model = sc >> 4;
        f32x4 S[2][8];
#pragma unroll
        for (int j = 0; j < 2; ++j)
#pragma unroll
            for (int kt = 0; kt < 8; ++kt) S[j][kt] = (f32x4){0.f, 0.f, 0.f, 0.f};
        __syncthreads();
        if (F.tid < 128) nb[F.tid] = 0.f;
        float gacc = 1.f;
        mscan_run<false>(F, model, b, h, dir, half, seg, S, gacc);
        __syncthreads();
        if (F.wave < 4) {
#pragma unroll
            for (int j = 0; j < 2; ++j) { unsigned so = (unsigned)((2 * F.wave + j) * 512 + F.lane) * 8u; asm volatile("" : "+v"(so));
                bf16* st = (bf16*)((unsigned char*)mstate_ptr(F, sc, slot, half) + so);
#pragma unroll
                for (int kt = 0; kt < 8; ++kt) { u32x2 v; v.x = pkbf(S[j][kt][0], S[j][kt][1]); v.y = pkbf(S[j][kt][2], S[j][kt][3]); *(u32x2*)(st + kt * 256) = v; } } }
        if (half == 0 && F.tid < 128) { wsp<float>(F, WS_NST)[(sc * 8 + slot) * 128 + F.tid] = nb[F.tid]; wsp<float>(F, WS_GSEG)[(sc * 8 + slot) * 128 + F.tid] = gacc; }
    }
}
__device__ __forceinline__ void p5m_scan_out(Frame& F) {
    LAS float* nb = (LAS float*)(F.lds + L_N);
    for (int it0 = F.bid; it0 < 2 * 2 * 4 * 8 * 2; it0 += F.G) {
        const int it = (F.G == 256) ? ((((it0 >> 4) << 3) | (it0 & 7)) << 1) | ((it0 >> 3) & 1) : it0;
        const int half = it & 1, seg = (it >> 1) & 7, h = (it >> 4) & 3, b = (it >> 6) & 1, model = it >> 7;
        for (int dir = 0; dir < 2; ++dir) {
            const int sc = ((model * 2 + b) * 4 + h) * 2 + dir, s = dir == 0 ? seg : 7 - seg;
            f32x4 S[2][8];
#pragma unroll
            for (int j = 0; j < 2; ++j)
#pragma unroll
                for (int kt = 0; kt < 8; ++kt) S[j][kt] = (f32x4){0.f, 0.f, 0.f, 0.f};
            float nn = 0.f;
            for (int slot = 0; slot <= s; ++slot) {
                const float* gs = wsp<float>(F, WS_GSEG) + (sc * 8 + slot) * 128;
                const float gv = gs[F.tid & 127], nv = wsp<float>(F, WS_NST)[(sc * 8 + slot) * 128 + (F.tid & 127)];
                if (F.wave < 4) {
                    f32x4 gv4[8];
#pragma unroll
                    for (int kt = 0; kt < 8; ++kt) gv4[kt] = *(const f32x4*)(gs + 16 * kt + 4 * (F.lane >> 4));
#pragma unroll
                    for (int j = 0; j < 2; ++j) { unsigned so = (unsigned)((2 * F.wave + j) * 512 + F.lane) * 8u; asm volatile("" : "+v"(so));
                        const bf16* stp = (const bf16*)((const unsigned char*)mstate_ptr(F, sc, slot, half) + so);
                        u32x2 sv[8];
#pragma unroll
                        for (int kt = 0; kt < 8; ++kt) sv[kt] = *(const u32x2*)(stp + kt * 256);
#pragma unroll
                        for (int kt = 0; kt < 8; ++kt) { const u32x2 v = sv[kt]; f32x4 g4 = gv4[kt]; if (slot == 0) g4 = (f32x4){0.f, 0.f, 0.f, 0.f};
                            S[j][kt][0] = g4[0] * S[j][kt][0] + bflo(v.x); S[j][kt][1] = g4[1] * S[j][kt][1] + bfhi(v.x); S[j][kt][2] = g4[2] * S[j][kt][2] + bflo(v.y); S[j][kt][3] = g4[3] * S[j][kt][3] + bfhi(v.y); } } }
                nn = (slot > 0 ? gv : 0.f) * nn + nv; }
            __syncthreads();
            if (F.tid < 128) { nb[F.tid] = nn; LAS unsigned short* nbh = (LAS unsigned short*)(F.lds + L_N + 2048);
                const unsigned hi = pkbf(nn, nn) & 0xffffu; nbh[128 + F.tid] = (unsigned short)hi; nbh[256 + F.tid] = (unsigned short)(pkbf(nn - bflo(hi), 0.f) & 0xffffu); }
            float gacc = 1.f;
            mscan_run<true>(F, model, b, h, dir, half, s, S, gacc);
        }
    }
}

struct EpiProjB {
    unsigned char* ws; const float* ml_norm; const float* gla_norm;
    __device__ __forceinline__ void operator()(const f32x4 (&acc)[2][2][4][2], const Unit& u, int wr, int wc, int fr, int fq) const {
        const int row0 = u.pm * 256 + wr * 64 + fr, colt = (u.pn & 3) * 256 + wc * 32 + 8 * fq;
        if (u.pn < 8) {
            const int model = u.pn >> 2, head = u.pn & 3;
            bf16* base = (bf16*)(ws + (model == 0 ? WS_QKM : WS_QKG)) + colt;
            const float* nw = (model == 0 ? ml_norm : gla_norm) + colt;
            const float* ssq = (const float*)(ws + WS_SSQ);
            const float gsel = model == 0 ? 0.f : 1.f;
            f32x4 nwv[2][2];
#pragma unroll
            for (int bj = 0; bj < 2; ++bj) { nwv[bj][0] = *(const f32x4*)(nw + bj * 128); nwv[bj][1] = *(const f32x4*)(nw + bj * 128 + 4); }
            u32x4 hvq[8][2]; f32x2 sqq[8];
#define EPB_ISSUE(g) do { const int row_ = row0 + ((g) >> 2) * 128 + ((g) & 3) * 16; const bf16* rp_ = base + (size_t)row_ * 1024; hvq[g][0] = *(const u32x4*)rp_; hvq[g][1] = *(const u32x4*)(rp_ + 128); \
                sqq[g] = *(const f32x2*)(ssq + ((size_t)row_ * 8 + model * 4 + head) * 2); } while (0)
            EPB_ISSUE(0); EPB_ISSUE(1); EPB_ISSUE(2); EPB_ISSUE(3);
#pragma unroll
            for (int g = 0; g < 8; ++g) { const int ai = g >> 2, m = g & 3;
                __builtin_amdgcn_sched_barrier(0);
                if (g == 1) { EPB_ISSUE(4); EPB_ISSUE(5); }
                if (g == 2) { EPB_ISSUE(6); EPB_ISSUE(7); }
                __builtin_amdgcn_sched_barrier(0);
                const int row = row0 + ai * 128 + m * 16; bf16* rowp = base + (size_t)row * 1024;
                const float rstd = 1.f / sqrtf((sqq[g].x + sqq[g].y) * (1.f / 256.f) + EPS);
                float one = 1.f; asm volatile("" : "+v"(one));
#pragma unroll
                for (int bj = 0; bj < 2; ++bj) { const f32x4 a0 = acc[ai][bj][m][0] * one, a1 = acc[ai][bj][m][1] * one;
                    const f32x4 n0 = nwv[bj][0], n1 = nwv[bj][1];
                    float hvf[8]; unpack8(hvq[g][bj], hvf); float o[8];
#pragma unroll
                    for (int j = 0; j < 4; ++j) { const float s0 = sigm(a0[j]), s1 = sigm(a1[j]);
                        o[j] = hvf[j] * rstd * n0[j] * (s0 + gsel * (s0 * a0[j] - s0)); o[4 + j] = hvf[4 + j] * rstd * n1[j] * (s1 + gsel * (s1 * a1[j] - s1)); }
                    u32x4 w; w.x = cvt_pk_bf16(o[0], o[1]); w.y = cvt_pk_bf16(o[2], o[3]); w.z = cvt_pk_bf16(o[4], o[5]); w.w = cvt_pk_bf16(o[6], o[7]);
                    *(u32x4*)(rowp + bj * 128) = w; } }
#undef EPB_ISSUE
        } else {
            bf16* base = (bf16*)(ws + (u.pn < 12 ? WS_VG : WS_QKMC)) + colt;
#pragma unroll
            for (int ai = 0; ai < 2; ++ai)
#pragma unroll
                for (int m = 0; m < 4; ++m) { bf16* rowp = base + (size_t)(row0 + ai * 128 + m * 16) * 1024;
#pragma unroll
                    for (int bj = 0; bj < 2; ++bj) { const f32x4 a0 = acc[ai][bj][m][0], a1 = acc[ai][bj][m][1];
                        u32x4 w; w.x = pkbf(sigm(a0[0]), sigm(a0[1])); w.y = pkbf(sigm(a0[2]), sigm(a0[3])); w.z = pkbf(sigm(a1[0]), sigm(a1[1])); w.w = pkbf(sigm(a1[2]), sigm(a1[3]));
                        *(u32x4*)(rowp + bj * 128) = w; } }
        }
    }
};
template <int STEP> struct EpiGate {
    unsigned char* ws;
    __device__ __forceinline__ void operator()(const f32x4 (&acc)[2][2][4][2], const Unit& u, int wr, int wc, int fr, int fq) const {
        const int row0 = u.pm * 256 + wr * 64 + fr, colt = u.pn * 256 + wc * 32 + 8 * fq;
        const bf16* sg = (const bf16*)(ws + (STEP == 0 ? WS_VG : WS_QKMC)) + colt; bf16* ty = (bf16*)(ws + WS_VM) + colt;
#pragma unroll
        for (int ai = 0; ai < 2; ++ai)
#pragma unroll
            for (int m = 0; m < 4; ++m) { const size_t ro = (size_t)(row0 + ai * 128 + m * 16) * 1024;
#pragma unroll
                for (int bj = 0; bj < 2; ++bj) { const f32x4 a0 = acc[ai][bj][m][0], a1 = acc[ai][bj][m][1];
                    const u32x4 s = *(const u32x4*)(sg + ro + bj * 128);
                    float r[8] = {bflo(s.x) * a0[0], bfhi(s.x) * a0[1], bflo(s.y) * a0[2], bfhi(s.y) * a0[3], bflo(s.z) * a1[0], bfhi(s.z) * a1[1], bflo(s.w) * a1[2], bfhi(s.w) * a1[3]};
                    if (STEP == 1) { const u32x4 t = *(const u32x4*)(ty + ro + bj * 128);
                        r[0] += bflo(t.x); r[1] += bfhi(t.x); r[2] += bflo(t.y); r[3] += bfhi(t.y); r[4] += bflo(t.z); r[5] += bfhi(t.z); r[6] += bflo(t.w); r[7] += bfhi(t.w); }
                    u32x4 w; w.x = cvt_pk_bf16(r[0], r[1]); w.y = cvt_pk_bf16(r[2], r[3]); w.z = cvt_pk_bf16(r[4], r[5]); w.w = cvt_pk_bf16(r[6], r[7]);
                    *(u32x4*)(ty + ro + bj * 128) = w; } }
    }
};
struct EpiOut {
    const float* x; float* out; const float* modv;
    __device__ __forceinline__ void operator()(const f32x4 (&acc)[2][2][4][2], const Unit& u, int wr, int wc, int fr, int fq) const {
        const int row0 = u.pm * 256 + wr * 64 + fr, colt = u.pn * 256 + wc * 32 + 8 * fq;
        const float* gt = modv + ((u.pm * 256) >> 13) * 6144 + 2048 + colt;
#pragma unroll
        for (int bj = 0; bj < 2; ++bj) { const f32x4 g0 = *(const f32x4*)(gt + bj * 128), g1 = *(const f32x4*)(gt + bj * 128 + 4);
#pragma unroll
            for (int ai = 0; ai < 2; ++ai)
#pragma unroll
                for (int m = 0; m < 4; ++m) { const size_t off = (size_t)(row0 + ai * 128 + m * 16) * 1024 + colt + bj * 128;
                    *(f32x4*)(out + off) = *(const f32x4*)(x + off) + g0 * acc[ai][bj][m][0]; *(f32x4*)(out + off + 4) = *(const f32x4*)(x + off + 4) + g1 * acc[ai][bj][m][1]; } }
    }
};

__device__ __forceinline__ void p9_route(Frame& F) {
    PMARK0(40)
    const float* modv = wsp<float>(F, WS_MODV);
    constexpr int WP = 1032;
    LAS unsigned short* Wt = (LAS unsigned short*)F.lds;
    LAS int* hist = (LAS int*)(F.lds + 40 * WP * 2 + 16384);
    if (F.tid < 32) hist[F.tid] = 0;
    for (int k = F.tid; k < 1024; k += NTHR) {
        const f32x4 wg = *(const f32x4*)(F.w_grp + (size_t)k * 4), w0 = *(const f32x4*)(F.w_rexp + (size_t)k * 16), w1 = *(const f32x4*)(F.w_rexp + (size_t)k * 16 + 4), w2 = *(const f32x4*)(F.w_rexp + (size_t)k * 16 + 8), w3 = *(const f32x4*)(F.w_rexp + (size_t)k * 16 + 12);
        const float wv[20] = {wg[0], wg[1], wg[2], wg[3], w0[0], w0[1], w0[2], w0[3], w1[0], w1[1], w1[2], w1[3], w2[0], w2[1], w2[2], w2[3], w3[0], w3[1], w3[2], w3[3]};
#pragma unroll
        for (int n = 0; n < 20; ++n) { const unsigned hi = pkbf(wv[n], 0.f) & 0xffffu; Wt[n * WP + k] = (unsigned short)hi; Wt[(20 + n) * WP + k] = (unsigned short)(pkbf(wv[n] - bflo(hi), 0.f) & 0xffffu); } }
    __syncthreads();
    int* rexp = (int*)(F.ws + WS_ROUTE + RT_EXP); float* rw = (float*)(F.ws + WS_ROUTE + RT_W); int* rpos = (int*)(F.ws + WS_ROUTE + RT_POS);
    const int li = F.lane & 15, lg = F.lane >> 4;
    const int n1 = 16 + li < 20 ? 16 + li : 19;
    LAS float* gco = (LAS float*)(F.lds + 40 * WP * 2 + 16384 + 256);
    LAS float* shv = gco + 1024;
    LAS float* ssh = shv + 1024;
    LAS float* lgall = (LAS float*)(F.lds + 40 * WP * 2);
    const int tp = F.wave >> 1, hf = F.wave & 1;
    for (int tg = F.bid; tg < M_LAT / 64; tg += F.G) {
        const int mrow0 = 64 * tg, m = mrow0 + 16 * tp + li;
        const float* mvb = modv + (mrow0 >> 13) * 6144;
        __syncthreads();
        for (int c = F.tid; c < 1024; c += NTHR) { gco[c] = F.g_norm2[c] * (mvb[4096 + c] + 1.f); shv[c] = mvb[3072 + c]; }
        const float* src = F.out + (size_t)m * D + hf * 512 + 8 * lg;
        f32x4 xa[16], xb[16];
#pragma unroll
        for (int ks = 0; ks < 16; ++ks) { xa[ks] = *(const f32x4*)(src + 32 * ks); xb[ks] = *(const f32x4*)(src + 32 * ks + 4); }
        float ss = 0.f;
#pragma unroll
        for (int ks = 0; ks < 16; ++ks) { const f32x4 a = xa[ks], c = xb[ks]; ss += (a.x * a.x + a.y * a.y) + (a.z * a.z + a.w * a.w) + (c.x * c.x + c.y * c.y) + (c.z * c.z + c.w * c.w); }
        ss += __shfl_xor(ss, 16); ss += __shfl_xor(ss, 32);
        if (lg == 0) ssh[F.wave * 16 + li] = ss;
        __syncthreads();
        const float rstd = 1.f / sqrtf((ssh[F.wave * 16 + li] + ssh[(F.wave ^ 1) * 16 + li]) * (1.f / D) + EPS);
        f32x4 acc0 = {0.f, 0.f, 0.f, 0.f}, acc1 = acc0;
        bf16* o = wsp<bf16>(F, WS_H2) + (size_t)m * D + hf * 512 + 8 * lg;
#pragma unroll
        for (int ks = 0; ks < 16; ++ks) { const int c = hf * 512 + 32 * ks + 8 * lg;
            const f32x4 ga = *(const LAS f32x4*)(gco + c), gb = *(const LAS f32x4*)(gco + c + 4), sha = *(const LAS f32x4*)(shv + c), shb = *(const LAS f32x4*)(shv + c + 4);
            const f32x4 ha = (xa[ks] * rstd) * ga + sha, hb = (xb[ks] * rstd) * gb + shb;
            u32x4 hi; hi.x = pkbf(ha[0], ha[1]); hi.y = pkbf(ha[2], ha[3]); hi.z = pkbf(hb[0], hb[1]); hi.w = pkbf(hb[2], hb[3]);
            u32x4 lo; lo.x = pkbf(ha[0] - bflo(hi.x), ha[1] - bfhi(hi.x)); lo.y = pkbf(ha[2] - bflo(hi.y), ha[3] - bfhi(hi.y)); lo.z = pkbf(hb[0] - bflo(hi.z), hb[1] - bfhi(hi.z)); lo.w = pkbf(hb[2] - bflo(hi.w), hb[3] - bfhi(hi.w));
            *(u32x4*)(o + 32 * ks) = hi;
            const bf16x8 Ah = __builtin_bit_cast(bf16x8, hi), Al = __builtin_bit_cast(bf16x8, lo);
            const bf16x8 bh0 = *(const LAS bf16x8*)(Wt + li * WP + c), bh1 = *(const LAS bf16x8*)(Wt + n1 * WP + c), bl0 = *(const LAS bf16x8*)(Wt + (20 + li) * WP + c), bl1 = *(const LAS bf16x8*)(Wt + (20 + n1) * WP + c);
            acc0 = __builtin_amdgcn_mfma_f32_16x16x32_bf16(Ah, bh0, acc0, 0, 0, 0); acc1 = __builtin_amdgcn_mfma_f32_16x16x32_bf16(Ah, bh1, acc1, 0, 0, 0);
            acc0 = __builtin_amdgcn_mfma_f32_16x16x32_bf16(Al, bh0, acc0, 0, 0, 0); acc1 = __builtin_amdgcn_mfma_f32_16x16x32_bf16(Al, bh1, acc1, 0, 0, 0);
            acc0 = __builtin_amdgcn_mfma_f32_16x16x32_bf16(Ah, bl0, acc0, 0, 0, 0); acc1 = __builtin_amdgcn_mfma_f32_16x16x32_bf16(Ah, bl1, acc1, 0, 0, 0); }
        LAS float* lgs = lgall + F.wave * 512;
#pragma unroll
        for (int r = 0; r < 4; ++r) { lgs[(4 * lg + r) * 32 + li] = acc0[r]; lgs[(4 * lg + r) * 32 + 16 + li] = acc1[r]; }
        __syncthreads();
        if (hf == 0 && F.lane < 16) {
            const int mr = mrow0 + 16 * tp + F.lane;
            const LAS float* l0 = lgs + F.lane * 32; const LAS float* l1 = l0 + 512;
            const f32x4 lq0 = *(const LAS f32x4*)(l0) + *(const LAS f32x4*)(l1), lq1 = *(const LAS f32x4*)(l0 + 4) + *(const LAS f32x4*)(l1 + 4), lq2 = *(const LAS f32x4*)(l0 + 8) + *(const LAS f32x4*)(l1 + 8),
                        lq3 = *(const LAS f32x4*)(l0 + 12) + *(const LAS f32x4*)(l1 + 12), lq4 = *(const LAS f32x4*)(l0 + 16) + *(const LAS f32x4*)(l1 + 16);
            const f32x4 bg = *(const f32x4*)F.b_grp;
            float gl[4] = {lq0[0] + bg[0], lq0[1] + bg[1], lq0[2] + bg[2], lq0[3] + bg[3]};
            int grp = 0; float gmax = gl[0];
#pragma unroll
            for (int q = 1; q < 4; ++q) if (gl[q] > gmax) { gmax = gl[q]; grp = q; }
            float gs = 0.f;
#pragma unroll
            for (int q = 0; q < 4; ++q) gs += expf(gl[q] - gmax);
            const float grp_p = 1.f / gs;
            float el[4];
#pragma unroll
            for (int q = 0; q < 4; ++q) { float v = lq1[q]; v = grp == 1 ? lq2[q] : v; v = grp == 2 ? lq3[q] : v; v = grp == 3 ? lq4[q] : v; asm volatile("" : "+v"(v)); el[q] = v + F.b_rexp[grp * 4 + q]; }
            int i0 = 0; float e0v = el[0];
#pragma unroll
            for (int q = 1; q < 4; ++q) if (el[q] > e0v) { e0v = el[q]; i0 = q; }
            int i1 = -1; float e1v = -3.0e38f;
#pragma unroll
            for (int q = 0; q < 4; ++q) if (q != i0 && el[q] > e1v) { e1v = el[q]; i1 = q; }
            const float e1 = expf(e1v - e0v); const float w0 = grp_p / (1.f + e1), w1 = grp_p * e1 / (1.f + e1);
            const int x0 = grp * 4 + i0, x1 = grp * 4 + i1;
            rexp[2 * mr] = x0; rexp[2 * mr + 1] = x1; rw[2 * mr] = w0; rw[2 * mr + 1] = w1;
            rpos[2 * mr] = __hip_atomic_fetch_add(hist + x0, 1, __ATOMIC_RELAXED, __HIP_MEMORY_SCOPE_WORKGROUP);
            rpos[2 * mr + 1] = __hip_atomic_fetch_add(hist + x1, 1, __ATOMIC_RELAXED, __HIP_MEMORY_SCOPE_WORKGROUP);
        }
    }
    __syncthreads();
    if (F.tid < 16) hist[16 + F.tid] = (int)__hip_atomic_fetch_add((unsigned*)(F.ws + WS_CTL) + CW_CNT + 64 * F.tid, (unsigned)hist[F.tid], __ATOMIC_RELAXED, __HIP_MEMORY_SCOPE_AGENT);
    __syncthreads();
    VM_WAIT();
    for (int tg = F.bid; tg < M_LAT / 64; tg += F.G) if (F.tid < 128) { const int a = 128 * tg + F.tid, e = rexp[a], pos = rpos[a] + hist[16 + e]; rpos[a] = pos;
        wsp<int>(F, WS_LTOK)[e * LCAP + pos] = a >> 1; wsp<float>(F, WS_LW)[e * LCAP + pos] = rw[a]; }
    __syncthreads();
    PMARK1(40)
    PMARK0(41)
    moe_weight_copies<0>(F);
    PMARK1(41)
}
__device__ __forceinline__ void moe_layout(Frame& F) {
    LAS int* tab = (LAS int*)(F.lds + LDS_TAB);
    if (F.tid == 0) { int a = 0; for (int e = 0; e < 16; ++e) { const int c = (int)__hip_atomic_load((unsigned*)(F.ws + WS_CTL) + CW_CNT + 64 * e, __ATOMIC_RELAXED, __HIP_MEMORY_SCOPE_AGENT); tab[e] = a; tab[32 + e] = c; a += (c + 255) & ~255; } tab[16] = a; tab[17] = a >> 8; }
    __syncthreads();
}
struct EpiUp {
    unsigned char* ws;
    __device__ __forceinline__ void operator()(const f32x4 (&acc)[2][2][4][2], const Unit& u, int wr, int wc, int fr, int fq) const {
        const int row0 = u.pm * 256 + wr * 64 + fr; bf16* base = (bf16*)(ws + WS_HID) + u.pn * 128 + wc * 32 + 8 * fq;
#pragma unroll
        for (int ai = 0; ai < 2; ++ai)
#pragma unroll
            for (int m = 0; m < 4; ++m) { const f32x4 g0 = acc[ai][0][m][0], g1 = acc[ai][0][m][1], u0 = acc[ai][1][m][0], u1 = acc[ai][1][m][1];
                u32x4 w; w.x = cvt_pk_bf16(siluf(g0[0]) * u0[0], siluf(g0[1]) * u0[1]); w.y = cvt_pk_bf16(siluf(g0[2]) * u0[2], siluf(g0[3]) * u0[3]);
                w.z = cvt_pk_bf16(siluf(g1[0]) * u1[0], siluf(g1[1]) * u1[1]); w.w = cvt_pk_bf16(siluf(g1[2]) * u1[2], siluf(g1[3]) * u1[3]);
                *(u32x4*)(base + (size_t)(row0 + ai * 128 + m * 16) * 512) = w; }
    }
};
struct EpiDown {
    unsigned char* ws; const LAS int* tab;
    __device__ __forceinline__ void operator()(const f32x4 (&acc)[2][2][4][2], const Unit& u, int wr, int wc, int fr, int fq) const {
        const int row0 = u.pm * 256 + wr * 64 + fr; bf16* base = (bf16*)(ws + WS_YROWS) + u.pn * 256 + wc * 32 + 8 * fq;
        const float* lw = (const float*)(ws + WS_LW) + u.e * LCAP - tab[u.e];
#pragma unroll
        for (int ai = 0; ai < 2; ++ai)
#pragma unroll
            for (int m = 0; m < 4; ++m) { const int row = row0 + ai * 128 + m * 16; const float rwt = lw[row];
#pragma unroll
                for (int bj = 0; bj < 2; ++bj) { const f32x4 v0 = acc[ai][bj][m][0] * rwt, v1 = acc[ai][bj][m][1] * rwt;
                    u32x4 w; w.x = cvt_pk_bf16(v0[0], v0[1]); w.y = cvt_pk_bf16(v0[2], v0[3]); w.z = cvt_pk_bf16(v1[0], v1[1]); w.w = cvt_pk_bf16(v1[2], v1[3]);
                    *(u32x4*)(base + (size_t)row * 1024 + bj * 128) = w; } }
    }
};
__device__ __forceinline__ void p13_final(Frame& F) {
    moe_layout(F);
    const LAS int* tab = (const LAS int*)(F.lds + LDS_TAB);
    const float* modv = wsp<float>(F, WS_MODV); const int* rpos = (const int*)(F.ws + WS_ROUTE + RT_POS); const int* rexp = (const int*)(F.ws + WS_ROUTE + RT_EXP); const bf16* Y = wsp<bf16>(F, WS_YROWS);
    const int gw = F.bid * NW + F.wave, NGW = F.G * NW;
    for (int m = gw; m < M_LAT; m += NGW) {
        float* row = F.out + (size_t)m * D; const float* gt = modv + (m >> 13) * 6144 + 5120;
        const bf16* y0 = Y + (size_t)(tab[rexp[2 * m]] + rpos[2 * m]) * 1024; const bf16* y1 = Y + (size_t)(tab[rexp[2 * m + 1]] + rpos[2 * m + 1]) * 1024;
        f32x4 v[4]; float s = 0.f;
#pragma unroll
        for (int j = 0; j < 4; ++j) { const int c = 4 * F.lane + 256 * j; const u32x2 a = *(const u32x2*)(y0 + c), b = *(const u32x2*)(y1 + c); const f32x4 g = *(const f32x4*)(gt + c);
            f32x4 yy; yy.x = bflo(a.x) + bflo(b.x); yy.y = bfhi(a.x) + bfhi(b.x); yy.z = bflo(a.y) + bflo(b.y); yy.w = bfhi(a.y) + bfhi(b.y);
            v[j] = *(const f32x4*)(row + c) + g * yy; s += (v[j].x * v[j].x + v[j].y * v[j].y) + (v[j].z * v[j].z + v[j].w * v[j].w); }
        const float rstd = 1.f / sqrtf(wave_sum(s) * (1.f / D) + EPS);
#pragma unroll
        for (int j = 0; j < 4; ++j) { const int c = 4 * F.lane + 256 * j; *(f32x4*)(row + c) = (v[j] * rstd) * *(const f32x4*)(F.g_final + c); }
    }
}

typedef const Args __attribute__((address_space(4))) * KArgsP;
__device__ __forceinline__ void load_inputs(Frame& F) {
    KArgsP ap = (KArgsP)__builtin_amdgcn_kernarg_segment_ptr();
    asm volatile("" : "+s"(ap));
    F.x = ap->in[0]; F.c = ap->in[1]; F.ctx = ap->in[2]; F.c_ctx = ap->in[3]; F.w_mod = ap->in[4]; F.b_mod = ap->in[5]; F.g_norm1 = ap->in[6]; F.w_in = ap->in[7];
    F.ml_conv = ap->in[8]; F.ml_conv_b = ap->in[9]; F.b_mgate = ap->in[10]; F.ml_norm = ap->in[11]; F.gla_w2 = ap->in[12]; F.gla_b2 = ap->in[13]; F.gla_norm = ap->in[14];
    F.w_proj_m = ap->in[15]; F.w_proj_g = ap->in[16]; F.w_out = ap->in[17]; F.g_norm2 = ap->in[18]; F.w_grp = ap->in[19]; F.b_grp = ap->in[20]; F.w_rexp = ap->in[21]; F.b_rexp = ap->in[22];
    F.w_up = ap->in[23]; F.w_down = ap->in[24]; F.g_final = ap->in[25];
    F.ws = ap->ws; F.out = ap->out;
    int ln = (int)__builtin_amdgcn_mbcnt_hi(~0u, __builtin_amdgcn_mbcnt_lo(~0u, 0u)); asm volatile("" : "+v"(ln)); F.lane = ln; F.tid = F.wave * 64 + ln;
}
constexpr int N_PHASES = 14;
__global__ void __launch_bounds__(NTHR, 2) mk_fwd(Args args) {
    extern __shared__ __attribute__((aligned(16))) unsigned char lds[];
    Frame F;
    F.lds = (LAS unsigned char*)lds; F.MISC = (volatile LAS unsigned*)(F.lds + MISC_OFF);
    F.tid = threadIdx.x; F.lane = F.tid & 63; F.wave = __builtin_amdgcn_readfirstlane(F.tid >> 6); F.G = gridDim.x; F.bid = blockIdx.x;
    F.ws = args.ws; F.out = args.out;
    for (int u = F.tid; u < (LDS_BYTES - LDSCTL_OFF) / 4; u += NTHR) ((LAS unsigned*)(F.lds + LDSCTL_OFF))[u] = 0u;
    __syncthreads();
    const int lo = args.ph_lo, hi = args.ph_hi;
    XcdBarrier bar; bar.bar = (unsigned*)(F.ws + WS_CTL) + CW_BAR; bar.x = 0; bar.st = nullptr;
    if (hi - lo > 1) bar = xcd_barrier_post((unsigned*)(F.ws + WS_CTL) + CW_BAR, F.MISC + 8);
#ifndef PH_MASK
#define PH_MASK 0xFFFF
#endif
#define IN(k) (((PH_MASK >> (k)) & 1) && lo <= (k) && (k) < hi)
#define REPS(k) for (int rep_ = 0; rep_ < (((REP_MASK >> (k)) & 1) ? 2 : 1); ++rep_)
#define SEAM(k) do { if (IN(k) && IN((k) + 1)) xcd_barrier(bar, F.tid); } while (0)
    const int vc = (int)blockIdx.x;
#ifdef PROBE_SEL
    unsigned long long pt0_ = 0, pdur_ = 0;
#define PH_BEGIN(k) do { if ((k) == PROBE_SEL % 20) pt0_ = __builtin_amdgcn_s_memrealtime(); if (F.tid == 0) { F.MISC[64] = ((k) == PROBE_SEL % 20) ? 1u : 0u; if ((k) == 0) F.MISC[65] = 0u; } } while (0)
#define PH_END(k) do { if ((k) == PROBE_SEL % 20) pdur_ = __builtin_amdgcn_s_memrealtime() - pt0_; } while (0)
#else
#define PH_BEGIN(k) do { } while (0)
#define PH_END(k) do { } while (0)
#endif
    if (IN(0)) REPS(0) { load_inputs(F); PH_BEGIN(0); p0_prologue(F); SEAM(0); PH_END(0); }
    if (IN(1)) REPS(1) { load_inputs(F); PH_BEGIN(1); { PMARK0(43) p1_hx(F); PMARK1(43) } { PMARK0(44) p0_weight_copies<0>(F); PMARK1(44) } { PMARK0(45) SEAM(1); PMARK1(45) } PH_END(1); }
    if (IN(2)) REPS(2) { load_inputs(F); PH_BEGIN(2); pg8::DenseSched S; S.init(wsp<bf16>(F, WS_HX), wsp<bf16>(F, WS_WA), MT, NA, D, F.G, vc); EpiProjA E{F.ws, F.b_mgate};
        pg8::gemm_phase<EpiProjA, pg8::DenseSched, true>(F.lds, S, E, F.wave); p0_weight_copies<1>(F, F.G == 256 ? (MT / 256) * (NA / 256) % 256 : 0); SEAM(2); PH_END(2); }
    if (IN(3)) REPS(3) { load_inputs(F); PH_BEGIN(3); p3_prep(F); SEAM(3); PH_END(3); }
#if SCAN_SCALAR
    if (IN(4)) REPS(4) { load_inputs(F); PH_BEGIN(4); p4_scan_local(F); SEAM(4); PH_END(4); }
    if (IN(5)) REPS(5) { load_inputs(F); PH_BEGIN(5); p5_scan_out(F); SEAM(5); PH_END(5); }
#else
    if (IN(4)) REPS(4) { load_inputs(F); PH_BEGIN(4); p4m_scan_local(F); SEAM(4); PH_END(4); }
    if (IN(5)) REPS(5) { load_inputs(F); PH_BEGIN(5); p5m_scan_out(F); SEAM(5); PH_END(5); }
#endif
    if (IN(6)) REPS(6) { load_inputs(F); PH_BEGIN(6); pg8::DenseSched S; S.init(wsp<bf16>(F, WS_HX), wsp<bf16>(F, WS_WB), M_LAT, NB, D, F.G, vc); EpiProjB E{F.ws, F.ml_norm, F.gla_norm};
        pg8::gemm_phase<EpiProjB, pg8::DenseSched, true>(F.lds, S, E, F.wave); SEAM(6); PH_END(6); }
    if (IN(7)) REPS(7) { load_inputs(F); PH_BEGIN(7);
        { pg8::DenseSched S; S.init(wsp<bf16>(F, WS_QKM), wsp<bf16>(F, WS_WPM), M_LAT, D, D, F.G, vc); EpiGate<0> E{F.ws}; pg8::gemm_phase<EpiGate<0>, pg8::DenseSched, false>(F.lds, S, E, F.wave); }
        VM_WAIT(); __syncthreads();
        { pg8::DenseSched S; S.init(wsp<bf16>(F, WS_QKG), wsp<bf16>(F, WS_WPG), M_LAT, D, D, F.G, vc); EpiGate<1> E{F.ws}; pg8::gemm_phase<EpiGate<1>, pg8::DenseSched, false>(F.lds, S, E, F.wave); }
        SEAM(7); PH_END(7); }
    if (IN(8)) REPS(8) { load_inputs(F); PH_BEGIN(8); pg8::DenseSched S; S.init(wsp<bf16>(F, WS_VM), wsp<bf16>(F, WS_WOUT), M_LAT, D, D, F.G, vc); EpiOut E{F.x, F.out, wsp<float>(F, WS_MODV)};
        pg8::gemm_phase<EpiOut, pg8::DenseSched, false>(F.lds, S, E, F.wave); SEAM(8); PH_END(8); }
    if (IN(9)) REPS(9) { load_inputs(F); PH_BEGIN(9); p9_route(F); if (IN(9) && IN(11)) xcd_barrier(bar, F.tid); PH_END(9); }
    if (IN(11)) REPS(11) { load_inputs(F); PH_BEGIN(11); moe_layout(F); pg8::GroupSched<true> S; S.A = wsp<bf16>(F, WS_H2); S.Bt = wsp<bf16>(F, WS_WUP); S.list_tok = wsp<int>(F, WS_LTOK); S.tab = (const LAS int*)(F.lds + LDS_TAB);
        S.K = 1024; S.ntiles = S.tab[17]; S.G = F.G; S.c = vc; EpiUp E{F.ws};
        pg8::gemm_phase<EpiUp, pg8::GroupSched<true>, true>(F.lds, S, E, F.wave); moe_weight_copies<1>(F, F.G == 256 ? (S.ntiles * 4) % 256 : 0); SEAM(11); PH_END(11); }
    if (IN(12)) REPS(12) { load_inputs(F); PH_BEGIN(12); moe_layout(F); pg8::GroupSched<false> S; S.A = wsp<bf16>(F, WS_HID); S.Bt = wsp<bf16>(F, WS_WDN); S.list_tok = nullptr; S.tab = (const LAS int*)(F.lds + LDS_TAB);
        S.K = 512; S.ntiles = S.tab[17]; S.G = F.G; S.c = vc; EpiDown E{F.ws, (const LAS int*)(F.lds + LDS_TAB)};
        pg8::gemm_phase<EpiDown, pg8::GroupSched<false>, true>(F.lds, S, E, F.wave); SEAM(12); PH_END(12); }
    if (IN(13)) REPS(13) { load_inputs(F); PH_BEGIN(13); p13_final(F); PH_END(13); }
#ifdef PROBE_SEL
    if (F.bid == PROBE_WG && F.tid == 0) { const unsigned long long d_ = PROBE_SEL < 20 ? pdur_ : (unsigned long long)F.MISC[65]; const unsigned long long te_ = __builtin_amdgcn_s_memrealtime() + 4ull * d_;
        while (__builtin_amdgcn_s_memrealtime() < te_) __builtin_amdgcn_s_sleep(8); }
#endif
#undef IN
#undef SEAM
}

extern "C" void kernel_launch(void* const* d_in, const int* in_sizes, int n_in, void* d_out, int out_size, void* d_ws, size_t ws_size, hipStream_t stream) {
    static int grid = 0;
    if (grid == 0) {
        if (n_in != 26 || out_size != M_LAT * D || ws_size < WS_END) { fprintf(stderr, "kernel_launch: unexpected shapes (n_in %d, out %d, ws %zu)\n", n_in, out_size, ws_size); grid = -1; return; }
        int dev = 0, cus = 0, per_cu = 0;
        if (hipGetDevice(&dev) != hipSuccess || hipDeviceGetAttribute(&cus, hipDeviceAttributeMultiprocessorCount, dev) != hipSuccess) { grid = -1; return; }
        if (hipFuncSetAttribute((const void*)mk_fwd, hipFuncAttributeMaxDynamicSharedMemorySize, LDS_BYTES) != hipSuccess) { fprintf(stderr, "kernel_launch: hipFuncSetAttribute failed\n"); grid = -1; return; }
        if (hipOccupancyMaxActiveBlocksPerMultiprocessor(&per_cu, (const void*)mk_fwd, NTHR, LDS_BYTES) != hipSuccess || per_cu < 1) fprintf(stderr, "kernel_launch: occupancy query reports %d\n", per_cu);
        (void)hipGetLastError();
        grid = cus;
    }
    if (grid < 0) return;
    (void)hipMemsetAsync((char*)d_ws + WS_CTL, 0, CTL_ZERO_BYTES, stream);
    Args a{};
    for (int i = 0; i < 26; ++i) a.in[i] = (const float*)d_in[i];
    a.out = (float*)d_out; a.ws = (unsigned char*)d_ws;
#if MK_ONE_LAUNCH
    a.ph_lo = 0; a.ph_hi = N_PHASES;
    hipLaunchKernelGGL(mk_fwd, dim3(grid), dim3(NTHR), LDS_BYTES, stream, a);
#else
    for (int p = 0; p < N_PHASES; ++p) { a.ph_lo = p; a.ph_hi = p + 1; hipLaunchKernelGGL(mk_fwd, dim3(grid), dim3(NTHR), LDS_BYTES, stream, a); }
#endif
}
```

```cpp
#include <hip/hip_runtime.h>
#include <cstdio>
#include <cstdint>

#ifndef SCAN_SCALAR
#define SCAN_SCALAR 0
#endif
#ifndef REP_MASK
#define REP_MASK 0x0
#endif
#ifndef MK_ONE_LAUNCH
#define MK_ONE_LAUNCH 1
#endif

#define LAS __attribute__((address_space(3)))
typedef unsigned short bf16;
typedef short bf16x8 __attribute__((ext_vector_type(8)));
typedef float f32x4 __attribute__((ext_vector_type(4)));
typedef float f32x2 __attribute__((ext_vector_type(2)));
typedef unsigned u32x4 __attribute__((ext_vector_type(4)));
typedef unsigned u32x2 __attribute__((ext_vector_type(2)));

constexpr int D = 1024, BATCH = 2, SEQ = 8192, CTXL = 256;
constexpr int M_LAT = BATCH * SEQ;
constexpr int M_CTX = BATCH * CTXL;
constexpr int MT = M_LAT + M_CTX;
constexpr int NW = 8, NTHR = 512;
constexpr int IN_W = 8240;
constexpr int NA = 4352;
constexpr int NB = 4096;
constexpr int CHUNK = 64, NCH_LAT = SEQ / CHUNK  , NCH_CTX = CTXL / CHUNK  ;
constexpr int NCHUNK = BATCH * NCH_LAT + BATCH * NCH_CTX;
constexpr int NSEG = 8, CPS = NCH_LAT / NSEG;
constexpr int NEXP = 16, DEXP = 512, NROWS_MAX = 36864  ;
constexpr float EPS = 1e-6f;

constexpr size_t MiB = 1u << 20;
constexpr size_t BIG = (size_t)MT * 1024 * 2;
constexpr size_t WS_CTL = 0, CTL_ZERO_BYTES = 1 * MiB;
constexpr size_t WS_MODV = 1 * MiB;
constexpr size_t WS_AB = 2 * MiB;
constexpr size_t WS_GENDM = WS_AB + 1088 * 1024;
constexpr size_t WS_GENDG = 4 * MiB;
constexpr size_t WS_SSQ = WS_GENDG + 1088 * 1024;
constexpr size_t WS_WA = 7 * MiB;
constexpr size_t WS_WB = 16 * MiB;
constexpr size_t WS_WPM = 24 * MiB, WS_WPG = 26 * MiB, WS_WOUT = 28 * MiB;
constexpr size_t WS_GATES = 30 * MiB;
constexpr size_t WS_NST = 35 * MiB;
constexpr size_t WS_GSEG = WS_NST + 256 * 1024;
constexpr size_t WS_ROUTE = 36 * MiB;
constexpr size_t WS_HX = 37 * MiB;
constexpr size_t WS_QKM = WS_HX + BIG;
constexpr size_t WS_VM = WS_QKM + BIG;
constexpr size_t WS_QKG = WS_VM + BIG;
constexpr size_t WS_VG = WS_QKG + BIG;
constexpr size_t WS_QKMC = WS_VG + BIG;
constexpr size_t WS_STATE = WS_QKMC + BIG;
constexpr size_t WS_QKGTC = WS_STATE + 16 * MiB;
constexpr size_t WS_END = WS_QKGTC + 2 * MiB;
static_assert(WS_END <= 256 * MiB, "ws map");
constexpr size_t WS_WUP = WS_HX;
constexpr size_t WS_H2 = 70 * MiB;
constexpr size_t WS_WDN = 103 * MiB;
constexpr size_t WS_HID = 136 * MiB;
constexpr size_t WS_YROWS = 172 * MiB;
constexpr size_t RT_EXP = 0;
constexpr size_t RT_W = 128 * 1024;
constexpr size_t RT_POS = 256 * 1024;
constexpr size_t RT_ROWTOK = 384 * 1024;
constexpr size_t RT_ROWW = 384 * 1024 + 144 * 1024;
constexpr size_t RT_TILE_E = 384 * 1024 + 288 * 1024;
constexpr size_t WS_LTOK = 120 * MiB, WS_LW = 122 * MiB;
constexpr int LCAP = 32768;
constexpr int LDS_TAB = 147456 - 1024 + 768;
constexpr int CW_BAR = 4096;
constexpr int CW_CNT = 8192;

#ifdef PROBE_SEL
#ifndef PROBE_WG
#define PROBE_WG 0
#endif
#define PMARK0(id) unsigned long long pm0_##id = 0; if (PROBE_SEL == (id)) pm0_##id = __builtin_amdgcn_s_memrealtime();
#define PMARK1(id) if (PROBE_SEL == (id) && F.tid == 0) F.MISC[65] += (unsigned)(__builtin_amdgcn_s_memrealtime() - pm0_##id);
#else
#define PMARK0(id)
#define PMARK1(id)
#endif
#define LDS_WAIT() asm volatile("s_waitcnt lgkmcnt(0)" ::: "memory")
#define VM_WAIT() asm volatile("s_waitcnt vmcnt(0)" ::: "memory")
__device__ __forceinline__ unsigned f2bf(float f) { unsigned u = __builtin_bit_cast(unsigned, f); return (u + 0x7fffu + ((u >> 16) & 1u)) >> 16; }
typedef __bf16 bf16x2_t __attribute__((ext_vector_type(2)));
__device__ __forceinline__ unsigned pkbf(float lo, float hi) { f32x2 v = {lo, hi}; return __builtin_bit_cast(unsigned, __builtin_convertvector(v, bf16x2_t)); }
__device__ __forceinline__ unsigned pk2(float lo, float hi) { return pkbf(lo, hi); }
__device__ __forceinline__ float bf2f(unsigned short h) { return __builtin_bit_cast(float, (unsigned)h << 16); }
__device__ __forceinline__ float bflo(unsigned w) { return __builtin_bit_cast(float, w << 16); }
__device__ __forceinline__ float bfhi(unsigned w) { return __builtin_bit_cast(float, w & 0xffff0000u); }
__device__ __forceinline__ float sigm(float x) { return __builtin_amdgcn_rcpf(1.f + __expf(-x)); }
__device__ __forceinline__ float siluf(float x) { return x * __builtin_amdgcn_rcpf(1.f + __expf(-x)); }
__device__ __forceinline__ float logsig(float x) { return fminf(x, 0.f) - log1pf(expf(-fabsf(x))); }
__device__ __forceinline__ float wave_sum(float v) {
#pragma unroll
    for (int o = 1; o < 64; o <<= 1) v += __shfl_xor(v, o);
    return v;
}

namespace pg8 {
#define PG8_LAS __attribute__((address_space(3)))
constexpr int BM = 256, BK = 64, HALF = 128, HTB = HALF * BK * 2, STAGE_BYTES = 8 * HTB, NXCD = 8, WGM = 8;
__host__ __device__ __forceinline__ int lds_byte(int r, int c) { const int st = (r >> 4) * 2 + (c >> 5), rr = r & 15, cc = c & 31, ob = rr * 64 + cc * 2; return st * 1024 + (ob ^ (((ob >> 9) & 1) << 5)); }
__host__ __device__ __forceinline__ void stage_rc(int b, int& R, int& C) { const int st = b / 1024, sb = b % 1024, swz = sb ^ (((sb >> 9) & 1) << 5); R = (st >> 1) * 16 + swz / 64; C = (st & 1) * 32 + (swz % 64) / 2; }
__host__ __device__ __forceinline__ int perm32(int rho) { const int n = rho >> 4, i = rho & 15; return 8 * (i >> 2) + 4 * n + (i & 3); }
struct Unit { int pm, pn, e; };
__device__ __forceinline__ unsigned cvt_pk_bf16(float lo, float hi) { return pkbf(lo, hi); }

struct DenseSched {
    static constexpr bool GATHER = false;
    const bf16* A; const bf16* Bt; int K, nM, nN, nwg, G, c;
    __device__ void init(const bf16* A_, const bf16* Bt_, int M, int N, int K_, int G_, int c_) { A = A_; Bt = Bt_; K = K_; nM = M / BM; nN = N / BM; nwg = nM * nN; G = G_; c = c_; }
    __device__ bool next(int i, Unit& u) const {
        const long L = (long)i * G + c; if (L >= nwg) return false;
        int wgid = (int)L; { const int q = nwg / NXCD, r = nwg % NXCD, xcd = wgid % NXCD, off = wgid / NXCD; wgid = (xcd < r ? xcd * (q + 1) : r * (q + 1) + (xcd - r) * q) + off; }
        const int nig = WGM * nN, gid = wgid / nig, fm = gid * WGM, gsz = (nM - fm) < WGM ? (nM - fm) : WGM;
        u.pm = fm + ((wgid % nig) % gsz); u.pn = (wgid % nig) / gsz; u.e = 0; return true;
    }
    __device__ __forceinline__ const char* a_base(const Unit& u) const { return (const char*)A + (size_t)u.pm * BM * K * 2; }
    __device__ __forceinline__ const char* b_base(const Unit& u) const { return (const char*)Bt + (size_t)u.pn * BM * K * 2; }
    __device__ __forceinline__ void a_offs(const Unit&, const int (&R)[2], const int (&C)[2], unsigned (&o)[2][2]) const {
#pragma unroll
        for (int h = 0; h < 2; ++h)
#pragma unroll
            for (int i = 0; i < 2; ++i) o[h][i] = (unsigned)((h * HALF + R[i]) * K + C[i]) * 2u;
    }
};
template <bool GATHER_> struct GroupSched {
    static constexpr bool GATHER = GATHER_;
    const bf16* A; const bf16* Bt; const int* list_tok; const PG8_LAS int* tab; int K, ntiles, G, c;
    __device__ bool next(int i, Unit& u) const {
        long L = (long)i * G + c;
        if (G == 256 && (long)(i + 1) * 256 <= (long)ntiles * 4) { const int xc = c & 7, j = c >> 3; L = (long)i * 256 + (long)(((xc << 3) | (j >> 2)) << 2) + (j & 3); }
        if (L >= (long)ntiles * 4) return false;
        u.pm = (int)(L >> 2); u.pn = (int)(L & 3); int e = 0; while (e < 15 && u.pm * BM >= tab[e + 1]) ++e; u.e = e; return true;
    }
    __device__ __forceinline__ const char* a_base(const Unit& u) const { return GATHER ? (const char*)A : (const char*)A + (size_t)u.pm * BM * K * 2; }
    __device__ __forceinline__ const char* b_base(const Unit& u) const { return (const char*)Bt + ((size_t)u.e * 1024 + (size_t)u.pn * BM) * K * 2; }
    __device__ __forceinline__ void a_offs(const Unit& u, const int (&R)[2], const int (&C)[2], unsigned (&o)[2][2]) const {
        const int pos0 = u.pm * BM - tab[u.e], cnt = tab[32 + u.e];
#pragma unroll
        for (int h = 0; h < 2; ++h)
#pragma unroll
            for (int i = 0; i < 2; ++i) {
                int row = h * HALF + R[i];
                if (GATHER) { const int pos = pos0 + row; const int pc = pos < cnt ? pos : 0; const int tk = list_tok[u.e * 32768 + pc]; row = pos < cnt ? tk : 0; }
                o[h][i] = (unsigned)(row * K + C[i]) * 2u; }
    }
};

template <class Epi, class Sched, bool ALIGN_EPI>
__device__ __forceinline__ void gemm_phase(PG8_LAS unsigned char* lds, const Sched& S, const Epi& E, const int wave_id) {
    int ln_ = (int)__builtin_amdgcn_mbcnt_hi(~0u, __builtin_amdgcn_mbcnt_lo(~0u, 0u)); asm volatile("" : "+v"(ln_));
    const int wid = wave_id, lane = ln_, tid = wid * 64 + lane, wr = wid >> 2, wc = wid & 3, fr = lane & 15, fq = lane >> 4;
    const int K = S.K, nt = K / BK;
    int Rr[2], Cc[2]; unsigned voffB[2];
#pragma unroll
    for (int i = 0; i < 2; ++i) { stage_rc(tid * 16 + i * 8192, Rr[i], Cc[i]); const int Rb = (Rr[i] & ~31) + perm32(Rr[i] & 31); voffB[i] = (unsigned)(Rb * K + Cc[i]) * 2u; }
    const size_t kstep = (size_t)(BK * 2);
    const size_t hstep = (size_t)HALF * K * 2;
    const unsigned ldsw = (unsigned)wid * 1024u;
    const int aoff = lds_byte(wr * 64 + fr, fq * 8), boff = lds_byte(wc * 32 + fr, fq * 8);
#define PG8_SA(b, h) (((b) * 2 + (h)) * HTB)
#define PG8_SB(b, h) ((4 + (b) * 2 + (h)) * HTB)
#define PG8_STAGE(bufoff, gbase, voff) do { _Pragma("unroll") for (int _i = 0; _i < 2; ++_i) \
        __builtin_amdgcn_global_load_lds((const unsigned*)((const char*)(gbase) + (voff)[_i]), (PG8_LAS unsigned*)(lds + (bufoff) + ldsw + _i * 8192), 16, 0, 0); } while (0)
#define PG8_LDA(dst, b, h) do { _Pragma("unroll") for (int m = 0; m < 4; ++m) _Pragma("unroll") for (int k = 0; k < 2; ++k) dst[m][k] = *(const PG8_LAS bf16x8*)(lds + PG8_SA(b, h) + aoff + m * 2048 + k * 1024); } while (0)
#define PG8_LDB(dst, b, h) do { _Pragma("unroll") for (int n = 0; n < 2; ++n) _Pragma("unroll") for (int k = 0; k < 2; ++k) dst[n][k] = *(const PG8_LAS bf16x8*)(lds + PG8_SB(b, h) + boff + n * 2048 + k * 1024); } while (0)
#define PG8_MMA(ai, bj, At, Bt) do { __builtin_amdgcn_s_setprio(1); _Pragma("unroll") for (int m = 0; m < 4; ++m) _Pragma("unroll") for (int n = 0; n < 2; ++n) _Pragma("unroll") for (int k = 0; k < 2; ++k) \
        acc[ai][bj][m][n] = __builtin_amdgcn_mfma_f32_16x16x32_bf16(Bt[n][k], At[m][k], acc[ai][bj][m][n], 0, 0, 0); __builtin_amdgcn_s_setprio(0); } while (0)
#define PG8_WAIT_V(n) asm volatile("s_waitcnt vmcnt(" #n ")" ::: "memory")
#define PG8_WAIT_L(n) asm volatile("s_waitcnt lgkmcnt(" #n ")" ::: "memory")
#define PG8_BAR __builtin_amdgcn_s_barrier()
#define PG8_SCHED __builtin_amdgcn_sched_barrier(0)
    Unit cur, nxt; int ui = 0;
    if (!S.next(0, cur)) return;
    unsigned ao[2][2], nao[2][2];
    S.a_offs(cur, Rr, Cc, ao);
    f32x4 acc[2][2][4][2];
#pragma unroll
    for (int a = 0; a < 2; ++a)
#pragma unroll
        for (int b = 0; b < 2; ++b)
#pragma unroll
            for (int m = 0; m < 4; ++m)
#pragma unroll
                for (int n = 0; n < 2; ++n) acc[a][b][m][n] = (f32x4){0.f, 0.f, 0.f, 0.f};
    bf16x8 At[4][2], B0[2][2], B1[2][2];
    const char* cA = S.a_base(cur); const char* cB = S.b_base(cur);
    PG8_STAGE(PG8_SB(0, 0), cB, voffB); PG8_STAGE(PG8_SB(0, 1), cB + hstep, voffB); PG8_STAGE(PG8_SA(0, 0), cA, ao[0]); PG8_STAGE(PG8_SA(0, 1), cA, ao[1]);
    if (wr == 1) PG8_BAR;
    PG8_WAIT_V(2); PG8_BAR;
    PG8_STAGE(PG8_SB(1, 0), cB + kstep, voffB); PG8_STAGE(PG8_SA(1, 0), cA + kstep, ao[0]); PG8_STAGE(PG8_SB(1, 1), cB + hstep + kstep, voffB);
    PG8_WAIT_V(6); PG8_BAR;
    for (;;) {
        const bool has_next = S.next(ui + 1, nxt);
        if (Sched::GATHER && has_next) S.a_offs(nxt, Rr, Cc, nao);
        else {
#pragma unroll
            for (int h = 0; h < 2; ++h)
#pragma unroll
                for (int i = 0; i < 2; ++i) nao[h][i] = ao[h][i]; }
        const char* nA = has_next ? S.a_base(nxt) : cA; const char* nB = has_next ? S.b_base(nxt) : cB;
        for (int t = 0; t < nt; t += 2) {
            const bool last = (t == nt - 2);
            const char* a1 = cA + (size_t)(t + 1) * kstep;
            const char* a2 = last ? nA : cA + (size_t)(t + 2) * kstep; const char* b2 = last ? nB : cB + (size_t)(t + 2) * kstep;
            const char* a3 = a2 + kstep; const char* b3 = b2 + kstep;
            unsigned o2[2][2];
#pragma unroll
            for (int h = 0; h < 2; ++h)
#pragma unroll
                for (int i = 0; i < 2; ++i) o2[h][i] = (Sched::GATHER && last) ? nao[h][i] : ao[h][i];
            PG8_LDB(B0, 0, 0); PG8_LDB(B1, 0, 1); PG8_SCHED; PG8_LDA(At, 0, 0); PG8_STAGE(PG8_SA(1, 1), a1, ao[1]);
            PG8_WAIT_V(8); PG8_WAIT_L(0); PG8_BAR; PG8_MMA(0, 0, At, B0); PG8_MMA(0, 1, At, B1); PG8_BAR; PG8_SCHED;
            PG8_LDA(At, 0, 1); PG8_STAGE(PG8_SB(0, 0), b2, voffB); PG8_STAGE(PG8_SB(0, 1), b2 + hstep, voffB); PG8_STAGE(PG8_SA(0, 0), a2, o2[0]);
            PG8_WAIT_V(8); PG8_WAIT_L(0); PG8_BAR; PG8_MMA(1, 0, At, B0); PG8_MMA(1, 1, At, B1); PG8_BAR; PG8_SCHED;
            PG8_LDB(B0, 1, 0); PG8_LDB(B1, 1, 1); PG8_SCHED; PG8_LDA(At, 1, 0); PG8_STAGE(PG8_SA(0, 1), a2, o2[1]);
            PG8_WAIT_V(8); PG8_WAIT_L(0); PG8_BAR; PG8_MMA(0, 0, At, B0); PG8_MMA(0, 1, At, B1); PG8_BAR; PG8_SCHED;
            PG8_LDA(At, 1, 1); PG8_STAGE(PG8_SB(1, 0), b3, voffB); PG8_STAGE(PG8_SB(1, 1), b3 + hstep, voffB); PG8_STAGE(PG8_SA(1, 0), a3, o2[0]);
            PG8_WAIT_V(8); PG8_WAIT_L(0); PG8_BAR; PG8_MMA(1, 0, At, B0); PG8_MMA(1, 1, At, B1); PG8_BAR; PG8_SCHED;
        }
        if constexpr (ALIGN_EPI) { if (wr == 0) PG8_BAR; }
#ifdef PROBE_SEL
        const unsigned long long pe0_ = __builtin_amdgcn_s_memrealtime();
#endif
        { int fr_ = fr, fq_ = fq; asm volatile("" : "+v"(fr_), "+v"(fq_));
          E(acc, cur, wr, wc, fr_, fq_); }
#ifdef PROBE_SEL
        { const unsigned long long pe1_ = __builtin_amdgcn_s_memrealtime(); volatile PG8_LAS unsigned* M_ = (volatile PG8_LAS unsigned*)(lds + 147456 - 1024 + 320); if (tid == 0 && M_[64] && PROBE_SEL < 40) M_[65] += (unsigned)(pe1_ - pe0_); }
#endif
        if (!has_next) break;
#pragma unroll
        for (int a = 0; a < 2; ++a)
#pragma unroll
            for (int b = 0; b < 2; ++b)
#pragma unroll
                for (int m = 0; m < 4; ++m)
#pragma unroll
                    for (int n = 0; n < 2; ++n) acc[a][b][m][n] = (f32x4){0.f, 0.f, 0.f, 0.f};
        cur = nxt; cA = nA; cB = nB; ++ui;
#pragma unroll
        for (int h = 0; h < 2; ++h)
#pragma unroll
            for (int i = 0; i < 2; ++i) ao[h][i] = nao[h][i];
        if constexpr (ALIGN_EPI) { if (wr == 1) PG8_BAR; }
    }
    PG8_WAIT_V(0);
    if constexpr (!ALIGN_EPI) { if (wr == 0) PG8_BAR; }
    PG8_BAR;
#undef PG8_SA
#undef PG8_SB
#undef PG8_STAGE
#undef PG8_LDA
#undef PG8_LDB
#undef PG8_MMA
#undef PG8_WAIT_V
#undef PG8_WAIT_L
#undef PG8_BAR
#undef PG8_SCHED
}
}
using pg8::Unit; using pg8::cvt_pk_bf16;

#define XB_TMO      128
#define XB_XCNT(j)  (256  + 64 * (j))
#define XB_XSUB(j)  (1280 + 64 * (j))
#define XB_XGEN(j)  (2304 + 64 * (j))
#define XB_TOP      3328
#define XB_TOPGEN   3392
#define XCD_BAR_WORDS 3456
#define XB_SPIN_CAP (1u << 18)
__device__ __forceinline__ unsigned xb_ld(unsigned* p)              { return __hip_atomic_load(p, __ATOMIC_RELAXED, __HIP_MEMORY_SCOPE_AGENT); }
__device__ __forceinline__ unsigned xb_add(unsigned* p, unsigned v) { return __hip_atomic_fetch_add(p, v, __ATOMIC_RELAXED, __HIP_MEMORY_SCOPE_AGENT); }
__device__ __forceinline__ unsigned xb_xcc_id() { return (unsigned)__builtin_amdgcn_s_getreg((3 << 11) | 20) & 0xFu; }
#define XB_SPIN(cond, bar) do { unsigned _sp = 0; while (cond) { __builtin_amdgcn_s_sleep(1); \
    if ((++_sp & 255u) == 0u) { if (xb_ld(&(bar)[XB_TMO])) break; if (_sp > XB_SPIN_CAP) { atomicAdd(&(bar)[XB_TMO], 1u); break; } } } } while (0)
struct XcdBarrier { unsigned* bar; unsigned x; volatile LAS unsigned* st; };
__device__ __forceinline__ XcdBarrier xcd_barrier_post(unsigned* bar, volatile LAS unsigned* st) {
    XcdBarrier b; b.bar = bar; b.x = xb_xcc_id(); b.st = st;
    if (threadIdx.x == 0) (void)xb_add(&bar[XB_XCNT(b.x)], 1u);
    return b;
}
__device__ __forceinline__ void xcd_barrier_complete(unsigned* bar, unsigned x, unsigned& nloc, unsigned& nx) {
    const unsigned G = gridDim.x * gridDim.y * gridDim.z;
    unsigned sum, cnt, mine, sp = 0u;
    for (;;) {
        sum = 0u; cnt = 0u; mine = 0u;
#pragma unroll
        for (unsigned j = 0; j < 16; ++j) { const unsigned c = xb_ld(&bar[XB_XCNT(j)]); sum += c; cnt += (c > 0u) ? 1u : 0u; mine = (j == x) ? c : mine; }
        if (sum == G) break;
        __builtin_amdgcn_s_sleep(1);
        if ((++sp & 255u) == 0u) { if (xb_ld(&bar[XB_TMO])) break; if (sp > XB_SPIN_CAP) { atomicAdd(&bar[XB_TMO], 1u); break; } }
    }
    nloc = mine > 0u ? mine : 1u; nx = cnt > 0u ? cnt : 1u;
}
__device__ __forceinline__ void xcd_barrier(const XcdBarrier& b, const int tid) {
    asm volatile("s_waitcnt vmcnt(0)" ::: "memory");
    __syncthreads();
    if (tid == 0) {
        unsigned* bar = b.bar;
        __builtin_amdgcn_s_waitcnt(0);
        unsigned nloc = b.st[0], nx = b.st[1];
        if (nloc == 0u) { xcd_barrier_complete(bar, b.x, nloc, nx); b.st[0] = nloc; b.st[1] = nx; }
        const unsigned old = xb_add(&bar[XB_XSUB(b.x)], 1u);
        const unsigned gen = old / nloc;
        if (old + 1u == (gen + 1u) * nloc) {
            __builtin_amdgcn_fence(__ATOMIC_RELEASE, "agent");
            asm volatile("s_waitcnt vmcnt(0)" ::: "memory");
            const unsigned og = xb_add(&bar[XB_TOP], 1u);
            const unsigned tg = og / nx;
            if (og + 1u == (tg + 1u) * nx) xb_add(&bar[XB_TOPGEN], 1u);
            else XB_SPIN(xb_ld(&bar[XB_TOPGEN]) == tg, bar);
            __builtin_amdgcn_fence(__ATOMIC_ACQUIRE, "agent");
            xb_add(&bar[XB_XGEN(b.x)], 1u);
            asm volatile("s_waitcnt vmcnt(0)" ::: "memory");
        } else {
            XB_SPIN(xb_ld(&bar[XB_XGEN(b.x)]) == gen, bar);
            __builtin_amdgcn_fence(__ATOMIC_ACQUIRE, "agent");
            asm volatile("s_waitcnt vmcnt(0)" ::: "memory");
        }
    }
    __syncthreads();
}

constexpr int RING_BYTES = 131072;
constexpr int LDS_BYTES = 147456;
constexpr int LDSCTL_OFF = LDS_BYTES - 1024, MISC_OFF = LDSCTL_OFF + 320;

struct Args { const float* in[26]; float* out; unsigned char* ws; int ph_lo, ph_hi; };
struct Frame {
    LAS unsigned char* lds; volatile LAS unsigned* MISC;
    int tid, lane, wave, G, bid;
    unsigned char* ws; float* out;
    const float *x, *c, *ctx, *c_ctx, *w_mod, *b_mod, *g_norm1, *w_in, *ml_conv, *ml_conv_b, *b_mgate, *ml_norm, *gla_w2, *gla_b2, *gla_norm,
                *w_proj_m, *w_proj_g, *w_out, *g_norm2, *w_grp, *b_grp, *w_rexp, *b_rexp, *w_up, *w_down, *g_final;
};
template <class T> __device__ __forceinline__ T* wsp(const Frame& F, size_t off) { return (T*)(F.ws + off); }

struct TItem { const float* W; bf16* WT; int Nsrc, K, k0, n0, sc; };
__device__ __forceinline__ int map_a(int n) { return n < 2048 ? n : (n < 4096 ? n + 1040 : (n < 4112 ? 3072 + (n - 4096) : (n < 4144 ? 6160 + (n - 4112) : -1))); }
__device__ __forceinline__ int map_b(int n) { return n < 1024 ? 2048 + n : (n < 2048 ? 5136 + (n - 1024) : (n < 3072 ? 6192 + (n - 2048) : 7216 + (n - 3072))); }
__device__ __forceinline__ int map_up(int n) { const int pn = n >> 8, j = n & 255; return j < 128 ? 128 * pn + j : 512 + 128 * pn + (j - 128); }
__device__ __forceinline__ void titem_load(const TItem& t, int lane, f32x4 (&v)[8]) {
    const int scc = t.sc < 0 ? 0 : t.sc;
#pragma unroll
    for (int r = 0; r < 8; ++r) v[r] = *(const f32x4*)(t.W + (size_t)(t.k0 + 8 * r + (lane >> 3)) * t.Nsrc + scc);
}
__device__ __forceinline__ void titem_store(const TItem& t, int lane, const f32x4 (&v)[8], LAS float* scr) {
    const float z = t.sc < 0 ? 0.f : 1.f;
#pragma unroll
    for (int r = 0; r < 8; ++r) { const int kk = 8 * r + (lane >> 3); LAS float* d = scr + kk * 33 + 4 * (lane & 7); d[0] = v[r][0] * z; d[1] = v[r][1] * z; d[2] = v[r][2] * z; d[3] = v[r][3] * z; }
    LDS_WAIT(); asm volatile("" ::: "memory");
    const int c = lane & 7;
#pragma unroll
    for (int j = 0; j < 4; ++j) { const int n = (lane >> 3) + 8 * j; const LAS float* s = scr + (8 * c) * 33 + n;
        u32x4 o; o.x = pk2(s[0 * 33], s[1 * 33]); o.y = pk2(s[2 * 33], s[3 * 33]); o.z = pk2(s[4 * 33], s[5 * 33]); o.w = pk2(s[6 * 33], s[7 * 33]);
        *(u32x4*)(t.WT + (size_t)(t.n0 + n) * t.K + t.k0 + 8 * c) = o; }
    LDS_WAIT(); asm volatile("" ::: "memory");
}
template <class Dec>
__device__ __forceinline__ void run_transposes(Frame& F, int nitems, Dec dec, const int skip = 0) {
    LAS float* scr = (LAS float*)(F.lds + F.wave * 16384);
    if (F.bid < skip) return;
    const int gw = (F.bid - skip) * NW + F.wave, NGW = (F.G - skip) * NW, last = nitems - 1;
    if (gw >= nitems) return;
    f32x4 va[8], vb[8]; TItem ia, ib;
    ia = dec(gw, F.lane); titem_load(ia, F.lane, va);
    for (int it = gw; it < nitems; it += 2 * NGW) {
        { const int j = it + NGW; ib = dec(j < last ? j : last, F.lane); titem_load(ib, F.lane, vb); }
        titem_store(ia, F.lane, va, scr);
        { const int j = it + 2 * NGW; ia = dec(j < last ? j : last, F.lane); titem_load(ia, F.lane, va); }
        if (it + NGW < nitems) titem_store(ib, F.lane, vb, scr);
    }
}
__device__ __forceinline__ void p0_prologue(Frame& F) {
    LAS float* scr = (LAS float*)(F.lds + F.wave * 16384);
    const int gw = F.bid * NW + F.wave, NGW = F.G * NW;
    if (F.bid < 192) {
        LAS float* red = (LAS float*)(F.lds);
        const int r = F.tid >> 3, c4 = F.tid & 7, col0 = F.bid * 32 + 4 * c4;
        f32x4 a0 = {0.f, 0.f, 0.f, 0.f}, a1 = a0, a2 = a0;
        for (int k = r; k < D; k += 64) {
            const f32x4 w = *(const f32x4*)(F.w_mod + (size_t)k * 6144 + col0);
            const float s0 = siluf(F.c[k]), s1 = siluf(F.c[D + k]), s2 = siluf(F.c_ctx[k]);
            a0 += w * s0; a1 += w * s1; a2 += w * s2; }
#pragma unroll
        for (int j = 0; j < 4; ++j) { red[r * 96 + 0 + 4 * c4 + j] = a0[j]; red[r * 96 + 32 + 4 * c4 + j] = a1[j]; red[r * 96 + 64 + 4 * c4 + j] = a2[j]; }
        __syncthreads();
        if (F.tid < 96) { float s = 0.f; for (int q = 0; q < 64; ++q) s += red[q * 96 + F.tid]; const int rr = F.tid >> 5, j = F.bid * 32 + (F.tid & 31);
            wsp<float>(F, WS_MODV)[rr * 6144 + j] = s + F.b_mod[j]; }
        __syncthreads();
    }
}
template <int PART>
__device__ __forceinline__ void p0_weight_copies(Frame& F, const int skip = 0) {
    constexpr int I_A = (NA / 32) * 16, I_B = (NB / 32) * 16, I_P = (1024 / 32) * 16;
    const float* w_in = F.w_in; const float* wpm = F.w_proj_m; const float* wpg = F.w_proj_g; const float* wo = F.w_out; unsigned char* ws = F.ws;
    run_transposes(F, PART == 0 ? I_A : I_B + 3 * I_P, [=](int it, int lane) {
        TItem t; t.K = D; const int r = PART == 0 ? it : it + I_A;
        const bool isA = r < I_A, isB = !isA && r < I_A + I_B; const int rp = r - I_A - I_B, pi = rp < 0 ? 0 : rp / I_P;
        const int rr = isA ? r : (isB ? r - I_A : rp - pi * I_P);
        t.k0 = 64 * (rr & 15); t.n0 = 32 * (rr >> 4); const int n = t.n0 + 4 * (lane & 7);
        t.W = (isA || isB) ? w_in : (pi == 0 ? wpm : (pi == 1 ? wpg : wo)); t.Nsrc = (isA || isB) ? IN_W : D;
        t.WT = (bf16*)(ws + (isA ? WS_WA : (isB ? WS_WB : (pi == 0 ? WS_WPM : (pi == 1 ? WS_WPG : WS_WOUT)))));
        t.sc = isA ? map_a(n) : (isB ? map_b(n) : n);
        return t; }, skip);
}
template <int PART>
__device__ __forceinline__ void moe_weight_copies(Frame& F, const int skip = 0) {
    constexpr int I_U = (1024 / 32) * 16  , I_D = (1024 / 32) * 8;
    const float* wup = F.w_up; const float* wdn = F.w_down; unsigned char* ws = F.ws;
    run_transposes(F, NEXP * (PART == 0 ? I_U : I_D), [=](int it, int lane) {
        TItem t; constexpr bool up = PART == 0; const int e = it / (up ? I_U : I_D), rr = it % (up ? I_U : I_D);
        t.K = up ? 1024 : 512; t.Nsrc = 1024;
        t.k0 = up ? 64 * (rr & 15) : 64 * (rr & 7); t.n0 = up ? 32 * (rr >> 4) : 32 * (rr >> 3); const int n = t.n0 + 4 * (lane & 7);
        t.W = up ? wup + (size_t)e * 1024 * 1024 : wdn + (size_t)e * 512 * 1024;
        t.WT = up ? (bf16*)(ws + WS_WUP) + (size_t)e * 1024 * 1024 : (bf16*)(ws + WS_WDN) + (size_t)e * 1024 * 512;
        t.sc = up ? map_up(n) : n;
        return t; }, skip);
}

__device__ __forceinline__ void p1_hx(Frame& F) {
    const int gw = F.bid * NW + F.wave, NGW = F.G * NW;
    const float* modv = wsp<float>(F, WS_MODV);
    LAS float* co = (LAS float*)F.lds; LAS float* shl = co + 3072;
    for (int i = F.tid; i < 3072; i += NTHR) { const int bsel = i >> 10, c = i & 1023; co[i] = F.g_norm1[c] * (modv[bsel * 6144 + 1024 + c] + 1.f); shl[i] = modv[bsel * 6144 + c]; }
    __syncthreads();
    constexpr int RPT = 9;
    for (int m0 = gw; m0 < MT; m0 += RPT * NGW) {
        f32x4 v[RPT][4];
#pragma unroll
        for (int k = 0; k < RPT; ++k) { const int m = m0 + k * NGW < MT ? m0 + k * NGW : m0;
            const float* src = m < M_LAT ? F.x + (size_t)m * D : F.ctx + (size_t)(m - M_LAT) * D;
#pragma unroll
            for (int j = 0; j < 4; ++j) v[k][j] = *(const f32x4*)(src + 4 * F.lane + 256 * j); }
        __builtin_amdgcn_sched_barrier(0);
#pragma unroll
        for (int k = 0; k < RPT; ++k) { const int m = m0 + k * NGW;
            if (m < MT) {
                float ssq = 0.f;
#pragma unroll
                for (int j = 0; j < 4; ++j) ssq += (v[k][j].x * v[k][j].x + v[k][j].y * v[k][j].y) + (v[k][j].z * v[k][j].z + v[k][j].w * v[k][j].w);
                const float rstd = 1.f / sqrtf(wave_sum(ssq) * (1.f / D) + EPS);
                const int bsel = m < M_LAT ? (m >> 13) : 2;
                bf16* o = wsp<bf16>(F, WS_HX) + (size_t)m * D;
#pragma unroll
                for (int j = 0; j < 4; ++j) { const int c = 4 * F.lane + 256 * j;
                    const f32x4 g = *(const LAS f32x4*)(co + bsel * 1024 + c), sh = *(const LAS f32x4*)(shl + bsel * 1024 + c);
                    const f32x4 h = (v[k][j] * rstd) * g + sh;
                    u32x2 w; w.x = pk2(h.x, h.y); w.y = pk2(h.z, h.w); *(u32x2*)(o + c) = w; } } }
    }
    __syncthreads();
}

struct EpiProjA {
    unsigned char* ws; const float* b_mgate;
    __device__ __forceinline__ void operator()(const f32x4 (&acc)[2][2][4][2], const Unit& u, int wr, int wc, int fr, int fq) const {
        const int row0 = u.pm * 256 + wr * 64 + fr;
        if (u.pn < 16) {
            bf16* base = (bf16*)(ws + WS_QKM + (size_t)(u.pn >> 2) * BIG) + (u.pn & 3) * 256 + wc * 32 + 8 * fq;
#pragma unroll
            for (int ai = 0; ai < 2; ++ai)
#pragma unroll
                for (int m = 0; m < 4; ++m) { bf16* rowp = base + (size_t)(row0 + ai * 128 + m * 16) * 1024;
#pragma unroll
                    for (int bj = 0; bj < 2; ++bj) { const f32x4 v0 = acc[ai][bj][m][0], v1 = acc[ai][bj][m][1];
                        u32x4 w; w.x = cvt_pk_bf16(v0[0], v0[1]); w.y = cvt_pk_bf16(v0[2], v0[3]); w.z = cvt_pk_bf16(v1[0], v1[1]); w.w = cvt_pk_bf16(v1[2], v1[3]);
                        *(u32x4*)(rowp + bj * 128) = w; } }
        } else if (wc < 2) {
            const int col = wc * 32 + 8 * fq;
            float* g = (float*)(ws + WS_GATES);
            f32x4 b0 = {0.f, 0.f, 0.f, 0.f}, b1 = b0;
            if (col < 16) { b0 = *(const f32x4*)(b_mgate + col); b1 = *(const f32x4*)(b_mgate + col + 4); }
#pragma unroll
            for (int ai = 0; ai < 2; ++ai)
#pragma unroll
                for (int m = 0; m < 4; ++m) { float* rowp = g + (size_t)(row0 + ai * 128 + m * 16) * 64 + col;
                    *(f32x4*)rowp = acc[ai][0][m][0] + b0; *(f32x4*)(rowp + 4) = acc[ai][0][m][1] + b1; }
        }
    }
};

#define LBAR_P3() do { asm volatile("s_waitcnt vmcnt(16) lgkmcnt(0)" ::: "memory"); __builtin_amdgcn_s_barrier(); } while (0)
__device__ __forceinline__ int chunk_row0(int ci) { return ci < 256 ? (ci >> 7) * SEQ + (ci & 127) * 64 : M_LAT + ((ci - 256) >> 2) * CTXL + ((ci - 256) & 3) * 64; }
__device__ __forceinline__ bf16* qkgt_row(const Frame& F, int dir, int m) {
    return m < M_LAT ? (bf16*)F.out + ((size_t)dir * M_LAT + m) * 1024 : wsp<bf16>(F, WS_QKGTC) + ((size_t)dir * M_CTX + (m - M_LAT)) * 1024;
}
__device__ __forceinline__ float logsig_fast(float x) { return fminf(x, 0.f) - __logf(1.f + __expf(-fabsf(x))); }
__device__ __forceinline__ void unpack8(const u32x4& v, float (&f)[8]) { f[0] = bflo(v.x); f[1] = bfhi(v.x); f[2] = bflo(v.y); f[3] = bfhi(v.y); f[4] = bflo(v.z); f[5] = bfhi(v.z); f[6] = bflo(v.w); f[7] = bfhi(v.w); }
__device__ __forceinline__ void p3_prep(Frame& F) {
    const bf16* QKM = wsp<bf16>(F, WS_QKM); bf16* QKMC = wsp<bf16>(F, WS_QKMC); const float* GATES = wsp<float>(F, WS_GATES); const bf16* QKG = wsp<bf16>(F, WS_QKG);
    for (int it = F.bid; it < NCHUNK * 3; it += F.G) {
        int tidl = F.tid; asm volatile("" : "+v"(tidl));
        const int lanel = tidl & 63;
        if (it < NCHUNK) {
            const int ci = F.G == 256 ? (it < 256 ? (it & 7) * 33 + (it >> 3) : (it - 256) * 33 + 32) : it, m0 = chunk_row0(ci);
            const int cg = tidl & 127, cq = tidl >> 7, ch = 8 * cg;
            const bool lat = ci < 256; const int c = lat ? (ci & 127) : ((ci - 256) & 3);
            const bool has_up = lat && c > 0, has_dn = lat && c < 127;
            const float osc = ch >= 512 ? 0.08838834764831845f : 1.f;
            f32x4 bz0 = *(const f32x4*)(F.ml_conv_b + ch), bz1 = *(const f32x4*)(F.ml_conv_b + ch + 4);
            f32x4 cw0[9], cw1[9];
#pragma unroll
            for (int q = 0; q < 9; ++q) { cw0[q] = *(const f32x4*)(F.ml_conv + q * 1024 + ch); cw1[q] = *(const f32x4*)(F.ml_conv + q * 1024 + ch + 4); }
            const f32x4 z4 = {0.f, 0.f, 0.f, 0.f};
#pragma unroll
            for (int q = 0; q < 3; ++q) { if (!has_up) { cw0[q] = z4; cw1[q] = z4; } if (!has_dn) { cw0[6 + q] = z4; cw1[6 + q] = z4; } }
            const int collo = lat ? 0 : (c == 0 ? 0 : -1), colhi = lat ? 63 : (c == 3 ? 63 : 64);
            const bf16* rb0 = QKM + (size_t)(has_up ? m0 - 64 : m0) * 1024 + ch; const bf16* rb1 = QKM + (size_t)m0 * 1024 + ch; const bf16* rb2 = QKM + (size_t)(has_dn ? m0 + 64 : m0) * 1024 + ch;
            auto ldc = [&](int dr, int col) -> u32x4 { const int cc = min(max(col, collo), colhi); const bf16* rb = dr == 0 ? rb0 : dr == 1 ? rb1 : rb2; return *(const u32x4*)(rb + (ptrdiff_t)cc * 1024); };
            const u32x4 zu = {0u, 0u, 0u, 0u};
            int cc = cq * 16;
            u32x4 w0[3], w1[3], n0[3], n1[3];
#pragma unroll
            for (int dr = 0; dr < 3; ++dr) { const u32x4 v = ldc(dr, cc - 1); w0[dr] = cc - 1 >= collo ? v : zu; w1[dr] = ldc(dr, cc); n0[dr] = ldc(dr, cc + 1); n1[dr] = ldc(dr, cc + 2); }
#pragma unroll 1
            for (int cb = 0; cb < 8; ++cb, cc += 2) {
                u32x4 p0[3], p1[3];
#pragma unroll
                for (int dr = 0; dr < 3; ++dr) { p0[dr] = ldc(dr, cc + 3); p1[dr] = ldc(dr, cc + 4); }
                __builtin_amdgcn_sched_barrier(0);
                float acc[2][8];
#pragma unroll
                for (int oc = 0; oc < 2; ++oc) { acc[oc][0] = bz0[0]; acc[oc][1] = bz0[1]; acc[oc][2] = bz0[2]; acc[oc][3] = bz0[3]; acc[oc][4] = bz1[0]; acc[oc][5] = bz1[1]; acc[oc][6] = bz1[2]; acc[oc][7] = bz1[3]; }
#pragma unroll
                for (int dr = 0; dr < 3; ++dr)
#pragma unroll
                    for (int dc = 0; dc < 4; ++dc) { float f[8]; unpack8(dc == 0 ? w0[dr] : dc == 1 ? w1[dr] : dc == 2 ? n0[dr] : n1[dr], f);
#pragma unroll
                        for (int oc = 0; oc < 2; ++oc) { const int t = dc - oc; if (t < 0 || t > 2) continue; const f32x4 k0 = cw0[dr * 3 + t], k1 = cw1[dr * 3 + t];
                            acc[oc][0] += k0[0] * f[0]; acc[oc][1] += k0[1] * f[1]; acc[oc][2] += k0[2] * f[2]; acc[oc][3] += k0[3] * f[3]; acc[oc][4] += k1[0] * f[4]; acc[oc][5] += k1[1] * f[5]; acc[oc][6] += k1[2] * f[6]; acc[oc][7] += k1[3] * f[7]; } }
#pragma unroll
                for (int oc = 0; oc < 2; ++oc) { u32x4 o; o.x = pk2(siluf(acc[oc][0]) * osc, siluf(acc[oc][1]) * osc); o.y = pk2(siluf(acc[oc][2]) * osc, siluf(acc[oc][3]) * osc);
                    o.z = pk2(siluf(acc[oc][4]) * osc, siluf(acc[oc][5]) * osc); o.w = pk2(siluf(acc[oc][6]) * osc, siluf(acc[oc][7]) * osc);
                    *(u32x4*)(QKMC + (size_t)(m0 + cc + oc) * 1024 + ch) = o; }
                __builtin_amdgcn_sched_barrier(0);
                const bool k0 = cc + 3 <= colhi, k1 = cc + 4 <= colhi;
#pragma unroll
                for (int dr = 0; dr < 3; ++dr) { w0[dr] = n0[dr]; w1[dr] = n1[dr]; n0[dr] = k0 ? p0[dr] : zu; n1[dr] = k1 ? p1[dr] : zu; }
            }
            {
                const int dir = F.wave >> 2, h = F.wave & 3, m = m0 + lanel;
                const float ip = GATES[(size_t)m * 64 + dir * 8 + h], lf = logsig(GATES[(size_t)m * 64 + dir * 8 + 4 + h]);
                float b = lf;
#pragma unroll
                for (int o = 1; o < 64; o <<= 1) { const float t = dir == 0 ? __shfl_up(b, o) : __shfl_down(b, o); const bool ok = dir == 0 ? (lanel >= o) : (lanel + o < 64); if (ok) b += t; }
                f32x2 ab; ab.x = expf(b); ab.y = expf(ip - b);
                wsp<f32x2>(F, WS_AB)[((size_t)dir * MT + m) * 4 + h] = ab;
                if (lanel == (dir == 0 ? 63 : 0)) wsp<float>(F, WS_GENDM)[((size_t)dir * NCHUNK + ci) * 4 + h] = expf(b);
            }
        } else {
            const int gi0 = it - NCHUNK;
            const int gi = F.G == 256 ? ((((gi0 >> 4) << 3) | (gi0 & 7)) << 1) | ((gi0 >> 3) & 1) : gi0;
            const int ci = gi >> 1, dir = gi & 1, m0 = chunk_row0(ci);
            LAS float* lr = (LAS float*)F.lds;
            LAS float* Bl = (LAS float*)(F.lds + 4096);
            __syncthreads();
            for (int i = tidl; i < 1024; i += NTHR) lr[i] = GATES[(size_t)(m0 + (i >> 4)) * 64 + 16 + dir * 16 + (i & 15)];
            const int ch = tidl;
            f32x2 w2p[8];
#pragma unroll
            for (int r = 0; r < 8; ++r) { w2p[r].x = F.gla_w2[((size_t)dir * 16 + 2 * r) * 512 + ch]; w2p[r].y = F.gla_w2[((size_t)dir * 16 + 2 * r + 1) * 512 + ch]; }
            const float b2 = F.gla_b2[dir * 512 + ch];
            u32x4 vin[16];
            const int cp = tidl & 127, r0 = tidl >> 7; const bool isk = cp >= 64;
            const float sg = isk ? -1.4426950408889634f : 1.4426950408889634f, eoff = isk ? 0.f : -3.5f;
            const bf16* irow = QKG + (size_t)(m0 + r0) * 1024 + cp * 8; bf16* orow = qkgt_row(F, dir, m0) + (size_t)r0 * 1024 + cp * 8;
            const LAS float* brow = Bl + r0 * 512 + 8 * (cp & 63);
#pragma unroll
            for (int j = 0; j < 16; ++j) vin[j] = *(const u32x4*)(irow + (size_t)j * 4096);
            LBAR_P3();
            float b = 0.f;
#pragma unroll 1
            for (int i0 = 0; i0 < 64; i0 += 4) {
                f32x4 l[4][4];
#pragma unroll
                for (int u = 0; u < 4; ++u) { const int r = dir == 0 ? i0 + u : 63 - i0 - u;
#pragma unroll
                    for (int q = 0; q < 4; ++q) l[u][q] = *(const LAS f32x4*)(lr + r * 16 + 4 * q); }
                float ls[4];
#pragma unroll
                for (int u = 0; u < 4; ++u) {
                    f32x2 a2 = {b2, 0.f};
#pragma unroll
                    for (int q = 0; q < 4; ++q) { a2 = __builtin_elementwise_fma((f32x2){l[u][q][0], l[u][q][1]}, w2p[2 * q], a2); a2 = __builtin_elementwise_fma((f32x2){l[u][q][2], l[u][q][3]}, w2p[2 * q + 1], a2); }
                    const float xg = a2.x + a2.y;
                    ls[u] = fminf(xg, 0.f) - 0.6931471805599453f * __builtin_amdgcn_logf(1.f + __builtin_amdgcn_exp2f(-1.4426950408889634f * fabsf(xg))); }
#pragma unroll
                for (int u = 0; u < 4; ++u) { const int r = dir == 0 ? i0 + u : 63 - i0 - u; b += ls[u] * (1.f / 16.f); Bl[r * 512 + ch] = b; }
            }
            wsp<float>(F, WS_GENDG)[((size_t)dir * NCHUNK + ci) * 512 + ch] = __expf(b);
            __syncthreads();
#pragma unroll
            for (int j = 0; j < 16; ++j) {
                const u32x4 v = vin[j];
                const f32x4 b0 = *(const LAS f32x4*)(brow + j * 2048), b1 = *(const LAS f32x4*)(brow + j * 2048 + 4);
                float f[8]; unpack8(v, f); float e[8];
#pragma unroll
                for (int q = 0; q < 4; ++q) { e[q] = __builtin_amdgcn_exp2f(__builtin_fmaf(b0[q], sg, eoff)); e[4 + q] = __builtin_amdgcn_exp2f(__builtin_fmaf(b1[q], sg, eoff)); }
                u32x4 o; o.x = pk2(f[0] * e[0], f[1] * e[1]); o.y = pk2(f[2] * e[2], f[3] * e[3]); o.z = pk2(f[4] * e[4], f[5] * e[5]); o.w = pk2(f[6] * e[6], f[7] * e[7]);
                *(u32x4*)(orow + (size_t)j * 4096) = o; }
        }
    }
}

constexpr int L_AQ = 0, L_AK = 16384, L_VP = 32768, L_P = 49152, L_S = 65536, L_N = 131072 + 1024  ;
struct ScanSrc { const bf16* q; const bf16* k; const bf16* v; const f32x2* ab; const float* gend; int gstride; };
__device__ __forceinline__ int seg_chunk(int seg, int dir, int i) {
    if (seg < 0) return dir == 0 ? i : 3 - i;
    return dir == 0 ? seg * CPS + i : (NCH_LAT - 1 - seg * CPS) - i;
}
__device__ __forceinline__ void scan_stage(Frame& F, int model, int b, int h, int dir, int half, int ci, bool need_q) {
    const int m0 = chunk_row0(ci);
    LAS float* nb = (LAS float*)(F.lds + L_N);
    if (model == 0 && F.tid < 64) { const f32x2 ab = wsp<f32x2>(F, WS_AB)[((size_t)dir * MT + m0 + F.tid) * 4 + h]; nb[256 + F.tid] = ab.y; nb[320 + F.tid] = ab.x; }
    if (F.tid >= 64 && F.tid < 192) { const int dk = F.tid - 64;
        nb[128 + dk] = model == 0 ? wsp<float>(F, WS_GENDM)[((size_t)dir * NCHUNK + ci) * 4 + h] : wsp<float>(F, WS_GENDG)[((size_t)dir * NCHUNK + ci) * 512 + h * 128 + dk]; }
#pragma unroll
    for (int i = 0; i < 2; ++i) { const int p = F.tid + i * 512, r = p >> 4, cpart = p & 15, m = m0 + r;
        const bf16* qrow; const bf16* vrow;
        if (model == 0) { qrow = wsp<bf16>(F, WS_QKMC) + (size_t)m * 1024; vrow = wsp<bf16>(F, WS_VM) + (size_t)m * 1024; }
        else { qrow = qkgt_row(F, dir, m); vrow = wsp<bf16>(F, WS_VG) + (size_t)m * 1024; }
        if (need_q) *(LAS u32x4*)(F.lds + L_AQ + r * 256 + cpart * 16) = *(const u32x4*)(qrow + h * 128 + cpart * 8);
        *(LAS u32x4*)(F.lds + L_AK + r * 256 + cpart * 16) = *(const u32x4*)(qrow + 512 + h * 128 + cpart * 8);
        u32x4 v = *(const u32x4*)(vrow + h * 256 + half * 128 + cpart * 8);
        if (model == 0) { const float be = wsp<f32x2>(F, WS_AB)[((size_t)dir * MT + m) * 4 + h].y;
            v.x = pk2(bflo(v.x) * be, bfhi(v.x) * be); v.y = pk2(bflo(v.y) * be, bfhi(v.y) * be); v.z = pk2(bflo(v.z) * be, bfhi(v.z) * be); v.w = pk2(bflo(v.w) * be, bfhi(v.w) * be); }
        *(LAS u32x4*)(F.lds + L_VP + r * 256 + cpart * 16) = v; }
}
__device__ __forceinline__ void scan_update(Frame& F, int model) {
    LAS float* S = (LAS float*)(F.lds + L_S); LAS float* nb = (LAS float*)(F.lds + L_N);
    const LAS bf16* AK = (const LAS bf16*)(F.lds + L_AK); const LAS bf16* VP = (const LAS bf16*)(F.lds + L_VP);
    const int dk = F.tid >> 2, dv0 = (F.tid & 3) * 32;
    float a[32];
#pragma unroll
    for (int j = 0; j < 32; ++j) a[j] = S[dk * 128 + dv0 + j];
    float nn = 0.f;
    for (int s = 0; s < 64; ++s) { const float k = bf2f(AK[s * 128 + dk]);
        if (model == 0) nn += k * nb[256 + s];
#pragma unroll
        for (int j = 0; j < 32; j += 2) { const unsigned v = *(const LAS unsigned*)(VP + s * 128 + dv0 + j); a[j] += k * bflo(v); a[j + 1] += k * bfhi(v); } }
    const float g = nb[128 + dk];
#pragma unroll
    for (int j = 0; j < 32; ++j) S[dk * 128 + dv0 + j] = g * a[j];
    if (model == 0 && (F.tid & 3) == 0) nb[dk] = g * (nb[dk] + nn);
}
__device__ __forceinline__ bf16* state_ptr(const Frame& F, int sc, int slot, int half) { return wsp<bf16>(F, WS_STATE) + ((size_t)(sc * 8 + slot) * 2 + half) * 16384; }

__device__ __forceinline__ void p4_scan_local(Frame& F) {
    LAS float* S = (LAS float*)(F.lds + L_S); LAS float* nb = (LAS float*)(F.lds + L_N);
    for (int it0 = F.bid; it0 < 32 * 8 * 2; it0 += F.G) {
        const int it = (F.G == 256) ? (it0 & ~255) | ((((((it0 & 255) >> 4) << 3) | (it0 & 7)) << 1) | ((it0 >> 3) & 1)) : it0;
        const int half = it & 1, slot = (it >> 1) & 7, sc = it >> 4, seg = slot - 1;
        const int dir = sc & 1, h = (sc >> 1) & 3, b = (sc >> 3) & 1, model = sc >> 4;
        for (int i = F.tid; i < 16384; i += NTHR) S[i] = 0.f;
        if (F.tid < 128) nb[F.tid] = 0.f;
        float gacc = 1.f;
        __syncthreads();
        const int nch = seg < 0 ? NCH_CTX : CPS;
        for (int i = 0; i < nch; ++i) {
            const int c = seg_chunk(seg, dir, i), ci = seg < 0 ? 256 + b * 4 + c : b * 128 + c;
            scan_stage(F, model, b, h, dir, half, ci, false);
            __syncthreads();
            if (F.tid < 128) gacc *= nb[128 + F.tid];
            scan_update(F, model);
            __syncthreads();
        }
        bf16* st = state_ptr(F, sc, slot, half);
        for (int i = F.tid; i < 8192; i += NTHR) ((unsigned*)st)[i] = pk2(S[2 * i], S[2 * i + 1]);
        if (half == 0 && F.tid < 128) { wsp<float>(F, WS_NST)[(sc * 8 + slot) * 128 + F.tid] = nb[F.tid]; wsp<float>(F, WS_GSEG)[(sc * 8 + slot) * 128 + F.tid] = gacc; }
        __syncthreads();
    }
}
__device__ __forceinline__ void p5_scan_out(Frame& F) {
    LAS float* S = (LAS float*)(F.lds + L_S); LAS float* nb = (LAS float*)(F.lds + L_N); LAS float* P = (LAS float*)(F.lds + L_P);
    const LAS bf16* AQ = (const LAS bf16*)(F.lds + L_AQ); const LAS bf16* AK = (const LAS bf16*)(F.lds + L_AK); const LAS bf16* VP = (const LAS bf16*)(F.lds + L_VP);
    for (int it0 = F.bid; it0 < 2 * 2 * 4 * 8 * 2; it0 += F.G) {
        const int it = (F.G == 256) ? ((((it0 >> 4) << 3) | (it0 & 7)) << 1) | ((it0 >> 3) & 1) : it0;
        const int half = it & 1, seg = (it >> 1) & 7, h = (it >> 4) & 3, b = (it >> 6) & 1, model = it >> 7;
        bf16* HS = wsp<bf16>(F, model == 0 ? WS_QKM : WS_QKG);
        for (int dir = 0; dir < 2; ++dir) {
            const int sc = ((model * 2 + b) * 4 + h) * 2 + dir, s = dir == 0 ? seg : 7 - seg;
            { const int dk = F.tid >> 2, dv0 = (F.tid & 3) * 32; float a[32]; float nn = 0.f;
#pragma unroll
              for (int j = 0; j < 32; ++j) a[j] = 0.f;
              for (int slot = 0; slot <= s; ++slot) {
                  const float g = slot == 0 ? 0.f : wsp<float>(F, WS_GSEG)[(sc * 8 + slot) * 128 + dk];
                  const bf16* st = state_ptr(F, sc, slot, half) + dk * 128 + dv0;
#pragma unroll
                  for (int j = 0; j < 32; j += 2) { const unsigned v = *(const unsigned*)(st + j); a[j] = g * a[j] + bflo(v); a[j + 1] = g * a[j + 1] + bfhi(v); }
                  nn = g * nn + wsp<float>(F, WS_NST)[(sc * 8 + slot) * 128 + dk]; }
#pragma unroll
              for (int j = 0; j < 32; ++j) S[dk * 128 + dv0 + j] = a[j];
              if ((F.tid & 3) == 0) nb[dk] = nn; }
            __syncthreads();
            for (int i = 0; i < CPS; ++i) {
                const int c = seg_chunk(s, dir, i), ci = b * 128 + c, m0 = chunk_row0(ci);
                scan_stage(F, model, b, h, dir, half, ci, true);
                __syncthreads();
                for (int e = F.tid; e < 4096; e += NTHR) { const int t = e >> 6, s2 = e & 63; float p = 0.f;
                    if (dir == 0 ? (s2 <= t) : (s2 >= t)) {
                        for (int d8 = 0; d8 < 16; ++d8) { const u32x4 qa = *(const LAS u32x4*)(AQ + t * 128 + d8 * 8), ka = *(const LAS u32x4*)(AK + s2 * 128 + d8 * 8);
                            p += bflo(qa.x) * bflo(ka.x) + bfhi(qa.x) * bfhi(ka.x) + bflo(qa.y) * bflo(ka.y) + bfhi(qa.y) * bfhi(ka.y)
                               + bflo(qa.z) * bflo(ka.z) + bfhi(qa.z) * bfhi(ka.z) + bflo(qa.w) * bflo(ka.w) + bfhi(qa.w) * bfhi(ka.w); } }
                    P[e] = bf2f((unsigned short)f2bf(p)); }
                __syncthreads();
                { const int t = F.tid >> 3, dv0 = (F.tid & 7) * 16; float o[16];
#pragma unroll
                  for (int j = 0; j < 16; ++j) o[j] = 0.f;
                  float den = 0.f;
                  for (int s2 = 0; s2 < 64; ++s2) { const float p = P[t * 64 + s2];
                      if (model == 0) den += p * nb[256 + s2];
                      const u32x4 v0 = *(const LAS u32x4*)(VP + s2 * 128 + dv0), v1 = *(const LAS u32x4*)(VP + s2 * 128 + dv0 + 8);
                      o[0] += p * bflo(v0.x); o[1] += p * bfhi(v0.x); o[2] += p * bflo(v0.y); o[3] += p * bfhi(v0.y); o[4] += p * bflo(v0.z); o[5] += p * bfhi(v0.z); o[6] += p * bflo(v0.w); o[7] += p * bfhi(v0.w);
                      o[8] += p * bflo(v1.x); o[9] += p * bfhi(v1.x); o[10] += p * bflo(v1.y); o[11] += p * bfhi(v1.y); o[12] += p * bflo(v1.z); o[13] += p * bfhi(v1.z); o[14] += p * bflo(v1.w); o[15] += p * bfhi(v1.w); }
                  for (int dk = 0; dk < 128; ++dk) { const float q = bf2f(AQ[t * 128 + dk]);
                      if (model == 0) den += q * nb[dk];
                      const LAS float* sr = S + dk * 128 + dv0;
#pragma unroll
                      for (int j = 0; j < 16; ++j) o[j] += q * bf2f((unsigned short)f2bf(sr[j])); }
                  float rs = 1.f;
                  if (model == 0) { const float al = nb[320 + t]; rs = al / fmaxf(al * fabsf(den), 1.f); }
                  bf16* dst = HS + (size_t)(m0 + t) * 1024 + h * 256 + half * 128 + dv0;
                  float ssq = 0.f;
                  if (dir == 0) {
                      u32x4 w0, w1; w0.x = pk2(o[0] * rs, o[1] * rs); w0.y = pk2(o[2] * rs, o[3] * rs); w0.z = pk2(o[4] * rs, o[5] * rs); w0.w = pk2(o[6] * rs, o[7] * rs);
                      w1.x = pk2(o[8] * rs, o[9] * rs); w1.y = pk2(o[10] * rs, o[11] * rs); w1.z = pk2(o[12] * rs, o[13] * rs); w1.w = pk2(o[14] * rs, o[15] * rs);
                      *(u32x4*)dst = w0; *(u32x4*)(dst + 8) = w1;
                  } else {
                      const u32x4 p0 = *(const u32x4*)dst, p1 = *(const u32x4*)(dst + 8);
                      const float f[16] = {bflo(p0.x), bfhi(p0.x), bflo(p0.y), bfhi(p0.y), bflo(p0.z), bfhi(p0.z), bflo(p0.w), bfhi(p0.w), bflo(p1.x), bfhi(p1.x), bflo(p1.y), bfhi(p1.y), bflo(p1.z), bfhi(p1.z), bflo(p1.w), bfhi(p1.w)};
                      float r[16];
#pragma unroll
                      for (int j = 0; j < 16; ++j) { r[j] = f[j] + o[j] * rs; ssq += r[j] * r[j]; }
                      u32x4 w0, w1; w0.x = pk2(r[0], r[1]); w0.y = pk2(r[2], r[3]); w0.z = pk2(r[4], r[5]); w0.w = pk2(r[6], r[7]);
                      w1.x = pk2(r[8], r[9]); w1.y = pk2(r[10], r[11]); w1.z = pk2(r[12], r[13]); w1.w = pk2(r[14], r[15]);
                      *(u32x4*)dst = w0; *(u32x4*)(dst + 8) = w1;
                      ssq += __shfl_xor(ssq, 1); ssq += __shfl_xor(ssq, 2); ssq += __shfl_xor(ssq, 4);
                      if ((F.tid & 7) == 0) wsp<float>(F, WS_SSQ)[((size_t)(m0 + t) * 8 + model * 4 + h) * 2 + half] = ssq;
                  } }
                __syncthreads();
                scan_update(F, model);
                __syncthreads();
            }
        }
    }
}

typedef short s16x4 __attribute__((ext_vector_type(4)));
__device__ __forceinline__ unsigned offb(int row, int ch) { return 256u * (unsigned)row + 16u * (unsigned)(ch ^ (((row & 3) << 2) | ((row >> 2) & 3))); }
constexpr int M_AQ = 0, M_AK = 16384, M_VP = 32768, M_P = 49152, M_O = 57344, O_LD = 132;
template <int TILE>
__device__ __forceinline__ void tr_frag2(unsigned x0, unsigned x1, bf16x8& f0, bf16x8& f1) {
    s16x4 r0, r1, r2, r3;
    asm volatile("ds_read_b64_tr_b16 %0, %4 offset:%6\n\tds_read_b64_tr_b16 %1, %5 offset:%6\n\tds_read_b64_tr_b16 %2, %4 offset:%7\n\tds_read_b64_tr_b16 %3, %5 offset:%7\n\ts_waitcnt lgkmcnt(0)"
                 : "=&v"(r0), "=&v"(r1), "=&v"(r2), "=&v"(r3) : "v"(x0), "v"(x1), "i"(TILE), "i"(TILE + 8192) : "memory");
    f0 = __builtin_shufflevector(r0, r1, 0, 1, 2, 3, 4, 5, 6, 7); f1 = __builtin_shufflevector(r2, r3, 0, 1, 2, 3, 4, 5, 6, 7);
}
template <int TILE>
__device__ __forceinline__ void tr_frag8(unsigned a0, unsigned a1, unsigned b0, unsigned b1, unsigned c0, unsigned c1, unsigned d0, unsigned d1, bf16x8 (&f)[8]) {
    s16x4 r[16];
    asm volatile("ds_read_b64_tr_b16 %0, %16 offset:%24\n\tds_read_b64_tr_b16 %1, %17 offset:%24\n\tds_read_b64_tr_b16 %2, %16 offset:%25\n\tds_read_b64_tr_b16 %3, %17 offset:%25\n\t"
                 "ds_read_b64_tr_b16 %4, %18 offset:%24\n\tds_read_b64_tr_b16 %5, %19 offset:%24\n\tds_read_b64_tr_b16 %6, %18 offset:%25\n\tds_read_b64_tr_b16 %7, %19 offset:%25\n\t"
                 "ds_read_b64_tr_b16 %8, %20 offset:%24\n\tds_read_b64_tr_b16 %9, %21 offset:%24\n\tds_read_b64_tr_b16 %10, %20 offset:%25\n\tds_read_b64_tr_b16 %11, %21 offset:%25\n\t"
                 "ds_read_b64_tr_b16 %12, %22 offset:%24\n\tds_read_b64_tr_b16 %13, %23 offset:%24\n\tds_read_b64_tr_b16 %14, %22 offset:%25\n\tds_read_b64_tr_b16 %15, %23 offset:%25\n\ts_waitcnt lgkmcnt(0)"
                 : "=&v"(r[0]), "=&v"(r[1]), "=&v"(r[2]), "=&v"(r[3]), "=&v"(r[4]), "=&v"(r[5]), "=&v"(r[6]), "=&v"(r[7]), "=&v"(r[8]), "=&v"(r[9]), "=&v"(r[10]), "=&v"(r[11]), "=&v"(r[12]), "=&v"(r[13]), "=&v"(r[14]), "=&v"(r[15])
                 : "v"(a0), "v"(a1), "v"(b0), "v"(b1), "v"(c0), "v"(c1), "v"(d0), "v"(d1), "i"(TILE), "i"(TILE + 8192) : "memory");
#pragma unroll
    for (int j = 0; j < 8; ++j) f[j] = __builtin_shufflevector(r[2 * j], r[2 * j + 1], 0, 1, 2, 3, 4, 5, 6, 7);
}
template <int TILE>
__device__ __forceinline__ void tr_frag4(unsigned x0, unsigned x1, unsigned y0, unsigned y1, bf16x8& f0, bf16x8& f1, bf16x8& f2, bf16x8& f3) {
    s16x4 r0, r1, r2, r3, r4, r5, r6, r7;
    asm volatile("ds_read_b64_tr_b16 %0, %8 offset:%12\n\tds_read_b64_tr_b16 %1, %9 offset:%12\n\tds_read_b64_tr_b16 %2, %8 offset:%13\n\tds_read_b64_tr_b16 %3, %9 offset:%13\n\t"
                 "ds_read_b64_tr_b16 %4, %10 offset:%12\n\tds_read_b64_tr_b16 %5, %11 offset:%12\n\tds_read_b64_tr_b16 %6, %10 offset:%13\n\tds_read_b64_tr_b16 %7, %11 offset:%13\n\ts_waitcnt lgkmcnt(0)"
                 : "=&v"(r0), "=&v"(r1), "=&v"(r2), "=&v"(r3), "=&v"(r4), "=&v"(r5), "=&v"(r6), "=&v"(r7) : "v"(x0), "v"(x1), "v"(y0), "v"(y1), "i"(TILE), "i"(TILE + 8192) : "memory");
    f0 = __builtin_shufflevector(r0, r1, 0, 1, 2, 3, 4, 5, 6, 7); f1 = __builtin_shufflevector(r2, r3, 0, 1, 2, 3, 4, 5, 6, 7);
    f2 = __builtin_shufflevector(r4, r5, 0, 1, 2, 3, 4, 5, 6, 7); f3 = __builtin_shufflevector(r6, r7, 0, 1, 2, 3, 4, 5, 6, 7);
}
#define MFMA16(a, b, c) __builtin_amdgcn_mfma_f32_16x16x32_bf16((a), (b), (c), 0, 0, 0)
__device__ __forceinline__ bf16* mstate_ptr(const Frame& F, int sc, int slot, int half) { return wsp<bf16>(F, WS_STATE) + ((size_t)(sc * 8 + slot) * 2 + half) * 16384; }

#define LBAR() asm volatile("s_waitcnt lgkmcnt(0)\n\ts_barrier" ::: "memory")
template <bool OUT>
__device__ __forceinline__ void mscan_run(Frame& F, int model, int b, int h, int dir, int half, int seg, f32x4 (&S)[2][8], float& gacc) {
    LAS unsigned char* lds = F.lds; LAS float* nb = (LAS float*)(F.lds + L_N);
    LAS unsigned short* nbh = (LAS unsigned short*)(F.lds + L_N + 2048);
    const unsigned lb = (unsigned)(uintptr_t)F.lds;
    const int w = F.wave, lane = F.lane, li = lane & 15, lg = lane >> 4, tq = li >> 2, tp = lane & 3;
    const bool st = w < 4; const int sw = w & 3;
    const int nch = seg < 0 ? NCH_CTX : CPS;
    bf16* HS = wsp<bf16>(F, model == 0 ? WS_QKM : WS_QKG);
    const int mli = ((li & 3) << 2) | ((li >> 2) & 3);
    const unsigned rowb = 256u * li + 16u * (lg ^ mli);
    const unsigned o2b = 256u * li + 16u * ((lg >> 1) ^ mli) + 8u * (lg & 1);
    const unsigned trb0 = 256u * (8 * lg + tq) + 16u * ((tp >> 1) ^ ((tq << 2) | ((2 * lg) & 3))) + 8u * (tp & 1);
    const unsigned trb1 = 256u * (8 * lg + 4 + tq) + 16u * ((tp >> 1) ^ ((tq << 2) | ((2 * lg + 1) & 3))) + 8u * (tp & 1);
    const unsigned pra0 = lb + M_P + (128u * li + 16u * (lg ^ (li & 7))), pra1 = lb + M_P + ((128u * li + 16u * (lg ^ (li & 7))) ^ 64u);
    const unsigned poff0 = (unsigned)((F.tid >> 4) * 1024 + (F.tid & 15) * 8) * 2u, poff1 = poff0 + 32u * 2048u;
    auto final_pass = [&](const int m0, const u32x4 (&prevh)[2]) {
        LAS float* Ol = (LAS float*)(F.lds + M_O);
#pragma unroll
        for (int i = 0; i < 2; ++i) { const int p = F.tid + i * 512, t = p >> 4, c8 = p & 15;
            const f32x4 o0 = *(const LAS f32x4*)(Ol + t * O_LD + 8 * c8), o1 = *(const LAS f32x4*)(Ol + t * O_LD + 8 * c8 + 4);
            float rs = 1.f;
            if (model == 0) rs = nb[384 + t];
            bf16* dst = (bf16*)((unsigned char*)(HS + (size_t)m0 * 1024 + h * 256 + half * 128) + (i == 0 ? poff0 : poff1));
            float r[8] = {o0[0] * rs, o0[1] * rs, o0[2] * rs, o0[3] * rs, o1[0] * rs, o1[1] * rs, o1[2] * rs, o1[3] * rs};
            if (dir == 1) { const u32x4 pv = prevh[i];
                r[0] += bflo(pv.x); r[1] += bfhi(pv.x); r[2] += bflo(pv.y); r[3] += bfhi(pv.y); r[4] += bflo(pv.z); r[5] += bfhi(pv.z); r[6] += bflo(pv.w); r[7] += bfhi(pv.w);
                float ssq = (r[0] * r[0] + r[1] * r[1]) + (r[2] * r[2] + r[3] * r[3]) + (r[4] * r[4] + r[5] * r[5]) + (r[6] * r[6] + r[7] * r[7]);
                ssq += __shfl_xor(ssq, 1); ssq += __shfl_xor(ssq, 2); ssq += __shfl_xor(ssq, 4); ssq += __shfl_xor(ssq, 8);
                if (c8 == 0) wsp<float>(F, WS_SSQ)[((size_t)(m0 + t) * 8 + model * 4 + h) * 2 + half] = ssq; }
            u32x4 wv; wv.x = pkbf(r[0], r[1]); wv.y = pkbf(r[2], r[3]); wv.z = pkbf(r[4], r[5]); wv.w = pkbf(r[6], r[7]);
            *(u32x4*)dst = wv; }
    };
    const unsigned pwb = 128u * li + 8u * (lg & 1) + 16u * ((lg >> 1) ^ (li & 7));
    auto ptile = [&](const int ti, const int sh) {
        const bool used = dir == 0 ? !(sh == 1 && ti < 2) : !(sh == 0 && ti >= 2);
        if (!used) return;
        unsigned rowl = rowb; asm volatile("" : "+v"(rowl));
        bf16x8 pa[4], pb0[4], pb1[4];
#pragma unroll
        for (int kk = 0; kk < 4; ++kk) { const unsigned ra = lb + (rowl ^ ((unsigned)kk << 6)); pa[kk] = *(const LAS bf16x8*)(uintptr_t)(ra + M_AQ + 4096u * ti); pb0[kk] = *(const LAS bf16x8*)(uintptr_t)(ra + M_AK + 8192u * sh); pb1[kk] = *(const LAS bf16x8*)(uintptr_t)(ra + M_AK + 8192u * sh + 4096u); }
        f32x4 acc0 = {0.f, 0.f, 0.f, 0.f}, acc1 = acc0;
#pragma unroll
        for (int kk = 0; kk < 4; ++kk) { acc0 = MFMA16(pb0[kk], pa[kk], acc0); acc1 = MFMA16(pb1[kk], pa[kk], acc1); }
        const int t = 16 * ti + li;
#pragma unroll
        for (int sj = 0; sj < 2; ++sj) { const f32x4 acc = sj == 0 ? acc0 : acc1; const int s0 = 16 * (2 * sh + sj) + 4 * lg; float pv[4];
#pragma unroll
            for (int r = 0; r < 4; ++r) { const bool keep = dir == 0 ? (s0 + r <= t) : (s0 + r >= t); pv[r] = keep ? acc[r] : 0.f; }
            u32x2 pw; pw.x = pkbf(pv[0], pv[1]); pw.y = pkbf(pv[2], pv[3]);
            *(LAS u32x2*)(uintptr_t)(lb + M_P + 2048u * ti + (pwb ^ ((unsigned)(4 * sh + 2 * sj) << 4))) = pw; }
    };
    auto chunk_m0 = [&](const int ic) { const int c = seg_chunk(seg, dir, ic), ci = seg < 0 ? 256 + b * 4 + c : b * 128 + c; return chunk_row0(ci); };
    if (st) {
        const unsigned ola = lb + M_O + 4u * ((4 * lg) * O_LD + 32 * sw + li);
        for (int ic = 0; ic < nch; ++ic) {
            const int m0 = chunk_m0(ic);
            LBAR();
            if (F.tid < 128) gacc *= nb[128 + F.tid];
            unsigned o2l = o2b, tr0l = trb0, tr1l = trb1; asm volatile("" : "+v"(o2l), "+v"(tr0l), "+v"(tr1l));
            bf16x8 VB[2][2];
            tr_frag4<M_VP>(lb + (tr0l ^ ((unsigned)(2 * sw) << 5)), lb + (tr1l ^ ((unsigned)(2 * sw) << 5)), lb + (tr0l ^ ((unsigned)(2 * sw + 1) << 5)), lb + (tr1l ^ ((unsigned)(2 * sw + 1) << 5)), VB[0][0], VB[0][1], VB[1][0], VB[1][1]);
            u32x4 prevh[2] = {{0u, 0u, 0u, 0u}, {0u, 0u, 0u, 0u}};
            if (OUT) {
#pragma unroll
                for (int i = 0; i < 2; ++i) prevh[i] = *(const u32x4*)((const unsigned char*)(HS + (size_t)m0 * 1024 + h * 256 + half * 128) + (i == 0 ? poff0 : poff1) * (unsigned)dir);
                ptile(sw, 1);
                f32x4 O[2][4];
#pragma unroll
                for (int j = 0; j < 2; ++j)
#pragma unroll
                    for (int q = 0; q < 4; ++q) O[j][q] = (f32x4){0.f, 0.f, 0.f, 0.f};
#pragma unroll
                for (int kh = 0; kh < 2; ++kh) {
                    u32x2 alo[2][4], ahi[2][4];
#pragma unroll
                    for (int k2 = 0; k2 < 2; ++k2)
#pragma unroll
                        for (int q = 0; q < 4; ++q) { alo[k2][q] = *(const LAS u32x2*)(uintptr_t)((o2l ^ ((unsigned)(4 * (2 * kh + k2)) << 4)) + lb + M_AQ + 4096u * q); ahi[k2][q] = *(const LAS u32x2*)(uintptr_t)((o2l ^ ((unsigned)(4 * (2 * kh + k2) + 2) << 4)) + lb + M_AQ + 4096u * q); }
#pragma unroll
                    for (int k2 = 0; k2 < 2; ++k2) { const int kk = 2 * kh + k2; bf16x8 Bk[2];
#pragma unroll
                        for (int j = 0; j < 2; ++j) { u32x4 bw; bw.x = pkbf(S[j][2 * kk][0], S[j][2 * kk][1]); bw.y = pkbf(S[j][2 * kk][2], S[j][2 * kk][3]); bw.z = pkbf(S[j][2 * kk + 1][0], S[j][2 * kk + 1][1]); bw.w = pkbf(S[j][2 * kk + 1][2], S[j][2 * kk + 1][3]); Bk[j] = __builtin_bit_cast(bf16x8, bw); }
#pragma unroll
                        for (int q = 0; q < 4; ++q) { u32x4 aw; aw.x = alo[k2][q].x; aw.y = alo[k2][q].y; aw.z = ahi[k2][q].x; aw.w = ahi[k2][q].y; const bf16x8 Af = __builtin_bit_cast(bf16x8, aw);
                            O[0][q] = MFMA16(Af, Bk[0], O[0][q]); O[1][q] = MFMA16(Af, Bk[1], O[1][q]); } }
                    asm volatile("" ::: "memory");
                }
                LBAR();
                bf16x8 p0[4], p1[4];
#pragma unroll
                for (int q = 0; q < 4; ++q) { p0[q] = *(const LAS bf16x8*)(uintptr_t)(pra0 + 2048u * q); p1[q] = *(const LAS bf16x8*)(uintptr_t)(pra1 + 2048u * q); }
#pragma unroll
                for (int q = 0; q < 4; ++q) {
                    if (dir == 0 || q < 2) { O[0][q] = MFMA16(p0[q], VB[0][0], O[0][q]); O[1][q] = MFMA16(p0[q], VB[1][0], O[1][q]); }
                    if (dir == 1 || q >= 2) { O[0][q] = MFMA16(p1[q], VB[0][1], O[0][q]); O[1][q] = MFMA16(p1[q], VB[1][1], O[1][q]); } }
#pragma unroll
                for (int j = 0; j < 2; ++j)
#pragma unroll
                    for (int q = 0; q < 4; ++q)
#pragma unroll
                        for (int r = 0; r < 4; ++r) *(LAS float*)(uintptr_t)(ola + 64u * j + 4u * (unsigned)((16 * q + r) * O_LD)) = O[j][q][r];
            }
#pragma unroll
            for (int kp = 0; kp < 4; ++kp) { bf16x8 A0, A1, A2, A3; const int kt = 2 * kp;
                const f32x4 g0 = *(const LAS f32x4*)(nb + 128 + 16 * kt + 4 * lg), g1 = *(const LAS f32x4*)(nb + 128 + 16 * (kt + 1) + 4 * lg);
                tr_frag4<M_AK>(lb + (tr0l ^ ((unsigned)kt << 5)), lb + (tr1l ^ ((unsigned)kt << 5)), lb + (tr0l ^ ((unsigned)(kt + 1) << 5)), lb + (tr1l ^ ((unsigned)(kt + 1) << 5)), A0, A1, A2, A3);
#pragma unroll
                for (int j = 0; j < 2; ++j) { S[j][kt] = MFMA16(A0, VB[j][0], S[j][kt]); S[j][kt + 1] = MFMA16(A2, VB[j][0], S[j][kt + 1]); }
#pragma unroll
                for (int j = 0; j < 2; ++j) { S[j][kt] = MFMA16(A1, VB[j][1], S[j][kt]); S[j][kt + 1] = MFMA16(A3, VB[j][1], S[j][kt + 1]); }
#pragma unroll
                for (int j = 0; j < 2; ++j) { S[j][kt] = S[j][kt] * g0; S[j][kt + 1] = S[j][kt + 1] * g1; } }
            LBAR();
            if (OUT) final_pass(m0, prevh);
        }
    } else {
        const int ht = F.tid - 256;
        const unsigned hoff = (unsigned)((ht >> 4) * 1024 + (ht & 15) * 8) * 2u;
        const unsigned aoff = (unsigned)(ht >> 4) * 32u + 4u, aoffl = (unsigned)(ht & 63) * 32u;
        const f32x2* ABd = wsp<f32x2>(F, WS_AB) + (size_t)dir * MT * 4 + h;
        const bf16* vbase = wsp<bf16>(F, model == 0 ? WS_VM : WS_VG) + h * 256 + half * 128;
        struct SR { u32x4 q[4], k[4], v[4]; float be[4]; f32x2 ab; float ge; };
        SR R;
        auto issue = [&](const int ic_) {
            const int c_ = seg_chunk(seg, dir, ic_), ci_ = seg < 0 ? 256 + b * 4 + c_ : b * 128 + c_, m0_ = chunk_row0(ci_);
            const unsigned char* abr = (const unsigned char*)(ABd + (size_t)m0_ * 4);
            { const float* abp = (const float*)(abr + aoffl); R.ab.x = abp[0]; R.ab.y = abp[1]; }
            const float* gp = model == 0 ? wsp<float>(F, WS_GENDM) + ((size_t)dir * NCHUNK + ci_) * 4 + h : wsp<float>(F, WS_GENDG) + ((size_t)dir * NCHUNK + ci_) * 512 + h * 128 + ((ht - 64) & 127);
            R.ge = *gp;
            const long long qoff = model == 0 ? (long long)WS_QKMC : (m0_ < M_LAT ? 0ll : (long long)WS_QKGTC + ((long long)dir * M_CTX - M_LAT) * 2048);
            const unsigned char* qbb = (model == 1 && m0_ < M_LAT) ? (const unsigned char*)F.out + (size_t)dir * M_LAT * 2048 : (const unsigned char*)F.ws + qoff;
            const unsigned char* qr = qbb + (size_t)m0_ * 2048 + h * 256;
            const unsigned char* vr = (const unsigned char*)(vbase + (size_t)m0_ * 1024);
#pragma unroll
            for (int i = 0; i < 4; ++i) { const unsigned o = hoff + (unsigned)i * 16u * 2048u;
                if (OUT) R.q[i] = *(const u32x4*)(qr + o);
                R.k[i] = *(const u32x4*)(qr + 1024 + o); R.v[i] = *(const u32x4*)(vr + o); R.be[i] = *(const float*)(abr + aoff + (unsigned)i * 16u * 32u); }
        };
        const int ti = sw;
        const unsigned fra = lb + L_N + 2048 + (li == 1 ? 128u : 0u) + 16u * lg;
        const unsigned nfa = lb + L_N + 2048 + 256 + (li == 1 ? 256u : 0u) + 16u * lg;
        issue(0);
        for (int ic = 0; ic < nch; ++ic) {
            const int m0 = chunk_m0(ic);
            if (model == 0 && ht < 64) { const float be = R.ab.y; nb[320 + ht] = R.ab.x;
                const unsigned hi = pkbf(be, be) & 0xffffu; nbh[ht] = (unsigned short)hi; nbh[64 + ht] = (unsigned short)(pkbf(be - bflo(hi), 0.f) & 0xffffu); }
            if (ht >= 64 && ht < 192) nb[128 + ht - 64] = R.ge;
#pragma unroll
            for (int i = 0; i < 4; ++i) { const int p = ht + i * 256, r = p >> 4, cp = p & 15;
                const unsigned o = offb(r, cp);
                if (OUT) *(LAS u32x4*)(lds + M_AQ + o) = R.q[i];
                *(LAS u32x4*)(lds + M_AK + o) = R.k[i];
                u32x4 v = R.v[i];
                if (model == 0) { const float be = R.be[i];
                    v.x = pkbf(bflo(v.x) * be, bfhi(v.x) * be); v.y = pkbf(bflo(v.y) * be, bfhi(v.y) * be); v.z = pkbf(bflo(v.z) * be, bfhi(v.z) * be); v.w = pkbf(bflo(v.w) * be, bfhi(v.w) * be); }
                *(LAS u32x4*)(lds + M_VP + o) = v; }
            LBAR();
            u32x4 prevh[2] = {{0u, 0u, 0u, 0u}, {0u, 0u, 0u, 0u}};
            if (OUT) {
#pragma unroll
                for (int i = 0; i < 2; ++i) prevh[i] = *(const u32x4*)((const unsigned char*)(HS + (size_t)m0 * 1024 + h * 256 + half * 128) + (i == 0 ? poff0 : poff1) * (unsigned)dir);
                ptile(ti, 0);
            }
            if (ic + 1 < nch) issue(ic + 1);
            unsigned rowl = rowb, tr0l = trb0, tr1l = trb1; asm volatile("" : "+v"(rowl), "+v"(tr0l), "+v"(tr1l));
            bf16x8 BB0, BB1;
            { u32x4 z = {0u, 0u, 0u, 0u}; BB0 = __builtin_bit_cast(bf16x8, z); BB1 = BB0; }
            if (model == 0) { u32x4 f0 = *(const LAS u32x4*)(uintptr_t)fra, f1 = *(const LAS u32x4*)(uintptr_t)(fra + 64u); const u32x4 z = {0u, 0u, 0u, 0u};
                if (li > 1) { f0 = z; f1 = z; } BB0 = __builtin_bit_cast(bf16x8, f0); BB1 = __builtin_bit_cast(bf16x8, f1); }
            f32x4 dq = {0.f, 0.f, 0.f, 0.f};
            if (OUT && model == 0) {
                bf16x8 pa[4]; u32x4 nf[4]; const u32x4 z = {0u, 0u, 0u, 0u};
#pragma unroll
                for (int kk = 0; kk < 4; ++kk) { pa[kk] = *(const LAS bf16x8*)(uintptr_t)(lb + (rowl ^ ((unsigned)kk << 6)) + M_AQ + 4096u * ti); nf[kk] = *(const LAS u32x4*)(uintptr_t)(nfa + 64u * kk); if (li > 1) nf[kk] = z; }
#pragma unroll
                for (int kk = 0; kk < 4; ++kk) dq = MFMA16(pa[kk], __builtin_bit_cast(bf16x8, nf[kk]), dq);
            }
            f32x4 nacc0 = {0.f, 0.f, 0.f, 0.f}, nacc1 = nacc0;
            if (model == 0) { bf16x8 A0, A1, A2, A3;
                tr_frag4<M_AK>(lb + (tr0l ^ ((unsigned)(2 * ti) << 5)), lb + (tr1l ^ ((unsigned)(2 * ti) << 5)), lb + (tr0l ^ ((unsigned)(2 * ti + 1) << 5)), lb + (tr1l ^ ((unsigned)(2 * ti + 1) << 5)), A0, A1, A2, A3);
                nacc0 = MFMA16(A0, BB0, nacc0); nacc0 = MFMA16(A1, BB1, nacc0); nacc1 = MFMA16(A2, BB0, nacc1); nacc1 = MFMA16(A3, BB1, nacc1); }
            float nnew[8] = {0.f, 0.f, 0.f, 0.f, 0.f, 0.f, 0.f, 0.f};
            if (model == 0) { const f32x4 no0 = *(const LAS f32x4*)(nb + 32 * ti + 4 * lg), no1 = *(const LAS f32x4*)(nb + 32 * ti + 16 + 4 * lg), gw0 = *(const LAS f32x4*)(nb + 128 + 32 * ti + 4 * lg), gw1 = *(const LAS f32x4*)(nb + 128 + 32 * ti + 16 + 4 * lg);
#pragma unroll
                for (int r = 0; r < 4; ++r) { nnew[r] = gw0[r] * (no0[r] + nacc0[r] + __shfl_xor(nacc0[r], 1)); nnew[4 + r] = gw1[r] * (no1[r] + nacc1[r] + __shfl_xor(nacc1[r], 1)); } }
            if (OUT) {
                LBAR();
                if (model == 0) { f32x4 dp = dq;
                    const bf16x8 p0 = *(const LAS bf16x8*)(uintptr_t)(pra0 + 2048u * ti), p1 = *(const LAS bf16x8*)(uintptr_t)(pra1 + 2048u * ti);
                    if (dir == 0 || ti < 2) dp = MFMA16(p0, BB0, dp);
                    if (dir == 1 || ti >= 2) dp = MFMA16(p1, BB1, dp);
#pragma unroll
                    for (int r = 0; r < 4; ++r) { const float v = dp[r] + __shfl_xor(dp[r], 1); const float al = nb[320 + 16 * ti + 4 * lg + r];
                        if (li == 0) nb[384 + 16 * ti + 4 * lg + r] = al / fmaxf(al * fabsf(v), 1.f); } }
            }
            LBAR();
            if (model == 0 && li == 0) {
#pragma unroll
                for (int j = 0; j < 2; ++j) { const int dk0 = 32 * ti + 16 * j + 4 * lg; const float* nn = nnew + 4 * j;
                    f32x4 nv = {nn[0], nn[1], nn[2], nn[3]}; *(LAS f32x4*)(nb + dk0) = nv;
                    u32x2 hv, lv; const unsigned h0 = pkbf(nn[0], nn[1]), h1 = pkbf(nn[2], nn[3]); hv.x = h0; hv.y = h1;
                    lv.x = pkbf(nn[0] - bflo(h0), nn[1] - bfhi(h0)); lv.y = pkbf(nn[2] - bflo(h1), nn[3] - bfhi(h1));
                    *(LAS u32x2*)(nbh + 128 + dk0) = hv; *(LAS u32x2*)(nbh + 256 + dk0) = lv; } }
            if (OUT) final_pass(m0, prevh);
        }
    }
}
__device__ __forceinline__ void p4m_scan_local(Frame& F) {
    LAS float* nb = (LAS float*)(F.lds + L_N);
    for (int it0 = F.bid; it0 < 32 * 8 * 2; it0 += F.G) {
        const int it = (F.G == 256) ? (it0 & ~255) | ((((((it0 & 255) >> 4) << 3) | (it0 & 7)) << 1) | ((it0 >> 3) & 1)) : it0;
        const int half = it & 1, slot = (it >> 1) & 7, sc = it >> 4, seg = slot - 1;
        const int dir = sc & 1, h = (sc >> 1) & 3, b = (sc >> 3) & 1, model = sc >> 4;
        f32x4 S[2][8];
#pragma unroll
        for (int j = 0; j < 2; ++j)
#pragma unroll
            for (int kt = 0; kt < 8; ++kt) S[j][kt] = (f32x4){0.f, 0.f, 0.f, 0.f};
        __syncthreads();
        if (F.tid < 128) nb[F.tid] = 0.f;
        float gacc = 1.f;
        mscan_run<false>(F, model, b, h, dir, half, seg, S, gacc);
        __syncthreads();
        if (F.wave < 4) {
#pragma unroll
            for (int j = 0; j < 2; ++j) { unsigned so = (unsigned)((2 * F.wave + j) * 512 + F.lane) * 8u; asm volatile("" : "+v"(so));
                bf16* st = (bf16*)((unsigned char*)mstate_ptr(F, sc, slot, half) + so);
#pragma unroll
                for (int kt = 0; kt < 8; ++kt) { u32x2 v; v.x = pkbf(S[j][kt][0], S[j][kt][1]); v.y = pkbf(S[j][kt][2], S[j][kt][3]); *(u32x2*)(st + kt * 256) = v; } } }
        if (half == 0 && F.tid < 128) { wsp<float>(F, WS_NST)[(sc * 8 + slot) * 128 + F.tid] = nb[F.tid]; wsp<float>(F, WS_GSEG)[(sc * 8 + slot) * 128 + F.tid] = gacc; }
    }
}
__device__ __forceinline__ void p5m_scan_out(Frame& F) {
    LAS float* nb = (LAS float*)(F.lds + L_N);
    for (int it0 = F.bid; it0 < 2 * 2 * 4 * 8 * 2; it0 += F.G) {
        const int it = (F.G == 256) ? ((((it0 >> 4) << 3) | (it0 & 7)) << 1) | ((it0 >> 3) & 1) : it0;
        const int half = it & 1, seg = (it >> 1) & 7, h = (it >> 4) & 3, b = (it >> 6) & 1, model = it >> 7;
        for (int dir = 0; dir < 2; ++dir) {
            const int sc = ((model * 2 + b) * 4 + h) * 2 + dir, s = dir == 0 ? seg : 7 - seg;
            f32x4 S[2][8];
#pragma unroll
            for (int j = 0; j < 2; ++j)
#pragma unroll
                for (int kt = 0; kt < 8; ++kt) S[j][kt] = (f32x4){0.f, 0.f, 0.f, 0.f};
            float nn = 0.f;
            for (int slot = 0; slot <= s; ++slot) {
                const float* gs = wsp<float>(F, WS_GSEG) + (sc * 8 + slot) * 128;
                const float gv = gs[F.tid & 127], nv = wsp<float>(F, WS_NST)[(sc * 8 + slot) * 128 + (F.tid & 127)];
                if (F.wave < 4) {
                    f32x4 gv4[8];
#pragma unroll
                    for (int kt = 0; kt < 8; ++kt) gv4[kt] = *(const f32x4*)(gs + 16 * kt + 4 * (F.lane >> 4));
#pragma unroll
                    for (int j = 0; j < 2; ++j) { unsigned so = (unsigned)((2 * F.wave + j) * 512 + F.lane) * 8u; asm volatile("" : "+v"(so));
                        const bf16* stp = (const bf16*)((const unsigned char*)mstate_ptr(F, sc, slot, half) + so);
                        u32x2 sv[8];
#pragma unroll
                        for (int kt = 0; kt < 8; ++kt) sv[kt] = *(const u32x2*)(stp + kt * 256);
#pragma unroll
                        for (int kt = 0; kt < 8; ++kt) { const u32x2 v = sv[kt]; f32x4 g4 = gv4[kt]; if (slot == 0) g4 = (f32x4){0.f, 0.f, 0.f, 0.f};
                            S[j][kt][0] = g4[0] * S[j][kt][0] + bflo(v.x); S[j][kt][1] = g4[1] * S[j][kt][1] + bfhi(v.x); S[j][kt][2] = g4[2] * S[j][kt][2] + bflo(v.y); S[j][kt][3] = g4[3] * S[j][kt][3] + bfhi(v.y); } } }
                nn = (slot > 0 ? gv : 0.f) * nn + nv; }
            __syncthreads();
            if (F.tid < 128) { nb[F.tid] = nn; LAS unsigned short* nbh = (LAS unsigned short*)(F.lds + L_N + 2048);
                const unsigned hi = pkbf(nn, nn) & 0xffffu; nbh[128 + F.tid] = (unsigned short)hi; nbh[256 + F.tid] = (unsigned short)(pkbf(nn - bflo(hi), 0.f) & 0xffffu); }
            float gacc = 1.f;
            mscan_run<true>(F, model, b, h, dir, half, s, S, gacc);
        }
    }
}

struct EpiProjB {
    unsigned char* ws; const float* ml_norm; const float* gla_norm;
    __device__ __forceinline__ void operator()(const f32x4 (&acc)[2][2][4][2], const Unit& u, int wr, int wc, int fr, int fq) const {
        const int row0 = u.pm * 256 + wr * 64 + fr, colt = (u.pn & 3) * 256 + wc * 32 + 8 * fq;
        if (u.pn < 8) {
            const int model = u.pn >> 2, head = u.pn & 3;
            bf16* base = (bf16*)(ws + (model == 0 ? WS_QKM : WS_QKG)) + colt;
            const float* nw = (model == 0 ? ml_norm : gla_norm) + colt;
            const float* ssq = (const float*)(ws + WS_SSQ);
            const float gsel = model == 0 ? 0.f : 1.f;
            f32x4 nwv[2][2];
#pragma unroll
            for (int bj = 0; bj < 2; ++bj) { nwv[bj][0] = *(const f32x4*)(nw + bj * 128); nwv[bj][1] = *(const f32x4*)(nw + bj * 128 + 4); }
            u32x4 hvq[8][2]; f32x2 sqq[8];
#define EPB_ISSUE(g) do { const int row_ = row0 + ((g) >> 2) * 128 + ((g) & 3) * 16; const bf16* rp_ = base + (size_t)row_ * 1024; hvq[g][0] = *(const u32x4*)rp_; hvq[g][1] = *(const u32x4*)(rp_ + 128); \
                sqq[g] = *(const f32x2*)(ssq + ((size_t)row_ * 8 + model * 4 + head) * 2); } while (0)
            EPB_ISSUE(0); EPB_ISSUE(1); EPB_ISSUE(2); EPB_ISSUE(3);
#pragma unroll
            for (int g = 0; g < 8; ++g) { const int ai = g >> 2, m = g & 3;
                __builtin_amdgcn_sched_barrier(0);
                if (g == 1) { EPB_ISSUE(4); EPB_ISSUE(5); }
                if (g == 2) { EPB_ISSUE(6); EPB_ISSUE(7); }
                __builtin_amdgcn_sched_barrier(0);
                const int row = row0 + ai * 128 + m * 16; bf16* rowp = base + (size_t)row * 1024;
                const float rstd = 1.f / sqrtf((sqq[g].x + sqq[g].y) * (1.f / 256.f) + EPS);
                float one = 1.f; asm volatile("" : "+v"(one));
#pragma unroll
                for (int bj = 0; bj < 2; ++bj) { const f32x4 a0 = acc[ai][bj][m][0] * one, a1 = acc[ai][bj][m][1] * one;
                    const f32x4 n0 = nwv[bj][0], n1 = nwv[bj][1];
                    float hvf[8]; unpack8(hvq[g][bj], hvf); float o[8];
#pragma unroll
                    for (int j = 0; j < 4; ++j) { const float s0 = sigm(a0[j]), s1 = sigm(a1[j]);
                        o[j] = hvf[j] * rstd * n0[j] * (s0 + gsel * (s0 * a0[j] - s0)); o[4 + j] = hvf[4 + j] * rstd * n1[j] * (s1 + gsel * (s1 * a1[j] - s1)); }
                    u32x4 w; w.x = cvt_pk_bf16(o[0], o[1]); w.y = cvt_pk_bf16(o[2], o[3]); w.z = cvt_pk_bf16(o[4], o[5]); w.w = cvt_pk_bf16(o[6], o[7]);
                    *(u32x4*)(rowp + bj * 128) = w; } }
#undef EPB_ISSUE
        } else {
            bf16* base = (bf16*)(ws + (u.pn < 12 ? WS_VG : WS_QKMC)) + colt;
#pragma unroll
            for (int ai = 0; ai < 2; ++ai)
#pragma unroll
                for (int m = 0; m < 4; ++m) { bf16* rowp = base + (size_t)(row0 + ai * 128 + m * 16) * 1024;
#pragma unroll
                    for (int bj = 0; bj < 2; ++bj) { const f32x4 a0 = acc[ai][bj][m][0], a1 = acc[ai][bj][m][1];
                        u32x4 w; w.x = pkbf(sigm(a0[0]), sigm(a0[1])); w.y = pkbf(sigm(a0[2]), sigm(a0[3])); w.z = pkbf(sigm(a1[0]), sigm(a1[1])); w.w = pkbf(sigm(a1[2]), sigm(a1[3]));
                        *(u32x4*)(rowp + bj * 128) = w; } }
        }
    }
};
template <int STEP> struct EpiGate {
    unsigned char* ws;
    __device__ __forceinline__ void operator()(const f32x4 (&acc)[2][2][4][2], const Unit& u, int wr, int wc, int fr, int fq) const {
        const int row0 = u.pm * 256 + wr * 64 + fr, colt = u.pn * 256 + wc * 32 + 8 * fq;
        const bf16* sg = (const bf16*)(ws + (STEP == 0 ? WS_VG : WS_QKMC)) + colt; bf16* ty = (bf16*)(ws + WS_VM) + colt;
#pragma unroll
        for (int ai = 0; ai < 2; ++ai)
#pragma unroll
            for (int m = 0; m < 4; ++m) { const size_t ro = (size_t)(row0 + ai * 128 + m * 16) * 1024;
#pragma unroll
                for (int bj = 0; bj < 2; ++bj) { const f32x4 a0 = acc[ai][bj][m][0], a1 = acc[ai][bj][m][1];
                    const u32x4 s = *(const u32x4*)(sg + ro + bj * 128);
                    float r[8] = {bflo(s.x) * a0[0], bfhi(s.x) * a0[1], bflo(s.y) * a0[2], bfhi(s.y) * a0[3], bflo(s.z) * a1[0], bfhi(s.z) * a1[1], bflo(s.w) * a1[2], bfhi(s.w) * a1[3]};
                    if (STEP == 1) { const u32x4 t = *(const u32x4*)(ty + ro + bj * 128);
                        r[0] += bflo(t.x); r[1] += bfhi(t.x); r[2] += bflo(t.y); r[3] += bfhi(t.y); r[4] += bflo(t.z); r[5] += bfhi(t.z); r[6] += bflo(t.w); r[7] += bfhi(t.w); }
                    u32x4 w; w.x = cvt_pk_bf16(r[0], r[1]); w.y = cvt_pk_bf16(r[2], r[3]); w.z = cvt_pk_bf16(r[4], r[5]); w.w = cvt_pk_bf16(r[6], r[7]);
                    *(u32x4*)(ty + ro + bj * 128) = w; } }
    }
};
struct EpiOut {
    const float* x; float* out; const float* modv;
    __device__ __forceinline__ void operator()(const f32x4 (&acc)[2][2][4][2], const Unit& u, int wr, int wc, int fr, int fq) const {
        const int row0 = u.pm * 256 + wr * 64 + fr, colt = u.pn * 256 + wc * 32 + 8 * fq;
        const float* gt = modv + ((u.pm * 256) >> 13) * 6144 + 2048 + colt;
#pragma unroll
        for (int bj = 0; bj < 2; ++bj) { const f32x4 g0 = *(const f32x4*)(gt + bj * 128), g1 = *(const f32x4*)(gt + bj * 128 + 4);
#pragma unroll
            for (int ai = 0; ai < 2; ++ai)
#pragma unroll
                for (int m = 0; m < 4; ++m) { const size_t off = (size_t)(row0 + ai * 128 + m * 16) * 1024 + colt + bj * 128;
                    *(f32x4*)(out + off) = *(const f32x4*)(x + off) + g0 * acc[ai][bj][m][0]; *(f32x4*)(out + off + 4) = *(const f32x4*)(x + off + 4) + g1 * acc[ai][bj][m][1]; } }
    }
};

__device__ __forceinline__ void p9_route(Frame& F) {
    PMARK0(40)
    const float* modv = wsp<float>(F, WS_MODV);
    constexpr int WP = 1032;
    LAS unsigned short* Wt = (LAS unsigned short*)F.lds;
    LAS int* hist = (LAS int*)(F.lds + 40 * WP * 2 + 16384);
    if (F.tid < 32) hist[F.tid] = 0;
    for (int k = F.tid; k < 1024; k += NTHR) {
        const f32x4 wg = *(const f32x4*)(F.w_grp + (size_t)k * 4), w0 = *(const f32x4*)(F.w_rexp + (size_t)k * 16), w1 = *(const f32x4*)(F.w_rexp + (size_t)k * 16 + 4), w2 = *(const f32x4*)(F.w_rexp + (size_t)k * 16 + 8), w3 = *(const f32x4*)(F.w_rexp + (size_t)k * 16 + 12);
        const float wv[20] = {wg[0], wg[1], wg[2], wg[3], w0[0], w0[1], w0[2], w0[3], w1[0], w1[1], w1[2], w1[3], w2[0], w2[1], w2[2], w2[3], w3[0], w3[1], w3[2], w3[3]};
#pragma unroll
        for (int n = 0; n < 20; ++n) { const unsigned hi = pkbf(wv[n], 0.f) & 0xffffu; Wt[n * WP + k] = (unsigned short)hi; Wt[(20 + n) * WP + k] = (unsigned short)(pkbf(wv[n] - bflo(hi), 0.f) & 0xffffu); } }
    __syncthreads();
    int* rexp = (int*)(F.ws + WS_ROUTE + RT_EXP); float* rw = (float*)(F.ws + WS_ROUTE + RT_W); int* rpos = (int*)(F.ws + WS_ROUTE + RT_POS);
    const int li = F.lane & 15, lg = F.lane >> 4;
    const int n1 = 16 + li < 20 ? 16 + li : 19;
    LAS float* gco = (LAS float*)(F.lds + 40 * WP * 2 + 16384 + 256);
    LAS float* shv = gco + 1024;
    LAS float* ssh = shv + 1024;
    LAS float* lgall = (LAS float*)(F.lds + 40 * WP * 2);
    const int tp = F.wave >> 1, hf = F.wave & 1;
    for (int tg = F.bid; tg < M_LAT / 64; tg += F.G) {
        const int mrow0 = 64 * tg, m = mrow0 + 16 * tp + li;
        const float* mvb = modv + (mrow0 >> 13) * 6144;
        __syncthreads();
        for (int c = F.tid; c < 1024; c += NTHR) { gco[c] = F.g_norm2[c] * (mvb[4096 + c] + 1.f); shv[c] = mvb[3072 + c]; }
        const float* src = F.out + (size_t)m * D + hf * 512 + 8 * lg;
        f32x4 xa[16], xb[16];
#pragma unroll
        for (int ks = 0; ks < 16; ++ks) { xa[ks] = *(const f32x4*)(src + 32 * ks); xb[ks] = *(const f32x4*)(src + 32 * ks + 4); }
        float ss = 0.f;
#pragma unroll
        for (int ks = 0; ks < 16; ++ks) { const f32x4 a = xa[ks], c = xb[ks]; ss += (a.x * a.x + a.y * a.y) + (a.z * a.z + a.w * a.w) + (c.x * c.x + c.y * c.y) + (c.z * c.z + c.w * c.w); }
        ss += __shfl_xor(ss, 16); ss += __shfl_xor(ss, 32);
        if (lg == 0) ssh[F.wave * 16 + li] = ss;
        __syncthreads();
        const float rstd = 1.f / sqrtf((ssh[F.wave * 16 + li] + ssh[(F.wave ^ 1) * 16 + li]) * (1.f / D) + EPS);
        f32x4 acc0 = {0.f, 0.f, 0.f, 0.f}, acc1 = acc0;
        bf16* o = wsp<bf16>(F, WS_H2) + (size_t)m * D + hf * 512 + 8 * lg;
#pragma unroll
        for (int ks = 0; ks < 16; ++ks) { const int c = hf * 512 + 32 * ks + 8 * lg;
            const f32x4 ga = *(const LAS f32x4*)(gco + c), gb = *(const LAS f32x4*)(gco + c + 4), sha = *(const LAS f32x4*)(shv + c), shb = *(const LAS f32x4*)(shv + c + 4);
            const f32x4 ha = (xa[ks] * rstd) * ga + sha, hb = (xb[ks] * rstd) * gb + shb;
            u32x4 hi; hi.x = pkbf(ha[0], ha[1]); hi.y = pkbf(ha[2], ha[3]); hi.z = pkbf(hb[0], hb[1]); hi.w = pkbf(hb[2], hb[3]);
            u32x4 lo; lo.x = pkbf(ha[0] - bflo(hi.x), ha[1] - bfhi(hi.x)); lo.y = pkbf(ha[2] - bflo(hi.y), ha[3] - bfhi(hi.y)); lo.z = pkbf(hb[0] - bflo(hi.z), hb[1] - bfhi(hi.z)); lo.w = pkbf(hb[2] - bflo(hi.w), hb[3] - bfhi(hi.w));
            *(u32x4*)(o + 32 * ks) = hi;
            const bf16x8 Ah = __builtin_bit_cast(bf16x8, hi), Al = __builtin_bit_cast(bf16x8, lo);
            const bf16x8 bh0 = *(const LAS bf16x8*)(Wt + li * WP + c), bh1 = *(const LAS bf16x8*)(Wt + n1 * WP + c), bl0 = *(const LAS bf16x8*)(Wt + (20 + li) * WP + c), bl1 = *(const LAS bf16x8*)(Wt + (20 + n1) * WP + c);
            acc0 = __builtin_amdgcn_mfma_f32_16x16x32_bf16(Ah, bh0, acc0, 0, 0, 0); acc1 = __builtin_amdgcn_mfma_f32_16x16x32_bf16(Ah, bh1, acc1, 0, 0, 0);
            acc0 = __builtin_amdgcn_mfma_f32_16x16x32_bf16(Al, bh0, acc0, 0, 0, 0); acc1 = __builtin_amdgcn_mfma_f32_16x16x32_bf16(Al, bh1, acc1, 0, 0, 0);
            acc0 = __builtin_amdgcn_mfma_f32_16x16x32_bf16(Ah, bl0, acc0, 0, 0, 0); acc1 = __builtin_amdgcn_mfma_f32_16x16x32_bf16(Ah, bl1, acc1, 0, 0, 0); }
        LAS float* lgs = lgall + F.wave * 512;
#pragma unroll
        for (int r = 0; r < 4; ++r) { lgs[(4 * lg + r) * 32 + li] = acc0[r]; lgs[(4 * lg + r) * 32 + 16 + li] = acc1[r]; }
        __syncthreads();
        if (hf == 0 && F.lane < 16) {
            const int mr = mrow0 + 16 * tp + F.lane;
            const LAS float* l0 = lgs + F.lane * 32; const LAS float* l1 = l0 + 512;
            const f32x4 lq0 = *(const LAS f32x4*)(l0) + *(const LAS f32x4*)(l1), lq1 = *(const LAS f32x4*)(l0 + 4) + *(const LAS f32x4*)(l1 + 4), lq2 = *(const LAS f32x4*)(l0 + 8) + *(const LAS f32x4*)(l1 + 8),
                        lq3 = *(const LAS f32x4*)(l0 + 12) + *(const LAS f32x4*)(l1 + 12), lq4 = *(const LAS f32x4*)(l0 + 16) + *(const LAS f32x4*)(l1 + 16);
            const f32x4 bg = *(const f32x4*)F.b_grp;
            float gl[4] = {lq0[0] + bg[0], lq0[1] + bg[1], lq0[2] + bg[2], lq0[3] + bg[3]};
            int grp = 0; float gmax = gl[0];
#pragma unroll
            for (int q = 1; q < 4; ++q) if (gl[q] > gmax) { gmax = gl[q]; grp = q; }
            float gs = 0.f;
#pragma unroll
            for (int q = 0; q < 4; ++q) gs += expf(gl[q] - gmax);
            const float grp_p = 1.f / gs;
            float el[4];
#pragma unroll
            for (int q = 0; q < 4; ++q) { float v = lq1[q]; v = grp == 1 ? lq2[q] : v; v = grp == 2 ? lq3[q] : v; v = grp == 3 ? lq4[q] : v; asm volatile("" : "+v"(v)); el[q] = v + F.b_rexp[grp * 4 + q]; }
            int i0 = 0; float e0v = el[0];
#pragma unroll
            for (int q = 1; q < 4; ++q) if (el[q] > e0v) { e0v = el[q]; i0 = q; }
            int i1 = -1; float e1v = -3.0e38f;
#pragma unroll
            for (int q = 0; q < 4; ++q) if (q != i0 && el[q] > e1v) { e1v = el[q]; i1 = q; }
            const float e1 = expf(e1v - e0v); const float w0 = grp_p / (1.f + e1), w1 = grp_p * e1 / (1.f + e1);
            const int x0 = grp * 4 + i0, x1 = grp * 4 + i1;
            rexp[2 * mr] = x0; rexp[2 * mr + 1] = x1; rw[2 * mr] = w0; rw[2 * mr + 1] = w1;
            rpos[2 * mr] = __hip_atomic_fetch_add(hist + x0, 1, __ATOMIC_RELAXED, __HIP_MEMORY_SCOPE_WORKGROUP);
            rpos[2 * mr + 1] = __hip_atomic_fetch_add(hist + x1, 1, __ATOMIC_RELAXED, __HIP_MEMORY_SCOPE_WORKGROUP);
        }
    }
    __syncthreads();
    if (F.tid < 16) hist[16 + F.tid] = (int)__hip_atomic_fetch_add((unsigned*)(F.ws + WS_CTL) + CW_CNT + 64 * F.tid, (unsigned)hist[F.tid], __ATOMIC_RELAXED, __HIP_MEMORY_SCOPE_AGENT);
    __syncthreads();
    VM_WAIT();
    for (int tg = F.bid; tg < M_LAT / 64; tg += F.G) if (F.tid < 128) { const int a = 128 * tg + F.tid, e = rexp[a], pos = rpos[a] + hist[16 + e]; rpos[a] = pos;
        wsp<int>(F, WS_LTOK)[e * LCAP + pos] = a >> 1; wsp<float>(F, WS_LW)[e * LCAP + pos] = rw[a]; }
    __syncthreads();
    PMARK1(40)
    PMARK0(41)
    moe_weight_copies<0>(F);
    PMARK1(41)
}
__device__ __forceinline__ void moe_layout(Frame& F) {
    LAS int* tab = (LAS int*)(F.lds + LDS_TAB);
    if (F.tid == 0) { int a = 0; for (int e = 0; e < 16; ++e) { const int c = (int)__hip_atomic_load((unsigned*)(F.ws + WS_CTL) + CW_CNT + 64 * e, __ATOMIC_RELAXED, __HIP_MEMORY_SCOPE_AGENT); tab[e] = a; tab[32 + e] = c; a += (c + 255) & ~255; } tab[16] = a; tab[17] = a >> 8; }
    __syncthreads();
}
struct EpiUp {
    unsigned char* ws;
    __device__ __forceinline__ void operator()(const f32x4 (&acc)[2][2][4][2], const Unit& u, int wr, int wc, int fr, int fq) const {
        const int row0 = u.pm * 256 + wr * 64 + fr; bf16* base = (bf16*)(ws + WS_HID) + u.pn * 128 + wc * 32 + 8 * fq;
#pragma unroll
        for (int ai = 0; ai < 2; ++ai)
#pragma unroll
            for (int m = 0; m < 4; ++m) { const f32x4 g0 = acc[ai][0][m][0], g1 = acc[ai][0][m][1], u0 = acc[ai][1][m][0], u1 = acc[ai][1][m][1];
                u32x4 w; w.x = cvt_pk_bf16(siluf(g0[0]) * u0[0], siluf(g0[1]) * u0[1]); w.y = cvt_pk_bf16(siluf(g0[2]) * u0[2], siluf(g0[3]) * u0[3]);
                w.z = cvt_pk_bf16(siluf(g1[0]) * u1[0], siluf(g1[1]) * u1[1]); w.w = cvt_pk_bf16(siluf(g1[2]) * u1[2], siluf(g1[3]) * u1[3]);
                *(u32x4*)(base + (size_t)(row0 + ai * 128 + m * 16) * 512) = w; }
    }
};
struct EpiDown {
    unsigned char* ws; const LAS int* tab;
    __device__ __forceinline__ void operator()(const f32x4 (&acc)[2][2][4][2], const Unit& u, int wr, int wc, int fr, int fq) const {
        const int row0 = u.pm * 256 + wr * 64 + fr; bf16* base = (bf16*)(ws + WS_YROWS) + u.pn * 256 + wc * 32 + 8 * fq;
        const float* lw = (const float*)(ws + WS_LW) + u.e * LCAP - tab[u.e];
#pragma unroll
        for (int ai = 0; ai < 2; ++ai)
#pragma unroll
            for (int m = 0; m < 4; ++m) { const int row = row0 + ai * 128 + m * 16; const float rwt = lw[row];
#pragma unroll
                for (int bj = 0; bj < 2; ++bj) { const f32x4 v0 = acc[ai][bj][m][0] * rwt, v1 = acc[ai][bj][m][1] * rwt;
                    u32x4 w; w.x = cvt_pk_bf16(v0[0], v0[1]); w.y = cvt_pk_bf16(v0[2], v0[3]); w.z = cvt_pk_bf16(v1[0], v1[1]); w.w = cvt_pk_bf16(v1[2], v1[3]);
                    *(u32x4*)(base + (size_t)row * 1024 + bj * 128) = w; } }
    }
};
__device__ __forceinline__ void p13_final(Frame& F) {
    moe_layout(F);
    const LAS int* tab = (const LAS int*)(F.lds + LDS_TAB);
    const float* modv = wsp<float>(F, WS_MODV); const int* rpos = (const int*)(F.ws + WS_ROUTE + RT_POS); const int* rexp = (const int*)(F.ws + WS_ROUTE + RT_EXP); const bf16* Y = wsp<bf16>(F, WS_YROWS);
    const int gw = F.bid * NW + F.wave, NGW = F.G * NW;
    for (int m = gw; m < M_LAT; m += NGW) {
        float* row = F.out + (size_t)m * D; const float* gt = modv + (m >> 13) * 6144 + 5120;
        const bf16* y0 = Y + (size_t)(tab[rexp[2 * m]] + rpos[2 * m]) * 1024; const bf16* y1 = Y + (size_t)(tab[rexp[2 * m + 1]] + rpos[2 * m + 1]) * 1024;
        f32x4 v[4]; float s = 0.f;
#pragma unroll
        for (int j = 0; j < 4; ++j) { const int c = 4 * F.lane + 256 * j; const u32x2 a = *(const u32x2*)(y0 + c), b = *(const u32x2*)(y1 + c); const f32x4 g = *(const f32x4*)(gt + c);
            f32x4 yy; yy.x = bflo(a.x) + bflo(b.x); yy.y = bfhi(a.x) + bfhi(b.x); yy.z = bflo(a.y) + bflo(b.y); yy.w = bfhi(a.y) + bfhi(b.y);
            v[j] = *(const f32x4*)(row + c) + g * yy; s += (v[j].x * v[j].x + v[j].y * v[j].y) + (v[j].z * v[j].z + v[j].w * v[j].w); }
        const float rstd = 1.f / sqrtf(wave_sum(s) * (1.f / D) + EPS);
#pragma unroll
        for (int j = 0; j < 4; ++j) { const int c = 4 * F.lane + 256 * j; *(f32x4*)(row + c) = (v[j] * rstd) * *(const f32x4*)(F.g_final + c); }
    }
}

typedef const Args __attribute__((address_space(4))) * KArgsP;
__device__ __forceinline__ void load_inputs(Frame& F) {
    KArgsP ap = (KArgsP)__builtin_amdgcn_kernarg_segment_ptr();
    asm volatile("" : "+s"(ap));
    F.x = ap->in[0]; F.c = ap->in[1]; F.ctx = ap->in[2]; F.c_ctx = ap->in[3]; F.w_mod = ap->in[4]; F.b_mod = ap->in[5]; F.g_norm1 = ap->in[6]; F.w_in = ap->in[7];
    F.ml_conv = ap->in[8]; F.ml_conv_b = ap->in[9]; F.b_mgate = ap->in[10]; F.ml_norm = ap->in[11]; F.gla_w2 = ap->in[12]; F.gla_b2 = ap->in[13]; F.gla_norm = ap->in[14];
    F.w_proj_m = ap->in[15]; F.w_proj_g = ap->in[16]; F.w_out = ap->in[17]; F.g_norm2 = ap->in[18]; F.w_grp = ap->in[19]; F.b_grp = ap->in[20]; F.w_rexp = ap->in[21]; F.b_rexp = ap->in[22];
    F.w_up = ap->in[23]; F.w_down = ap->in[24]; F.g_final = ap->in[25];
    F.ws = ap->ws; F.out = ap->out;
    int ln = (int)__builtin_amdgcn_mbcnt_hi(~0u, __builtin_amdgcn_mbcnt_lo(~0u, 0u)); asm volatile("" : "+v"(ln)); F.lane = ln; F.tid = F.wave * 64 + ln;
}
constexpr int N_PHASES = 14;
__global__ void __launch_bounds__(NTHR, 2) mk_fwd(Args args) {
    extern __shared__ __attribute__((aligned(16))) unsigned char lds[];
    Frame F;
    F.lds = (LAS unsigned char*)lds; F.MISC = (volatile LAS unsigned*)(F.lds + MISC_OFF);
    F.tid = threadIdx.x; F.lane = F.tid & 63; F.wave = __builtin_amdgcn_readfirstlane(F.tid >> 6); F.G = gridDim.x; F.bid = blockIdx.x;
    F.ws = args.ws; F.out = args.out;
    for (int u = F.tid; u < (LDS_BYTES - LDSCTL_OFF) / 4; u += NTHR) ((LAS unsigned*)(F.lds + LDSCTL_OFF))[u] = 0u;
    __syncthreads();
    const int lo = args.ph_lo, hi = args.ph_hi;
    XcdBarrier bar; bar.bar = (unsigned*)(F.ws + WS_CTL) + CW_BAR; bar.x = 0; bar.st = nullptr;
    if (hi - lo > 1) bar = xcd_barrier_post((unsigned*)(F.ws + WS_CTL) + CW_BAR, F.MISC + 8);
#ifndef PH_MASK
#define PH_MASK 0xFFFF
#endif
#define IN(k) (((PH_MASK >> (k)) & 1) && lo <= (k) && (k) < hi)
#define REPS(k) for (int rep_ = 0; rep_ < (((REP_MASK >> (k)) & 1) ? 2 : 1); ++rep_)
#define SEAM(k) do { if (IN(k) && IN((k) + 1)) xcd_barrier(bar, F.tid); } while (0)
    const int vc = (int)blockIdx.x;
#ifdef PROBE_SEL
    unsigned long long pt0_ = 0, pdur_ = 0;
#define PH_BEGIN(k) do { if ((k) == PROBE_SEL % 20) pt0_ = __builtin_amdgcn_s_memrealtime(); if (F.tid == 0) { F.MISC[64] = ((k) == PROBE_SEL % 20) ? 1u : 0u; if ((k) == 0) F.MISC[65] = 0u; } } while (0)
#define PH_END(k) do { if ((k) == PROBE_SEL % 20) pdur_ = __builtin_amdgcn_s_memrealtime() - pt0_; } while (0)
#else
#define PH_BEGIN(k) do { } while (0)
#define PH_END(k) do { } while (0)
#endif
    if (IN(0)) REPS(0) { load_inputs(F); PH_BEGIN(0); p0_prologue(F); SEAM(0); PH_END(0); }
    if (IN(1)) REPS(1) { load_inputs(F); PH_BEGIN(1); { PMARK0(43) p1_hx(F); PMARK1(43) } { PMARK0(44) p0_weight_copies<0>(F); PMARK1(44) } { PMARK0(45) SEAM(1); PMARK1(45) } PH_END(1); }
    if (IN(2)) REPS(2) { load_inputs(F); PH_BEGIN(2); pg8::DenseSched S; S.init(wsp<bf16>(F, WS_HX), wsp<bf16>(F, WS_WA), MT, NA, D, F.G, vc); EpiProjA E{F.ws, F.b_mgate};
        pg8::gemm_phase<EpiProjA, pg8::DenseSched, true>(F.lds, S, E, F.wave); p0_weight_copies<1>(F, F.G == 256 ? (MT / 256) * (NA / 256) % 256 : 0); SEAM(2); PH_END(2); }
    if (IN(3)) REPS(3) { load_inputs(F); PH_BEGIN(3); { PMARK0(53) p3_prep(F); PMARK1(53) } { PMARK0(49) SEAM(3); PMARK1(49) } PH_END(3); }
#if SCAN_SCALAR
    if (IN(4)) REPS(4) { load_inputs(F); PH_BEGIN(4); p4_scan_local(F); SEAM(4); PH_END(4); }
    if (IN(5)) REPS(5) { load_inputs(F); PH_BEGIN(5); p5_scan_out(F); SEAM(5); PH_END(5); }
#else
    if (IN(4)) REPS(4) { load_inputs(F); PH_BEGIN(4); p4m_scan_local(F); SEAM(4); PH_END(4); }
    if (IN(5)) REPS(5) { load_inputs(F); PH_BEGIN(5); p5m_scan_out(F); SEAM(5); PH_END(5); }
#endif
    if (IN(6)) REPS(6) { load_inputs(F); PH_BEGIN(6); pg8::DenseSched S; S.init(wsp<bf16>(F, WS_HX), wsp<bf16>(F, WS_WB), M_LAT, NB, D, F.G, vc); EpiProjB E{F.ws, F.ml_norm, F.gla_norm};
        pg8::gemm_phase<EpiProjB, pg8::DenseSched, true>(F.lds, S, E, F.wave); SEAM(6); PH_END(6); }
    if (IN(7)) REPS(7) { load_inputs(F); PH_BEGIN(7);
        { pg8::DenseSched S; S.init(wsp<bf16>(F, WS_QKM), wsp<bf16>(F, WS_WPM), M_LAT, D, D, F.G, vc); EpiGate<0> E{F.ws}; pg8::gemm_phase<EpiGate<0>, pg8::DenseSched, false>(F.lds, S, E, F.wave); }
        VM_WAIT(); __syncthreads();
        { pg8::DenseSched S; S.init(wsp<bf16>(F, WS_QKG), wsp<bf16>(F, WS_WPG), M_LAT, D, D, F.G, vc); EpiGate<1> E{F.ws}; pg8::gemm_phase<EpiGate<1>, pg8::DenseSched, false>(F.lds, S, E, F.wave); }
        SEAM(7); PH_END(7); }
    if (IN(8)) REPS(8) { load_inputs(F); PH_BEGIN(8); pg8::DenseSched S; S.init(wsp<bf16>(F, WS_VM), wsp<bf16>(F, WS_WOUT), M_LAT, D, D, F.G, vc); EpiOut E{F.x, F.out, wsp<float>(F, WS_MODV)};
        pg8::gemm_phase<EpiOut, pg8::DenseSched, false>(F.lds, S, E, F.wave); SEAM(8); PH_END(8); }
    if (IN(9)) REPS(9) { load_inputs(F); PH_BEGIN(9); p9_route(F); if (IN(9) && IN(11)) xcd_barrier(bar, F.tid); PH_END(9); }
    if (IN(11)) REPS(11) { load_inputs(F); PH_BEGIN(11); moe_layout(F); pg8::GroupSched<true> S; S.A = wsp<bf16>(F, WS_H2); S.Bt = wsp<bf16>(F, WS_WUP); S.list_tok = wsp<int>(F, WS_LTOK); S.tab = (const LAS int*)(F.lds + LDS_TAB);
        S.K = 1024; S.ntiles = S.tab[17]; S.G = F.G; S.c = vc; EpiUp E{F.ws};
        pg8::gemm_phase<EpiUp, pg8::GroupSched<true>, true>(F.lds, S, E, F.wave); moe_weight_copies<1>(F, F.G == 256 ? (S.ntiles * 4) % 256 : 0); SEAM(11); PH_END(11); }
    if (IN(12)) REPS(12) { load_inputs(F); PH_BEGIN(12); moe_layout(F); pg8::GroupSched<false> S; S.A = wsp<bf16>(F, WS_HID); S.Bt = wsp<bf16>(F, WS_WDN); S.list_tok = nullptr; S.tab = (const LAS int*)(F.lds + LDS_TAB);
        S.K = 512; S.ntiles = S.tab[17]; S.G = F.G; S.c = vc; EpiDown E{F.ws, (const LAS int*)(F.lds + LDS_TAB)};
        pg8::gemm_phase<EpiDown, pg8::GroupSched<false>, true>(F.lds, S, E, F.wave); SEAM(12); PH_END(12); }
    if (IN(13)) REPS(13) { load_inputs(F); PH_BEGIN(13); p13_final(F); PH_END(13); }
#ifdef PROBE_SEL
    if (F.bid == PROBE_WG && F.tid == 0) { const unsigned long long d_ = PROBE_SEL < 20 ? pdur_ : (unsigned long long)F.MISC[65]; const unsigned long long te_ = __builtin_amdgcn_s_memrealtime() + 4ull * d_;
        while (__builtin_amdgcn_s_memrealtime() < te_) __builtin_amdgcn_s_sleep(8); }
#endif
#undef IN
#undef SEAM
}

extern "C" void kernel_launch(void* const* d_in, const int* in_sizes, int n_in, void* d_out, int out_size, void* d_ws, size_t ws_size, hipStream_t stream) {
    static int grid = 0;
    if (grid == 0) {
        if (n_in != 26 || out_size != M_LAT * D || ws_size < WS_END) { fprintf(stderr, "kernel_launch: unexpected shapes (n_in %d, out %d, ws %zu)\n", n_in, out_size, ws_size); grid = -1; return; }
        int dev = 0, cus = 0, per_cu = 0;
        if (hipGetDevice(&dev) != hipSuccess || hipDeviceGetAttribute(&cus, hipDeviceAttributeMultiprocessorCount, dev) != hipSuccess) { grid = -1; return; }
        if (hipFuncSetAttribute((const void*)mk_fwd, hipFuncAttributeMaxDynamicSharedMemorySize, LDS_BYTES) != hipSuccess) { fprintf(stderr, "kernel_launch: hipFuncSetAttribute failed\n"); grid = -1; return; }
        if (hipOccupancyMaxActiveBlocksPerMultiprocessor(&per_cu, (const void*)mk_fwd, NTHR, LDS_BYTES) != hipSuccess || per_cu < 1) fprintf(stderr, "kernel_launch: occupancy query reports %d\n", per_cu);
        (void)hipGetLastError();
        grid = cus;
    }
    if (grid < 0) return;
    (void)hipMemsetAsync((char*)d_ws + WS_CTL, 0, CTL_ZERO_BYTES, stream);
    Args a{};
    for (int i = 0; i < 26; ++i) a.in[i] = (const float*)d_in[i];
    a.out = (float*)d_out; a.ws = (unsigned char*)d_ws;
#if MK_ONE_LAUNCH
    a.ph_lo = 0; a.ph_hi = N_PHASES;
    hipLaunchKernelGGL(mk_fwd, dim3(grid), dim3(NTHR), LDS_BYTES, stream, a);
#else
    for (int p = 0; p < N_PHASES; ++p) { a.ph_lo = p; a.ph_hi = p + 1; hipLaunchKernelGGL(mk_fwd, dim3(grid), dim3(NTHR), LDS_BYTES, stream, a); }
#endif
}
```

```cpp
#include <hip/hip_runtime.h>
#include <cstdio>
#include <cstdint>

#ifndef SCAN_SCALAR
#define SCAN_SCALAR 0
#endif
#ifndef REP_MASK
#define REP_MASK 0x0
#endif
#ifndef MK_ONE_LAUNCH
#define MK_ONE_LAUNCH 1
#endif

#define LAS __attribute__((address_space(3)))
typedef unsigned short bf16;
typedef short bf16x8 __attribute__((ext_vector_type(8)));
typedef float f32x4 __attribute__((ext_vector_type(4)));
typedef float f32x2 __attribute__((ext_vector_type(2)));
typedef unsigned u32x4 __attribute__((ext_vector_type(4)));
typedef unsigned u32x2 __attribute__((ext_vector_type(2)));

constexpr int D = 1024, BATCH = 2, SEQ = 8192, CTXL = 256;
constexpr int M_LAT = BATCH * SEQ;
constexpr int M_CTX = BATCH * CTXL;
constexpr int MT = M_LAT + M_CTX;
constexpr int NW = 8, NTHR = 512;
constexpr int IN_W = 8240;
constexpr int NA = 4352;
constexpr int NB = 4096;
constexpr int CHUNK = 64, NCH_LAT = SEQ / CHUNK  , NCH_CTX = CTXL / CHUNK  ;
constexpr int NCHUNK = BATCH * NCH_LAT + BATCH * NCH_CTX;
constexpr int NSEG = 8, CPS = NCH_LAT / NSEG;
constexpr int NEXP = 16, DEXP = 512, NROWS_MAX = 36864  ;
constexpr float EPS = 1e-6f;

constexpr size_t MiB = 1u << 20;
constexpr size_t BIG = (size_t)MT * 1024 * 2;
constexpr size_t WS_CTL = 0, CTL_ZERO_BYTES = 1 * MiB;
constexpr size_t WS_MODV = 1 * MiB;
constexpr size_t WS_AB = 2 * MiB;
constexpr size_t WS_GENDM = WS_AB + 1088 * 1024;
constexpr size_t WS_GENDG = 4 * MiB;
constexpr size_t WS_SSQ = WS_GENDG + 1088 * 1024;
constexpr size_t WS_WA = 7 * MiB;
constexpr size_t WS_WB = 16 * MiB;
constexpr size_t WS_WPM = 24 * MiB, WS_WPG = 26 * MiB, WS_WOUT = 28 * MiB;
constexpr size_t WS_GATES = 30 * MiB;
constexpr size_t WS_NST = 35 * MiB;
constexpr size_t WS_GSEG = WS_NST + 256 * 1024;
constexpr size_t WS_ROUTE = 36 * MiB;
constexpr size_t WS_HX = 37 * MiB;
constexpr size_t WS_QKM = WS_HX + BIG;
constexpr size_t WS_VM = WS_QKM + BIG;
constexpr size_t WS_QKG = WS_VM + BIG;
constexpr size_t WS_VG = WS_QKG + BIG;
constexpr size_t WS_QKMC = WS_VG + BIG;
constexpr size_t WS_STATE = WS_QKMC + BIG;
constexpr size_t WS_QKGTC = WS_STATE + 16 * MiB;
constexpr size_t WS_END = WS_QKGTC + 2 * MiB;
static_assert(WS_END <= 256 * MiB, "ws map");
constexpr size_t WS_WUP = WS_HX;
constexpr size_t WS_H2 = 70 * MiB;
constexpr size_t WS_WDN = 103 * MiB;
constexpr size_t WS_HID = 136 * MiB;
constexpr size_t WS_YROWS = 172 * MiB;
constexpr size_t RT_EXP = 0;
constexpr size_t RT_W = 128 * 1024;
constexpr size_t RT_POS = 256 * 1024;
constexpr size_t RT_ROWTOK = 384 * 1024;
constexpr size_t RT_ROWW = 384 * 1024 + 144 * 1024;
constexpr size_t RT_TILE_E = 384 * 1024 + 288 * 1024;
constexpr size_t WS_LTOK = 120 * MiB, WS_LW = 122 * MiB;
constexpr int LCAP = 32768;
constexpr int LDS_TAB = 147456 - 1024 + 768;
constexpr int CW_BAR = 4096;
constexpr int CW_CNT = 8192;

#ifdef PROBE_SEL
#ifndef PROBE_WG
#define PROBE_WG 0
#endif
#define PMARK0(id) unsigned long long pm0_##id = 0; if (PROBE_SEL == (id)) pm0_##id = __builtin_amdgcn_s_memrealtime();
#define PMARK1(id) if (PROBE_SEL == (id) && F.tid == 0) F.MISC[65] += (unsigned)(__builtin_amdgcn_s_memrealtime() - pm0_##id);
#else
#define PMARK0(id)
#define PMARK1(id)
#endif
#define LDS_WAIT() asm volatile("s_waitcnt lgkmcnt(0)" ::: "memory")
#define VM_WAIT() asm volatile("s_waitcnt vmcnt(0)" ::: "memory")
__device__ __forceinline__ unsigned f2bf(float f) { unsigned u = __builtin_bit_cast(unsigned, f); return (u + 0x7fffu + ((u >> 16) & 1u)) >> 16; }
typedef __bf16 bf16x2_t __attribute__((ext_vector_type(2)));
__device__ __forceinline__ unsigned pkbf(float lo, float hi) { f32x2 v = {lo, hi}; return __builtin_bit_cast(unsigned, __builtin_convertvector(v, bf16x2_t)); }
__device__ __forceinline__ unsigned pk2(float lo, float hi) { return pkbf(lo, hi); }
__device__ __forceinline__ float bf2f(unsigned short h) { return __builtin_bit_cast(float, (unsigned)h << 16); }
__device__ __forceinline__ float bflo(unsigned w) { return __builtin_bit_cast(float, w << 16); }
__device__ __forceinline__ float bfhi(unsigned w) { return __builtin_bit_cast(float, w & 0xffff0000u); }
__device__ __forceinline__ float sigm(float x) { return __builtin_amdgcn_rcpf(1.f + __expf(-x)); }
__device__ __forceinline__ float siluf(float x) { return x * __builtin_amdgcn_rcpf(1.f + __expf(-x)); }
__device__ __forceinline__ float logsig(float x) { return fminf(x, 0.f) - log1pf(expf(-fabsf(x))); }
__device__ __forceinline__ float wave_sum(float v) {
#pragma unroll
    for (int o = 1; o < 64; o <<= 1) v += __shfl_xor(v, o);
    return v;
}

namespace pg8 {
#define PG8_LAS __attribute__((address_space(3)))
constexpr int BM = 256, BK = 64, HALF = 128, HTB = HALF * BK * 2, STAGE_BYTES = 8 * HTB, NXCD = 8, WGM = 8;
__host__ __device__ __forceinline__ int lds_byte(int r, int c) { const int st = (r >> 4) * 2 + (c >> 5), rr = r & 15, cc = c & 31, ob = rr * 64 + cc * 2; return st * 1024 + (ob ^ (((ob >> 9) & 1) << 5)); }
__host__ __device__ __forceinline__ void stage_rc(int b, int& R, int& C) { const int st = b / 1024, sb = b % 1024, swz = sb ^ (((sb >> 9) & 1) << 5); R = (st >> 1) * 16 + swz / 64; C = (st & 1) * 32 + (swz % 64) / 2; }
__host__ __device__ __forceinline__ int perm32(int rho) { const int n = rho >> 4, i = rho & 15; return 8 * (i >> 2) + 4 * n + (i & 3); }
struct Unit { int pm, pn, e; };
__device__ __forceinline__ unsigned cvt_pk_bf16(float lo, float hi) { return pkbf(lo, hi); }

struct DenseSched {
    static constexpr bool GATHER = false;
    const bf16* A; const bf16* Bt; int K, nM, nN, nwg, G, c;
    __device__ void init(const bf16* A_, const bf16* Bt_, int M, int N, int K_, int G_, int c_) { A = A_; Bt = Bt_; K = K_; nM = M / BM; nN = N / BM; nwg = nM * nN; G = G_; c = c_; }
    __device__ bool next(int i, Unit& u) const {
        const long L = (long)i * G + c; if (L >= nwg) return false;
        int wgid = (int)L; { const int q = nwg / NXCD, r = nwg % NXCD, xcd = wgid % NXCD, off = wgid / NXCD; wgid = (xcd < r ? xcd * (q + 1) : r * (q + 1) + (xcd - r) * q) + off; }
        const int nig = WGM * nN, gid = wgid / nig, fm = gid * WGM, gsz = (nM - fm) < WGM ? (nM - fm) : WGM;
        u.pm = fm + ((wgid % nig) % gsz); u.pn = (wgid % nig) / gsz; u.e = 0; return true;
    }
    __device__ __forceinline__ const char* a_base(const Unit& u) const { return (const char*)A + (size_t)u.pm * BM * K * 2; }
    __device__ __forceinline__ const char* b_base(const Unit& u) const { return (const char*)Bt + (size_t)u.pn * BM * K * 2; }
    __device__ __forceinline__ void a_offs(const Unit&, const int (&R)[2], const int (&C)[2], unsigned (&o)[2][2]) const {
#pragma unroll
        for (int h = 0; h < 2; ++h)
#pragma unroll
            for (int i = 0; i < 2; ++i) o[h][i] = (unsigned)((h * HALF + R[i]) * K + C[i]) * 2u;
    }
};
template <bool GATHER_> struct GroupSched {
    static constexpr bool GATHER = GATHER_;
    const bf16* A; const bf16* Bt; const int* list_tok; const PG8_LAS int* tab; int K, ntiles, G, c;
    __device__ bool next(int i, Unit& u) const {
        long L = (long)i * G + c;
        if (G == 256 && (long)(i + 1) * 256 <= (long)ntiles * 4) { const int xc = c & 7, j = c >> 3; L = (long)i * 256 + (long)(((xc << 3) | (j >> 2)) << 2) + (j & 3); }
        if (L >= (long)ntiles * 4) return false;
        u.pm = (int)(L >> 2); u.pn = (int)(L & 3); int e = 0; while (e < 15 && u.pm * BM >= tab[e + 1]) ++e; u.e = e; return true;
    }
    __device__ __forceinline__ const char* a_base(const Unit& u) const { return GATHER ? (const char*)A : (const char*)A + (size_t)u.pm * BM * K * 2; }
    __device__ __forceinline__ const char* b_base(const Unit& u) const { return (const char*)Bt + ((size_t)u.e * 1024 + (size_t)u.pn * BM) * K * 2; }
    __device__ __forceinline__ void a_offs(const Unit& u, const int (&R)[2], const int (&C)[2], unsigned (&o)[2][2]) const {
        const int pos0 = u.pm * BM - tab[u.e], cnt = tab[32 + u.e];
#pragma unroll
        for (int h = 0; h < 2; ++h)
#pragma unroll
            for (int i = 0; i < 2; ++i) {
                int row = h * HALF + R[i];
                if (GATHER) { const int pos = pos0 + row; const int pc = pos < cnt ? pos : 0; const int tk = list_tok[u.e * 32768 + pc]; row = pos < cnt ? tk : 0; }
                o[h][i] = (unsigned)(row * K + C[i]) * 2u; }
    }
};

template <class Epi, class Sched, bool ALIGN_EPI>
__device__ __forceinline__ void gemm_phase(PG8_LAS unsigned char* lds, const Sched& S, const Epi& E, const int wave_id) {
    int ln_ = (int)__builtin_amdgcn_mbcnt_hi(~0u, __builtin_amdgcn_mbcnt_lo(~0u, 0u)); asm volatile("" : "+v"(ln_));
    const int wid = wave_id, lane = ln_, tid = wid * 64 + lane, wr = wid >> 2, wc = wid & 3, fr = lane & 15, fq = lane >> 4;
    const int K = S.K, nt = K / BK;
    int Rr[2], Cc[2]; unsigned voffB[2];
#pragma unroll
    for (int i = 0; i < 2; ++i) { stage_rc(tid * 16 + i * 8192, Rr[i], Cc[i]); const int Rb = (Rr[i] & ~31) + perm32(Rr[i] & 31); voffB[i] = (unsigned)(Rb * K + Cc[i]) * 2u; }
    const size_t kstep = (size_t)(BK * 2);
    const size_t hstep = (size_t)HALF * K * 2;
    const unsigned ldsw = (unsigned)wid * 1024u;
    const int aoff = lds_byte(wr * 64 + fr, fq * 8), boff = lds_byte(wc * 32 + fr, fq * 8);
#define PG8_SA(b, h) (((b) * 2 + (h)) * HTB)
#define PG8_SB(b, h) ((4 + (b) * 2 + (h)) * HTB)
#define PG8_STAGE(bufoff, gbase, voff) do { _Pragma("unroll") for (int _i = 0; _i < 2; ++_i) \
        __builtin_amdgcn_global_load_lds((const unsigned*)((const char*)(gbase) + (voff)[_i]), (PG8_LAS unsigned*)(lds + (bufoff) + ldsw + _i * 8192), 16, 0, 0); } while (0)
#define PG8_LDA(dst, b, h) do { _Pragma("unroll") for (int m = 0; m < 4; ++m) _Pragma("unroll") for (int k = 0; k < 2; ++k) dst[m][k] = *(const PG8_LAS bf16x8*)(lds + PG8_SA(b, h) + aoff + m * 2048 + k * 1024); } while (0)
#define PG8_LDB(dst, b, h) do { _Pragma("unroll") for (int n = 0; n < 2; ++n) _Pragma("unroll") for (int k = 0; k < 2; ++k) dst[n][k] = *(const PG8_LAS bf16x8*)(lds + PG8_SB(b, h) + boff + n * 2048 + k * 1024); } while (0)
#define PG8_MMA(ai, bj, At, Bt) do { __builtin_amdgcn_s_setprio(1); _Pragma("unroll") for (int m = 0; m < 4; ++m) _Pragma("unroll") for (int n = 0; n < 2; ++n) _Pragma("unroll") for (int k = 0; k < 2; ++k) \
        acc[ai][bj][m][n] = __builtin_amdgcn_mfma_f32_16x16x32_bf16(Bt[n][k], At[m][k], acc[ai][bj][m][n], 0, 0, 0); __builtin_amdgcn_s_setprio(0); } while (0)
#define PG8_WAIT_V(n) asm volatile("s_waitcnt vmcnt(" #n ")" ::: "memory")
#define PG8_WAIT_L(n) asm volatile("s_waitcnt lgkmcnt(" #n ")" ::: "memory")
#define PG8_BAR __builtin_amdgcn_s_barrier()
#define PG8_SCHED __builtin_amdgcn_sched_barrier(0)
    Unit cur, nxt; int ui = 0;
    if (!S.next(0, cur)) return;
    unsigned ao[2][2], nao[2][2];
    S.a_offs(cur, Rr, Cc, ao);
    f32x4 acc[2][2][4][2];
#pragma unroll
    for (int a = 0; a < 2; ++a)
#pragma unroll
        for (int b = 0; b < 2; ++b)
#pragma unroll
            for (int m = 0; m < 4; ++m)
#pragma unroll
                for (int n = 0; n < 2; ++n) acc[a][b][m][n] = (f32x4){0.f, 0.f, 0.f, 0.f};
    bf16x8 At[4][2], B0[2][2], B1[2][2];
    const char* cA = S.a_base(cur); const char* cB = S.b_base(cur);
    PG8_STAGE(PG8_SB(0, 0), cB, voffB); PG8_STAGE(PG8_SB(0, 1), cB + hstep, voffB); PG8_STAGE(PG8_SA(0, 0), cA, ao[0]); PG8_STAGE(PG8_SA(0, 1), cA, ao[1]);
    if (wr == 1) PG8_BAR;
    PG8_WAIT_V(2); PG8_BAR;
    PG8_STAGE(PG8_SB(1, 0), cB + kstep, voffB); PG8_STAGE(PG8_SA(1, 0), cA + kstep, ao[0]); PG8_STAGE(PG8_SB(1, 1), cB + hstep + kstep, voffB);
    PG8_WAIT_V(6); PG8_BAR;
    for (;;) {
        const bool has_next = S.next(ui + 1, nxt);
        if (Sched::GATHER && has_next) S.a_offs(nxt, Rr, Cc, nao);
        else {
#pragma unroll
            for (int h = 0; h < 2; ++h)
#pragma unroll
                for (int i = 0; i < 2; ++i) nao[h][i] = ao[h][i]; }
        const char* nA = has_next ? S.a_base(nxt) : cA; const char* nB = has_next ? S.b_base(nxt) : cB;
        for (int t = 0; t < nt; t += 2) {
            const bool last = (t == nt - 2);
            const char* a1 = cA + (size_t)(t + 1) * kstep;
            const char* a2 = last ? nA : cA + (size_t)(t + 2) * kstep; const char* b2 = last ? nB : cB + (size_t)(t + 2) * kstep;
            const char* a3 = a2 + kstep; const char* b3 = b2 + kstep;
            unsigned o2[2][2];
#pragma unroll
            for (int h = 0; h < 2; ++h)
#pragma unroll
                for (int i = 0; i < 2; ++i) o2[h][i] = (Sched::GATHER && last) ? nao[h][i] : ao[h][i];
            PG8_LDB(B0, 0, 0); PG8_LDB(B1, 0, 1); PG8_SCHED; PG8_LDA(At, 0, 0); PG8_STAGE(PG8_SA(1, 1), a1, ao[1]);
            PG8_WAIT_V(8); PG8_WAIT_L(0); PG8_BAR; PG8_MMA(0, 0, At, B0); PG8_MMA(0, 1, At, B1); PG8_BAR; PG8_SCHED;
            PG8_LDA(At, 0, 1); PG8_STAGE(PG8_SB(0, 0), b2, voffB); PG8_STAGE(PG8_SB(0, 1), b2 + hstep, voffB); PG8_STAGE(PG8_SA(0, 0), a2, o2[0]);
            PG8_WAIT_V(8); PG8_WAIT_L(0); PG8_BAR; PG8_MMA(1, 0, At, B0); PG8_MMA(1, 1, At, B1); PG8_BAR; PG8_SCHED;
            PG8_LDB(B0, 1, 0); PG8_LDB(B1, 1, 1); PG8_SCHED; PG8_LDA(At, 1, 0); PG8_STAGE(PG8_SA(0, 1), a2, o2[1]);
            PG8_WAIT_V(8); PG8_WAIT_L(0); PG8_BAR; PG8_MMA(0, 0, At, B0); PG8_MMA(0, 1, At, B1); PG8_BAR; PG8_SCHED;
            PG8_LDA(At, 1, 1); PG8_STAGE(PG8_SB(1, 0), b3, voffB); PG8_STAGE(PG8_SB(1, 1), b3 + hstep, voffB); PG8_STAGE(PG8_SA(1, 0), a3, o2[0]);
            PG8_WAIT_V(8); PG8_WAIT_L(0); PG8_BAR; PG8_MMA(1, 0, At, B0); PG8_MMA(1, 1, At, B1); PG8_BAR; PG8_SCHED;
        }
        if constexpr (ALIGN_EPI) { if (wr == 0) PG8_BAR; }
#ifdef PROBE_SEL
        const unsigned long long pe0_ = __builtin_amdgcn_s_memrealtime();
#endif
        { int fr_ = fr, fq_ = fq; asm volatile("" : "+v"(fr_), "+v"(fq_));
          E(acc, cur, wr, wc, fr_, fq_); }
#ifdef PROBE_SEL
        { const unsigned long long pe1_ = __builtin_amdgcn_s_memrealtime(); volatile PG8_LAS unsigned* M_ = (volatile PG8_LAS unsigned*)(lds + 147456 - 1024 + 320); if (tid == 0 && M_[64] && PROBE_SEL < 40) M_[65] += (unsigned)(pe1_ - pe0_); }
#endif
        if (!has_next) break;
#pragma unroll
        for (int a = 0; a < 2; ++a)
#pragma unroll
            for (int b = 0; b < 2; ++b)
#pragma unroll
                for (int m = 0; m < 4; ++m)
#pragma unroll
                    for (int n = 0; n < 2; ++n) acc[a][b][m][n] = (f32x4){0.f, 0.f, 0.f, 0.f};
        cur = nxt; cA = nA; cB = nB; ++ui;
#pragma unroll
        for (int h = 0; h < 2; ++h)
#pragma unroll
            for (int i = 0; i < 2; ++i) ao[h][i] = nao[h][i];
        if constexpr (ALIGN_EPI) { if (wr == 1) PG8_BAR; }
    }
    PG8_WAIT_V(0);
    if constexpr (!ALIGN_EPI) { if (wr == 0) PG8_BAR; }
    PG8_BAR;
#undef PG8_SA
#undef PG8_SB
#undef PG8_STAGE
#undef PG8_LDA
#undef PG8_LDB
#undef PG8_MMA
#undef PG8_WAIT_V
#undef PG8_WAIT_L
#undef PG8_BAR
#undef PG8_SCHED
}
}
using pg8::Unit; using pg8::cvt_pk_bf16;

#define XB_TMO      128
#define XB_XCNT(j)  (256  + 64 * (j))
#define XB_XSUB(j)  (1280 + 64 * (j))
#define XB_XGEN(j)  (2304 + 64 * (j))
#define XB_TOP      3328
#define XB_TOPGEN   3392
#define XCD_BAR_WORDS 3456
#define XB_SPIN_CAP (1u << 18)
__device__ __forceinline__ unsigned xb_ld(unsigned* p)              { return __hip_atomic_load(p, __ATOMIC_RELAXED, __HIP_MEMORY_SCOPE_AGENT); }
__device__ __forceinline__ unsigned xb_add(unsigned* p, unsigned v) { return __hip_atomic_fetch_add(p, v, __ATOMIC_RELAXED, __HIP_MEMORY_SCOPE_AGENT); }
__device__ __forceinline__ unsigned xb_xcc_id() { return (unsigned)__builtin_amdgcn_s_getreg((3 << 11) | 20) & 0xFu; }
#define XB_SPIN(cond, bar) do { unsigned _sp = 0; while (cond) { __builtin_amdgcn_s_sleep(1); \
    if ((++_sp & 255u) == 0u) { if (xb_ld(&(bar)[XB_TMO])) break; if (_sp > XB_SPIN_CAP) { atomicAdd(&(bar)[XB_TMO], 1u); break; } } } } while (0)
struct XcdBarrier { unsigned* bar; unsigned x; volatile LAS unsigned* st; };
__device__ __forceinline__ XcdBarrier xcd_barrier_post(unsigned* bar, volatile LAS unsigned* st) {
    XcdBarrier b; b.bar = bar; b.x = xb_xcc_id(); b.st = st;
    if (threadIdx.x == 0) (void)xb_add(&bar[XB_XCNT(b.x)], 1u);
    return b;
}
__device__ __forceinline__ void xcd_barrier_complete(unsigned* bar, unsigned x, unsigned& nloc, unsigned& nx) {
    const unsigned G = gridDim.x * gridDim.y * gridDim.z;
    unsigned sum, cnt, mine, sp = 0u;
    for (;;) {
        sum = 0u; cnt = 0u; mine = 0u;
#pragma unroll
        for (unsigned j = 0; j < 16; ++j) { const unsigned c = xb_ld(&bar[XB_XCNT(j)]); sum += c; cnt += (c > 0u) ? 1u : 0u; mine = (j == x) ? c : mine; }
        if (sum == G) break;
        __builtin_amdgcn_s_sleep(1);
        if ((++sp & 255u) == 0u) { if (xb_ld(&bar[XB_TMO])) break; if (sp > XB_SPIN_CAP) { atomicAdd(&bar[XB_TMO], 1u); break; } }
    }
    nloc = mine > 0u ? mine : 1u; nx = cnt > 0u ? cnt : 1u;
}
__device__ __forceinline__ void xcd_barrier(const XcdBarrier& b, const int tid) {
    asm volatile("s_waitcnt vmcnt(0)" ::: "memory");
    __syncthreads();
    if (tid == 0) {
        unsigned* bar = b.bar;
        __builtin_amdgcn_s_waitcnt(0);
        unsigned nloc = b.st[0], nx = b.st[1];
        if (nloc == 0u) { xcd_barrier_complete(bar, b.x, nloc, nx); b.st[0] = nloc; b.st[1] = nx; }
        const unsigned old = xb_add(&bar[XB_XSUB(b.x)], 1u);
        const unsigned gen = old / nloc;
        if (old + 1u == (gen + 1u) * nloc) {
            __builtin_amdgcn_fence(__ATOMIC_RELEASE, "agent");
            asm volatile("s_waitcnt vmcnt(0)" ::: "memory");
            const unsigned og = xb_add(&bar[XB_TOP], 1u);
            const unsigned tg = og / nx;
            if (og + 1u == (tg + 1u) * nx) xb_add(&bar[XB_TOPGEN], 1u);
            else XB_SPIN(xb_ld(&bar[XB_TOPGEN]) == tg, bar);
            __builtin_amdgcn_fence(__ATOMIC_ACQUIRE, "agent");
            xb_add(&bar[XB_XGEN(b.x)], 1u);
            asm volatile("s_waitcnt vmcnt(0)" ::: "memory");
        } else {
            XB_SPIN(xb_ld(&bar[XB_XGEN(b.x)]) == gen, bar);
            __builtin_amdgcn_fence(__ATOMIC_ACQUIRE, "agent");
            asm volatile("s_waitcnt vmcnt(0)" ::: "memory");
        }
    }
    __syncthreads();
}

constexpr int RING_BYTES = 131072;
constexpr int LDS_BYTES = 147456;
constexpr int LDSCTL_OFF = LDS_BYTES - 1024, MISC_OFF = LDSCTL_OFF + 320;

struct Args { const float* in[26]; float* out; unsigned char* ws; int ph_lo, ph_hi; };
struct Frame {
    LAS unsigned char* lds; volatile LAS unsigned* MISC;
    int tid, lane, wave, G, bid;
    unsigned char* ws; float* out;
    const float *x, *c, *ctx, *c_ctx, *w_mod, *b_mod, *g_norm1, *w_in, *ml_conv, *ml_conv_b, *b_mgate, *ml_norm, *gla_w2, *gla_b2, *gla_norm,
                *w_proj_m, *w_proj_g, *w_out, *g_norm2, *w_grp, *b_grp, *w_rexp, *b_rexp, *w_up, *w_down, *g_final;
};
template <class T> __device__ __forceinline__ T* wsp(const Frame& F, size_t off) { return (T*)(F.ws + off); }

struct TItem { const float* W; bf16* WT; int Nsrc, K, k0, n0, sc; };
__device__ __forceinline__ int map_a(int n) { return n < 2048 ? n : (n < 4096 ? n + 1040 : (n < 4112 ? 3072 + (n - 4096) : (n < 4144 ? 6160 + (n - 4112) : -1))); }
__device__ __forceinline__ int map_b(int n) { return n < 1024 ? 2048 + n : (n < 2048 ? 5136 + (n - 1024) : (n < 3072 ? 6192 + (n - 2048) : 7216 + (n - 3072))); }
__device__ __forceinline__ int map_up(int n) { const int pn = n >> 8, j = n & 255; return j < 128 ? 128 * pn + j : 512 + 128 * pn + (j - 128); }
__device__ __forceinline__ void titem_load(const TItem& t, int lane, f32x4 (&v)[8]) {
    const int scc = t.sc < 0 ? 0 : t.sc;
#pragma unroll
    for (int r = 0; r < 8; ++r) v[r] = *(const f32x4*)(t.W + (size_t)(t.k0 + 8 * r + (lane >> 3)) * t.Nsrc + scc);
}
__device__ __forceinline__ void titem_store(const TItem& t, int lane, const f32x4 (&v)[8], LAS float* scr) {
    const float z = t.sc < 0 ? 0.f : 1.f;
#pragma unroll
    for (int r = 0; r < 8; ++r) { const int kk = 8 * r + (lane >> 3); LAS float* d = scr + kk * 33 + 4 * (lane & 7); d[0] = v[r][0] * z; d[1] = v[r][1] * z; d[2] = v[r][2] * z; d[3] = v[r][3] * z; }
    LDS_WAIT(); asm volatile("" ::: "memory");
    const int c = lane & 7;
#pragma unroll
    for (int j = 0; j < 4; ++j) { const int n = (lane >> 3) + 8 * j; const LAS float* s = scr + (8 * c) * 33 + n;
        u32x4 o; o.x = pk2(s[0 * 33], s[1 * 33]); o.y = pk2(s[2 * 33], s[3 * 33]); o.z = pk2(s[4 * 33], s[5 * 33]); o.w = pk2(s[6 * 33], s[7 * 33]);
        *(u32x4*)(t.WT + (size_t)(t.n0 + n) * t.K + t.k0 + 8 * c) = o; }
    LDS_WAIT(); asm volatile("" ::: "memory");
}
template <class Dec>
__device__ __forceinline__ void run_transposes(Frame& F, int nitems, Dec dec, const int skip = 0) {
    LAS float* scr = (LAS float*)(F.lds + F.wave * 16384);
    if (F.bid < skip) return;
    const int gw = (F.bid - skip) * NW + F.wave, NGW = (F.G - skip) * NW, last = nitems - 1;
    if (gw >= nitems) return;
    f32x4 va[8], vb[8]; TItem ia, ib;
    ia = dec(gw, F.lane); titem_load(ia, F.lane, va);
    for (int it = gw; it < nitems; it += 2 * NGW) {
        { const int j = it + NGW; ib = dec(j < last ? j : last, F.lane); titem_load(ib, F.lane, vb); }
        titem_store(ia, F.lane, va, scr);
        { const int j = it + 2 * NGW; ia = dec(j < last ? j : last, F.lane); titem_load(ia, F.lane, va); }
        if (it + NGW < nitems) titem_store(ib, F.lane, vb, scr);
    }
}
__device__ __forceinline__ void p0_prologue(Frame& F) {
    LAS float* scr = (LAS float*)(F.lds + F.wave * 16384);
    const int gw = F.bid * NW + F.wave, NGW = F.G * NW;
    if (F.bid < 192) {
        LAS float* red = (LAS float*)(F.lds);
        const int r = F.tid >> 3, c4 = F.tid & 7, col0 = F.bid * 32 + 4 * c4;
        f32x4 a0 = {0.f, 0.f, 0.f, 0.f}, a1 = a0, a2 = a0;
        for (int k = r; k < D; k += 64) {
            const f32x4 w = *(const f32x4*)(F.w_mod + (size_t)k * 6144 + col0);
            const float s0 = siluf(F.c[k]), s1 = siluf(F.c[D + k]), s2 = siluf(F.c_ctx[k]);
            a0 += w * s0; a1 += w * s1; a2 += w * s2; }
#pragma unroll
        for (int j = 0; j < 4; ++j) { red[r * 96 + 0 + 4 * c4 + j] = a0[j]; red[r * 96 + 32 + 4 * c4 + j] = a1[j]; red[r * 96 + 64 + 4 * c4 + j] = a2[j]; }
        __syncthreads();
        if (F.tid < 96) { float s = 0.f; for (int q = 0; q < 64; ++q) s += red[q * 96 + F.tid]; const int rr = F.tid >> 5, j = F.bid * 32 + (F.tid & 31);
            wsp<float>(F, WS_MODV)[rr * 6144 + j] = s + F.b_mod[j]; }
        __syncthreads();
    }
}
template <int PART>
__device__ __forceinline__ void p0_weight_copies(Frame& F, const int skip = 0) {
    constexpr int I_A = (NA / 32) * 16, I_B = (NB / 32) * 16, I_P = (1024 / 32) * 16;
    const float* w_in = F.w_in; const float* wpm = F.w_proj_m; const float* wpg = F.w_proj_g; const float* wo = F.w_out; unsigned char* ws = F.ws;
    run_transposes(F, PART == 0 ? I_A : I_B + 3 * I_P, [=](int it, int lane) {
        TItem t; t.K = D; const int r = PART == 0 ? it : it + I_A;
        const bool isA = r < I_A, isB = !isA && r < I_A + I_B; const int rp = r - I_A - I_B, pi = rp < 0 ? 0 : rp / I_P;
        const int rr = isA ? r : (isB ? r - I_A : rp - pi * I_P);
        t.k0 = 64 * (rr & 15); t.n0 = 32 * (rr >> 4); const int n = t.n0 + 4 * (lane & 7);
        t.W = (isA || isB) ? w_in : (pi == 0 ? wpm : (pi == 1 ? wpg : wo)); t.Nsrc = (isA || isB) ? IN_W : D;
        t.WT = (bf16*)(ws + (isA ? WS_WA : (isB ? WS_WB : (pi == 0 ? WS_WPM : (pi == 1 ? WS_WPG : WS_WOUT)))));
        t.sc = isA ? map_a(n) : (isB ? map_b(n) : n);
        return t; }, skip);
}
template <int PART>
__device__ __forceinline__ void moe_weight_copies(Frame& F, const int skip = 0) {
    constexpr int I_U = (1024 / 32) * 16  , I_D = (1024 / 32) * 8;
    const float* wup = F.w_up; const float* wdn = F.w_down; unsigned char* ws = F.ws;
    run_transposes(F, NEXP * (PART == 0 ? I_U : I_D), [=](int it, int lane) {
        TItem t; constexpr bool up = PART == 0; const int e = it / (up ? I_U : I_D), rr = it % (up ? I_U : I_D);
        t.K = up ? 1024 : 512; t.Nsrc = 1024;
        t.k0 = up ? 64 * (rr & 15) : 64 * (rr & 7); t.n0 = up ? 32 * (rr >> 4) : 32 * (rr >> 3); const int n = t.n0 + 4 * (lane & 7);
        t.W = up ? wup + (size_t)e * 1024 * 1024 : wdn + (size_t)e * 512 * 1024;
        t.WT = up ? (bf16*)(ws + WS_WUP) + (size_t)e * 1024 * 1024 : (bf16*)(ws + WS_WDN) + (size_t)e * 1024 * 512;
        t.sc = up ? map_up(n) : n;
        return t; }, skip);
}

__device__ __forceinline__ void p1_hx(Frame& F) {
    const int gw = F.bid * NW + F.wave, NGW = F.G * NW;
    const float* modv = wsp<float>(F, WS_MODV);
    LAS float* co = (LAS float*)F.lds; LAS float* shl = co + 3072;
    for (int i = F.tid; i < 3072; i += NTHR) { const int bsel = i >> 10, c = i & 1023; co[i] = F.g_norm1[c] * (modv[bsel * 6144 + 1024 + c] + 1.f); shl[i] = modv[bsel * 6144 + c]; }
    __syncthreads();
    constexpr int RPT = 9;
    for (int m0 = gw; m0 < MT; m0 += RPT * NGW) {
        f32x4 v[RPT][4];
#pragma unroll
        for (int k = 0; k < RPT; ++k) { const int m = m0 + k * NGW < MT ? m0 + k * NGW : m0;
            const float* src = m < M_LAT ? F.x + (size_t)m * D : F.ctx + (size_t)(m - M_LAT) * D;
#pragma unroll
            for (int j = 0; j < 4; ++j) v[k][j] = *(const f32x4*)(src + 4 * F.lane + 256 * j); }
        __builtin_amdgcn_sched_barrier(0);
#pragma unroll
        for (int k = 0; k < RPT; ++k) { const int m = m0 + k * NGW;
            if (m < MT) {
                float ssq = 0.f;
#pragma unroll
                for (int j = 0; j < 4; ++j) ssq += (v[k][j].x * v[k][j].x + v[k][j].y * v[k][j].y) + (v[k][j].z * v[k][j].z + v[k][j].w * v[k][j].w);
                const float rstd = 1.f / sqrtf(wave_sum(ssq) * (1.f / D) + EPS);
                const int bsel = m < M_LAT ? (m >> 13) : 2;
                bf16* o = wsp<bf16>(F, WS_HX) + (size_t)m * D;
#pragma unroll
                for (int j = 0; j < 4; ++j) { const int c = 4 * F.lane + 256 * j;
                    const f32x4 g = *(const LAS f32x4*)(co + bsel * 1024 + c), sh = *(const LAS f32x4*)(shl + bsel * 1024 + c);
                    const f32x4 h = (v[k][j] * rstd) * g + sh;
                    u32x2 w; w.x = pk2(h.x, h.y); w.y = pk2(h.z, h.w); *(u32x2*)(o + c) = w; } } }
    }
    __syncthreads();
}

struct EpiProjA {
    unsigned char* ws; const float* b_mgate;
    __device__ __forceinline__ void operator()(const f32x4 (&acc)[2][2][4][2], const Unit& u, int wr, int wc, int fr, int fq) const {
        const int row0 = u.pm * 256 + wr * 64 + fr;
        if (u.pn < 16) {
            bf16* base = (bf16*)(ws + WS_QKM + (size_t)(u.pn >> 2) * BIG) + (u.pn & 3) * 256 + wc * 32 + 8 * fq;
#pragma unroll
            for (int ai = 0; ai < 2; ++ai)
#pragma unroll
                for (int m = 0; m < 4; ++m) { bf16* rowp = base + (size_t)(row0 + ai * 128 + m * 16) * 1024;
#pragma unroll
                    for (int bj = 0; bj < 2; ++bj) { const f32x4 v0 = acc[ai][bj][m][0], v1 = acc[ai][bj][m][1];
                        u32x4 w; w.x = cvt_pk_bf16(v0[0], v0[1]); w.y = cvt_pk_bf16(v0[2], v0[3]); w.z = cvt_pk_bf16(v1[0], v1[1]); w.w = cvt_pk_bf16(v1[2], v1[3]);
                        *(u32x4*)(rowp + bj * 128) = w; } }
        } else if (wc < 2) {
            const int col = wc * 32 + 8 * fq;
            float* g = (float*)(ws + WS_GATES);
            f32x4 b0 = {0.f, 0.f, 0.f, 0.f}, b1 = b0;
            if (col < 16) { b0 = *(const f32x4*)(b_mgate + col); b1 = *(const f32x4*)(b_mgate + col + 4); }
#pragma unroll
            for (int ai = 0; ai < 2; ++ai)
#pragma unroll
                for (int m = 0; m < 4; ++m) { float* rowp = g + (size_t)(row0 + ai * 128 + m * 16) * 64 + col;
                    *(f32x4*)rowp = acc[ai][0][m][0] + b0; *(f32x4*)(rowp + 4) = acc[ai][0][m][1] + b1; }
        }
    }
};

#define LBAR_P3() do { asm volatile("s_waitcnt vmcnt(16) lgkmcnt(0)" ::: "memory"); __builtin_amdgcn_s_barrier(); } while (0)
__device__ __forceinline__ int chunk_row0(int ci) { return ci < 256 ? (ci >> 7) * SEQ + (ci & 127) * 64 : M_LAT + ((ci - 256) >> 2) * CTXL + ((ci - 256) & 3) * 64; }
__device__ __forceinline__ bf16* qkgt_row(const Frame& F, int dir, int m) {
    return m < M_LAT ? (bf16*)F.out + ((size_t)dir * M_LAT + m) * 1024 : wsp<bf16>(F, WS_QKGTC) + ((size_t)dir * M_CTX + (m - M_LAT)) * 1024;
}
__device__ __forceinline__ float logsig_fast(float x) { return fminf(x, 0.f) - __logf(1.f + __expf(-fabsf(x))); }
__device__ __forceinline__ void unpack8(const u32x4& v, float (&f)[8]) { f[0] = bflo(v.x); f[1] = bfhi(v.x); f[2] = bflo(v.y); f[3] = bfhi(v.y); f[4] = bflo(v.z); f[5] = bfhi(v.z); f[6] = bflo(v.w); f[7] = bfhi(v.w); }
__device__ __forceinline__ void p3_prep(Frame& F) {
    const bf16* QKM = wsp<bf16>(F, WS_QKM); bf16* QKMC = wsp<bf16>(F, WS_QKMC); const float* GATES = wsp<float>(F, WS_GATES); const bf16* QKG = wsp<bf16>(F, WS_QKG);
    for (int it = F.bid; it < NCHUNK * 3; it += F.G) {
        int tidl = F.tid; asm volatile("" : "+v"(tidl));
        const int lanel = tidl & 63;
        if (it < NCHUNK) {
            const int ci = F.G == 256 ? (it < 256 ? (it & 7) * 33 + (it >> 3) : (it - 256) * 33 + 32) : it, m0 = chunk_row0(ci);
            const int cg = tidl & 127, cq = tidl >> 7, ch = 8 * cg;
            const bool lat = ci < 256; const int c = lat ? (ci & 127) : ((ci - 256) & 3);
            const bool has_up = lat && c > 0, has_dn = lat && c < 127;
            const float osc = ch >= 512 ? 0.08838834764831845f : 1.f;
            const float gate_ip = GATES[(size_t)(m0 + lanel) * 64 + (F.wave >> 2) * 8 + (F.wave & 3)], gate_lf = GATES[(size_t)(m0 + lanel) * 64 + (F.wave >> 2) * 8 + 4 + (F.wave & 3)];
            f32x4 bz0 = *(const f32x4*)(F.ml_conv_b + ch), bz1 = *(const f32x4*)(F.ml_conv_b + ch + 4);
            f32x4 cw0[9], cw1[9];
#pragma unroll
            for (int q = 0; q < 9; ++q) { cw0[q] = *(const f32x4*)(F.ml_conv + q * 1024 + ch); cw1[q] = *(const f32x4*)(F.ml_conv + q * 1024 + ch + 4); }
            const f32x4 z4 = {0.f, 0.f, 0.f, 0.f};
#pragma unroll
            for (int q = 0; q < 3; ++q) { if (!has_up) { cw0[q] = z4; cw1[q] = z4; } if (!has_dn) { cw0[6 + q] = z4; cw1[6 + q] = z4; } }
            const int collo = lat ? 0 : (c == 0 ? 0 : -1), colhi = lat ? 63 : (c == 3 ? 63 : 64);
            const bf16* rb0 = QKM + (size_t)(has_up ? m0 - 64 : m0) * 1024 + ch; const bf16* rb1 = QKM + (size_t)m0 * 1024 + ch; const bf16* rb2 = QKM + (size_t)(has_dn ? m0 + 64 : m0) * 1024 + ch;
            auto ldc = [&](int dr, int col) -> u32x4 { const int cc = min(max(col, collo), colhi); const bf16* rb = dr == 0 ? rb0 : dr == 1 ? rb1 : rb2; return *(const u32x4*)(rb + (ptrdiff_t)cc * 1024); };
            const u32x4 zu = {0u, 0u, 0u, 0u};
            int cc = cq * 16;
            u32x4 w0[3], w1[3], n0[3], n1[3];
#pragma unroll
            for (int dr = 0; dr < 3; ++dr) { const u32x4 v = ldc(dr, cc - 1); w0[dr] = cc - 1 >= collo ? v : zu; w1[dr] = ldc(dr, cc); n0[dr] = ldc(dr, cc + 1); n1[dr] = ldc(dr, cc + 2); }
#pragma unroll 1
            for (int cb = 0; cb < 8; ++cb, cc += 2) {
                u32x4 p0[3], p1[3];
#pragma unroll
                for (int dr = 0; dr < 3; ++dr) { p0[dr] = ldc(dr, cc + 3); p1[dr] = ldc(dr, cc + 4); }
                __builtin_amdgcn_sched_barrier(0);
                float acc[2][8];
#pragma unroll
                for (int oc = 0; oc < 2; ++oc) { acc[oc][0] = bz0[0]; acc[oc][1] = bz0[1]; acc[oc][2] = bz0[2]; acc[oc][3] = bz0[3]; acc[oc][4] = bz1[0]; acc[oc][5] = bz1[1]; acc[oc][6] = bz1[2]; acc[oc][7] = bz1[3]; }
#pragma unroll
                for (int dr = 0; dr < 3; ++dr)
#pragma unroll
                    for (int dc = 0; dc < 4; ++dc) { float f[8]; unpack8(dc == 0 ? w0[dr] : dc == 1 ? w1[dr] : dc == 2 ? n0[dr] : n1[dr], f);
#pragma unroll
                        for (int oc = 0; oc < 2; ++oc) { const int t = dc - oc; if (t < 0 || t > 2) continue; const f32x4 k0 = cw0[dr * 3 + t], k1 = cw1[dr * 3 + t];
                            acc[oc][0] += k0[0] * f[0]; acc[oc][1] += k0[1] * f[1]; acc[oc][2] += k0[2] * f[2]; acc[oc][3] += k0[3] * f[3]; acc[oc][4] += k1[0] * f[4]; acc[oc][5] += k1[1] * f[5]; acc[oc][6] += k1[2] * f[6]; acc[oc][7] += k1[3] * f[7]; } }
#pragma unroll
                for (int oc = 0; oc < 2; ++oc) { u32x4 o; o.x = pk2(siluf(acc[oc][0]) * osc, siluf(acc[oc][1]) * osc); o.y = pk2(siluf(acc[oc][2]) * osc, siluf(acc[oc][3]) * osc);
                    o.z = pk2(siluf(acc[oc][4]) * osc, siluf(acc[oc][5]) * osc); o.w = pk2(siluf(acc[oc][6]) * osc, siluf(acc[oc][7]) * osc);
                    *(u32x4*)(QKMC + (size_t)(m0 + cc + oc) * 1024 + ch) = o; }
                __builtin_amdgcn_sched_barrier(0);
                const bool k0 = cc + 3 <= colhi, k1 = cc + 4 <= colhi;
#pragma unroll
                for (int dr = 0; dr < 3; ++dr) { w0[dr] = n0[dr]; w1[dr] = n1[dr]; n0[dr] = k0 ? p0[dr] : zu; n1[dr] = k1 ? p1[dr] : zu; }
            }
            {
                const int dir = F.wave >> 2, h = F.wave & 3, m = m0 + lanel;
                const float ip = gate_ip, lf = logsig(gate_lf);
                float b = lf;
#pragma unroll
                for (int o = 1; o < 64; o <<= 1) { const float t = dir == 0 ? __shfl_up(b, o) : __shfl_down(b, o); const bool ok = dir == 0 ? (lanel >= o) : (lanel + o < 64); if (ok) b += t; }
                f32x2 ab; ab.x = expf(b); ab.y = expf(ip - b);
                wsp<f32x2>(F, WS_AB)[((size_t)dir * MT + m) * 4 + h] = ab;
                if (lanel == (dir == 0 ? 63 : 0)) wsp<float>(F, WS_GENDM)[((size_t)dir * NCHUNK + ci) * 4 + h] = expf(b);
            }
        } else {
            const int gi0 = it - NCHUNK;
            const int gi = F.G == 256 ? ((((gi0 >> 4) << 3) | (gi0 & 7)) << 1) | ((gi0 >> 3) & 1) : gi0;
            const int ci = gi >> 1, dir = gi & 1, m0 = chunk_row0(ci);
            LAS float* lr = (LAS float*)F.lds;
            LAS float* Bl = (LAS float*)(F.lds + 4096);
            __syncthreads();
            for (int i = tidl; i < 1024; i += NTHR) lr[i] = GATES[(size_t)(m0 + (i >> 4)) * 64 + 16 + dir * 16 + (i & 15)];
            const int ch = tidl;
            f32x2 w2p[8];
#pragma unroll
            for (int r = 0; r < 8; ++r) { w2p[r].x = F.gla_w2[((size_t)dir * 16 + 2 * r) * 512 + ch]; w2p[r].y = F.gla_w2[((size_t)dir * 16 + 2 * r + 1) * 512 + ch]; }
            const float b2 = F.gla_b2[dir * 512 + ch];
            u32x4 vin[16];
            const int cp = tidl & 127, r0 = tidl >> 7; const bool isk = cp >= 64;
            const float sg = isk ? -1.4426950408889634f : 1.4426950408889634f, eoff = isk ? 0.f : -3.5f;
            const bf16* irow = QKG + (size_t)(m0 + r0) * 1024 + cp * 8; bf16* orow = qkgt_row(F, dir, m0) + (size_t)r0 * 1024 + cp * 8;
            const LAS float* brow = Bl + r0 * 512 + 8 * (cp & 63);
#pragma unroll
            for (int j = 0; j < 16; ++j) vin[j] = *(const u32x4*)(irow + (size_t)j * 4096);
            LBAR_P3();
            float b = 0.f;
#pragma unroll 1
            for (int i0 = 0; i0 < 64; i0 += 4) {
                f32x4 l[4][4];
#pragma unroll
                for (int u = 0; u < 4; ++u) { const int r = dir == 0 ? i0 + u : 63 - i0 - u;
#pragma unroll
                    for (int q = 0; q < 4; ++q) l[u][q] = *(const LAS f32x4*)(lr + r * 16 + 4 * q); }
                float ls[4];
#pragma unroll
                for (int u = 0; u < 4; ++u) {
                    f32x2 a2 = {b2, 0.f};
#pragma unroll
                    for (int q = 0; q < 4; ++q) { a2 = __builtin_elementwise_fma((f32x2){l[u][q][0], l[u][q][1]}, w2p[2 * q], a2); a2 = __builtin_elementwise_fma((f32x2){l[u][q][2], l[u][q][3]}, w2p[2 * q + 1], a2); }
                    const float xg = a2.x + a2.y;
                    ls[u] = fminf(xg, 0.f) - 0.6931471805599453f * __builtin_amdgcn_logf(1.f + __builtin_amdgcn_exp2f(-1.4426950408889634f * fabsf(xg))); }
#pragma unroll
                for (int u = 0; u < 4; ++u) { const int r = dir == 0 ? i0 + u : 63 - i0 - u; b += ls[u] * (1.f / 16.f); Bl[r * 512 + ch] = b; }
            }
            wsp<float>(F, WS_GENDG)[((size_t)dir * NCHUNK + ci) * 512 + ch] = __expf(b);
            __syncthreads();
#pragma unroll
            for (int j = 0; j < 16; ++j) {
                const u32x4 v = vin[j];
                const f32x4 b0 = *(const LAS f32x4*)(brow + j * 2048), b1 = *(const LAS f32x4*)(brow + j * 2048 + 4);
                float f[8]; unpack8(v, f); float e[8];
#pragma unroll
                for (int q = 0; q < 4; ++q) { e[q] = __builtin_amdgcn_exp2f(__builtin_fmaf(b0[q], sg, eoff)); e[4 + q] = __builtin_amdgcn_exp2f(__builtin_fmaf(b1[q], sg, eoff)); }
                u32x4 o; o.x = pk2(f[0] * e[0], f[1] * e[1]); o.y = pk2(f[2] * e[2], f[3] * e[3]); o.z = pk2(f[4] * e[4], f[5] * e[5]); o.w = pk2(f[6] * e[6], f[7] * e[7]);
                *(u32x4*)(orow + (size_t)j * 4096) = o; }
        }
    }
}

constexpr int L_AQ = 0, L_AK = 16384, L_VP = 32768, L_P = 49152, L_S = 65536, L_N = 131072 + 1024  ;
struct ScanSrc { const bf16* q; const bf16* k; const bf16* v; const f32x2* ab; const float* gend; int gstride; };
__device__ __forceinline__ int seg_chunk(int seg, int dir, int i) {
    if (seg < 0) return dir == 0 ? i : 3 - i;
    return dir == 0 ? seg * CPS + i : (NCH_LAT - 1 - seg * CPS) - i;
}
__device__ __forceinline__ void scan_stage(Frame& F, int model, int b, int h, int dir, int half, int ci, bool need_q) {
    const int m0 = chunk_row0(ci);
    LAS float* nb = (LAS float*)(F.lds + L_N);
    if (model == 0 && F.tid < 64) { const f32x2 ab = wsp<f32x2>(F, WS_AB)[((size_t)dir * MT + m0 + F.tid) * 4 + h]; nb[256 + F.tid] = ab.y; nb[320 + F.tid] = ab.x; }
    if (F.tid >= 64 && F.tid < 192) { const int dk = F.tid - 64;
        nb[128 + dk] = model == 0 ? wsp<float>(F, WS_GENDM)[((size_t)dir * NCHUNK + ci) * 4 + h] : wsp<float>(F, WS_GENDG)[((size_t)dir * NCHUNK + ci) * 512 + h * 128 + dk]; }
#pragma unroll
    for (int i = 0; i < 2; ++i) { const int p = F.tid + i * 512, r = p >> 4, cpart = p & 15, m = m0 + r;
        const bf16* qrow; const bf16* vrow;
        if (model == 0) { qrow = wsp<bf16>(F, WS_QKMC) + (size_t)m * 1024; vrow = wsp<bf16>(F, WS_VM) + (size_t)m * 1024; }
        else { qrow = qkgt_row(F, dir, m); vrow = wsp<bf16>(F, WS_VG) + (size_t)m * 1024; }
        if (need_q) *(LAS u32x4*)(F.lds + L_AQ + r * 256 + cpart * 16) = *(const u32x4*)(qrow + h * 128 + cpart * 8);
        *(LAS u32x4*)(F.lds + L_AK + r * 256 + cpart * 16) = *(const u32x4*)(qrow + 512 + h * 128 + cpart * 8);
        u32x4 v = *(const u32x4*)(vrow + h * 256 + half * 128 + cpart * 8);
        if (model == 0) { const float be = wsp<f32x2>(F, WS_AB)[((size_t)dir * MT + m) * 4 + h].y;
            v.x = pk2(bflo(v.x) * be, bfhi(v.x) * be); v.y = pk2(bflo(v.y) * be, bfhi(v.y) * be); v.z = pk2(bflo(v.z) * be, bfhi(v.z) * be); v.w = pk2(bflo(v.w) * be, bfhi(v.w) * be); }
        *(LAS u32x4*)(F.lds + L_VP + r * 256 + cpart * 16) = v; }
}
__device__ __forceinline__ void scan_update(Frame& F, int model) {
    LAS float* S = (LAS float*)(F.lds + L_S); LAS float* nb = (LAS float*)(F.lds + L_N);
    const LAS bf16* AK = (const LAS bf16*)(F.lds + L_AK); const LAS bf16* VP = (const LAS bf16*)(F.lds + L_VP);
    const int dk = F.tid >> 2, dv0 = (F.tid & 3) * 32;
    float a[32];
#pragma unroll
    for (int j = 0; j < 32; ++j) a[j] = S[dk * 128 + dv0 + j];
    float nn = 0.f;
    for (int s = 0; s < 64; ++s) { const float k = bf2f(AK[s * 128 + dk]);
        if (model == 0) nn += k * nb[256 + s];
#pragma unroll
        for (int j = 0; j < 32; j += 2) { const unsigned v = *(const LAS unsigned*)(VP + s * 128 + dv0 + j); a[j] += k * bflo(v); a[j + 1] += k * bfhi(v); } }
    const float g = nb[128 + dk];
#pragma unroll
    for (int j = 0; j < 32; ++j) S[dk * 128 + dv0 + j] = g * a[j];
    if (model == 0 && (F.tid & 3) == 0) nb[dk] = g * (nb[dk] + nn);
}
__device__ __forceinline__ bf16* state_ptr(const Frame& F, int sc, int slot, int half) { return wsp<bf16>(F, WS_STATE) + ((size_t)(sc * 8 + slot) * 2 + half) * 16384; }

__device__ __forceinline__ void p4_scan_local(Frame& F) {
    LAS float* S = (LAS float*)(F.lds + L_S); LAS float* nb = (LAS float*)(F.lds + L_N);
    for (int it0 = F.bid; it0 < 32 * 8 * 2; it0 += F.G) {
        const int it = (F.G == 256) ? (it0 & ~255) | ((((((it0 & 255) >> 4) << 3) | (it0 & 7)) << 1) | ((it0 >> 3) & 1)) : it0;
        const int half = it & 1, slot = (it >> 1) & 7, sc = it >> 4, seg = slot - 1;
        const int dir = sc & 1, h = (sc >> 1) & 3, b = (sc >> 3) & 1, model = sc >> 4;
        for (int i = F.tid; i < 16384; i += NTHR) S[i] = 0.f;
        if (F.tid < 128) nb[F.tid] = 0.f;
        float gacc = 1.f;
        __syncthreads();
        const int nch = seg < 0 ? NCH_CTX : CPS;
        for (int i = 0; i < nch; ++i) {
            const int c = seg_chunk(seg, dir, i), ci = seg < 0 ? 256 + b * 4 + c : b * 128 + c;
            scan_stage(F, model, b, h, dir, half, ci, false);
            __syncthreads();
            if (F.tid < 128) gacc *= nb[128 + F.tid];
            scan_update(F, model);
            __syncthreads();
        }
        bf16* st = state_ptr(F, sc, slot, half);
        for (int i = F.tid; i < 8192; i += NTHR) ((unsigned*)st)[i] = pk2(S[2 * i], S[2 * i + 1]);
        if (half == 0 && F.tid < 128) { wsp<float>(F, WS_NST)[(sc * 8 + slot) * 128 + F.tid] = nb[F.tid]; wsp<float>(F, WS_GSEG)[(sc * 8 + slot) * 128 + F.tid] = gacc; }
        __syncthreads();
    }
}
__device__ __forceinline__ void p5_scan_out(Frame& F) {
    LAS float* S = (LAS float*)(F.lds + L_S); LAS float* nb = (LAS float*)(F.lds + L_N); LAS float* P = (LAS float*)(F.lds + L_P);
    const LAS bf16* AQ = (const LAS bf16*)(F.lds + L_AQ); const LAS bf16* AK = (const LAS bf16*)(F.lds + L_AK); const LAS bf16* VP = (const LAS bf16*)(F.lds + L_VP);
    for (int it0 = F.bid; it0 < 2 * 2 * 4 * 8 * 2; it0 += F.G) {
        const int it = (F.G == 256) ? ((((it0 >> 4) << 3) | (it0 & 7)) << 1) | ((it0 >> 3) & 1) : it0;
        const int half = it & 1, seg = (it >> 1) & 7, h = (it >> 4) & 3, b = (it >> 6) & 1, model = it >> 7;
        bf16* HS = wsp<bf16>(F, model == 0 ? WS_QKM : WS_QKG);
        for (int dir = 0; dir < 2; ++dir) {
            const int sc = ((model * 2 + b) * 4 + h) * 2 + dir, s = dir == 0 ? seg : 7 - seg;
            { const int dk = F.tid >> 2, dv0 = (F.tid & 3) * 32; float a[32]; float nn = 0.f;
#pragma unroll
              for (int j = 0; j < 32; ++j) a[j] = 0.f;
              for (int slot = 0; slot <= s; ++slot) {
                  const float g = slot == 0 ? 0.f : wsp<float>(F, WS_GSEG)[(sc * 8 + slot) * 128 + dk];
                  const bf16* st = state_ptr(F, sc, slot, half) + dk * 128 + dv0;
#pragma unroll
                  for (int j = 0; j < 32; j += 2) { const unsigned v = *(const unsigned*)(st + j); a[j] = g * a[j] + bflo(v); a[j + 1] = g * a[j + 1] + bfhi(v); }
                  nn = g * nn + wsp<float>(F, WS_NST)[(sc * 8 + slot) * 128 + dk]; }
#pragma unroll
              for (int j = 0; j < 32; ++j) S[dk * 128 + dv0 + j] = a[j];
              if ((F.tid & 3) == 0) nb[dk] = nn; }
            __syncthreads();
            for (int i = 0; i < CPS; ++i) {
                const int c = seg_chunk(s, dir, i), ci = b * 128 + c, m0 = chunk_row0(ci);
                scan_stage(F, model, b, h, dir, half, ci, true);
                __syncthreads();
                for (int e = F.tid; e < 4096; e += NTHR) { const int t = e >> 6, s2 = e & 63; float p = 0.f;
                    if (dir == 0 ? (s2 <= t) : (s2 >= t)) {
                        for (int d8 = 0; d8 < 16; ++d8) { const u32x4 qa = *(const LAS u32x4*)(AQ + t * 128 + d8 * 8), ka = *(const LAS u32x4*)(AK + s2 * 128 + d8 * 8);
                            p += bflo(qa.x) * bflo(ka.x) + bfhi(qa.x) * bfhi(ka.x) + bflo(qa.y) * bflo(ka.y) + bfhi(qa.y) * bfhi(ka.y)
                               + bflo(qa.z) * bflo(ka.z) + bfhi(qa.z) * bfhi(ka.z) + bflo(qa.w) * bflo(ka.w) + bfhi(qa.w) * bfhi(ka.w); } }
                    P[e] = bf2f((unsigned short)f2bf(p)); }
                __syncthreads();
                { const int t = F.tid >> 3, dv0 = (F.tid & 7) * 16; float o[16];
#pragma unroll
                  for (int j = 0; j < 16; ++j) o[j] = 0.f;
                  float den = 0.f;
                  for (int s2 = 0; s2 < 64; ++s2) { const float p = P[t * 64 + s2];
                      if (model == 0) den += p * nb[256 + s2];
                      const u32x4 v0 = *(const LAS u32x4*)(VP + s2 * 128 + dv0), v1 = *(const LAS u32x4*)(VP + s2 * 128 + dv0 + 8);
                      o[0] += p * bflo(v0.x); o[1] += p * bfhi(v0.x); o[2] += p * bflo(v0.y); o[3] += p * bfhi(v0.y); o[4] += p * bflo(v0.z); o[5] += p * bfhi(v0.z); o[6] += p * bflo(v0.w); o[7] += p * bfhi(v0.w);
                      o[8] += p * bflo(v1.x); o[9] += p * bfhi(v1.x); o[10] += p * bflo(v1.y); o[11] += p * bfhi(v1.y); o[12] += p * bflo(v1.z); o[13] += p * bfhi(v1.z); o[14] += p * bflo(v1.w); o[15] += p * bfhi(v1.w); }
                  for (int dk = 0; dk < 128; ++dk) { const float q = bf2f(AQ[t * 128 + dk]);
                      if (model == 0) den += q * nb[dk];
                      const LAS float* sr = S + dk * 128 + dv0;
#pragma unroll
                      for (int j = 0; j < 16; ++j) o[j] += q * bf2f((unsigned short)f2bf(sr[j])); }
                  float rs = 1.f;
                  if (model == 0) { const float al = nb[320 + t]; rs = al / fmaxf(al * fabsf(den), 1.f); }
                  bf16* dst = HS + (size_t)(m0 + t) * 1024 + h * 256 + half * 128 + dv0;
                  float ssq = 0.f;
                  if (dir == 0) {
                      u32x4 w0, w1; w0.x = pk2(o[0] * rs, o[1] * rs); w0.y = pk2(o[2] * rs, o[3] * rs); w0.z = pk2(o[4] * rs, o[5] * rs); w0.w = pk2(o[6] * rs, o[7] * rs);
                      w1.x = pk2(o[8] * rs, o[9] * rs); w1.y = pk2(o[10] * rs, o[11] * rs); w1.z = pk2(o[12] * rs, o[13] * rs); w1.w = pk2(o[14] * rs, o[15] * rs);
                      *(u32x4*)dst = w0; *(u32x4*)(dst + 8) = w1;
                  } else {
                      const u32x4 p0 = *(const u32x4*)dst, p1 = *(const u32x4*)(dst + 8);
                      const float f[16] = {bflo(p0.x), bfhi(p0.x), bflo(p0.y), bfhi(p0.y), bflo(p0.z), bfhi(p0.z), bflo(p0.w), bfhi(p0.w), bflo(p1.x), bfhi(p1.x), bflo(p1.y), bfhi(p1.y), bflo(p1.z), bfhi(p1.z), bflo(p1.w), bfhi(p1.w)};
                      float r[16];
#pragma unroll
                      for (int j = 0; j < 16; ++j) { r[j] = f[j] + o[j] * rs; ssq += r[j] * r[j]; }
                      u32x4 w0, w1; w0.x = pk2(r[0], r[1]); w0.y = pk2(r[2], r[3]); w0.z = pk2(r[4], r[5]); w0.w = pk2(r[6], r[7]);
                      w1.x = pk2(r[8], r[9]); w1.y = pk2(r[10], r[11]); w1.z = pk2(r[12], r[13]); w1.w = pk2(r[14], r[15]);
                      *(u32x4*)dst = w0; *(u32x4*)(dst + 8) = w1;
                      ssq += __shfl_xor(ssq, 1); ssq += __shfl_xor(ssq, 2); ssq += __shfl_xor(ssq, 4);
                      if ((F.tid & 7) == 0) wsp<float>(F, WS_SSQ)[((size_t)(m0 + t) * 8 + model * 4 + h) * 2 + half] = ssq;
                  } }
                __syncthreads();
                scan_update(F, model);
                __syncthreads();
            }
        }
    }
}

typedef short s16x4 __attribute__((ext_vector_type(4)));
__device__ __forceinline__ unsigned offb(int row, int ch) { return 256u * (unsigned)row + 16u * (unsigned)(ch ^ (((row & 3) << 2) | ((row >> 2) & 3))); }
constexpr int M_AQ = 0, M_AK = 16384, M_VP = 32768, M_P = 49152, M_O = 57344, O_LD = 132;
template <int TILE>
__device__ __forceinline__ void tr_frag2(unsigned x0, unsigned x1, bf16x8& f0, bf16x8& f1) {
    s16x4 r0, r1, r2, r3;
    asm volatile("ds_read_b64_tr_b16 %0, %4 offset:%6\n\tds_read_b64_tr_b16 %1, %5 offset:%6\n\tds_read_b64_tr_b16 %2, %4 offset:%7\n\tds_read_b64_tr_b16 %3, %5 offset:%7\n\ts_waitcnt lgkmcnt(0)"
                 : "=&v"(r0), "=&v"(r1), "=&v"(r2), "=&v"(r3) : "v"(x0), "v"(x1), "i"(TILE), "i"(TILE + 8192) : "memory");
    f0 = __builtin_shufflevector(r0, r1, 0, 1, 2, 3, 4, 5, 6, 7); f1 = __builtin_shufflevector(r2, r3, 0, 1, 2, 3, 4, 5, 6, 7);
}
template <int TILE>
__device__ __forceinline__ void tr_frag8(unsigned a0, unsigned a1, unsigned b0, unsigned b1, unsigned c0, unsigned c1, unsigned d0, unsigned d1, bf16x8 (&f)[8]) {
    s16x4 r[16];
    asm volatile("ds_read_b64_tr_b16 %0, %16 offset:%24\n\tds_read_b64_tr_b16 %1, %17 offset:%24\n\tds_read_b64_tr_b16 %2, %16 offset:%25\n\tds_read_b64_tr_b16 %3, %17 offset:%25\n\t"
                 "ds_read_b64_tr_b16 %4, %18 offset:%24\n\tds_read_b64_tr_b16 %5, %19 offset:%24\n\tds_read_b64_tr_b16 %6, %18 offset:%25\n\tds_read_b64_tr_b16 %7, %19 offset:%25\n\t"
                 "ds_read_b64_tr_b16 %8, %20 offset:%24\n\tds_read_b64_tr_b16 %9, %21 offset:%24\n\tds_read_b64_tr_b16 %10, %20 offset:%25\n\tds_read_b64_tr_b16 %11, %21 offset:%25\n\t"
                 "ds_read_b64_tr_b16 %12, %22 offset:%24\n\tds_read_b64_tr_b16 %13, %23 offset:%24\n\tds_read_b64_tr_b16 %14, %22 offset:%25\n\tds_read_b64_tr_b16 %15, %23 offset:%25\n\ts_waitcnt lgkmcnt(0)"
                 : "=&v"(r[0]), "=&v"(r[1]), "=&v"(r[2]), "=&v"(r[3]), "=&v"(r[4]), "=&v"(r[5]), "=&v"(r[6]), "=&v"(r[7]), "=&v"(r[8]), "=&v"(r[9]), "=&v"(r[10]), "=&v"(r[11]), "=&v"(r[12]), "=&v"(r[13]), "=&v"(r[14]), "=&v"(r[15])
                 : "v"(a0), "v"(a1), "v"(b0), "v"(b1), "v"(c0), "v"(c1), "v"(d0), "v"(d1), "i"(TILE), "i"(TILE + 8192) : "memory");
#pragma unroll
    for (int j = 0; j < 8; ++j) f[j] = __builtin_shufflevector(r[2 * j], r[2 * j + 1], 0, 1, 2, 3, 4, 5, 6, 7);
}
template <int TILE>
__device__ __forceinline__ void tr_frag4(unsigned x0, unsigned x1, unsigned y0, unsigned y1, bf16x8& f0, bf16x8& f1, bf16x8& f2, bf16x8& f3) {
    s16x4 r0, r1, r2, r3, r4, r5, r6, r7;
    asm volatile("ds_read_b64_tr_b16 %0, %8 offset:%12\n\tds_read_b64_tr_b16 %1, %9 offset:%12\n\tds_read_b64_tr_b16 %2, %8 offset:%13\n\tds_read_b64_tr_b16 %3, %9 offset:%13\n\t"
                 "ds_read_b64_tr_b16 %4, %10 offset:%12\n\tds_read_b64_tr_b16 %5, %11 offset:%12\n\tds_read_b64_tr_b16 %6, %10 offset:%13\n\tds_read_b64_tr_b16 %7, %11 offset:%13\n\ts_waitcnt lgkmcnt(0)"
                 : "=&v"(r0), "=&v"(r1), "=&v"(r2), "=&v"(r3), "=&v"(r4), "=&v"(r5), "=&v"(r6), "=&v"(r7) : "v"(x0), "v"(x1), "v"(y0), "v"(y1), "i"(TILE), "i"(TILE + 8192) : "memory");
    f0 = __builtin_shufflevector(r0, r1, 0, 1, 2, 3, 4, 5, 6, 7); f1 = __builtin_shufflevector(r2, r3, 0, 1, 2, 3, 4, 5, 6, 7);
    f2 = __builtin_shufflevector(r4, r5, 0, 1, 2, 3, 4, 5, 6, 7); f3 = __builtin_shufflevector(r6, r7, 0, 1, 2, 3, 4, 5, 6, 7);
}
#define MFMA16(a, b, c) __builtin_amdgcn_mfma_f32_16x16x32_bf16((a), (b), (c), 0, 0, 0)
__device__ __forceinline__ bf16* mstate_ptr(const Frame& F, int sc, int slot, int half) { return wsp<bf16>(F, WS_STATE) + ((size_t)(sc * 8 + slot) * 2 + half) * 16384; }

#define LBAR() asm volatile("s_waitcnt lgkmcnt(0)\n\ts_barrier" ::: "memory")
template <bool OUT>
__device__ __forceinline__ void mscan_run(Frame& F, int model, int b, int h, int dir, int half, int seg, f32x4 (&S)[2][8], float& gacc) {
    LAS unsigned char* lds = F.lds; LAS float* nb = (LAS float*)(F.lds + L_N);
    LAS unsigned short* nbh = (LAS unsigned short*)(F.lds + L_N + 2048);
    const unsigned lb = (unsigned)(uintptr_t)F.lds;
    const int w = F.wave, lane = F.lane, li = lane & 15, lg = lane >> 4, tq = li >> 2, tp = lane & 3;
    const bool st = w < 4; const int sw = w & 3;
    const int nch = seg < 0 ? NCH_CTX : CPS;
    bf16* HS = wsp<bf16>(F, model == 0 ? WS_QKM : WS_QKG);
    const int mli = ((li & 3) << 2) | ((li >> 2) & 3);
    const unsigned rowb = 256u * li + 16u * (lg ^ mli);
    const unsigned o2b = 256u * li + 16u * ((lg >> 1) ^ mli) + 8u * (lg & 1);
    const unsigned trb0 = 256u * (8 * lg + tq) + 16u * ((tp >> 1) ^ ((tq << 2) | ((2 * lg) & 3))) + 8u * (tp & 1);
    const unsigned trb1 = 256u * (8 * lg + 4 + tq) + 16u * ((tp >> 1) ^ ((tq << 2) | ((2 * lg + 1) & 3))) + 8u * (tp & 1);
    const unsigned pra0 = lb + M_P + (128u * li + 16u * (lg ^ (li & 7))), pra1 = lb + M_P + ((128u * li + 16u * (lg ^ (li & 7))) ^ 64u);
    const unsigned poff0 = (unsigned)((F.tid >> 4) * 1024 + (F.tid & 15) * 8) * 2u, poff1 = poff0 + 32u * 2048u;
    auto final_pass = [&](const int m0, const u32x4 (&prevh)[2]) {
        LAS float* Ol = (LAS float*)(F.lds + M_O);
#pragma unroll
        for (int i = 0; i < 2; ++i) { const int p = F.tid + i * 512, t = p >> 4, c8 = p & 15;
            const f32x4 o0 = *(const LAS f32x4*)(Ol + t * O_LD + 8 * c8), o1 = *(const LAS f32x4*)(Ol + t * O_LD + 8 * c8 + 4);
            float rs = 1.f;
            if (model == 0) rs = nb[384 + t];
            bf16* dst = (bf16*)((unsigned char*)(HS + (size_t)m0 * 1024 + h * 256 + half * 128) + (i == 0 ? poff0 : poff1));
            float r[8] = {o0[0] * rs, o0[1] * rs, o0[2] * rs, o0[3] * rs, o1[0] * rs, o1[1] * rs, o1[2] * rs, o1[3] * rs};
            if (dir == 1) { const u32x4 pv = prevh[i];
                r[0] += bflo(pv.x); r[1] += bfhi(pv.x); r[2] += bflo(pv.y); r[3] += bfhi(pv.y); r[4] += bflo(pv.z); r[5] += bfhi(pv.z); r[6] += bflo(pv.w); r[7] += bfhi(pv.w);
                float ssq = (r[0] * r[0] + r[1] * r[1]) + (r[2] * r[2] + r[3] * r[3]) + (r[4] * r[4] + r[5] * r[5]) + (r[6] * r[6] + r[7] * r[7]);
                ssq += __shfl_xor(ssq, 1); ssq += __shfl_xor(ssq, 2); ssq += __shfl_xor(ssq, 4); ssq += __shfl_xor(ssq, 8);
                if (c8 == 0) wsp<float>(F, WS_SSQ)[((size_t)(m0 + t) * 8 + model * 4 + h) * 2 + half] = ssq; }
            u32x4 wv; wv.x = pkbf(r[0], r[1]); wv.y = pkbf(r[2], r[3]); wv.z = pkbf(r[4], r[5]); wv.w = pkbf(r[6], r[7]);
            *(u32x4*)dst = wv; }
    };
    const unsigned pwb = 128u * li + 8u * (lg & 1) + 16u * ((lg >> 1) ^ (li & 7));
    auto ptile = [&](const int ti, const int sh) {
        const bool used = dir == 0 ? !(sh == 1 && ti < 2) : !(sh == 0 && ti >= 2);
        if (!used) return;
        unsigned rowl = rowb; asm volatile("" : "+v"(rowl));
        bf16x8 pa[4], pb0[4], pb1[4];
#pragma unroll
        for (int kk = 0; kk < 4; ++kk) { const unsigned ra = lb + (rowl ^ ((unsigned)kk << 6)); pa[kk] = *(const LAS bf16x8*)(uintptr_t)(ra + M_AQ + 4096u * ti); pb0[kk] = *(const LAS bf16x8*)(uintptr_t)(ra + M_AK + 8192u * sh); pb1[kk] = *(const LAS bf16x8*)(uintptr_t)(ra + M_AK + 8192u * sh + 4096u); }
        f32x4 acc0 = {0.f, 0.f, 0.f, 0.f}, acc1 = acc0;
#pragma unroll
        for (int kk = 0; kk < 4; ++kk) { acc0 = MFMA16(pb0[kk], pa[kk], acc0); acc1 = MFMA16(pb1[kk], pa[kk], acc1); }
        const int t = 16 * ti + li;
#pragma unroll
        for (int sj = 0; sj < 2; ++sj) { const f32x4 acc = sj == 0 ? acc0 : acc1; const int s0 = 16 * (2 * sh + sj) + 4 * lg; float pv[4];
#pragma unroll
            for (int r = 0; r < 4; ++r) { const bool keep = dir == 0 ? (s0 + r <= t) : (s0 + r >= t); pv[r] = keep ? acc[r] : 0.f; }
            u32x2 pw; pw.x = pkbf(pv[0], pv[1]); pw.y = pkbf(pv[2], pv[3]);
            *(LAS u32x2*)(uintptr_t)(lb + M_P + 2048u * ti + (pwb ^ ((unsigned)(4 * sh + 2 * sj) << 4))) = pw; }
    };
    auto chunk_m0 = [&](const int ic) { const int c = seg_chunk(seg, dir, ic), ci = seg < 0 ? 256 + b * 4 + c : b * 128 + c; return chunk_row0(ci); };
    if (st) {
        const unsigned ola = lb + M_O + 4u * ((4 * lg) * O_LD + 32 * sw + li);
        for (int ic = 0; ic < nch; ++ic) {
            const int m0 = chunk_m0(ic);
            LBAR();
            if (F.tid < 128) gacc *= nb[128 + F.tid];
            unsigned o2l = o2b, tr0l = trb0, tr1l = trb1; asm volatile("" : "+v"(o2l), "+v"(tr0l), "+v"(tr1l));
            bf16x8 VB[2][2];
            tr_frag4<M_VP>(lb + (tr0l ^ ((unsigned)(2 * sw) << 5)), lb + (tr1l ^ ((unsigned)(2 * sw) << 5)), lb + (tr0l ^ ((unsigned)(2 * sw + 1) << 5)), lb + (tr1l ^ ((unsigned)(2 * sw + 1) << 5)), VB[0][0], VB[0][1], VB[1][0], VB[1][1]);
            u32x4 prevh[2] = {{0u, 0u, 0u, 0u}, {0u, 0u, 0u, 0u}};
            if (OUT) {
#pragma unroll
                for (int i = 0; i < 2; ++i) prevh[i] = *(const u32x4*)((const unsigned char*)(HS + (size_t)m0 * 1024 + h * 256 + half * 128) + (i == 0 ? poff0 : poff1) * (unsigned)dir);
                ptile(sw, 1);
                f32x4 O[2][4];
#pragma unroll
                for (int j = 0; j < 2; ++j)
#pragma unroll
                    for (int q = 0; q < 4; ++q) O[j][q] = (f32x4){0.f, 0.f, 0.f, 0.f};
#pragma unroll
                for (int kh = 0; kh < 2; ++kh) {
                    u32x2 alo[2][4], ahi[2][4];
#pragma unroll
                    for (int k2 = 0; k2 < 2; ++k2)
#pragma unroll
                        for (int q = 0; q < 4; ++q) { alo[k2][q] = *(const LAS u32x2*)(uintptr_t)((o2l ^ ((unsigned)(4 * (2 * kh + k2)) << 4)) + lb + M_AQ + 4096u * q); ahi[k2][q] = *(const LAS u32x2*)(uintptr_t)((o2l ^ ((unsigned)(4 * (2 * kh + k2) + 2) << 4)) + lb + M_AQ + 4096u * q); }
#pragma unroll
                    for (int k2 = 0; k2 < 2; ++k2) { const int kk = 2 * kh + k2; bf16x8 Bk[2];
#pragma unroll
                        for (int j = 0; j < 2; ++j) { u32x4 bw; bw.x = pkbf(S[j][2 * kk][0], S[j][2 * kk][1]); bw.y = pkbf(S[j][2 * kk][2], S[j][2 * kk][3]); bw.z = pkbf(S[j][2 * kk + 1][0], S[j][2 * kk + 1][1]); bw.w = pkbf(S[j][2 * kk + 1][2], S[j][2 * kk + 1][3]); Bk[j] = __builtin_bit_cast(bf16x8, bw); }
#pragma unroll
                        for (int q = 0; q < 4; ++q) { u32x4 aw; aw.x = alo[k2][q].x; aw.y = alo[k2][q].y; aw.z = ahi[k2][q].x; aw.w = ahi[k2][q].y; const bf16x8 Af = __builtin_bit_cast(bf16x8, aw);
                            O[0][q] = MFMA16(Af, Bk[0], O[0][q]); O[1][q] = MFMA16(Af, Bk[1], O[1][q]); } }
                    asm volatile("" ::: "memory");
                }
                LBAR();
                bf16x8 p0[4], p1[4];
#pragma unroll
                for (int q = 0; q < 4; ++q) { p0[q] = *(const LAS bf16x8*)(uintptr_t)(pra0 + 2048u * q); p1[q] = *(const LAS bf16x8*)(uintptr_t)(pra1 + 2048u * q); }
#pragma unroll
                for (int q = 0; q < 4; ++q) {
                    if (dir == 0 || q < 2) { O[0][q] = MFMA16(p0[q], VB[0][0], O[0][q]); O[1][q] = MFMA16(p0[q], VB[1][0], O[1][q]); }
                    if (dir == 1 || q >= 2) { O[0][q] = MFMA16(p1[q], VB[0][1], O[0][q]); O[1][q] = MFMA16(p1[q], VB[1][1], O[1][q]); } }
#pragma unroll
                for (int j = 0; j < 2; ++j)
#pragma unroll
                    for (int q = 0; q < 4; ++q)
#pragma unroll
                        for (int r = 0; r < 4; ++r) *(LAS float*)(uintptr_t)(ola + 64u * j + 4u * (unsigned)((16 * q + r) * O_LD)) = O[j][q][r];
            }
#pragma unroll
            for (int kp = 0; kp < 4; ++kp) { bf16x8 A0, A1, A2, A3; const int kt = 2 * kp;
                const f32x4 g0 = *(const LAS f32x4*)(nb + 128 + 16 * kt + 4 * lg), g1 = *(const LAS f32x4*)(nb + 128 + 16 * (kt + 1) + 4 * lg);
                tr_frag4<M_AK>(lb + (tr0l ^ ((unsigned)kt << 5)), lb + (tr1l ^ ((unsigned)kt << 5)), lb + (tr0l ^ ((unsigned)(kt + 1) << 5)), lb + (tr1l ^ ((unsigned)(kt + 1) << 5)), A0, A1, A2, A3);
#pragma unroll
                for (int j = 0; j < 2; ++j) { S[j][kt] = MFMA16(A0, VB[j][0], S[j][kt]); S[j][kt + 1] = MFMA16(A2, VB[j][0], S[j][kt + 1]); }
#pragma unroll
                for (int j = 0; j < 2; ++j) { S[j][kt] = MFMA16(A1, VB[j][1], S[j][kt]); S[j][kt + 1] = MFMA16(A3, VB[j][1], S[j][kt + 1]); }
#pragma unroll
                for (int j = 0; j < 2; ++j) { S[j][kt] = S[j][kt] * g0; S[j][kt + 1] = S[j][kt + 1] * g1; } }
            LBAR();
            if (OUT) final_pass(m0, prevh);
        }
    } else {
        const int ht = F.tid - 256;
        const unsigned hoff = (unsigned)((ht >> 4) * 1024 + (ht & 15) * 8) * 2u;
        const unsigned aoff = (unsigned)(ht >> 4) * 32u + 4u, aoffl = (unsigned)(ht & 63) * 32u;
        const f32x2* ABd = wsp<f32x2>(F, WS_AB) + (size_t)dir * MT * 4 + h;
        const bf16* vbase = wsp<bf16>(F, model == 0 ? WS_VM : WS_VG) + h * 256 + half * 128;
        struct SR { u32x4 q[4], k[4], v[4]; float be[4]; f32x2 ab; float ge; };
        SR R;
        auto issue = [&](const int ic_) {
            const int c_ = seg_chunk(seg, dir, ic_), ci_ = seg < 0 ? 256 + b * 4 + c_ : b * 128 + c_, m0_ = chunk_row0(ci_);
            const unsigned char* abr = (const unsigned char*)(ABd + (size_t)m0_ * 4);
            { const float* abp = (const float*)(abr + aoffl); R.ab.x = abp[0]; R.ab.y = abp[1]; }
            const float* gp = model == 0 ? wsp<float>(F, WS_GENDM) + ((size_t)dir * NCHUNK + ci_) * 4 + h : wsp<float>(F, WS_GENDG) + ((size_t)dir * NCHUNK + ci_) * 512 + h * 128 + ((ht - 64) & 127);
            R.ge = *gp;
            const long long qoff = model == 0 ? (long long)WS_QKMC : (m0_ < M_LAT ? 0ll : (long long)WS_QKGTC + ((long long)dir * M_CTX - M_LAT) * 2048);
            const unsigned char* qbb = (model == 1 && m0_ < M_LAT) ? (const unsigned char*)F.out + (size_t)dir * M_LAT * 2048 : (const unsigned char*)F.ws + qoff;
            const unsigned char* qr = qbb + (size_t)m0_ * 2048 + h * 256;
            const unsigned char* vr = (const unsigned char*)(vbase + (size_t)m0_ * 1024);
#pragma unroll
            for (int i = 0; i < 4; ++i) { const unsigned o = hoff + (unsigned)i * 16u * 2048u;
                if (OUT) R.q[i] = *(const u32x4*)(qr + o);
                R.k[i] = *(const u32x4*)(qr + 1024 + o); R.v[i] = *(const u32x4*)(vr + o); R.be[i] = *(const float*)(abr + aoff + (unsigned)i * 16u * 32u); }
        };
        const int ti = sw;
        const unsigned fra = lb + L_N + 2048 + (li == 1 ? 128u : 0u) + 16u * lg;
        const unsigned nfa = lb + L_N + 2048 + 256 + (li == 1 ? 256u : 0u) + 16u * lg;
        issue(0);
        for (int ic = 0; ic < nch; ++ic) {
            const int m0 = chunk_m0(ic);
            if (model == 0 && ht < 64) { const float be = R.ab.y; nb[320 + ht] = R.ab.x;
                const unsigned hi = pkbf(be, be) & 0xffffu; nbh[ht] = (unsigned short)hi; nbh[64 + ht] = (unsigned short)(pkbf(be - bflo(hi), 0.f) & 0xffffu); }
            if (ht >= 64 && ht < 192) nb[128 + ht - 64] = R.ge;
#pragma unroll
            for (int i = 0; i < 4; ++i) { const int p = ht + i * 256, r = p >> 4, cp = p & 15;
                const unsigned o = offb(r, cp);
                if (OUT) *(LAS u32x4*)(lds + M_AQ + o) = R.q[i];
                *(LAS u32x4*)(lds + M_AK + o) = R.k[i];
                u32x4 v = R.v[i];
                if (model == 0) { const float be = R.be[i];
                    v.x = pkbf(bflo(v.x) * be, bfhi(v.x) * be); v.y = pkbf(bflo(v.y) * be, bfhi(v.y) * be); v.z = pkbf(bflo(v.z) * be, bfhi(v.z) * be); v.w = pkbf(bflo(v.w) * be, bfhi(v.w) * be); }
                *(LAS u32x4*)(lds + M_VP + o) = v; }
            LBAR();
            u32x4 prevh[2] = {{0u, 0u, 0u, 0u}, {0u, 0u, 0u, 0u}};
            if (OUT) {
#pragma unroll
                for (int i = 0; i < 2; ++i) prevh[i] = *(const u32x4*)((const unsigned char*)(HS + (size_t)m0 * 1024 + h * 256 + half * 128) + (i == 0 ? poff0 : poff1) * (unsigned)dir);
                ptile(ti, 0);
            }
            if (ic + 1 < nch) issue(ic + 1);
            unsigned rowl = rowb, tr0l = trb0, tr1l = trb1; asm volatile("" : "+v"(rowl), "+v"(tr0l), "+v"(tr1l));
            bf16x8 BB0, BB1;
            { u32x4 z = {0u, 0u, 0u, 0u}; BB0 = __builtin_bit_cast(bf16x8, z); BB1 = BB0; }
            if (model == 0) { u32x4 f0 = *(const LAS u32x4*)(uintptr_t)fra, f1 = *(const LAS u32x4*)(uintptr_t)(fra + 64u); const u32x4 z = {0u, 0u, 0u, 0u};
                if (li > 1) { f0 = z; f1 = z; } BB0 = __builtin_bit_cast(bf16x8, f0); BB1 = __builtin_bit_cast(bf16x8, f1); }
            f32x4 dq = {0.f, 0.f, 0.f, 0.f};
            if (OUT && model == 0) {
                bf16x8 pa[4]; u32x4 nf[4]; const u32x4 z = {0u, 0u, 0u, 0u};
#pragma unroll
                for (int kk = 0; kk < 4; ++kk) { pa[kk] = *(const LAS bf16x8*)(uintptr_t)(lb + (rowl ^ ((unsigned)kk << 6)) + M_AQ + 4096u * ti); nf[kk] = *(const LAS u32x4*)(uintptr_t)(nfa + 64u * kk); if (li > 1) nf[kk] = z; }
#pragma unroll
                for (int kk = 0; kk < 4; ++kk) dq = MFMA16(pa[kk], __builtin_bit_cast(bf16x8, nf[kk]), dq);
            }
            f32x4 nacc0 = {0.f, 0.f, 0.f, 0.f}, nacc1 = nacc0;
            if (model == 0) { bf16x8 A0, A1, A2, A3;
                tr_frag4<M_AK>(lb + (tr0l ^ ((unsigned)(2 * ti) << 5)), lb + (tr1l ^ ((unsigned)(2 * ti) << 5)), lb + (tr0l ^ ((unsigned)(2 * ti + 1) << 5)), lb + (tr1l ^ ((unsigned)(2 * ti + 1) << 5)), A0, A1, A2, A3);
                nacc0 = MFMA16(A0, BB0, nacc0); nacc0 = MFMA16(A1, BB1, nacc0); nacc1 = MFMA16(A2, BB0, nacc1); nacc1 = MFMA16(A3, BB1, nacc1); }
            float nnew[8] = {0.f, 0.f, 0.f, 0.f, 0.f, 0.f, 0.f, 0.f};
            if (model == 0) { const f32x4 no0 = *(const LAS f32x4*)(nb + 32 * ti + 4 * lg), no1 = *(const LAS f32x4*)(nb + 32 * ti + 16 + 4 * lg), gw0 = *(const LAS f32x4*)(nb + 128 + 32 * ti + 4 * lg), gw1 = *(const LAS f32x4*)(nb + 128 + 32 * ti + 16 + 4 * lg);
#pragma unroll
                for (int r = 0; r < 4; ++r) { nnew[r] = gw0[r] * (no0[r] + nacc0[r] + __shfl_xor(nacc0[r], 1)); nnew[4 + r] = gw1[r] * (no1[r] + nacc1[r] + __shfl_xor(nacc1[r], 1)); } }
            if (OUT) {
                LBAR();
                if (model == 0) { f32x4 dp = dq;
                    const bf16x8 p0 = *(const LAS bf16x8*)(uintptr_t)(pra0 + 2048u * ti), p1 = *(const LAS bf16x8*)(uintptr_t)(pra1 + 2048u * ti);
                    if (dir == 0 || ti < 2) dp = MFMA16(p0, BB0, dp);
                    if (dir == 1 || ti >= 2) dp = MFMA16(p1, BB1, dp);
#pragma unroll
                    for (int r = 0; r < 4; ++r) { const float v = dp[r] + __shfl_xor(dp[r], 1); const float al = nb[320 + 16 * ti + 4 * lg + r];
                        if (li == 0) nb[384 + 16 * ti + 4 * lg + r] = al / fmaxf(al * fabsf(v), 1.f); } }
            }
            LBAR();
            if (model == 0 && li == 0) {
#pragma unroll
                for (int j = 0; j < 2; ++j) { const int dk0 = 32 * ti + 16 * j + 4 * lg; const float* nn = nnew + 4 * j;
                    f32x4 nv = {nn[0], nn[1], nn[2], nn[3]}; *(LAS f32x4*)(nb + dk0) = nv;
                    u32x2 hv, lv; const unsigned h0 = pkbf(nn[0], nn[1]), h1 = pkbf(nn[2], nn[3]); hv.x = h0; hv.y = h1;
                    lv.x = pkbf(nn[0] - bflo(h0), nn[1] - bfhi(h0)); lv.y = pkbf(nn[2] - bflo(h1), nn[3] - bfhi(h1));
                    *(LAS u32x2*)(nbh + 128 + dk0) = hv; *(LAS u32x2*)(nbh + 256 + dk0) = lv; } }
            if (OUT) final_pass(m0, prevh);
        }
    }
}
__device__ __forceinline__ void p4m_scan_local(Frame& F) {
    LAS float* nb = (LAS float*)(F.lds + L_N);
    for (int it0 = F.bid; it0 < 32 * 8 * 2; it0 += F.G) {
        const int it = (F.G == 256) ? (it0 & ~255) | ((((((it0 & 255) >> 4) << 3) | (it0 & 7)) << 1) | ((it0 >> 3) & 1)) : it0;
        const int half = it & 1, slot = (it >> 1) & 7, sc = it >> 4, seg = slot - 1;
        const int dir = sc & 1, h = (sc >> 1) & 3, b = (sc >> 3) & 1, model = sc >> 4;
        f32x4 S[2][8];
#pragma unroll
        for (int j = 0; j < 2; ++j)
#pragma unroll
            for (int kt = 0; kt < 8; ++kt) S[j][kt] = (f32x4){0.f, 0.f, 0.f, 0.f};
        __syncthreads();
        if (F.tid < 128) nb[F.tid] = 0.f;
        float gacc = 1.f;
        mscan_run<false>(F, model, b, h, dir, half, seg, S, gacc);
        __syncthreads();
        if (F.wave < 4) {
#pragma unroll
            for (int j = 0; j < 2; ++j) { unsigned so = (unsigned)((2 * F.wave + j) * 512 + F.lane) * 8u; asm volatile("" : "+v"(so));
                bf16* st = (bf16*)((unsigned char*)mstate_ptr(F, sc, slot, half) + so);
#pragma unroll
                for (int kt = 0; kt < 8; ++kt) { u32x2 v; v.x = pkbf(S[j][kt][0], S[j][kt][1]); v.y = pkbf(S[j][kt][2], S[j][kt][3]); *(u32x2*)(st + kt * 256) = v; } } }
        if (half == 0 && F.tid < 128) { wsp<float>(F, WS_NST)[(sc * 8 + slot) * 128 + F.tid] = nb[F.tid]; wsp<float>(F, WS_GSEG)[(sc * 8 + slot) * 128 + F.tid] = gacc; }
    }
}
__device__ __forceinline__ void p5m_scan_out(Frame& F) {
    LAS float* nb = (LAS float*)(F.lds + L_N);
    for (int it0 = F.bid; it0 < 2 * 2 * 4 * 8 * 2; it0 += F.G) {
        const int it = (F.G == 256) ? ((((it0 >> 4) << 3) | (it0 & 7)) << 1) | ((it0 >> 3) & 1) : it0;
        const int half = it & 1, seg = (it >> 1) & 7, h = (it >> 4) & 3, b = (it >> 6) & 1, model = it >> 7;
        for (int dir = 0; dir < 2; ++dir) {
            const int sc = ((model * 2 + b) * 4 + h) * 2 + dir, s = dir == 0 ? seg : 7 - seg;
            f32x4 S[2][8];
#pragma unroll
            for (int j = 0; j < 2; ++j)
#pragma unroll
                for (int kt = 0; kt < 8; ++kt) S[j][kt] = (f32x4){0.f, 0.f, 0.f, 0.f};
            float nn = 0.f;
            for (int slot = 0; slot <= s; ++slot) {
                const float* gs = wsp<float>(F, WS_GSEG) + (sc * 8 + slot) * 128;
                const float gv = gs[F.tid & 127], nv = wsp<float>(F, WS_NST)[(sc * 8 + slot) * 128 + (F.tid & 127)];
                if (F.wave < 4) {
                    f32x4 gv4[8];
#pragma unroll
                    for (int kt = 0; kt < 8; ++kt) gv4[kt] = *(const f32x4*)(gs + 16 * kt + 4 * (F.lane >> 4));
#pragma unroll
                    for (int j = 0; j < 2; ++j) { unsigned so = (unsigned)((2 * F.wave + j) * 512 + F.lane) * 8u; asm volatile("" : "+v"(so));
                        const bf16* stp = (const bf16*)((const unsigned char*)mstate_ptr(F, sc, slot, half) + so);
                        u32x2 sv[8];
#pragma unroll
                        for (int kt = 0; kt < 8; ++kt) sv[kt] = *(const u32x2*)(stp + kt * 256);
#pragma unroll
                        for (int kt = 0; kt < 8; ++kt) { const u32x2 v = sv[kt]; f32x4 g4 = gv4[kt]; if (slot == 0) g4 = (f32x4){0.f, 0.f, 0.f, 0.f};
                            S[j][kt][0] = g4[0] * S[j][kt][0] + bflo(v.x); S[j][kt][1] = g4[1] * S[j][kt][1] + bfhi(v.x); S[j][kt][2] = g4[2] * S[j][kt][2] + bflo(v.y); S[j][kt][3] = g4[3] * S[j][kt][3] + bfhi(v.y); } } }
                nn = (slot > 0 ? gv : 0.f) * nn + nv; }
            __syncthreads();
            if (F.tid < 128) { nb[F.tid] = nn; LAS unsigned short* nbh = (LAS unsigned short*)(F.lds + L_N + 2048);
                const unsigned hi = pkbf(nn, nn) & 0xffffu; nbh[128 + F.tid] = (unsigned short)hi; nbh[256 + F.tid] = (unsigned short)(pkbf(nn - bflo(hi), 0.f) & 0xffffu); }
            float gacc = 1.f;
            mscan_run<true>(F, model, b, h, dir, half, s, S, gacc);
        }
    }
}

struct EpiProjB {
    unsigned char* ws; const float* ml_norm; const float* gla_norm;
    __device__ __forceinline__ void operator()(const f32x4 (&acc)[2][2][4][2], const Unit& u, int wr, int wc, int fr, int fq) const {
        const int row0 = u.pm * 256 + wr * 64 + fr, colt = (u.pn & 3) * 256 + wc * 32 + 8 * fq;
        if (u.pn < 8) {
            const int model = u.pn >> 2, head = u.pn & 3;
            bf16* base = (bf16*)(ws + (model == 0 ? WS_QKM : WS_QKG)) + colt;
            const float* nw = (model == 0 ? ml_norm : gla_norm) + colt;
            const float* ssq = (const float*)(ws + WS_SSQ);
            const float gsel = model == 0 ? 0.f : 1.f;
            f32x4 nwv[2][2];
#pragma unroll
            for (int bj = 0; bj < 2; ++bj) { nwv[bj][0] = *(const f32x4*)(nw + bj * 128); nwv[bj][1] = *(const f32x4*)(nw + bj * 128 + 4); }
            u32x4 hvq[8][2]; f32x2 sqq[8];
#define EPB_ISSUE(g) do { const int row_ = row0 + ((g) >> 2) * 128 + ((g) & 3) * 16; const bf16* rp_ = base + (size_t)row_ * 1024; hvq[g][0] = *(const u32x4*)rp_; hvq[g][1] = *(const u32x4*)(rp_ + 128); \
                sqq[g] = *(const f32x2*)(ssq + ((size_t)row_ * 8 + model * 4 + head) * 2); } while (0)
            EPB_ISSUE(0); EPB_ISSUE(1); EPB_ISSUE(2); EPB_ISSUE(3);
#pragma unroll
            for (int g = 0; g < 8; ++g) { const int ai = g >> 2, m = g & 3;
                __builtin_amdgcn_sched_barrier(0);
                if (g == 1) { EPB_ISSUE(4); EPB_ISSUE(5); }
                if (g == 2) { EPB_ISSUE(6); EPB_ISSUE(7); }
                __builtin_amdgcn_sched_barrier(0);
                const int row = row0 + ai * 128 + m * 16; bf16* rowp = base + (size_t)row * 1024;
                const float rstd = 1.f / sqrtf((sqq[g].x + sqq[g].y) * (1.f / 256.f) + EPS);
                float one = 1.f; asm volatile("" : "+v"(one));
#pragma unroll
                for (int bj = 0; bj < 2; ++bj) { const f32x4 a0 = acc[ai][bj][m][0] * one, a1 = acc[ai][bj][m][1] * one;
                    const f32x4 n0 = nwv[bj][0], n1 = nwv[bj][1];
                    float hvf[8]; unpack8(hvq[g][bj], hvf); float o[8];
#pragma unroll
                    for (int j = 0; j < 4; ++j) { const float s0 = sigm(a0[j]), s1 = sigm(a1[j]);
                        o[j] = hvf[j] * rstd * n0[j] * (s0 + gsel * (s0 * a0[j] - s0)); o[4 + j] = hvf[4 + j] * rstd * n1[j] * (s1 + gsel * (s1 * a1[j] - s1)); }
                    u32x4 w; w.x = cvt_pk_bf16(o[0], o[1]); w.y = cvt_pk_bf16(o[2], o[3]); w.z = cvt_pk_bf16(o[4], o[5]); w.w = cvt_pk_bf16(o[6], o[7]);
                    *(u32x4*)(rowp + bj * 128) = w; } }
#undef EPB_ISSUE
        } else {
            bf16* base = (bf16*)(ws + (u.pn < 12 ? WS_VG : WS_QKMC)) + colt;
#pragma unroll
            for (int ai = 0; ai < 2; ++ai)
#pragma unroll
                for (int m = 0; m < 4; ++m) { bf16* rowp = base + (size_t)(row0 + ai * 128 + m * 16) * 1024;
#pragma unroll
                    for (int bj = 0; bj < 2; ++bj) { const f32x4 a0 = acc[ai][bj][m][0], a1 = acc[ai][bj][m][1];
                        u32x4 w; w.x = pkbf(sigm(a0[0]), sigm(a0[1])); w.y = pkbf(sigm(a0[2]), sigm(a0[3])); w.z = pkbf(sigm(a1[0]), sigm(a1[1])); w.w = pkbf(sigm(a1[2]), sigm(a1[3]));
                        *(u32x4*)(rowp + bj * 128) = w; } }
        }
    }
};
template <int STEP> struct EpiGate {
    unsigned char* ws;
    __device__ __forceinline__ void operator()(const f32x4 (&acc)[2][2][4][2], const Unit& u, int wr, int wc, int fr, int fq) const {
        const int row0 = u.pm * 256 + wr * 64 + fr, colt = u.pn * 256 + wc * 32 + 8 * fq;
        const bf16* sg = (const bf16*)(ws + (STEP == 0 ? WS_VG : WS_QKMC)) + colt; bf16* ty = (bf16*)(ws + WS_VM) + colt;
#pragma unroll
        for (int ai = 0; ai < 2; ++ai)
#pragma unroll
            for (int m = 0; m < 4; ++m) { const size_t ro = (size_t)(row0 + ai * 128 + m * 16) * 1024;
#pragma unroll
                for (int bj = 0; bj < 2; ++bj) { const f32x4 a0 = acc[ai][bj][m][0], a1 = acc[ai][bj][m][1];
                    const u32x4 s = *(const u32x4*)(sg + ro + bj * 128);
                    float r[8] = {bflo(s.x) * a0[0], bfhi(s.x) * a0[1], bflo(s.y) * a0[2], bfhi(s.y) * a0[3], bflo(s.z) * a1[0], bfhi(s.z) * a1[1], bflo(s.w) * a1[2], bfhi(s.w) * a1[3]};
                    if (STEP == 1) { const u32x4 t = *(const u32x4*)(ty + ro + bj * 128);
                        r[0] += bflo(t.x); r[1] += bfhi(t.x); r[2] += bflo(t.y); r[3] += bfhi(t.y); r[4] += bflo(t.z); r[5] += bfhi(t.z); r[6] += bflo(t.w); r[7] += bfhi(t.w); }
                    u32x4 w; w.x = cvt_pk_bf16(r[0], r[1]); w.y = cvt_pk_bf16(r[2], r[3]); w.z = cvt_pk_bf16(r[4], r[5]); w.w = cvt_pk_bf16(r[6], r[7]);
                    *(u32x4*)(ty + ro + bj * 128) = w; } }
    }
};
struct EpiOut {
    const float* x; float* out; const float* modv;
    __device__ __forceinline__ void operator()(const f32x4 (&acc)[2][2][4][2], const Unit& u, int wr, int wc, int fr, int fq) const {
        const int row0 = u.pm * 256 + wr * 64 + fr, colt = u.pn * 256 + wc * 32 + 8 * fq;
        const float* gt = modv + ((u.pm * 256) >> 13) * 6144 + 2048 + colt;
#pragma unroll
        for (int bj = 0; bj < 2; ++bj) { const f32x4 g0 = *(const f32x4*)(gt + bj * 128), g1 = *(const f32x4*)(gt + bj * 128 + 4);
#pragma unroll
            for (int ai = 0; ai < 2; ++ai)
#pragma unroll
                for (int m = 0; m < 4; ++m) { const size_t off = (size_t)(row0 + ai * 128 + m * 16) * 1024 + colt + bj * 128;
                    *(f32x4*)(out + off) = *(const f32x4*)(x + off) + g0 * acc[ai][bj][m][0]; *(f32x4*)(out + off + 4) = *(const f32x4*)(x + off + 4) + g1 * acc[ai][bj][m][1]; } }
    }
};

__device__ __forceinline__ void p9_route(Frame& F) {
    PMARK0(40)
    const float* modv = wsp<float>(F, WS_MODV);
    constexpr int WP = 1032;
    LAS unsigned short* Wt = (LAS unsigned short*)F.lds;
    LAS int* hist = (LAS int*)(F.lds + 40 * WP * 2 + 16384);
    if (F.tid < 32) hist[F.tid] = 0;
    const int li = F.lane & 15, lg = F.lane >> 4;
    const int tp = F.wave >> 1, hf = F.wave & 1;
    f32x4 xa[16], xb[16];
    { const int tg0 = F.bid < M_LAT / 64 ? F.bid : 0; const float* src0 = F.out + (size_t)(64 * tg0 + 16 * tp + li) * D + hf * 512 + 8 * lg;
#pragma unroll
      for (int ks = 0; ks < 16; ++ks) { xa[ks] = *(const f32x4*)(src0 + 32 * ks); xb[ks] = *(const f32x4*)(src0 + 32 * ks + 4); } }
    for (int k = F.tid; k < 1024; k += NTHR) {
        const f32x4 wg = *(const f32x4*)(F.w_grp + (size_t)k * 4), w0 = *(const f32x4*)(F.w_rexp + (size_t)k * 16), w1 = *(const f32x4*)(F.w_rexp + (size_t)k * 16 + 4), w2 = *(const f32x4*)(F.w_rexp + (size_t)k * 16 + 8), w3 = *(const f32x4*)(F.w_rexp + (size_t)k * 16 + 12);
        const float wv[20] = {wg[0], wg[1], wg[2], wg[3], w0[0], w0[1], w0[2], w0[3], w1[0], w1[1], w1[2], w1[3], w2[0], w2[1], w2[2], w2[3], w3[0], w3[1], w3[2], w3[3]};
#pragma unroll
        for (int n = 0; n < 20; ++n) { const unsigned hi = pkbf(wv[n], 0.f) & 0xffffu; Wt[n * WP + k] = (unsigned short)hi; Wt[(20 + n) * WP + k] = (unsigned short)(pkbf(wv[n] - bflo(hi), 0.f) & 0xffffu); } }
    __syncthreads();
    int* rexp = (int*)(F.ws + WS_ROUTE + RT_EXP); float* rw = (float*)(F.ws + WS_ROUTE + RT_W); int* rpos = (int*)(F.ws + WS_ROUTE + RT_POS);
    const int n1 = 16 + li < 20 ? 16 + li : 19;
    LAS float* gco = (LAS float*)(F.lds + 40 * WP * 2 + 16384 + 256);
    LAS float* shv = gco + 1024;
    LAS float* ssh = shv + 1024;
    LAS float* lgall = (LAS float*)(F.lds + 40 * WP * 2);
    for (int tg = F.bid; tg < M_LAT / 64; tg += F.G) {
        const int mrow0 = 64 * tg, m = mrow0 + 16 * tp + li;
        const float* mvb = modv + (mrow0 >> 13) * 6144;
        __syncthreads();
        for (int c = F.tid; c < 1024; c += NTHR) { gco[c] = F.g_norm2[c] * (mvb[4096 + c] + 1.f); shv[c] = mvb[3072 + c]; }
        if (tg != F.bid) {
            const float* src = F.out + (size_t)m * D + hf * 512 + 8 * lg;
#pragma unroll
            for (int ks = 0; ks < 16; ++ks) { xa[ks] = *(const f32x4*)(src + 32 * ks); xb[ks] = *(const f32x4*)(src + 32 * ks + 4); } }
        float ss = 0.f;
#pragma unroll
        for (int ks = 0; ks < 16; ++ks) { const f32x4 a = xa[ks], c = xb[ks]; ss += (a.x * a.x + a.y * a.y) + (a.z * a.z + a.w * a.w) + (c.x * c.x + c.y * c.y) + (c.z * c.z + c.w * c.w); }
        ss += __shfl_xor(ss, 16); ss += __shfl_xor(ss, 32);
        if (lg == 0) ssh[F.wave * 16 + li] = ss;
        __syncthreads();
        const float rstd = 1.f / sqrtf((ssh[F.wave * 16 + li] + ssh[(F.wave ^ 1) * 16 + li]) * (1.f / D) + EPS);
        f32x4 acc0 = {0.f, 0.f, 0.f, 0.f}, acc1 = acc0;
        bf16* o = wsp<bf16>(F, WS_H2) + (size_t)m * D + hf * 512 + 8 * lg;
#pragma unroll
        for (int ks = 0; ks < 16; ++ks) { const int c = hf * 512 + 32 * ks + 8 * lg;
            const f32x4 ga = *(const LAS f32x4*)(gco + c), gb = *(const LAS f32x4*)(gco + c + 4), sha = *(const LAS f32x4*)(shv + c), shb = *(const LAS f32x4*)(shv + c + 4);
            const f32x4 ha = (xa[ks] * rstd) * ga + sha, hb = (xb[ks] * rstd) * gb + shb;
            u32x4 hi; hi.x = pkbf(ha[0], ha[1]); hi.y = pkbf(ha[2], ha[3]); hi.z = pkbf(hb[0], hb[1]); hi.w = pkbf(hb[2], hb[3]);
            u32x4 lo; lo.x = pkbf(ha[0] - bflo(hi.x), ha[1] - bfhi(hi.x)); lo.y = pkbf(ha[2] - bflo(hi.y), ha[3] - bfhi(hi.y)); lo.z = pkbf(hb[0] - bflo(hi.z), hb[1] - bfhi(hi.z)); lo.w = pkbf(hb[2] - bflo(hi.w), hb[3] - bfhi(hi.w));
            *(u32x4*)(o + 32 * ks) = hi;
            const bf16x8 Ah = __builtin_bit_cast(bf16x8, hi), Al = __builtin_bit_cast(bf16x8, lo);
            const bf16x8 bh0 = *(const LAS bf16x8*)(Wt + li * WP + c), bh1 = *(const LAS bf16x8*)(Wt + n1 * WP + c), bl0 = *(const LAS bf16x8*)(Wt + (20 + li) * WP + c), bl1 = *(const LAS bf16x8*)(Wt + (20 + n1) * WP + c);
            acc0 = __builtin_amdgcn_mfma_f32_16x16x32_bf16(Ah, bh0, acc0, 0, 0, 0); acc1 = __builtin_amdgcn_mfma_f32_16x16x32_bf16(Ah, bh1, acc1, 0, 0, 0);
            acc0 = __builtin_amdgcn_mfma_f32_16x16x32_bf16(Al, bh0, acc0, 0, 0, 0); acc1 = __builtin_amdgcn_mfma_f32_16x16x32_bf16(Al, bh1, acc1, 0, 0, 0);
            acc0 = __builtin_amdgcn_mfma_f32_16x16x32_bf16(Ah, bl0, acc0, 0, 0, 0); acc1 = __builtin_amdgcn_mfma_f32_16x16x32_bf16(Ah, bl1, acc1, 0, 0, 0); }
        LAS float* lgs = lgall + F.wave * 512;
#pragma unroll
        for (int r = 0; r < 4; ++r) { lgs[(4 * lg + r) * 32 + li] = acc0[r]; lgs[(4 * lg + r) * 32 + 16 + li] = acc1[r]; }
        __syncthreads();
        if (hf == 0 && F.lane < 16) {
            const int mr = mrow0 + 16 * tp + F.lane;
            const LAS float* l0 = lgs + F.lane * 32; const LAS float* l1 = l0 + 512;
            const f32x4 lq0 = *(const LAS f32x4*)(l0) + *(const LAS f32x4*)(l1), lq1 = *(const LAS f32x4*)(l0 + 4) + *(const LAS f32x4*)(l1 + 4), lq2 = *(const LAS f32x4*)(l0 + 8) + *(const LAS f32x4*)(l1 + 8),
                        lq3 = *(const LAS f32x4*)(l0 + 12) + *(const LAS f32x4*)(l1 + 12), lq4 = *(const LAS f32x4*)(l0 + 16) + *(const LAS f32x4*)(l1 + 16);
            const f32x4 bg = *(const f32x4*)F.b_grp;
            float gl[4] = {lq0[0] + bg[0], lq0[1] + bg[1], lq0[2] + bg[2], lq0[3] + bg[3]};
            int grp = 0; float gmax = gl[0];
#pragma unroll
            for (int q = 1; q < 4; ++q) if (gl[q] > gmax) { gmax = gl[q]; grp = q; }
            float gs = 0.f;
#pragma unroll
            for (int q = 0; q < 4; ++q) gs += expf(gl[q] - gmax);
            const float grp_p = 1.f / gs;
            float el[4];
#pragma unroll
            for (int q = 0; q < 4; ++q) { float v = lq1[q]; v = grp == 1 ? lq2[q] : v; v = grp == 2 ? lq3[q] : v; v = grp == 3 ? lq4[q] : v; asm volatile("" : "+v"(v)); el[q] = v + F.b_rexp[grp * 4 + q]; }
            int i0 = 0; float e0v = el[0];
#pragma unroll
            for (int q = 1; q < 4; ++q) if (el[q] > e0v) { e0v = el[q]; i0 = q; }
            int i1 = -1; float e1v = -3.0e38f;
#pragma unroll
            for (int q = 0; q < 4; ++q) if (q != i0 && el[q] > e1v) { e1v = el[q]; i1 = q; }
            const float e1 = expf(e1v - e0v); const float w0 = grp_p / (1.f + e1), w1 = grp_p * e1 / (1.f + e1);
            const int x0 = grp * 4 + i0, x1 = grp * 4 + i1;
            rexp[2 * mr] = x0; rexp[2 * mr + 1] = x1; rw[2 * mr] = w0; rw[2 * mr + 1] = w1;
            rpos[2 * mr] = __hip_atomic_fetch_add(hist + x0, 1, __ATOMIC_RELAXED, __HIP_MEMORY_SCOPE_WORKGROUP);
            rpos[2 * mr + 1] = __hip_atomic_fetch_add(hist + x1, 1, __ATOMIC_RELAXED, __HIP_MEMORY_SCOPE_WORKGROUP);
        }
    }
    __syncthreads();
    if (F.tid < 16) hist[16 + F.tid] = (int)__hip_atomic_fetch_add((unsigned*)(F.ws + WS_CTL) + CW_CNT + 64 * F.tid, (unsigned)hist[F.tid], __ATOMIC_RELAXED, __HIP_MEMORY_SCOPE_AGENT);
    __syncthreads();
    VM_WAIT();
    for (int tg = F.bid; tg < M_LAT / 64; tg += F.G) if (F.tid < 128) { const int a = 128 * tg + F.tid, e = rexp[a], pos = rpos[a] + hist[16 + e]; rpos[a] = pos;
        wsp<int>(F, WS_LTOK)[e * LCAP + pos] = a >> 1; wsp<float>(F, WS_LW)[e * LCAP + pos] = rw[a]; }
    __syncthreads();
    PMARK1(40)
    PMARK0(41)
    moe_weight_copies<0>(F);
    PMARK1(41)
}
__device__ __forceinline__ void moe_layout(Frame& F) {
    LAS int* tab = (LAS int*)(F.lds + LDS_TAB);
    if (F.tid < 64) {
        const int e = F.tid & 15;
        const int c = (int)__hip_atomic_load((unsigned*)(F.ws + WS_CTL) + CW_CNT + 64 * e, __ATOMIC_RELAXED, __HIP_MEMORY_SCOPE_AGENT);
        const int pad = (c + 255) & ~255;
        int incl = pad;
#pragma unroll
        for (int o = 1; o < 16; o <<= 1) { const int t = __shfl_up(incl, o); if ((F.tid & 63) >= o) incl += t; }
        if (F.tid < 16) { tab[e] = incl - pad; tab[32 + e] = c; if (e == 15) { tab[16] = incl; tab[17] = incl >> 8; } }
    }
    __syncthreads();
}
struct EpiUp {
    unsigned char* ws;
    __device__ __forceinline__ void operator()(const f32x4 (&acc)[2][2][4][2], const Unit& u, int wr, int wc, int fr, int fq) const {
        const int row0 = u.pm * 256 + wr * 64 + fr; bf16* base = (bf16*)(ws + WS_HID) + u.pn * 128 + wc * 32 + 8 * fq;
#pragma unroll
        for (int ai = 0; ai < 2; ++ai)
#pragma unroll
            for (int m = 0; m < 4; ++m) { const f32x4 g0 = acc[ai][0][m][0], g1 = acc[ai][0][m][1], u0 = acc[ai][1][m][0], u1 = acc[ai][1][m][1];
                u32x4 w; w.x = cvt_pk_bf16(siluf(g0[0]) * u0[0], siluf(g0[1]) * u0[1]); w.y = cvt_pk_bf16(siluf(g0[2]) * u0[2], siluf(g0[3]) * u0[3]);
                w.z = cvt_pk_bf16(siluf(g1[0]) * u1[0], siluf(g1[1]) * u1[1]); w.w = cvt_pk_bf16(siluf(g1[2]) * u1[2], siluf(g1[3]) * u1[3]);
                *(u32x4*)(base + (size_t)(row0 + ai * 128 + m * 16) * 512) = w; }
    }
};
struct EpiDown {
    unsigned char* ws; const LAS int* tab;
    __device__ __forceinline__ void operator()(const f32x4 (&acc)[2][2][4][2], const Unit& u, int wr, int wc, int fr, int fq) const {
        const int row0 = u.pm * 256 + wr * 64 + fr; bf16* base = (bf16*)(ws + WS_YROWS) + u.pn * 256 + wc * 32 + 8 * fq;
        const float* lw = (const float*)(ws + WS_LW) + u.e * LCAP - tab[u.e];
#pragma unroll
        for (int ai = 0; ai < 2; ++ai)
#pragma unroll
            for (int m = 0; m < 4; ++m) { const int row = row0 + ai * 128 + m * 16; const float rwt = lw[row];
#pragma unroll
                for (int bj = 0; bj < 2; ++bj) { const f32x4 v0 = acc[ai][bj][m][0] * rwt, v1 = acc[ai][bj][m][1] * rwt;
                    u32x4 w; w.x = cvt_pk_bf16(v0[0], v0[1]); w.y = cvt_pk_bf16(v0[2], v0[3]); w.z = cvt_pk_bf16(v1[0], v1[1]); w.w = cvt_pk_bf16(v1[2], v1[3]);
                    *(u32x4*)(base + (size_t)row * 1024 + bj * 128) = w; } }
    }
};
__device__ __forceinline__ void p13_final(Frame& F) {
    moe_layout(F);
    const LAS int* tab = (const LAS int*)(F.lds + LDS_TAB);
    const float* modv = wsp<float>(F, WS_MODV); const int* rpos = (const int*)(F.ws + WS_ROUTE + RT_POS); const int* rexp = (const int*)(F.ws + WS_ROUTE + RT_EXP); const bf16* Y = wsp<bf16>(F, WS_YROWS);
    const int gw = F.bid * NW + F.wave, NGW = F.G * NW;
    LAS float* gtl = (LAS float*)F.lds; LAS float* gfl = gtl + 2048;
    for (int i = F.tid; i < 3072; i += NTHR) { if (i < 2048) gtl[i] = modv[(i >> 10) * 6144 + 5120 + (i & 1023)]; else gfl[i - 2048] = F.g_final[i - 2048]; }
    __syncthreads();
    constexpr int RPT = 8;
    for (int m0 = gw; m0 < M_LAT; m0 += RPT * NGW) {
        int e0[RPT], e1[RPT], q0[RPT], q1[RPT]; f32x4 xr[RPT][4];
#pragma unroll
        for (int k = 0; k < RPT; ++k) { const int m = m0 + k * NGW < M_LAT ? m0 + k * NGW : m0; e0[k] = rexp[2 * m]; e1[k] = rexp[2 * m + 1]; q0[k] = rpos[2 * m]; q1[k] = rpos[2 * m + 1]; }
#pragma unroll
        for (int k = 0; k < RPT; ++k) { const int m = m0 + k * NGW < M_LAT ? m0 + k * NGW : m0; const float* row = F.out + (size_t)m * D;
#pragma unroll
            for (int j = 0; j < 4; ++j) xr[k][j] = *(const f32x4*)(row + 4 * F.lane + 256 * j); }
#pragma unroll
        for (int hh = 0; hh < RPT / 4; ++hh) {
            u32x2 ya[4][4], yb[4][4];
#pragma unroll
            for (int kk = 0; kk < 4; ++kk) { const int k = 4 * hh + kk;
                const bf16* y0 = Y + (size_t)(tab[e0[k]] + q0[k]) * 1024; const bf16* y1 = Y + (size_t)(tab[e1[k]] + q1[k]) * 1024;
#pragma unroll
                for (int j = 0; j < 4; ++j) { const int c = 4 * F.lane + 256 * j; ya[kk][j] = *(const u32x2*)(y0 + c); yb[kk][j] = *(const u32x2*)(y1 + c); } }
            __builtin_amdgcn_sched_barrier(0);
#pragma unroll
            for (int kk = 0; kk < 4; ++kk) { const int k = 4 * hh + kk, m = m0 + k * NGW;
                if (m < M_LAT) {
                    float* row = F.out + (size_t)m * D; const LAS float* gt = gtl + (m >> 13) * 1024;
                    f32x4 v[4]; float sq = 0.f;
#pragma unroll
                    for (int j = 0; j < 4; ++j) { const int c = 4 * F.lane + 256 * j; const u32x2 a = ya[kk][j], bq = yb[kk][j]; const f32x4 g = *(const LAS f32x4*)(gt + c);
                        f32x4 yy; yy.x = bflo(a.x) + bflo(bq.x); yy.y = bfhi(a.x) + bfhi(bq.x); yy.z = bflo(a.y) + bflo(bq.y); yy.w = bfhi(a.y) + bfhi(bq.y);
                        v[j] = xr[k][j] + g * yy; sq += (v[j].x * v[j].x + v[j].y * v[j].y) + (v[j].z * v[j].z + v[j].w * v[j].w); }
                    const float rstd = 1.f / sqrtf(wave_sum(sq) * (1.f / D) + EPS);
#pragma unroll
                    for (int j = 0; j < 4; ++j) { const int c = 4 * F.lane + 256 * j; *(f32x4*)(row + c) = (v[j] * rstd) * *(const LAS f32x4*)(gfl + c); } } }
        }
    }
}

typedef const Args __attribute__((address_space(4))) * KArgsP;
__device__ __forceinline__ void load_inputs(Frame& F) {
    KArgsP ap = (KArgsP)__builtin_amdgcn_kernarg_segment_ptr();
    asm volatile("" : "+s"(ap));
    F.x = ap->in[0]; F.c = ap->in[1]; F.ctx = ap->in[2]; F.c_ctx = ap->in[3]; F.w_mod = ap->in[4]; F.b_mod = ap->in[5]; F.g_norm1 = ap->in[6]; F.w_in = ap->in[7];
    F.ml_conv = ap->in[8]; F.ml_conv_b = ap->in[9]; F.b_mgate = ap->in[10]; F.ml_norm = ap->in[11]; F.gla_w2 = ap->in[12]; F.gla_b2 = ap->in[13]; F.gla_norm = ap->in[14];
    F.w_proj_m = ap->in[15]; F.w_proj_g = ap->in[16]; F.w_out = ap->in[17]; F.g_norm2 = ap->in[18]; F.w_grp = ap->in[19]; F.b_grp = ap->in[20]; F.w_rexp = ap->in[21]; F.b_rexp = ap->in[22];
    F.w_up = ap->in[23]; F.w_down = ap->in[24]; F.g_final = ap->in[25];
    F.ws = ap->ws; F.out = ap->out;
    int ln = (int)__builtin_amdgcn_mbcnt_hi(~0u, __builtin_amdgcn_mbcnt_lo(~0u, 0u)); asm volatile("" : "+v"(ln)); F.lane = ln; F.tid = F.wave * 64 + ln;
}
constexpr int N_PHASES = 14;
__global__ void __launch_bounds__(NTHR, 2) mk_fwd(Args args) {
    extern __shared__ __attribute__((aligned(16))) unsigned char lds[];
    Frame F;
    F.lds = (LAS unsigned char*)lds; F.MISC = (volatile LAS unsigned*)(F.lds + MISC_OFF);
    F.tid = threadIdx.x; F.lane = F.tid & 63; F.wave = __builtin_amdgcn_readfirstlane(F.tid >> 6); F.G = gridDim.x; F.bid = blockIdx.x;
    F.ws = args.ws; F.out = args.out;
    for (int u = F.tid; u < (LDS_BYTES - LDSCTL_OFF) / 4; u += NTHR) ((LAS unsigned*)(F.lds + LDSCTL_OFF))[u] = 0u;
    __syncthreads();
    const int lo = args.ph_lo, hi = args.ph_hi;
    XcdBarrier bar; bar.bar = (unsigned*)(F.ws + WS_CTL) + CW_BAR; bar.x = 0; bar.st = nullptr;
    if (hi - lo > 1) bar = xcd_barrier_post((unsigned*)(F.ws + WS_CTL) + CW_BAR, F.MISC + 8);
#ifndef PH_MASK
#define PH_MASK 0xFFFF
#endif
#define IN(k) (((PH_MASK >> (k)) & 1) && lo <= (k) && (k) < hi)
#define REPS(k) for (int rep_ = 0; rep_ < (((REP_MASK >> (k)) & 1) ? 2 : 1); ++rep_)
#define SEAM(k) do { if (IN(k) && IN((k) + 1)) xcd_barrier(bar, F.tid); } while (0)
    const int vc = (int)blockIdx.x;
#ifdef PROBE_SEL
    unsigned long long pt0_ = 0, pdur_ = 0;
#define PH_BEGIN(k) do { if ((k) == PROBE_SEL % 20) pt0_ = __builtin_amdgcn_s_memrealtime(); if (F.tid == 0) { F.MISC[64] = ((k) == PROBE_SEL % 20) ? 1u : 0u; if ((k) == 0) F.MISC[65] = 0u; } } while (0)
#define PH_END(k) do { if ((k) == PROBE_SEL % 20) pdur_ = __builtin_amdgcn_s_memrealtime() - pt0_; } while (0)
#else
#define PH_BEGIN(k) do { } while (0)
#define PH_END(k) do { } while (0)
#endif
    if (IN(0)) REPS(0) { load_inputs(F); PH_BEGIN(0); p0_prologue(F); SEAM(0); PH_END(0); }
    if (IN(1)) REPS(1) { load_inputs(F); PH_BEGIN(1); { PMARK0(43) p1_hx(F); PMARK1(43) } { PMARK0(44) p0_weight_copies<0>(F); PMARK1(44) } { PMARK0(45) SEAM(1); PMARK1(45) } PH_END(1); }
    if (IN(2)) REPS(2) { load_inputs(F); PH_BEGIN(2); pg8::DenseSched S; S.init(wsp<bf16>(F, WS_HX), wsp<bf16>(F, WS_WA), MT, NA, D, F.G, vc); EpiProjA E{F.ws, F.b_mgate};
        pg8::gemm_phase<EpiProjA, pg8::DenseSched, true>(F.lds, S, E, F.wave); p0_weight_copies<1>(F, F.G == 256 ? (MT / 256) * (NA / 256) % 256 : 0); SEAM(2); PH_END(2); }
    if (IN(3)) REPS(3) { load_inputs(F); PH_BEGIN(3); { PMARK0(53) p3_prep(F); PMARK1(53) } { PMARK0(49) SEAM(3); PMARK1(49) } PH_END(3); }
#if SCAN_SCALAR
    if (IN(4)) REPS(4) { load_inputs(F); PH_BEGIN(4); p4_scan_local(F); SEAM(4); PH_END(4); }
    if (IN(5)) REPS(5) { load_inputs(F); PH_BEGIN(5); p5_scan_out(F); SEAM(5); PH_END(5); }
#else
    if (IN(4)) REPS(4) { load_inputs(F); PH_BEGIN(4); p4m_scan_local(F); SEAM(4); PH_END(4); }
    if (IN(5)) REPS(5) { load_inputs(F); PH_BEGIN(5); p5m_scan_out(F); SEAM(5); PH_END(5); }
#endif
    if (IN(6)) REPS(6) { load_inputs(F); PH_BEGIN(6); pg8::DenseSched S; S.init(wsp<bf16>(F, WS_HX), wsp<bf16>(F, WS_WB), M_LAT, NB, D, F.G, vc); EpiProjB E{F.ws, F.ml_norm, F.gla_norm};
        pg8::gemm_phase<EpiProjB, pg8::DenseSched, true>(F.lds, S, E, F.wave); SEAM(6); PH_END(6); }
    if (IN(7)) REPS(7) { load_inputs(F); PH_BEGIN(7);
        { pg8::DenseSched S; S.init(wsp<bf16>(F, WS_QKM), wsp<bf16>(F, WS_WPM), M_LAT, D, D, F.G, vc); EpiGate<0> E{F.ws}; pg8::gemm_phase<EpiGate<0>, pg8::DenseSched, false>(F.lds, S, E, F.wave); }
        VM_WAIT(); __syncthreads();
        { pg8::DenseSched S; S.init(wsp<bf16>(F, WS_QKG), wsp<bf16>(F, WS_WPG), M_LAT, D, D, F.G, vc); EpiGate<1> E{F.ws}; pg8::gemm_phase<EpiGate<1>, pg8::DenseSched, false>(F.lds, S, E, F.wave); }
        SEAM(7); PH_END(7); }
    if (IN(8)) REPS(8) { load_inputs(F); PH_BEGIN(8); pg8::DenseSched S; S.init(wsp<bf16>(F, WS_VM), wsp<bf16>(F, WS_WOUT), M_LAT, D, D, F.G, vc); EpiOut E{F.x, F.out, wsp<float>(F, WS_MODV)};
        pg8::gemm_phase<EpiOut, pg8::DenseSched, false>(F.lds, S, E, F.wave); SEAM(8); PH_END(8); }
    if (IN(9)) REPS(9) { load_inputs(F); PH_BEGIN(9); p9_route(F); if (IN(9) && IN(11)) xcd_barrier(bar, F.tid); PH_END(9); }
    if (IN(11)) REPS(11) { load_inputs(F); PH_BEGIN(11); moe_layout(F); pg8::GroupSched<true> S; S.A = wsp<bf16>(F, WS_H2); S.Bt = wsp<bf16>(F, WS_WUP); S.list_tok = wsp<int>(F, WS_LTOK); S.tab = (const LAS int*)(F.lds + LDS_TAB);
        S.K = 1024; S.ntiles = S.tab[17]; S.G = F.G; S.c = vc; EpiUp E{F.ws};
        pg8::gemm_phase<EpiUp, pg8::GroupSched<true>, true>(F.lds, S, E, F.wave); moe_weight_copies<1>(F, F.G == 256 ? (S.ntiles * 4) % 256 : 0); SEAM(11); PH_END(11); }
    if (IN(12)) REPS(12) { load_inputs(F); PH_BEGIN(12); moe_layout(F); pg8::GroupSched<false> S; S.A = wsp<bf16>(F, WS_HID); S.Bt = wsp<bf16>(F, WS_WDN); S.list_tok = nullptr; S.tab = (const LAS int*)(F.lds + LDS_TAB);
        S.K = 512; S.ntiles = S.tab[17]; S.G = F.G; S.c = vc; EpiDown E{F.ws, (const LAS int*)(F.lds + LDS_TAB)};
        pg8::gemm_phase<EpiDown, pg8::GroupSched<false>, true>(F.lds, S, E, F.wave); SEAM(12); PH_END(12); }
    if (IN(13)) REPS(13) { load_inputs(F); PH_BEGIN(13); p13_final(F); PH_END(13); }
#ifdef PROBE_SEL
    if (F.bid == PROBE_WG && F.tid == 0) { const unsigned long long d_ = PROBE_SEL < 20 ? pdur_ : (unsigned long long)F.MISC[65]; const unsigned long long te_ = __builtin_amdgcn_s_memrealtime() + 4ull * d_;
        while (__builtin_amdgcn_s_memrealtime() < te_) __builtin_amdgcn_s_sleep(8); }
#endif
#undef IN
#undef SEAM
}

extern "C" void kernel_launch(void* const* d_in, const int* in_sizes, int n_in, void* d_out, int out_size, void* d_ws, size_t ws_size, hipStream_t stream) {
    static int grid = 0;
    if (grid == 0) {
        if (n_in != 26 || out_size != M_LAT * D || ws_size < WS_END) { fprintf(stderr, "kernel_launch: unexpected shapes (n_in %d, out %d, ws %zu)\n", n_in, out_size, ws_size); grid = -1; return; }
        int dev = 0, cus = 0, per_cu = 0;
        if (hipGetDevice(&dev) != hipSuccess || hipDeviceGetAttribute(&cus, hipDeviceAttributeMultiprocessorCount, dev) != hipSuccess) { grid = -1; return; }
        if (hipFuncSetAttribute((const void*)mk_fwd, hipFuncAttributeMaxDynamicSharedMemorySize, LDS_BYTES) != hipSuccess) { fprintf(stderr, "kernel_launch: hipFuncSetAttribute failed\n"); grid = -1; return; }
        if (hipOccupancyMaxActiveBlocksPerMultiprocessor(&per_cu, (const void*)mk_fwd, NTHR, LDS_BYTES) != hipSuccess || per_cu < 1) fprintf(stderr, "kernel_launch: occupancy query reports %d\n", per_cu);
        (void)hipGetLastError();
        grid = cus;
    }
    if (grid < 0) return;
    (void)hipMemsetAsync((char*)d_ws + WS_CTL, 0, CTL_ZERO_BYTES, stream);
    Args a{};
    for (int i = 0; i < 26; ++i) a.in[i] = (const float*)d_in[i];
    a.out = (float*)d_out; a.ws = (unsigned char*)d_ws;
#if MK_ONE_LAUNCH
    a.ph_lo = 0; a.ph_hi = N_PHASES;
    hipLaunchKernelGGL(mk_fwd, dim3(grid), dim3(NTHR), LDS_BYTES, stream, a);
#else
    for (int p = 0; p < N_PHASES; ++p) { a.ph_lo = p; a.ph_hi = p + 1; hipLaunchKernelGGL(mk_fwd, dim3(grid), dim3(NTHR), LDS_BYTES, stream, a); }
#endif
}
```
